# Optimizing an MI355X kernel written in HIP

```python
import math
import jax, jax.numpy as jnp
from jax import lax
import numpy as np

D_MODEL = 2048
BATCH = 16
SEQ = 256
DEPTH = 4
DEC_BATCH = 4
DEC_SEQ = 1024
PAST_LEN = 512

GRID_W = 64
RG_WIDTH = 1024
RG_HEADS = 8
RG_BLOCK = RG_WIDTH // RG_HEADS
RG_CONV = 4
RG_C = 8.0
S5_WIDTH = 1024
S5_GROUP_CH = 16
S5_GROUPS = S5_WIDTH // S5_GROUP_CH
S5_STATE = 64
NA_HEADS = 8
NA_HEAD_DIM = 128
NA_WIDTH = NA_HEADS * NA_HEAD_DIM
NA_KH = 8
NA_KW = 16
NA_QB_W = 16
NA_KB_W = 32
NA_SCALE = NA_HEAD_DIM ** -0.5
Q_BLOCK = 128
NEG_INF = -1e30
N_BRANCH = 3
FF_HIDDEN = (8 * D_MODEL + 3 * 256 - 1) // (3 * 256) * 256
RMS_EPS = 1e-6
OFF_RG_X = 0
OFF_RG_G = OFF_RG_X + RG_WIDTH
OFF_S5 = OFF_RG_G + RG_WIDTH
OFF_Q = OFF_S5 + S5_WIDTH
OFF_K = OFF_Q + NA_WIDTH
OFF_V = OFF_K + NA_WIDTH
OFF_GATE = OFF_V + NA_WIDTH
IN_WIDTH = OFF_GATE + N_BRANCH * D_MODEL

kernel_name = "hybrid_rglru_s5_natten_prefix_dit_step"


def rms_norm(x, g):
    xf = x.astype(jnp.float32)
    y = xf * lax.rsqrt(jnp.mean(xf * xf, axis=-1, keepdims=True) + RMS_EPS)
    return (y * g.astype(jnp.float32)).astype(x.dtype)


def modulation(cond, w_mod, b_mod):
    m = jax.nn.silu(cond) @ w_mod + b_mod
    return jnp.split(m, 6, axis=-1)


def linear_scan(a, b, h0, reverse):
    if reverse:
        b = b.at[:, -1].add(a[:, -1] * h0)
    else:
        b = b.at[:, 0].add(a[:, 0] * h0)

    def combine(l, r):
        return (l[0] * r[0], r[0] * l[1] + r[1])

    _, h = lax.associative_scan(combine, (a, b), reverse=reverse, axis=1)
    return h


def depthwise_conv_centred(x, w, b):
    k = w.shape[0]
    pad_l = (k - 1) // 2
    y = lax.conv_general_dilated(x, w[:, None, :], window_strides=(1,), padding=[(pad_l, k - 1 - pad_l)],
                                 dimension_numbers=('NWC', 'WIO', 'NWC'), feature_group_count=x.shape[-1])
    return y + b


def rglru_branch(xr, xg, conv_w, conv_b, gate_w, gate_b, lam, h0, return_state):
    f32 = jnp.float32
    x = depthwise_conv_centred(xr, conv_w, conv_b)
    bsz, length, _ = x.shape
    xh = x.reshape(bsz, length, RG_HEADS, RG_BLOCK)
    gl = jnp.einsum('blhi,dghij->dgblhj', xh, gate_w).reshape(2, 2, bsz, length, RG_WIDTH)
    gates = jax.nn.sigmoid((gl + gate_b[:, :, None, None, :]).astype(f32))
    r, i = gates[:, 0], gates[:, 1]
    log_a = -RG_C * r * jax.nn.softplus(-lam.astype(f32))[:, None, None, :]
    a = jnp.exp(log_a)
    bx = jnp.sqrt(-jnp.expm1(2.0 * log_a)) * i * x.astype(f32)[None]
    h_f = linear_scan(a[0], bx[0], h0[:, 0], reverse=False)
    h_b = linear_scan(a[1], bx[1], h0[:, 1], reverse=True)
    y = ((h_f + h_b) * jax.nn.gelu(xg.astype(f32))).astype(xr.dtype)
    if return_state:
        return y, jnp.stack([h_f[:, -1], h_b[:, 0]], axis=1)
    return y


def s5_branch(u, lam_re, lam_im, log_dt, b_re, b_im, c_re, c_im, d, w_glu, h0, return_state):
    f32 = jnp.float32
    bsz, length, _ = u.shape
    uc = u.astype(f32).reshape(bsz, length, S5_GROUPS, S5_GROUP_CH).astype(jnp.complex64)
    lam = lax.complex(lam_re.astype(f32), lam_im.astype(f32))
    dt = jnp.exp(log_dt.astype(f32))[..., None]
    lam_bar = jnp.exp(lam * dt)
    b_bar = ((lam_bar - 1.0) / lam)[..., None] * lax.complex(b_re.astype(f32), b_im.astype(f32))
    bu = jnp.einsum('blgn,dgpn->dblgp', uc, b_bar)
    h_f = linear_scan(jnp.broadcast_to(lam_bar[0], bu.shape[1:]), bu[0], h0[:, 0], reverse=False)
    h_b = linear_scan(jnp.broadcast_to(lam_bar[1], bu.shape[1:]), bu[1], h0[:, 1], reverse=True)
    c_mat = lax.complex(c_re.astype(f32), c_im.astype(f32))
    y = jnp.real(jnp.einsum('blgp,gnp->blgn', h_f, c_mat[0]) + jnp.einsum('blgp,gnp->blgn', h_b, c_mat[1]))
    y = y.reshape(bsz, length, S5_WIDTH) + d.astype(f32) * u.astype(f32)
    z = jax.nn.gelu(y)
    out = (z * jax.nn.sigmoid(z @ w_glu.astype(f32))).astype(u.dtype)
    if return_state:
        return out, jnp.stack([h_f[:, -1], h_b[:, 0]], axis=1)
    return out


def context_attention(q, k, v):
    bsz, length, h, dh = q.shape
    qb = q.reshape(bsz, length // Q_BLOCK, Q_BLOCK, h, dh).transpose(1, 0, 2, 3, 4)

    def one_block(qi):
        s = jnp.einsum('bqhd,bkhd->bhqk', qi, k).astype(jnp.float32)
        p = jax.nn.softmax(s, axis=-1).astype(v.dtype)
        return jnp.einsum('bhqk,bkhd->bqhd', p, v)

    o = lax.map(one_block, qb)
    return o.transpose(1, 0, 2, 3, 4).reshape(bsz, length, h * dh)


def _na_tables(rows):
    kh = min(NA_KH, rows)
    ncb = GRID_W // NA_QB_W
    r = np.arange(rows)
    row_start = np.clip(r - kh // 2, 0, rows - kh)
    key_rows = row_start[:, None] + np.arange(kh)[None, :]
    blk_start = np.clip(np.arange(ncb) * NA_QB_W - NA_KW // 2, 0, GRID_W - NA_KB_W)
    key_cols = blk_start[:, None] + np.arange(NA_KB_W)[None, :]
    q_cols = np.arange(ncb)[:, None] * NA_QB_W + np.arange(NA_QB_W)[None, :]
    win_start = np.clip(q_cols - NA_KW // 2, 0, GRID_W - NA_KW)
    in_win = (key_cols[:, None, :] >= win_start[:, :, None]) & (key_cols[:, None, :] < win_start[:, :, None] + NA_KW)
    key_idx = (key_rows[:, None, :, None] * GRID_W + key_cols[None, :, None, :]).reshape(rows, ncb, kh * NA_KB_W)
    row_part = (key_rows - r[:, None] + NA_KH - 1) * (2 * NA_KW - 1)
    col_part = np.clip(key_cols[:, None, :] - q_cols[:, :, None], -(NA_KW - 1), NA_KW - 1) + NA_KW - 1
    bias_idx = (row_part[:, None, None, :, None] + col_part[None, :, :, None, :]).reshape(rows, ncb, NA_QB_W, kh * NA_KB_W)
    mask = np.broadcast_to(in_win[None, :, :, None, :], (rows, ncb, NA_QB_W, kh, NA_KB_W)).reshape(rows, ncb, NA_QB_W, kh * NA_KB_W)
    return jnp.asarray(key_idx, jnp.int32), jnp.asarray(bias_idx, jnp.int32), jnp.asarray(mask)


def neighbourhood_attention(q, k, v, k_ctx, v_ctx, rpb, rows):
    bsz, length, h, dh = q.shape
    ncb = GRID_W // NA_QB_W
    key_idx, bias_idx, mask = _na_tables(rows)
    rpb_flat = rpb.reshape(h, -1)
    q_rows = q.reshape(bsz, rows, ncb, NA_QB_W, h, dh).transpose(1, 0, 2, 3, 4, 5)

    def row_step(args):
        q_r, kidx, bidx, msk = args
        k_loc = k[:, kidx]
        v_loc = v[:, kidx]
        s_loc = jnp.einsum('bjqhd,bjkhd->bhjqk', q_r, k_loc).astype(jnp.float32)
        s_loc = jnp.where(msk, s_loc + rpb_flat[:, bidx].astype(jnp.float32), NEG_INF)
        s_ctx = jnp.einsum('bjqhd,bchd->bhjqc', q_r, k_ctx).astype(jnp.float32)
        p = jax.nn.softmax(jnp.concatenate([s_loc, s_ctx], axis=-1), axis=-1).astype(v.dtype)
        kb = kidx.shape[-1]
        return (jnp.einsum('bhjqk,bjkhd->bjqhd', p[..., :kb], v_loc)
                + jnp.einsum('bhjqc,bchd->bjqhd', p[..., kb:], v_ctx))

    o = lax.map(row_step, (q_rows, key_idx, bias_idx, mask))
    return o.transpose(1, 0, 2, 3, 4, 5).reshape(bsz, length, h * dh)


def mixer_proj(x, g_pre, shift, scale, w_in):
    proj = (rms_norm(x, g_pre) * (1 + scale) + shift) @ w_in
    bsz, length, _ = proj.shape
    xr = proj[..., OFF_RG_X:OFF_RG_G]
    xg = proj[..., OFF_RG_G:OFF_S5]
    u = proj[..., OFF_S5:OFF_Q]
    q = proj[..., OFF_Q:OFF_K].reshape(bsz, length, NA_HEADS, NA_HEAD_DIM) * NA_SCALE
    k = proj[..., OFF_K:OFF_V].reshape(bsz, length, NA_HEADS, NA_HEAD_DIM)
    v = proj[..., OFF_V:OFF_GATE].reshape(bsz, length, NA_HEADS, NA_HEAD_DIM)
    return xr, xg, u, q, k, v, proj[..., OFF_GATE:]


def merge_branches(x, gate_logits, y_rg, y_s5, y_na, w_rg_out, w_s5_out, w_na_out, w_o, g_post, gate):
    g = jax.nn.sigmoid(gate_logits.astype(jnp.float32)).astype(x.dtype)
    g_rg, g_s5, g_na = jnp.split(g, N_BRANCH, axis=-1)
    m = g_rg * (y_rg @ w_rg_out) + g_s5 * (y_s5 @ w_s5_out) + g_na * (y_na @ w_na_out)
    return x + gate * rms_norm(m @ w_o, g_post)


def ffn_sublayer(x, g_pre, g_post, shift, scale, gate, w_ffn_in, w_ffn_out):
    h = rms_norm(x, g_pre) * (1 + scale) + shift
    a, b = jnp.split(h @ w_ffn_in, 2, axis=-1)
    return x + gate * rms_norm((jax.nn.silu(a) * b) @ w_ffn_out, g_post)


def setup_inputs(seed: int = 0) -> dict:
    key = jax.random.key(seed)
    ks = iter(jax.random.split(key, 48))
    D = D_MODEL

    def nrm(shape, s):
        return jax.random.normal(next(ks), shape, jnp.float32) * s

    x_prompt = nrm((BATCH, SEQ, D), 1.0)
    x_sample = nrm((DEC_BATCH, DEC_SEQ, D), 1.0)
    cache_na_k = nrm((DEC_BATCH, DEPTH, PAST_LEN, NA_HEADS, NA_HEAD_DIM), 1.0)
    cache_na_v = nrm((DEC_BATCH, DEPTH, PAST_LEN, NA_HEADS, NA_HEAD_DIM), 1.0)
    state_rglru = nrm((DEC_BATCH, DEPTH, 2, RG_WIDTH), 1.0)
    state_s5 = nrm((DEC_BATCH, DEPTH, 2, S5_GROUPS, S5_STATE, 2), 0.1)
    c = nrm((DEC_BATCH, D), 1.0)
    c_ctx = nrm((D,), 1.0)
    w_mod = nrm((DEPTH, D, 6 * D), 0.5 * D ** -0.5)
    b_mod = nrm((DEPTH, 6 * D), 0.02)
    g_mix_pre = 1.0 + nrm((DEPTH, D), 0.02)
    g_mix_post = 1.0 + nrm((DEPTH, D), 0.02)
    g_ffn_pre = 1.0 + nrm((DEPTH, D), 0.02)
    g_ffn_post = 1.0 + nrm((DEPTH, D), 0.02)
    w_in = nrm((DEPTH, D, IN_WIDTH), D ** -0.5)
    rg_conv_w = nrm((DEPTH, RG_CONV, RG_WIDTH), RG_CONV ** -0.5)
    rg_conv_b = nrm((DEPTH, RG_WIDTH), 0.02)
    rg_gate_w = nrm((DEPTH, 2, 2, RG_HEADS, RG_BLOCK, RG_BLOCK), RG_BLOCK ** -0.5)
    rg_gate_b = nrm((DEPTH, 2, 2, RG_WIDTH), 0.02)
    a_pow = jax.random.uniform(next(ks), (DEPTH, 2, RG_WIDTH), jnp.float32, 0.9, 0.999)
    a_base = a_pow ** (1.0 / RG_C)
    rg_lambda = jnp.log(a_base) - jnp.log1p(-a_base)
    s5_lambda_re = -0.5 + nrm((DEPTH, 2, S5_GROUPS, S5_STATE), 0.01)
    s5_lambda_im = math.pi * jnp.arange(S5_STATE, dtype=jnp.float32) + nrm((DEPTH, 2, S5_GROUPS, S5_STATE), 0.01)
    s5_log_dt = jax.random.uniform(next(ks), (DEPTH, 2, S5_GROUPS), jnp.float32, math.log(1e-3), math.log(1e-1))
    s5_b_re = nrm((DEPTH, 2, S5_GROUPS, S5_STATE, S5_GROUP_CH), (2 * S5_GROUP_CH) ** -0.5)
    s5_b_im = nrm((DEPTH, 2, S5_GROUPS, S5_STATE, S5_GROUP_CH), (2 * S5_GROUP_CH) ** -0.5)
    s5_c_re = nrm((DEPTH, 2, S5_GROUPS, S5_GROUP_CH, S5_STATE), S5_STATE ** -0.5)
    s5_c_im = nrm((DEPTH, 2, S5_GROUPS, S5_GROUP_CH, S5_STATE), S5_STATE ** -0.5)
    s5_d = nrm((DEPTH, S5_WIDTH), 1.0)
    s5_w_glu = nrm((DEPTH, S5_WIDTH, S5_WIDTH), S5_WIDTH ** -0.5)
    na_rpb = nrm((DEPTH, NA_HEADS, 2 * NA_KH - 1, 2 * NA_KW - 1), 0.02)
    w_rg_out = nrm((DEPTH, RG_WIDTH, D), RG_WIDTH ** -0.5)
    w_s5_out = nrm((DEPTH, S5_WIDTH, D), S5_WIDTH ** -0.5)
    w_na_out = nrm((DEPTH, NA_WIDTH, D), NA_WIDTH ** -0.5)
    w_o = nrm((DEPTH, D, D), D ** -0.5)
    w_ffn_in = nrm((DEPTH, D, 2 * FF_HIDDEN), D ** -0.5)
    w_ffn_out = nrm((DEPTH, FF_HIDDEN, D), FF_HIDDEN ** -0.5)
    return {"x_prompt": x_prompt, "x_sample": x_sample, "cache_na_k": cache_na_k, "cache_na_v": cache_na_v,
            "state_rglru": state_rglru, "state_s5": state_s5, "c": c, "c_ctx": c_ctx,
            "w_mod": w_mod, "b_mod": b_mod, "g_mix_pre": g_mix_pre, "g_mix_post": g_mix_post,
            "g_ffn_pre": g_ffn_pre, "g_ffn_post": g_ffn_post, "w_in": w_in,
            "rg_conv_w": rg_conv_w, "rg_conv_b": rg_conv_b, "rg_gate_w": rg_gate_w, "rg_gate_b": rg_gate_b,
            "rg_lambda": rg_lambda, "s5_lambda_re": s5_lambda_re, "s5_lambda_im": s5_lambda_im,
            "s5_log_dt": s5_log_dt, "s5_b_re": s5_b_re, "s5_b_im": s5_b_im, "s5_c_re": s5_c_re,
            "s5_c_im": s5_c_im, "s5_d": s5_d, "s5_w_glu": s5_w_glu, "na_rpb": na_rpb,
            "w_rg_out": w_rg_out, "w_s5_out": w_s5_out, "w_na_out": w_na_out, "w_o": w_o,
            "w_ffn_in": w_ffn_in, "w_ffn_out": w_ffn_out}


def reference(x_prompt, x_sample, cache_na_k, cache_na_v, state_rglru, state_s5, c, c_ctx,
              w_mod, b_mod, g_mix_pre, g_mix_post, g_ffn_pre, g_ffn_post, w_in,
              rg_conv_w, rg_conv_b, rg_gate_w, rg_gate_b, rg_lambda,
              s5_lambda_re, s5_lambda_im, s5_log_dt, s5_b_re, s5_b_im, s5_c_re, s5_c_im, s5_d, s5_w_glu,
              na_rpb, w_rg_out, w_s5_out, w_na_out, w_o, w_ffn_in, w_ffn_out):
    f32 = jnp.float32
    rows = x_sample.shape[1] // GRID_W
    bp = x_prompt.shape[0]
    s5_cache = lax.complex(state_s5[..., 0].astype(f32), state_s5[..., 1].astype(f32))
    rg_zero = jnp.zeros((bp, 2, RG_WIDTH), f32)
    s5_zero = jnp.zeros((bp, 2, S5_GROUPS, S5_STATE), jnp.complex64)
    xp, xs = x_prompt, x_sample
    ks, vs, rgs, s5s = [], [], [], []
    for l in range(DEPTH):
        rg_p = (rg_conv_w[l], rg_conv_b[l], rg_gate_w[l], rg_gate_b[l], rg_lambda[l])
        s5_p = (s5_lambda_re[l], s5_lambda_im[l], s5_log_dt[l], s5_b_re[l], s5_b_im[l],
                s5_c_re[l], s5_c_im[l], s5_d[l], s5_w_glu[l])
        out_p = (w_rg_out[l], w_s5_out[l], w_na_out[l], w_o[l])

        mp = modulation(c_ctx[None, None, :], w_mod[l], b_mod[l])
        xr, xg, u, q, k, v, gl = mixer_proj(xp, g_mix_pre[l], mp[0], mp[1], w_in[l])
        y_rg, st_rg = rglru_branch(xr, xg, *rg_p, rg_zero, True)
        y_s5, st_s5 = s5_branch(u, *s5_p, s5_zero, True)
        y_na = context_attention(q, k, v)
        xp = merge_branches(xp, gl, y_rg, y_s5, y_na, *out_p, g_mix_post[l], mp[2])
        xp = ffn_sublayer(xp, g_ffn_pre[l], g_ffn_post[l], mp[3], mp[4], mp[5], w_ffn_in[l], w_ffn_out[l])
        ks.append(k)
        vs.append(v)
        rgs.append(st_rg)
        s5s.append(jnp.stack([jnp.real(st_s5), jnp.imag(st_s5)], axis=-1))

        ms = modulation(c[:, None, :], w_mod[l], b_mod[l])
        xr, xg, u, q, k, v, gl = mixer_proj(xs, g_mix_pre[l], ms[0], ms[1], w_in[l])
        y_rg = rglru_branch(xr, xg, *rg_p, state_rglru[:, l], False)
        y_s5 = s5_branch(u, *s5_p, s5_cache[:, l], False)
        y_na = neighbourhood_attention(q, k, v, cache_na_k[:, l], cache_na_v[:, l], na_rpb[l], rows)
        xs = merge_branches(xs, gl, y_rg, y_s5, y_na, *out_p, g_mix_post[l], ms[2])
        xs = ffn_sublayer(xs, g_ffn_pre[l], g_ffn_post[l], ms[3], ms[4], ms[5], w_ffn_in[l], w_ffn_out[l])

    new_na_k = jnp.stack(ks, axis=1)
    new_na_v = jnp.stack(vs, axis=1)
    new_rglru = jnp.stack(rgs, axis=1)
    new_s5 = jnp.stack(s5s, axis=1)
    return (xp, xs, new_na_k, new_na_v, new_rglru, new_s5)
```

```cpp
#include <hip/hip_runtime.h>
#include <hip/hip_bf16.h>
#include <cstdio>
#include <cstdint>

#ifndef MK_N_LAUNCHES
#define MK_N_LAUNCHES 1
#endif
#ifndef DBG_KEEP
#define DBG_KEEP 0
#endif
#ifndef DBG_LMASK
#define DBG_LMASK 15
#endif
#ifndef DBG_DUMP
#define DBG_DUMP 0
#endif
#ifndef DBG_NL
#define DBG_NL 4
#endif

constexpr int DM = 2048, ROWS = 8192, CTXR = 4096, INW = 12288, FFH = 5632, NL = 4, W1K = 1024;
constexpr int NCV = 5;
constexpr float RMS_EPS = 1e-6f;
constexpr size_t MiB = 1u << 20;

constexpr size_t O_X = 0, O_K = 16777216, O_V = 33554432, O_RG = 50331648, O_S5 = 50462720, O_END = 51511296;

constexpr size_t WS_CTL = 0, CTL_ZERO_BYTES = 1 * MiB;
constexpr size_t WS_MODP = 1 * MiB;
constexpr size_t WS_MOD  = 17 * MiB;
constexpr size_t WS_SP   = 18 * MiB;
constexpr size_t WS_LT   = 18 * MiB + 65536;
constexpr size_t WS_GWT  = 19 * MiB;
constexpr size_t WS_WINT = 24 * MiB;
constexpr size_t WS_GLUT = 216 * MiB;
constexpr size_t WS_OUTT = 224 * MiB;
constexpr size_t WS_WOT  = 272 * MiB;
constexpr size_t WS_FINT = 304 * MiB;
constexpr size_t WS_FOUTT = 480 * MiB;
constexpr size_t WS_MT   = 568 * MiB;
constexpr size_t WS_ET   = 600 * MiB;
constexpr size_t WS_FT   = 632 * MiB;
constexpr size_t WS_CK   = 664 * MiB;
constexpr size_t WS_CV   = 680 * MiB;
constexpr size_t WS_H    = 696 * MiB;
constexpr size_t WS_XR   = 728 * MiB;
constexpr size_t WS_XG   = 744 * MiB;
constexpr size_t WS_XC   = 760 * MiB;
constexpr size_t WS_Q    = 776 * MiB;
constexpr size_t WS_K    = 792 * MiB;
constexpr size_t WS_V    = 808 * MiB;
constexpr size_t WS_YRG  = 824 * MiB;
constexpr size_t WS_YS5  = 840 * MiB;
constexpr size_t WS_YNA  = 856 * MiB;
constexpr size_t WS_ZS   = 872 * MiB;
constexpr size_t WS_UG   = 888 * MiB;
constexpr size_t WS_HIN  = 904 * MiB;
constexpr size_t WS_G    = 920 * MiB;
constexpr size_t WS_AB   = 1016 * MiB;
constexpr size_t WS_FH   = 1016 * MiB;
constexpr size_t WS_HF   = 1144 * MiB;
constexpr size_t WS_HLOC = 1176 * MiB;
constexpr size_t WS_Z    = 1144 * MiB;
constexpr size_t WS_MM   = 1208 * MiB;
constexpr size_t WS_END  = 1240 * MiB;

constexpr int CW_TMO = 0, CW_BAR = 4096;

constexpr int RING_BYTES = 131072;
constexpr int LDSCTL_OFF = RING_BYTES, MISC_OFF = LDSCTL_OFF + 320;
constexpr int LDS_BYTES = 147456;

#define GAS __attribute__((address_space(1)))
#define LAS __attribute__((address_space(3)))
typedef unsigned short bf16;
typedef unsigned v4u __attribute__((ext_vector_type(4)));
typedef unsigned v2u __attribute__((ext_vector_type(2)));
typedef float f32x4 __attribute__((ext_vector_type(4)));
typedef float f32x2 __attribute__((ext_vector_type(2)));
typedef short bf16x8 __attribute__((ext_vector_type(8)));
typedef GAS unsigned gu32;
#define RLX_AGENT __ATOMIC_RELAXED, __HIP_MEMORY_SCOPE_AGENT
#define LDS_WAIT() asm volatile("s_waitcnt lgkmcnt(0)" ::: "memory")
#define VM_WAIT() asm volatile("s_waitcnt vmcnt(0)" ::: "memory")

__device__ __forceinline__ unsigned f2bf(float f) { unsigned u = __builtin_bit_cast(unsigned, f); return (u + 0x7fffu + ((u >> 16) & 1u)) >> 16; }
typedef __bf16 bf16x2_t __attribute__((ext_vector_type(2)));
__device__ __forceinline__ unsigned pk2(float lo, float hi) { const f32x2 v = {lo, hi}; const bf16x2_t b = __builtin_convertvector(v, bf16x2_t); return __builtin_bit_cast(unsigned, b); }
__device__ __forceinline__ float bflo(unsigned w) { return __builtin_bit_cast(float, w << 16); }
__device__ __forceinline__ float bfhi(unsigned w) { return __builtin_bit_cast(float, w & 0xffff0000u); }
__device__ __forceinline__ float bf2f(bf16 h) { return __builtin_bit_cast(float, (unsigned)h << 16); }
__device__ __forceinline__ float fsigmoid(float x) { return __builtin_amdgcn_rcpf(1.0f + __expf(-x)); }
__device__ __forceinline__ float gelu_tanh(float x) { const float y = 0.7978845608028654f * (x + 0.044715f * x * x * x); return x * __builtin_amdgcn_rcpf(1.0f + __expf(-2.0f * y)); }
__device__ __forceinline__ float wave_sum(float v) {
#pragma unroll
    for (int o = 1; o < 64; o <<= 1) v += __shfl_xor(v, o);
    return v;
}
__device__ __forceinline__ void unpack8(const v4u w, float (&f)[8]) { f[0] = bflo(w.x); f[1] = bfhi(w.x); f[2] = bflo(w.y); f[3] = bfhi(w.y); f[4] = bflo(w.z); f[5] = bfhi(w.z); f[6] = bflo(w.w); f[7] = bfhi(w.w); }
__device__ __forceinline__ v4u pack8(const float (&f)[8]) { v4u w; w.x = pk2(f[0], f[1]); w.y = pk2(f[2], f[3]); w.z = pk2(f[4], f[5]); w.w = pk2(f[6], f[7]); return w; }

#define XB_TMO      128
#define XB_XCNT(j)  (256  + 64 * (j))
#define XB_XSUB(j)  (1280 + 64 * (j))
#define XB_XGEN(j)  (2304 + 64 * (j))
#define XB_TOP      3328
#define XB_TOPGEN   3392
#define XCD_BAR_WORDS 3456
#define XB_SPIN_CAP (1u << 18)
__device__ __forceinline__ unsigned xb_ld(unsigned* p)              { return __hip_atomic_load(p, __ATOMIC_RELAXED, __HIP_MEMORY_SCOPE_AGENT); }
__device__ __forceinline__ unsigned xb_add(unsigned* p, unsigned v) { return __hip_atomic_fetch_add(p, v, __ATOMIC_RELAXED, __HIP_MEMORY_SCOPE_AGENT); }
__device__ __forceinline__ unsigned xb_xcc_id() { return (unsigned)__builtin_amdgcn_s_getreg((3 << 11) | 20) & 0xFu; }
#define XB_SPIN(cond, bar) do { unsigned _sp = 0; while (cond) { __builtin_amdgcn_s_sleep(1); \
    if ((++_sp & 255u) == 0u) { if (xb_ld(&(bar)[XB_TMO])) break; if (_sp > XB_SPIN_CAP) { atomicAdd(&(bar)[XB_TMO], 1u); break; } } } } while (0)
struct XcdBarrier { unsigned* bar; unsigned x; volatile LAS unsigned* st; };
__device__ __forceinline__ XcdBarrier xcd_barrier_post(unsigned* bar, volatile LAS unsigned* st) {
    XcdBarrier b; b.bar = bar; b.x = xb_xcc_id(); b.st = st;
    if (threadIdx.x == 0) (void)xb_add(&bar[XB_XCNT(b.x)], 1u);
    return b;
}
__device__ __forceinline__ void xcd_barrier_complete(unsigned* bar, unsigned x, unsigned& nloc, unsigned& nx) {
    const unsigned G = gridDim.x * gridDim.y * gridDim.z;
    unsigned sum, cnt, mine, sp = 0u;
    for (;;) {
        sum = 0u; cnt = 0u; mine = 0u;
#pragma unroll
        for (unsigned j = 0; j < 16; ++j) { const unsigned c = xb_ld(&bar[XB_XCNT(j)]); sum += c; cnt += (c > 0u) ? 1u : 0u; mine = (j == x) ? c : mine; }
        if (sum == G) break;
        __builtin_amdgcn_s_sleep(1);
        if ((++sp & 255u) == 0u) { if (xb_ld(&bar[XB_TMO])) break; if (sp > XB_SPIN_CAP) { atomicAdd(&bar[XB_TMO], 1u); break; } }
    }
    nloc = mine > 0u ? mine : 1u; nx = cnt > 0u ? cnt : 1u;
}
__device__ __forceinline__ void xcd_barrier(const XcdBarrier& b) {
    asm volatile("s_waitcnt vmcnt(0)" ::: "memory");
    __syncthreads();
    int tid_b = threadIdx.x; asm volatile("" : "+v"(tid_b));
    if (tid_b == 0) {
        unsigned* bar = b.bar;
        __builtin_amdgcn_s_waitcnt(0);
        unsigned nloc = b.st[0], nx = b.st[1];
        if (nloc == 0u) { xcd_barrier_complete(bar, b.x, nloc, nx); b.st[0] = nloc; b.st[1] = nx; }
        const unsigned old = xb_add(&bar[XB_XSUB(b.x)], 1u);
        const unsigned gen = old / nloc;
        if (old + 1u == (gen + 1u) * nloc) {
            __builtin_amdgcn_fence(__ATOMIC_RELEASE, "agent");
            asm volatile("s_waitcnt vmcnt(0)" ::: "memory");
            const unsigned og = xb_add(&bar[XB_TOP], 1u);
            const unsigned tg = og / nx;
            if (og + 1u == (tg + 1u) * nx) xb_add(&bar[XB_TOPGEN], 1u);
            else XB_SPIN(xb_ld(&bar[XB_TOPGEN]) == tg, bar);
            __builtin_amdgcn_fence(__ATOMIC_ACQUIRE, "agent");
            xb_add(&bar[XB_XGEN(b.x)], 1u);
            asm volatile("s_waitcnt vmcnt(0)" ::: "memory");
        } else {
            XB_SPIN(xb_ld(&bar[XB_XGEN(b.x)]) == gen, bar);
            __builtin_amdgcn_fence(__ATOMIC_ACQUIRE, "agent");
            asm volatile("s_waitcnt vmcnt(0)" ::: "memory");
        }
    }
    __syncthreads();
}

namespace pg8 {
#define PG8_LAS __attribute__((address_space(3)))
constexpr int BM = 256, BK = 64, HALF = 128, HTB = HALF * BK * 2, STAGE_BYTES = 8 * HTB;
__host__ __device__ __forceinline__ int lds_byte(int r, int c) { const int st = (r >> 4) * 2 + (c >> 5), rr = r & 15, cc = c & 31, ob = rr * 64 + cc * 2; return st * 1024 + (ob ^ (((ob >> 9) & 1) << 5)); }
__host__ __device__ __forceinline__ void stage_rc(int b, int& R, int& C) { const int st = b / 1024, sb = b % 1024, swz = sb ^ (((sb >> 9) & 1) << 5); R = (st >> 1) * 16 + swz / 64; C = (st & 1) * 32 + (swz % 64) / 2; }
__host__ __device__ __forceinline__ int perm32(int rho) { const int n = rho >> 4, i = rho & 15; return 8 * (i >> 2) + 4 * n + (i & 3); }

struct Unit { const char* A; const char* B; int pm, pn, aux, last; };

__device__ __forceinline__ bool tile_order(long L, int nM, int nN, int& pm, int& pn) {
    const int nwg = nM * nN; if (L >= nwg) return false;
    int wgid = (int)L; { const int q = nwg / 8, r = nwg % 8, xcd = wgid % 8, off = wgid / 8; wgid = (xcd < r ? xcd * (q + 1) : r * (q + 1) + (xcd - r) * q) + off; }
    const int nig = 8 * nN, gid = wgid / nig, fm = gid * 8, gsz = (nM - fm) < 8 ? (nM - fm) : 8;
    pm = fm + ((wgid % nig) % gsz); pn = (wgid % nig) / gsz; return true;
}

typedef float f32x4 __attribute__((ext_vector_type(4)));
typedef short bf16x8 __attribute__((ext_vector_type(8)));

template <class Epi, class Sched>
__device__ __forceinline__ void gemm_phase(PG8_LAS unsigned char* lds, const int K, const int lda, const int ldb, const Sched& S, const Epi& E) {
    int tid_ = threadIdx.x; asm volatile("" : "+v"(tid_));
    const int tid = tid_, wid = __builtin_amdgcn_readfirstlane(tid >> 6), lane = tid & 63, wr = wid >> 2, wc = wid & 3, fr = lane & 15, fq = lane >> 4;
    const int nt = K / BK;
    unsigned voffA[2], voffB[2];
#pragma unroll
    for (int i = 0; i < 2; ++i) { int R, C; stage_rc(tid * 16 + i * 8192, R, C); const int Rb = Epi::PERM ? ((R & ~31) + perm32(R & 31)) : R;
        voffA[i] = (unsigned)(R * lda + C) * 2u; voffB[i] = (unsigned)(Rb * ldb + C) * 2u; }
    const size_t kstep = (size_t)(BK * 2);
    const size_t hstepA = (size_t)HALF * lda * 2, hstepB = (size_t)HALF * ldb * 2;
    const unsigned ldsw = (unsigned)wid * 1024u;
    const int aoff = lds_byte(wr * 64 + fr, fq * 8), boff = lds_byte(wc * 32 + fr, fq * 8);
#define PG8_SA(b, h) (((b) * 2 + (h)) * HTB)
#define PG8_SB(b, h) ((4 + (b) * 2 + (h)) * HTB)
#define PG8_STAGE(bufoff, gbase, voff) do { _Pragma("unroll") for (int _i = 0; _i < 2; ++_i) \
        __builtin_amdgcn_global_load_lds((const unsigned*)((const char*)(gbase) + (voff)[_i]), (PG8_LAS unsigned*)(lds + (bufoff) + ldsw + _i * 8192), 16, 0, 0); } while (0)
#define PG8_LDA(dst, b, h) do { _Pragma("unroll") for (int m = 0; m < 4; ++m) _Pragma("unroll") for (int k = 0; k < 2; ++k) dst[m][k] = *(const PG8_LAS bf16x8*)(lds + PG8_SA(b, h) + aoff + m * 2048 + k * 1024); } while (0)
#define PG8_LDB(dst, b, h) do { _Pragma("unroll") for (int n = 0; n < 2; ++n) _Pragma("unroll") for (int k = 0; k < 2; ++k) dst[n][k] = *(const PG8_LAS bf16x8*)(lds + PG8_SB(b, h) + boff + n * 2048 + k * 1024); } while (0)
#define PG8_MMA(ai, bj, At, Bt) do { __builtin_amdgcn_s_setprio(1); _Pragma("unroll") for (int m = 0; m < 4; ++m) _Pragma("unroll") for (int n = 0; n < 2; ++n) _Pragma("unroll") for (int k = 0; k < 2; ++k) \
        acc[ai][bj][m][n] = __builtin_amdgcn_mfma_f32_16x16x32_bf16(Bt[n][k], At[m][k], acc[ai][bj][m][n], 0, 0, 0); __builtin_amdgcn_s_setprio(0); } while (0)
#define PG8_WAIT_V(n) asm volatile("s_waitcnt vmcnt(" #n ")" ::: "memory")
#define PG8_WAIT_L(n) asm volatile("s_waitcnt lgkmcnt(" #n ")" ::: "memory")
#define PG8_BAR __builtin_amdgcn_s_barrier()
#define PG8_SCHED __builtin_amdgcn_sched_barrier(0)
    Unit cur, nxt; int ui = 0;
    if (!S.next(0, cur)) return;
    f32x4 acc[2][2][4][2];
#pragma unroll
    for (int a = 0; a < 2; ++a)
#pragma unroll
        for (int b = 0; b < 2; ++b)
#pragma unroll
            for (int m = 0; m < 4; ++m)
#pragma unroll
                for (int n = 0; n < 2; ++n) acc[a][b][m][n] = (f32x4){0.f, 0.f, 0.f, 0.f};
    bf16x8 At[4][2], B0[2][2], B1[2][2];
    const char* cA = cur.A; const char* cB = cur.B;
    PG8_STAGE(PG8_SB(0, 0), cB, voffB); PG8_STAGE(PG8_SB(0, 1), cB + hstepB, voffB); PG8_STAGE(PG8_SA(0, 0), cA, voffA); PG8_STAGE(PG8_SA(0, 1), cA + hstepA, voffA);
    if (wr == 1) PG8_BAR;
    PG8_WAIT_V(2); PG8_BAR;
    PG8_STAGE(PG8_SB(1, 0), cB + kstep, voffB); PG8_STAGE(PG8_SA(1, 0), cA + kstep, voffA); PG8_STAGE(PG8_SB(1, 1), cB + hstepB + kstep, voffB);
    PG8_WAIT_V(6); PG8_BAR;
    for (;;) {
        const bool has_next = S.next(ui + 1, nxt);
        const char* nA = has_next ? nxt.A : cA; const char* nB = has_next ? nxt.B : cB;
#pragma unroll 1
        for (int t = 0; t < nt; t += 2) {
            const bool last = (t == nt - 2);
            const char* a1 = cA + (size_t)(t + 1) * kstep;
            const char* a2 = last ? nA : cA + (size_t)(t + 2) * kstep; const char* b2 = last ? nB : cB + (size_t)(t + 2) * kstep;
            const char* a3 = a2 + kstep; const char* b3 = b2 + kstep;
            PG8_LDB(B0, 0, 0); PG8_LDB(B1, 0, 1); PG8_SCHED; PG8_LDA(At, 0, 0); PG8_STAGE(PG8_SA(1, 1), a1 + hstepA, voffA);
            PG8_WAIT_V(8); PG8_WAIT_L(0); PG8_BAR; PG8_MMA(0, 0, At, B0); PG8_MMA(0, 1, At, B1); PG8_BAR; PG8_SCHED;
            PG8_LDA(At, 0, 1); PG8_STAGE(PG8_SB(0, 0), b2, voffB); PG8_STAGE(PG8_SB(0, 1), b2 + hstepB, voffB); PG8_STAGE(PG8_SA(0, 0), a2, voffA);
            PG8_WAIT_V(8); PG8_WAIT_L(0); PG8_BAR; PG8_MMA(1, 0, At, B0); PG8_MMA(1, 1, At, B1); PG8_BAR; PG8_SCHED;
            PG8_LDB(B0, 1, 0); PG8_LDB(B1, 1, 1); PG8_SCHED; PG8_LDA(At, 1, 0); PG8_STAGE(PG8_SA(0, 1), a2 + hstepA, voffA);
            PG8_WAIT_V(8); PG8_WAIT_L(0); PG8_BAR; PG8_MMA(0, 0, At, B0); PG8_MMA(0, 1, At, B1); PG8_BAR; PG8_SCHED;
            PG8_LDA(At, 1, 1); PG8_STAGE(PG8_SB(1, 0), b3, voffB); PG8_STAGE(PG8_SB(1, 1), b3 + hstepB, voffB); PG8_STAGE(PG8_SA(1, 0), a3, voffA);
            PG8_WAIT_V(8); PG8_WAIT_L(0); PG8_BAR; PG8_MMA(1, 0, At, B0); PG8_MMA(1, 1, At, B1); PG8_BAR; PG8_SCHED;
        }
        if (wr == 0) PG8_BAR;
        if (cur.last) E(acc, cur, wr, wc, fr, fq); else E.mid(acc, cur, wr, wc, fr, fq);
        if (!has_next) break;
        if (cur.last) {
#pragma unroll
            for (int a = 0; a < 2; ++a)
#pragma unroll
                for (int b = 0; b < 2; ++b)
#pragma unroll
                    for (int m = 0; m < 4; ++m)
#pragma unroll
                        for (int n = 0; n < 2; ++n) acc[a][b][m][n] = (f32x4){0.f, 0.f, 0.f, 0.f};
        }
        cur = nxt; cA = nA; cB = nB; ++ui;
        if (wr == 1) PG8_BAR;
    }
    PG8_WAIT_V(0);
    PG8_BAR;
#undef PG8_SA
#undef PG8_SB
#undef PG8_STAGE
#undef PG8_LDA
#undef PG8_LDB
#undef PG8_MMA
#undef PG8_WAIT_V
#undef PG8_WAIT_L
#undef PG8_BAR
#undef PG8_SCHED
}

typedef const f32x4 (&AccC)[2][2][4][2];
typedef f32x4 (&AccM)[2][2][4][2];
#define EPI_ROWS_BEGIN _Pragma("unroll") for (int ai = 0; ai < 2; ++ai) _Pragma("unroll") for (int m = 0; m < 4; ++m) { const int row = u.pm * 256 + ai * 128 + wr * 64 + m * 16 + fr;
#define EPI_ROWS_END }

#define EPI_NO_MID __device__ __forceinline__ void mid(AccM, const Unit&, int, int, int, int) const {}

struct EpiF32 {
    EPI_NO_MID
    static constexpr bool PERM = false;
    float* O; int ldc;
    __device__ __forceinline__ void operator()(AccC acc, const Unit& u, int wr, int wc, int fr, int fq) const {
        const int col0 = u.pn * 256 + wc * 32 + 4 * fq; float* base = O;
        EPI_ROWS_BEGIN
            float* rowp = base + (size_t)row * ldc + col0;
#pragma unroll
            for (int bj = 0; bj < 2; ++bj)
#pragma unroll
                for (int n = 0; n < 2; ++n) *(f32x4*)(rowp + bj * 128 + n * 16) = acc[ai][bj][m][n];
        EPI_ROWS_END
    }
};
struct EpiHloc {
    EPI_NO_MID
    static constexpr bool PERM = false;
    float* O;
    __device__ __forceinline__ void operator()(AccC acc, const Unit& u, int wr, int wc, int fr, int fq) const {
        const int col0 = wc * 32 + 4 * fq; float* base = O + (size_t)u.aux * 512 * 256;
        EPI_ROWS_BEGIN
            float* rowp = base + (size_t)row * 256 + col0;
#pragma unroll
            for (int bj = 0; bj < 2; ++bj)
#pragma unroll
                for (int n = 0; n < 2; ++n) *(f32x4*)(rowp + bj * 128 + n * 16) = acc[ai][bj][m][n];
        EPI_ROWS_END
    }
};
struct EpiWin {
    EPI_NO_MID
    static constexpr bool PERM = true;
    bf16 *XR, *XG, *UG, *Q, *Kb, *Vb, *G; float *outK, *outV;
    __device__ __forceinline__ void operator()(AccC acc, const Unit& u, int wr, int wc, int fr, int fq) const {
        const int pn = u.pn, seg = pn >> 2;
        const int cseg = (pn & 3) * 256 + wc * 32 + 8 * fq;
        EPI_ROWS_BEGIN
#pragma unroll
            for (int bj = 0; bj < 2; ++bj) {
                const f32x4 v0 = acc[ai][bj][m][0], v1 = acc[ai][bj][m][1];
                float f[8] = {v0[0], v0[1], v0[2], v0[3], v1[0], v1[1], v1[2], v1[3]};
                const int c = cseg + bj * 128;
                if (seg >= 6) {
#pragma unroll
                    for (int e = 0; e < 8; ++e) f[e] = fsigmoid(f[e]);
                    *(v4u*)(G + (size_t)row * 6144 + (pn - 24) * 256 + wc * 32 + 8 * fq + bj * 128) = pack8(f);
                } else if (seg == 1) {
#pragma unroll
                    for (int e = 0; e < 8; ++e) f[e] = gelu_tanh(f[e]);
                    *(v4u*)(XG + (size_t)row * 1024 + c) = pack8(f);
                } else if (seg == 2) {
                    const int g = c >> 4, m0 = c & 15;
                    *(v4u*)(UG + ((size_t)g * 512 + (row >> 4)) * 256 + (row & 15) * 16 + m0) = pack8(f);
                } else {
                    bf16* dst = seg == 0 ? XR : (seg == 3 ? Q : (seg == 4 ? Kb : Vb));
                    *(v4u*)(dst + (size_t)row * 1024 + c) = pack8(f);
                    if (seg >= 4 && row < CTXR) {
                        float* o = (seg == 4 ? outK : outV) + ((size_t)(row >> 8) * 4 * 256 + (row & 255)) * 1024 + c;
                        *(f32x4*)o = v0; *(f32x4*)(o + 4) = v1;
                    }
                }
            }
        EPI_ROWS_END
    }
};
struct EpiRg {
    EPI_NO_MID
    static constexpr bool PERM = true;
    const bf16* XC; const float* gb; const float* sp; f32x2* AB;
    __device__ __forceinline__ void operator()(AccC acc, const Unit& u, int wr, int wc, int fr, int fq) const {
        const int h = u.aux >> 1, d = u.aux & 1, c0 = h * 128 + wc * 32 + 8 * fq;
        const float* gbr = gb + (d * 2 + 0) * 1024 + c0; const float* gbi = gb + (d * 2 + 1) * 1024 + c0; const float* spp = sp + d * 1024 + c0;
        EPI_ROWS_BEGIN
            float xc[8]; unpack8(*(const v4u*)(XC + (size_t)row * 1024 + c0), xc);
            const f32x4 r0 = acc[ai][0][m][0], r1 = acc[ai][0][m][1], i0 = acc[ai][1][m][0], i1 = acc[ai][1][m][1];
            const float rr[8] = {r0[0], r0[1], r0[2], r0[3], r1[0], r1[1], r1[2], r1[3]}, ii[8] = {i0[0], i0[1], i0[2], i0[3], i1[0], i1[1], i1[2], i1[3]};
            f32x2* dst = AB + ((size_t)d * ROWS + row) * 1024 + c0;
#pragma unroll
            for (int e = 0; e < 8; e += 2) {
                f32x4 o;
#pragma unroll
                for (int q = 0; q < 2; ++q) {
                    const float r = fsigmoid(rr[e + q] + gbr[e + q]), ig = fsigmoid(ii[e + q] + gbi[e + q]);
                    const float la = -8.0f * r * spp[e + q]; const float a = __expf(la); const float mult = sqrtf(-expm1f(2.0f * la));
                    o[2 * q] = a; o[2 * q + 1] = mult * ig * xc[e + q];
                }
                *(f32x4*)(dst + e) = o;
            }
            asm volatile("" ::: "memory");
        EPI_ROWS_END
    }
};
struct EpiS5Y {
    EPI_NO_MID
    static constexpr bool PERM = true;
    const bf16* UG; const float* dvec; bf16* ZS;
    __device__ __forceinline__ void operator()(AccC acc, const Unit& u, int wr, int wc, int fr, int fq) const {
        const int g = u.aux;
        EPI_ROWS_BEGIN
#pragma unroll
            for (int bj = 0; bj < 2; ++bj) {
                const int col = bj * 128 + wc * 32 + 8 * fq, t = col >> 4, n0 = col & 15;
                float uu[8]; unpack8(*(const v4u*)(UG + ((size_t)g * 512 + row) * 256 + col), uu);
                const f32x4 v0 = acc[ai][bj][m][0], v1 = acc[ai][bj][m][1];
                float f[8] = {v0[0], v0[1], v0[2], v0[3], v1[0], v1[1], v1[2], v1[3]};
#pragma unroll
                for (int e = 0; e < 8; ++e) f[e] = gelu_tanh(f[e] + dvec[g * 16 + n0 + e] * uu[e]);
                *(v4u*)(ZS + ((size_t)row * 16 + t) * 1024 + g * 16 + n0) = pack8(f);
            }
        EPI_ROWS_END
    }
};
struct EpiGlu {
    EPI_NO_MID
    static constexpr bool PERM = true;
    const bf16* ZS; bf16* Y;
    __device__ __forceinline__ void operator()(AccC acc, const Unit& u, int wr, int wc, int fr, int fq) const {
        const int col0 = u.pn * 256 + wc * 32 + 8 * fq;
        EPI_ROWS_BEGIN
#pragma unroll
            for (int bj = 0; bj < 2; ++bj) {
                float z[8]; unpack8(*(const v4u*)(ZS + (size_t)row * 1024 + col0 + bj * 128), z);
                const f32x4 v0 = acc[ai][bj][m][0], v1 = acc[ai][bj][m][1];
                float f[8] = {v0[0], v0[1], v0[2], v0[3], v1[0], v1[1], v1[2], v1[3]};
#pragma unroll
                for (int e = 0; e < 8; ++e) f[e] = z[e] * fsigmoid(f[e]);
                *(v4u*)(Y + (size_t)row * 1024 + col0 + bj * 128) = pack8(f);
            }
        EPI_ROWS_END
    }
};
struct EpiMerge {
    static constexpr bool PERM = true;
    const bf16* G; bf16* MM;
    __device__ __forceinline__ void mid(AccM acc, const Unit& u, int wr, int wc, int fr, int fq) const {
        const int col0 = u.pn * 256 + wc * 32 + 8 * fq, b = u.aux;
        EPI_ROWS_BEGIN
#pragma unroll
            for (int bj = 0; bj < 2; ++bj) {
                float ga[8], gn[8]; unpack8(*(const v4u*)(G + (size_t)row * 6144 + b * 2048 + col0 + bj * 128), ga); unpack8(*(const v4u*)(G + (size_t)row * 6144 + (b + 1) * 2048 + col0 + bj * 128), gn);
#pragma unroll
                for (int e = 0; e < 8; ++e) { const float rt = ga[e] * __builtin_amdgcn_rcpf(fmaxf(gn[e], 1e-30f)); acc[ai][bj][m][e >> 2][e & 3] *= rt; }
            }
        EPI_ROWS_END
    }
    __device__ __forceinline__ void operator()(AccC acc, const Unit& u, int wr, int wc, int fr, int fq) const {
        const int col0 = u.pn * 256 + wc * 32 + 8 * fq;
        EPI_ROWS_BEGIN
#pragma unroll
            for (int bj = 0; bj < 2; ++bj) {
                float g2[8]; unpack8(*(const v4u*)(G + (size_t)row * 6144 + 2 * 2048 + col0 + bj * 128), g2);
                const f32x4 v0 = acc[ai][bj][m][0], v1 = acc[ai][bj][m][1];
                float f[8] = {v0[0], v0[1], v0[2], v0[3], v1[0], v1[1], v1[2], v1[3]};
#pragma unroll
                for (int e = 0; e < 8; ++e) f[e] *= g2[e];
                *(v4u*)(MM + (size_t)row * 2048 + col0 + bj * 128) = pack8(f);
            }
        EPI_ROWS_END
    }
};
struct EpiSwiglu {
    EPI_NO_MID
    static constexpr bool PERM = true;
    bf16* FH;
    __device__ __forceinline__ void operator()(AccC acc, const Unit& u, int wr, int wc, int fr, int fq) const {
        const int col0 = u.pn * 128 + wc * 32 + 8 * fq;
        EPI_ROWS_BEGIN
            const f32x4 a0 = acc[ai][0][m][0], a1 = acc[ai][0][m][1], b0 = acc[ai][1][m][0], b1 = acc[ai][1][m][1];
            const float av[8] = {a0[0], a0[1], a0[2], a0[3], a1[0], a1[1], a1[2], a1[3]}, bv[8] = {b0[0], b0[1], b0[2], b0[3], b1[0], b1[1], b1[2], b1[3]};
            float f[8];
#pragma unroll
            for (int e = 0; e < 8; ++e) f[e] = av[e] * fsigmoid(av[e]) * bv[e];
            *(v4u*)(FH + (size_t)row * FFH + col0) = pack8(f);
        EPI_ROWS_END
    }
};

struct SchedPlain {
    const char* A; const char* B; int nM, nN, G, c; size_t tA, tB;
    __device__ __forceinline__ bool next(int i, Unit& u) const { int pm, pn; if (!tile_order((long)i * G + c, nM, nN, pm, pn)) return false; u.A = A + (size_t)pm * tA; u.B = B + (size_t)pn * tB; u.pm = pm; u.pn = pn; u.aux = 0; u.last = 1; return true; }
};
struct SchedMerge {
    const char* A0; const char* A1; const char* A2; const char* B; int G, c;
    __device__ __forceinline__ bool next(int i, Unit& u) const { const int ti = i / 3, b = i - ti * 3; int pm, pn; if (!tile_order((long)ti * G + c, 32, 8, pm, pn)) return false;
        const char* Ab = b == 0 ? A0 : (b == 1 ? A1 : A2); u.A = Ab + (size_t)pm * 256 * 1024 * 2; u.B = B + ((size_t)b * 2048 + pn * 256) * 1024 * 2; u.pm = pm; u.pn = pn; u.aux = b; u.last = (b == 2); return true; }
};
struct SchedS5E {
    const char* UG; const char* ET; int G, c;
    __device__ __forceinline__ bool next(int i, Unit& u) const { const int L = i * G + c; if (L >= 128) return false; const int g = L >> 1, pm = L & 1;
        u.A = UG + ((size_t)g * 512 + pm * 256) * 256 * 2; u.B = ET + (size_t)g * 256 * 256 * 2; u.pm = pm; u.pn = 0; u.aux = g; u.last = 1; return true; }
};
struct SchedS5Y {
    const char* UG; const char* HIN; const char* MT; const char* FT; int G, c;
    __device__ __forceinline__ bool next(int i, Unit& u) const { const int ti = i >> 1, part = i & 1, L = ti * G + c; if (L >= 128) return false; const int g = L >> 1, pm = L & 1;
        u.A = (part ? HIN : UG) + ((size_t)g * 512 + pm * 256) * 256 * 2; u.B = (part ? FT : MT) + (size_t)g * 256 * 256 * 2; u.pm = pm; u.pn = 0; u.aux = g; u.last = part; return true; }
};
struct SchedRg {
    const char* XC; const char* GWT; int G, c;
    __device__ __forceinline__ bool next(int i, Unit& u) const { const int L = i * G + c; if (L >= 512) return false; const int pm = L & 31, hd = L >> 5;
        u.A = XC + ((size_t)pm * 256 * 1024 + (hd >> 1) * 128) * 2; u.B = GWT + (size_t)hd * 256 * 128 * 2; u.pm = pm; u.pn = 0; u.aux = hd; u.last = 1; return true; }
};
}

namespace att {
using bf16x8 = __attribute__((ext_vector_type(8))) short;
using s16x4  = __attribute__((ext_vector_type(4))) short;
using f32x16 = __attribute__((ext_vector_type(16))) float;
using u32x4  = __attribute__((ext_vector_type(4))) unsigned;
constexpr int D = 128, NW = 8, QBLK = 32, KVBLK = 64, LD = 1024;
constexpr float SCALE = 0.088388347648318440f, THR = 8.f;
constexpr size_t SHM_V = KVBLK * D * 2, SHM_K = KVBLK * D * 2, SHM_ATTN = 2 * SHM_V + 2 * SHM_K + NW * 64 * 4;
constexpr int RPB_OFF = (int)SHM_ATTN + 256;
#define KSWZ(row, colB) ((row) * 256 + ((colB) ^ (((row) & 7) << 4)))
#define SBAR() __builtin_amdgcn_sched_barrier(0)
__device__ __forceinline__ int crow(int r, int hi) { return (r & 3) + 8 * (r >> 2) + 4 * hi; }
__device__ __forceinline__ unsigned cvtpk(float lo, float hi) { return pk2(lo, hi); }
__device__ __forceinline__ void partialSM(f32x16& p0, f32x16& p1, float& m_reg, float& mn, float& alpha) {
  constexpr float C = SCALE * 1.4426950408889634f;
  float pmax = p0[0]; for (int r = 1; r < 16; ++r) pmax = fmaxf(pmax, p0[r]); for (int r = 0; r < 16; ++r) pmax = fmaxf(pmax, p1[r]);
  { auto rr = __builtin_amdgcn_permlane32_swap(__float_as_uint(pmax), __float_as_uint(pmax), false, false);
    pmax = fmaxf(__uint_as_float(rr[0]), __uint_as_float(rr[1])); }
  if (__builtin_expect(__all(pmax - m_reg <= THR / SCALE), 1)) { mn = m_reg; alpha = 1.f; }
  else { mn = fmaxf(m_reg, pmax); alpha = __builtin_amdgcn_exp2f((m_reg - mn) * C); m_reg = mn; }
  float mnC = -mn * C;
  for (int r = 0; r < 16; ++r) p0[r] = fmaf(p0[r], C, mnC); for (int r = 0; r < 16; ++r) p1[r] = fmaf(p1[r], C, mnC);
  for (int r = 0; r < 16; ++r) p0[r] = __builtin_amdgcn_exp2f(p0[r]);
}
__device__ __forceinline__ void finishSM(f32x16& p0, f32x16& p1, float alpha, float& l_reg, bf16x8& pa0, bf16x8& pa1, bf16x8& pa2, bf16x8& pa3) {
  for (int r = 0; r < 16; ++r) p1[r] = __builtin_amdgcn_exp2f(p1[r]);
  float ps = 0; for (int r = 0; r < 16; ++r) ps += p0[r]; for (int r = 0; r < 16; ++r) ps += p1[r];
  { auto rr = __builtin_amdgcn_permlane32_swap(__float_as_uint(ps), __float_as_uint(ps), false, false);
    ps = __uint_as_float(rr[0]) + __uint_as_float(rr[1]); }
  l_reg = l_reg * alpha + ps;
#define PK4(P, BASE, OUT) do { unsigned a0 = cvtpk(P[BASE + 0], P[BASE + 1]), a1 = cvtpk(P[BASE + 2], P[BASE + 3]);   \
    unsigned b0 = cvtpk(P[BASE + 4], P[BASE + 5]), b1 = cvtpk(P[BASE + 6], P[BASE + 7]);                              \
    auto r0 = __builtin_amdgcn_permlane32_swap(a0, b0, false, false); auto r1 = __builtin_amdgcn_permlane32_swap(a1, b1, false, false); \
    u32x4 w = {r0[0], r1[0], r0[1], r1[1]}; OUT = *reinterpret_cast<bf16x8*>(&w); } while (0)
  PK4(p0, 0, pa0); PK4(p0, 8, pa1); PK4(p1, 0, pa2); PK4(p1, 8, pa3);
#undef PK4
}
__device__ __forceinline__ void qkt(f32x16& p0, f32x16& p1, const bf16* Ks, const bf16x8* qr, int r32, int hi) {
  p0 = f32x16{}; p1 = f32x16{};
  for (int d0 = 0; d0 < 8; ++d0) { int cb = (d0 * 16 + hi * 8) * 2;
    bf16x8 b0 = *reinterpret_cast<const bf16x8*>((const char*)Ks + KSWZ(r32, cb));
    bf16x8 b1 = *reinterpret_cast<const bf16x8*>((const char*)Ks + KSWZ(32 + r32, cb));
    p0 = __builtin_amdgcn_mfma_f32_32x32x16_bf16(b0, qr[d0], p0, 0, 0, 0);
    p1 = __builtin_amdgcn_mfma_f32_32x32x16_bf16(b1, qr[d0], p1, 0, 0, 0); }
}
__device__ __forceinline__ int v_st(int k, int c) { const int kk = (k & ~0xC) | ((k & 4) << 1) | ((k & 8) >> 1); return ((kk >> 3) * 4 + (c >> 5)) * 512 + ((kk & 7) * 32 + (c & 31)) * 2; }
__device__ __forceinline__ int v_rd_base(int lane) { return ((lane & 3) << 3) | (((lane >> 2) & 3) << 6) | (((lane >> 4) & 1) << 5) | (((lane >> 5) & 1) << 8); }
constexpr int v_rd_off(int d0, int ks, int half) { return d0 * 512 + ks * 4096 + half * 2048; }
template <int OFF> __device__ __forceinline__ s16x4 tr_read(int vb) {
  s16x4 r; asm volatile("ds_read_b64_tr_b16 %0, %1 offset:%2" : "=&v"(r) : "v"(vb), "i"(OFF) : "memory"); return r;
}
template <int D0> __device__ __forceinline__ void pv_one(f32x16& od, int vb, bf16x8 pa0, bf16x8 pa1, bf16x8 pa2, bf16x8 pa3) {
  const s16x4 l0 = tr_read<v_rd_off(D0, 0, 0)>(vb), h0 = tr_read<v_rd_off(D0, 0, 1)>(vb), l1 = tr_read<v_rd_off(D0, 1, 0)>(vb), h1 = tr_read<v_rd_off(D0, 1, 1)>(vb);
  const s16x4 l2 = tr_read<v_rd_off(D0, 2, 0)>(vb), h2 = tr_read<v_rd_off(D0, 2, 1)>(vb), l3 = tr_read<v_rd_off(D0, 3, 0)>(vb), h3 = tr_read<v_rd_off(D0, 3, 1)>(vb);
  asm volatile("s_waitcnt lgkmcnt(0)" ::: "memory"); SBAR();
#define PK(L, H) (bf16x8){L[0], L[1], L[2], L[3], H[0], H[1], H[2], H[3]}
  od = __builtin_amdgcn_mfma_f32_32x32x16_bf16(pa0, PK(l0, h0), od, 0, 0, 0);
  od = __builtin_amdgcn_mfma_f32_32x32x16_bf16(pa1, PK(l1, h1), od, 0, 0, 0);
  od = __builtin_amdgcn_mfma_f32_32x32x16_bf16(pa2, PK(l2, h2), od, 0, 0, 0);
  od = __builtin_amdgcn_mfma_f32_32x32x16_bf16(pa3, PK(l3, h3), od, 0, 0, 0);
#undef PK
}
__device__ __forceinline__ void pv_d0(f32x16* o, int vb, bf16x8 pa0, bf16x8 pa1, bf16x8 pa2, bf16x8 pa3) {
  pv_one<0>(o[0], vb, pa0, pa1, pa2, pa3); pv_one<1>(o[1], vb, pa0, pa1, pa2, pa3); pv_one<2>(o[2], vb, pa0, pa1, pa2, pa3); pv_one<3>(o[3], vb, pa0, pa1, pa2, pa3);
}
__device__ __forceinline__ void na_mask(f32x16& p0, f32x16& p1, int kr, int qr, int rs, int ws, const float* rpbl, int hi) {
  if (kr < rs || kr >= rs + 8) {
#pragma unroll
    for (int r = 0; r < 16; ++r) { p0[r] = -1e30f; p1[r] = -1e30f; }
  } else {
    const float* row = rpbl + (kr - qr + 7) * 31 + 4 * hi; const unsigned w0 = (unsigned)(4 * hi - ws);
#pragma unroll
    for (int r = 0; r < 16; ++r) {
      const int kc = (r & 3) + 8 * (r >> 2);
      const float b0 = row[kc], b1 = row[kc + 32];
      p0[r] = (w0 + (unsigned)kc < 16u) ? p0[r] + b0 : -1e30f; p1[r] = (w0 + (unsigned)(kc + 32) < 16u) ? p1[r] + b1 : -1e30f;
      if ((r & 3) == 3) SBAR();
    }
  }
}
template <bool NA, int SD>
__device__ __forceinline__ void attn_body(const bf16* __restrict__ Qb, const bf16* __restrict__ K0, const bf16* __restrict__ V0, const bf16* __restrict__ K1, const bf16* __restrict__ V1,
                                          bf16* __restrict__ Ob, const int NT, const int lo, const int rg, char* lds) {
  int tid_ = threadIdx.x; asm volatile("" : "+v"(tid_));
  const int tid = tid_, wid = tid >> 6, lane = tid & 63, r32 = lane & 31, hi = lane >> 5;
  bf16* V_lds = (bf16*)lds; bf16* K_lds = (bf16*)(lds + 2 * SHM_V);
  float* ws_ = (float*)(lds + 2 * SHM_V + 2 * SHM_K) + wid * 64; float* li_l = ws_; float* al_l = ws_ + 32;
  const int qrow = 4 * rg + (wid >> 1), qc = 32 * (wid & 1) + r32;
  const int rs = qrow - 4 < 0 ? 0 : (qrow - 4 > 8 ? 8 : qrow - 4), wsn = qc - 8 < 0 ? 0 : (qc - 8 > 48 ? 48 : qc - 8);
  const float* rpbl = (const float*)(lds + RPB_OFF) + 15 - qc;
  float m_reg = -1e30f, l_reg = 0; f32x16 o[4] = {}; bf16x8 qr[8];
  const bf16* Qw = Qb + (long)(wid * QBLK + r32) * LD + hi * 8;
#pragma unroll
  for (int d0 = 0; d0 < 8; ++d0) qr[d0] = *reinterpret_cast<const bf16x8*>(Qw + d0 * 16);
  const int sr = tid >> 4, sc = (tid & 15) * 8, vst0 = v_st(sr, sc), vst1 = v_st(32 + sr, sc);
  const int vb0 = (int)(uintptr_t)V_lds + v_rd_base(lane);
  struct { bf16x8 vs0, vs1, ks0, ks1; } sr_[SD];
#define TILEK(t) ((NA && (t) >= 8) ? K1 + (long)((t) - 8) * 64 * LD : K0 + (long)(t) * 64 * LD)
#define TILEV(t) ((NA && (t) >= 8) ? V1 + (long)((t) - 8) * 64 * LD : V0 + (long)(t) * 64 * LD)
#define SLOAD(i, t) do { const bf16* kp_ = TILEK(t); const bf16* vp_ = TILEV(t); \
    sr_[i].vs0 = *reinterpret_cast<const bf16x8*>(&vp_[(long)sr * LD + sc]); sr_[i].vs1 = *reinterpret_cast<const bf16x8*>(&vp_[(long)(32 + sr) * LD + sc]); \
    sr_[i].ks0 = *reinterpret_cast<const bf16x8*>(&kp_[(long)sr * LD + sc]); sr_[i].ks1 = *reinterpret_cast<const bf16x8*>(&kp_[(long)(32 + sr) * LD + sc]); } while (0)
#define SWRITE(b, i) do { *(bf16x8*)((char*)V_lds + (b) * SHM_V + vst0) = sr_[i].vs0;          \
    *(bf16x8*)((char*)V_lds + (b) * SHM_V + vst1) = sr_[i].vs1; int kc = sc * 2;               \
    *(bf16x8*)((char*)K_lds + (b) * SHM_K + KSWZ(sr, kc)) = sr_[i].ks0;                       \
    *(bf16x8*)((char*)K_lds + (b) * SHM_K + KSWZ(32 + sr, kc)) = sr_[i].ks1; } while (0)
#define SWAIT() do { if constexpr (SD == 2) asm volatile("s_waitcnt vmcnt(4)" ::: "memory"); else asm volatile("s_waitcnt vmcnt(0)" ::: "memory"); } while (0)
#define RESC(a) do { if (__any((a) < 1.f)) { if (hi == 0) al_l[r32] = (a); asm volatile("s_waitcnt lgkmcnt(0)" ::: "memory"); \
    for (int d = 0; d < 4; ++d) for (int r = 0; r < 16; ++r) o[d][r] *= al_l[crow(r, hi)]; } } while (0)
#define MASK(P0, P1, t) do { if (NA && (t) >= 8) na_mask(P0, P1, lo + (t) - 8, qrow, rs, wsn, rpbl, hi); } while (0)
  f32x16 pA0, pA1, pB0, pB1; float mnA, mnB, alA, alB; bf16x8 pa0, pa1, pa2, pa3;
  constexpr int SE = 0, SO = SD - 1;
  SLOAD(SE, 0); asm volatile("s_waitcnt vmcnt(0)" ::: "memory"); SWRITE(0, SE); __syncthreads();
  qkt(pA0, pA1, K_lds, qr, r32, hi); partialSM(pA0, pA1, m_reg, mnA, alA);
  SLOAD(SO, 1); if constexpr (SD == 2) { if (2 < NT) SLOAD(SE, 2); }
  SWAIT(); SWRITE(1, SO); __syncthreads();
  for (int j = 1; j + 1 < NT; j += 2) {
    SBAR(); qkt(pB0, pB1, (bf16*)((char*)K_lds + SHM_K), qr, r32, hi); MASK(pB0, pB1, j);
    finishSM(pA0, pA1, alA, l_reg, pa0, pa1, pa2, pa3); SBAR();
    SLOAD(SO, j + SD); SBAR();
    pv_d0(o, vb0, pa0, pa1, pa2, pa3); partialSM(pB0, pB1, m_reg, mnB, alB);
    __syncthreads(); SWAIT(); SWRITE(0, SE);
    RESC(alB); __syncthreads();
    SBAR(); qkt(pA0, pA1, K_lds, qr, r32, hi); MASK(pA0, pA1, j + 1);
    finishSM(pB0, pB1, alB, l_reg, pa0, pa1, pa2, pa3); SBAR();
    if (SD == 1 || j + 3 < NT) SLOAD(SE, j + 1 + SD); SBAR();
    pv_d0(o, vb0 + (int)SHM_V, pa0, pa1, pa2, pa3); partialSM(pA0, pA1, m_reg, mnA, alA);
    __syncthreads(); SWAIT(); SWRITE(1, SO);
    RESC(alA); __syncthreads();
  }
  SBAR(); qkt(pB0, pB1, (bf16*)((char*)K_lds + SHM_K), qr, r32, hi); MASK(pB0, pB1, NT - 1);
  finishSM(pA0, pA1, alA, l_reg, pa0, pa1, pa2, pa3); SBAR();
  pv_d0(o, vb0, pa0, pa1, pa2, pa3); partialSM(pB0, pB1, m_reg, mnB, alB);
  __syncthreads(); RESC(alB);
  finishSM(pB0, pB1, alB, l_reg, pa0, pa1, pa2, pa3); SBAR();
  pv_d0(o, vb0 + (int)SHM_V, pa0, pa1, pa2, pa3);
  if (hi == 0) li_l[r32] = l_reg; asm volatile("s_waitcnt lgkmcnt(0)" ::: "memory");
  float rli[16];
#pragma unroll
  for (int r = 0; r < 16; ++r) rli[r] = __builtin_amdgcn_rcpf(li_l[crow(r, hi)]);
  bf16* Ow = Ob + (long)(wid * QBLK) * LD;
#pragma unroll
  for (int r = 0; r < 16; ++r) { int orow = crow(r, hi);
    for (int d0 = 0; d0 < 4; ++d0) Ow[(long)orow * LD + d0 * 32 + r32] = (bf16)f2bf(o[d0][r] * rli[r]); }
  asm volatile("s_waitcnt vmcnt(0)" ::: "memory"); __syncthreads();
#undef TILEK
#undef TILEV
#undef SLOAD
#undef SWRITE
#undef SWAIT
#undef RESC
#undef MASK
}
}

constexpr int NWAVES = 8;
struct Args { const float* in[36]; float* out; unsigned char* ws; int ph_lo, ph_hi; };
struct Frame { LAS unsigned char* lds; char* ldsg; volatile LAS unsigned* MISC; int tid, lane, wave, vcu, G; };
constexpr int INTAB_OFF = MISC_OFF + 128;
__device__ __forceinline__ const float* ld_in(const LAS unsigned char* lds, int i) { const unsigned long long v = ((const LAS unsigned long long*)(lds + INTAB_OFF))[i];
    const unsigned lo = __builtin_amdgcn_readfirstlane((unsigned)v), hi = __builtin_amdgcn_readfirstlane((unsigned)(v >> 32)); return (const float*)(((unsigned long long)hi << 32) | lo); }
#define IN(i) ld_in(F.lds, (i))

__device__ __forceinline__ void transpose_item(const float* W, int N, int k0, int n0, bf16* WT, int ldo, int drow0, float* scr, int lane) {
#pragma unroll 8
    for (int i = 0; i < 32; ++i) { const int kk = 2 * i + (lane >> 5); scr[kk * 33 + (lane & 31)] = W[(size_t)(k0 + kk) * N + n0 + (lane & 31)]; }
    LDS_WAIT(); asm volatile("" ::: "memory");
    const int c = lane & 7;
#pragma unroll
    for (int j = 0; j < 4; ++j) { const int n = (lane >> 3) + 8 * j; const float* s = scr + (8 * c) * 33 + n;
        v4u o; o.x = pk2(s[0 * 33], s[1 * 33]); o.y = pk2(s[2 * 33], s[3 * 33]); o.z = pk2(s[4 * 33], s[5 * 33]); o.w = pk2(s[6 * 33], s[7 * 33]);
        *(v4u*)(WT + (size_t)(drow0 + n) * ldo + k0 + 8 * c) = o; }
    LDS_WAIT(); asm volatile("" ::: "memory");
}

__device__ __forceinline__ int cv_of_row(int row) { return row < CTXR ? 0 : 1 + ((row - CTXR) >> 10); }

template <bool FIRST, bool HASNEXT>
__device__ __forceinline__ void resnorm_rows(const Frame& F, const float* xin0, const float* xin1, float* X, const float* Z, const float* gpost, const float* modGate  ,
                                             const float* gpre, const float* modShift, const float* modScale, bf16* H) {
    const int gw = F.vcu * NWAVES + F.wave, NGW = F.G * NWAVES;
    for (int row = gw; row < ROWS; row += NGW) {
        const int cv = cv_of_row(row);
        f32x4 x[8];
        if (FIRST) {
            const f32x4* src = (const f32x4*)(row < CTXR ? xin0 + (size_t)row * DM : xin1 + (size_t)(row - CTXR) * DM) + F.lane;
#pragma unroll
            for (int j = 0; j < 8; ++j) x[j] = src[64 * j];
        } else {
            const f32x4* zr = (const f32x4*)(Z + (size_t)row * DM) + F.lane; const f32x4* xr = (const f32x4*)(X + (size_t)row * DM) + F.lane;
            f32x4 z[8]; float ss = 0.f;
#pragma unroll
            for (int j = 0; j < 8; ++j) { z[j] = zr[64 * j]; ss += (z[j].x * z[j].x + z[j].y * z[j].y) + (z[j].z * z[j].z + z[j].w * z[j].w); }
            const float rstd = rsqrtf(wave_sum(ss) * (1.f / DM) + RMS_EPS);
#pragma unroll
            for (int j = 0; j < 8; ++j) { const f32x4 gp = ((const f32x4*)gpost)[F.lane + 64 * j], gt = ((const f32x4*)(modGate + (size_t)cv * 12288))[F.lane + 64 * j];
                x[j] = xr[64 * j] + gt * (z[j] * rstd * gp); }
        }
        { f32x4* xo = (f32x4*)(X + (size_t)row * DM) + F.lane;
#pragma unroll
          for (int j = 0; j < 8; ++j) xo[64 * j] = x[j]; }
        if (HASNEXT) {
            float ss = 0.f;
#pragma unroll
            for (int j = 0; j < 8; ++j) ss += (x[j].x * x[j].x + x[j].y * x[j].y) + (x[j].z * x[j].z + x[j].w * x[j].w);
            const float rstd = rsqrtf(wave_sum(ss) * (1.f / DM) + RMS_EPS);
            v2u* ho = (v2u*)(H + (size_t)row * DM) + F.lane;
#pragma unroll
            for (int j = 0; j < 8; ++j) { const f32x4 g = ((const f32x4*)gpre)[F.lane + 64 * j], sh = ((const f32x4*)(modShift + (size_t)cv * 12288))[F.lane + 64 * j], sc = ((const f32x4*)(modScale + (size_t)cv * 12288))[F.lane + 64 * j];
                const f32x4 h = x[j] * rstd * g * (sc + 1.0f) + sh; v2u w; w.x = pk2(h.x, h.y); w.y = pk2(h.z, h.w); ho[64 * j] = w; }
        }
    }
}

__device__ __forceinline__ void s5_tables(const Frame& F, int l, int g, unsigned char* ws) {
    char* L = F.ldsg;
    f32x2* POW = (f32x2*)L;
    f32x2* BB = (f32x2*)(L + 17408);
    f32x2* CC = (f32x2*)(L + 17408 + 16384);
    float* KT = (float*)(L + 17408 + 32768);
    const int tid = F.tid;
    __syncthreads();
    if (tid < 128) {
        const int d = tid >> 6, p = tid & 63; const size_t li = ((size_t)(l * 2 + d) * 64 + g) * 64 + p;
        const float dt = expf(IN(22)[(l * 2 + d) * 64 + g]); const float lre = IN(20)[li], lim = IN(21)[li];
        const float er = expf(lre * dt); float sn, cs; sincosf(lim * dt, &sn, &cs);
        const float br = er * cs, bi = er * sn;
        const float nr = br - 1.0f, ni = bi, den = lre * lre + lim * lim;
        const float cr = (nr * lre + ni * lim) / den, ci = (ni * lre - nr * lim) / den;
        float pr = 1.f, pi = 0.f;
        for (int t = 0; t <= 16; ++t) { POW[(d * 64 + p) * 17 + t] = (f32x2){pr, pi}; const float nr2 = pr * br - pi * bi, ni2 = pr * bi + pi * br; pr = nr2; pi = ni2; }
        ((f32x2*)(ws + WS_LT))[li] = POW[(d * 64 + p) * 17 + 16];
        for (int m = 0; m < 16; ++m) { const float xr = IN(23)[li * 16 + m], xi = IN(24)[li * 16 + m]; BB[(d * 64 + p) * 16 + m] = (f32x2){cr * xr - ci * xi, cr * xi + ci * xr}; }
    }
    for (int i = tid; i < 2048; i += 512) { const int d = i >> 10, n = (i >> 6) & 15, p = i & 63; const size_t ci_ = (((size_t)(l * 2 + d) * 64 + g) * 16 + n) * 64 + p; CC[i] = (f32x2){IN(25)[ci_], IN(26)[ci_]}; }
    __syncthreads();
    for (int i = tid; i < 8192; i += 512) {
        const int d = i >> 12, tau = (i >> 8) & 15, n = (i >> 4) & 15, m = i & 15; float s = 0.f;
        for (int p = 0; p < 64; ++p) { const f32x2 c = CC[(d * 16 + n) * 64 + p], w = POW[(d * 64 + p) * 17 + tau], b = BB[(d * 64 + p) * 16 + m];
            const float tr = c.x * w.x - c.y * w.y, ti = c.x * w.y + c.y * w.x; s += tr * b.x - ti * b.y; }
        KT[i] = s;
    }
    __syncthreads();
    bf16* MT = (bf16*)(ws + WS_MT) + (size_t)(l * 64 + g) * 65536; bf16* ET = (bf16*)(ws + WS_ET) + (size_t)(l * 64 + g) * 65536; bf16* FT = (bf16*)(ws + WS_FT) + (size_t)(l * 64 + g) * 65536;
    for (int i = tid; i < 8192; i += 512) {
        const int rowi = i >> 5, k0 = (i & 31) * 8;
        { const int t = rowi >> 4, n = rowi & 15, s = k0 >> 4, m0 = k0 & 15; float f[8];
#pragma unroll
          for (int e = 0; e < 8; ++e) { float v = 0.f; if (s <= t) v += KT[((0 * 16 + (t - s)) * 16 + n) * 16 + m0 + e]; if (s >= t) v += KT[((1 * 16 + (s - t)) * 16 + n) * 16 + m0 + e]; f[e] = v; }
          *(v4u*)(MT + (size_t)rowi * 256 + k0) = pack8(f); }
        { const int d = rowi >> 7, p = (rowi >> 1) & 63, c = rowi & 1, s = k0 >> 4, m0 = k0 & 15; float f[8];
          const f32x2 w = POW[(d * 64 + p) * 17 + (d == 0 ? 15 - s : s)];
#pragma unroll
          for (int e = 0; e < 8; ++e) { const f32x2 b = BB[(d * 64 + p) * 16 + m0 + e]; f[e] = c == 0 ? (w.x * b.x - w.y * b.y) : (w.x * b.y + w.y * b.x); }
          *(v4u*)(ET + (size_t)rowi * 256 + k0) = pack8(f); }
        { const int t = rowi >> 4, n = rowi & 15; float f[8];
#pragma unroll
          for (int e = 0; e < 8; ++e) { const int k = k0 + e, d = k >> 7, p = (k >> 1) & 63, c = k & 1; const f32x2 cc = CC[(d * 16 + n) * 64 + p], w = POW[(d * 64 + p) * 17 + (d == 0 ? t + 1 : 16 - t)];
              f[e] = c == 0 ? (cc.x * w.x - cc.y * w.y) : -(cc.x * w.y + cc.y * w.x); }
          *(v4u*)(FT + (size_t)rowi * 256 + k0) = pack8(f); }
    }
    __syncthreads();
}

__global__ void __launch_bounds__(NWAVES * 64, 2) fwd_kernel(Args args) {
    extern __shared__ __attribute__((aligned(16))) unsigned char lds[];
    const int G0 = gridDim.x, c0 = (int)blockIdx.x;
    volatile LAS unsigned* MISC0 = (volatile LAS unsigned*)((LAS unsigned char*)lds + MISC_OFF);
    unsigned char* const ws0 = args.ws; float* const out0 = args.out;
    gu32* ctl = (gu32*)(ws0 + WS_CTL);
    for (int u = threadIdx.x; u < (LDS_BYTES - LDSCTL_OFF) / 4; u += NWAVES * 64) ((LAS unsigned*)((LAS unsigned char*)lds + LDSCTL_OFF))[u] = 0u;
    __syncthreads();
    if (threadIdx.x == 0) {
#pragma unroll
        for (int i = 0; i < 36; ++i) ((LAS unsigned long long*)((LAS unsigned char*)lds + INTAB_OFF))[i] = (unsigned long long)args.in[i]; }
    __syncthreads();
    XcdBarrier bar; bar.bar = (unsigned*)(ctl + CW_BAR); bar.x = 0; bar.st = nullptr;
    if (MK_N_LAUNCHES == 1) bar = xcd_barrier_post((unsigned*)(ctl + CW_BAR), MISC0 + 8);
    const int lo = args.ph_lo, hi = args.ph_hi;
    int ph = 0;
#ifndef PHMASK
#define PHMASK 0xFFFFFFFFu
#endif
#define PHASE_BEGIN(k) if (((PHMASK >> (k)) & 1u) && lo <= ph && ph < hi) { unsigned char* ws = ws0; float* outp = out0; int tid_p = threadIdx.x, G = G0, c = c0; asm volatile("" : "+s"(ws), "+s"(outp), "+v"(tid_p), "+s"(G), "+s"(c)); const int vcu = (G % 8 == 0) ? (c % 8) * (G / 8) + c / 8 : c;     \
    Frame F; F.lds = (LAS unsigned char*)lds; F.ldsg = (char*)lds; F.MISC = (volatile LAS unsigned*)(F.lds + MISC_OFF); F.tid = tid_p; F.lane = tid_p & 63; F.wave = __builtin_amdgcn_readfirstlane(tid_p >> 6); F.G = G; F.vcu = vcu; \
    const int gw = vcu * NWAVES + F.wave, NGW = G * NWAVES, gt = vcu * 512 + F.tid, NGT = G * 512; (void)gw; (void)NGW; (void)gt; (void)NGT; \
    float* const X = outp + O_X; bf16* const Hb = (bf16*)(ws + WS_H); float* const MOD = (float*)(ws + WS_MOD); const float* const modl = MOD + (size_t)l_ * NCV * INW; (void)X; (void)Hb; (void)modl;
#define PHASE_END   if (MK_N_LAUNCHES == 1 && ph + 1 < hi) { XcdBarrier b_ = bar; asm volatile("" : "+s"(b_.bar)); xcd_barrier(b_); } } ++ph;
    int l_ = 0;

    PHASE_BEGIN(0)
    {
        for (int it = F.vcu; it < NL * 64; it += G) s5_tables(F, it >> 6, it & 63, ws);
        __syncthreads();
        { const float* lamp = IN(19); for (int i = gt; i < NL * 2 * 1024; i += NGT) ((float*)(ws + WS_SP))[i] = log1pf(expf(-lamp[i])); }
        float* scr = (float*)(F.ldsg + F.wave * 16384);
        constexpr int I_WIN = 32 * 384, I_GLU = 16 * 32, I_OUT = 16 * 64, I_WO = 32 * 64, I_FIN = 32 * 352, I_FOUT = 88 * 64, I_GW = 32 * 8;
        constexpr int I_LAYER = I_WIN + I_GLU + 3 * I_OUT + I_WO + I_FIN + I_FOUT + I_GW;
        for (int it = gw; it < NL * I_LAYER; it += NGW) {
            const int l = it / I_LAYER; int r = it - l * I_LAYER;
            if (r < I_WIN) { const int kb = r / 384, nb = r % 384; transpose_item(IN(14) + (size_t)l * DM * INW, INW, kb * 64, nb * 32, (bf16*)(ws + WS_WINT) + (size_t)l * INW * DM, DM, nb * 32, scr, F.lane); continue; } r -= I_WIN;
            if (r < I_GLU) { const int kb = r / 32, nb = r % 32; transpose_item(IN(28) + (size_t)l * 1024 * 1024, 1024, kb * 64, nb * 32, (bf16*)(ws + WS_GLUT) + (size_t)l * 1024 * 1024, 1024, nb * 32, scr, F.lane); continue; } r -= I_GLU;
            if (r < 3 * I_OUT) { const int b = r / I_OUT, q = r % I_OUT, kb = q / 64, nb = q % 64; transpose_item(IN(30 + b) + (size_t)l * 1024 * DM, DM, kb * 64, nb * 32, (bf16*)(ws + WS_OUTT) + ((size_t)l * 3 + b) * DM * 1024, 1024, nb * 32, scr, F.lane); continue; } r -= 3 * I_OUT;
            if (r < I_WO) { const int kb = r / 64, nb = r % 64; transpose_item(IN(33) + (size_t)l * DM * DM, DM, kb * 64, nb * 32, (bf16*)(ws + WS_WOT) + (size_t)l * DM * DM, DM, nb * 32, scr, F.lane); continue; } r -= I_WO;
            if (r < I_FIN) { const int kb = r / 352, nb = r % 352; const int n0 = nb * 32, half = n0 >= FFH, j = n0 - half * FFH; const int drow = 256 * (j >> 7) + 128 * half + (j & 127);
                transpose_item(IN(34) + (size_t)l * DM * 2 * FFH, 2 * FFH, kb * 64, n0, (bf16*)(ws + WS_FINT) + (size_t)l * 2 * FFH * DM, DM, drow, scr, F.lane); continue; } r -= I_FIN;
            if (r < I_FOUT) { const int kb = r / 64, nb = r % 64; transpose_item(IN(35) + (size_t)l * FFH * DM, DM, kb * 64, nb * 32, (bf16*)(ws + WS_FOUTT) + (size_t)l * DM * FFH, FFH, nb * 32, scr, F.lane); continue; } r -= I_FOUT;
            { const int mi = r >> 3, q = r & 7, kb = q >> 2, nb = q & 3;
              const int d = mi >> 4, g = (mi >> 3) & 1, h = mi & 7;
              transpose_item(IN(17) + ((size_t)l * 32 + mi) * 128 * 128, 128, kb * 64, nb * 32, (bf16*)(ws + WS_GWT) + (((size_t)l * 8 + h) * 2 + d) * 256 * 128, 128, g * 128 + nb * 32, scr, F.lane); }
        }
        const float* ckp = IN(2); const float* cvp = IN(3);
        for (int i = gt; i < 2 * 1048576; i += NGT) { const int which = i >> 20, j = i & 1048575; const f32x4* s = (const f32x4*)(which ? cvp : ckp) + (size_t)j * 2; const f32x4 a0 = s[0], a1 = s[1];
            v4u o; o.x = pk2(a0.x, a0.y); o.y = pk2(a0.z, a0.w); o.z = pk2(a1.x, a1.y); o.w = pk2(a1.z, a1.w); ((v4u*)(ws + (which ? WS_CV : WS_CK)))[j] = o; }
        const float* cctx = IN(7); const float* cvec = IN(6); const float* wmod = IN(8);
        for (int task = gt; task < 16 * NL * 3072; task += NGT) {
            const int n4 = task % 3072, l = (task / 3072) % NL, ks = task / (3072 * NL);
            f32x4 acc[NCV];
#pragma unroll
            for (int v = 0; v < NCV; ++v) acc[v] = (f32x4){0.f, 0.f, 0.f, 0.f};
            const f32x4* wp = (const f32x4*)(wmod + ((size_t)l * DM + ks * 128) * INW) + n4;
#pragma unroll 4
            for (int k = 0; k < 128; ++k) { const f32x4 w = wp[(size_t)k * (INW / 4)]; const int kk = ks * 128 + k;
#pragma unroll
                for (int v = 0; v < NCV; ++v) { const float cnd = v == 0 ? cctx[kk] : cvec[(v - 1) * DM + kk]; const float sl = cnd * fsigmoid(cnd); acc[v] += w * sl; } }
#pragma unroll
            for (int v = 0; v < NCV; ++v) ((f32x4*)(ws + WS_MODP))[(((size_t)ks * NL + l) * NCV + v) * 3072 + n4] = acc[v];
        }
    }
    PHASE_END
    PHASE_BEGIN(1)
        const float* bmod = IN(9);
        for (int i = gt; i < NL * NCV * 3072; i += NGT) { const int n4 = i % 3072, v = (i / 3072) % NCV, l = i / (3072 * NCV);
            f32x4 s = ((const f32x4*)(bmod + (size_t)l * INW))[n4];
#pragma unroll
            for (int ks = 0; ks < 16; ++ks) s += ((const f32x4*)(ws + WS_MODP))[(((size_t)ks * NL + l) * NCV + v) * 3072 + n4];
            ((f32x4*)MOD)[i] = s; }
    PHASE_END
    PHASE_BEGIN(2)
        resnorm_rows<true, true>(F, IN(0), IN(1), X, nullptr, nullptr, nullptr, IN(10), MOD + 0 * DM, MOD + 1 * DM, Hb);
    PHASE_END

    for (int l = 0; l < DBG_NL; ++l) {
        l_ = l;
        PHASE_BEGIN(3)
        {   pg8::SchedPlain S{(const char*)Hb, (const char*)(ws + WS_WINT) + (size_t)l * INW * DM * 2, 32, 48, G, c, (size_t)256 * DM * 2, (size_t)256 * DM * 2};
            pg8::EpiWin E{(bf16*)(ws + WS_XR), (bf16*)(ws + WS_XG), (bf16*)(ws + WS_UG), (bf16*)(ws + WS_Q), (bf16*)(ws + WS_K), (bf16*)(ws + WS_V), (bf16*)(ws + WS_G),
                          outp + O_K + (size_t)l * 256 * 1024, outp + O_V + (size_t)l * 256 * 1024};
            pg8::gemm_phase(F.lds, DM, DM, DM, S, E); }
        PHASE_END
        PHASE_BEGIN(4)
        {
            { pg8::SchedS5E S{(const char*)(ws + WS_UG), (const char*)(ws + WS_ET) + (size_t)l * 64 * 65536 * 2, G, c}; pg8::EpiHloc E{(float*)(ws + WS_HLOC)};
              pg8::gemm_phase(F.lds, 256, 256, 256, S, E); }
            { const bf16* XR = (const bf16*)(ws + WS_XR); bf16* XC = (bf16*)(ws + WS_XC); const float* cw = IN(15) + (size_t)l * 4 * 1024; const float* cb = IN(16) + (size_t)l * 1024;
              for (int i = gt; i < ROWS * 128; i += NGT) { const int row = i >> 7, c8 = (i & 127) * 8;
                  const int s0 = row < CTXR ? (row & ~255) : (CTXR + ((row - CTXR) & ~1023)), s1 = row < CTXR ? s0 + 256 : s0 + 1024;
                  float acc[8];
#pragma unroll
                  for (int e = 0; e < 8; ++e) acc[e] = cb[c8 + e];
#pragma unroll
                  for (int k = 0; k < 4; ++k) { const int rr = row + k - 1; if (rr >= s0 && rr < s1) { float xv[8]; unpack8(*(const v4u*)(XR + (size_t)rr * 1024 + c8), xv);
#pragma unroll
                      for (int e = 0; e < 8; ++e) acc[e] += cw[k * 1024 + c8 + e] * xv[e]; } }
                  *(v4u*)(XC + (size_t)row * 1024 + c8) = pack8(acc); } }
            __syncthreads();
            { float* rp = (float*)(F.ldsg + att::RPB_OFF); const bf16* Qb = (const bf16*)(ws + WS_Q); const bf16* Kb = (const bf16*)(ws + WS_K); const bf16* Vb = (const bf16*)(ws + WS_V); bf16* Ob = (bf16*)(ws + WS_YNA);
              for (int u = (c + G / 2) % G; u < 256; u += G) {
                  if (u < 128) { const int b = u >> 5, h = (u >> 2) & 7, rg = u & 3; const int lo_ = rg == 0 ? 0 : (rg == 1 ? 0 : (rg == 2 ? 4 : 8)), NT = (rg == 0 || rg == 3) ? 16 : 20;
                      for (int i = F.tid; i < 465; i += 512) rp[i] = IN(29)[((size_t)l * 8 + h) * 465 + i] * (1.0f / att::SCALE);
                      __syncthreads();
                      const size_t qoff = (size_t)(CTXR + b * 1024 + rg * 256) * 1024 + h * 128, koff = (size_t)(CTXR + b * 1024 + lo_ * 64) * 1024 + h * 128, coff = ((size_t)(b * 4 + l) * 512) * 1024 + h * 128;
                      att::attn_body<true, 1>(Qb + qoff, (const bf16*)(ws + WS_CK) + coff, (const bf16*)(ws + WS_CV) + coff, Kb + koff, Vb + koff, Ob + qoff, NT, lo_, rg, F.ldsg);
                  } else { const int b = (u - 128) >> 3, h = (u - 128) & 7; const size_t off = (size_t)(b * 256) * 1024 + h * 128;
                      att::attn_body<false, 2>(Qb + off, Kb + off, Vb + off, Kb + off, Vb + off, Ob + off, 4, 0, 0, F.ldsg); }
              } }
        }
        PHASE_END
        PHASE_BEGIN(5)
        {   { const float* HLOC = (const float*)(ws + WS_HLOC); bf16* HIN = (bf16*)(ws + WS_HIN); const f32x2* LT = (const f32x2*)(ws + WS_LT) + (size_t)l * 2 * 64 * 64;
              for (int i = gt; i < 20 * 64 * 2 * 64; i += NGT) { const int p = i & 63, d = (i >> 6) & 1, g = (i >> 7) & 63, seq = i >> 13;
                  const int nch = seq < 16 ? 16 : 64, ch0 = seq < 16 ? seq * 16 : 256 + (seq - 16) * 64;
                  const f32x2 lam = LT[(d * 64 + g) * 64 + p]; float hr = 0.f, hi_ = 0.f;
                  if (seq >= 16) { const f32x2 h0 = ((const f32x2*)IN(5))[((((size_t)(seq - 16) * 4 + l) * 2 + d) * 64 + g) * 64 + p]; hr = h0.x; hi_ = h0.y; }
                  for (int k = 0; k < nch; ++k) { const int ch = d == 0 ? ch0 + k : ch0 + nch - 1 - k; const size_t idx = ((size_t)g * 512 + ch) * 256 + d * 128 + p * 2;
                      *(unsigned*)(HIN + idx) = pk2(hr, hi_);
                      const f32x2 hl = *(const f32x2*)(HLOC + idx); const float nr = lam.x * hr - lam.y * hi_ + hl.x, ni = lam.x * hi_ + lam.y * hr + hl.y; hr = nr; hi_ = ni; }
                  if (seq < 16) ((f32x2*)(outp + O_S5))[((((size_t)seq * 4 + l) * 2 + d) * 64 + g) * 64 + p] = (f32x2){hr, hi_}; } }
            { pg8::SchedRg S{(const char*)(ws + WS_XC), (const char*)(ws + WS_GWT) + (size_t)l * 8 * 2 * 256 * 128 * 2, G, c};
              pg8::EpiRg E{(const bf16*)(ws + WS_XC), IN(18) + (size_t)l * 4 * 1024, (const float*)(ws + WS_SP) + (size_t)l * 2048, (f32x2*)(ws + WS_AB)};
              pg8::gemm_phase(F.lds, 128, 1024, 128, S, E); }
        }
        PHASE_END
        PHASE_BEGIN(6)
        {   { pg8::SchedS5Y S{(const char*)(ws + WS_UG), (const char*)(ws + WS_HIN), (const char*)(ws + WS_MT) + (size_t)l * 64 * 65536 * 2, (const char*)(ws + WS_FT) + (size_t)l * 64 * 65536 * 2, G, c};
              pg8::EpiS5Y E{(const bf16*)(ws + WS_UG), IN(27) + (size_t)l * 1024, (bf16*)(ws + WS_ZS)};
              pg8::gemm_phase(F.lds, 256, 256, 256, S, E); }
            { const f32x2* AB = (const f32x2*)(ws + WS_AB); float* HF = (float*)(ws + WS_HF); const bf16* XG = (const bf16*)(ws + WS_XG); bf16* YRG = (bf16*)(ws + WS_YRG);
              float* cs = (float*)F.ldsg;
              for (int task = (c + G / 2) % G; task < 320; task += G) {
                  const bool lat = task >= 64 && task < 128; const int ti = lat ? task - 64 : (task < 64 ? task : task - 64); const int seq = ti >> 4, cb = ti & 15;
                  const int L = lat ? 1024 : 256, row0 = lat ? CTXR + seq * 1024 : seq * 256, ch = cb * 64 + F.lane, len = L / 8, t0 = row0 + F.wave * len;
                  __syncthreads();
                  float pf = 1.f, hf = 0.f, pb = 1.f, hb = 0.f;
                  for (int t = 0; t < len; ++t) { const f32x2 v = AB[(size_t)(t0 + t) * 1024 + ch]; hf = v.x * hf + v.y; pf *= v.x; }
                  for (int t = len - 1; t >= 0; --t) { const f32x2 v = AB[((size_t)ROWS + t0 + t) * 1024 + ch]; hb = v.x * hb + v.y; pb *= v.x; }
                  cs[(F.wave * 4 + 0) * 64 + F.lane] = pf; cs[(F.wave * 4 + 1) * 64 + F.lane] = hf; cs[(F.wave * 4 + 2) * 64 + F.lane] = pb; cs[(F.wave * 4 + 3) * 64 + F.lane] = hb;
                  __syncthreads();
                  float cf = lat ? IN(4)[((size_t)(seq * 4 + l) * 2 + 0) * 1024 + ch] : 0.f, cbk = lat ? IN(4)[((size_t)(seq * 4 + l) * 2 + 1) * 1024 + ch] : 0.f;
                  for (int w = 0; w < F.wave; ++w) cf = cs[(w * 4 + 0) * 64 + F.lane] * cf + cs[(w * 4 + 1) * 64 + F.lane];
                  for (int w = 7; w > F.wave; --w) cbk = cs[(w * 4 + 2) * 64 + F.lane] * cbk + cs[(w * 4 + 3) * 64 + F.lane];
                  if (!lat) { if (F.wave == 7) outp[O_RG + ((size_t)(seq * 4 + l) * 2 + 0) * 1024 + ch] = pf * cf + hf; if (F.wave == 0) outp[O_RG + ((size_t)(seq * 4 + l) * 2 + 1) * 1024 + ch] = pb * cbk + hb; }
                  float h = cf;
                  for (int t = 0; t < len; ++t) { const f32x2 v = AB[(size_t)(t0 + t) * 1024 + ch]; h = v.x * h + v.y; HF[(size_t)(t0 + t) * 1024 + ch] = h; }
                  h = cbk;
                  for (int t = len - 1; t >= 0; --t) { const f32x2 v = AB[((size_t)ROWS + t0 + t) * 1024 + ch]; h = v.x * h + v.y; const size_t o = (size_t)(t0 + t) * 1024 + ch;
                      YRG[o] = (bf16)f2bf((HF[o] + h) * bf2f(XG[o])); }
              } }
        }
        PHASE_END
        PHASE_BEGIN(7)
        {   pg8::SchedPlain S{(const char*)(ws + WS_ZS), (const char*)(ws + WS_GLUT) + (size_t)l * 1024 * 1024 * 2, 32, 4, G, c, (size_t)256 * 1024 * 2, (size_t)256 * 1024 * 2};
            pg8::EpiGlu E{(const bf16*)(ws + WS_ZS), (bf16*)(ws + WS_YS5)};
            pg8::gemm_phase(F.lds, 1024, 1024, 1024, S, E); }
        PHASE_END
        PHASE_BEGIN(8)
        {   pg8::SchedMerge S{(const char*)(ws + WS_YRG), (const char*)(ws + WS_YS5), (const char*)(ws + WS_YNA), (const char*)(ws + WS_OUTT) + (size_t)l * 3 * DM * 1024 * 2, G, c};
            pg8::EpiMerge E{(const bf16*)(ws + WS_G), (bf16*)(ws + WS_MM)};
            pg8::gemm_phase(F.lds, 1024, 1024, 1024, S, E); }
        PHASE_END
        PHASE_BEGIN(9)
        {   pg8::SchedPlain S{(const char*)(ws + WS_MM), (const char*)(ws + WS_WOT) + (size_t)l * DM * DM * 2, 32, 8, G, c, (size_t)256 * DM * 2, (size_t)256 * DM * 2};
            pg8::EpiF32 E{(float*)(ws + WS_Z), DM};
            pg8::gemm_phase(F.lds, DM, DM, DM, S, E); }
        PHASE_END
        PHASE_BEGIN(10)
            resnorm_rows<false, true>(F, nullptr, nullptr, X, (const float*)(ws + WS_Z), IN(11) + (size_t)l * DM, modl + 2 * DM, IN(12) + (size_t)l * DM, modl + 3 * DM, modl + 4 * DM, Hb);
        PHASE_END
        PHASE_BEGIN(11)
        {   pg8::SchedPlain S{(const char*)Hb, (const char*)(ws + WS_FINT) + (size_t)l * 2 * FFH * DM * 2, 32, 44, G, c, (size_t)256 * DM * 2, (size_t)256 * DM * 2};
            pg8::EpiSwiglu E{(bf16*)(ws + WS_FH)};
            pg8::gemm_phase(F.lds, DM, DM, DM, S, E); }
        PHASE_END
        PHASE_BEGIN(12)
        {   pg8::SchedPlain S{(const char*)(ws + WS_FH), (const char*)(ws + WS_FOUTT) + (size_t)l * DM * FFH * 2, 32, 8, G, c, (size_t)256 * FFH * 2, (size_t)256 * FFH * 2};
            pg8::EpiF32 E{(float*)(ws + WS_Z), DM};
            pg8::gemm_phase(F.lds, FFH, FFH, FFH, S, E); }
        PHASE_END
        PHASE_BEGIN(13)
            if (l + 1 < NL) resnorm_rows<false, true>(F, nullptr, nullptr, X, (const float*)(ws + WS_Z), IN(13) + (size_t)l * DM, modl + 5 * DM, IN(10) + (size_t)(l + 1) * DM, modl + NCV * INW + 0 * DM, modl + NCV * INW + 1 * DM, Hb);
            else resnorm_rows<false, false>(F, nullptr, nullptr, X, (const float*)(ws + WS_Z), IN(13) + (size_t)l * DM, modl + 5 * DM, nullptr, nullptr, nullptr, Hb);
        PHASE_END
    }
#if DBG_KEEP
    PHASE_BEGIN(14)
        for (size_t i = (size_t)gt; i < O_END; i += (size_t)NGT) {
            int r, lay = 0;
            if (i < O_K) r = i < O_K / 2 ? 0 : 1;
            else if (i < O_V) { r = 2; lay = (int)(((i - O_K) / (256 * 1024)) & 3); }
            else if (i < O_RG) { r = 3; lay = (int)(((i - O_V) / (256 * 1024)) & 3); }
            else if (i < O_S5) { r = 4; lay = (int)(((i - O_RG) / 2048) & 3); }
            else { r = 5; lay = (int)(((i - O_S5) / 16384) & 3); }
            const bool keep = ((DBG_KEEP >> r) & 1) && (r < 2 || ((DBG_LMASK >> lay) & 1));
            float v = keep ? 3.0f * outp[i] : 0.0f;
#if DBG_DUMP
            v = 0.f;
            if (i >= O_K && i < O_K + (size_t)ROWS * 1024) { const size_t j = i - O_K;
                if (DBG_DUMP == 1) v = bf2f(((const bf16*)(ws + WS_YNA))[j]);
                if (DBG_DUMP == 2) v = bf2f(((const bf16*)(ws + WS_YS5))[j]);
                if (DBG_DUMP == 3) v = bf2f(((const bf16*)(ws + WS_YRG))[j]);
                if (DBG_DUMP == 4) v = bf2f(((const bf16*)(ws + WS_ZS))[j]);
                if (DBG_DUMP == 5) v = bf2f(((const bf16*)(ws + WS_MM))[j]);
                if (DBG_DUMP == 6) v = ((const float*)(ws + WS_Z))[j];
                if (DBG_DUMP == 7) v = bf2f(((const bf16*)(ws + WS_FH))[j]);
                if (DBG_DUMP == 8) v = bf2f(((const bf16*)(ws + WS_H))[j]);
                if (DBG_DUMP == 9) v = bf2f(((const bf16*)(ws + WS_G))[j]);
                if (DBG_DUMP == 11) v = bf2f(((const bf16*)(ws + WS_G))[(size_t)8192 * 6144 + j]);
                if (DBG_DUMP == 10) v = bf2f(((const bf16*)(ws + WS_WINT))[(size_t)6144 * 2048 + j]);
            }
#endif
            outp[i] = v;
        }
    PHASE_END
#endif
#undef PHASE_BEGIN
#undef PHASE_END
}
constexpr int N_PHASES = 3 + DBG_NL * 11 + (DBG_KEEP ? 1 : 0);

extern "C" void kernel_launch(void* const* d_in, const int* in_sizes, int n_in, void* d_out, int out_size, void* d_ws, size_t ws_size, hipStream_t stream) {
    static int grid = 0;
    if (grid == 0) {
        if (n_in != 36 || out_size != (int)O_END || ws_size < WS_END) { fprintf(stderr, "kernel_launch: unexpected shapes (n_in %d out %d ws %zu)\n", n_in, out_size, ws_size); grid = -1; return; }
        int dev = 0, cus = 0, per_cu = 0;
        if (hipGetDevice(&dev) != hipSuccess || hipDeviceGetAttribute(&cus, hipDeviceAttributeMultiprocessorCount, dev) != hipSuccess) { grid = -1; return; }
        if (hipFuncSetAttribute((const void*)fwd_kernel, hipFuncAttributeMaxDynamicSharedMemorySize, LDS_BYTES) != hipSuccess) { fprintf(stderr, "kernel_launch: hipFuncSetAttribute failed\n"); grid = -1; return; }
        if (hipOccupancyMaxActiveBlocksPerMultiprocessor(&per_cu, (const void*)fwd_kernel, NWAVES * 64, LDS_BYTES) != hipSuccess || per_cu < 1) { fprintf(stderr, "kernel_launch: occupancy query reports %d blocks per CU\n", per_cu); }
        (void)hipGetLastError();
        grid = cus;
    }
    if (grid < 0) return;
    if (hipMemsetAsync((char*)d_ws + WS_CTL, 0, CTL_ZERO_BYTES, stream) != hipSuccess) return;
    Args a{};
    for (int i = 0; i < 36; ++i) a.in[i] = (const float*)d_in[i];
    a.out = (float*)d_out; a.ws = (unsigned char*)d_ws;
    if (MK_N_LAUNCHES == 1) { a.ph_lo = 0; a.ph_hi = N_PHASES; hipLaunchKernelGGL(fwd_kernel, dim3(grid), dim3(NWAVES * 64), LDS_BYTES, stream, a); }
    else for (int p = 0; p < N_PHASES; ++p) { a.ph_lo = p; a.ph_hi = p + 1; hipLaunchKernelGGL(fwd_kernel, dim3(grid), dim3(NWAVES * 64), LDS_BYTES, stream, a); }
}
```

```cpp
#include <hip/hip_runtime.h>
#include <hip/hip_bf16.h>
#include <cstdio>
#include <cstdint>

#ifndef MK_N_LAUNCHES
#define MK_N_LAUNCHES 1
#endif
#ifndef DBG_KEEP
#define DBG_KEEP 0
#endif
#ifndef DUP_SCAN
#define DUP_SCAN 1
#endif
#ifndef DUP_ATT
#define DUP_ATT 1
#endif
#ifndef DUP_CARRY
#define DUP_CARRY 1
#endif
#ifndef DUP_CONV
#define DUP_CONV 1
#endif
#ifndef DUP_RGG
#define DUP_RGG 1
#endif
#ifndef DUP_S5
#define DUP_S5 1
#endif
#ifndef DUP_GEMM
#define DUP_GEMM 1
#endif
#ifndef DUP_MASK
#define DUP_MASK 0u
#endif
#ifndef DBG_LMASK
#define DBG_LMASK 15
#endif
#ifndef DBG_DUMP
#define DBG_DUMP 0
#endif
#ifndef DBG_NL
#define DBG_NL 4
#endif

constexpr int DM = 2048, ROWS = 8192, CTXR = 4096, INW = 12288, FFH = 5632, NL = 4, W1K = 1024;
constexpr int NCV = 5;
constexpr float RMS_EPS = 1e-6f;
constexpr size_t MiB = 1u << 20;

constexpr size_t O_X = 0, O_K = 16777216, O_V = 33554432, O_RG = 50331648, O_S5 = 50462720, O_END = 51511296;

constexpr size_t WS_CTL = 0, CTL_ZERO_BYTES = 1 * MiB;
constexpr size_t WS_MODP = 1 * MiB;
constexpr size_t WS_MOD  = 17 * MiB;
constexpr size_t WS_SP   = 18 * MiB;
constexpr size_t WS_LT   = 18 * MiB + 65536;
constexpr size_t WS_GWT  = 19 * MiB;
constexpr size_t WS_WINT = 24 * MiB;
constexpr size_t WS_GLUT = 216 * MiB;
constexpr size_t WS_OUTT = 224 * MiB;
constexpr size_t WS_WOT  = 272 * MiB;
constexpr size_t WS_FINT = 304 * MiB;
constexpr size_t WS_FOUTT = 480 * MiB;
constexpr size_t WS_MT   = 568 * MiB;
constexpr size_t WS_ET   = 600 * MiB;
constexpr size_t WS_FT   = 632 * MiB;
constexpr size_t WS_CK   = 664 * MiB;
constexpr size_t WS_CV   = 680 * MiB;
constexpr size_t WS_H    = 696 * MiB;
constexpr size_t WS_XR   = 728 * MiB;
constexpr size_t WS_XG   = 744 * MiB;
constexpr size_t WS_XC   = 760 * MiB;
constexpr size_t WS_Q    = 776 * MiB;
constexpr size_t WS_K    = 792 * MiB;
constexpr size_t WS_V    = 808 * MiB;
constexpr size_t WS_YRG  = 824 * MiB;
constexpr size_t WS_YS5  = 840 * MiB;
constexpr size_t WS_YNA  = 856 * MiB;
constexpr size_t WS_ZS   = 872 * MiB;
constexpr size_t WS_UG   = 888 * MiB;
constexpr size_t WS_HIN  = 904 * MiB;
constexpr size_t WS_G    = 920 * MiB;
constexpr size_t WS_AB   = 1016 * MiB;
constexpr size_t WS_FH   = 1016 * MiB;
constexpr size_t WS_HF   = 1144 * MiB;
constexpr size_t WS_HLOC = 1176 * MiB;
constexpr size_t WS_Z    = 1144 * MiB;
constexpr size_t WS_MM   = 1208 * MiB;
constexpr size_t WS_END  = 1240 * MiB;

constexpr int CW_TMO = 0, CW_BAR = 4096;

constexpr int RING_BYTES = 131072;
constexpr int LDSCTL_OFF = RING_BYTES, MISC_OFF = LDSCTL_OFF + 320;
constexpr int LDS_BYTES = 147456;

#define GAS __attribute__((address_space(1)))
#define LAS __attribute__((address_space(3)))
typedef unsigned short bf16;
typedef unsigned v4u __attribute__((ext_vector_type(4)));
typedef unsigned v2u __attribute__((ext_vector_type(2)));
typedef float f32x4 __attribute__((ext_vector_type(4)));
typedef float f32x2 __attribute__((ext_vector_type(2)));
typedef short bf16x8 __attribute__((ext_vector_type(8)));
typedef GAS unsigned gu32;
#define RLX_AGENT __ATOMIC_RELAXED, __HIP_MEMORY_SCOPE_AGENT
#define LDS_WAIT() asm volatile("s_waitcnt lgkmcnt(0)" ::: "memory")
#define VM_WAIT() asm volatile("s_waitcnt vmcnt(0)" ::: "memory")

__device__ __forceinline__ unsigned f2bf(float f) { unsigned u = __builtin_bit_cast(unsigned, f); return (u + 0x7fffu + ((u >> 16) & 1u)) >> 16; }
typedef __bf16 bf16x2_t __attribute__((ext_vector_type(2)));
__device__ __forceinline__ unsigned pk2(float lo, float hi) { const f32x2 v = {lo, hi}; const bf16x2_t b = __builtin_convertvector(v, bf16x2_t); return __builtin_bit_cast(unsigned, b); }
__device__ __forceinline__ float bflo(unsigned w) { return __builtin_bit_cast(float, w << 16); }
__device__ __forceinline__ float bfhi(unsigned w) { return __builtin_bit_cast(float, w & 0xffff0000u); }
__device__ __forceinline__ float bf2f(bf16 h) { return __builtin_bit_cast(float, (unsigned)h << 16); }
__device__ __forceinline__ float fsigmoid(float x) { return __builtin_amdgcn_rcpf(1.0f + __expf(-x)); }
__device__ __forceinline__ float gelu_tanh(float x) { const float y = 0.7978845608028654f * (x + 0.044715f * x * x * x); return x * __builtin_amdgcn_rcpf(1.0f + __expf(-2.0f * y)); }
__device__ __forceinline__ float wave_sum(float v) {
#pragma unroll
    for (int o = 1; o < 64; o <<= 1) v += __shfl_xor(v, o);
    return v;
}
__device__ __forceinline__ void unpack8(const v4u w, float (&f)[8]) { f[0] = bflo(w.x); f[1] = bfhi(w.x); f[2] = bflo(w.y); f[3] = bfhi(w.y); f[4] = bflo(w.z); f[5] = bfhi(w.z); f[6] = bflo(w.w); f[7] = bfhi(w.w); }
__device__ __forceinline__ v4u pack8(const float (&f)[8]) { v4u w; w.x = pk2(f[0], f[1]); w.y = pk2(f[2], f[3]); w.z = pk2(f[4], f[5]); w.w = pk2(f[6], f[7]); return w; }

#define XB_TMO      128
#define XB_XCNT(j)  (256  + 64 * (j))
#define XB_XSUB(j)  (1280 + 64 * (j))
#define XB_XGEN(j)  (2304 + 64 * (j))
#define XB_TOP      3328
#define XB_TOPGEN   3392
#define XCD_BAR_WORDS 3456
#define XB_SPIN_CAP (1u << 18)
__device__ __forceinline__ unsigned xb_ld(unsigned* p)              { return __hip_atomic_load(p, __ATOMIC_RELAXED, __HIP_MEMORY_SCOPE_AGENT); }
__device__ __forceinline__ unsigned xb_add(unsigned* p, unsigned v) { return __hip_atomic_fetch_add(p, v, __ATOMIC_RELAXED, __HIP_MEMORY_SCOPE_AGENT); }
__device__ __forceinline__ unsigned xb_xcc_id() { return (unsigned)__builtin_amdgcn_s_getreg((3 << 11) | 20) & 0xFu; }
#define XB_SPIN(cond, bar) do { unsigned _sp = 0; while (cond) { __builtin_amdgcn_s_sleep(1); \
    if ((++_sp & 255u) == 0u) { if (xb_ld(&(bar)[XB_TMO])) break; if (_sp > XB_SPIN_CAP) { atomicAdd(&(bar)[XB_TMO], 1u); break; } } } } while (0)
struct XcdBarrier { unsigned* bar; unsigned x; volatile LAS unsigned* st; };
__device__ __forceinline__ XcdBarrier xcd_barrier_post(unsigned* bar, volatile LAS unsigned* st) {
    XcdBarrier b; b.bar = bar; b.x = xb_xcc_id(); b.st = st;
    if (threadIdx.x == 0) (void)xb_add(&bar[XB_XCNT(b.x)], 1u);
    return b;
}
__device__ __forceinline__ void xcd_barrier_complete(unsigned* bar, unsigned x, unsigned& nloc, unsigned& nx) {
    const unsigned G = gridDim.x * gridDim.y * gridDim.z;
    unsigned sum, cnt, mine, sp = 0u;
    for (;;) {
        sum = 0u; cnt = 0u; mine = 0u;
#pragma unroll
        for (unsigned j = 0; j < 16; ++j) { const unsigned c = xb_ld(&bar[XB_XCNT(j)]); sum += c; cnt += (c > 0u) ? 1u : 0u; mine = (j == x) ? c : mine; }
        if (sum == G) break;
        __builtin_amdgcn_s_sleep(1);
        if ((++sp & 255u) == 0u) { if (xb_ld(&bar[XB_TMO])) break; if (sp > XB_SPIN_CAP) { atomicAdd(&bar[XB_TMO], 1u); break; } }
    }
    nloc = mine > 0u ? mine : 1u; nx = cnt > 0u ? cnt : 1u;
}
__device__ __forceinline__ void xcd_barrier(const XcdBarrier& b) {
    asm volatile("s_waitcnt vmcnt(0)" ::: "memory");
    __syncthreads();
    int tid_b = threadIdx.x; asm volatile("" : "+v"(tid_b));
    if (tid_b == 0) {
        unsigned* bar = b.bar;
        __builtin_amdgcn_s_waitcnt(0);
        unsigned nloc = b.st[0], nx = b.st[1];
        if (nloc == 0u) { xcd_barrier_complete(bar, b.x, nloc, nx); b.st[0] = nloc; b.st[1] = nx; }
        const unsigned old = xb_add(&bar[XB_XSUB(b.x)], 1u);
        const unsigned gen = old / nloc;
        if (old + 1u == (gen + 1u) * nloc) {
            __builtin_amdgcn_fence(__ATOMIC_RELEASE, "agent");
            asm volatile("s_waitcnt vmcnt(0)" ::: "memory");
            const unsigned og = xb_add(&bar[XB_TOP], 1u);
            const unsigned tg = og / nx;
            if (og + 1u == (tg + 1u) * nx) xb_add(&bar[XB_TOPGEN], 1u);
            else XB_SPIN(xb_ld(&bar[XB_TOPGEN]) == tg, bar);
            __builtin_amdgcn_fence(__ATOMIC_ACQUIRE, "agent");
            xb_add(&bar[XB_XGEN(b.x)], 1u);
            asm volatile("s_waitcnt vmcnt(0)" ::: "memory");
        } else {
            XB_SPIN(xb_ld(&bar[XB_XGEN(b.x)]) == gen, bar);
            __builtin_amdgcn_fence(__ATOMIC_ACQUIRE, "agent");
            asm volatile("s_waitcnt vmcnt(0)" ::: "memory");
        }
    }
    __syncthreads();
}

namespace pg8 {
#define PG8_LAS __attribute__((address_space(3)))
constexpr int BM = 256, BK = 64, HALF = 128, HTB = HALF * BK * 2, STAGE_BYTES = 8 * HTB;
__host__ __device__ __forceinline__ int lds_byte(int r, int c) { const int st = (r >> 4) * 2 + (c >> 5), rr = r & 15, cc = c & 31, ob = rr * 64 + cc * 2; return st * 1024 + (ob ^ (((ob >> 9) & 1) << 5)); }
__host__ __device__ __forceinline__ void stage_rc(int b, int& R, int& C) { const int st = b / 1024, sb = b % 1024, swz = sb ^ (((sb >> 9) & 1) << 5); R = (st >> 1) * 16 + swz / 64; C = (st & 1) * 32 + (swz % 64) / 2; }
__host__ __device__ __forceinline__ int perm32(int rho) { const int n = rho >> 4, i = rho & 15; return 8 * (i >> 2) + 4 * n + (i & 3); }

struct Unit { const char* A; const char* B; int pm, pn, aux, last; };

__device__ __forceinline__ bool tile_order(long L, int nM, int nN, int& pm, int& pn) {
    const int nwg = nM * nN; if (L >= nwg) return false;
    int wgid = (int)L; { const int q = nwg / 8, r = nwg % 8, xcd = wgid % 8, off = wgid / 8; wgid = (xcd < r ? xcd * (q + 1) : r * (q + 1) + (xcd - r) * q) + off; }
    const int nig = 8 * nN, gid = wgid / nig, fm = gid * 8, gsz = (nM - fm) < 8 ? (nM - fm) : 8;
    pm = fm + ((wgid % nig) % gsz); pn = (wgid % nig) / gsz; return true;
}

typedef float f32x4 __attribute__((ext_vector_type(4)));
typedef short bf16x8 __attribute__((ext_vector_type(8)));

template <class Epi, class Sched>
__device__ __forceinline__ void gemm_phase(PG8_LAS unsigned char* lds, const int K, const int lda, const int ldb, const Sched& S, const Epi& E) {
    int tid_ = threadIdx.x; asm volatile("" : "+v"(tid_));
    const int tid = tid_, wid = __builtin_amdgcn_readfirstlane(tid >> 6), lane = tid & 63, wr = wid >> 2, wc = wid & 3, fr = lane & 15, fq = lane >> 4;
    const int nt = K / BK;
    unsigned voffA[2], voffB[2];
#pragma unroll
    for (int i = 0; i < 2; ++i) { int R, C; stage_rc(tid * 16 + i * 8192, R, C); const int Rb = Epi::PERM ? ((R & ~31) + perm32(R & 31)) : R;
        voffA[i] = (unsigned)(R * lda + C) * 2u; voffB[i] = (unsigned)(Rb * ldb + C) * 2u; }
    const size_t kstep = (size_t)(BK * 2);
    const size_t hstepA = (size_t)HALF * lda * 2, hstepB = (size_t)HALF * ldb * 2;
    const unsigned ldsw = (unsigned)wid * 1024u;
    const int aoff = lds_byte(wr * 64 + fr, fq * 8), boff = lds_byte(wc * 32 + fr, fq * 8);
#define PG8_SA(b, h) (((b) * 2 + (h)) * HTB)
#define PG8_SB(b, h) ((4 + (b) * 2 + (h)) * HTB)
#define PG8_STAGE(bufoff, gbase, voff) do { _Pragma("unroll") for (int _i = 0; _i < 2; ++_i) \
        __builtin_amdgcn_global_load_lds((const unsigned*)((const char*)(gbase) + (voff)[_i]), (PG8_LAS unsigned*)(lds + (bufoff) + ldsw + _i * 8192), 16, 0, 0); } while (0)
#define PG8_LDA(dst, b, h) do { _Pragma("unroll") for (int m = 0; m < 4; ++m) _Pragma("unroll") for (int k = 0; k < 2; ++k) dst[m][k] = *(const PG8_LAS bf16x8*)(lds + PG8_SA(b, h) + aoff + m * 2048 + k * 1024); } while (0)
#define PG8_LDB(dst, b, h) do { _Pragma("unroll") for (int n = 0; n < 2; ++n) _Pragma("unroll") for (int k = 0; k < 2; ++k) dst[n][k] = *(const PG8_LAS bf16x8*)(lds + PG8_SB(b, h) + boff + n * 2048 + k * 1024); } while (0)
#define PG8_MMA(ai, bj, At, Bt) do { __builtin_amdgcn_s_setprio(1); _Pragma("unroll") for (int m = 0; m < 4; ++m) _Pragma("unroll") for (int n = 0; n < 2; ++n) _Pragma("unroll") for (int k = 0; k < 2; ++k) \
        acc[ai][bj][m][n] = __builtin_amdgcn_mfma_f32_16x16x32_bf16(Bt[n][k], At[m][k], acc[ai][bj][m][n], 0, 0, 0); __builtin_amdgcn_s_setprio(0); } while (0)
#define PG8_WAIT_V(n) asm volatile("s_waitcnt vmcnt(" #n ")" ::: "memory")
#define PG8_WAIT_L(n) asm volatile("s_waitcnt lgkmcnt(" #n ")" ::: "memory")
#define PG8_BAR __builtin_amdgcn_s_barrier()
#define PG8_SCHED __builtin_amdgcn_sched_barrier(0)
    Unit cur, nxt; int ui = 0;
    if (!S.next(0, cur)) return;
    f32x4 acc[2][2][4][2];
#pragma unroll
    for (int a = 0; a < 2; ++a)
#pragma unroll
        for (int b = 0; b < 2; ++b)
#pragma unroll
            for (int m = 0; m < 4; ++m)
#pragma unroll
                for (int n = 0; n < 2; ++n) acc[a][b][m][n] = (f32x4){0.f, 0.f, 0.f, 0.f};
    bf16x8 At[4][2], B0[2][2], B1[2][2];
    const char* cA = cur.A; const char* cB = cur.B;
    PG8_STAGE(PG8_SB(0, 0), cB, voffB); PG8_STAGE(PG8_SB(0, 1), cB + hstepB, voffB); PG8_STAGE(PG8_SA(0, 0), cA, voffA); PG8_STAGE(PG8_SA(0, 1), cA + hstepA, voffA);
    if (wr == 1) PG8_BAR;
    PG8_WAIT_V(2); PG8_BAR;
    PG8_STAGE(PG8_SB(1, 0), cB + kstep, voffB); PG8_STAGE(PG8_SA(1, 0), cA + kstep, voffA); PG8_STAGE(PG8_SB(1, 1), cB + hstepB + kstep, voffB);
    PG8_WAIT_V(6); PG8_BAR;
    for (;;) {
        const bool has_next = S.next(ui + 1, nxt);
        const char* nA = has_next ? nxt.A : cA; const char* nB = has_next ? nxt.B : cB;
#pragma unroll 1
        for (int t = 0; t < nt; t += 2) {
            const bool last = (t == nt - 2);
            const char* a1 = cA + (size_t)(t + 1) * kstep;
            const char* a2 = last ? nA : cA + (size_t)(t + 2) * kstep; const char* b2 = last ? nB : cB + (size_t)(t + 2) * kstep;
            const char* a3 = a2 + kstep; const char* b3 = b2 + kstep;
            PG8_LDB(B0, 0, 0); PG8_LDB(B1, 0, 1); PG8_SCHED; PG8_LDA(At, 0, 0); PG8_STAGE(PG8_SA(1, 1), a1 + hstepA, voffA);
            PG8_WAIT_V(8); PG8_WAIT_L(0); PG8_BAR; PG8_MMA(0, 0, At, B0); PG8_MMA(0, 1, At, B1); PG8_BAR; PG8_SCHED;
            PG8_LDA(At, 0, 1); PG8_STAGE(PG8_SB(0, 0), b2, voffB); PG8_STAGE(PG8_SB(0, 1), b2 + hstepB, voffB); PG8_STAGE(PG8_SA(0, 0), a2, voffA);
            PG8_WAIT_V(8); PG8_WAIT_L(0); PG8_BAR; PG8_MMA(1, 0, At, B0); PG8_MMA(1, 1, At, B1); PG8_BAR; PG8_SCHED;
            PG8_LDB(B0, 1, 0); PG8_LDB(B1, 1, 1); PG8_SCHED; PG8_LDA(At, 1, 0); PG8_STAGE(PG8_SA(0, 1), a2 + hstepA, voffA);
            PG8_WAIT_V(8); PG8_WAIT_L(0); PG8_BAR; PG8_MMA(0, 0, At, B0); PG8_MMA(0, 1, At, B1); PG8_BAR; PG8_SCHED;
            PG8_LDA(At, 1, 1); PG8_STAGE(PG8_SB(1, 0), b3, voffB); PG8_STAGE(PG8_SB(1, 1), b3 + hstepB, voffB); PG8_STAGE(PG8_SA(1, 0), a3, voffA);
            PG8_WAIT_V(8); PG8_WAIT_L(0); PG8_BAR; PG8_MMA(1, 0, At, B0); PG8_MMA(1, 1, At, B1); PG8_BAR; PG8_SCHED;
        }
        if (wr == 0) PG8_BAR;
        if (cur.last) E(acc, cur, wr, wc, fr, fq); else E.mid(acc, cur, wr, wc, fr, fq);
        if (!has_next) break;
        if (cur.last) {
#pragma unroll
            for (int a = 0; a < 2; ++a)
#pragma unroll
                for (int b = 0; b < 2; ++b)
#pragma unroll
                    for (int m = 0; m < 4; ++m)
#pragma unroll
                        for (int n = 0; n < 2; ++n) acc[a][b][m][n] = (f32x4){0.f, 0.f, 0.f, 0.f};
        }
        cur = nxt; cA = nA; cB = nB; ++ui;
        if (wr == 1) PG8_BAR;
    }
    PG8_WAIT_V(0);
    PG8_BAR;
#undef PG8_SA
#undef PG8_SB
#undef PG8_STAGE
#undef PG8_LDA
#undef PG8_LDB
#undef PG8_MMA
#undef PG8_WAIT_V
#undef PG8_WAIT_L
#undef PG8_BAR
#undef PG8_SCHED
}

typedef const f32x4 (&AccC)[2][2][4][2];
typedef f32x4 (&AccM)[2][2][4][2];
#define EPI_ROWS_BEGIN _Pragma("unroll") for (int ai = 0; ai < 2; ++ai) _Pragma("unroll") for (int m = 0; m < 4; ++m) { const int row = u.pm * 256 + ai * 128 + wr * 64 + m * 16 + fr;
#define EPI_ROWS_END }

#define EPI_NO_MID __device__ __forceinline__ void mid(AccM, const Unit&, int, int, int, int) const {}

struct EpiF32 {
    EPI_NO_MID
    static constexpr bool PERM = false;
    float* O; int ldc;
    __device__ __forceinline__ void operator()(AccC acc, const Unit& u, int wr, int wc, int fr, int fq) const {
        const int col0 = u.pn * 256 + wc * 32 + 4 * fq; float* base = O;
        EPI_ROWS_BEGIN
            float* rowp = base + (size_t)row * ldc + col0;
#pragma unroll
            for (int bj = 0; bj < 2; ++bj)
#pragma unroll
                for (int n = 0; n < 2; ++n) *(GAS f32x4*)(rowp + bj * 128 + n * 16) = acc[ai][bj][m][n];
        EPI_ROWS_END
    }
};
struct EpiHloc {
    EPI_NO_MID
    static constexpr bool PERM = false;
    float* O;
    __device__ __forceinline__ void operator()(AccC acc, const Unit& u, int wr, int wc, int fr, int fq) const {
        const int col0 = wc * 32 + 4 * fq; float* base = O + (size_t)u.aux * 512 * 256;
        EPI_ROWS_BEGIN
            float* rowp = base + (size_t)row * 256 + col0;
#pragma unroll
            for (int bj = 0; bj < 2; ++bj)
#pragma unroll
                for (int n = 0; n < 2; ++n) *(GAS f32x4*)(rowp + bj * 128 + n * 16) = acc[ai][bj][m][n];
        EPI_ROWS_END
    }
};
struct EpiWin {
    EPI_NO_MID
    static constexpr bool PERM = true;
    bf16 *XR, *XG, *UG, *Q, *Kb, *Vb, *G; float *outK, *outV;
    __device__ __forceinline__ void operator()(AccC acc, const Unit& u, int wr, int wc, int fr, int fq) const {
        const int pn = u.pn, seg = pn >> 2;
        const int cseg = (pn & 3) * 256 + wc * 32 + 8 * fq;
        EPI_ROWS_BEGIN
#pragma unroll
            for (int bj = 0; bj < 2; ++bj) {
                const f32x4 v0 = acc[ai][bj][m][0], v1 = acc[ai][bj][m][1];
                float f[8] = {v0[0], v0[1], v0[2], v0[3], v1[0], v1[1], v1[2], v1[3]};
                const int c = cseg + bj * 128;
                if (seg >= 6) {
#pragma unroll
                    for (int e = 0; e < 8; ++e) f[e] = fsigmoid(f[e]);
                    *(GAS v4u*)(G + (size_t)row * 6144 + (pn - 24) * 256 + wc * 32 + 8 * fq + bj * 128) = pack8(f);
                } else if (seg == 1) {
#pragma unroll
                    for (int e = 0; e < 8; ++e) f[e] = gelu_tanh(f[e]);
                    *(GAS v4u*)(XG + (size_t)row * 1024 + c) = pack8(f);
                } else if (seg == 2) {
                    const int g = c >> 4, m0 = c & 15;
                    *(GAS v4u*)(UG + ((size_t)g * 512 + (row >> 4)) * 256 + (row & 15) * 16 + m0) = pack8(f);
                } else {
                    bf16* dst = seg == 0 ? XR : (seg == 3 ? Q : (seg == 4 ? Kb : Vb));
                    *(GAS v4u*)(dst + (size_t)row * 1024 + c) = pack8(f);
                    if (seg >= 4 && row < CTXR) {
                        float* o = (seg == 4 ? outK : outV) + ((size_t)(row >> 8) * 4 * 256 + (row & 255)) * 1024 + c;
                        *(f32x4*)o = v0; *(GAS f32x4*)(o + 4) = v1;
                    }
                }
            }
        EPI_ROWS_END
    }
};
struct EpiRg {
    EPI_NO_MID
    static constexpr bool PERM = true;
    const bf16* XC; const float* gb; const float* sp; f32x2* AB;
    __device__ __forceinline__ void operator()(AccC acc, const Unit& u, int wr, int wc, int fr, int fq) const {
        const int h = u.aux >> 1, d = u.aux & 1, c0 = h * 128 + wc * 32 + 8 * fq;
        const GAS float* gbr = (const GAS float*)(gb + (d * 2 + 0) * 1024 + c0); const GAS float* gbi = (const GAS float*)(gb + (d * 2 + 1) * 1024 + c0); const GAS float* spp = (const GAS float*)(sp + d * 1024 + c0);
        EPI_ROWS_BEGIN
            float xc[8]; unpack8(*(const GAS v4u*)(XC + (size_t)row * 1024 + c0), xc);
            const f32x4 r0 = acc[ai][0][m][0], r1 = acc[ai][0][m][1], i0 = acc[ai][1][m][0], i1 = acc[ai][1][m][1];
            const float rr[8] = {r0[0], r0[1], r0[2], r0[3], r1[0], r1[1], r1[2], r1[3]}, ii[8] = {i0[0], i0[1], i0[2], i0[3], i1[0], i1[1], i1[2], i1[3]};
            f32x2* dst = AB + ((size_t)d * ROWS + row) * 1024 + c0;
#pragma unroll
            for (int e = 0; e < 8; e += 2) {
                f32x4 o;
#pragma unroll
                for (int q = 0; q < 2; ++q) {
                    const float r = fsigmoid(rr[e + q] + gbr[e + q]), ig = fsigmoid(ii[e + q] + gbi[e + q]);
                    const float la = -8.0f * r * spp[e + q]; const float a = __expf(la); const float mult = sqrtf(-expm1f(2.0f * la));
                    o[2 * q] = a; o[2 * q + 1] = mult * ig * xc[e + q];
                }
                *(GAS f32x4*)(dst + e) = o;
            }
            asm volatile("" ::: "memory");
        EPI_ROWS_END
    }
};
struct EpiS5Y {
    EPI_NO_MID
    static constexpr bool PERM = true;
    const bf16* UG; const float* dvec; bf16* ZS;
    __device__ __forceinline__ void operator()(AccC acc, const Unit& u, int wr, int wc, int fr, int fq) const {
        const int g = u.aux;
        EPI_ROWS_BEGIN
#pragma unroll
            for (int bj = 0; bj < 2; ++bj) {
                const int col = bj * 128 + wc * 32 + 8 * fq, t = col >> 4, n0 = col & 15;
                float uu[8]; unpack8(*(const GAS v4u*)(UG + ((size_t)g * 512 + row) * 256 + col), uu);
                const f32x4 v0 = acc[ai][bj][m][0], v1 = acc[ai][bj][m][1];
                float f[8] = {v0[0], v0[1], v0[2], v0[3], v1[0], v1[1], v1[2], v1[3]};
#pragma unroll
                for (int e = 0; e < 8; ++e) f[e] = gelu_tanh(f[e] + ((const GAS float*)dvec)[g * 16 + n0 + e] * uu[e]);
                *(GAS v4u*)(ZS + ((size_t)row * 16 + t) * 1024 + g * 16 + n0) = pack8(f);
            }
        EPI_ROWS_END
    }
};
struct EpiGlu {
    EPI_NO_MID
    static constexpr bool PERM = true;
    const bf16* ZS; bf16* Y;
    __device__ __forceinline__ void operator()(AccC acc, const Unit& u, int wr, int wc, int fr, int fq) const {
        const int col0 = u.pn * 256 + wc * 32 + 8 * fq;
        EPI_ROWS_BEGIN
#pragma unroll
            for (int bj = 0; bj < 2; ++bj) {
                float z[8]; unpack8(*(const GAS v4u*)(ZS + (size_t)row * 1024 + col0 + bj * 128), z);
                const f32x4 v0 = acc[ai][bj][m][0], v1 = acc[ai][bj][m][1];
                float f[8] = {v0[0], v0[1], v0[2], v0[3], v1[0], v1[1], v1[2], v1[3]};
#pragma unroll
                for (int e = 0; e < 8; ++e) f[e] = z[e] * fsigmoid(f[e]);
                *(GAS v4u*)(Y + (size_t)row * 1024 + col0 + bj * 128) = pack8(f);
            }
        EPI_ROWS_END
    }
};
struct EpiMerge {
    static constexpr bool PERM = true;
    const bf16* G; bf16* MM;
    __device__ __forceinline__ void mid(AccM acc, const Unit& u, int wr, int wc, int fr, int fq) const {
        const int col0 = u.pn * 256 + wc * 32 + 8 * fq, b = u.aux;
        EPI_ROWS_BEGIN
#pragma unroll
            for (int bj = 0; bj < 2; ++bj) {
                float ga[8], gn[8]; unpack8(*(const GAS v4u*)(G + (size_t)row * 6144 + b * 2048 + col0 + bj * 128), ga); unpack8(*(const GAS v4u*)(G + (size_t)row * 6144 + (b + 1) * 2048 + col0 + bj * 128), gn);
#pragma unroll
                for (int e = 0; e < 8; ++e) { const float rt = ga[e] * __builtin_amdgcn_rcpf(fmaxf(gn[e], 1e-30f)); acc[ai][bj][m][e >> 2][e & 3] *= rt; }
            }
        EPI_ROWS_END
    }
    __device__ __forceinline__ void operator()(AccC acc, const Unit& u, int wr, int wc, int fr, int fq) const {
        const int col0 = u.pn * 256 + wc * 32 + 8 * fq;
        EPI_ROWS_BEGIN
#pragma unroll
            for (int bj = 0; bj < 2; ++bj) {
                float g2[8]; unpack8(*(const GAS v4u*)(G + (size_t)row * 6144 + 2 * 2048 + col0 + bj * 128), g2);
                const f32x4 v0 = acc[ai][bj][m][0], v1 = acc[ai][bj][m][1];
                float f[8] = {v0[0], v0[1], v0[2], v0[3], v1[0], v1[1], v1[2], v1[3]};
#pragma unroll
                for (int e = 0; e < 8; ++e) f[e] *= g2[e];
                *(GAS v4u*)(MM + (size_t)row * 2048 + col0 + bj * 128) = pack8(f);
            }
        EPI_ROWS_END
    }
};
struct EpiSwiglu {
    EPI_NO_MID
    static constexpr bool PERM = true;
    bf16* FH;
    __device__ __forceinline__ void operator()(AccC acc, const Unit& u, int wr, int wc, int fr, int fq) const {
        const int col0 = u.pn * 128 + wc * 32 + 8 * fq;
        EPI_ROWS_BEGIN
            const f32x4 a0 = acc[ai][0][m][0], a1 = acc[ai][0][m][1], b0 = acc[ai][1][m][0], b1 = acc[ai][1][m][1];
            const float av[8] = {a0[0], a0[1], a0[2], a0[3], a1[0], a1[1], a1[2], a1[3]}, bv[8] = {b0[0], b0[1], b0[2], b0[3], b1[0], b1[1], b1[2], b1[3]};
            float f[8];
#pragma unroll
            for (int e = 0; e < 8; ++e) f[e] = av[e] * fsigmoid(av[e]) * bv[e];
            *(GAS v4u*)(FH + (size_t)row * FFH + col0) = pack8(f);
        EPI_ROWS_END
    }
};

struct SchedPlain {
    const char* A; const char* B; int nM, nN, G, c; size_t tA, tB;
    __device__ __forceinline__ bool next(int i, Unit& u) const { int pm, pn; if (!tile_order((long)(i / DUP_GEMM) * G + c, nM, nN, pm, pn)) return false; u.A = A + (size_t)pm * tA; u.B = B + (size_t)pn * tB; u.pm = pm; u.pn = pn; u.aux = 0; u.last = 1; return true; }
};
struct SchedMerge {
    const char* A0; const char* A1; const char* A2; const char* B; int G, c;
    __device__ __forceinline__ bool next(int i, Unit& u) const { const int ti = i / 3, b = i - ti * 3; int pm, pn; if (!tile_order((long)(ti / DUP_GEMM) * G + c, 32, 8, pm, pn)) return false;
        const char* Ab = b == 0 ? A0 : (b == 1 ? A1 : A2); u.A = Ab + (size_t)pm * 256 * 1024 * 2; u.B = B + ((size_t)b * 2048 + pn * 256) * 1024 * 2; u.pm = pm; u.pn = pn; u.aux = b; u.last = (b == 2); return true; }
};
struct SchedS5E {
    const char* UG; const char* ET; int G, c;
    __device__ __forceinline__ bool next(int i, Unit& u) const { const int L = (i / DUP_S5) * G + c; if (L >= 128) return false; const int g = L >> 1, pm = L & 1;
        u.A = UG + ((size_t)g * 512 + pm * 256) * 256 * 2; u.B = ET + (size_t)g * 256 * 256 * 2; u.pm = pm; u.pn = 0; u.aux = g; u.last = 1; return true; }
};
struct SchedS5Y {
    const char* UG; const char* HIN; const char* MT; const char* FT; int G, c;
    __device__ __forceinline__ bool next(int i, Unit& u) const { const int ti = (i >> 1) / DUP_S5, part = i & 1, L = ti * G + c; if (L >= 128) return false; const int g = L >> 1, pm = L & 1;
        u.A = (part ? HIN : UG) + ((size_t)g * 512 + pm * 256) * 256 * 2; u.B = (part ? FT : MT) + (size_t)g * 256 * 256 * 2; u.pm = pm; u.pn = 0; u.aux = g; u.last = part; return true; }
};
struct SchedRg {
    const char* XC; const char* GWT; int G, c;
    __device__ __forceinline__ bool next(int i, Unit& u) const { const int L = (i / DUP_RGG) * G + c; if (L >= 512) return false; const int pm = L & 31, hd = L >> 5;
        u.A = XC + ((size_t)pm * 256 * 1024 + (hd >> 1) * 128) * 2; u.B = GWT + (size_t)hd * 256 * 128 * 2; u.pm = pm; u.pn = 0; u.aux = hd; u.last = 1; return true; }
};
}

namespace att {
using bf16x8 = __attribute__((ext_vector_type(8))) short;
using s16x4  = __attribute__((ext_vector_type(4))) short;
using f32x16 = __attribute__((ext_vector_type(16))) float;
using u32x4  = __attribute__((ext_vector_type(4))) unsigned;
constexpr int D = 128, NW = 8, QBLK = 32, KVBLK = 64, LD = 1024;
constexpr float SCALE = 0.088388347648318440f, THR = 8.f;
constexpr size_t SHM_V = KVBLK * D * 2, SHM_K = KVBLK * D * 2, SHM_ATTN = 2 * SHM_V + 2 * SHM_K + NW * 64 * 4;
constexpr int RPB_OFF = (int)SHM_ATTN + 256;
#define KSWZ(row, colB) ((row) * 256 + ((colB) ^ (((row) & 7) << 4)))
#define SBAR() __builtin_amdgcn_sched_barrier(0)
__device__ __forceinline__ int crow(int r, int hi) { return (r & 3) + 8 * (r >> 2) + 4 * hi; }
__device__ __forceinline__ unsigned cvtpk(float lo, float hi) { return pk2(lo, hi); }
__device__ __forceinline__ void partialSM(f32x16& p0, f32x16& p1, float& m_reg, float& mn, float& alpha) {
  constexpr float C = SCALE * 1.4426950408889634f;
  float pmax = p0[0]; for (int r = 1; r < 16; ++r) pmax = fmaxf(pmax, p0[r]); for (int r = 0; r < 16; ++r) pmax = fmaxf(pmax, p1[r]);
  { auto rr = __builtin_amdgcn_permlane32_swap(__float_as_uint(pmax), __float_as_uint(pmax), false, false);
    pmax = fmaxf(__uint_as_float(rr[0]), __uint_as_float(rr[1])); }
  if (__builtin_expect(__all(pmax - m_reg <= THR / SCALE), 1)) { mn = m_reg; alpha = 1.f; }
  else { mn = fmaxf(m_reg, pmax); alpha = __builtin_amdgcn_exp2f((m_reg - mn) * C); m_reg = mn; }
  float mnC = -mn * C;
  for (int r = 0; r < 16; ++r) p0[r] = fmaf(p0[r], C, mnC); for (int r = 0; r < 16; ++r) p1[r] = fmaf(p1[r], C, mnC);
  for (int r = 0; r < 16; ++r) p0[r] = __builtin_amdgcn_exp2f(p0[r]);
}
__device__ __forceinline__ void finishSM(f32x16& p0, f32x16& p1, float alpha, float& l_reg, bf16x8& pa0, bf16x8& pa1, bf16x8& pa2, bf16x8& pa3) {
  for (int r = 0; r < 16; ++r) p1[r] = __builtin_amdgcn_exp2f(p1[r]);
  float ps = 0; for (int r = 0; r < 16; ++r) ps += p0[r]; for (int r = 0; r < 16; ++r) ps += p1[r];
  { auto rr = __builtin_amdgcn_permlane32_swap(__float_as_uint(ps), __float_as_uint(ps), false, false);
    ps = __uint_as_float(rr[0]) + __uint_as_float(rr[1]); }
  l_reg = l_reg * alpha + ps;
#define PK4(P, BASE, OUT) do { unsigned a0 = cvtpk(P[BASE + 0], P[BASE + 1]), a1 = cvtpk(P[BASE + 2], P[BASE + 3]);   \
    unsigned b0 = cvtpk(P[BASE + 4], P[BASE + 5]), b1 = cvtpk(P[BASE + 6], P[BASE + 7]);                              \
    auto r0 = __builtin_amdgcn_permlane32_swap(a0, b0, false, false); auto r1 = __builtin_amdgcn_permlane32_swap(a1, b1, false, false); \
    u32x4 w = {r0[0], r1[0], r0[1], r1[1]}; OUT = *reinterpret_cast<bf16x8*>(&w); } while (0)
  PK4(p0, 0, pa0); PK4(p0, 8, pa1); PK4(p1, 0, pa2); PK4(p1, 8, pa3);
#undef PK4
}
__device__ __forceinline__ void qkt(f32x16& p0, f32x16& p1, const bf16* Ks, const bf16x8* qr, int r32, int hi) {
  p0 = f32x16{}; p1 = f32x16{};
  for (int d0 = 0; d0 < 8; ++d0) { int cb = (d0 * 16 + hi * 8) * 2;
    bf16x8 b0 = *reinterpret_cast<const bf16x8*>((const char*)Ks + KSWZ(r32, cb));
    bf16x8 b1 = *reinterpret_cast<const bf16x8*>((const char*)Ks + KSWZ(32 + r32, cb));
    p0 = __builtin_amdgcn_mfma_f32_32x32x16_bf16(b0, qr[d0], p0, 0, 0, 0);
    p1 = __builtin_amdgcn_mfma_f32_32x32x16_bf16(b1, qr[d0], p1, 0, 0, 0); }
}
__device__ __forceinline__ int v_st(int k, int c) { const int kk = (k & ~0xC) | ((k & 4) << 1) | ((k & 8) >> 1); return ((kk >> 3) * 4 + (c >> 5)) * 512 + ((kk & 7) * 32 + (c & 31)) * 2; }
__device__ __forceinline__ int v_rd_base(int lane) { return ((lane & 3) << 3) | (((lane >> 2) & 3) << 6) | (((lane >> 4) & 1) << 5) | (((lane >> 5) & 1) << 8); }
constexpr int v_rd_off(int d0, int ks, int half) { return d0 * 512 + ks * 4096 + half * 2048; }
template <int OFF> __device__ __forceinline__ s16x4 tr_read(int vb) {
  s16x4 r; asm volatile("ds_read_b64_tr_b16 %0, %1 offset:%2" : "=&v"(r) : "v"(vb), "i"(OFF) : "memory"); return r;
}
template <int D0> __device__ __forceinline__ void pv_one(f32x16& od, int vb, bf16x8 pa0, bf16x8 pa1, bf16x8 pa2, bf16x8 pa3) {
  const s16x4 l0 = tr_read<v_rd_off(D0, 0, 0)>(vb), h0 = tr_read<v_rd_off(D0, 0, 1)>(vb), l1 = tr_read<v_rd_off(D0, 1, 0)>(vb), h1 = tr_read<v_rd_off(D0, 1, 1)>(vb);
  const s16x4 l2 = tr_read<v_rd_off(D0, 2, 0)>(vb), h2 = tr_read<v_rd_off(D0, 2, 1)>(vb), l3 = tr_read<v_rd_off(D0, 3, 0)>(vb), h3 = tr_read<v_rd_off(D0, 3, 1)>(vb);
  asm volatile("s_waitcnt lgkmcnt(0)" ::: "memory"); SBAR();
#define PK(L, H) (bf16x8){L[0], L[1], L[2], L[3], H[0], H[1], H[2], H[3]}
  od = __builtin_amdgcn_mfma_f32_32x32x16_bf16(pa0, PK(l0, h0), od, 0, 0, 0);
  od = __builtin_amdgcn_mfma_f32_32x32x16_bf16(pa1, PK(l1, h1), od, 0, 0, 0);
  od = __builtin_amdgcn_mfma_f32_32x32x16_bf16(pa2, PK(l2, h2), od, 0, 0, 0);
  od = __builtin_amdgcn_mfma_f32_32x32x16_bf16(pa3, PK(l3, h3), od, 0, 0, 0);
#undef PK
}
__device__ __forceinline__ void pv_d0(f32x16* o, int vb, bf16x8 pa0, bf16x8 pa1, bf16x8 pa2, bf16x8 pa3) {
  pv_one<0>(o[0], vb, pa0, pa1, pa2, pa3); pv_one<1>(o[1], vb, pa0, pa1, pa2, pa3); pv_one<2>(o[2], vb, pa0, pa1, pa2, pa3); pv_one<3>(o[3], vb, pa0, pa1, pa2, pa3);
}
__device__ __forceinline__ void na_mask(f32x16& p0, f32x16& p1, int kr, int qr, int rs, int ws, const float* rpbl, int hi) {
  if (kr < rs || kr >= rs + 8) {
#pragma unroll
    for (int r = 0; r < 16; ++r) { p0[r] = -1e30f; p1[r] = -1e30f; }
  } else {
    const float* row = rpbl + (kr - qr + 7) * 31 + 4 * hi; const unsigned w0 = (unsigned)(4 * hi - ws);
#pragma unroll
    for (int r = 0; r < 16; ++r) {
      const int kc = (r & 3) + 8 * (r >> 2);
      const float b0 = row[kc], b1 = row[kc + 32];
      p0[r] = (w0 + (unsigned)kc < 16u) ? p0[r] + b0 : -1e30f; p1[r] = (w0 + (unsigned)(kc + 32) < 16u) ? p1[r] + b1 : -1e30f;
      if ((r & 3) == 3) SBAR();
    }
  }
}
template <bool NA, int SD>
__device__ __forceinline__ void attn_body(const bf16* __restrict__ Qb, const bf16* __restrict__ K0, const bf16* __restrict__ V0, const bf16* __restrict__ K1, const bf16* __restrict__ V1,
                                          bf16* __restrict__ Ob, const int NT, const int lo, const int rg, char* lds) {
  int tid_ = threadIdx.x; asm volatile("" : "+v"(tid_));
  const int tid = tid_, wid = tid >> 6, lane = tid & 63, r32 = lane & 31, hi = lane >> 5;
  bf16* V_lds = (bf16*)lds; bf16* K_lds = (bf16*)(lds + 2 * SHM_V);
  float* ws_ = (float*)(lds + 2 * SHM_V + 2 * SHM_K) + wid * 64; float* li_l = ws_; float* al_l = ws_ + 32;
  const int qrow = 4 * rg + (wid >> 1), qc = 32 * (wid & 1) + r32;
  const int rs = qrow - 4 < 0 ? 0 : (qrow - 4 > 8 ? 8 : qrow - 4), wsn = qc - 8 < 0 ? 0 : (qc - 8 > 48 ? 48 : qc - 8);
  const float* rpbl = (const float*)(lds + RPB_OFF) + 15 - qc;
  float m_reg = -1e30f, l_reg = 0; f32x16 o[4] = {}; bf16x8 qr[8];
  const bf16* Qw = Qb + (long)(wid * QBLK + r32) * LD + hi * 8;
#pragma unroll
  for (int d0 = 0; d0 < 8; ++d0) qr[d0] = *(const GAS bf16x8*)(Qw + d0 * 16);
  const int sr = tid >> 4, sc = (tid & 15) * 8, vst0 = v_st(sr, sc), vst1 = v_st(32 + sr, sc);
  const int vb0 = (int)(uintptr_t)V_lds + v_rd_base(lane);
  struct { bf16x8 vs0, vs1, ks0, ks1; } sr_[SD];
#define TILEK(t) ((NA && (t) >= 8) ? K1 + (long)((t) - 8) * 64 * LD : K0 + (long)(t) * 64 * LD)
#define TILEV(t) ((NA && (t) >= 8) ? V1 + (long)((t) - 8) * 64 * LD : V0 + (long)(t) * 64 * LD)
#define SLOAD(i, t) do { const bf16* kp_ = TILEK(t); const bf16* vp_ = TILEV(t); \
    sr_[i].vs0 = *(const GAS bf16x8*)(&vp_[(long)sr * LD + sc]); sr_[i].vs1 = *(const GAS bf16x8*)(&vp_[(long)(32 + sr) * LD + sc]); \
    sr_[i].ks0 = *(const GAS bf16x8*)(&kp_[(long)sr * LD + sc]); sr_[i].ks1 = *(const GAS bf16x8*)(&kp_[(long)(32 + sr) * LD + sc]); } while (0)
#define SWRITE(b, i) do { *(bf16x8*)((char*)V_lds + (b) * SHM_V + vst0) = sr_[i].vs0;          \
    *(bf16x8*)((char*)V_lds + (b) * SHM_V + vst1) = sr_[i].vs1; int kc = sc * 2;               \
    *(bf16x8*)((char*)K_lds + (b) * SHM_K + KSWZ(sr, kc)) = sr_[i].ks0;                       \
    *(bf16x8*)((char*)K_lds + (b) * SHM_K + KSWZ(32 + sr, kc)) = sr_[i].ks1; } while (0)
#define SWAIT() do { if constexpr (SD == 2) asm volatile("s_waitcnt vmcnt(4)" ::: "memory"); else asm volatile("s_waitcnt vmcnt(0)" ::: "memory"); } while (0)
#define RESC(a) do { if (__any((a) < 1.f)) { if (hi == 0) al_l[r32] = (a); asm volatile("s_waitcnt lgkmcnt(0)" ::: "memory"); \
    for (int d = 0; d < 4; ++d) for (int r = 0; r < 16; ++r) o[d][r] *= al_l[crow(r, hi)]; } } while (0)
#define MASK(P0, P1, t) do { if (NA && (t) >= 8) na_mask(P0, P1, lo + (t) - 8, qrow, rs, wsn, rpbl, hi); } while (0)
  f32x16 pA0, pA1, pB0, pB1; float mnA, mnB, alA, alB; bf16x8 pa0, pa1, pa2, pa3;
  constexpr int SE = 0, SO = SD - 1;
  SLOAD(SE, 0); asm volatile("s_waitcnt vmcnt(0)" ::: "memory"); SWRITE(0, SE); __syncthreads();
  qkt(pA0, pA1, K_lds, qr, r32, hi); partialSM(pA0, pA1, m_reg, mnA, alA);
  SLOAD(SO, 1); if constexpr (SD == 2) { if (2 < NT) SLOAD(SE, 2); }
  SWAIT(); SWRITE(1, SO); __syncthreads();
  for (int j = 1; j + 1 < NT; j += 2) {
    SBAR(); qkt(pB0, pB1, (bf16*)((char*)K_lds + SHM_K), qr, r32, hi); MASK(pB0, pB1, j);
    finishSM(pA0, pA1, alA, l_reg, pa0, pa1, pa2, pa3); SBAR();
    SLOAD(SO, j + SD); SBAR();
    pv_d0(o, vb0, pa0, pa1, pa2, pa3); partialSM(pB0, pB1, m_reg, mnB, alB);
    __syncthreads(); SWAIT(); SWRITE(0, SE);
    RESC(alB); __syncthreads();
    SBAR(); qkt(pA0, pA1, K_lds, qr, r32, hi); MASK(pA0, pA1, j + 1);
    finishSM(pB0, pB1, alB, l_reg, pa0, pa1, pa2, pa3); SBAR();
    if (SD == 1 || j + 3 < NT) SLOAD(SE, j + 1 + SD); SBAR();
    pv_d0(o, vb0 + (int)SHM_V, pa0, pa1, pa2, pa3); partialSM(pA0, pA1, m_reg, mnA, alA);
    __syncthreads(); SWAIT(); SWRITE(1, SO);
    RESC(alA); __syncthreads();
  }
  SBAR(); qkt(pB0, pB1, (bf16*)((char*)K_lds + SHM_K), qr, r32, hi); MASK(pB0, pB1, NT - 1);
  finishSM(pA0, pA1, alA, l_reg, pa0, pa1, pa2, pa3); SBAR();
  pv_d0(o, vb0, pa0, pa1, pa2, pa3); partialSM(pB0, pB1, m_reg, mnB, alB);
  __syncthreads(); RESC(alB);
  finishSM(pB0, pB1, alB, l_reg, pa0, pa1, pa2, pa3); SBAR();
  pv_d0(o, vb0 + (int)SHM_V, pa0, pa1, pa2, pa3);
  if (hi == 0) li_l[r32] = l_reg; asm volatile("s_waitcnt lgkmcnt(0)" ::: "memory");
  float rli[16];
#pragma unroll
  for (int r = 0; r < 16; ++r) rli[r] = __builtin_amdgcn_rcpf(li_l[crow(r, hi)]);
  bf16* Ow = Ob + (long)(wid * QBLK) * LD;
#pragma unroll
  for (int r = 0; r < 16; ++r) { int orow = crow(r, hi);
    for (int d0 = 0; d0 < 4; ++d0) *(GAS bf16*)(Ow + (long)orow * LD + d0 * 32 + r32) = (bf16)f2bf(o[d0][r] * rli[r]); }
  asm volatile("s_waitcnt vmcnt(0)" ::: "memory"); __syncthreads();
#undef TILEK
#undef TILEV
#undef SLOAD
#undef SWRITE
#undef SWAIT
#undef RESC
#undef MASK
}
}

constexpr int NWAVES = 8;
struct Args { const float* in[36]; float* out; unsigned char* ws; int ph_lo, ph_hi; };
struct Frame { LAS unsigned char* lds; char* ldsg; volatile LAS unsigned* MISC; int tid, lane, wave, vcu, G; };
constexpr int INTAB_OFF = MISC_OFF + 128;
__device__ __forceinline__ const float* ld_in(const LAS unsigned char* lds, int i) { const unsigned long long v = ((const LAS unsigned long long*)(lds + INTAB_OFF))[i];
    const unsigned lo = __builtin_amdgcn_readfirstlane((unsigned)v), hi = __builtin_amdgcn_readfirstlane((unsigned)(v >> 32)); return (const float*)(((unsigned long long)hi << 32) | lo); }
#define IN(i) ld_in(F.lds, (i))

__device__ __forceinline__ void transpose_item(const float* W, int N, int k0, int n0, bf16* WT, int ldo, int drow0, float* scr, int lane) {
    const int kr = lane >> 3, n4 = (lane & 7) * 4;
    f32x4 v[8];
#pragma unroll
    for (int i = 0; i < 8; ++i) v[i] = *(const GAS f32x4*)(W + (size_t)(k0 + kr + 8 * i) * N + n0 + n4);
#pragma unroll
    for (int i = 0; i < 8; ++i) { float* d = scr + (kr + 8 * i) * 33 + n4; d[0] = v[i].x; d[1] = v[i].y; d[2] = v[i].z; d[3] = v[i].w; }
    LDS_WAIT(); asm volatile("" ::: "memory");
    const int c = lane & 7;
#pragma unroll
    for (int j = 0; j < 4; ++j) { const int n = (lane >> 3) + 8 * j; const float* s = scr + (8 * c) * 33 + n;
        v4u o; o.x = pk2(s[0 * 33], s[1 * 33]); o.y = pk2(s[2 * 33], s[3 * 33]); o.z = pk2(s[4 * 33], s[5 * 33]); o.w = pk2(s[6 * 33], s[7 * 33]);
        *(GAS v4u*)(WT + (size_t)(drow0 + n) * ldo + k0 + 8 * c) = o; }
    LDS_WAIT(); asm volatile("" ::: "memory");
}

__device__ __forceinline__ int cv_of_row(int row) { return row < CTXR ? 0 : 1 + ((row - CTXR) >> 10); }

template <bool FIRST, bool HASNEXT>
__device__ __forceinline__ void resnorm_rows(const Frame& F, const float* xin0, const float* xin1, float* X, const float* Z, const float* gpost, const float* modGate  ,
                                             const float* gpre, const float* modShift, const float* modScale, bf16* H) {
    const int gw = F.vcu * NWAVES + F.wave, NGW = F.G * NWAVES;
    for (int row = gw; row < ROWS; row += NGW) {
        const int cv = cv_of_row(row);
        f32x4 x[8];
        if (FIRST) {
            const GAS f32x4* src = (const GAS f32x4*)(row < CTXR ? xin0 + (size_t)row * DM : xin1 + (size_t)(row - CTXR) * DM) + F.lane;
#pragma unroll
            for (int j = 0; j < 8; ++j) x[j] = src[64 * j];
        } else {
            const GAS f32x4* zr = (const GAS f32x4*)(Z + (size_t)row * DM) + F.lane; const GAS f32x4* xr = (const GAS f32x4*)(X + (size_t)row * DM) + F.lane;
            f32x4 z[8]; float ss = 0.f;
#pragma unroll
            for (int j = 0; j < 8; ++j) { z[j] = zr[64 * j]; ss += (z[j].x * z[j].x + z[j].y * z[j].y) + (z[j].z * z[j].z + z[j].w * z[j].w); }
            const float rstd = rsqrtf(wave_sum(ss) * (1.f / DM) + RMS_EPS);
#pragma unroll
            for (int j = 0; j < 8; ++j) { const f32x4 gp = ((const GAS f32x4*)gpost)[F.lane + 64 * j], gt = ((const GAS f32x4*)(modGate + (size_t)cv * 12288))[F.lane + 64 * j];
                x[j] = xr[64 * j] + gt * (z[j] * rstd * gp); }
        }
        { GAS f32x4* xo = (GAS f32x4*)(X + (size_t)row * DM) + F.lane;
#pragma unroll
          for (int j = 0; j < 8; ++j) xo[64 * j] = x[j]; }
        if (HASNEXT) {
            float ss = 0.f;
#pragma unroll
            for (int j = 0; j < 8; ++j) ss += (x[j].x * x[j].x + x[j].y * x[j].y) + (x[j].z * x[j].z + x[j].w * x[j].w);
            const float rstd = rsqrtf(wave_sum(ss) * (1.f / DM) + RMS_EPS);
            GAS v2u* ho = (GAS v2u*)(H + (size_t)row * DM) + F.lane;
#pragma unroll
            for (int j = 0; j < 8; ++j) { const f32x4 g = ((const GAS f32x4*)gpre)[F.lane + 64 * j], sh = ((const GAS f32x4*)(modShift + (size_t)cv * 12288))[F.lane + 64 * j], sc = ((const GAS f32x4*)(modScale + (size_t)cv * 12288))[F.lane + 64 * j];
                const f32x4 h = x[j] * rstd * g * (sc + 1.0f) + sh; v2u w; w.x = pk2(h.x, h.y); w.y = pk2(h.z, h.w); ho[64 * j] = w; }
        }
    }
}

__device__ __forceinline__ void s5_tables(const Frame& F, int l, int g, unsigned char* ws) {
    char* L = F.ldsg;
    f32x2* POW = (f32x2*)L;
    f32x2* BB = (f32x2*)(L + 17408);
    f32x2* CC = (f32x2*)(L + 17408 + 16384);
    float* KT = (float*)(L + 17408 + 32768);
    const int tid = F.tid;
    __syncthreads();
    if (tid < 128) {
        const int d = tid >> 6, p = tid & 63; const size_t li = ((size_t)(l * 2 + d) * 64 + g) * 64 + p;
        const float dt = expf(IN(22)[(l * 2 + d) * 64 + g]); const float lre = IN(20)[li], lim = IN(21)[li];
        const float er = expf(lre * dt); float sn, cs; sincosf(lim * dt, &sn, &cs);
        const float br = er * cs, bi = er * sn;
        const float nr = br - 1.0f, ni = bi, den = lre * lre + lim * lim;
        const float cr = (nr * lre + ni * lim) / den, ci = (ni * lre - nr * lim) / den;
        float pr = 1.f, pi = 0.f;
        for (int t = 0; t <= 16; ++t) { POW[(d * 64 + p) * 17 + t] = (f32x2){pr, pi}; const float nr2 = pr * br - pi * bi, ni2 = pr * bi + pi * br; pr = nr2; pi = ni2; }
        ((f32x2*)(ws + WS_LT))[li] = POW[(d * 64 + p) * 17 + 16];
        for (int m = 0; m < 16; ++m) { const float xr = IN(23)[li * 16 + m], xi = IN(24)[li * 16 + m]; BB[(d * 64 + p) * 16 + m] = (f32x2){cr * xr - ci * xi, cr * xi + ci * xr}; }
    }
    for (int i = tid; i < 2048; i += 512) { const int d = i >> 10, n = (i >> 6) & 15, p = i & 63; const size_t ci_ = (((size_t)(l * 2 + d) * 64 + g) * 16 + n) * 64 + p; CC[i] = (f32x2){IN(25)[ci_], IN(26)[ci_]}; }
    __syncthreads();
    for (int i = tid; i < 8192; i += 512) {
        const int d = i >> 12, tau = (i >> 8) & 15, n = (i >> 4) & 15, m = i & 15; float s = 0.f;
        for (int p = 0; p < 64; ++p) { const f32x2 c = CC[(d * 16 + n) * 64 + p], w = POW[(d * 64 + p) * 17 + tau], b = BB[(d * 64 + p) * 16 + m];
            const float tr = c.x * w.x - c.y * w.y, ti = c.x * w.y + c.y * w.x; s += tr * b.x - ti * b.y; }
        KT[i] = s;
    }
    __syncthreads();
    bf16* MT = (bf16*)(ws + WS_MT) + (size_t)(l * 64 + g) * 65536; bf16* ET = (bf16*)(ws + WS_ET) + (size_t)(l * 64 + g) * 65536; bf16* FT = (bf16*)(ws + WS_FT) + (size_t)(l * 64 + g) * 65536;
    for (int i = tid; i < 8192; i += 512) {
        const int rowi = i >> 5, k0 = (i & 31) * 8;
        { const int t = rowi >> 4, n = rowi & 15, s = k0 >> 4, m0 = k0 & 15; float f[8];
#pragma unroll
          for (int e = 0; e < 8; ++e) { float v = 0.f; if (s <= t) v += KT[((0 * 16 + (t - s)) * 16 + n) * 16 + m0 + e]; if (s >= t) v += KT[((1 * 16 + (s - t)) * 16 + n) * 16 + m0 + e]; f[e] = v; }
          *(GAS v4u*)(MT + (size_t)rowi * 256 + k0) = pack8(f); }
        { const int d = rowi >> 7, p = (rowi >> 1) & 63, c = rowi & 1, s = k0 >> 4, m0 = k0 & 15; float f[8];
          const f32x2 w = POW[(d * 64 + p) * 17 + (d == 0 ? 15 - s : s)];
#pragma unroll
          for (int e = 0; e < 8; ++e) { const f32x2 b = BB[(d * 64 + p) * 16 + m0 + e]; f[e] = c == 0 ? (w.x * b.x - w.y * b.y) : (w.x * b.y + w.y * b.x); }
          *(GAS v4u*)(ET + (size_t)rowi * 256 + k0) = pack8(f); }
        { const int t = rowi >> 4, n = rowi & 15; float f[8];
#pragma unroll
          for (int e = 0; e < 8; ++e) { const int k = k0 + e, d = k >> 7, p = (k >> 1) & 63, c = k & 1; const f32x2 cc = CC[(d * 16 + n) * 64 + p], w = POW[(d * 64 + p) * 17 + (d == 0 ? t + 1 : 16 - t)];
              f[e] = c == 0 ? (cc.x * w.x - cc.y * w.y) : -(cc.x * w.y + cc.y * w.x); }
          *(GAS v4u*)(FT + (size_t)rowi * 256 + k0) = pack8(f); }
    }
    __syncthreads();
}

__global__ void __launch_bounds__(NWAVES * 64, 2) fwd_kernel(Args args) {
    extern __shared__ __attribute__((aligned(16))) unsigned char lds[];
    const int G0 = gridDim.x, c0 = (int)blockIdx.x;
    volatile LAS unsigned* MISC0 = (volatile LAS unsigned*)((LAS unsigned char*)lds + MISC_OFF);
    unsigned char* const ws0 = args.ws; float* const out0 = args.out;
    gu32* ctl = (gu32*)(ws0 + WS_CTL);
    for (int u = threadIdx.x; u < (LDS_BYTES - LDSCTL_OFF) / 4; u += NWAVES * 64) ((LAS unsigned*)((LAS unsigned char*)lds + LDSCTL_OFF))[u] = 0u;
    __syncthreads();
    if (threadIdx.x == 0) {
#pragma unroll
        for (int i = 0; i < 36; ++i) ((LAS unsigned long long*)((LAS unsigned char*)lds + INTAB_OFF))[i] = (unsigned long long)args.in[i]; }
    __syncthreads();
    XcdBarrier bar; bar.bar = (unsigned*)(ctl + CW_BAR); bar.x = 0; bar.st = nullptr;
    if (MK_N_LAUNCHES == 1) bar = xcd_barrier_post((unsigned*)(ctl + CW_BAR), MISC0 + 8);
    const int lo = args.ph_lo, hi = args.ph_hi;
    int ph = 0;
#ifndef PHMASK
#define PHMASK 0xFFFFFFFFu
#endif
#define PHASE_BEGIN(k) if (((PHMASK >> (k)) & 1u) && lo <= ph && ph < hi) { unsigned char* ws = ws0; float* outp = out0; int tid_p = threadIdx.x, G = G0, c = c0; asm volatile("" : "+s"(ws), "+s"(outp), "+v"(tid_p), "+s"(G), "+s"(c)); const int vcu = (G % 8 == 0) ? (c % 8) * (G / 8) + c / 8 : c;     \
    Frame F; F.lds = (LAS unsigned char*)lds; F.ldsg = (char*)lds; F.MISC = (volatile LAS unsigned*)(F.lds + MISC_OFF); F.tid = tid_p; F.lane = tid_p & 63; F.wave = __builtin_amdgcn_readfirstlane(tid_p >> 6); F.G = G; F.vcu = vcu; \
    const int gw = vcu * NWAVES + F.wave, NGW = G * NWAVES, gt = vcu * 512 + F.tid, NGT = G * 512; (void)gw; (void)NGW; (void)gt; (void)NGT; \
    float* const X = outp + O_X; bf16* const Hb = (bf16*)(ws + WS_H); float* const MOD = (float*)(ws + WS_MOD); const float* const modl = MOD + (size_t)l_ * NCV * INW; (void)X; (void)Hb; (void)modl;
#define PHASE_END   if (MK_N_LAUNCHES == 1 && ph + 1 < hi) { XcdBarrier b_ = bar; asm volatile("" : "+s"(b_.bar)); xcd_barrier(b_); } } ++ph;
    int l_ = 0;

    PHASE_BEGIN(0)
    {
        for (int it = F.vcu; it < NL * 64; it += G) s5_tables(F, it >> 6, it & 63, ws);
        __syncthreads();
        { const float* lamp = IN(19); for (int i = gt; i < NL * 2 * 1024; i += NGT) ((float*)(ws + WS_SP))[i] = log1pf(expf(-lamp[i])); }
        float* scr = (float*)(F.ldsg + F.wave * 16384);
        constexpr int I_WIN = 32 * 384, I_GLU = 16 * 32, I_OUT = 16 * 64, I_WO = 32 * 64, I_FIN = 32 * 352, I_FOUT = 88 * 64, I_GW = 32 * 8;
        constexpr int I_LAYER = I_WIN + I_GLU + 3 * I_OUT + I_WO + I_FIN + I_FOUT + I_GW;
        for (int it = gw; it < NL * I_LAYER; it += NGW) {
            const int l = it / I_LAYER; int r = it - l * I_LAYER;
            if (r < I_WIN) { const int kb = r / 384, nb = r % 384; transpose_item(IN(14) + (size_t)l * DM * INW, INW, kb * 64, nb * 32, (bf16*)(ws + WS_WINT) + (size_t)l * INW * DM, DM, nb * 32, scr, F.lane); continue; } r -= I_WIN;
            if (r < I_GLU) { const int kb = r / 32, nb = r % 32; transpose_item(IN(28) + (size_t)l * 1024 * 1024, 1024, kb * 64, nb * 32, (bf16*)(ws + WS_GLUT) + (size_t)l * 1024 * 1024, 1024, nb * 32, scr, F.lane); continue; } r -= I_GLU;
            if (r < 3 * I_OUT) { const int b = r / I_OUT, q = r % I_OUT, kb = q / 64, nb = q % 64; transpose_item(IN(30 + b) + (size_t)l * 1024 * DM, DM, kb * 64, nb * 32, (bf16*)(ws + WS_OUTT) + ((size_t)l * 3 + b) * DM * 1024, 1024, nb * 32, scr, F.lane); continue; } r -= 3 * I_OUT;
            if (r < I_WO) { const int kb = r / 64, nb = r % 64; transpose_item(IN(33) + (size_t)l * DM * DM, DM, kb * 64, nb * 32, (bf16*)(ws + WS_WOT) + (size_t)l * DM * DM, DM, nb * 32, scr, F.lane); continue; } r -= I_WO;
            if (r < I_FIN) { const int kb = r / 352, nb = r % 352; const int n0 = nb * 32, half = n0 >= FFH, j = n0 - half * FFH; const int drow = 256 * (j >> 7) + 128 * half + (j & 127);
                transpose_item(IN(34) + (size_t)l * DM * 2 * FFH, 2 * FFH, kb * 64, n0, (bf16*)(ws + WS_FINT) + (size_t)l * 2 * FFH * DM, DM, drow, scr, F.lane); continue; } r -= I_FIN;
            if (r < I_FOUT) { const int kb = r / 64, nb = r % 64; transpose_item(IN(35) + (size_t)l * FFH * DM, DM, kb * 64, nb * 32, (bf16*)(ws + WS_FOUTT) + (size_t)l * DM * FFH, FFH, nb * 32, scr, F.lane); continue; } r -= I_FOUT;
            { const int mi = r >> 3, q = r & 7, kb = q >> 2, nb = q & 3;
              const int d = mi >> 4, g = (mi >> 3) & 1, h = mi & 7;
              transpose_item(IN(17) + ((size_t)l * 32 + mi) * 128 * 128, 128, kb * 64, nb * 32, (bf16*)(ws + WS_GWT) + (((size_t)l * 8 + h) * 2 + d) * 256 * 128, 128, g * 128 + nb * 32, scr, F.lane); }
        }
        const float* ckp = IN(2); const float* cvp = IN(3);
        for (int i = gt; i < 2 * 1048576; i += NGT) { const int which = i >> 20, j = i & 1048575; const GAS f32x4* s = (const GAS f32x4*)(which ? cvp : ckp) + (size_t)j * 2; const f32x4 a0 = s[0], a1 = s[1];
            v4u o; o.x = pk2(a0.x, a0.y); o.y = pk2(a0.z, a0.w); o.z = pk2(a1.x, a1.y); o.w = pk2(a1.z, a1.w); ((GAS v4u*)(ws + (which ? WS_CV : WS_CK)))[j] = o; }
        const float* cctx = IN(7); const float* cvec = IN(6); const float* wmod = IN(8);
        for (int task = gt; task < 16 * NL * 3072; task += NGT) {
            const int n4 = task % 3072, l = (task / 3072) % NL, ks = task / (3072 * NL);
            f32x4 acc[NCV];
#pragma unroll
            for (int v = 0; v < NCV; ++v) acc[v] = (f32x4){0.f, 0.f, 0.f, 0.f};
            const GAS f32x4* wp = (const GAS f32x4*)(wmod + ((size_t)l * DM + ks * 128) * INW) + n4;
#pragma unroll 16
            for (int k = 0; k < 128; ++k) { const f32x4 w = wp[(size_t)k * (INW / 4)]; const int kk = ks * 128 + k;
#pragma unroll
                for (int v = 0; v < NCV; ++v) { const float cnd = v == 0 ? cctx[kk] : cvec[(v - 1) * DM + kk]; const float sl = cnd * fsigmoid(cnd); acc[v] += w * sl; } }
#pragma unroll
            for (int v = 0; v < NCV; ++v) ((f32x4*)(ws + WS_MODP))[(((size_t)ks * NL + l) * NCV + v) * 3072 + n4] = acc[v];
        }
    }
    PHASE_END
    PHASE_BEGIN(1)
        const float* bmod = IN(9);
        for (int i = gt; i < NL * NCV * 3072; i += NGT) { const int n4 = i % 3072, v = (i / 3072) % NCV, l = i / (3072 * NCV);
            f32x4 s = ((const f32x4*)(bmod + (size_t)l * INW))[n4];
#pragma unroll
            for (int ks = 0; ks < 16; ++ks) s += ((const f32x4*)(ws + WS_MODP))[(((size_t)ks * NL + l) * NCV + v) * 3072 + n4];
            ((f32x4*)MOD)[i] = s; }
    PHASE_END
    PHASE_BEGIN(2)
        resnorm_rows<true, true>(F, IN(0), IN(1), X, nullptr, nullptr, nullptr, IN(10), MOD + 0 * DM, MOD + 1 * DM, Hb);
    PHASE_END

    for (int l = 0; l < DBG_NL; ++l) {
        l_ = l;
        PHASE_BEGIN(3)
        {   pg8::SchedPlain S{(const char*)Hb, (const char*)(ws + WS_WINT) + (size_t)l * INW * DM * 2, 32, 48, G, c, (size_t)256 * DM * 2, (size_t)256 * DM * 2};
            pg8::EpiWin E{(bf16*)(ws + WS_XR), (bf16*)(ws + WS_XG), (bf16*)(ws + WS_UG), (bf16*)(ws + WS_Q), (bf16*)(ws + WS_K), (bf16*)(ws + WS_V), (bf16*)(ws + WS_G),
                          outp + O_K + (size_t)l * 256 * 1024, outp + O_V + (size_t)l * 256 * 1024};
            pg8::gemm_phase(F.lds, DM, DM, DM, S, E); }
        PHASE_END
        PHASE_BEGIN(4)
        {
            { pg8::SchedS5E S{(const char*)(ws + WS_UG), (const char*)(ws + WS_ET) + (size_t)l * 64 * 65536 * 2, G, c}; pg8::EpiHloc E{(float*)(ws + WS_HLOC)};
              pg8::gemm_phase(F.lds, 256, 256, 256, S, E); }
            { const bf16* XR = (const bf16*)(ws + WS_XR); bf16* XC = (bf16*)(ws + WS_XC); const GAS float* cw = (const GAS float*)(IN(15) + (size_t)l * 4 * 1024); const GAS float* cb = (const GAS float*)(IN(16) + (size_t)l * 1024);
              for (int i_ = gt; i_ < ROWS * 128 * DUP_CONV; i_ += NGT) { const int i = i_ % (ROWS * 128); const int row = i >> 7, c8 = (i & 127) * 8;
                  const int s0 = row < CTXR ? (row & ~255) : (CTXR + ((row - CTXR) & ~1023)), s1 = row < CTXR ? s0 + 256 : s0 + 1024;
                  float acc[8];
#pragma unroll
                  for (int e = 0; e < 8; ++e) acc[e] = cb[c8 + e];
#pragma unroll
                  for (int k = 0; k < 4; ++k) { const int rr = row + k - 1; if (rr >= s0 && rr < s1) { float xv[8]; unpack8(*(const GAS v4u*)(XR + (size_t)rr * 1024 + c8), xv);
#pragma unroll
                      for (int e = 0; e < 8; ++e) acc[e] += cw[k * 1024 + c8 + e] * xv[e]; } }
                  *(GAS v4u*)(XC + (size_t)row * 1024 + c8) = pack8(acc); } }
            __syncthreads();
            { float* rp = (float*)(F.ldsg + att::RPB_OFF); const bf16* Qb = (const bf16*)(ws + WS_Q); const bf16* Kb = (const bf16*)(ws + WS_K); const bf16* Vb = (const bf16*)(ws + WS_V); bf16* Ob = (bf16*)(ws + WS_YNA);
              for (int u_ = (c + G / 2) % G; u_ < 256 * DUP_ATT; u_ += G) { const int u = u_ & 255;
                  if (u < 128) { const int b = u >> 5, h = (u >> 2) & 7, rg = u & 3; const int lo_ = rg == 0 ? 0 : (rg == 1 ? 0 : (rg == 2 ? 4 : 8)), NT = (rg == 0 || rg == 3) ? 16 : 20;
                      for (int i = F.tid; i < 465; i += 512) rp[i] = IN(29)[((size_t)l * 8 + h) * 465 + i] * (1.0f / att::SCALE);
                      __syncthreads();
                      const size_t qoff = (size_t)(CTXR + b * 1024 + rg * 256) * 1024 + h * 128, koff = (size_t)(CTXR + b * 1024 + lo_ * 64) * 1024 + h * 128, coff = ((size_t)(b * 4 + l) * 512) * 1024 + h * 128;
                      att::attn_body<true, 1>(Qb + qoff, (const bf16*)(ws + WS_CK) + coff, (const bf16*)(ws + WS_CV) + coff, Kb + koff, Vb + koff, Ob + qoff, NT, lo_, rg, F.ldsg);
                  } else { const int b = (u - 128) >> 3, h = (u - 128) & 7; const size_t off = (size_t)(b * 256) * 1024 + h * 128;
                      att::attn_body<false, 2>(Qb + off, Kb + off, Vb + off, Kb + off, Vb + off, Ob + off, 4, 0, 0, F.ldsg); }
              } }
        }
        PHASE_END
        PHASE_BEGIN(5)
        {   { const float* HLOC = (const float*)(ws + WS_HLOC); bf16* HIN = (bf16*)(ws + WS_HIN); const GAS f32x2* LT = (const GAS f32x2*)(ws + WS_LT) + (size_t)l * 2 * 64 * 64;
              for (int i_ = gt; i_ < 20 * 64 * 2 * 64 * DUP_CARRY; i_ += NGT) { const int i = i_ % (20 * 64 * 2 * 64); const int p = i & 63, d = (i >> 6) & 1, g = (i >> 7) & 63, seq = i >> 13;
                  const int nch = seq < 16 ? 16 : 64, ch0 = seq < 16 ? seq * 16 : 256 + (seq - 16) * 64;
                  const f32x2 lam = LT[(d * 64 + g) * 64 + p]; float hr = 0.f, hi_ = 0.f;
                  if (seq >= 16) { const f32x2 h0 = ((const f32x2*)IN(5))[((((size_t)(seq - 16) * 4 + l) * 2 + d) * 64 + g) * 64 + p]; hr = h0.x; hi_ = h0.y; }
                  for (int k = 0; k < nch; ++k) { const int ch = d == 0 ? ch0 + k : ch0 + nch - 1 - k; const size_t idx = ((size_t)g * 512 + ch) * 256 + d * 128 + p * 2;
                      *(GAS unsigned*)(HIN + idx) = pk2(hr, hi_);
                      const f32x2 hl = *(const GAS f32x2*)(HLOC + idx); const float nr = lam.x * hr - lam.y * hi_ + hl.x, ni = lam.x * hi_ + lam.y * hr + hl.y; hr = nr; hi_ = ni; }
                  if (seq < 16) ((f32x2*)(outp + O_S5))[((((size_t)seq * 4 + l) * 2 + d) * 64 + g) * 64 + p] = (f32x2){hr, hi_}; } }
            { pg8::SchedRg S{(const char*)(ws + WS_XC), (const char*)(ws + WS_GWT) + (size_t)l * 8 * 2 * 256 * 128 * 2, G, c};
              pg8::EpiRg E{(const bf16*)(ws + WS_XC), IN(18) + (size_t)l * 4 * 1024, (const float*)(ws + WS_SP) + (size_t)l * 2048, (f32x2*)(ws + WS_AB)};
              pg8::gemm_phase(F.lds, 128, 1024, 128, S, E); }
        }
        PHASE_END
        PHASE_BEGIN(6)
        {   { pg8::SchedS5Y S{(const char*)(ws + WS_UG), (const char*)(ws + WS_HIN), (const char*)(ws + WS_MT) + (size_t)l * 64 * 65536 * 2, (const char*)(ws + WS_FT) + (size_t)l * 64 * 65536 * 2, G, c};
              pg8::EpiS5Y E{(const bf16*)(ws + WS_UG), IN(27) + (size_t)l * 1024, (bf16*)(ws + WS_ZS)};
              pg8::gemm_phase(F.lds, 256, 256, 256, S, E); }
            { const GAS f32x2* AB = (const GAS f32x2*)(ws + WS_AB); GAS float* HF = (GAS float*)(ws + WS_HF); const GAS bf16* XG = (const GAS bf16*)(ws + WS_XG); GAS bf16* YRG = (GAS bf16*)(ws + WS_YRG);
              float* cs = (float*)F.ldsg;
              for (int task_ = (c + G / 2) % G; task_ < 320 * DUP_SCAN; task_ += G) { const int task = task_ % 320;
                  const bool lat = task >= 64 && task < 128; const int ti = lat ? task - 64 : (task < 64 ? task : task - 64); const int seq = ti >> 4, cb = ti & 15;
                  const int L = lat ? 1024 : 256, row0 = lat ? CTXR + seq * 1024 : seq * 256, ch = cb * 64 + F.lane, len = L / 8, t0 = row0 + F.wave * len;
                  __syncthreads();
                  float pf = 1.f, hf = 0.f, pb = 1.f, hb = 0.f;
                  for (int t = 0; t < len; ++t) { const f32x2 v = AB[(size_t)(t0 + t) * 1024 + ch]; hf = v.x * hf + v.y; pf *= v.x; }
                  for (int t = len - 1; t >= 0; --t) { const f32x2 v = AB[((size_t)ROWS + t0 + t) * 1024 + ch]; hb = v.x * hb + v.y; pb *= v.x; }
                  cs[(F.wave * 4 + 0) * 64 + F.lane] = pf; cs[(F.wave * 4 + 1) * 64 + F.lane] = hf; cs[(F.wave * 4 + 2) * 64 + F.lane] = pb; cs[(F.wave * 4 + 3) * 64 + F.lane] = hb;
                  __syncthreads();
                  float cf = lat ? IN(4)[((size_t)(seq * 4 + l) * 2 + 0) * 1024 + ch] : 0.f, cbk = lat ? IN(4)[((size_t)(seq * 4 + l) * 2 + 1) * 1024 + ch] : 0.f;
                  for (int w = 0; w < F.wave; ++w) cf = cs[(w * 4 + 0) * 64 + F.lane] * cf + cs[(w * 4 + 1) * 64 + F.lane];
                  for (int w = 7; w > F.wave; --w) cbk = cs[(w * 4 + 2) * 64 + F.lane] * cbk + cs[(w * 4 + 3) * 64 + F.lane];
                  if (!lat) { if (F.wave == 7) outp[O_RG + ((size_t)(seq * 4 + l) * 2 + 0) * 1024 + ch] = pf * cf + hf; if (F.wave == 0) outp[O_RG + ((size_t)(seq * 4 + l) * 2 + 1) * 1024 + ch] = pb * cbk + hb; }
                  float h = cf;
                  for (int t = 0; t < len; ++t) { const f32x2 v = AB[(size_t)(t0 + t) * 1024 + ch]; h = v.x * h + v.y; HF[(size_t)(t0 + t) * 1024 + ch] = h; }
                  h = cbk;
                  for (int t = len - 1; t >= 0; --t) { const f32x2 v = AB[((size_t)ROWS + t0 + t) * 1024 + ch]; h = v.x * h + v.y; const size_t o = (size_t)(t0 + t) * 1024 + ch;
                      YRG[o] = (bf16)f2bf((HF[o] + h) * bf2f(XG[o])); }
              } }
        }
        PHASE_END
        PHASE_BEGIN(7)
        {   pg8::SchedPlain S{(const char*)(ws + WS_ZS), (const char*)(ws + WS_GLUT) + (size_t)l * 1024 * 1024 * 2, 32, 4, G, c, (size_t)256 * 1024 * 2, (size_t)256 * 1024 * 2};
            pg8::EpiGlu E{(const bf16*)(ws + WS_ZS), (bf16*)(ws + WS_YS5)};
            pg8::gemm_phase(F.lds, 1024, 1024, 1024, S, E); }
        PHASE_END
        PHASE_BEGIN(8)
        {   pg8::SchedMerge S{(const char*)(ws + WS_YRG), (const char*)(ws + WS_YS5), (const char*)(ws + WS_YNA), (const char*)(ws + WS_OUTT) + (size_t)l * 3 * DM * 1024 * 2, G, c};
            pg8::EpiMerge E{(const bf16*)(ws + WS_G), (bf16*)(ws + WS_MM)};
            pg8::gemm_phase(F.lds, 1024, 1024, 1024, S, E); }
        PHASE_END
        PHASE_BEGIN(9)
        {   pg8::SchedPlain S{(const char*)(ws + WS_MM), (const char*)(ws + WS_WOT) + (size_t)l * DM * DM * 2, 32, 8, G, c, (size_t)256 * DM * 2, (size_t)256 * DM * 2};
            pg8::EpiF32 E{(float*)(ws + WS_Z), DM};
            pg8::gemm_phase(F.lds, DM, DM, DM, S, E); }
        PHASE_END
        PHASE_BEGIN(10)
            resnorm_rows<false, true>(F, nullptr, nullptr, X, (const float*)(ws + WS_Z), IN(11) + (size_t)l * DM, modl + 2 * DM, IN(12) + (size_t)l * DM, modl + 3 * DM, modl + 4 * DM, Hb);
        PHASE_END
        PHASE_BEGIN(11)
        {   pg8::SchedPlain S{(const char*)Hb, (const char*)(ws + WS_FINT) + (size_t)l * 2 * FFH * DM * 2, 32, 44, G, c, (size_t)256 * DM * 2, (size_t)256 * DM * 2};
            pg8::EpiSwiglu E{(bf16*)(ws + WS_FH)};
            pg8::gemm_phase(F.lds, DM, DM, DM, S, E); }
        PHASE_END
        PHASE_BEGIN(12)
        {   pg8::SchedPlain S{(const char*)(ws + WS_FH), (const char*)(ws + WS_FOUTT) + (size_t)l * DM * FFH * 2, 32, 8, G, c, (size_t)256 * FFH * 2, (size_t)256 * FFH * 2};
            pg8::EpiF32 E{(float*)(ws + WS_Z), DM};
            pg8::gemm_phase(F.lds, FFH, FFH, FFH, S, E); }
        PHASE_END
        PHASE_BEGIN(13)
            if (l + 1 < NL) resnorm_rows<false, true>(F, nullptr, nullptr, X, (const float*)(ws + WS_Z), IN(13) + (size_t)l * DM, modl + 5 * DM, IN(10) + (size_t)(l + 1) * DM, modl + NCV * INW + 0 * DM, modl + NCV * INW + 1 * DM, Hb);
            else resnorm_rows<false, false>(F, nullptr, nullptr, X, (const float*)(ws + WS_Z), IN(13) + (size_t)l * DM, modl + 5 * DM, nullptr, nullptr, nullptr, Hb);
        PHASE_END
    }
#if DBG_KEEP
    PHASE_BEGIN(14)
        for (size_t i = (size_t)gt; i < O_END; i += (size_t)NGT) {
            int r, lay = 0;
            if (i < O_K) r = i < O_K / 2 ? 0 : 1;
            else if (i < O_V) { r = 2; lay = (int)(((i - O_K) / (256 * 1024)) & 3); }
            else if (i < O_RG) { r = 3; lay = (int)(((i - O_V) / (256 * 1024)) & 3); }
            else if (i < O_S5) { r = 4; lay = (int)(((i - O_RG) / 2048) & 3); }
            else { r = 5; lay = (int)(((i - O_S5) / 16384) & 3); }
            const bool keep = ((DBG_KEEP >> r) & 1) && (r < 2 || ((DBG_LMASK >> lay) & 1));
            float v = keep ? 3.0f * outp[i] : 0.0f;
#if DBG_DUMP
            v = 0.f;
            if (i >= O_K && i < O_K + (size_t)ROWS * 1024) { const size_t j = i - O_K;
                if (DBG_DUMP == 1) v = bf2f(((const bf16*)(ws + WS_YNA))[j]);
                if (DBG_DUMP == 2) v = bf2f(((const bf16*)(ws + WS_YS5))[j]);
                if (DBG_DUMP == 3) v = bf2f(((const bf16*)(ws + WS_YRG))[j]);
                if (DBG_DUMP == 4) v = bf2f(((const bf16*)(ws + WS_ZS))[j]);
                if (DBG_DUMP == 5) v = bf2f(((const bf16*)(ws + WS_MM))[j]);
                if (DBG_DUMP == 6) v = ((const float*)(ws + WS_Z))[j];
                if (DBG_DUMP == 7) v = bf2f(((const bf16*)(ws + WS_FH))[j]);
                if (DBG_DUMP == 8) v = bf2f(((const bf16*)(ws + WS_H))[j]);
                if (DBG_DUMP == 9) v = bf2f(((const bf16*)(ws + WS_G))[j]);
                if (DBG_DUMP == 11) v = bf2f(((const bf16*)(ws + WS_G))[(size_t)8192 * 6144 + j]);
                if (DBG_DUMP == 10) v = bf2f(((const bf16*)(ws + WS_WINT))[(size_t)6144 * 2048 + j]);
            }
#endif
            outp[i] = v;
        }
    PHASE_END
#endif
#undef PHASE_BEGIN
#undef PHASE_END
}
constexpr int N_PHASES = 3 + DBG_NL * 11 + (DBG_KEEP ? 1 : 0);

extern "C" void kernel_launch(void* const* d_in, const int* in_sizes, int n_in, void* d_out, int out_size, void* d_ws, size_t ws_size, hipStream_t stream) {
    static int grid = 0;
    if (grid == 0) {
        if (n_in != 36 || out_size != (int)O_END || ws_size < WS_END) { fprintf(stderr, "kernel_launch: unexpected shapes (n_in %d out %d ws %zu)\n", n_in, out_size, ws_size); grid = -1; return; }
        int dev = 0, cus = 0, per_cu = 0;
        if (hipGetDevice(&dev) != hipSuccess || hipDeviceGetAttribute(&cus, hipDeviceAttributeMultiprocessorCount, dev) != hipSuccess) { grid = -1; return; }
        if (hipFuncSetAttribute((const void*)fwd_kernel, hipFuncAttributeMaxDynamicSharedMemorySize, LDS_BYTES) != hipSuccess) { fprintf(stderr, "kernel_launch: hipFuncSetAttribute failed\n"); grid = -1; return; }
        if (hipOccupancyMaxActiveBlocksPerMultiprocessor(&per_cu, (const void*)fwd_kernel, NWAVES * 64, LDS_BYTES) != hipSuccess || per_cu < 1) { fprintf(stderr, "kernel_launch: occupancy query reports %d blocks per CU\n", per_cu); }
        (void)hipGetLastError();
        grid = cus;
    }
    if (grid < 0) return;
    if (hipMemsetAsync((char*)d_ws + WS_CTL, 0, CTL_ZERO_BYTES, stream) != hipSuccess) return;
    Args a{};
    for (int i = 0; i < 36; ++i) a.in[i] = (const float*)d_in[i];
    a.out = (float*)d_out; a.ws = (unsigned char*)d_ws;
    if (MK_N_LAUNCHES == 1) { a.ph_lo = 0; a.ph_hi = N_PHASES; hipLaunchKernelGGL(fwd_kernel, dim3(grid), dim3(NWAVES * 64), LDS_BYTES, stream, a); }
    else for (int p = 0; p < N_PHASES; ++p) { a.ph_lo = p; a.ph_hi = p + 1; hipLaunchKernelGGL(fwd_kernel, dim3(grid), dim3(NWAVES * 64), LDS_BYTES, stream, a); }
}
```

```cpp
#include <hip/hip_runtime.h>
#include <hip/hip_bf16.h>
#include <cstdio>
#include <cstdint>

#ifndef MK_N_LAUNCHES
#define MK_N_LAUNCHES 1
#endif
#ifndef DBG_KEEP
#define DBG_KEEP 0
#endif
#ifndef DUP_SCAN
#define DUP_SCAN 1
#endif
#ifndef DUP_ATT
#define DUP_ATT 1
#endif
#ifndef DUP_CARRY
#define DUP_CARRY 1
#endif
#ifndef DUP_CONV
#define DUP_CONV 1
#endif
#ifndef DUP_RGG
#define DUP_RGG 1
#endif
#ifndef DUP_S5
#define DUP_S5 1
#endif
#ifndef TSEL
#define TSEL (-1)
#endif
#ifndef DUPG1
#define DUPG1 1
#endif
#ifndef DUPG6
#define DUPG6 1
#endif
#ifndef DUPG9
#define DUPG9 1
#endif
#ifndef DUPG10
#define DUPG10 1
#endif
#ifndef DUP_GEMM
#define DUP_GEMM 1
#endif
#ifndef DUP_MASK
#define DUP_MASK 0u
#endif
#ifndef DBG_LMASK
#define DBG_LMASK 15
#endif
#ifndef DBG_DUMP
#define DBG_DUMP 0
#endif
#ifndef DBG_NL
#define DBG_NL 4
#endif

constexpr int DM = 2048, ROWS = 8192, CTXR = 4096, INW = 12288, FFH = 5632, NL = 4, W1K = 1024;
constexpr int NCV = 5;
constexpr float RMS_EPS = 1e-6f;
constexpr size_t MiB = 1u << 20;

constexpr size_t O_X = 0, O_K = 16777216, O_V = 33554432, O_RG = 50331648, O_S5 = 50462720, O_END = 51511296;

constexpr size_t WS_CTL = 0, CTL_ZERO_BYTES = 1 * MiB;
constexpr size_t WS_MODP = 1 * MiB;
constexpr size_t WS_MOD  = 17 * MiB;
constexpr size_t WS_SP   = 18 * MiB;
constexpr size_t WS_LT   = 18 * MiB + 65536;
constexpr size_t WS_GWT  = 19 * MiB;
constexpr size_t WS_WINT = 24 * MiB;
constexpr size_t WS_GLUT = 216 * MiB;
constexpr size_t WS_OUTT = 224 * MiB;
constexpr size_t WS_WOT  = 272 * MiB;
constexpr size_t WS_FINT = 304 * MiB;
constexpr size_t WS_FOUTT = 480 * MiB;
constexpr size_t WS_MT   = 568 * MiB;
constexpr size_t WS_ET   = 600 * MiB;
constexpr size_t WS_FT   = 632 * MiB;
constexpr size_t WS_CK   = 664 * MiB;
constexpr size_t WS_CV   = 680 * MiB;
constexpr size_t WS_H    = 696 * MiB;
constexpr size_t WS_XR   = 728 * MiB;
constexpr size_t WS_XG   = 744 * MiB;
constexpr size_t WS_XC   = 760 * MiB;
constexpr size_t WS_Q    = 776 * MiB;
constexpr size_t WS_K    = 792 * MiB;
constexpr size_t WS_V    = 808 * MiB;
constexpr size_t WS_YRG  = 824 * MiB;
constexpr size_t WS_YS5  = 840 * MiB;
constexpr size_t WS_YNA  = 856 * MiB;
constexpr size_t WS_ZS   = 872 * MiB;
constexpr size_t WS_UG   = 888 * MiB;
constexpr size_t WS_HIN  = 904 * MiB;
constexpr size_t WS_G    = 920 * MiB;
constexpr size_t WS_AB   = 1016 * MiB;
constexpr size_t WS_FH   = 1016 * MiB;
constexpr size_t WS_HF   = 1144 * MiB;
constexpr size_t WS_HLOC = 1176 * MiB;
constexpr size_t WS_Z    = 1144 * MiB;
constexpr size_t WS_MM   = 1208 * MiB;
constexpr size_t WS_END  = 1240 * MiB;

constexpr int CW_TMO = 0, CW_BAR = 4096;

constexpr int RING_BYTES = 131072;
constexpr int LDSCTL_OFF = RING_BYTES, MISC_OFF = LDSCTL_OFF + 320;
constexpr int LDS_BYTES = 147456;

#define GAS __attribute__((address_space(1)))
#define LAS __attribute__((address_space(3)))
typedef unsigned short bf16;
typedef unsigned v4u __attribute__((ext_vector_type(4)));
typedef unsigned v2u __attribute__((ext_vector_type(2)));
typedef float f32x4 __attribute__((ext_vector_type(4)));
typedef float f32x2 __attribute__((ext_vector_type(2)));
typedef short bf16x8 __attribute__((ext_vector_type(8)));
typedef GAS unsigned gu32;
#define RLX_AGENT __ATOMIC_RELAXED, __HIP_MEMORY_SCOPE_AGENT
#define LDS_WAIT() asm volatile("s_waitcnt lgkmcnt(0)" ::: "memory")
#define VM_WAIT() asm volatile("s_waitcnt vmcnt(0)" ::: "memory")

__device__ __forceinline__ unsigned f2bf(float f) { unsigned u = __builtin_bit_cast(unsigned, f); return (u + 0x7fffu + ((u >> 16) & 1u)) >> 16; }
typedef __bf16 bf16x2_t __attribute__((ext_vector_type(2)));
__device__ __forceinline__ unsigned pk2(float lo, float hi) { const f32x2 v = {lo, hi}; const bf16x2_t b = __builtin_convertvector(v, bf16x2_t); return __builtin_bit_cast(unsigned, b); }
__device__ __forceinline__ float bflo(unsigned w) { return __builtin_bit_cast(float, w << 16); }
__device__ __forceinline__ float bfhi(unsigned w) { return __builtin_bit_cast(float, w & 0xffff0000u); }
__device__ __forceinline__ float bf2f(bf16 h) { return __builtin_bit_cast(float, (unsigned)h << 16); }
__device__ __forceinline__ float fsigmoid(float x) { return __builtin_amdgcn_rcpf(1.0f + __expf(-x)); }
__device__ __forceinline__ float gelu_tanh(float x) { const float y = 0.7978845608028654f * (x + 0.044715f * x * x * x); return x * __builtin_amdgcn_rcpf(1.0f + __expf(-2.0f * y)); }
__device__ __forceinline__ float wave_sum(float v, int lane) {
#pragma unroll
    for (int o = 1; o < 64; o <<= 1) v += __builtin_bit_cast(float, __builtin_amdgcn_ds_bpermute((lane ^ o) << 2, __builtin_bit_cast(int, v)));
    return v;
}
__device__ __forceinline__ void unpack8(const v4u w, float (&f)[8]) { f[0] = bflo(w.x); f[1] = bfhi(w.x); f[2] = bflo(w.y); f[3] = bfhi(w.y); f[4] = bflo(w.z); f[5] = bfhi(w.z); f[6] = bflo(w.w); f[7] = bfhi(w.w); }
__device__ __forceinline__ v4u pack8(const float (&f)[8]) { v4u w; w.x = pk2(f[0], f[1]); w.y = pk2(f[2], f[3]); w.z = pk2(f[4], f[5]); w.w = pk2(f[6], f[7]); return w; }

#define XB_TMO      128
#define XB_XCNT(j)  (256  + 64 * (j))
#define XB_XSUB(j)  (1280 + 64 * (j))
#define XB_XGEN(j)  (2304 + 64 * (j))
#define XB_TOP      3328
#define XB_TOPGEN   3392
#define XCD_BAR_WORDS 3456
#define XB_SPIN_CAP (1u << 18)
__device__ __forceinline__ unsigned xb_ld(unsigned* p)              { return __hip_atomic_load(p, __ATOMIC_RELAXED, __HIP_MEMORY_SCOPE_AGENT); }
__device__ __forceinline__ unsigned xb_add(unsigned* p, unsigned v) { return __hip_atomic_fetch_add(p, v, __ATOMIC_RELAXED, __HIP_MEMORY_SCOPE_AGENT); }
__device__ __forceinline__ unsigned xb_xcc_id() { return (unsigned)__builtin_amdgcn_s_getreg((3 << 11) | 20) & 0xFu; }
#define XB_SPIN(cond, bar) do { unsigned _sp = 0; while (cond) { __builtin_amdgcn_s_sleep(1); \
    if ((++_sp & 255u) == 0u) { if (xb_ld(&(bar)[XB_TMO])) break; if (_sp > XB_SPIN_CAP) { atomicAdd(&(bar)[XB_TMO], 1u); break; } } } } while (0)
struct XcdBarrier { unsigned* bar; unsigned x; volatile LAS unsigned* st; };
__device__ __forceinline__ XcdBarrier xcd_barrier_post(unsigned* bar, volatile LAS unsigned* st) {
    XcdBarrier b; b.bar = bar; b.x = xb_xcc_id(); b.st = st;
    if (threadIdx.x == 0) (void)xb_add(&bar[XB_XCNT(b.x)], 1u);
    return b;
}
__device__ __forceinline__ void xcd_barrier_complete(unsigned* bar, unsigned x, unsigned& nloc, unsigned& nx) {
    const unsigned G = gridDim.x * gridDim.y * gridDim.z;
    unsigned sum, cnt, mine, sp = 0u;
    for (;;) {
        sum = 0u; cnt = 0u; mine = 0u;
#pragma unroll
        for (unsigned j = 0; j < 16; ++j) { const unsigned c = xb_ld(&bar[XB_XCNT(j)]); sum += c; cnt += (c > 0u) ? 1u : 0u; mine = (j == x) ? c : mine; }
        if (sum == G) break;
        __builtin_amdgcn_s_sleep(1);
        if ((++sp & 255u) == 0u) { if (xb_ld(&bar[XB_TMO])) break; if (sp > XB_SPIN_CAP) { atomicAdd(&bar[XB_TMO], 1u); break; } }
    }
    nloc = mine > 0u ? mine : 1u; nx = cnt > 0u ? cnt : 1u;
}
__device__ __forceinline__ void xcd_barrier(const XcdBarrier& b) {
    asm volatile("s_waitcnt vmcnt(0)" ::: "memory");
    __syncthreads();
    int tid_b = threadIdx.x; asm volatile("" : "+v"(tid_b));
    if (tid_b == 0) {
        unsigned* bar = b.bar;
        __builtin_amdgcn_s_waitcnt(0);
        unsigned nloc = b.st[0], nx = b.st[1];
        if (nloc == 0u) { xcd_barrier_complete(bar, b.x, nloc, nx); b.st[0] = nloc; b.st[1] = nx; }
        const unsigned old = xb_add(&bar[XB_XSUB(b.x)], 1u);
        const unsigned gen = old / nloc;
        if (old + 1u == (gen + 1u) * nloc) {
            __builtin_amdgcn_fence(__ATOMIC_RELEASE, "agent");
            asm volatile("s_waitcnt vmcnt(0)" ::: "memory");
            const unsigned og = xb_add(&bar[XB_TOP], 1u);
            const unsigned tg = og / nx;
            if (og + 1u == (tg + 1u) * nx) xb_add(&bar[XB_TOPGEN], 1u);
            else XB_SPIN(xb_ld(&bar[XB_TOPGEN]) == tg, bar);
            __builtin_amdgcn_fence(__ATOMIC_ACQUIRE, "agent");
            xb_add(&bar[XB_XGEN(b.x)], 1u);
            asm volatile("s_waitcnt vmcnt(0)" ::: "memory");
        } else {
            XB_SPIN(xb_ld(&bar[XB_XGEN(b.x)]) == gen, bar);
            __builtin_amdgcn_fence(__ATOMIC_ACQUIRE, "agent");
            asm volatile("s_waitcnt vmcnt(0)" ::: "memory");
        }
    }
    __syncthreads();
}

namespace pg8 {
#define PG8_LAS __attribute__((address_space(3)))
constexpr int BM = 256, BK = 64, HALF = 128, HTB = HALF * BK * 2, STAGE_BYTES = 8 * HTB;
__host__ __device__ __forceinline__ int lds_byte(int r, int c) { const int st = (r >> 4) * 2 + (c >> 5), rr = r & 15, cc = c & 31, ob = rr * 64 + cc * 2; return st * 1024 + (ob ^ (((ob >> 9) & 1) << 5)); }
__host__ __device__ __forceinline__ void stage_rc(int b, int& R, int& C) { const int st = b / 1024, sb = b % 1024, swz = sb ^ (((sb >> 9) & 1) << 5); R = (st >> 1) * 16 + swz / 64; C = (st & 1) * 32 + (swz % 64) / 2; }
__host__ __device__ __forceinline__ int perm32(int rho) { const int n = rho >> 4, i = rho & 15; return 8 * (i >> 2) + 4 * n + (i & 3); }

struct Unit { const char* A; const char* B; int pm, pn, aux, last; };

__device__ __forceinline__ bool tile_order(long L, int nM, int nN, int& pm, int& pn) {
    const int nwg = nM * nN; if (L >= nwg) return false;
    int wgid = (int)L; { const int q = nwg / 8, r = nwg % 8, xcd = wgid % 8, off = wgid / 8; wgid = (xcd < r ? xcd * (q + 1) : r * (q + 1) + (xcd - r) * q) + off; }
    const int nig = 8 * nN, gid = wgid / nig, fm = gid * 8, gsz = (nM - fm) < 8 ? (nM - fm) : 8;
    pm = fm + ((wgid % nig) % gsz); pn = (wgid % nig) / gsz; return true;
}

typedef float f32x4 __attribute__((ext_vector_type(4)));
typedef short bf16x8 __attribute__((ext_vector_type(8)));

template <class Epi, class Sched>
__device__ __forceinline__ void gemm_phase(PG8_LAS unsigned char* lds, const int K, const int lda, const int ldb, const Sched& S, const Epi& E) {
    int tid_ = threadIdx.x; asm volatile("" : "+v"(tid_));
    const int tid = tid_, wid = __builtin_amdgcn_readfirstlane(tid >> 6), lane = tid & 63, wr = wid >> 2, wc = wid & 3, fr = lane & 15, fq = lane >> 4;
    const int nt = K / BK;
    unsigned voffA[2], voffB[2];
#pragma unroll
    for (int i = 0; i < 2; ++i) { int R, C; stage_rc(tid * 16 + i * 8192, R, C); const int Rb = Epi::PERM ? ((R & ~31) + perm32(R & 31)) : R;
        voffA[i] = (unsigned)(R * lda + C) * 2u; voffB[i] = (unsigned)(Rb * ldb + C) * 2u; }
    const size_t kstep = (size_t)(BK * 2);
    const size_t hstepA = (size_t)HALF * lda * 2, hstepB = (size_t)HALF * ldb * 2;
    const unsigned ldsw = (unsigned)wid * 1024u;
    const int aoff = lds_byte(wr * 64 + fr, fq * 8), boff = lds_byte(wc * 32 + fr, fq * 8);
#define PG8_SA(b, h) (((b) * 2 + (h)) * HTB)
#define PG8_SB(b, h) ((4 + (b) * 2 + (h)) * HTB)
#define PG8_STAGE(bufoff, gbase, voff) do { _Pragma("unroll") for (int _i = 0; _i < 2; ++_i) \
        __builtin_amdgcn_global_load_lds((const unsigned*)((const char*)(gbase) + (voff)[_i]), (PG8_LAS unsigned*)(lds + (bufoff) + ldsw + _i * 8192), 16, 0, 0); } while (0)
#define PG8_LDA(dst, b, h) do { _Pragma("unroll") for (int m = 0; m < 4; ++m) _Pragma("unroll") for (int k = 0; k < 2; ++k) dst[m][k] = *(const PG8_LAS bf16x8*)(lds + PG8_SA(b, h) + aoff + m * 2048 + k * 1024); } while (0)
#define PG8_LDB(dst, b, h) do { _Pragma("unroll") for (int n = 0; n < 2; ++n) _Pragma("unroll") for (int k = 0; k < 2; ++k) dst[n][k] = *(const PG8_LAS bf16x8*)(lds + PG8_SB(b, h) + boff + n * 2048 + k * 1024); } while (0)
#define PG8_MMA(ai, bj, At, Bt) do { __builtin_amdgcn_s_setprio(1); _Pragma("unroll") for (int m = 0; m < 4; ++m) _Pragma("unroll") for (int n = 0; n < 2; ++n) _Pragma("unroll") for (int k = 0; k < 2; ++k) \
        acc[ai][bj][m][n] = __builtin_amdgcn_mfma_f32_16x16x32_bf16(Bt[n][k], At[m][k], acc[ai][bj][m][n], 0, 0, 0); __builtin_amdgcn_s_setprio(0); } while (0)
#define PG8_WAIT_V(n) asm volatile("s_waitcnt vmcnt(" #n ")" ::: "memory")
#define PG8_WAIT_L(n) asm volatile("s_waitcnt lgkmcnt(" #n ")" ::: "memory")
#define PG8_BAR __builtin_amdgcn_s_barrier()
#define PG8_SCHED __builtin_amdgcn_sched_barrier(0)
    Unit cur, nxt; int ui = 0;
    if (!S.next(0, cur)) return;
    f32x4 acc[2][2][4][2];
#pragma unroll
    for (int a = 0; a < 2; ++a)
#pragma unroll
        for (int b = 0; b < 2; ++b)
#pragma unroll
            for (int m = 0; m < 4; ++m)
#pragma unroll
                for (int n = 0; n < 2; ++n) acc[a][b][m][n] = (f32x4){0.f, 0.f, 0.f, 0.f};
    bf16x8 At[4][2], B0[2][2], B1[2][2];
    const char* cA = cur.A; const char* cB = cur.B;
    PG8_STAGE(PG8_SB(0, 0), cB, voffB); PG8_STAGE(PG8_SB(0, 1), cB + hstepB, voffB); PG8_STAGE(PG8_SA(0, 0), cA, voffA); PG8_STAGE(PG8_SA(0, 1), cA + hstepA, voffA);
    if (wr == 1) PG8_BAR;
    PG8_WAIT_V(2); PG8_BAR;
    PG8_STAGE(PG8_SB(1, 0), cB + kstep, voffB); PG8_STAGE(PG8_SA(1, 0), cA + kstep, voffA); PG8_STAGE(PG8_SB(1, 1), cB + hstepB + kstep, voffB);
    PG8_WAIT_V(6); PG8_BAR;
    for (;;) {
        const bool has_next = S.next(ui + 1, nxt);
        const char* nA = has_next ? nxt.A : cA; const char* nB = has_next ? nxt.B : cB;
#pragma unroll 1
        for (int t = 0; t < nt; t += 2) {
            const bool last = (t == nt - 2);
            const char* a1 = cA + (size_t)(t + 1) * kstep;
            const char* a2 = last ? nA : cA + (size_t)(t + 2) * kstep; const char* b2 = last ? nB : cB + (size_t)(t + 2) * kstep;
            const char* a3 = a2 + kstep; const char* b3 = b2 + kstep;
            PG8_LDB(B0, 0, 0); PG8_LDB(B1, 0, 1); PG8_SCHED; PG8_LDA(At, 0, 0); PG8_STAGE(PG8_SA(1, 1), a1 + hstepA, voffA);
            PG8_WAIT_V(8); PG8_WAIT_L(0); PG8_BAR; PG8_MMA(0, 0, At, B0); PG8_MMA(0, 1, At, B1); PG8_BAR; PG8_SCHED;
            PG8_LDA(At, 0, 1); PG8_STAGE(PG8_SB(0, 0), b2, voffB); PG8_STAGE(PG8_SB(0, 1), b2 + hstepB, voffB); PG8_STAGE(PG8_SA(0, 0), a2, voffA);
            PG8_WAIT_V(8); PG8_WAIT_L(0); PG8_BAR; PG8_MMA(1, 0, At, B0); PG8_MMA(1, 1, At, B1); PG8_BAR; PG8_SCHED;
            PG8_LDB(B0, 1, 0); PG8_LDB(B1, 1, 1); PG8_SCHED; PG8_LDA(At, 1, 0); PG8_STAGE(PG8_SA(0, 1), a2 + hstepA, voffA);
            PG8_WAIT_V(8); PG8_WAIT_L(0); PG8_BAR; PG8_MMA(0, 0, At, B0); PG8_MMA(0, 1, At, B1); PG8_BAR; PG8_SCHED;
            PG8_LDA(At, 1, 1); PG8_STAGE(PG8_SB(1, 0), b3, voffB); PG8_STAGE(PG8_SB(1, 1), b3 + hstepB, voffB); PG8_STAGE(PG8_SA(1, 0), a3, voffA);
            PG8_WAIT_V(8); PG8_WAIT_L(0); PG8_BAR; PG8_MMA(1, 0, At, B0); PG8_MMA(1, 1, At, B1); PG8_BAR; PG8_SCHED;
        }
        if (wr == 0) PG8_BAR;
        if (cur.last) E(acc, cur, wr, wc, fr, fq); else E.mid(acc, cur, wr, wc, fr, fq);
        if (!has_next) break;
        if (cur.last) {
#pragma unroll
            for (int a = 0; a < 2; ++a)
#pragma unroll
                for (int b = 0; b < 2; ++b)
#pragma unroll
                    for (int m = 0; m < 4; ++m)
#pragma unroll
                        for (int n = 0; n < 2; ++n) acc[a][b][m][n] = (f32x4){0.f, 0.f, 0.f, 0.f};
        }
        cur = nxt; cA = nA; cB = nB; ++ui;
        if (wr == 1) PG8_BAR;
    }
    PG8_WAIT_V(0);
    PG8_BAR;
#undef PG8_SA
#undef PG8_SB
#undef PG8_STAGE
#undef PG8_LDA
#undef PG8_LDB
#undef PG8_MMA
#undef PG8_WAIT_V
#undef PG8_WAIT_L
#undef PG8_BAR
#undef PG8_SCHED
}

typedef const f32x4 (&AccC)[2][2][4][2];
typedef f32x4 (&AccM)[2][2][4][2];
#define EPI_ROWS_BEGIN _Pragma("unroll") for (int ai = 0; ai < 2; ++ai) _Pragma("unroll") for (int m = 0; m < 4; ++m) { const int row = u.pm * 256 + ai * 128 + wr * 64 + m * 16 + fr;
#define EPI_ROWS_END }

#define EPI_NO_MID __device__ __forceinline__ void mid(AccM, const Unit&, int, int, int, int) const {}

struct EpiB16 {
    EPI_NO_MID
    static constexpr bool PERM = true;
    bf16* O; int ldc;
    __device__ __forceinline__ void operator()(AccC acc, const Unit& u, int wr, int wc, int fr, int fq) const {
        const int col0 = u.pn * 256 + wc * 32 + 8 * fq;
        EPI_ROWS_BEGIN
#pragma unroll
            for (int bj = 0; bj < 2; ++bj) { const f32x4 v0 = acc[ai][bj][m][0], v1 = acc[ai][bj][m][1]; const float f[8] = {v0[0], v0[1], v0[2], v0[3], v1[0], v1[1], v1[2], v1[3]};
                *(GAS v4u*)(O + (size_t)row * ldc + col0 + bj * 128) = pack8(f); }
        EPI_ROWS_END
    }
};
struct EpiHloc {
    EPI_NO_MID
    static constexpr bool PERM = false;
    float* O;
    __device__ __forceinline__ void operator()(AccC acc, const Unit& u, int wr, int wc, int fr, int fq) const {
        const int col0 = wc * 32 + 4 * fq; float* base = O + (size_t)u.aux * 512 * 256;
        EPI_ROWS_BEGIN
            float* rowp = base + (size_t)row * 256 + col0;
#pragma unroll
            for (int bj = 0; bj < 2; ++bj)
#pragma unroll
                for (int n = 0; n < 2; ++n) *(GAS f32x4*)(rowp + bj * 128 + n * 16) = acc[ai][bj][m][n];
        EPI_ROWS_END
    }
};
struct EpiWin {
    EPI_NO_MID
    static constexpr bool PERM = true;
    bf16 *XR, *XG, *UG, *Q, *Kb, *Vb, *G; float *outK, *outV;
    __device__ __forceinline__ void operator()(AccC acc, const Unit& u, int wr, int wc, int fr, int fq) const {
        const int pn = u.pn, seg = pn >> 2;
        const int cseg = (pn & 3) * 256 + wc * 32 + 8 * fq;
        EPI_ROWS_BEGIN
#pragma unroll
            for (int bj = 0; bj < 2; ++bj) {
                const f32x4 v0 = acc[ai][bj][m][0], v1 = acc[ai][bj][m][1];
                float f[8] = {v0[0], v0[1], v0[2], v0[3], v1[0], v1[1], v1[2], v1[3]};
                const int c = cseg + bj * 128;
                if (seg >= 6) {
#pragma unroll
                    for (int e = 0; e < 8; ++e) f[e] = fsigmoid(f[e]);
                    *(GAS v4u*)(G + (size_t)row * 6144 + (pn - 24) * 256 + wc * 32 + 8 * fq + bj * 128) = pack8(f);
                } else if (seg == 1) {
#pragma unroll
                    for (int e = 0; e < 8; ++e) f[e] = gelu_tanh(f[e]);
                    *(GAS v4u*)(XG + (size_t)row * 1024 + c) = pack8(f);
                } else if (seg == 2) {
                    const int g = c >> 4, m0 = c & 15;
                    *(GAS v4u*)(UG + ((size_t)g * 512 + (row >> 4)) * 256 + (row & 15) * 16 + m0) = pack8(f);
                } else {
                    bf16* dst = seg == 0 ? XR : (seg == 3 ? Q : (seg == 4 ? Kb : Vb));
                    *(GAS v4u*)(dst + (size_t)row * 1024 + c) = pack8(f);
                    if (seg >= 4 && row < CTXR) {
                        float* o = (seg == 4 ? outK : outV) + ((size_t)(row >> 8) * 4 * 256 + (row & 255)) * 1024 + c;
                        *(f32x4*)o = v0; *(GAS f32x4*)(o + 4) = v1;
                    }
                }
            }
        EPI_ROWS_END
    }
};
struct EpiRg {
    EPI_NO_MID
    static constexpr bool PERM = true;
    const bf16* XC; const float* gb; const float* sp; f32x2* AB;
    __device__ __forceinline__ void operator()(AccC acc, const Unit& u, int wr, int wc, int fr, int fq) const {
        const int h = u.aux >> 1, d = u.aux & 1, c0 = h * 128 + wc * 32 + 8 * fq;
        const GAS float* gbr = (const GAS float*)(gb + (d * 2 + 0) * 1024 + c0); const GAS float* gbi = (const GAS float*)(gb + (d * 2 + 1) * 1024 + c0); const GAS float* spp = (const GAS float*)(sp + d * 1024 + c0);
        EPI_ROWS_BEGIN
            float xc[8]; unpack8(*(const GAS v4u*)(XC + (size_t)row * 1024 + c0), xc);
            const f32x4 r0 = acc[ai][0][m][0], r1 = acc[ai][0][m][1], i0 = acc[ai][1][m][0], i1 = acc[ai][1][m][1];
            const float rr[8] = {r0[0], r0[1], r0[2], r0[3], r1[0], r1[1], r1[2], r1[3]}, ii[8] = {i0[0], i0[1], i0[2], i0[3], i1[0], i1[1], i1[2], i1[3]};
            f32x2* dst = AB + ((size_t)d * ROWS + row) * 1024 + c0;
#pragma unroll
            for (int e = 0; e < 8; e += 2) {
                f32x4 o;
#pragma unroll
                for (int q = 0; q < 2; ++q) {
                    const float r = fsigmoid(rr[e + q] + gbr[e + q]), ig = fsigmoid(ii[e + q] + gbi[e + q]);
                    const float la = -8.0f * r * spp[e + q]; const float a = __expf(la); const float mult = sqrtf(-expm1f(2.0f * la));
                    o[2 * q] = a; o[2 * q + 1] = mult * ig * xc[e + q];
                }
                *(GAS f32x4*)(dst + e) = o;
            }
            asm volatile("" ::: "memory");
        EPI_ROWS_END
    }
};
struct EpiS5Y {
    EPI_NO_MID
    static constexpr bool PERM = true;
    const bf16* UG; const float* dvec; bf16* ZS;
    __device__ __forceinline__ void operator()(AccC acc, const Unit& u, int wr, int wc, int fr, int fq) const {
        const int g = u.aux;
        EPI_ROWS_BEGIN
#pragma unroll
            for (int bj = 0; bj < 2; ++bj) {
                const int col = bj * 128 + wc * 32 + 8 * fq, t = col >> 4, n0 = col & 15;
                float uu[8]; unpack8(*(const GAS v4u*)(UG + ((size_t)g * 512 + row) * 256 + col), uu);
                const f32x4 v0 = acc[ai][bj][m][0], v1 = acc[ai][bj][m][1];
                float f[8] = {v0[0], v0[1], v0[2], v0[3], v1[0], v1[1], v1[2], v1[3]};
#pragma unroll
                for (int e = 0; e < 8; ++e) f[e] = gelu_tanh(f[e] + ((const GAS float*)dvec)[g * 16 + n0 + e] * uu[e]);
                *(GAS v4u*)(ZS + ((size_t)row * 16 + t) * 1024 + g * 16 + n0) = pack8(f);
            }
        EPI_ROWS_END
    }
};
struct EpiGlu {
    EPI_NO_MID
    static constexpr bool PERM = true;
    const bf16* ZS; bf16* Y;
    __device__ __forceinline__ void operator()(AccC acc, const Unit& u, int wr, int wc, int fr, int fq) const {
        const int col0 = u.pn * 256 + wc * 32 + 8 * fq;
        EPI_ROWS_BEGIN
#pragma unroll
            for (int bj = 0; bj < 2; ++bj) {
                float z[8]; unpack8(*(const GAS v4u*)(ZS + (size_t)row * 1024 + col0 + bj * 128), z);
                const f32x4 v0 = acc[ai][bj][m][0], v1 = acc[ai][bj][m][1];
                float f[8] = {v0[0], v0[1], v0[2], v0[3], v1[0], v1[1], v1[2], v1[3]};
#pragma unroll
                for (int e = 0; e < 8; ++e) f[e] = z[e] * fsigmoid(f[e]);
                *(GAS v4u*)(Y + (size_t)row * 1024 + col0 + bj * 128) = pack8(f);
            }
        EPI_ROWS_END
    }
};
struct EpiMerge {
    static constexpr bool PERM = true;
    const bf16* G; bf16* MM;
    __device__ __forceinline__ void mid(AccM acc, const Unit& u, int wr, int wc, int fr, int fq) const {
        const int col0 = u.pn * 256 + wc * 32 + 8 * fq, b = u.aux;
        EPI_ROWS_BEGIN
#pragma unroll
            for (int bj = 0; bj < 2; ++bj) {
                float ga[8], gn[8]; unpack8(*(const GAS v4u*)(G + (size_t)row * 6144 + b * 2048 + col0 + bj * 128), ga); unpack8(*(const GAS v4u*)(G + (size_t)row * 6144 + (b + 1) * 2048 + col0 + bj * 128), gn);
#pragma unroll
                for (int e = 0; e < 8; ++e) { const float rt = ga[e] * __builtin_amdgcn_rcpf(fmaxf(gn[e], 1e-30f)); acc[ai][bj][m][e >> 2][e & 3] *= rt; }
            }
        EPI_ROWS_END
    }
    __device__ __forceinline__ void operator()(AccC acc, const Unit& u, int wr, int wc, int fr, int fq) const {
        const int col0 = u.pn * 256 + wc * 32 + 8 * fq;
        EPI_ROWS_BEGIN
#pragma unroll
            for (int bj = 0; bj < 2; ++bj) {
                float g2[8]; unpack8(*(const GAS v4u*)(G + (size_t)row * 6144 + 2 * 2048 + col0 + bj * 128), g2);
                const f32x4 v0 = acc[ai][bj][m][0], v1 = acc[ai][bj][m][1];
                float f[8] = {v0[0], v0[1], v0[2], v0[3], v1[0], v1[1], v1[2], v1[3]};
#pragma unroll
                for (int e = 0; e < 8; ++e) f[e] *= g2[e];
                *(GAS v4u*)(MM + (size_t)row * 2048 + col0 + bj * 128) = pack8(f);
            }
        EPI_ROWS_END
    }
};
struct EpiSwiglu {
    EPI_NO_MID
    static constexpr bool PERM = true;
    bf16* FH;
    __device__ __forceinline__ void operator()(AccC acc, const Unit& u, int wr, int wc, int fr, int fq) const {
        const int col0 = u.pn * 128 + wc * 32 + 8 * fq;
        EPI_ROWS_BEGIN
            const f32x4 a0 = acc[ai][0][m][0], a1 = acc[ai][0][m][1], b0 = acc[ai][1][m][0], b1 = acc[ai][1][m][1];
            const float av[8] = {a0[0], a0[1], a0[2], a0[3], a1[0], a1[1], a1[2], a1[3]}, bv[8] = {b0[0], b0[1], b0[2], b0[3], b1[0], b1[1], b1[2], b1[3]};
            float f[8];
#pragma unroll
            for (int e = 0; e < 8; ++e) f[e] = av[e] * fsigmoid(av[e]) * bv[e];
            *(GAS v4u*)(FH + (size_t)row * FFH + col0) = pack8(f);
        EPI_ROWS_END
    }
};

struct SchedPlain {
    const char* A; const char* B; int nM, nN, G, c; size_t tA, tB; int dup;
    __device__ __forceinline__ bool next(int i, Unit& u) const { int pm, pn; const int q = i / (dup * DUP_GEMM), r = i - q * (dup * DUP_GEMM); long L = (long)q * G + c; const int nwg = nM * nN; if (L >= nwg) return false;
        if (r) L = (L + nwg / 2 + 8) % nwg;
        if (!tile_order(L, nM, nN, pm, pn)) return false; u.A = A + (size_t)pm * tA; u.B = B + (size_t)pn * tB; u.pm = pm; u.pn = pn; u.aux = 0; u.last = 1; return true; }
};
struct SchedMerge {
    const char* A0; const char* A1; const char* A2; const char* B; int G, c;
    __device__ __forceinline__ bool next(int i, Unit& u) const { const int ti = i / 3, b = i - ti * 3; int pm, pn; const int q = ti / (DUPG6 * DUP_GEMM), r = ti - q * (DUPG6 * DUP_GEMM); long L = (long)q * G + c; if (L >= 256) return false; if (r) L = (L + 136) % 256;
        if (!tile_order(L, 32, 8, pm, pn)) return false;
        const char* Ab = b == 0 ? A0 : (b == 1 ? A1 : A2); u.A = Ab + (size_t)pm * 256 * 1024 * 2; u.B = B + ((size_t)b * 2048 + pn * 256) * 1024 * 2; u.pm = pm; u.pn = pn; u.aux = b; u.last = (b == 2); return true; }
};
struct SchedS5E {
    const char* UG; const char* ET; int G, c;
    __device__ __forceinline__ bool next(int i, Unit& u) const { const int L = (i / DUP_S5) * G + c; if (L >= 128) return false; const int g = L >> 1, pm = L & 1;
        u.A = UG + ((size_t)g * 512 + pm * 256) * 256 * 2; u.B = ET + (size_t)g * 256 * 256 * 2; u.pm = pm; u.pn = 0; u.aux = g; u.last = 1; return true; }
};
struct SchedS5Y {
    const char* UG; const char* HIN; const char* MT; const char* FT; int G, c;
    __device__ __forceinline__ bool next(int i, Unit& u) const { const int ti = (i >> 1) / DUP_S5, part = i & 1, L = ti * G + c; if (L >= 128) return false; const int g = L >> 1, pm = L & 1;
        u.A = (part ? HIN : UG) + ((size_t)g * 512 + pm * 256) * 256 * 2; u.B = (part ? FT : MT) + (size_t)g * 256 * 256 * 2; u.pm = pm; u.pn = 0; u.aux = g; u.last = part; return true; }
};
struct SchedRg {
    const char* XC; const char* GWT; int G, c;
    __device__ __forceinline__ bool next(int i, Unit& u) const { const int L = (i / DUP_RGG) * G + c; if (L >= 512) return false; const int pm = L & 31, hd = L >> 5;
        u.A = XC + ((size_t)pm * 256 * 1024 + (hd >> 1) * 128) * 2; u.B = GWT + (size_t)hd * 256 * 128 * 2; u.pm = pm; u.pn = 0; u.aux = hd; u.last = 1; return true; }
};
}

namespace att {
using bf16x8 = __attribute__((ext_vector_type(8))) short;
using s16x4  = __attribute__((ext_vector_type(4))) short;
using f32x16 = __attribute__((ext_vector_type(16))) float;
using u32x4  = __attribute__((ext_vector_type(4))) unsigned;
constexpr int D = 128, NW = 8, QBLK = 32, KVBLK = 64, LD = 1024;
constexpr float SCALE = 0.088388347648318440f, THR = 8.f;
constexpr size_t SHM_V = KVBLK * D * 2, SHM_K = KVBLK * D * 2, SHM_ATTN = 2 * SHM_V + 2 * SHM_K + NW * 64 * 4;
constexpr int RPB_OFF = (int)SHM_ATTN + 256;
#define KSWZ(row, colB) ((row) * 256 + ((colB) ^ (((row) & 7) << 4)))
#define SBAR() __builtin_amdgcn_sched_barrier(0)
__device__ __forceinline__ int crow(int r, int hi) { return (r & 3) + 8 * (r >> 2) + 4 * hi; }
__device__ __forceinline__ unsigned cvtpk(float lo, float hi) { return pk2(lo, hi); }
__device__ __forceinline__ void partialSM(f32x16& p0, f32x16& p1, float& m_reg, float& mn, float& alpha) {
  constexpr float C = SCALE * 1.4426950408889634f;
  float pmax = p0[0]; for (int r = 1; r < 16; ++r) pmax = fmaxf(pmax, p0[r]); for (int r = 0; r < 16; ++r) pmax = fmaxf(pmax, p1[r]);
  { auto rr = __builtin_amdgcn_permlane32_swap(__float_as_uint(pmax), __float_as_uint(pmax), false, false);
    pmax = fmaxf(__uint_as_float(rr[0]), __uint_as_float(rr[1])); }
  if (__builtin_expect(__all(pmax - m_reg <= THR / SCALE), 1)) { mn = m_reg; alpha = 1.f; }
  else { mn = fmaxf(m_reg, pmax); alpha = __builtin_amdgcn_exp2f((m_reg - mn) * C); m_reg = mn; }
  float mnC = -mn * C;
  for (int r = 0; r < 16; ++r) p0[r] = fmaf(p0[r], C, mnC); for (int r = 0; r < 16; ++r) p1[r] = fmaf(p1[r], C, mnC);
  for (int r = 0; r < 16; ++r) p0[r] = __builtin_amdgcn_exp2f(p0[r]);
}
__device__ __forceinline__ void finishSM(f32x16& p0, f32x16& p1, float alpha, float& l_reg, bf16x8& pa0, bf16x8& pa1, bf16x8& pa2, bf16x8& pa3) {
  for (int r = 0; r < 16; ++r) p1[r] = __builtin_amdgcn_exp2f(p1[r]);
  float ps = 0; for (int r = 0; r < 16; ++r) ps += p0[r]; for (int r = 0; r < 16; ++r) ps += p1[r];
  { auto rr = __builtin_amdgcn_permlane32_swap(__float_as_uint(ps), __float_as_uint(ps), false, false);
    ps = __uint_as_float(rr[0]) + __uint_as_float(rr[1]); }
  l_reg = l_reg * alpha + ps;
#define PK4(P, BASE, OUT) do { unsigned a0 = cvtpk(P[BASE + 0], P[BASE + 1]), a1 = cvtpk(P[BASE + 2], P[BASE + 3]);   \
    unsigned b0 = cvtpk(P[BASE + 4], P[BASE + 5]), b1 = cvtpk(P[BASE + 6], P[BASE + 7]);                              \
    auto r0 = __builtin_amdgcn_permlane32_swap(a0, b0, false, false); auto r1 = __builtin_amdgcn_permlane32_swap(a1, b1, false, false); \
    u32x4 w = {r0[0], r1[0], r0[1], r1[1]}; OUT = *reinterpret_cast<bf16x8*>(&w); } while (0)
  PK4(p0, 0, pa0); PK4(p0, 8, pa1); PK4(p1, 0, pa2); PK4(p1, 8, pa3);
#undef PK4
}
__device__ __forceinline__ void qkt(f32x16& p0, f32x16& p1, const bf16* Ks, const bf16x8* qr, int r32, int hi) {
  p0 = f32x16{}; p1 = f32x16{};
  for (int d0 = 0; d0 < 8; ++d0) { int cb = (d0 * 16 + hi * 8) * 2;
    bf16x8 b0 = *reinterpret_cast<const bf16x8*>((const char*)Ks + KSWZ(r32, cb));
    bf16x8 b1 = *reinterpret_cast<const bf16x8*>((const char*)Ks + KSWZ(32 + r32, cb));
    p0 = __builtin_amdgcn_mfma_f32_32x32x16_bf16(b0, qr[d0], p0, 0, 0, 0);
    p1 = __builtin_amdgcn_mfma_f32_32x32x16_bf16(b1, qr[d0], p1, 0, 0, 0); }
}
__device__ __forceinline__ int v_st(int k, int c) { const int kk = (k & ~0xC) | ((k & 4) << 1) | ((k & 8) >> 1); return ((kk >> 3) * 4 + (c >> 5)) * 512 + ((kk & 7) * 32 + (c & 31)) * 2; }
__device__ __forceinline__ int v_rd_base(int lane) { return ((lane & 3) << 3) | (((lane >> 2) & 3) << 6) | (((lane >> 4) & 1) << 5) | (((lane >> 5) & 1) << 8); }
constexpr int v_rd_off(int d0, int ks, int half) { return d0 * 512 + ks * 4096 + half * 2048; }
template <int OFF> __device__ __forceinline__ s16x4 tr_read(int vb) {
  s16x4 r; asm volatile("ds_read_b64_tr_b16 %0, %1 offset:%2" : "=&v"(r) : "v"(vb), "i"(OFF) : "memory"); return r;
}
template <int D0> __device__ __forceinline__ void pv_one(f32x16& od, int vb, bf16x8 pa0, bf16x8 pa1, bf16x8 pa2, bf16x8 pa3) {
  const s16x4 l0 = tr_read<v_rd_off(D0, 0, 0)>(vb), h0 = tr_read<v_rd_off(D0, 0, 1)>(vb), l1 = tr_read<v_rd_off(D0, 1, 0)>(vb), h1 = tr_read<v_rd_off(D0, 1, 1)>(vb);
  const s16x4 l2 = tr_read<v_rd_off(D0, 2, 0)>(vb), h2 = tr_read<v_rd_off(D0, 2, 1)>(vb), l3 = tr_read<v_rd_off(D0, 3, 0)>(vb), h3 = tr_read<v_rd_off(D0, 3, 1)>(vb);
  asm volatile("s_waitcnt lgkmcnt(0)" ::: "memory"); SBAR();
#define PK(L, H) (bf16x8){L[0], L[1], L[2], L[3], H[0], H[1], H[2], H[3]}
  od = __builtin_amdgcn_mfma_f32_32x32x16_bf16(pa0, PK(l0, h0), od, 0, 0, 0);
  od = __builtin_amdgcn_mfma_f32_32x32x16_bf16(pa1, PK(l1, h1), od, 0, 0, 0);
  od = __builtin_amdgcn_mfma_f32_32x32x16_bf16(pa2, PK(l2, h2), od, 0, 0, 0);
  od = __builtin_amdgcn_mfma_f32_32x32x16_bf16(pa3, PK(l3, h3), od, 0, 0, 0);
#undef PK
}
__device__ __forceinline__ void pv_d0(f32x16* o, int vb, bf16x8 pa0, bf16x8 pa1, bf16x8 pa2, bf16x8 pa3) {
  pv_one<0>(o[0], vb, pa0, pa1, pa2, pa3); pv_one<1>(o[1], vb, pa0, pa1, pa2, pa3); pv_one<2>(o[2], vb, pa0, pa1, pa2, pa3); pv_one<3>(o[3], vb, pa0, pa1, pa2, pa3);
}
__device__ __forceinline__ void na_mask(f32x16& p0, f32x16& p1, int kr, int qr, int rs, int ws, const float* rpbl, int hi) {
  if (kr < rs || kr >= rs + 8) {
#pragma unroll
    for (int r = 0; r < 16; ++r) { p0[r] = -1e30f; p1[r] = -1e30f; }
  } else {
    const float* row = rpbl + (kr - qr + 7) * 31 + 4 * hi; const unsigned w0 = (unsigned)(4 * hi - ws);
#pragma unroll
    for (int r = 0; r < 16; ++r) {
      const int kc = (r & 3) + 8 * (r >> 2);
      const float b0 = row[kc], b1 = row[kc + 32];
      p0[r] = (w0 + (unsigned)kc < 16u) ? p0[r] + b0 : -1e30f; p1[r] = (w0 + (unsigned)(kc + 32) < 16u) ? p1[r] + b1 : -1e30f;
      if ((r & 3) == 3) SBAR();
    }
  }
}
template <bool NA, int SD>
__device__ __forceinline__ void attn_body(const bf16* __restrict__ Qb, const bf16* __restrict__ K0, const bf16* __restrict__ V0, const bf16* __restrict__ K1, const bf16* __restrict__ V1,
                                          bf16* __restrict__ Ob, const int NT, const int lo, const int rg, char* lds) {
  int tid_ = threadIdx.x; asm volatile("" : "+v"(tid_));
  const int tid = tid_, wid = tid >> 6, lane = tid & 63, r32 = lane & 31, hi = lane >> 5;
  bf16* V_lds = (bf16*)lds; bf16* K_lds = (bf16*)(lds + 2 * SHM_V);
  float* ws_ = (float*)(lds + 2 * SHM_V + 2 * SHM_K) + wid * 64; float* li_l = ws_; float* al_l = ws_ + 32;
  const int qrow = 4 * rg + (wid >> 1), qc = 32 * (wid & 1) + r32;
  const int rs = qrow - 4 < 0 ? 0 : (qrow - 4 > 8 ? 8 : qrow - 4), wsn = qc - 8 < 0 ? 0 : (qc - 8 > 48 ? 48 : qc - 8);
  const float* rpbl = (const float*)(lds + RPB_OFF) + 15 - qc;
  float m_reg = -1e30f, l_reg = 0; f32x16 o[4] = {}; bf16x8 qr[8];
  const bf16* Qw = Qb + (long)(wid * QBLK + r32) * LD + hi * 8;
#pragma unroll
  for (int d0 = 0; d0 < 8; ++d0) qr[d0] = *(const GAS bf16x8*)(Qw + d0 * 16);
  const int sr = tid >> 4, sc = (tid & 15) * 8, vst0 = v_st(sr, sc), vst1 = v_st(32 + sr, sc);
  const int vb0 = (int)(uintptr_t)V_lds + v_rd_base(lane);
  struct { bf16x8 vs0, vs1, ks0, ks1; } sr_[SD];
#define TILEK(t) ((NA && (t) >= 8) ? K1 + (long)((t) - 8) * 64 * LD : K0 + (long)(t) * 64 * LD)
#define TILEV(t) ((NA && (t) >= 8) ? V1 + (long)((t) - 8) * 64 * LD : V0 + (long)(t) * 64 * LD)
#define SLOAD(i, t) do { const bf16* kp_ = TILEK(t); const bf16* vp_ = TILEV(t); \
    sr_[i].vs0 = *(const GAS bf16x8*)(&vp_[(long)sr * LD + sc]); sr_[i].vs1 = *(const GAS bf16x8*)(&vp_[(long)(32 + sr) * LD + sc]); \
    sr_[i].ks0 = *(const GAS bf16x8*)(&kp_[(long)sr * LD + sc]); sr_[i].ks1 = *(const GAS bf16x8*)(&kp_[(long)(32 + sr) * LD + sc]); } while (0)
#define SWRITE(b, i) do { *(bf16x8*)((char*)V_lds + (b) * SHM_V + vst0) = sr_[i].vs0;          \
    *(bf16x8*)((char*)V_lds + (b) * SHM_V + vst1) = sr_[i].vs1; int kc = sc * 2;               \
    *(bf16x8*)((char*)K_lds + (b) * SHM_K + KSWZ(sr, kc)) = sr_[i].ks0;                       \
    *(bf16x8*)((char*)K_lds + (b) * SHM_K + KSWZ(32 + sr, kc)) = sr_[i].ks1; } while (0)
#define SWAIT() do { if constexpr (SD == 2) asm volatile("s_waitcnt vmcnt(4)" ::: "memory"); else asm volatile("s_waitcnt vmcnt(0)" ::: "memory"); } while (0)
#define RESC(a) do { if (__any((a) < 1.f)) { if (hi == 0) al_l[r32] = (a); asm volatile("s_waitcnt lgkmcnt(0)" ::: "memory"); \
    for (int d = 0; d < 4; ++d) for (int r = 0; r < 16; ++r) o[d][r] *= al_l[crow(r, hi)]; } } while (0)
#define MASK(P0, P1, t) do { if (NA && (t) >= 8) na_mask(P0, P1, lo + (t) - 8, qrow, rs, wsn, rpbl, hi); } while (0)
  f32x16 pA0, pA1, pB0, pB1; float mnA, mnB, alA, alB; bf16x8 pa0, pa1, pa2, pa3;
  constexpr int SE = 0, SO = SD - 1;
  SLOAD(SE, 0); asm volatile("s_waitcnt vmcnt(0)" ::: "memory"); SWRITE(0, SE); __syncthreads();
  qkt(pA0, pA1, K_lds, qr, r32, hi); partialSM(pA0, pA1, m_reg, mnA, alA);
  SLOAD(SO, 1); if constexpr (SD == 2) { if (2 < NT) SLOAD(SE, 2); }
  SWAIT(); SWRITE(1, SO); __syncthreads();
  for (int j = 1; j + 1 < NT; j += 2) {
    SBAR(); qkt(pB0, pB1, (bf16*)((char*)K_lds + SHM_K), qr, r32, hi); MASK(pB0, pB1, j);
    finishSM(pA0, pA1, alA, l_reg, pa0, pa1, pa2, pa3); SBAR();
    SLOAD(SO, j + SD); SBAR();
    pv_d0(o, vb0, pa0, pa1, pa2, pa3); partialSM(pB0, pB1, m_reg, mnB, alB);
    __syncthreads(); SWAIT(); SWRITE(0, SE);
    RESC(alB); __syncthreads();
    SBAR(); qkt(pA0, pA1, K_lds, qr, r32, hi); MASK(pA0, pA1, j + 1);
    finishSM(pB0, pB1, alB, l_reg, pa0, pa1, pa2, pa3); SBAR();
    if (SD == 1 || j + 3 < NT) SLOAD(SE, j + 1 + SD); SBAR();
    pv_d0(o, vb0 + (int)SHM_V, pa0, pa1, pa2, pa3); partialSM(pA0, pA1, m_reg, mnA, alA);
    __syncthreads(); SWAIT(); SWRITE(1, SO);
    RESC(alA); __syncthreads();
  }
  SBAR(); qkt(pB0, pB1, (bf16*)((char*)K_lds + SHM_K), qr, r32, hi); MASK(pB0, pB1, NT - 1);
  finishSM(pA0, pA1, alA, l_reg, pa0, pa1, pa2, pa3); SBAR();
  pv_d0(o, vb0, pa0, pa1, pa2, pa3); partialSM(pB0, pB1, m_reg, mnB, alB);
  __syncthreads(); RESC(alB);
  finishSM(pB0, pB1, alB, l_reg, pa0, pa1, pa2, pa3); SBAR();
  pv_d0(o, vb0 + (int)SHM_V, pa0, pa1, pa2, pa3);
  if (hi == 0) li_l[r32] = l_reg; asm volatile("s_waitcnt lgkmcnt(0)" ::: "memory");
  float rli[16];
#pragma unroll
  for (int r = 0; r < 16; ++r) rli[r] = __builtin_amdgcn_rcpf(li_l[crow(r, hi)]);
  bf16* Ow = Ob + (long)(wid * QBLK) * LD;
#pragma unroll
  for (int r = 0; r < 16; ++r) { int orow = crow(r, hi);
    for (int d0 = 0; d0 < 4; ++d0) *(GAS bf16*)(Ow + (long)orow * LD + d0 * 32 + r32) = (bf16)f2bf(o[d0][r] * rli[r]); }
  asm volatile("s_waitcnt vmcnt(0)" ::: "memory"); __syncthreads();
#undef TILEK
#undef TILEV
#undef SLOAD
#undef SWRITE
#undef SWAIT
#undef RESC
#undef MASK
}
}

constexpr int NWAVES = 8;
struct Args { const float* in[36]; float* out; unsigned char* ws; int ph_lo, ph_hi; };
struct Frame { LAS unsigned char* lds; char* ldsg; volatile LAS unsigned* MISC; int tid, lane, wave, vcu, G; };
constexpr int INTAB_OFF = MISC_OFF + 128;
__device__ __forceinline__ const float* ld_in(const LAS unsigned char* lds, int i) { const unsigned long long v = ((const LAS unsigned long long*)(lds + INTAB_OFF))[i];
    const unsigned lo = __builtin_amdgcn_readfirstlane((unsigned)v), hi = __builtin_amdgcn_readfirstlane((unsigned)(v >> 32)); return (const float*)(((unsigned long long)hi << 32) | lo); }
#define IN(i) ld_in(F.lds, (i))

__device__ __forceinline__ void transpose_item(const float* W, int N, int k0, int n0, bf16* WT, int ldo, int drow0, float* scr, int lane) {
    const int kr = lane >> 3, n4 = (lane & 7) * 4;
    f32x4 v[8];
#pragma unroll
    for (int i = 0; i < 8; ++i) v[i] = *(const GAS f32x4*)(W + (size_t)(k0 + kr + 8 * i) * N + n0 + n4);
#pragma unroll
    for (int i = 0; i < 8; ++i) { float* d = scr + (kr + 8 * i) * 33 + n4; d[0] = v[i].x; d[1] = v[i].y; d[2] = v[i].z; d[3] = v[i].w; }
    LDS_WAIT(); asm volatile("" ::: "memory");
    const int c = lane & 7;
#pragma unroll
    for (int j = 0; j < 4; ++j) { const int n = (lane >> 3) + 8 * j; const float* s = scr + (8 * c) * 33 + n;
        v4u o; o.x = pk2(s[0 * 33], s[1 * 33]); o.y = pk2(s[2 * 33], s[3 * 33]); o.z = pk2(s[4 * 33], s[5 * 33]); o.w = pk2(s[6 * 33], s[7 * 33]);
        *(GAS v4u*)(WT + (size_t)(drow0 + n) * ldo + k0 + 8 * c) = o; }
    LDS_WAIT(); asm volatile("" ::: "memory");
}

__device__ __forceinline__ int cv_of_row(int row) { return row < CTXR ? 0 : 1 + ((row - CTXR) >> 10); }

template <bool FIRST, bool HASNEXT>
__device__ __forceinline__ void resnorm_rows(const Frame& F, const float* xin0, const float* xin1, float* X, const bf16* Z, const float* gpost, const float* modGate  ,
                                             const float* gpre, const float* modShift, const float* modScale, bf16* H) {
    const int gw = F.vcu * NWAVES + F.wave, NGW = F.G * NWAVES;
    for (int row = gw; row < ROWS; row += NGW) {
        const int cv = cv_of_row(row);
        f32x4 x[8];
        if (FIRST) {
            const GAS f32x4* src = (const GAS f32x4*)(row < CTXR ? xin0 + (size_t)row * DM : xin1 + (size_t)(row - CTXR) * DM);
#pragma unroll
            for (int j = 0; j < 8; ++j) x[j] = src[2 * (F.lane + 64 * (j >> 1)) + (j & 1)];
        } else {
            const GAS v4u* zr = (const GAS v4u*)(Z + (size_t)row * DM); const GAS f32x4* xr = (const GAS f32x4*)(X + (size_t)row * DM);
            f32x4 z[8]; float ss = 0.f;
#pragma unroll
            for (int jj = 0; jj < 4; ++jj) { float f[8]; unpack8(zr[F.lane + 64 * jj], f); z[2 * jj] = (f32x4){f[0], f[1], f[2], f[3]}; z[2 * jj + 1] = (f32x4){f[4], f[5], f[6], f[7]}; }
#pragma unroll
            for (int j = 0; j < 8; ++j) ss += (z[j].x * z[j].x + z[j].y * z[j].y) + (z[j].z * z[j].z + z[j].w * z[j].w);
            const float rstd = rsqrtf(wave_sum(ss, F.lane) * (1.f / DM) + RMS_EPS);
#pragma unroll
            for (int j = 0; j < 8; ++j) { const int q = 2 * (F.lane + 64 * (j >> 1)) + (j & 1); const f32x4 gp = ((const GAS f32x4*)gpost)[q], gt = ((const GAS f32x4*)(modGate + (size_t)cv * 12288))[q];
                x[j] = xr[q] + gt * (z[j] * rstd * gp); }
        }
        { GAS f32x4* xo = (GAS f32x4*)(X + (size_t)row * DM);
#pragma unroll
          for (int j = 0; j < 8; ++j) xo[2 * (F.lane + 64 * (j >> 1)) + (j & 1)] = x[j]; }
        if (HASNEXT) {
            float ss = 0.f;
#pragma unroll
            for (int j = 0; j < 8; ++j) ss += (x[j].x * x[j].x + x[j].y * x[j].y) + (x[j].z * x[j].z + x[j].w * x[j].w);
            const float rstd = rsqrtf(wave_sum(ss, F.lane) * (1.f / DM) + RMS_EPS);
            GAS v4u* ho = (GAS v4u*)(H + (size_t)row * DM);
#pragma unroll
            for (int jj = 0; jj < 4; ++jj) { float f[8];
#pragma unroll
                for (int h = 0; h < 2; ++h) { const int q = 2 * (F.lane + 64 * jj) + h; const f32x4 g = ((const GAS f32x4*)gpre)[q], sh = ((const GAS f32x4*)(modShift + (size_t)cv * 12288))[q], sc = ((const GAS f32x4*)(modScale + (size_t)cv * 12288))[q];
                    const f32x4 hv = x[2 * jj + h] * rstd * g * (sc + 1.0f) + sh; f[4 * h] = hv.x; f[4 * h + 1] = hv.y; f[4 * h + 2] = hv.z; f[4 * h + 3] = hv.w; }
                ho[F.lane + 64 * jj] = pack8(f); }
        }
    }
}

__device__ __forceinline__ void s5_tables(const Frame& F, int l, int g, unsigned char* ws) {
    char* L = F.ldsg;
    f32x2* POW = (f32x2*)L;
    f32x2* BB = (f32x2*)(L + 17408);
    f32x2* CC = (f32x2*)(L + 17408 + 16384);
    float* KT = (float*)(L + 17408 + 32768);
    const int tid = F.tid;
    __syncthreads();
    if (tid < 128) {
        const int d = tid >> 6, p = tid & 63; const size_t li = ((size_t)(l * 2 + d) * 64 + g) * 64 + p;
        const float dt = expf(IN(22)[(l * 2 + d) * 64 + g]); const float lre = IN(20)[li], lim = IN(21)[li];
        const float er = expf(lre * dt); float sn, cs; sincosf(lim * dt, &sn, &cs);
        const float br = er * cs, bi = er * sn;
        const float nr = br - 1.0f, ni = bi, den = lre * lre + lim * lim;
        const float cr = (nr * lre + ni * lim) / den, ci = (ni * lre - nr * lim) / den;
        float pr = 1.f, pi = 0.f;
        for (int t = 0; t <= 16; ++t) { POW[(d * 64 + p) * 17 + t] = (f32x2){pr, pi}; const float nr2 = pr * br - pi * bi, ni2 = pr * bi + pi * br; pr = nr2; pi = ni2; }
        ((f32x2*)(ws + WS_LT))[li] = POW[(d * 64 + p) * 17 + 16];
        for (int m = 0; m < 16; ++m) { const float xr = IN(23)[li * 16 + m], xi = IN(24)[li * 16 + m]; BB[(d * 64 + p) * 16 + m] = (f32x2){cr * xr - ci * xi, cr * xi + ci * xr}; }
    }
    for (int i = tid; i < 2048; i += 512) { const int d = i >> 10, n = (i >> 6) & 15, p = i & 63; const size_t ci_ = (((size_t)(l * 2 + d) * 64 + g) * 16 + n) * 64 + p; CC[i] = (f32x2){IN(25)[ci_], IN(26)[ci_]}; }
    __syncthreads();
    for (int i = tid; i < 8192; i += 512) {
        const int d = i >> 12, tau = (i >> 8) & 15, n = (i >> 4) & 15, m = i & 15; float s = 0.f;
        for (int p = 0; p < 64; ++p) { const f32x2 c = CC[(d * 16 + n) * 64 + p], w = POW[(d * 64 + p) * 17 + tau], b = BB[(d * 64 + p) * 16 + m];
            const float tr = c.x * w.x - c.y * w.y, ti = c.x * w.y + c.y * w.x; s += tr * b.x - ti * b.y; }
        KT[i] = s;
    }
    __syncthreads();
    bf16* MT = (bf16*)(ws + WS_MT) + (size_t)(l * 64 + g) * 65536; bf16* ET = (bf16*)(ws + WS_ET) + (size_t)(l * 64 + g) * 65536; bf16* FT = (bf16*)(ws + WS_FT) + (size_t)(l * 64 + g) * 65536;
    for (int i = tid; i < 8192; i += 512) {
        const int rowi = i >> 5, k0 = (i & 31) * 8;
        { const int t = rowi >> 4, n = rowi & 15, s = k0 >> 4, m0 = k0 & 15; float f[8];
#pragma unroll
          for (int e = 0; e < 8; ++e) { float v = 0.f; if (s <= t) v += KT[((0 * 16 + (t - s)) * 16 + n) * 16 + m0 + e]; if (s >= t) v += KT[((1 * 16 + (s - t)) * 16 + n) * 16 + m0 + e]; f[e] = v; }
          *(GAS v4u*)(MT + (size_t)rowi * 256 + k0) = pack8(f); }
        { const int d = rowi >> 7, p = (rowi >> 1) & 63, c = rowi & 1, s = k0 >> 4, m0 = k0 & 15; float f[8];
          const f32x2 w = POW[(d * 64 + p) * 17 + (d == 0 ? 15 - s : s)];
#pragma unroll
          for (int e = 0; e < 8; ++e) { const f32x2 b = BB[(d * 64 + p) * 16 + m0 + e]; f[e] = c == 0 ? (w.x * b.x - w.y * b.y) : (w.x * b.y + w.y * b.x); }
          *(GAS v4u*)(ET + (size_t)rowi * 256 + k0) = pack8(f); }
        { const int t = rowi >> 4, n = rowi & 15; float f[8];
#pragma unroll
          for (int e = 0; e < 8; ++e) { const int k = k0 + e, d = k >> 7, p = (k >> 1) & 63, c = k & 1; const f32x2 cc = CC[(d * 16 + n) * 64 + p], w = POW[(d * 64 + p) * 17 + (d == 0 ? t + 1 : 16 - t)];
              f[e] = c == 0 ? (cc.x * w.x - cc.y * w.y) : -(cc.x * w.y + cc.y * w.x); }
          *(GAS v4u*)(FT + (size_t)rowi * 256 + k0) = pack8(f); }
    }
    __syncthreads();
}

constexpr int I_WIN = 32 * 384, I_GLU = 16 * 32, I_OUT = 16 * 64, I_WO = 32 * 64, I_FIN = 32 * 352, I_FOUT = 88 * 64, I_GW = 32 * 8;
constexpr int I_LAYER = I_WIN + I_GLU + 3 * I_OUT + I_WO + I_FIN + I_FOUT + I_GW;
__device__ __forceinline__ void weight_item(const Frame& F, unsigned char* ws, int l, int r, float* scr) {
    if (r < I_WIN) { const int kb = r / 384, nb = r % 384; transpose_item(IN(14) + (size_t)l * DM * INW, INW, kb * 64, nb * 32, (bf16*)(ws + WS_WINT) + (size_t)l * INW * DM, DM, nb * 32, scr, F.lane); return; } r -= I_WIN;
    if (r < I_GLU) { const int kb = r / 32, nb = r % 32; transpose_item(IN(28) + (size_t)l * 1024 * 1024, 1024, kb * 64, nb * 32, (bf16*)(ws + WS_GLUT) + (size_t)l * 1024 * 1024, 1024, nb * 32, scr, F.lane); return; } r -= I_GLU;
    if (r < 3 * I_OUT) { const int b = r / I_OUT, q = r % I_OUT, kb = q / 64, nb = q % 64; transpose_item(IN(30 + b) + (size_t)l * 1024 * DM, DM, kb * 64, nb * 32, (bf16*)(ws + WS_OUTT) + ((size_t)l * 3 + b) * DM * 1024, 1024, nb * 32, scr, F.lane); return; } r -= 3 * I_OUT;
    if (r < I_WO) { const int kb = r / 64, nb = r % 64; transpose_item(IN(33) + (size_t)l * DM * DM, DM, kb * 64, nb * 32, (bf16*)(ws + WS_WOT) + (size_t)l * DM * DM, DM, nb * 32, scr, F.lane); return; } r -= I_WO;
    if (r < I_FIN) { const int kb = r / 352, nb = r % 352; const int n0 = nb * 32, half = n0 >= FFH, j = n0 - half * FFH; const int drow = 256 * (j >> 7) + 128 * half + (j & 127);
        transpose_item(IN(34) + (size_t)l * DM * 2 * FFH, 2 * FFH, kb * 64, n0, (bf16*)(ws + WS_FINT) + (size_t)l * 2 * FFH * DM, DM, drow, scr, F.lane); return; } r -= I_FIN;
    if (r < I_FOUT) { const int kb = r / 64, nb = r % 64; transpose_item(IN(35) + (size_t)l * FFH * DM, DM, kb * 64, nb * 32, (bf16*)(ws + WS_FOUTT) + (size_t)l * DM * FFH, FFH, nb * 32, scr, F.lane); return; } r -= I_FOUT;
    { const int mi = r >> 3, q = r & 7, kb = q >> 2, nb = q & 3;
      const int d = mi >> 4, g = (mi >> 3) & 1, h = mi & 7;
      transpose_item(IN(17) + ((size_t)l * 32 + mi) * 128 * 128, 128, kb * 64, nb * 32, (bf16*)(ws + WS_GWT) + (((size_t)l * 8 + h) * 2 + d) * 256 * 128, 128, g * 128 + nb * 32, scr, F.lane); }
}
constexpr int QB = 16;
static_assert(I_LAYER % QB == 0, "queue batch");
constexpr int Q_P2 = 562 * QB, Q_P3 = 624 * QB, Q_P4 = 1374 * QB, Q_P5 = 1813 * QB, Q_P9 = I_LAYER;
constexpr int CW_Q = 8192;
__device__ __forceinline__ void pull_weight_items(const Frame& F, unsigned char* ws, int l, int upto) {
    if (l >= NL) return;
    unsigned* ctr = (unsigned*)(ws + WS_CTL) + CW_Q + 64 * l; float* scr = (float*)(F.ldsg + F.wave * 16384);
    const int upto_b = upto / QB;
    for (;;) {
        unsigned i = 0;
        if (F.lane == 0) asm volatile("global_atomic_add %0, %1, %2, off sc0\n\ts_waitcnt vmcnt(0)" : "=&v"(i) : "v"(ctr), "v"(1u) : "memory");
        i = (unsigned)__builtin_amdgcn_readfirstlane((int)i);
        if ((int)i >= upto_b) { if (F.lane == 0) asm volatile("global_atomic_sub %0, %1, off" :: "v"(ctr), "v"(1u) : "memory"); break; }
        for (int j = 0; j < QB; ++j) weight_item(F, ws, l, (int)i * QB + j, scr);
    }
}

constexpr int SQ_P5 = 6, SQ_P9 = 10, SQ_END = (SQ_P5 + SQ_P9) * 1024;
__device__ __forceinline__ void static_weight_items(const Frame& F, unsigned char* ws, int l, int c, int G, int k0, int nk) {
    if (l >= NL || G != 256 || c < 128) return;
    float* scr = (float*)(F.ldsg + F.wave * 16384); const int w = (c - 128) * 8 + F.wave;
    for (int k = 0; k < nk; ++k) weight_item(F, ws, l, (k0 + k) * 1024 + w, scr);
}

__global__ void __launch_bounds__(NWAVES * 64, 2) fwd_kernel(Args args) {
    extern __shared__ __attribute__((aligned(16))) unsigned char lds[];
    const int G0 = gridDim.x, c0 = (int)blockIdx.x;
    volatile LAS unsigned* MISC0 = (volatile LAS unsigned*)((LAS unsigned char*)lds + MISC_OFF);
    unsigned char* const ws0 = args.ws; float* const out0 = args.out;
    gu32* ctl = (gu32*)(ws0 + WS_CTL);
    for (int u = threadIdx.x; u < (LDS_BYTES - LDSCTL_OFF) / 4; u += NWAVES * 64) ((LAS unsigned*)((LAS unsigned char*)lds + LDSCTL_OFF))[u] = 0u;
    __syncthreads();
    if (threadIdx.x == 0) {
#pragma unroll
        for (int i = 0; i < 36; ++i) ((LAS unsigned long long*)((LAS unsigned char*)lds + INTAB_OFF))[i] = (unsigned long long)args.in[i]; }
    __syncthreads();
    XcdBarrier bar; bar.bar = (unsigned*)(ctl + CW_BAR); bar.x = 0; bar.st = nullptr;
    if (MK_N_LAUNCHES == 1) bar = xcd_barrier_post((unsigned*)(ctl + CW_BAR), MISC0 + 8);
    const int lo = args.ph_lo, hi = args.ph_hi;
    int ph = 0;
#ifndef PHMASK
#define PHMASK 0xFFFFFFFFu
#endif
#define PHASE_BEGIN(k) if (((PHMASK >> (k)) & 1u) && lo <= ph && ph < hi) { if ((k) == TSEL && threadIdx.x == 0) *(volatile LAS unsigned long long*)(MISC0 + 16) = __builtin_amdgcn_s_memrealtime(); unsigned char* ws = ws0; float* outp = out0; int tid_p = threadIdx.x, G = G0, c = c0; asm volatile("" : "+s"(ws), "+s"(outp), "+v"(tid_p), "+s"(G), "+s"(c)); const int vcu = (G % 8 == 0) ? (c % 8) * (G / 8) + c / 8 : c;     \
    Frame F; F.lds = (LAS unsigned char*)lds; F.ldsg = (char*)lds; F.MISC = (volatile LAS unsigned*)(F.lds + MISC_OFF); F.tid = tid_p; F.lane = tid_p & 63; F.wave = __builtin_amdgcn_readfirstlane(tid_p >> 6); F.G = G; F.vcu = vcu; \
    const int gw = vcu * NWAVES + F.wave, NGW = G * NWAVES, gt = vcu * 512 + F.tid, NGT = G * 512; (void)gw; (void)NGW; (void)gt; (void)NGT; \
    float* const X = outp + O_X; bf16* const Hb = (bf16*)(ws + WS_H); float* const MOD = (float*)(ws + WS_MOD); const float* const modl = MOD + (size_t)l_ * NCV * INW; (void)X; (void)Hb; (void)modl;
#define PHASE_END(k)   if (MK_N_LAUNCHES == 1 && ph + 1 < hi) { XcdBarrier b_ = bar; asm volatile("" : "+s"(b_.bar)); xcd_barrier(b_); } if ((k) == TSEL && threadIdx.x == 0) *(volatile LAS unsigned long long*)(MISC0 + 18) += __builtin_amdgcn_s_memrealtime() - *(volatile LAS unsigned long long*)(MISC0 + 16); } ++ph;
    int l_ = 0;

    PHASE_BEGIN(0)
    {
        for (int it = F.vcu; it < NL * 64; it += G) s5_tables(F, it >> 6, it & 63, ws);
        __syncthreads();
        { const float* lamp = IN(19); for (int i = gt; i < NL * 2 * 1024; i += NGT) ((float*)(ws + WS_SP))[i] = log1pf(expf(-lamp[i])); }
        float* scr = (float*)(F.ldsg + F.wave * 16384);
        { const int rest = (G == 256) ? I_LAYER - SQ_END : I_LAYER;
          for (int it = gw; it < I_LAYER + 3 * rest; it += NGW) { if (it < I_LAYER) weight_item(F, ws, 0, it, scr); else { const int q = it - I_LAYER, l = 1 + q / rest, r = q % rest; weight_item(F, ws, l, I_LAYER - rest + r, scr); } } }
        const float* ckp = IN(2); const float* cvp = IN(3);
        for (int i = gt; i < 2 * 1048576; i += NGT) { const int which = i >> 20, j = i & 1048575; const GAS f32x4* s = (const GAS f32x4*)(which ? cvp : ckp) + (size_t)j * 2; const f32x4 a0 = s[0], a1 = s[1];
            v4u o; o.x = pk2(a0.x, a0.y); o.y = pk2(a0.z, a0.w); o.z = pk2(a1.x, a1.y); o.w = pk2(a1.z, a1.w); ((GAS v4u*)(ws + (which ? WS_CV : WS_CK)))[j] = o; }
        const float* cctx = IN(7); const float* cvec = IN(6); const float* wmod = IN(8);
        for (int task = gt; task < 16 * NL * 3072; task += NGT) {
            const int n4 = task % 3072, l = (task / 3072) % NL, ks = task / (3072 * NL);
            f32x4 acc[NCV];
#pragma unroll
            for (int v = 0; v < NCV; ++v) acc[v] = (f32x4){0.f, 0.f, 0.f, 0.f};
            const GAS f32x4* wp = (const GAS f32x4*)(wmod + ((size_t)l * DM + ks * 128) * INW) + n4;
#pragma unroll 16
            for (int k = 0; k < 128; ++k) { const f32x4 w = wp[(size_t)k * (INW / 4)]; const int kk = ks * 128 + k;
#pragma unroll
                for (int v = 0; v < NCV; ++v) { const float cnd = v == 0 ? cctx[kk] : cvec[(v - 1) * DM + kk]; const float sl = cnd * fsigmoid(cnd); acc[v] += w * sl; } }
#pragma unroll
            for (int v = 0; v < NCV; ++v) ((f32x4*)(ws + WS_MODP))[(((size_t)ks * NL + l) * NCV + v) * 3072 + n4] = acc[v];
        }
    }
    PHASE_END(0)
    PHASE_BEGIN(1)
        const float* bmod = IN(9);
        for (int i = gt; i < NL * NCV * 3072; i += NGT) { const int n4 = i % 3072, v = (i / 3072) % NCV, l = i / (3072 * NCV);
            f32x4 s = ((const f32x4*)(bmod + (size_t)l * INW))[n4];
#pragma unroll
            for (int ks = 0; ks < 16; ++ks) s += ((const f32x4*)(ws + WS_MODP))[(((size_t)ks * NL + l) * NCV + v) * 3072 + n4];
            ((f32x4*)MOD)[i] = s; }
    PHASE_END(1)
    PHASE_BEGIN(2)
        resnorm_rows<true, true>(F, IN(0), IN(1), X, nullptr, nullptr, nullptr, IN(10), MOD + 0 * DM, MOD + 1 * DM, Hb);
    PHASE_END(2)

    for (int l = 0; l < DBG_NL; ++l) {
        l_ = l;
        PHASE_BEGIN(3)
        {   pg8::SchedPlain S{(const char*)Hb, (const char*)(ws + WS_WINT) + (size_t)l * INW * DM * 2, 32, 48, G, c, (size_t)256 * DM * 2, (size_t)256 * DM * 2, DUPG1};
            pg8::EpiWin E{(bf16*)(ws + WS_XR), (bf16*)(ws + WS_XG), (bf16*)(ws + WS_UG), (bf16*)(ws + WS_Q), (bf16*)(ws + WS_K), (bf16*)(ws + WS_V), (bf16*)(ws + WS_G),
                          outp + O_K + (size_t)l * 256 * 1024, outp + O_V + (size_t)l * 256 * 1024};
            pg8::gemm_phase(F.lds, DM, DM, DM, S, E); }
        PHASE_END(3)
        PHASE_BEGIN(4)
        {
            { pg8::SchedS5E S{(const char*)(ws + WS_UG), (const char*)(ws + WS_ET) + (size_t)l * 64 * 65536 * 2, G, c}; pg8::EpiHloc E{(float*)(ws + WS_HLOC)};
              pg8::gemm_phase(F.lds, 256, 256, 256, S, E); }
            { const bf16* XR = (const bf16*)(ws + WS_XR); bf16* XC = (bf16*)(ws + WS_XC); const GAS float* cw = (const GAS float*)(IN(15) + (size_t)l * 4 * 1024); const GAS float* cb = (const GAS float*)(IN(16) + (size_t)l * 1024);
              for (int i_ = gt; i_ < ROWS * 128 * DUP_CONV; i_ += NGT) { const int i = i_ % (ROWS * 128); const int row = i >> 7, c8 = (i & 127) * 8;
                  const int s0 = row < CTXR ? (row & ~255) : (CTXR + ((row - CTXR) & ~1023)), s1 = row < CTXR ? s0 + 256 : s0 + 1024;
                  float acc[8];
#pragma unroll
                  for (int e = 0; e < 8; ++e) acc[e] = cb[c8 + e];
#pragma unroll
                  for (int k = 0; k < 4; ++k) { const int rr = row + k - 1; if (rr >= s0 && rr < s1) { float xv[8]; unpack8(*(const GAS v4u*)(XR + (size_t)rr * 1024 + c8), xv);
#pragma unroll
                      for (int e = 0; e < 8; ++e) acc[e] += cw[k * 1024 + c8 + e] * xv[e]; } }
                  *(GAS v4u*)(XC + (size_t)row * 1024 + c8) = pack8(acc); } }
            __syncthreads();
            { float* rp = (float*)(F.ldsg + att::RPB_OFF); const bf16* Qb = (const bf16*)(ws + WS_Q); const bf16* Kb = (const bf16*)(ws + WS_K); const bf16* Vb = (const bf16*)(ws + WS_V); bf16* Ob = (bf16*)(ws + WS_YNA);
              for (int u_ = (c + G / 2) % G; u_ < 256 * DUP_ATT; u_ += G) { const int u = u_ & 255;
                  if (u < 128) { const int b = u >> 5, h = (u >> 2) & 7, rg = u & 3; const int lo_ = rg == 0 ? 0 : (rg == 1 ? 0 : (rg == 2 ? 4 : 8)), NT = (rg == 0 || rg == 3) ? 16 : 20;
                      for (int i = F.tid; i < 465; i += 512) rp[i] = IN(29)[((size_t)l * 8 + h) * 465 + i] * (1.0f / att::SCALE);
                      __syncthreads();
                      const size_t qoff = (size_t)(CTXR + b * 1024 + rg * 256) * 1024 + h * 128, koff = (size_t)(CTXR + b * 1024 + lo_ * 64) * 1024 + h * 128, coff = ((size_t)(b * 4 + l) * 512) * 1024 + h * 128;
                      att::attn_body<true, 1>(Qb + qoff, (const bf16*)(ws + WS_CK) + coff, (const bf16*)(ws + WS_CV) + coff, Kb + koff, Vb + koff, Ob + qoff, NT, lo_, rg, F.ldsg);
                  } else { const int b = (u - 128) >> 3, h = (u - 128) & 7; const size_t off = (size_t)(b * 256) * 1024 + h * 128;
                      att::attn_body<false, 2>(Qb + off, Kb + off, Vb + off, Kb + off, Vb + off, Ob + off, 4, 0, 0, F.ldsg); }
              } }
        }
        PHASE_END(4)
        PHASE_BEGIN(5)
        {   { const float* HLOC = (const float*)(ws + WS_HLOC); bf16* HIN = (bf16*)(ws + WS_HIN); const GAS f32x2* LT = (const GAS f32x2*)(ws + WS_LT) + (size_t)l * 2 * 64 * 64;
              for (int i_ = gt; i_ < 20 * 64 * 2 * 64 * DUP_CARRY; i_ += NGT) { const int i = i_ % (20 * 64 * 2 * 64); const int p = i & 63, d = (i >> 6) & 1, g = (i >> 7) & 63, seq = i >> 13;
                  const int nch = seq < 16 ? 16 : 64, ch0 = seq < 16 ? seq * 16 : 256 + (seq - 16) * 64;
                  const f32x2 lam = LT[(d * 64 + g) * 64 + p]; float hr = 0.f, hi_ = 0.f;
                  if (seq >= 16) { const f32x2 h0 = ((const f32x2*)IN(5))[((((size_t)(seq - 16) * 4 + l) * 2 + d) * 64 + g) * 64 + p]; hr = h0.x; hi_ = h0.y; }
#pragma unroll 8
                  for (int k = 0; k < nch; ++k) { const int ch = d == 0 ? ch0 + k : ch0 + nch - 1 - k; const size_t idx = ((size_t)g * 512 + ch) * 256 + d * 128 + p * 2;
                      *(GAS unsigned*)(HIN + idx) = pk2(hr, hi_);
                      const f32x2 hl = *(const GAS f32x2*)(HLOC + idx); const float nr = lam.x * hr - lam.y * hi_ + hl.x, ni = lam.x * hi_ + lam.y * hr + hl.y; hr = nr; hi_ = ni; }
                  if (seq < 16) ((f32x2*)(outp + O_S5))[((((size_t)seq * 4 + l) * 2 + d) * 64 + g) * 64 + p] = (f32x2){hr, hi_}; } }
            { pg8::SchedRg S{(const char*)(ws + WS_XC), (const char*)(ws + WS_GWT) + (size_t)l * 8 * 2 * 256 * 128 * 2, G, c};
              pg8::EpiRg E{(const bf16*)(ws + WS_XC), IN(18) + (size_t)l * 4 * 1024, (const float*)(ws + WS_SP) + (size_t)l * 2048, (f32x2*)(ws + WS_AB)};
              pg8::gemm_phase(F.lds, 128, 1024, 128, S, E); }
        }
        PHASE_END(5)
        PHASE_BEGIN(6)
        {   { pg8::SchedS5Y S{(const char*)(ws + WS_UG), (const char*)(ws + WS_HIN), (const char*)(ws + WS_MT) + (size_t)l * 64 * 65536 * 2, (const char*)(ws + WS_FT) + (size_t)l * 64 * 65536 * 2, G, c};
              pg8::EpiS5Y E{(const bf16*)(ws + WS_UG), IN(27) + (size_t)l * 1024, (bf16*)(ws + WS_ZS)};
              pg8::gemm_phase(F.lds, 256, 256, 256, S, E); }
            { const GAS f32x2* AB = (const GAS f32x2*)(ws + WS_AB); GAS float* HF = (GAS float*)(ws + WS_HF); const GAS bf16* XG = (const GAS bf16*)(ws + WS_XG); GAS bf16* YRG = (GAS bf16*)(ws + WS_YRG);
              float* cs = (float*)F.ldsg;
              for (int task_ = (c + G / 2) % G; task_ < 320 * DUP_SCAN; task_ += G) { const int task = task_ % 320;
                  const bool lat = task >= 64 && task < 128; const int ti = lat ? task - 64 : (task < 64 ? task : task - 64); const int seq = ti >> 4, cb = ti & 15;
                  const int L = lat ? 1024 : 256, row0 = lat ? CTXR + seq * 1024 : seq * 256, ch = cb * 64 + F.lane, len = L / 8, t0 = row0 + F.wave * len;
                  __syncthreads();
                  float pf = 1.f, hf = 0.f, pb = 1.f, hb = 0.f;
#pragma unroll 16
                  for (int t = 0; t < len; ++t) { const f32x2 v = AB[(size_t)(t0 + t) * 1024 + ch]; hf = v.x * hf + v.y; pf *= v.x; }
#pragma unroll 16
                  for (int t = len - 1; t >= 0; --t) { const f32x2 v = AB[((size_t)ROWS + t0 + t) * 1024 + ch]; hb = v.x * hb + v.y; pb *= v.x; }
                  cs[(F.wave * 4 + 0) * 64 + F.lane] = pf; cs[(F.wave * 4 + 1) * 64 + F.lane] = hf; cs[(F.wave * 4 + 2) * 64 + F.lane] = pb; cs[(F.wave * 4 + 3) * 64 + F.lane] = hb;
                  __syncthreads();
                  float cf = lat ? IN(4)[((size_t)(seq * 4 + l) * 2 + 0) * 1024 + ch] : 0.f, cbk = lat ? IN(4)[((size_t)(seq * 4 + l) * 2 + 1) * 1024 + ch] : 0.f;
                  for (int w = 0; w < F.wave; ++w) cf = cs[(w * 4 + 0) * 64 + F.lane] * cf + cs[(w * 4 + 1) * 64 + F.lane];
                  for (int w = 7; w > F.wave; --w) cbk = cs[(w * 4 + 2) * 64 + F.lane] * cbk + cs[(w * 4 + 3) * 64 + F.lane];
                  if (!lat) { if (F.wave == 7) outp[O_RG + ((size_t)(seq * 4 + l) * 2 + 0) * 1024 + ch] = pf * cf + hf; if (F.wave == 0) outp[O_RG + ((size_t)(seq * 4 + l) * 2 + 1) * 1024 + ch] = pb * cbk + hb; }
                  float h = cf;
#pragma unroll 16
                  for (int t = 0; t < len; ++t) { const f32x2 v = AB[(size_t)(t0 + t) * 1024 + ch]; h = v.x * h + v.y; HF[(size_t)(t0 + t) * 1024 + ch] = h; }
                  h = cbk;
#pragma unroll 8
                  for (int t = len - 1; t >= 0; --t) { const f32x2 v = AB[((size_t)ROWS + t0 + t) * 1024 + ch]; h = v.x * h + v.y; const size_t o = (size_t)(t0 + t) * 1024 + ch;
                      YRG[o] = (bf16)f2bf((HF[o] + h) * bf2f(XG[o])); }
              } }
        }
        PHASE_END(6)
        PHASE_BEGIN(7)
        {   pg8::SchedPlain S{(const char*)(ws + WS_ZS), (const char*)(ws + WS_GLUT) + (size_t)l * 1024 * 1024 * 2, 32, 4, G, c, (size_t)256 * 1024 * 2, (size_t)256 * 1024 * 2, 1};
            pg8::EpiGlu E{(const bf16*)(ws + WS_ZS), (bf16*)(ws + WS_YS5)};
            pg8::gemm_phase(F.lds, 1024, 1024, 1024, S, E);
            __syncthreads(); static_weight_items(F, ws, l + 1, c, G, 0, SQ_P5); }
        PHASE_END(7)
        PHASE_BEGIN(8)
        {   pg8::SchedMerge S{(const char*)(ws + WS_YRG), (const char*)(ws + WS_YS5), (const char*)(ws + WS_YNA), (const char*)(ws + WS_OUTT) + (size_t)l * 3 * DM * 1024 * 2, G, c};
            pg8::EpiMerge E{(const bf16*)(ws + WS_G), (bf16*)(ws + WS_MM)};
            pg8::gemm_phase(F.lds, 1024, 1024, 1024, S, E); }
        PHASE_END(8)
        PHASE_BEGIN(9)
        {   pg8::SchedPlain S{(const char*)(ws + WS_MM), (const char*)(ws + WS_WOT) + (size_t)l * DM * DM * 2, 32, 8, G, c, (size_t)256 * DM * 2, (size_t)256 * DM * 2, 1};
            pg8::EpiB16 E{(bf16*)(ws + WS_Z), DM};
            pg8::gemm_phase(F.lds, DM, DM, DM, S, E); }
        PHASE_END(9)
        PHASE_BEGIN(10)
            resnorm_rows<false, true>(F, nullptr, nullptr, X, (const bf16*)(ws + WS_Z), IN(11) + (size_t)l * DM, modl + 2 * DM, IN(12) + (size_t)l * DM, modl + 3 * DM, modl + 4 * DM, Hb);
        PHASE_END(10)
        PHASE_BEGIN(11)
        {   pg8::SchedPlain S{(const char*)Hb, (const char*)(ws + WS_FINT) + (size_t)l * 2 * FFH * DM * 2, 32, 44, G, c, (size_t)256 * DM * 2, (size_t)256 * DM * 2, DUPG9};
            pg8::EpiSwiglu E{(bf16*)(ws + WS_FH)};
            pg8::gemm_phase(F.lds, DM, DM, DM, S, E);
            __syncthreads(); static_weight_items(F, ws, l + 1, c, G, SQ_P5, SQ_P9); }
        PHASE_END(11)
        PHASE_BEGIN(12)
        {   pg8::SchedPlain S{(const char*)(ws + WS_FH), (const char*)(ws + WS_FOUTT) + (size_t)l * DM * FFH * 2, 32, 8, G, c, (size_t)256 * FFH * 2, (size_t)256 * FFH * 2, DUPG10};
            pg8::EpiB16 E{(bf16*)(ws + WS_Z), DM};
            pg8::gemm_phase(F.lds, FFH, FFH, FFH, S, E); }
        PHASE_END(12)
        PHASE_BEGIN(13)
            if (l + 1 < NL) resnorm_rows<false, true>(F, nullptr, nullptr, X, (const bf16*)(ws + WS_Z), IN(13) + (size_t)l * DM, modl + 5 * DM, IN(10) + (size_t)(l + 1) * DM, modl + NCV * INW + 0 * DM, modl + NCV * INW + 1 * DM, Hb);
            else resnorm_rows<false, false>(F, nullptr, nullptr, X, (const bf16*)(ws + WS_Z), IN(13) + (size_t)l * DM, modl + 5 * DM, nullptr, nullptr, nullptr, Hb);
        PHASE_END(13)
    }
#if DBG_KEEP
    PHASE_BEGIN(14)
        for (size_t i = (size_t)gt; i < O_END; i += (size_t)NGT) {
            int r, lay = 0;
            if (i < O_K) r = i < O_K / 2 ? 0 : 1;
            else if (i < O_V) { r = 2; lay = (int)(((i - O_K) / (256 * 1024)) & 3); }
            else if (i < O_RG) { r = 3; lay = (int)(((i - O_V) / (256 * 1024)) & 3); }
            else if (i < O_S5) { r = 4; lay = (int)(((i - O_RG) / 2048) & 3); }
            else { r = 5; lay = (int)(((i - O_S5) / 16384) & 3); }
            const bool keep = ((DBG_KEEP >> r) & 1) && (r < 2 || ((DBG_LMASK >> lay) & 1));
            float v = keep ? 3.0f * outp[i] : 0.0f;
#if DBG_DUMP
            v = 0.f;
            if (i >= O_K && i < O_K + (size_t)ROWS * 1024) { const size_t j = i - O_K;
                if (DBG_DUMP == 1) v = bf2f(((const bf16*)(ws + WS_YNA))[j]);
                if (DBG_DUMP == 2) v = bf2f(((const bf16*)(ws + WS_YS5))[j]);
                if (DBG_DUMP == 3) v = bf2f(((const bf16*)(ws + WS_YRG))[j]);
                if (DBG_DUMP == 4) v = bf2f(((const bf16*)(ws + WS_ZS))[j]);
                if (DBG_DUMP == 5) v = bf2f(((const bf16*)(ws + WS_MM))[j]);
                if (DBG_DUMP == 6) v = ((const bf16*)(ws + WS_Z))[j];
                if (DBG_DUMP == 7) v = bf2f(((const bf16*)(ws + WS_FH))[j]);
                if (DBG_DUMP == 8) v = bf2f(((const bf16*)(ws + WS_H))[j]);
                if (DBG_DUMP == 9) v = bf2f(((const bf16*)(ws + WS_G))[j]);
                if (DBG_DUMP == 11) v = bf2f(((const bf16*)(ws + WS_G))[(size_t)8192 * 6144 + j]);
                if (DBG_DUMP == 10) v = bf2f(((const bf16*)(ws + WS_WINT))[(size_t)6144 * 2048 + j]);
            }
#endif
            outp[i] = v;
        }
    PHASE_END(14)
#endif
    if (TSEL >= 0 && blockIdx.x == 0 && threadIdx.x == 0) { const float us = (float)(*(volatile LAS unsigned long long*)(MISC0 + 18)) * 0.01f; out0[0] = exp2f(rintf(log2f(us) * 10.0f) * 0.1f); }
#undef PHASE_BEGIN
#undef PHASE_END
}
constexpr int N_PHASES = 3 + DBG_NL * 11 + (DBG_KEEP ? 1 : 0);

extern "C" void kernel_launch(void* const* d_in, const int* in_sizes, int n_in, void* d_out, int out_size, void* d_ws, size_t ws_size, hipStream_t stream) {
    static int grid = 0;
    if (grid == 0) {
        if (n_in != 36 || out_size != (int)O_END || ws_size < WS_END) { fprintf(stderr, "kernel_launch: unexpected shapes (n_in %d out %d ws %zu)\n", n_in, out_size, ws_size); grid = -1; return; }
        int dev = 0, cus = 0, per_cu = 0;
        if (hipGetDevice(&dev) != hipSuccess || hipDeviceGetAttribute(&cus, hipDeviceAttributeMultiprocessorCount, dev) != hipSuccess) { grid = -1; return; }
        if (hipFuncSetAttribute((const void*)fwd_kernel, hipFuncAttributeMaxDynamicSharedMemorySize, LDS_BYTES) != hipSuccess) { fprintf(stderr, "kernel_launch: hipFuncSetAttribute failed\n"); grid = -1; return; }
        if (hipOccupancyMaxActiveBlocksPerMultiprocessor(&per_cu, (const void*)fwd_kernel, NWAVES * 64, LDS_BYTES) != hipSuccess || per_cu < 1) { fprintf(stderr, "kernel_launch: occupancy query reports %d blocks per CU\n", per_cu); }
        (void)hipGetLastError();
        grid = cus;
    }
    if (grid < 0) return;
    if (hipMemsetAsync((char*)d_ws + WS_CTL, 0, CTL_ZERO_BYTES, stream) != hipSuccess) return;
    Args a{};
    for (int i = 0; i < 36; ++i) a.in[i] = (const float*)d_in[i];
    a.out = (float*)d_out; a.ws = (unsigned char*)d_ws;
    if (MK_N_LAUNCHES == 1) { a.ph_lo = 0; a.ph_hi = N_PHASES; hipLaunchKernelGGL(fwd_kernel, dim3(grid), dim3(NWAVES * 64), LDS_BYTES, stream, a); }
    else for (int p = 0; p < N_PHASES; ++p) { a.ph_lo = p; a.ph_hi = p + 1; hipLaunchKernelGGL(fwd_kernel, dim3(grid), dim3(NWAVES * 64), LDS_BYTES, stream, a); }
}
```

```cpp
#include <hip/hip_runtime.h>
#include <hip/hip_bf16.h>
#include <cstdio>
#include <cstdint>

#ifndef MK_N_LAUNCHES
#define MK_N_LAUNCHES 1
#endif
#ifndef DBG_KEEP
#define DBG_KEEP 0
#endif
#ifndef DUP_SCAN
#define DUP_SCAN 1
#endif
#ifndef DUP_ATT
#define DUP_ATT 1
#endif
#ifndef DUP_CARRY
#define DUP_CARRY 1
#endif
#ifndef DUP_CONV
#define DUP_CONV 1
#endif
#ifndef DUP_RGG
#define DUP_RGG 1
#endif
#ifndef DUP_S5
#define DUP_S5 1
#endif
#ifndef TSEL
#define TSEL (-1)
#endif
#ifndef DUPG1
#define DUPG1 1
#endif
#ifndef DUPG6
#define DUPG6 1
#endif
#ifndef DUPG9
#define DUPG9 1
#endif
#ifndef DUPG10
#define DUPG10 1
#endif
#ifndef DUP_GEMM
#define DUP_GEMM 1
#endif
#ifndef DUP_MASK
#define DUP_MASK 0u
#endif
#ifndef DBG_LMASK
#define DBG_LMASK 15
#endif
#ifndef DBG_DUMP
#define DBG_DUMP 0
#endif
#ifndef DBG_NL
#define DBG_NL 4
#endif

constexpr int DM = 2048, ROWS = 8192, CTXR = 4096, INW = 12288, FFH = 5632, NL = 4, W1K = 1024;
constexpr int NCV = 5;
constexpr float RMS_EPS = 1e-6f;
constexpr size_t MiB = 1u << 20;

constexpr size_t O_X = 0, O_K = 16777216, O_V = 33554432, O_RG = 50331648, O_S5 = 50462720, O_END = 51511296;

constexpr size_t WS_CTL = 0, CTL_ZERO_BYTES = 1 * MiB;
constexpr size_t WS_MODP = 1 * MiB;
constexpr size_t WS_MOD  = 17 * MiB;
constexpr size_t WS_SP   = 18 * MiB;
constexpr size_t WS_LT   = 18 * MiB + 65536;
constexpr size_t WS_GWT  = 19 * MiB;
constexpr size_t WS_WINT = 24 * MiB;
constexpr size_t WS_GLUT = 216 * MiB;
constexpr size_t WS_OUTT = 224 * MiB;
constexpr size_t WS_WOT  = 272 * MiB;
constexpr size_t WS_FINT = 304 * MiB;
constexpr size_t WS_FOUTT = 480 * MiB;
constexpr size_t WS_MT   = 568 * MiB;
constexpr size_t WS_ET   = 600 * MiB;
constexpr size_t WS_FT   = 632 * MiB;
constexpr size_t WS_CK   = 664 * MiB;
constexpr size_t WS_CV   = 680 * MiB;
constexpr size_t WS_H    = 696 * MiB;
constexpr size_t WS_XR   = 728 * MiB;
constexpr size_t WS_XG   = 744 * MiB;
constexpr size_t WS_XC   = 760 * MiB;
constexpr size_t WS_Q    = 776 * MiB;
constexpr size_t WS_K    = 792 * MiB;
constexpr size_t WS_V    = 808 * MiB;
constexpr size_t WS_YRG  = 824 * MiB;
constexpr size_t WS_YS5  = 840 * MiB;
constexpr size_t WS_YNA  = 856 * MiB;
constexpr size_t WS_ZS   = 872 * MiB;
constexpr size_t WS_UG   = 888 * MiB;
constexpr size_t WS_HIN  = 904 * MiB;
constexpr size_t WS_G    = 920 * MiB;
constexpr size_t WS_AB   = 1016 * MiB;
constexpr size_t WS_FH   = 1016 * MiB;
constexpr size_t WS_HF   = 1144 * MiB;
constexpr size_t WS_HLOC = 1176 * MiB;
constexpr size_t WS_Z    = 1144 * MiB;
constexpr size_t WS_MM   = 1208 * MiB;
constexpr size_t WS_END  = 1240 * MiB;

constexpr int CW_TMO = 0, CW_BAR = 4096;

constexpr int RING_BYTES = 131072;
constexpr int LDSCTL_OFF = RING_BYTES, MISC_OFF = LDSCTL_OFF + 320;
constexpr int LDS_BYTES = 147456;

#define GAS __attribute__((address_space(1)))
#define LAS __attribute__((address_space(3)))
typedef unsigned short bf16;
typedef unsigned v4u __attribute__((ext_vector_type(4)));
typedef unsigned v2u __attribute__((ext_vector_type(2)));
typedef float f32x4 __attribute__((ext_vector_type(4)));
typedef float f32x2 __attribute__((ext_vector_type(2)));
typedef short bf16x8 __attribute__((ext_vector_type(8)));
typedef GAS unsigned gu32;
#define RLX_AGENT __ATOMIC_RELAXED, __HIP_MEMORY_SCOPE_AGENT
#define LDS_WAIT() asm volatile("s_waitcnt lgkmcnt(0)" ::: "memory")
#define VM_WAIT() asm volatile("s_waitcnt vmcnt(0)" ::: "memory")

__device__ __forceinline__ unsigned f2bf(float f) { unsigned u = __builtin_bit_cast(unsigned, f); return (u + 0x7fffu + ((u >> 16) & 1u)) >> 16; }
typedef __bf16 bf16x2_t __attribute__((ext_vector_type(2)));
__device__ __forceinline__ unsigned pk2(float lo, float hi) { const f32x2 v = {lo, hi}; const bf16x2_t b = __builtin_convertvector(v, bf16x2_t); return __builtin_bit_cast(unsigned, b); }
__device__ __forceinline__ float bflo(unsigned w) { return __builtin_bit_cast(float, w << 16); }
__device__ __forceinline__ float bfhi(unsigned w) { return __builtin_bit_cast(float, w & 0xffff0000u); }
__device__ __forceinline__ float bf2f(bf16 h) { return __builtin_bit_cast(float, (unsigned)h << 16); }
__device__ __forceinline__ float fsigmoid(float x) { return __builtin_amdgcn_rcpf(1.0f + __expf(-x)); }
__device__ __forceinline__ float gelu_tanh(float x) { const float y = 0.7978845608028654f * (x + 0.044715f * x * x * x); return x * __builtin_amdgcn_rcpf(1.0f + __expf(-2.0f * y)); }
__device__ __forceinline__ float wave_sum(float v, int lane) {
#pragma unroll
    for (int o = 1; o < 64; o <<= 1) v += __builtin_bit_cast(float, __builtin_amdgcn_ds_bpermute((lane ^ o) << 2, __builtin_bit_cast(int, v)));
    return v;
}
__device__ __forceinline__ void unpack8(const v4u w, float (&f)[8]) { f[0] = bflo(w.x); f[1] = bfhi(w.x); f[2] = bflo(w.y); f[3] = bfhi(w.y); f[4] = bflo(w.z); f[5] = bfhi(w.z); f[6] = bflo(w.w); f[7] = bfhi(w.w); }
__device__ __forceinline__ v4u pack8(const float (&f)[8]) { v4u w; w.x = pk2(f[0], f[1]); w.y = pk2(f[2], f[3]); w.z = pk2(f[4], f[5]); w.w = pk2(f[6], f[7]); return w; }

#define XB_TMO      128
#define XB_XCNT(j)  (256  + 64 * (j))
#define XB_XSUB(j)  (1280 + 64 * (j))
#define XB_XGEN(j)  (2304 + 64 * (j))
#define XB_TOP      3328
#define XB_TOPGEN   3392
#define XCD_BAR_WORDS 3456
#define XB_SPIN_CAP (1u << 18)
__device__ __forceinline__ unsigned xb_ld(unsigned* p)              { return __hip_atomic_load(p, __ATOMIC_RELAXED, __HIP_MEMORY_SCOPE_AGENT); }
__device__ __forceinline__ unsigned xb_add(unsigned* p, unsigned v) { return __hip_atomic_fetch_add(p, v, __ATOMIC_RELAXED, __HIP_MEMORY_SCOPE_AGENT); }
__device__ __forceinline__ unsigned xb_xcc_id() { return (unsigned)__builtin_amdgcn_s_getreg((3 << 11) | 20) & 0xFu; }
#define XB_SPIN(cond, bar) do { unsigned _sp = 0; while (cond) { __builtin_amdgcn_s_sleep(1); \
    if ((++_sp & 255u) == 0u) { if (xb_ld(&(bar)[XB_TMO])) break; if (_sp > XB_SPIN_CAP) { atomicAdd(&(bar)[XB_TMO], 1u); break; } } } } while (0)
struct XcdBarrier { unsigned* bar; unsigned x; volatile LAS unsigned* st; };
__device__ __forceinline__ XcdBarrier xcd_barrier_post(unsigned* bar, volatile LAS unsigned* st) {
    XcdBarrier b; b.bar = bar; b.x = xb_xcc_id(); b.st = st;
    if (threadIdx.x == 0) (void)xb_add(&bar[XB_XCNT(b.x)], 1u);
    return b;
}
__device__ __forceinline__ void xcd_barrier_complete(unsigned* bar, unsigned x, unsigned& nloc, unsigned& nx) {
    const unsigned G = gridDim.x * gridDim.y * gridDim.z;
    unsigned sum, cnt, mine, sp = 0u;
    for (;;) {
        sum = 0u; cnt = 0u; mine = 0u;
#pragma unroll
        for (unsigned j = 0; j < 16; ++j) { const unsigned c = xb_ld(&bar[XB_XCNT(j)]); sum += c; cnt += (c > 0u) ? 1u : 0u; mine = (j == x) ? c : mine; }
        if (sum == G) break;
        __builtin_amdgcn_s_sleep(1);
        if ((++sp & 255u) == 0u) { if (xb_ld(&bar[XB_TMO])) break; if (sp > XB_SPIN_CAP) { atomicAdd(&bar[XB_TMO], 1u); break; } }
    }
    nloc = mine > 0u ? mine : 1u; nx = cnt > 0u ? cnt : 1u;
}
__device__ __forceinline__ void xcd_barrier(const XcdBarrier& b) {
    asm volatile("s_waitcnt vmcnt(0)" ::: "memory");
    __syncthreads();
    int tid_b = threadIdx.x; asm volatile("" : "+v"(tid_b));
    if (tid_b == 0) {
        unsigned* bar = b.bar;
        __builtin_amdgcn_s_waitcnt(0);
        unsigned nloc = b.st[0], nx = b.st[1];
        if (nloc == 0u) { xcd_barrier_complete(bar, b.x, nloc, nx); b.st[0] = nloc; b.st[1] = nx; }
        const unsigned old = xb_add(&bar[XB_XSUB(b.x)], 1u);
        const unsigned gen = old / nloc;
        if (old + 1u == (gen + 1u) * nloc) {
            __builtin_amdgcn_fence(__ATOMIC_RELEASE, "agent");
            asm volatile("s_waitcnt vmcnt(0)" ::: "memory");
            const unsigned og = xb_add(&bar[XB_TOP], 1u);
            const unsigned tg = og / nx;
            if (og + 1u == (tg + 1u) * nx) xb_add(&bar[XB_TOPGEN], 1u);
            else XB_SPIN(xb_ld(&bar[XB_TOPGEN]) == tg, bar);
            __builtin_amdgcn_fence(__ATOMIC_ACQUIRE, "agent");
            xb_add(&bar[XB_XGEN(b.x)], 1u);
            asm volatile("s_waitcnt vmcnt(0)" ::: "memory");
        } else {
            XB_SPIN(xb_ld(&bar[XB_XGEN(b.x)]) == gen, bar);
            __builtin_amdgcn_fence(__ATOMIC_ACQUIRE, "agent");
            asm volatile("s_waitcnt vmcnt(0)" ::: "memory");
        }
    }
    __syncthreads();
}

namespace pg8 {
#define PG8_LAS __attribute__((address_space(3)))
constexpr int BM = 256, BK = 64, HALF = 128, HTB = HALF * BK * 2, STAGE_BYTES = 8 * HTB;
__host__ __device__ __forceinline__ int lds_byte(int r, int c) { const int st = (r >> 4) * 2 + (c >> 5), rr = r & 15, cc = c & 31, ob = rr * 64 + cc * 2; return st * 1024 + (ob ^ (((ob >> 9) & 1) << 5)); }
__host__ __device__ __forceinline__ void stage_rc(int b, int& R, int& C) { const int st = b / 1024, sb = b % 1024, swz = sb ^ (((sb >> 9) & 1) << 5); R = (st >> 1) * 16 + swz / 64; C = (st & 1) * 32 + (swz % 64) / 2; }
__host__ __device__ __forceinline__ int perm32(int rho) { const int n = rho >> 4, i = rho & 15; return 8 * (i >> 2) + 4 * n + (i & 3); }

struct Unit { const char* A; const char* B; int pm, pn, aux, last; };

__device__ __forceinline__ bool tile_order(long L, int nM, int nN, int& pm, int& pn) {
    const int nwg = nM * nN; if (L >= nwg) return false;
    int wgid = (int)L; { const int q = nwg / 8, r = nwg % 8, xcd = wgid % 8, off = wgid / 8; wgid = (xcd < r ? xcd * (q + 1) : r * (q + 1) + (xcd - r) * q) + off; }
    const int nig = 8 * nN, gid = wgid / nig, fm = gid * 8, gsz = (nM - fm) < 8 ? (nM - fm) : 8;
    pm = fm + ((wgid % nig) % gsz); pn = (wgid % nig) / gsz; return true;
}

typedef float f32x4 __attribute__((ext_vector_type(4)));
typedef short bf16x8 __attribute__((ext_vector_type(8)));

template <class Epi, class Sched>
__device__ __forceinline__ void gemm_phase(PG8_LAS unsigned char* lds, const int K, const int lda, const int ldb, const Sched& S, const Epi& E) {
    int tid_ = threadIdx.x; asm volatile("" : "+v"(tid_));
    const int tid = tid_, wid = __builtin_amdgcn_readfirstlane(tid >> 6), lane = tid & 63, wr = wid >> 2, wc = wid & 3, fr = lane & 15, fq = lane >> 4;
    const int nt = K / BK;
    unsigned voffA[2], voffB[2];
#pragma unroll
    for (int i = 0; i < 2; ++i) { int R, C; stage_rc(tid * 16 + i * 8192, R, C); const int Rb = Epi::PERM ? ((R & ~31) + perm32(R & 31)) : R;
        voffA[i] = (unsigned)(R * lda + C) * 2u; voffB[i] = (unsigned)(Rb * ldb + C) * 2u; }
    const size_t kstep = (size_t)(BK * 2);
    const size_t hstepA = (size_t)HALF * lda * 2, hstepB = (size_t)HALF * ldb * 2;
    const unsigned ldsw = (unsigned)wid * 1024u;
    const int aoff = lds_byte(wr * 64 + fr, fq * 8), boff = lds_byte(wc * 32 + fr, fq * 8);
#define PG8_SA(b, h) (((b) * 2 + (h)) * HTB)
#define PG8_SB(b, h) ((4 + (b) * 2 + (h)) * HTB)
#define PG8_STAGE(bufoff, gbase, voff) do { _Pragma("unroll") for (int _i = 0; _i < 2; ++_i) \
        __builtin_amdgcn_global_load_lds((const unsigned*)((const char*)(gbase) + (voff)[_i]), (PG8_LAS unsigned*)(lds + (bufoff) + ldsw + _i * 8192), 16, 0, 0); } while (0)
#define PG8_LDA(dst, b, h) do { _Pragma("unroll") for (int m = 0; m < 4; ++m) _Pragma("unroll") for (int k = 0; k < 2; ++k) dst[m][k] = *(const PG8_LAS bf16x8*)(lds + PG8_SA(b, h) + aoff + m * 2048 + k * 1024); } while (0)
#define PG8_LDB(dst, b, h) do { _Pragma("unroll") for (int n = 0; n < 2; ++n) _Pragma("unroll") for (int k = 0; k < 2; ++k) dst[n][k] = *(const PG8_LAS bf16x8*)(lds + PG8_SB(b, h) + boff + n * 2048 + k * 1024); } while (0)
#define PG8_MMA(ai, bj, At, Bt) do { __builtin_amdgcn_s_setprio(1); _Pragma("unroll") for (int m = 0; m < 4; ++m) _Pragma("unroll") for (int n = 0; n < 2; ++n) _Pragma("unroll") for (int k = 0; k < 2; ++k) \
        acc[ai][bj][m][n] = __builtin_amdgcn_mfma_f32_16x16x32_bf16(Bt[n][k], At[m][k], acc[ai][bj][m][n], 0, 0, 0); __builtin_amdgcn_s_setprio(0); } while (0)
#define PG8_WAIT_V(n) asm volatile("s_waitcnt vmcnt(" #n ")" ::: "memory")
#define PG8_WAIT_L(n) asm volatile("s_waitcnt lgkmcnt(" #n ")" ::: "memory")
#define PG8_BAR __builtin_amdgcn_s_barrier()
#define PG8_SCHED __builtin_amdgcn_sched_barrier(0)
    Unit cur, nxt; int ui = 0;
    if (!S.next(0, cur)) return;
    f32x4 acc[2][2][4][2];
#pragma unroll
    for (int a = 0; a < 2; ++a)
#pragma unroll
        for (int b = 0; b < 2; ++b)
#pragma unroll
            for (int m = 0; m < 4; ++m)
#pragma unroll
                for (int n = 0; n < 2; ++n) acc[a][b][m][n] = (f32x4){0.f, 0.f, 0.f, 0.f};
    bf16x8 At[4][2], B0[2][2], B1[2][2];
    const char* cA = cur.A; const char* cB = cur.B;
    PG8_STAGE(PG8_SB(0, 0), cB, voffB); PG8_STAGE(PG8_SB(0, 1), cB + hstepB, voffB); PG8_STAGE(PG8_SA(0, 0), cA, voffA); PG8_STAGE(PG8_SA(0, 1), cA + hstepA, voffA);
    if (wr == 1) PG8_BAR;
    PG8_WAIT_V(2); PG8_BAR;
    PG8_STAGE(PG8_SB(1, 0), cB + kstep, voffB); PG8_STAGE(PG8_SA(1, 0), cA + kstep, voffA); PG8_STAGE(PG8_SB(1, 1), cB + hstepB + kstep, voffB);
    PG8_WAIT_V(6); PG8_BAR;
    for (;;) {
        const bool has_next = S.next(ui + 1, nxt);
        const char* nA = has_next ? nxt.A : cA; const char* nB = has_next ? nxt.B : cB;
#pragma unroll 1
        for (int t = 0; t < nt; t += 2) {
            const bool last = (t == nt - 2);
            const char* a1 = cA + (size_t)(t + 1) * kstep;
            const char* a2 = last ? nA : cA + (size_t)(t + 2) * kstep; const char* b2 = last ? nB : cB + (size_t)(t + 2) * kstep;
            const char* a3 = a2 + kstep; const char* b3 = b2 + kstep;
            PG8_LDB(B0, 0, 0); PG8_LDB(B1, 0, 1); PG8_SCHED; PG8_LDA(At, 0, 0); PG8_STAGE(PG8_SA(1, 1), a1 + hstepA, voffA);
            PG8_WAIT_V(8); PG8_WAIT_L(0); PG8_BAR; PG8_MMA(0, 0, At, B0); PG8_MMA(0, 1, At, B1); PG8_BAR; PG8_SCHED;
            PG8_LDA(At, 0, 1); PG8_STAGE(PG8_SB(0, 0), b2, voffB); PG8_STAGE(PG8_SB(0, 1), b2 + hstepB, voffB); PG8_STAGE(PG8_SA(0, 0), a2, voffA);
            PG8_WAIT_V(8); PG8_WAIT_L(0); PG8_BAR; PG8_MMA(1, 0, At, B0); PG8_MMA(1, 1, At, B1); PG8_BAR; PG8_SCHED;
            PG8_LDB(B0, 1, 0); PG8_LDB(B1, 1, 1); PG8_SCHED; PG8_LDA(At, 1, 0); PG8_STAGE(PG8_SA(0, 1), a2 + hstepA, voffA);
            PG8_WAIT_V(8); PG8_WAIT_L(0); PG8_BAR; PG8_MMA(0, 0, At, B0); PG8_MMA(0, 1, At, B1); PG8_BAR; PG8_SCHED;
            PG8_LDA(At, 1, 1); PG8_STAGE(PG8_SB(1, 0), b3, voffB); PG8_STAGE(PG8_SB(1, 1), b3 + hstepB, voffB); PG8_STAGE(PG8_SA(1, 0), a3, voffA);
            PG8_WAIT_V(8); PG8_WAIT_L(0); PG8_BAR; PG8_MMA(1, 0, At, B0); PG8_MMA(1, 1, At, B1); PG8_BAR; PG8_SCHED;
        }
        if (wr == 0) PG8_BAR;
        if (cur.last) E(acc, cur, wr, wc, fr, fq); else E.mid(acc, cur, wr, wc, fr, fq);
        if (!has_next) break;
        if (cur.last) {
#pragma unroll
            for (int a = 0; a < 2; ++a)
#pragma unroll
                for (int b = 0; b < 2; ++b)
#pragma unroll
                    for (int m = 0; m < 4; ++m)
#pragma unroll
                        for (int n = 0; n < 2; ++n) acc[a][b][m][n] = (f32x4){0.f, 0.f, 0.f, 0.f};
        }
        cur = nxt; cA = nA; cB = nB; ++ui;
        if (wr == 1) PG8_BAR;
    }
    PG8_WAIT_V(0);
    PG8_BAR;
#undef PG8_SA
#undef PG8_SB
#undef PG8_STAGE
#undef PG8_LDA
#undef PG8_LDB
#undef PG8_MMA
#undef PG8_WAIT_V
#undef PG8_WAIT_L
#undef PG8_BAR
#undef PG8_SCHED
}

typedef const f32x4 (&AccC)[2][2][4][2];
typedef f32x4 (&AccM)[2][2][4][2];
#define EPI_ROWS_BEGIN _Pragma("unroll") for (int ai = 0; ai < 2; ++ai) _Pragma("unroll") for (int m = 0; m < 4; ++m) { const int row = u.pm * 256 + ai * 128 + wr * 64 + m * 16 + fr;
#define EPI_ROWS_END }

#define EPI_NO_MID __device__ __forceinline__ void mid(AccM, const Unit&, int, int, int, int) const {}

struct EpiB16 {
    EPI_NO_MID
    static constexpr bool PERM = true;
    bf16* O; int ldc;
    __device__ __forceinline__ void operator()(AccC acc, const Unit& u, int wr, int wc, int fr, int fq) const {
        const int col0 = u.pn * 256 + wc * 32 + 8 * fq;
        EPI_ROWS_BEGIN
#pragma unroll
            for (int bj = 0; bj < 2; ++bj) { const f32x4 v0 = acc[ai][bj][m][0], v1 = acc[ai][bj][m][1]; const float f[8] = {v0[0], v0[1], v0[2], v0[3], v1[0], v1[1], v1[2], v1[3]};
                *(GAS v4u*)(O + (size_t)row * ldc + col0 + bj * 128) = pack8(f); }
        EPI_ROWS_END
    }
};
struct EpiHloc {
    EPI_NO_MID
    static constexpr bool PERM = false;
    float* O;
    __device__ __forceinline__ void operator()(AccC acc, const Unit& u, int wr, int wc, int fr, int fq) const {
        const int col0 = wc * 32 + 4 * fq; float* base = O + (size_t)u.aux * 512 * 256;
        EPI_ROWS_BEGIN
            float* rowp = base + (size_t)row * 256 + col0;
#pragma unroll
            for (int bj = 0; bj < 2; ++bj)
#pragma unroll
                for (int n = 0; n < 2; ++n) *(GAS f32x4*)(rowp + bj * 128 + n * 16) = acc[ai][bj][m][n];
        EPI_ROWS_END
    }
};
struct EpiWin {
    EPI_NO_MID
    static constexpr bool PERM = true;
    bf16 *XR, *XG, *UG, *Q, *Kb, *Vb, *G; float *outK, *outV;
    __device__ __forceinline__ void operator()(AccC acc, const Unit& u, int wr, int wc, int fr, int fq) const {
        const int pn = u.pn, seg = pn >> 2;
        const int cseg = (pn & 3) * 256 + wc * 32 + 8 * fq;
        EPI_ROWS_BEGIN
#pragma unroll
            for (int bj = 0; bj < 2; ++bj) {
                const f32x4 v0 = acc[ai][bj][m][0], v1 = acc[ai][bj][m][1];
                float f[8] = {v0[0], v0[1], v0[2], v0[3], v1[0], v1[1], v1[2], v1[3]};
                const int c = cseg + bj * 128;
                if (seg >= 6) {
#pragma unroll
                    for (int e = 0; e < 8; ++e) f[e] = fsigmoid(f[e]);
                    *(GAS v4u*)(G + (size_t)row * 6144 + (pn - 24) * 256 + wc * 32 + 8 * fq + bj * 128) = pack8(f);
                } else if (seg == 1) {
#pragma unroll
                    for (int e = 0; e < 8; ++e) f[e] = gelu_tanh(f[e]);
                    *(GAS v4u*)(XG + (size_t)row * 1024 + c) = pack8(f);
                } else if (seg == 2) {
                    const int g = c >> 4, m0 = c & 15;
                    *(GAS v4u*)(UG + ((size_t)g * 512 + (row >> 4)) * 256 + (row & 15) * 16 + m0) = pack8(f);
                } else {
                    bf16* dst = seg == 0 ? XR : (seg == 3 ? Q : (seg == 4 ? Kb : Vb));
                    *(GAS v4u*)(dst + (size_t)row * 1024 + c) = pack8(f);
                    if (seg >= 4 && row < CTXR) {
                        float* o = (seg == 4 ? outK : outV) + ((size_t)(row >> 8) * 4 * 256 + (row & 255)) * 1024 + c;
                        *(f32x4*)o = v0; *(GAS f32x4*)(o + 4) = v1;
                    }
                }
            }
        EPI_ROWS_END
    }
};
struct EpiRg {
    EPI_NO_MID
    static constexpr bool PERM = true;
    const bf16* XC; const float* gb; const float* sp; f32x2* AB;
    __device__ __forceinline__ void operator()(AccC acc, const Unit& u, int wr, int wc, int fr, int fq) const {
        const int h = u.aux >> 1, d = u.aux & 1, c0 = h * 128 + wc * 32 + 8 * fq;
        const GAS float* gbr = (const GAS float*)(gb + (d * 2 + 0) * 1024 + c0); const GAS float* gbi = (const GAS float*)(gb + (d * 2 + 1) * 1024 + c0); const GAS float* spp = (const GAS float*)(sp + d * 1024 + c0);
        EPI_ROWS_BEGIN
            float xc[8]; unpack8(*(const GAS v4u*)(XC + (size_t)row * 1024 + c0), xc);
            const f32x4 r0 = acc[ai][0][m][0], r1 = acc[ai][0][m][1], i0 = acc[ai][1][m][0], i1 = acc[ai][1][m][1];
            const float rr[8] = {r0[0], r0[1], r0[2], r0[3], r1[0], r1[1], r1[2], r1[3]}, ii[8] = {i0[0], i0[1], i0[2], i0[3], i1[0], i1[1], i1[2], i1[3]};
            f32x2* dst = AB + ((size_t)d * ROWS + row) * 1024 + c0;
#pragma unroll
            for (int e = 0; e < 8; e += 2) {
                f32x4 o;
#pragma unroll
                for (int q = 0; q < 2; ++q) {
                    const float r = fsigmoid(rr[e + q] + gbr[e + q]), ig = fsigmoid(ii[e + q] + gbi[e + q]);
                    const float la = -8.0f * r * spp[e + q]; const float a = __expf(la); const float mult = sqrtf(-expm1f(2.0f * la));
                    o[2 * q] = a; o[2 * q + 1] = mult * ig * xc[e + q];
                }
                *(GAS f32x4*)(dst + e) = o;
            }
            asm volatile("" ::: "memory");
        EPI_ROWS_END
    }
};
struct EpiS5Y {
    EPI_NO_MID
    static constexpr bool PERM = true;
    const bf16* UG; const float* dvec; bf16* ZS;
    __device__ __forceinline__ void operator()(AccC acc, const Unit& u, int wr, int wc, int fr, int fq) const {
        const int g = u.aux;
        EPI_ROWS_BEGIN
#pragma unroll
            for (int bj = 0; bj < 2; ++bj) {
                const int col = bj * 128 + wc * 32 + 8 * fq, t = col >> 4, n0 = col & 15;
                float uu[8]; unpack8(*(const GAS v4u*)(UG + ((size_t)g * 512 + row) * 256 + col), uu);
                const f32x4 v0 = acc[ai][bj][m][0], v1 = acc[ai][bj][m][1];
                float f[8] = {v0[0], v0[1], v0[2], v0[3], v1[0], v1[1], v1[2], v1[3]};
#pragma unroll
                for (int e = 0; e < 8; ++e) f[e] = gelu_tanh(f[e] + ((const GAS float*)dvec)[g * 16 + n0 + e] * uu[e]);
                *(GAS v4u*)(ZS + ((size_t)row * 16 + t) * 1024 + g * 16 + n0) = pack8(f);
            }
        EPI_ROWS_END
    }
};
struct EpiGlu {
    EPI_NO_MID
    static constexpr bool PERM = true;
    const bf16* ZS; bf16* Y;
    __device__ __forceinline__ void operator()(AccC acc, const Unit& u, int wr, int wc, int fr, int fq) const {
        const int col0 = u.pn * 256 + wc * 32 + 8 * fq;
        EPI_ROWS_BEGIN
#pragma unroll
            for (int bj = 0; bj < 2; ++bj) {
                float z[8]; unpack8(*(const GAS v4u*)(ZS + (size_t)row * 1024 + col0 + bj * 128), z);
                const f32x4 v0 = acc[ai][bj][m][0], v1 = acc[ai][bj][m][1];
                float f[8] = {v0[0], v0[1], v0[2], v0[3], v1[0], v1[1], v1[2], v1[3]};
#pragma unroll
                for (int e = 0; e < 8; ++e) f[e] = z[e] * fsigmoid(f[e]);
                *(GAS v4u*)(Y + (size_t)row * 1024 + col0 + bj * 128) = pack8(f);
            }
        EPI_ROWS_END
    }
};
struct EpiMerge {
    static constexpr bool PERM = true;
    const bf16* G; bf16* MM;
    __device__ __forceinline__ void mid(AccM acc, const Unit& u, int wr, int wc, int fr, int fq) const {
        const int col0 = u.pn * 256 + wc * 32 + 8 * fq, b = u.aux;
        EPI_ROWS_BEGIN
#pragma unroll
            for (int bj = 0; bj < 2; ++bj) {
                float ga[8], gn[8]; unpack8(*(const GAS v4u*)(G + (size_t)row * 6144 + b * 2048 + col0 + bj * 128), ga); unpack8(*(const GAS v4u*)(G + (size_t)row * 6144 + (b + 1) * 2048 + col0 + bj * 128), gn);
#pragma unroll
                for (int e = 0; e < 8; ++e) { const float rt = ga[e] * __builtin_amdgcn_rcpf(fmaxf(gn[e], 1e-30f)); acc[ai][bj][m][e >> 2][e & 3] *= rt; }
            }
        EPI_ROWS_END
    }
    __device__ __forceinline__ void operator()(AccC acc, const Unit& u, int wr, int wc, int fr, int fq) const {
        const int col0 = u.pn * 256 + wc * 32 + 8 * fq;
        EPI_ROWS_BEGIN
#pragma unroll
            for (int bj = 0; bj < 2; ++bj) {
                float g2[8]; unpack8(*(const GAS v4u*)(G + (size_t)row * 6144 + 2 * 2048 + col0 + bj * 128), g2);
                const f32x4 v0 = acc[ai][bj][m][0], v1 = acc[ai][bj][m][1];
                float f[8] = {v0[0], v0[1], v0[2], v0[3], v1[0], v1[1], v1[2], v1[3]};
#pragma unroll
                for (int e = 0; e < 8; ++e) f[e] *= g2[e];
                *(GAS v4u*)(MM + (size_t)row * 2048 + col0 + bj * 128) = pack8(f);
            }
        EPI_ROWS_END
    }
};
struct EpiSwiglu {
    EPI_NO_MID
    static constexpr bool PERM = true;
    bf16* FH;
    __device__ __forceinline__ void operator()(AccC acc, const Unit& u, int wr, int wc, int fr, int fq) const {
        const int col0 = u.pn * 128 + wc * 32 + 8 * fq;
        EPI_ROWS_BEGIN
            const f32x4 a0 = acc[ai][0][m][0], a1 = acc[ai][0][m][1], b0 = acc[ai][1][m][0], b1 = acc[ai][1][m][1];
            const float av[8] = {a0[0], a0[1], a0[2], a0[3], a1[0], a1[1], a1[2], a1[3]}, bv[8] = {b0[0], b0[1], b0[2], b0[3], b1[0], b1[1], b1[2], b1[3]};
            float f[8];
#pragma unroll
            for (int e = 0; e < 8; ++e) f[e] = av[e] * fsigmoid(av[e]) * bv[e];
            *(GAS v4u*)(FH + (size_t)row * FFH + col0) = pack8(f);
        EPI_ROWS_END
    }
};

struct SchedPlain {
    const char* A; const char* B; int nM, nN, G, c; size_t tA, tB; int dup;
    __device__ __forceinline__ bool next(int i, Unit& u) const { int pm, pn; const int q = i / (dup * DUP_GEMM), r = i - q * (dup * DUP_GEMM); long L = (long)q * G + c; const int nwg = nM * nN; if (L >= nwg) return false;
        if (r) L = (L + nwg / 2 + 8) % nwg;
        if (!tile_order(L, nM, nN, pm, pn)) return false; u.A = A + (size_t)pm * tA; u.B = B + (size_t)pn * tB; u.pm = pm; u.pn = pn; u.aux = 0; u.last = 1; return true; }
};
struct SchedMerge {
    const char* A0; const char* A1; const char* A2; const char* B; int G, c;
    __device__ __forceinline__ bool next(int i, Unit& u) const { const int ti = i / 3, b = i - ti * 3; int pm, pn; const int q = ti / (DUPG6 * DUP_GEMM), r = ti - q * (DUPG6 * DUP_GEMM); long L = (long)q * G + c; if (L >= 256) return false; if (r) L = (L + 136) % 256;
        if (!tile_order(L, 32, 8, pm, pn)) return false;
        const char* Ab = b == 0 ? A0 : (b == 1 ? A1 : A2); u.A = Ab + (size_t)pm * 256 * 1024 * 2; u.B = B + ((size_t)b * 2048 + pn * 256) * 1024 * 2; u.pm = pm; u.pn = pn; u.aux = b; u.last = (b == 2); return true; }
};
struct SchedS5E {
    const char* UG; const char* ET; int G, c;
    __device__ __forceinline__ bool next(int i, Unit& u) const { const int L = (i / DUP_S5) * G + c; if (L >= 128) return false; const int g = L >> 1, pm = L & 1;
        u.A = UG + ((size_t)g * 512 + pm * 256) * 256 * 2; u.B = ET + (size_t)g * 256 * 256 * 2; u.pm = pm; u.pn = 0; u.aux = g; u.last = 1; return true; }
};
struct SchedS5Y {
    const char* UG; const char* HIN; const char* MT; const char* FT; int G, c;
    __device__ __forceinline__ bool next(int i, Unit& u) const { const int ti = (i >> 1) / DUP_S5, part = i & 1, L = ti * G + c; if (L >= 128) return false; const int g = L >> 1, pm = L & 1;
        u.A = (part ? HIN : UG) + ((size_t)g * 512 + pm * 256) * 256 * 2; u.B = (part ? FT : MT) + (size_t)g * 256 * 256 * 2; u.pm = pm; u.pn = 0; u.aux = g; u.last = part; return true; }
};
struct SchedOne {
    const char* A0; const char* B0; const char* A1; const char* B1; int pm, aux, nparts;
    __device__ __forceinline__ bool next(int i, Unit& u) const { if (i >= nparts) return false; u.A = i ? A1 : A0; u.B = i ? B1 : B0; u.pm = pm; u.pn = 0; u.aux = aux; u.last = (i == nparts - 1); return true; }
};
struct SchedRg {
    const char* XC; const char* GWT; int G, c;
    __device__ __forceinline__ bool next(int i, Unit& u) const { const int L = (i / DUP_RGG) * G + c; if (L >= 512) return false; const int pm = L & 31, hd = L >> 5;
        u.A = XC + ((size_t)pm * 256 * 1024 + (hd >> 1) * 128) * 2; u.B = GWT + (size_t)hd * 256 * 128 * 2; u.pm = pm; u.pn = 0; u.aux = hd; u.last = 1; return true; }
};
}

namespace att {
using bf16x8 = __attribute__((ext_vector_type(8))) short;
using s16x4  = __attribute__((ext_vector_type(4))) short;
using f32x16 = __attribute__((ext_vector_type(16))) float;
using u32x4  = __attribute__((ext_vector_type(4))) unsigned;
constexpr int D = 128, NW = 8, QBLK = 32, KVBLK = 64, LD = 1024;
constexpr float SCALE = 0.088388347648318440f, THR = 8.f;
constexpr size_t SHM_V = KVBLK * D * 2, SHM_K = KVBLK * D * 2, SHM_ATTN = 2 * SHM_V + 2 * SHM_K + NW * 64 * 4;
constexpr int RPB_OFF = (int)SHM_ATTN + 256;
#define KSWZ(row, colB) ((row) * 256 + ((colB) ^ (((row) & 7) << 4)))
#define SBAR() __builtin_amdgcn_sched_barrier(0)
__device__ __forceinline__ int crow(int r, int hi) { return (r & 3) + 8 * (r >> 2) + 4 * hi; }
__device__ __forceinline__ unsigned cvtpk(float lo, float hi) { return pk2(lo, hi); }
__device__ __forceinline__ void partialSM(f32x16& p0, f32x16& p1, float& m_reg, float& mn, float& alpha) {
  constexpr float C = SCALE * 1.4426950408889634f;
  float pmax = p0[0]; for (int r = 1; r < 16; ++r) pmax = fmaxf(pmax, p0[r]); for (int r = 0; r < 16; ++r) pmax = fmaxf(pmax, p1[r]);
  { auto rr = __builtin_amdgcn_permlane32_swap(__float_as_uint(pmax), __float_as_uint(pmax), false, false);
    pmax = fmaxf(__uint_as_float(rr[0]), __uint_as_float(rr[1])); }
  if (__builtin_expect(__all(pmax - m_reg <= THR / SCALE), 1)) { mn = m_reg; alpha = 1.f; }
  else { mn = fmaxf(m_reg, pmax); alpha = __builtin_amdgcn_exp2f((m_reg - mn) * C); m_reg = mn; }
  float mnC = -mn * C;
  for (int r = 0; r < 16; ++r) p0[r] = fmaf(p0[r], C, mnC); for (int r = 0; r < 16; ++r) p1[r] = fmaf(p1[r], C, mnC);
  for (int r = 0; r < 16; ++r) p0[r] = __builtin_amdgcn_exp2f(p0[r]);
}
__device__ __forceinline__ void finishSM(f32x16& p0, f32x16& p1, float alpha, float& l_reg, bf16x8& pa0, bf16x8& pa1, bf16x8& pa2, bf16x8& pa3) {
  for (int r = 0; r < 16; ++r) p1[r] = __builtin_amdgcn_exp2f(p1[r]);
  float ps = 0; for (int r = 0; r < 16; ++r) ps += p0[r]; for (int r = 0; r < 16; ++r) ps += p1[r];
  { auto rr = __builtin_amdgcn_permlane32_swap(__float_as_uint(ps), __float_as_uint(ps), false, false);
    ps = __uint_as_float(rr[0]) + __uint_as_float(rr[1]); }
  l_reg = l_reg * alpha + ps;
#define PK4(P, BASE, OUT) do { unsigned a0 = cvtpk(P[BASE + 0], P[BASE + 1]), a1 = cvtpk(P[BASE + 2], P[BASE + 3]);   \
    unsigned b0 = cvtpk(P[BASE + 4], P[BASE + 5]), b1 = cvtpk(P[BASE + 6], P[BASE + 7]);                              \
    auto r0 = __builtin_amdgcn_permlane32_swap(a0, b0, false, false); auto r1 = __builtin_amdgcn_permlane32_swap(a1, b1, false, false); \
    u32x4 w = {r0[0], r1[0], r0[1], r1[1]}; OUT = *reinterpret_cast<bf16x8*>(&w); } while (0)
  PK4(p0, 0, pa0); PK4(p0, 8, pa1); PK4(p1, 0, pa2); PK4(p1, 8, pa3);
#undef PK4
}
__device__ __forceinline__ void qkt(f32x16& p0, f32x16& p1, const bf16* Ks, const bf16x8* qr, int r32, int hi) {
  p0 = f32x16{}; p1 = f32x16{};
  for (int d0 = 0; d0 < 8; ++d0) { int cb = (d0 * 16 + hi * 8) * 2;
    bf16x8 b0 = *reinterpret_cast<const bf16x8*>((const char*)Ks + KSWZ(r32, cb));
    bf16x8 b1 = *reinterpret_cast<const bf16x8*>((const char*)Ks + KSWZ(32 + r32, cb));
    p0 = __builtin_amdgcn_mfma_f32_32x32x16_bf16(b0, qr[d0], p0, 0, 0, 0);
    p1 = __builtin_amdgcn_mfma_f32_32x32x16_bf16(b1, qr[d0], p1, 0, 0, 0); }
}
__device__ __forceinline__ int v_st(int k, int c) { const int kk = (k & ~0xC) | ((k & 4) << 1) | ((k & 8) >> 1); return ((kk >> 3) * 4 + (c >> 5)) * 512 + ((kk & 7) * 32 + (c & 31)) * 2; }
__device__ __forceinline__ int v_rd_base(int lane) { return ((lane & 3) << 3) | (((lane >> 2) & 3) << 6) | (((lane >> 4) & 1) << 5) | (((lane >> 5) & 1) << 8); }
constexpr int v_rd_off(int d0, int ks, int half) { return d0 * 512 + ks * 4096 + half * 2048; }
template <int OFF> __device__ __forceinline__ s16x4 tr_read(int vb) {
  s16x4 r; asm volatile("ds_read_b64_tr_b16 %0, %1 offset:%2" : "=&v"(r) : "v"(vb), "i"(OFF) : "memory"); return r;
}
template <int D0> __device__ __forceinline__ void pv_one(f32x16& od, int vb, bf16x8 pa0, bf16x8 pa1, bf16x8 pa2, bf16x8 pa3) {
  const s16x4 l0 = tr_read<v_rd_off(D0, 0, 0)>(vb), h0 = tr_read<v_rd_off(D0, 0, 1)>(vb), l1 = tr_read<v_rd_off(D0, 1, 0)>(vb), h1 = tr_read<v_rd_off(D0, 1, 1)>(vb);
  const s16x4 l2 = tr_read<v_rd_off(D0, 2, 0)>(vb), h2 = tr_read<v_rd_off(D0, 2, 1)>(vb), l3 = tr_read<v_rd_off(D0, 3, 0)>(vb), h3 = tr_read<v_rd_off(D0, 3, 1)>(vb);
  asm volatile("s_waitcnt lgkmcnt(0)" ::: "memory"); SBAR();
#define PK(L, H) (bf16x8){L[0], L[1], L[2], L[3], H[0], H[1], H[2], H[3]}
  od = __builtin_amdgcn_mfma_f32_32x32x16_bf16(pa0, PK(l0, h0), od, 0, 0, 0);
  od = __builtin_amdgcn_mfma_f32_32x32x16_bf16(pa1, PK(l1, h1), od, 0, 0, 0);
  od = __builtin_amdgcn_mfma_f32_32x32x16_bf16(pa2, PK(l2, h2), od, 0, 0, 0);
  od = __builtin_amdgcn_mfma_f32_32x32x16_bf16(pa3, PK(l3, h3), od, 0, 0, 0);
#undef PK
}
__device__ __forceinline__ void pv_d0(f32x16* o, int vb, bf16x8 pa0, bf16x8 pa1, bf16x8 pa2, bf16x8 pa3) {
  pv_one<0>(o[0], vb, pa0, pa1, pa2, pa3); pv_one<1>(o[1], vb, pa0, pa1, pa2, pa3); pv_one<2>(o[2], vb, pa0, pa1, pa2, pa3); pv_one<3>(o[3], vb, pa0, pa1, pa2, pa3);
}
__device__ __forceinline__ void na_mask(f32x16& p0, f32x16& p1, int kr, int qr, int rs, int ws, const float* rpbl, int hi) {
  if (kr < rs || kr >= rs + 8) {
#pragma unroll
    for (int r = 0; r < 16; ++r) { p0[r] = -1e30f; p1[r] = -1e30f; }
  } else {
    const float* row = rpbl + (kr - qr + 7) * 31 + 4 * hi; const unsigned w0 = (unsigned)(4 * hi - ws);
#pragma unroll
    for (int r = 0; r < 16; ++r) {
      const int kc = (r & 3) + 8 * (r >> 2);
      const float b0 = row[kc], b1 = row[kc + 32];
      p0[r] = (w0 + (unsigned)kc < 16u) ? p0[r] + b0 : -1e30f; p1[r] = (w0 + (unsigned)(kc + 32) < 16u) ? p1[r] + b1 : -1e30f;
      if ((r & 3) == 3) SBAR();
    }
  }
}
template <bool NA, int SD>
__device__ __forceinline__ void attn_body(const bf16* __restrict__ Qb, const bf16* __restrict__ K0, const bf16* __restrict__ V0, const bf16* __restrict__ K1, const bf16* __restrict__ V1,
                                          bf16* __restrict__ Ob, const int NT, const int lo, const int rg, char* lds) {
  int tid_ = threadIdx.x; asm volatile("" : "+v"(tid_));
  const int tid = tid_, wid = tid >> 6, lane = tid & 63, r32 = lane & 31, hi = lane >> 5;
  bf16* V_lds = (bf16*)lds; bf16* K_lds = (bf16*)(lds + 2 * SHM_V);
  float* ws_ = (float*)(lds + 2 * SHM_V + 2 * SHM_K) + wid * 64; float* li_l = ws_; float* al_l = ws_ + 32;
  const int qrow = 4 * rg + (wid >> 1), qc = 32 * (wid & 1) + r32;
  const int rs = qrow - 4 < 0 ? 0 : (qrow - 4 > 8 ? 8 : qrow - 4), wsn = qc - 8 < 0 ? 0 : (qc - 8 > 48 ? 48 : qc - 8);
  const float* rpbl = (const float*)(lds + RPB_OFF) + 15 - qc;
  float m_reg = -1e30f, l_reg = 0; f32x16 o[4] = {}; bf16x8 qr[8];
  const bf16* Qw = Qb + (long)(wid * QBLK + r32) * LD + hi * 8;
#pragma unroll
  for (int d0 = 0; d0 < 8; ++d0) qr[d0] = *(const GAS bf16x8*)(Qw + d0 * 16);
  const int sr = tid >> 4, sc = (tid & 15) * 8, vst0 = v_st(sr, sc), vst1 = v_st(32 + sr, sc);
  const int vb0 = (int)(uintptr_t)V_lds + v_rd_base(lane);
  struct { bf16x8 vs0, vs1, ks0, ks1; } sr_[SD];
#define TILEK(t) ((NA && (t) >= 8) ? K1 + (long)((t) - 8) * 64 * LD : K0 + (long)(t) * 64 * LD)
#define TILEV(t) ((NA && (t) >= 8) ? V1 + (long)((t) - 8) * 64 * LD : V0 + (long)(t) * 64 * LD)
#define SLOAD(i, t) do { const bf16* kp_ = TILEK(t); const bf16* vp_ = TILEV(t); \
    sr_[i].vs0 = *(const GAS bf16x8*)(&vp_[(long)sr * LD + sc]); sr_[i].vs1 = *(const GAS bf16x8*)(&vp_[(long)(32 + sr) * LD + sc]); \
    sr_[i].ks0 = *(const GAS bf16x8*)(&kp_[(long)sr * LD + sc]); sr_[i].ks1 = *(const GAS bf16x8*)(&kp_[(long)(32 + sr) * LD + sc]); } while (0)
#define SWRITE(b, i) do { *(bf16x8*)((char*)V_lds + (b) * SHM_V + vst0) = sr_[i].vs0;          \
    *(bf16x8*)((char*)V_lds + (b) * SHM_V + vst1) = sr_[i].vs1; int kc = sc * 2;               \
    *(bf16x8*)((char*)K_lds + (b) * SHM_K + KSWZ(sr, kc)) = sr_[i].ks0;                       \
    *(bf16x8*)((char*)K_lds + (b) * SHM_K + KSWZ(32 + sr, kc)) = sr_[i].ks1; } while (0)
#define SWAIT() do { if constexpr (SD == 2) asm volatile("s_waitcnt vmcnt(4)" ::: "memory"); else asm volatile("s_waitcnt vmcnt(0)" ::: "memory"); } while (0)
#define RESC(a) do { if (__any((a) < 1.f)) { if (hi == 0) al_l[r32] = (a); asm volatile("s_waitcnt lgkmcnt(0)" ::: "memory"); \
    for (int d = 0; d < 4; ++d) for (int r = 0; r < 16; ++r) o[d][r] *= al_l[crow(r, hi)]; } } while (0)
#define MASK(P0, P1, t) do { if (NA && (t) >= 8) na_mask(P0, P1, lo + (t) - 8, qrow, rs, wsn, rpbl, hi); } while (0)
  f32x16 pA0, pA1, pB0, pB1; float mnA, mnB, alA, alB; bf16x8 pa0, pa1, pa2, pa3;
  constexpr int SE = 0, SO = SD - 1;
  SLOAD(SE, 0); asm volatile("s_waitcnt vmcnt(0)" ::: "memory"); SWRITE(0, SE); __syncthreads();
  qkt(pA0, pA1, K_lds, qr, r32, hi); partialSM(pA0, pA1, m_reg, mnA, alA);
  SLOAD(SO, 1); if constexpr (SD == 2) { if (2 < NT) SLOAD(SE, 2); }
  SWAIT(); SWRITE(1, SO); __syncthreads();
  for (int j = 1; j + 1 < NT; j += 2) {
    SBAR(); qkt(pB0, pB1, (bf16*)((char*)K_lds + SHM_K), qr, r32, hi); MASK(pB0, pB1, j);
    finishSM(pA0, pA1, alA, l_reg, pa0, pa1, pa2, pa3); SBAR();
    SLOAD(SO, j + SD); SBAR();
    pv_d0(o, vb0, pa0, pa1, pa2, pa3); partialSM(pB0, pB1, m_reg, mnB, alB);
    __syncthreads(); SWAIT(); SWRITE(0, SE);
    RESC(alB); __syncthreads();
    SBAR(); qkt(pA0, pA1, K_lds, qr, r32, hi); MASK(pA0, pA1, j + 1);
    finishSM(pB0, pB1, alB, l_reg, pa0, pa1, pa2, pa3); SBAR();
    if (SD == 1 || j + 3 < NT) SLOAD(SE, j + 1 + SD); SBAR();
    pv_d0(o, vb0 + (int)SHM_V, pa0, pa1, pa2, pa3); partialSM(pA0, pA1, m_reg, mnA, alA);
    __syncthreads(); SWAIT(); SWRITE(1, SO);
    RESC(alA); __syncthreads();
  }
  SBAR(); qkt(pB0, pB1, (bf16*)((char*)K_lds + SHM_K), qr, r32, hi); MASK(pB0, pB1, NT - 1);
  finishSM(pA0, pA1, alA, l_reg, pa0, pa1, pa2, pa3); SBAR();
  pv_d0(o, vb0, pa0, pa1, pa2, pa3); partialSM(pB0, pB1, m_reg, mnB, alB);
  __syncthreads(); RESC(alB);
  finishSM(pB0, pB1, alB, l_reg, pa0, pa1, pa2, pa3); SBAR();
  pv_d0(o, vb0 + (int)SHM_V, pa0, pa1, pa2, pa3);
  if (hi == 0) li_l[r32] = l_reg; asm volatile("s_waitcnt lgkmcnt(0)" ::: "memory");
  float rli[16];
#pragma unroll
  for (int r = 0; r < 16; ++r) rli[r] = __builtin_amdgcn_rcpf(li_l[crow(r, hi)]);
  bf16* Ow = Ob + (long)(wid * QBLK) * LD;
#pragma unroll
  for (int r = 0; r < 16; ++r) { int orow = crow(r, hi);
    for (int d0 = 0; d0 < 4; ++d0) *(GAS bf16*)(Ow + (long)orow * LD + d0 * 32 + r32) = (bf16)f2bf(o[d0][r] * rli[r]); }
  asm volatile("s_waitcnt vmcnt(0)" ::: "memory"); __syncthreads();
#undef TILEK
#undef TILEV
#undef SLOAD
#undef SWRITE
#undef SWAIT
#undef RESC
#undef MASK
}
}

constexpr int NWAVES = 8;
struct Args { const float* in[36]; float* out; unsigned char* ws; int ph_lo, ph_hi; };
struct Frame { LAS unsigned char* lds; char* ldsg; volatile LAS unsigned* MISC; int tid, lane, wave, vcu, G; };
constexpr int INTAB_OFF = MISC_OFF + 128;
__device__ __forceinline__ const float* ld_in(const LAS unsigned char* lds, int i) { const unsigned long long v = ((const LAS unsigned long long*)(lds + INTAB_OFF))[i];
    const unsigned lo = __builtin_amdgcn_readfirstlane((unsigned)v), hi = __builtin_amdgcn_readfirstlane((unsigned)(v >> 32)); return (const float*)(((unsigned long long)hi << 32) | lo); }
#define IN(i) ld_in(F.lds, (i))

__device__ __forceinline__ void transpose_item(const float* W, int N, int k0, int n0, bf16* WT, int ldo, int drow0, float* scr, int lane) {
    const int kr = lane >> 3, n4 = (lane & 7) * 4;
    f32x4 v[8];
#pragma unroll
    for (int i = 0; i < 8; ++i) v[i] = *(const GAS f32x4*)(W + (size_t)(k0 + kr + 8 * i) * N + n0 + n4);
#pragma unroll
    for (int i = 0; i < 8; ++i) { float* d = scr + (kr + 8 * i) * 33 + n4; d[0] = v[i].x; d[1] = v[i].y; d[2] = v[i].z; d[3] = v[i].w; }
    LDS_WAIT(); asm volatile("" ::: "memory");
    const int c = lane & 7;
#pragma unroll
    for (int j = 0; j < 4; ++j) { const int n = (lane >> 3) + 8 * j; const float* s = scr + (8 * c) * 33 + n;
        v4u o; o.x = pk2(s[0 * 33], s[1 * 33]); o.y = pk2(s[2 * 33], s[3 * 33]); o.z = pk2(s[4 * 33], s[5 * 33]); o.w = pk2(s[6 * 33], s[7 * 33]);
        *(GAS v4u*)(WT + (size_t)(drow0 + n) * ldo + k0 + 8 * c) = o; }
    LDS_WAIT(); asm volatile("" ::: "memory");
}

__device__ __forceinline__ int cv_of_row(int row) { return row < CTXR ? 0 : 1 + ((row - CTXR) >> 10); }

template <bool FIRST, bool HASNEXT>
__device__ __forceinline__ void resnorm_rows(const Frame& F, const float* xin0, const float* xin1, float* X, const bf16* Z, const float* gpost, const float* modGate  ,
                                             const float* gpre, const float* modShift, const float* modScale, bf16* H) {
    const int gw = F.vcu * NWAVES + F.wave, NGW = F.G * NWAVES;
    for (int row = gw; row < ROWS; row += NGW) {
        const int cv = cv_of_row(row);
        f32x4 x[8];
        if (FIRST) {
            const GAS f32x4* src = (const GAS f32x4*)(row < CTXR ? xin0 + (size_t)row * DM : xin1 + (size_t)(row - CTXR) * DM);
#pragma unroll
            for (int j = 0; j < 8; ++j) x[j] = src[2 * (F.lane + 64 * (j >> 1)) + (j & 1)];
        } else {
            const GAS v4u* zr = (const GAS v4u*)(Z + (size_t)row * DM); const GAS f32x4* xr = (const GAS f32x4*)(X + (size_t)row * DM);
            f32x4 z[8]; float ss = 0.f;
#pragma unroll
            for (int jj = 0; jj < 4; ++jj) { float f[8]; unpack8(zr[F.lane + 64 * jj], f); z[2 * jj] = (f32x4){f[0], f[1], f[2], f[3]}; z[2 * jj + 1] = (f32x4){f[4], f[5], f[6], f[7]}; }
#pragma unroll
            for (int j = 0; j < 8; ++j) ss += (z[j].x * z[j].x + z[j].y * z[j].y) + (z[j].z * z[j].z + z[j].w * z[j].w);
            const float rstd = rsqrtf(wave_sum(ss, F.lane) * (1.f / DM) + RMS_EPS);
#pragma unroll
            for (int j = 0; j < 8; ++j) { const int q = 2 * (F.lane + 64 * (j >> 1)) + (j & 1); const f32x4 gp = ((const GAS f32x4*)gpost)[q], gt = ((const GAS f32x4*)(modGate + (size_t)cv * 12288))[q];
                x[j] = xr[q] + gt * (z[j] * rstd * gp); }
        }
        { GAS f32x4* xo = (GAS f32x4*)(X + (size_t)row * DM);
#pragma unroll
          for (int j = 0; j < 8; ++j) xo[2 * (F.lane + 64 * (j >> 1)) + (j & 1)] = x[j]; }
        if (HASNEXT) {
            float ss = 0.f;
#pragma unroll
            for (int j = 0; j < 8; ++j) ss += (x[j].x * x[j].x + x[j].y * x[j].y) + (x[j].z * x[j].z + x[j].w * x[j].w);
            const float rstd = rsqrtf(wave_sum(ss, F.lane) * (1.f / DM) + RMS_EPS);
            GAS v4u* ho = (GAS v4u*)(H + (size_t)row * DM);
#pragma unroll
            for (int jj = 0; jj < 4; ++jj) { float f[8];
#pragma unroll
                for (int h = 0; h < 2; ++h) { const int q = 2 * (F.lane + 64 * jj) + h; const f32x4 g = ((const GAS f32x4*)gpre)[q], sh = ((const GAS f32x4*)(modShift + (size_t)cv * 12288))[q], sc = ((const GAS f32x4*)(modScale + (size_t)cv * 12288))[q];
                    const f32x4 hv = x[2 * jj + h] * rstd * g * (sc + 1.0f) + sh; f[4 * h] = hv.x; f[4 * h + 1] = hv.y; f[4 * h + 2] = hv.z; f[4 * h + 3] = hv.w; }
                ho[F.lane + 64 * jj] = pack8(f); }
        }
    }
}

__device__ __forceinline__ void s5_tables(const Frame& F, int l, int g, unsigned char* ws) {
    char* L = F.ldsg;
    f32x2* POW = (f32x2*)L;
    f32x2* BB = (f32x2*)(L + 17408);
    f32x2* CC = (f32x2*)(L + 17408 + 16384);
    float* KT = (float*)(L + 17408 + 32768);
    const int tid = F.tid;
    __syncthreads();
    if (tid < 128) {
        const int d = tid >> 6, p = tid & 63; const size_t li = ((size_t)(l * 2 + d) * 64 + g) * 64 + p;
        const float dt = expf(IN(22)[(l * 2 + d) * 64 + g]); const float lre = IN(20)[li], lim = IN(21)[li];
        const float er = expf(lre * dt); float sn, cs; sincosf(lim * dt, &sn, &cs);
        const float br = er * cs, bi = er * sn;
        const float nr = br - 1.0f, ni = bi, den = lre * lre + lim * lim;
        const float cr = (nr * lre + ni * lim) / den, ci = (ni * lre - nr * lim) / den;
        float pr = 1.f, pi = 0.f;
        for (int t = 0; t <= 16; ++t) { POW[(d * 64 + p) * 17 + t] = (f32x2){pr, pi}; const float nr2 = pr * br - pi * bi, ni2 = pr * bi + pi * br; pr = nr2; pi = ni2; }
        ((f32x2*)(ws + WS_LT))[li] = POW[(d * 64 + p) * 17 + 16];
        for (int m = 0; m < 16; ++m) { const float xr = IN(23)[li * 16 + m], xi = IN(24)[li * 16 + m]; BB[(d * 64 + p) * 16 + m] = (f32x2){cr * xr - ci * xi, cr * xi + ci * xr}; }
    }
    for (int i = tid; i < 2048; i += 512) { const int d = i >> 10, n = (i >> 6) & 15, p = i & 63; const size_t ci_ = (((size_t)(l * 2 + d) * 64 + g) * 16 + n) * 64 + p; CC[i] = (f32x2){IN(25)[ci_], IN(26)[ci_]}; }
    __syncthreads();
    for (int i = tid; i < 8192; i += 512) {
        const int d = i >> 12, tau = (i >> 8) & 15, n = (i >> 4) & 15, m = i & 15; float s = 0.f;
        for (int p = 0; p < 64; ++p) { const f32x2 c = CC[(d * 16 + n) * 64 + p], w = POW[(d * 64 + p) * 17 + tau], b = BB[(d * 64 + p) * 16 + m];
            const float tr = c.x * w.x - c.y * w.y, ti = c.x * w.y + c.y * w.x; s += tr * b.x - ti * b.y; }
        KT[i] = s;
    }
    __syncthreads();
    bf16* MT = (bf16*)(ws + WS_MT) + (size_t)(l * 64 + g) * 65536; bf16* ET = (bf16*)(ws + WS_ET) + (size_t)(l * 64 + g) * 65536; bf16* FT = (bf16*)(ws + WS_FT) + (size_t)(l * 64 + g) * 65536;
    for (int i = tid; i < 8192; i += 512) {
        const int rowi = i >> 5, k0 = (i & 31) * 8;
        { const int t = rowi >> 4, n = rowi & 15, s = k0 >> 4, m0 = k0 & 15; float f[8];
#pragma unroll
          for (int e = 0; e < 8; ++e) { float v = 0.f; if (s <= t) v += KT[((0 * 16 + (t - s)) * 16 + n) * 16 + m0 + e]; if (s >= t) v += KT[((1 * 16 + (s - t)) * 16 + n) * 16 + m0 + e]; f[e] = v; }
          *(GAS v4u*)(MT + (size_t)rowi * 256 + k0) = pack8(f); }
        { const int d = rowi >> 7, p = (rowi >> 1) & 63, c = rowi & 1, s = k0 >> 4, m0 = k0 & 15; float f[8];
          const f32x2 w = POW[(d * 64 + p) * 17 + (d == 0 ? 15 - s : s)];
#pragma unroll
          for (int e = 0; e < 8; ++e) { const f32x2 b = BB[(d * 64 + p) * 16 + m0 + e]; f[e] = c == 0 ? (w.x * b.x - w.y * b.y) : (w.x * b.y + w.y * b.x); }
          *(GAS v4u*)(ET + (size_t)rowi * 256 + k0) = pack8(f); }
        { const int t = rowi >> 4, n = rowi & 15; float f[8];
#pragma unroll
          for (int e = 0; e < 8; ++e) { const int k = k0 + e, d = k >> 7, p = (k >> 1) & 63, c = k & 1; const f32x2 cc = CC[(d * 16 + n) * 64 + p], w = POW[(d * 64 + p) * 17 + (d == 0 ? t + 1 : 16 - t)];
              f[e] = c == 0 ? (cc.x * w.x - cc.y * w.y) : -(cc.x * w.y + cc.y * w.x); }
          *(GAS v4u*)(FT + (size_t)rowi * 256 + k0) = pack8(f); }
    }
    __syncthreads();
}

constexpr int I_WIN = 32 * 384, I_GLU = 16 * 32, I_OUT = 16 * 64, I_WO = 32 * 64, I_FIN = 32 * 352, I_FOUT = 88 * 64, I_GW = 32 * 8;
constexpr int I_LAYER = I_WIN + I_GLU + 3 * I_OUT + I_WO + I_FIN + I_FOUT + I_GW;
__device__ __forceinline__ void weight_item(const Frame& F, unsigned char* ws, int l, int r, float* scr) {
    if (r < I_WIN) { const int kb = r / 384, nb = r % 384; transpose_item(IN(14) + (size_t)l * DM * INW, INW, kb * 64, nb * 32, (bf16*)(ws + WS_WINT) + (size_t)l * INW * DM, DM, nb * 32, scr, F.lane); return; } r -= I_WIN;
    if (r < I_GLU) { const int kb = r / 32, nb = r % 32; transpose_item(IN(28) + (size_t)l * 1024 * 1024, 1024, kb * 64, nb * 32, (bf16*)(ws + WS_GLUT) + (size_t)l * 1024 * 1024, 1024, nb * 32, scr, F.lane); return; } r -= I_GLU;
    if (r < 3 * I_OUT) { const int b = r / I_OUT, q = r % I_OUT, kb = q / 64, nb = q % 64; transpose_item(IN(30 + b) + (size_t)l * 1024 * DM, DM, kb * 64, nb * 32, (bf16*)(ws + WS_OUTT) + ((size_t)l * 3 + b) * DM * 1024, 1024, nb * 32, scr, F.lane); return; } r -= 3 * I_OUT;
    if (r < I_WO) { const int kb = r / 64, nb = r % 64; transpose_item(IN(33) + (size_t)l * DM * DM, DM, kb * 64, nb * 32, (bf16*)(ws + WS_WOT) + (size_t)l * DM * DM, DM, nb * 32, scr, F.lane); return; } r -= I_WO;
    if (r < I_FIN) { const int kb = r / 352, nb = r % 352; const int n0 = nb * 32, half = n0 >= FFH, j = n0 - half * FFH; const int drow = 256 * (j >> 7) + 128 * half + (j & 127);
        transpose_item(IN(34) + (size_t)l * DM * 2 * FFH, 2 * FFH, kb * 64, n0, (bf16*)(ws + WS_FINT) + (size_t)l * 2 * FFH * DM, DM, drow, scr, F.lane); return; } r -= I_FIN;
    if (r < I_FOUT) { const int kb = r / 64, nb = r % 64; transpose_item(IN(35) + (size_t)l * FFH * DM, DM, kb * 64, nb * 32, (bf16*)(ws + WS_FOUTT) + (size_t)l * DM * FFH, FFH, nb * 32, scr, F.lane); return; } r -= I_FOUT;
    { const int mi = r >> 3, q = r & 7, kb = q >> 2, nb = q & 3;
      const int d = mi >> 4, g = (mi >> 3) & 1, h = mi & 7;
      transpose_item(IN(17) + ((size_t)l * 32 + mi) * 128 * 128, 128, kb * 64, nb * 32, (bf16*)(ws + WS_GWT) + (((size_t)l * 8 + h) * 2 + d) * 256 * 128, 128, g * 128 + nb * 32, scr, F.lane); }
}
constexpr int QB = 16;
static_assert(I_LAYER % QB == 0, "queue batch");
constexpr int Q_P2 = 562 * QB, Q_P3 = 624 * QB, Q_P4 = 1374 * QB, Q_P5 = 1813 * QB, Q_P9 = I_LAYER;
constexpr int CW_Q = 8192;
__device__ __forceinline__ void pull_weight_items(const Frame& F, unsigned char* ws, int l, int upto) {
    if (l >= NL) return;
    unsigned* ctr = (unsigned*)(ws + WS_CTL) + CW_Q + 64 * l; float* scr = (float*)(F.ldsg + F.wave * 16384);
    const int upto_b = upto / QB;
    for (;;) {
        unsigned i = 0;
        if (F.lane == 0) asm volatile("global_atomic_add %0, %1, %2, off sc0\n\ts_waitcnt vmcnt(0)" : "=&v"(i) : "v"(ctr), "v"(1u) : "memory");
        i = (unsigned)__builtin_amdgcn_readfirstlane((int)i);
        if ((int)i >= upto_b) { if (F.lane == 0) asm volatile("global_atomic_sub %0, %1, off" :: "v"(ctr), "v"(1u) : "memory"); break; }
        for (int j = 0; j < QB; ++j) weight_item(F, ws, l, (int)i * QB + j, scr);
    }
}

constexpr int SQ_P5 = 6, SQ_P9 = 10, SQ_END = (SQ_P5 + SQ_P9) * 1024;
__device__ __forceinline__ void static_weight_items(const Frame& F, unsigned char* ws, int l, int c, int G, int k0, int nk) {
    if (l >= NL || G != 256 || c < 128) return;
    float* scr = (float*)(F.ldsg + F.wave * 16384); const int w = (c - 128) * 8 + F.wave;
    for (int k = 0; k < nk; ++k) weight_item(F, ws, l, (k0 + k) * 1024 + w, scr);
}

__global__ void __launch_bounds__(NWAVES * 64, 2) fwd_kernel(Args args) {
    extern __shared__ __attribute__((aligned(16))) unsigned char lds[];
    const int G0 = gridDim.x, c0 = (int)blockIdx.x;
    volatile LAS unsigned* MISC0 = (volatile LAS unsigned*)((LAS unsigned char*)lds + MISC_OFF);
    unsigned char* const ws0 = args.ws; float* const out0 = args.out;
    gu32* ctl = (gu32*)(ws0 + WS_CTL);
    for (int u = threadIdx.x; u < (LDS_BYTES - LDSCTL_OFF) / 4; u += NWAVES * 64) ((LAS unsigned*)((LAS unsigned char*)lds + LDSCTL_OFF))[u] = 0u;
    __syncthreads();
    if (threadIdx.x == 0) {
#pragma unroll
        for (int i = 0; i < 36; ++i) ((LAS unsigned long long*)((LAS unsigned char*)lds + INTAB_OFF))[i] = (unsigned long long)args.in[i]; }
    __syncthreads();
    XcdBarrier bar; bar.bar = (unsigned*)(ctl + CW_BAR); bar.x = 0; bar.st = nullptr;
    if (MK_N_LAUNCHES == 1) bar = xcd_barrier_post((unsigned*)(ctl + CW_BAR), MISC0 + 8);
    const int lo = args.ph_lo, hi = args.ph_hi;
    int ph = 0;
#ifndef PHMASK
#define PHMASK 0xFFFFFFFFu
#endif
#define PHASE_BEGIN(k) if (((PHMASK >> (k)) & 1u) && lo <= ph && ph < hi) { if ((k) == TSEL && threadIdx.x == 0) *(volatile LAS unsigned long long*)(MISC0 + 16) = __builtin_amdgcn_s_memrealtime(); unsigned char* ws = ws0; float* outp = out0; int tid_p = threadIdx.x, G = G0, c = c0; asm volatile("" : "+s"(ws), "+s"(outp), "+v"(tid_p), "+s"(G), "+s"(c)); const int vcu = (G % 8 == 0) ? (c % 8) * (G / 8) + c / 8 : c;     \
    Frame F; F.lds = (LAS unsigned char*)lds; F.ldsg = (char*)lds; F.MISC = (volatile LAS unsigned*)(F.lds + MISC_OFF); F.tid = tid_p; F.lane = tid_p & 63; F.wave = __builtin_amdgcn_readfirstlane(tid_p >> 6); F.G = G; F.vcu = vcu; \
    const int gw = vcu * NWAVES + F.wave, NGW = G * NWAVES, gt = vcu * 512 + F.tid, NGT = G * 512; (void)gw; (void)NGW; (void)gt; (void)NGT; \
    float* const X = outp + O_X; bf16* const Hb = (bf16*)(ws + WS_H); float* const MOD = (float*)(ws + WS_MOD); const float* const modl = MOD + (size_t)l_ * NCV * INW; (void)X; (void)Hb; (void)modl;
#define PHASE_END(k)   if (MK_N_LAUNCHES == 1 && ph + 1 < hi) { XcdBarrier b_ = bar; asm volatile("" : "+s"(b_.bar)); xcd_barrier(b_); } if ((k) == TSEL && threadIdx.x == 0) *(volatile LAS unsigned long long*)(MISC0 + 18) += __builtin_amdgcn_s_memrealtime() - *(volatile LAS unsigned long long*)(MISC0 + 16); } ++ph;
    int l_ = 0;

    PHASE_BEGIN(0)
    {
        for (int it = F.vcu; it < NL * 64; it += G) s5_tables(F, it >> 6, it & 63, ws);
        __syncthreads();
        { const float* lamp = IN(19); for (int i = gt; i < NL * 2 * 1024; i += NGT) ((float*)(ws + WS_SP))[i] = log1pf(expf(-lamp[i])); }
        float* scr = (float*)(F.ldsg + F.wave * 16384);
        { const int rest = (G == 256) ? I_LAYER - SQ_END : I_LAYER;
          for (int it = gw; it < I_LAYER + 3 * rest; it += NGW) { if (it < I_LAYER) weight_item(F, ws, 0, it, scr); else { const int q = it - I_LAYER, l = 1 + q / rest, r = q % rest; weight_item(F, ws, l, I_LAYER - rest + r, scr); } } }
        const float* ckp = IN(2); const float* cvp = IN(3);
        for (int i = gt; i < 2 * 1048576; i += NGT) { const int which = i >> 20, j = i & 1048575; const GAS f32x4* s = (const GAS f32x4*)(which ? cvp : ckp) + (size_t)j * 2; const f32x4 a0 = s[0], a1 = s[1];
            v4u o; o.x = pk2(a0.x, a0.y); o.y = pk2(a0.z, a0.w); o.z = pk2(a1.x, a1.y); o.w = pk2(a1.z, a1.w); ((GAS v4u*)(ws + (which ? WS_CV : WS_CK)))[j] = o; }
        const float* cctx = IN(7); const float* cvec = IN(6); const float* wmod = IN(8);
        for (int task = gt; task < 16 * NL * 3072; task += NGT) {
            const int n4 = task % 3072, l = (task / 3072) % NL, ks = task / (3072 * NL);
            f32x4 acc[NCV];
#pragma unroll
            for (int v = 0; v < NCV; ++v) acc[v] = (f32x4){0.f, 0.f, 0.f, 0.f};
            const GAS f32x4* wp = (const GAS f32x4*)(wmod + ((size_t)l * DM + ks * 128) * INW) + n4;
#pragma unroll 16
            for (int k = 0; k < 128; ++k) { const f32x4 w = wp[(size_t)k * (INW / 4)]; const int kk = ks * 128 + k;
#pragma unroll
                for (int v = 0; v < NCV; ++v) { const float cnd = v == 0 ? cctx[kk] : cvec[(v - 1) * DM + kk]; const float sl = cnd * fsigmoid(cnd); acc[v] += w * sl; } }
#pragma unroll
            for (int v = 0; v < NCV; ++v) ((f32x4*)(ws + WS_MODP))[(((size_t)ks * NL + l) * NCV + v) * 3072 + n4] = acc[v];
        }
    }
    PHASE_END(0)
    PHASE_BEGIN(1)
        const float* bmod = IN(9);
        for (int i = gt; i < NL * NCV * 3072; i += NGT) { const int n4 = i % 3072, v = (i / 3072) % NCV, l = i / (3072 * NCV);
            f32x4 s = ((const f32x4*)(bmod + (size_t)l * INW))[n4];
#pragma unroll
            for (int ks = 0; ks < 16; ++ks) s += ((const f32x4*)(ws + WS_MODP))[(((size_t)ks * NL + l) * NCV + v) * 3072 + n4];
            ((f32x4*)MOD)[i] = s; }
    PHASE_END(1)
    PHASE_BEGIN(2)
        resnorm_rows<true, true>(F, IN(0), IN(1), X, nullptr, nullptr, nullptr, IN(10), MOD + 0 * DM, MOD + 1 * DM, Hb);
    PHASE_END(2)

    for (int l = 0; l < DBG_NL; ++l) {
        l_ = l;
        PHASE_BEGIN(3)
        {   pg8::SchedPlain S{(const char*)Hb, (const char*)(ws + WS_WINT) + (size_t)l * INW * DM * 2, 32, 48, G, c, (size_t)256 * DM * 2, (size_t)256 * DM * 2, DUPG1};
            pg8::EpiWin E{(bf16*)(ws + WS_XR), (bf16*)(ws + WS_XG), (bf16*)(ws + WS_UG), (bf16*)(ws + WS_Q), (bf16*)(ws + WS_K), (bf16*)(ws + WS_V), (bf16*)(ws + WS_G),
                          outp + O_K + (size_t)l * 256 * 1024, outp + O_V + (size_t)l * 256 * 1024};
            pg8::gemm_phase(F.lds, DM, DM, DM, S, E); }
        PHASE_END(3)
        PHASE_BEGIN(4)
        {
            { const bf16* XR = (const bf16*)(ws + WS_XR); bf16* XC = (bf16*)(ws + WS_XC); const GAS float* cw = (const GAS float*)(IN(15) + (size_t)l * 4 * 1024); const GAS float* cb = (const GAS float*)(IN(16) + (size_t)l * 1024);
              for (int i_ = gt; i_ < ROWS * 128 * DUP_CONV; i_ += NGT) { const int i = i_ % (ROWS * 128); const int row = i >> 7, c8 = (i & 127) * 8;
                  const int s0 = row < CTXR ? (row & ~255) : (CTXR + ((row - CTXR) & ~1023)), s1 = row < CTXR ? s0 + 256 : s0 + 1024;
                  float acc[8];
#pragma unroll
                  for (int e = 0; e < 8; ++e) acc[e] = cb[c8 + e];
#pragma unroll
                  for (int k = 0; k < 4; ++k) { const int rr = row + k - 1; if (rr >= s0 && rr < s1) { float xv[8]; unpack8(*(const GAS v4u*)(XR + (size_t)rr * 1024 + c8), xv);
#pragma unroll
                      for (int e = 0; e < 8; ++e) acc[e] += cw[k * 1024 + c8 + e] * xv[e]; } }
                  *(GAS v4u*)(XC + (size_t)row * 1024 + c8) = pack8(acc); } }
            for (int L = c; L < 128 * DUP_S5; L += G) { const int g = (L & 127) >> 1, pm = L & 1;
                { pg8::SchedOne S{(const char*)(ws + WS_UG) + ((size_t)g * 512 + pm * 256) * 256 * 2, (const char*)(ws + WS_ET) + ((size_t)l * 64 + g) * 65536 * 2, nullptr, nullptr, pm, g, 1}; pg8::EpiHloc E{(float*)(ws + WS_HLOC)};
                  pg8::gemm_phase(F.lds, 256, 256, 256, S, E); }
                { const float* HLOC = (const float*)(ws + WS_HLOC); bf16* HIN = (bf16*)(ws + WS_HIN); const GAS f32x2* LT = (const GAS f32x2*)(ws + WS_LT) + (size_t)l * 2 * 64 * 64;
                  const int nseq = pm ? 4 : 16, nch = pm ? 64 : 16;
                  for (int i = F.tid; i < nseq * 128; i += 512) { const int p = i & 63, d = (i >> 6) & 1, sq = i >> 7; const int seq = pm ? 16 + sq : sq, ch0 = pm ? 256 + sq * 64 : sq * 16;
                      const f32x2 lam = LT[(d * 64 + g) * 64 + p]; float hr = 0.f, hi_ = 0.f;
                      if (pm) { const f32x2 h0 = ((const f32x2*)IN(5))[((((size_t)sq * 4 + l) * 2 + d) * 64 + g) * 64 + p]; hr = h0.x; hi_ = h0.y; }
#pragma unroll 8
                      for (int k = 0; k < nch; ++k) { const int ch = d == 0 ? ch0 + k : ch0 + nch - 1 - k; const size_t idx = ((size_t)g * 512 + ch) * 256 + d * 128 + p * 2;
                          *(GAS unsigned*)(HIN + idx) = pk2(hr, hi_);
                          const f32x2 hl = *(const GAS f32x2*)(HLOC + idx); const float nr = lam.x * hr - lam.y * hi_ + hl.x, ni = lam.x * hi_ + lam.y * hr + hl.y; hr = nr; hi_ = ni; }
                      if (!pm) ((f32x2*)(outp + O_S5))[((((size_t)seq * 4 + l) * 2 + d) * 64 + g) * 64 + p] = (f32x2){hr, hi_}; }
                  VM_WAIT(); __syncthreads(); }
                { pg8::SchedOne S{(const char*)(ws + WS_UG) + ((size_t)g * 512 + pm * 256) * 256 * 2, (const char*)(ws + WS_MT) + ((size_t)l * 64 + g) * 65536 * 2,
                                  (const char*)(ws + WS_HIN) + ((size_t)g * 512 + pm * 256) * 256 * 2, (const char*)(ws + WS_FT) + ((size_t)l * 64 + g) * 65536 * 2, pm, g, 2};
                  pg8::EpiS5Y E{(const bf16*)(ws + WS_UG), IN(27) + (size_t)l * 1024, (bf16*)(ws + WS_ZS)};
                  pg8::gemm_phase(F.lds, 256, 256, 256, S, E); }
            }
            __syncthreads();
            { float* rp = (float*)(F.ldsg + att::RPB_OFF); const bf16* Qb = (const bf16*)(ws + WS_Q); const bf16* Kb = (const bf16*)(ws + WS_K); const bf16* Vb = (const bf16*)(ws + WS_V); bf16* Ob = (bf16*)(ws + WS_YNA);
              for (int u_ = (c + G / 2) % G; u_ < 256 * DUP_ATT; u_ += G) { const int u = u_ & 255;
                  if (u < 128) { const int b = u >> 5, h = (u >> 2) & 7, rg = u & 3; const int lo_ = rg == 0 ? 0 : (rg == 1 ? 0 : (rg == 2 ? 4 : 8)), NT = (rg == 0 || rg == 3) ? 16 : 20;
                      for (int i = F.tid; i < 465; i += 512) rp[i] = IN(29)[((size_t)l * 8 + h) * 465 + i] * (1.0f / att::SCALE);
                      __syncthreads();
                      const size_t qoff = (size_t)(CTXR + b * 1024 + rg * 256) * 1024 + h * 128, koff = (size_t)(CTXR + b * 1024 + lo_ * 64) * 1024 + h * 128, coff = ((size_t)(b * 4 + l) * 512) * 1024 + h * 128;
                      att::attn_body<true, 1>(Qb + qoff, (const bf16*)(ws + WS_CK) + coff, (const bf16*)(ws + WS_CV) + coff, Kb + koff, Vb + koff, Ob + qoff, NT, lo_, rg, F.ldsg);
                  } else { const int b = (u - 128) >> 3, h = (u - 128) & 7; const size_t off = (size_t)(b * 256) * 1024 + h * 128;
                      att::attn_body<false, 2>(Qb + off, Kb + off, Vb + off, Kb + off, Vb + off, Ob + off, 4, 0, 0, F.ldsg); }
              } }
        }
        PHASE_END(4)
        PHASE_BEGIN(5)
        {   { pg8::SchedRg S{(const char*)(ws + WS_XC), (const char*)(ws + WS_GWT) + (size_t)l * 8 * 2 * 256 * 128 * 2, G, c};
              pg8::EpiRg E{(const bf16*)(ws + WS_XC), IN(18) + (size_t)l * 4 * 1024, (const float*)(ws + WS_SP) + (size_t)l * 2048, (f32x2*)(ws + WS_AB)};
              pg8::gemm_phase(F.lds, 128, 1024, 128, S, E); }
            { pg8::SchedPlain S{(const char*)(ws + WS_ZS), (const char*)(ws + WS_GLUT) + (size_t)l * 1024 * 1024 * 2, 32, 4, G, c, (size_t)256 * 1024 * 2, (size_t)256 * 1024 * 2, 1};
              pg8::EpiGlu E{(const bf16*)(ws + WS_ZS), (bf16*)(ws + WS_YS5)};
              pg8::gemm_phase(F.lds, 1024, 1024, 1024, S, E); }
            __syncthreads(); static_weight_items(F, ws, l + 1, c, G, 0, SQ_P5);
        }
        PHASE_END(5)
        PHASE_BEGIN(6)
        {
            { const GAS f32x2* AB = (const GAS f32x2*)(ws + WS_AB); GAS float* HF = (GAS float*)(ws + WS_HF); const GAS bf16* XG = (const GAS bf16*)(ws + WS_XG); GAS bf16* YRG = (GAS bf16*)(ws + WS_YRG);
              float* cs = (float*)F.ldsg;
              for (int task_ = (c + G / 2) % G; task_ < 320 * DUP_SCAN; task_ += G) { const int task = task_ % 320;
                  const bool lat = task >= 64 && task < 128; const int ti = lat ? task - 64 : (task < 64 ? task : task - 64); const int seq = ti >> 4, cb = ti & 15;
                  const int L = lat ? 1024 : 256, row0 = lat ? CTXR + seq * 1024 : seq * 256, ch = cb * 64 + F.lane, len = L / 8, t0 = row0 + F.wave * len;
                  __syncthreads();
                  float pf = 1.f, hf = 0.f, pb = 1.f, hb = 0.f;
#pragma unroll 16
                  for (int t = 0; t < len; ++t) { const f32x2 v = AB[(size_t)(t0 + t) * 1024 + ch]; hf = v.x * hf + v.y; pf *= v.x; }
#pragma unroll 16
                  for (int t = len - 1; t >= 0; --t) { const f32x2 v = AB[((size_t)ROWS + t0 + t) * 1024 + ch]; hb = v.x * hb + v.y; pb *= v.x; }
                  cs[(F.wave * 4 + 0) * 64 + F.lane] = pf; cs[(F.wave * 4 + 1) * 64 + F.lane] = hf; cs[(F.wave * 4 + 2) * 64 + F.lane] = pb; cs[(F.wave * 4 + 3) * 64 + F.lane] = hb;
                  __syncthreads();
                  float cf = lat ? IN(4)[((size_t)(seq * 4 + l) * 2 + 0) * 1024 + ch] : 0.f, cbk = lat ? IN(4)[((size_t)(seq * 4 + l) * 2 + 1) * 1024 + ch] : 0.f;
                  for (int w = 0; w < F.wave; ++w) cf = cs[(w * 4 + 0) * 64 + F.lane] * cf + cs[(w * 4 + 1) * 64 + F.lane];
                  for (int w = 7; w > F.wave; --w) cbk = cs[(w * 4 + 2) * 64 + F.lane] * cbk + cs[(w * 4 + 3) * 64 + F.lane];
                  if (!lat) { if (F.wave == 7) outp[O_RG + ((size_t)(seq * 4 + l) * 2 + 0) * 1024 + ch] = pf * cf + hf; if (F.wave == 0) outp[O_RG + ((size_t)(seq * 4 + l) * 2 + 1) * 1024 + ch] = pb * cbk + hb; }
                  float h = cf;
#pragma unroll 16
                  for (int t = 0; t < len; ++t) { const f32x2 v = AB[(size_t)(t0 + t) * 1024 + ch]; h = v.x * h + v.y; HF[(size_t)(t0 + t) * 1024 + ch] = h; }
                  h = cbk;
#pragma unroll 8
                  for (int t = len - 1; t >= 0; --t) { const f32x2 v = AB[((size_t)ROWS + t0 + t) * 1024 + ch]; h = v.x * h + v.y; const size_t o = (size_t)(t0 + t) * 1024 + ch;
                      YRG[o] = (bf16)f2bf((HF[o] + h) * bf2f(XG[o])); }
              } }
        }
        PHASE_END(6)
        PHASE_BEGIN(8)
        {   pg8::SchedMerge S{(const char*)(ws + WS_YRG), (const char*)(ws + WS_YS5), (const char*)(ws + WS_YNA), (const char*)(ws + WS_OUTT) + (size_t)l * 3 * DM * 1024 * 2, G, c};
            pg8::EpiMerge E{(const bf16*)(ws + WS_G), (bf16*)(ws + WS_MM)};
            pg8::gemm_phase(F.lds, 1024, 1024, 1024, S, E); }
        PHASE_END(8)
        PHASE_BEGIN(9)
        {   pg8::SchedPlain S{(const char*)(ws + WS_MM), (const char*)(ws + WS_WOT) + (size_t)l * DM * DM * 2, 32, 8, G, c, (size_t)256 * DM * 2, (size_t)256 * DM * 2, 1};
            pg8::EpiB16 E{(bf16*)(ws + WS_Z), DM};
            pg8::gemm_phase(F.lds, DM, DM, DM, S, E); }
        PHASE_END(9)
        PHASE_BEGIN(10)
            resnorm_rows<false, true>(F, nullptr, nullptr, X, (const bf16*)(ws + WS_Z), IN(11) + (size_t)l * DM, modl + 2 * DM, IN(12) + (size_t)l * DM, modl + 3 * DM, modl + 4 * DM, Hb);
        PHASE_END(10)
        PHASE_BEGIN(11)
        {   pg8::SchedPlain S{(const char*)Hb, (const char*)(ws + WS_FINT) + (size_t)l * 2 * FFH * DM * 2, 32, 44, G, c, (size_t)256 * DM * 2, (size_t)256 * DM * 2, DUPG9};
            pg8::EpiSwiglu E{(bf16*)(ws + WS_FH)};
            pg8::gemm_phase(F.lds, DM, DM, DM, S, E);
            __syncthreads(); static_weight_items(F, ws, l + 1, c, G, SQ_P5, SQ_P9); }
        PHASE_END(11)
        PHASE_BEGIN(12)
        {   pg8::SchedPlain S{(const char*)(ws + WS_FH), (const char*)(ws + WS_FOUTT) + (size_t)l * DM * FFH * 2, 32, 8, G, c, (size_t)256 * FFH * 2, (size_t)256 * FFH * 2, DUPG10};
            pg8::EpiB16 E{(bf16*)(ws + WS_Z), DM};
            pg8::gemm_phase(F.lds, FFH, FFH, FFH, S, E); }
        PHASE_END(12)
        PHASE_BEGIN(13)
            if (l + 1 < NL) resnorm_rows<false, true>(F, nullptr, nullptr, X, (const bf16*)(ws + WS_Z), IN(13) + (size_t)l * DM, modl + 5 * DM, IN(10) + (size_t)(l + 1) * DM, modl + NCV * INW + 0 * DM, modl + NCV * INW + 1 * DM, Hb);
            else resnorm_rows<false, false>(F, nullptr, nullptr, X, (const bf16*)(ws + WS_Z), IN(13) + (size_t)l * DM, modl + 5 * DM, nullptr, nullptr, nullptr, Hb);
        PHASE_END(13)
    }
#if DBG_KEEP
    PHASE_BEGIN(14)
        for (size_t i = (size_t)gt; i < O_END; i += (size_t)NGT) {
            int r, lay = 0;
            if (i < O_K) r = i < O_K / 2 ? 0 : 1;
            else if (i < O_V) { r = 2; lay = (int)(((i - O_K) / (256 * 1024)) & 3); }
            else if (i < O_RG) { r = 3; lay = (int)(((i - O_V) / (256 * 1024)) & 3); }
            else if (i < O_S5) { r = 4; lay = (int)(((i - O_RG) / 2048) & 3); }
            else { r = 5; lay = (int)(((i - O_S5) / 16384) & 3); }
            const bool keep = ((DBG_KEEP >> r) & 1) && (r < 2 || ((DBG_LMASK >> lay) & 1));
            float v = keep ? 3.0f * outp[i] : 0.0f;
#if DBG_DUMP
            v = 0.f;
            if (i >= O_K && i < O_K + (size_t)ROWS * 1024) { const size_t j = i - O_K;
                if (DBG_DUMP == 1) v = bf2f(((const bf16*)(ws + WS_YNA))[j]);
                if (DBG_DUMP == 2) v = bf2f(((const bf16*)(ws + WS_YS5))[j]);
                if (DBG_DUMP == 3) v = bf2f(((const bf16*)(ws + WS_YRG))[j]);
                if (DBG_DUMP == 4) v = bf2f(((const bf16*)(ws + WS_ZS))[j]);
                if (DBG_DUMP == 5) v = bf2f(((const bf16*)(ws + WS_MM))[j]);
                if (DBG_DUMP == 6) v = ((const bf16*)(ws + WS_Z))[j];
                if (DBG_DUMP == 7) v = bf2f(((const bf16*)(ws + WS_FH))[j]);
                if (DBG_DUMP == 8) v = bf2f(((const bf16*)(ws + WS_H))[j]);
                if (DBG_DUMP == 9) v = bf2f(((const bf16*)(ws + WS_G))[j]);
                if (DBG_DUMP == 11) v = bf2f(((const bf16*)(ws + WS_G))[(size_t)8192 * 6144 + j]);
                if (DBG_DUMP == 10) v = bf2f(((const bf16*)(ws + WS_WINT))[(size_t)6144 * 2048 + j]);
            }
#endif
            outp[i] = v;
        }
    PHASE_END(14)
#endif
    if (TSEL >= 0 && blockIdx.x == 0 && threadIdx.x == 0) { const float us = (float)(*(volatile LAS unsigned long long*)(MISC0 + 18)) * 0.01f; out0[0] = exp2f(rintf(log2f(us) * 10.0f) * 0.1f); }
#undef PHASE_BEGIN
#undef PHASE_END
}
constexpr int N_PHASES = 3 + DBG_NL * 10 + (DBG_KEEP ? 1 : 0);

extern "C" void kernel_launch(void* const* d_in, const int* in_sizes, int n_in, void* d_out, int out_size, void* d_ws, size_t ws_size, hipStream_t stream) {
    static int grid = 0;
    if (grid == 0) {
        if (n_in != 36 || out_size != (int)O_END || ws_size < WS_END) { fprintf(stderr, "kernel_launch: unexpected shapes (n_in %d out %d ws %zu)\n", n_in, out_size, ws_size); grid = -1; return; }
        int dev = 0, cus = 0, per_cu = 0;
        if (hipGetDevice(&dev) != hipSuccess || hipDeviceGetAttribute(&cus, hipDeviceAttributeMultiprocessorCount, dev) != hipSuccess) { grid = -1; return; }
        if (hipFuncSetAttribute((const void*)fwd_kernel, hipFuncAttributeMaxDynamicSharedMemorySize, LDS_BYTES) != hipSuccess) { fprintf(stderr, "kernel_launch: hipFuncSetAttribute failed\n"); grid = -1; return; }
        if (hipOccupancyMaxActiveBlocksPerMultiprocessor(&per_cu, (const void*)fwd_kernel, NWAVES * 64, LDS_BYTES) != hipSuccess || per_cu < 1) { fprintf(stderr, "kernel_launch: occupancy query reports %d blocks per CU\n", per_cu); }
        (void)hipGetLastError();
        grid = cus;
    }
    if (grid < 0) return;
    if (hipMemsetAsync((char*)d_ws + WS_CTL, 0, CTL_ZERO_BYTES, stream) != hipSuccess) return;
    Args a{};
    for (int i = 0; i < 36; ++i) a.in[i] = (const float*)d_in[i];
    a.out = (float*)d_out; a.ws = (unsigned char*)d_ws;
    if (MK_N_LAUNCHES == 1) { a.ph_lo = 0; a.ph_hi = N_PHASES; hipLaunchKernelGGL(fwd_kernel, dim3(grid), dim3(NWAVES * 64), LDS_BYTES, stream, a); }
    else for (int p = 0; p < N_PHASES; ++p) { a.ph_lo = p; a.ph_hi = p + 1; hipLaunchKernelGGL(fwd_kernel, dim3(grid), dim3(NWAVES * 64), LDS_BYTES, stream, a); }
}
```

```cpp
#include <hip/hip_runtime.h>
#include <hip/hip_bf16.h>
#include <cstdio>
#include <cstdint>

#ifndef MK_N_LAUNCHES
#define MK_N_LAUNCHES 1
#endif
#ifndef DBG_KEEP
#define DBG_KEEP 0
#endif
#ifndef DUP_SCAN
#define DUP_SCAN 1
#endif
#ifndef DUP_ATT
#define DUP_ATT 1
#endif
#ifndef DUP_CARRY
#define DUP_CARRY 1
#endif
#ifndef DUP_CONV
#define DUP_CONV 1
#endif
#ifndef DUP_RGG
#define DUP_RGG 1
#endif
#ifndef DUP_S5
#define DUP_S5 1
#endif
#ifndef TSEL
#define TSEL (-1)
#endif
#ifndef DUPG1
#define DUPG1 1
#endif
#ifndef DUPG6
#define DUPG6 1
#endif
#ifndef DUPG9
#define DUPG9 1
#endif
#ifndef DUPG10
#define DUPG10 1
#endif
#ifndef DUP_GEMM
#define DUP_GEMM 1
#endif
#ifndef DUP_MASK
#define DUP_MASK 0u
#endif
#ifndef DBG_LMASK
#define DBG_LMASK 15
#endif
#ifndef DBG_DUMP
#define DBG_DUMP 0
#endif
#ifndef DBG_NL
#define DBG_NL 4
#endif

constexpr int DM = 2048, ROWS = 8192, CTXR = 4096, INW = 12288, FFH = 5632, NL = 4, W1K = 1024;
constexpr int NCV = 5;
constexpr float RMS_EPS = 1e-6f;
constexpr size_t MiB = 1u << 20;

constexpr size_t O_X = 0, O_K = 16777216, O_V = 33554432, O_RG = 50331648, O_S5 = 50462720, O_END = 51511296;

constexpr size_t WS_CTL = 0, CTL_ZERO_BYTES = 1 * MiB;
constexpr size_t WS_MODP = 1 * MiB;
constexpr size_t WS_MOD  = 17 * MiB;
constexpr size_t WS_SP   = 18 * MiB;
constexpr size_t WS_LT   = 18 * MiB + 65536;
constexpr size_t WS_GWT  = 19 * MiB;
constexpr size_t WS_WINT = 24 * MiB;
constexpr size_t WS_GLUT = 216 * MiB;
constexpr size_t WS_OUTT = 224 * MiB;
constexpr size_t WS_WOT  = 272 * MiB;
constexpr size_t WS_FINT = 304 * MiB;
constexpr size_t WS_FOUTT = 480 * MiB;
constexpr size_t WS_MT   = 568 * MiB;
constexpr size_t WS_ET   = 600 * MiB;
constexpr size_t WS_FT   = 632 * MiB;
constexpr size_t WS_CK   = 664 * MiB;
constexpr size_t WS_CV   = 680 * MiB;
constexpr size_t WS_H    = 696 * MiB;
constexpr size_t WS_XR   = 728 * MiB;
constexpr size_t WS_XG   = 744 * MiB;
constexpr size_t WS_XC   = 760 * MiB;
constexpr size_t WS_Q    = 776 * MiB;
constexpr size_t WS_K    = 792 * MiB;
constexpr size_t WS_V    = 808 * MiB;
constexpr size_t WS_YRG  = 824 * MiB;
constexpr size_t WS_YS5  = 840 * MiB;
constexpr size_t WS_YNA  = 856 * MiB;
constexpr size_t WS_ZS   = 872 * MiB;
constexpr size_t WS_UG   = 888 * MiB;
constexpr size_t WS_HIN  = 904 * MiB;
constexpr size_t WS_G    = 920 * MiB;
constexpr size_t WS_AB   = 1016 * MiB;
constexpr size_t WS_FH   = 1016 * MiB;
constexpr size_t WS_HF   = 1144 * MiB;
constexpr size_t WS_HLOC = 1176 * MiB;
constexpr size_t WS_Z    = 1144 * MiB;
constexpr size_t WS_MM   = 1208 * MiB;
constexpr size_t WS_END  = 1240 * MiB;

constexpr int CW_TMO = 0, CW_BAR = 4096;

constexpr int RING_BYTES = 131072;
constexpr int LDSCTL_OFF = RING_BYTES, MISC_OFF = LDSCTL_OFF + 320;
constexpr int LDS_BYTES = 147456;

#define GAS __attribute__((address_space(1)))
#define LAS __attribute__((address_space(3)))
typedef unsigned short bf16;
typedef unsigned v4u __attribute__((ext_vector_type(4)));
typedef unsigned v2u __attribute__((ext_vector_type(2)));
typedef float f32x4 __attribute__((ext_vector_type(4)));
typedef float f32x2 __attribute__((ext_vector_type(2)));
typedef short bf16x8 __attribute__((ext_vector_type(8)));
typedef GAS unsigned gu32;
#define RLX_AGENT __ATOMIC_RELAXED, __HIP_MEMORY_SCOPE_AGENT
#define LDS_WAIT() asm volatile("s_waitcnt lgkmcnt(0)" ::: "memory")
#define VM_WAIT() asm volatile("s_waitcnt vmcnt(0)" ::: "memory")

__device__ __forceinline__ unsigned f2bf(float f) { unsigned u = __builtin_bit_cast(unsigned, f); return (u + 0x7fffu + ((u >> 16) & 1u)) >> 16; }
typedef __bf16 bf16x2_t __attribute__((ext_vector_type(2)));
__device__ __forceinline__ unsigned pk2(float lo, float hi) { const f32x2 v = {lo, hi}; const bf16x2_t b = __builtin_convertvector(v, bf16x2_t); return __builtin_bit_cast(unsigned, b); }
__device__ __forceinline__ float bflo(unsigned w) { return __builtin_bit_cast(float, w << 16); }
__device__ __forceinline__ float bfhi(unsigned w) { return __builtin_bit_cast(float, w & 0xffff0000u); }
__device__ __forceinline__ float bf2f(bf16 h) { return __builtin_bit_cast(float, (unsigned)h << 16); }
__device__ __forceinline__ float fsigmoid(float x) { return __builtin_amdgcn_rcpf(1.0f + __expf(-x)); }
__device__ __forceinline__ float gelu_tanh(float x) { const float y = 0.7978845608028654f * (x + 0.044715f * x * x * x); return x * __builtin_amdgcn_rcpf(1.0f + __expf(-2.0f * y)); }
__device__ __forceinline__ float wave_sum(float v, int lane) {
#pragma unroll
    for (int o = 1; o < 64; o <<= 1) v += __builtin_bit_cast(float, __builtin_amdgcn_ds_bpermute((lane ^ o) << 2, __builtin_bit_cast(int, v)));
    return v;
}
__device__ __forceinline__ void unpack8(const v4u w, float (&f)[8]) { f[0] = bflo(w.x); f[1] = bfhi(w.x); f[2] = bflo(w.y); f[3] = bfhi(w.y); f[4] = bflo(w.z); f[5] = bfhi(w.z); f[6] = bflo(w.w); f[7] = bfhi(w.w); }
__device__ __forceinline__ v4u pack8(const float (&f)[8]) { v4u w; w.x = pk2(f[0], f[1]); w.y = pk2(f[2], f[3]); w.z = pk2(f[4], f[5]); w.w = pk2(f[6], f[7]); return w; }

#define XB_TMO      128
#define XB_XCNT(j)  (256  + 64 * (j))
#define XB_XSUB(j)  (1280 + 64 * (j))
#define XB_XGEN(j)  (2304 + 64 * (j))
#define XB_TOP      3328
#define XB_TOPGEN   3392
#define XCD_BAR_WORDS 3456
#define XB_SPIN_CAP (1u << 18)
__device__ __forceinline__ unsigned xb_ld(unsigned* p)              { return __hip_atomic_load(p, __ATOMIC_RELAXED, __HIP_MEMORY_SCOPE_AGENT); }
__device__ __forceinline__ unsigned xb_add(unsigned* p, unsigned v) { return __hip_atomic_fetch_add(p, v, __ATOMIC_RELAXED, __HIP_MEMORY_SCOPE_AGENT); }
__device__ __forceinline__ unsigned xb_xcc_id() { return (unsigned)__builtin_amdgcn_s_getreg((3 << 11) | 20) & 0xFu; }
#define XB_SPIN(cond, bar) do { unsigned _sp = 0; while (cond) { __builtin_amdgcn_s_sleep(1); \
    if ((++_sp & 255u) == 0u) { if (xb_ld(&(bar)[XB_TMO])) break; if (_sp > XB_SPIN_CAP) { atomicAdd(&(bar)[XB_TMO], 1u); break; } } } } while (0)
struct XcdBarrier { unsigned* bar; unsigned x; volatile LAS unsigned* st; };
__device__ __forceinline__ XcdBarrier xcd_barrier_post(unsigned* bar, volatile LAS unsigned* st) {
    XcdBarrier b; b.bar = bar; b.x = xb_xcc_id(); b.st = st;
    if (threadIdx.x == 0) (void)xb_add(&bar[XB_XCNT(b.x)], 1u);
    return b;
}
__device__ __forceinline__ void xcd_barrier_complete(unsigned* bar, unsigned x, unsigned& nloc, unsigned& nx) {
    const unsigned G = gridDim.x * gridDim.y * gridDim.z;
    unsigned sum, cnt, mine, sp = 0u;
    for (;;) {
        sum = 0u; cnt = 0u; mine = 0u;
#pragma unroll
        for (unsigned j = 0; j < 16; ++j) { const unsigned c = xb_ld(&bar[XB_XCNT(j)]); sum += c; cnt += (c > 0u) ? 1u : 0u; mine = (j == x) ? c : mine; }
        if (sum == G) break;
        __builtin_amdgcn_s_sleep(1);
        if ((++sp & 255u) == 0u) { if (xb_ld(&bar[XB_TMO])) break; if (sp > XB_SPIN_CAP) { atomicAdd(&bar[XB_TMO], 1u); break; } }
    }
    nloc = mine > 0u ? mine : 1u; nx = cnt > 0u ? cnt : 1u;
}
__device__ __forceinline__ void xcd_barrier(const XcdBarrier& b) {
    asm volatile("s_waitcnt vmcnt(0)" ::: "memory");
    __syncthreads();
    int tid_b = threadIdx.x; asm volatile("" : "+v"(tid_b));
    if (tid_b == 0) {
        unsigned* bar = b.bar;
        __builtin_amdgcn_s_waitcnt(0);
        unsigned nloc = b.st[0], nx = b.st[1];
        if (nloc == 0u) { xcd_barrier_complete(bar, b.x, nloc, nx); b.st[0] = nloc; b.st[1] = nx; }
        const unsigned old = xb_add(&bar[XB_XSUB(b.x)], 1u);
        const unsigned gen = old / nloc;
        if (old + 1u == (gen + 1u) * nloc) {
            __builtin_amdgcn_fence(__ATOMIC_RELEASE, "agent");
            asm volatile("s_waitcnt vmcnt(0)" ::: "memory");
            const unsigned og = xb_add(&bar[XB_TOP], 1u);
            const unsigned tg = og / nx;
            if (og + 1u == (tg + 1u) * nx) xb_add(&bar[XB_TOPGEN], 1u);
            else XB_SPIN(xb_ld(&bar[XB_TOPGEN]) == tg, bar);
            __builtin_amdgcn_fence(__ATOMIC_ACQUIRE, "agent");
            xb_add(&bar[XB_XGEN(b.x)], 1u);
            asm volatile("s_waitcnt vmcnt(0)" ::: "memory");
        } else {
            XB_SPIN(xb_ld(&bar[XB_XGEN(b.x)]) == gen, bar);
            __builtin_amdgcn_fence(__ATOMIC_ACQUIRE, "agent");
            asm volatile("s_waitcnt vmcnt(0)" ::: "memory");
        }
    }
    __syncthreads();
}

namespace pg8 {
#define PG8_LAS __attribute__((address_space(3)))
constexpr int BM = 256, BK = 64, HALF = 128, HTB = HALF * BK * 2, STAGE_BYTES = 8 * HTB;
__host__ __device__ __forceinline__ int lds_byte(int r, int c) { const int st = (r >> 4) * 2 + (c >> 5), rr = r & 15, cc = c & 31, ob = rr * 64 + cc * 2; return st * 1024 + (ob ^ (((ob >> 9) & 1) << 5)); }
__host__ __device__ __forceinline__ void stage_rc(int b, int& R, int& C) { const int st = b / 1024, sb = b % 1024, swz = sb ^ (((sb >> 9) & 1) << 5); R = (st >> 1) * 16 + swz / 64; C = (st & 1) * 32 + (swz % 64) / 2; }
__host__ __device__ __forceinline__ int perm32(int rho) { const int n = rho >> 4, i = rho & 15; return 8 * (i >> 2) + 4 * n + (i & 3); }

struct Unit { const char* A; const char* B; int pm, pn, aux, last; };

__device__ __forceinline__ bool tile_order(long L, int nM, int nN, int& pm, int& pn) {
    const int nwg = nM * nN; if (L >= nwg) return false;
    int wgid = (int)L; { const int q = nwg / 8, r = nwg % 8, xcd = wgid % 8, off = wgid / 8; wgid = (xcd < r ? xcd * (q + 1) : r * (q + 1) + (xcd - r) * q) + off; }
    const int nig = 8 * nN, gid = wgid / nig, fm = gid * 8, gsz = (nM - fm) < 8 ? (nM - fm) : 8;
    pm = fm + ((wgid % nig) % gsz); pn = (wgid % nig) / gsz; return true;
}

typedef float f32x4 __attribute__((ext_vector_type(4)));
typedef short bf16x8 __attribute__((ext_vector_type(8)));

template <class Epi, class Sched>
__device__ __forceinline__ void gemm_phase(PG8_LAS unsigned char* lds, const int K, const int lda, const int ldb, const Sched& S, const Epi& E) {
    int tid_ = threadIdx.x; asm volatile("" : "+v"(tid_));
    const int tid = tid_, wid = __builtin_amdgcn_readfirstlane(tid >> 6), lane = tid & 63, wr = wid >> 2, wc = wid & 3, fr = lane & 15, fq = lane >> 4;
    const int nt = K / BK;
    unsigned voffA[2], voffB[2];
#pragma unroll
    for (int i = 0; i < 2; ++i) { int R, C; stage_rc(tid * 16 + i * 8192, R, C); const int Rb = Epi::PERM ? ((R & ~31) + perm32(R & 31)) : R;
        voffA[i] = (unsigned)(R * lda + C) * 2u; voffB[i] = (unsigned)(Rb * ldb + C) * 2u; }
    const size_t kstep = (size_t)(BK * 2);
    const size_t hstepA = (size_t)HALF * lda * 2, hstepB = (size_t)HALF * ldb * 2;
    const unsigned ldsw = (unsigned)wid * 1024u;
    const int aoff = lds_byte(wr * 64 + fr, fq * 8), boff = lds_byte(wc * 32 + fr, fq * 8);
#define PG8_SA(b, h) (((b) * 2 + (h)) * HTB)
#define PG8_SB(b, h) ((4 + (b) * 2 + (h)) * HTB)
#define PG8_STAGE(bufoff, gbase, voff) do { _Pragma("unroll") for (int _i = 0; _i < 2; ++_i) \
        __builtin_amdgcn_global_load_lds((const unsigned*)((const char*)(gbase) + (voff)[_i]), (PG8_LAS unsigned*)(lds + (bufoff) + ldsw + _i * 8192), 16, 0, 0); } while (0)
#define PG8_LDA(dst, b, h) do { _Pragma("unroll") for (int m = 0; m < 4; ++m) _Pragma("unroll") for (int k = 0; k < 2; ++k) dst[m][k] = *(const PG8_LAS bf16x8*)(lds + PG8_SA(b, h) + aoff + m * 2048 + k * 1024); } while (0)
#define PG8_LDB(dst, b, h) do { _Pragma("unroll") for (int n = 0; n < 2; ++n) _Pragma("unroll") for (int k = 0; k < 2; ++k) dst[n][k] = *(const PG8_LAS bf16x8*)(lds + PG8_SB(b, h) + boff + n * 2048 + k * 1024); } while (0)
#define PG8_MMA(ai, bj, At, Bt) do { __builtin_amdgcn_s_setprio(1); _Pragma("unroll") for (int m = 0; m < 4; ++m) _Pragma("unroll") for (int n = 0; n < 2; ++n) _Pragma("unroll") for (int k = 0; k < 2; ++k) \
        acc[ai][bj][m][n] = __builtin_amdgcn_mfma_f32_16x16x32_bf16(Bt[n][k], At[m][k], acc[ai][bj][m][n], 0, 0, 0); __builtin_amdgcn_s_setprio(0); } while (0)
#define PG8_WAIT_V(n) asm volatile("s_waitcnt vmcnt(" #n ")" ::: "memory")
#define PG8_WAIT_L(n) asm volatile("s_waitcnt lgkmcnt(" #n ")" ::: "memory")
#define PG8_BAR __builtin_amdgcn_s_barrier()
#define PG8_SCHED __builtin_amdgcn_sched_barrier(0)
    Unit cur, nxt; int ui = 0;
    if (!S.next(0, cur)) return;
    f32x4 acc[2][2][4][2];
#pragma unroll
    for (int a = 0; a < 2; ++a)
#pragma unroll
        for (int b = 0; b < 2; ++b)
#pragma unroll
            for (int m = 0; m < 4; ++m)
#pragma unroll
                for (int n = 0; n < 2; ++n) acc[a][b][m][n] = (f32x4){0.f, 0.f, 0.f, 0.f};
    bf16x8 At[4][2], B0[2][2], B1[2][2];
    const char* cA = cur.A; const char* cB = cur.B;
    PG8_STAGE(PG8_SB(0, 0), cB, voffB); PG8_STAGE(PG8_SB(0, 1), cB + hstepB, voffB); PG8_STAGE(PG8_SA(0, 0), cA, voffA); PG8_STAGE(PG8_SA(0, 1), cA + hstepA, voffA);
    if (wr == 1) PG8_BAR;
    PG8_WAIT_V(2); PG8_BAR;
    PG8_STAGE(PG8_SB(1, 0), cB + kstep, voffB); PG8_STAGE(PG8_SA(1, 0), cA + kstep, voffA); PG8_STAGE(PG8_SB(1, 1), cB + hstepB + kstep, voffB);
    PG8_WAIT_V(6); PG8_BAR;
    for (;;) {
        const bool has_next = S.next(ui + 1, nxt);
        const char* nA = has_next ? nxt.A : cA; const char* nB = has_next ? nxt.B : cB;
#pragma unroll 1
        for (int t = 0; t < nt; t += 2) {
            const bool last = (t == nt - 2);
            const char* a1 = cA + (size_t)(t + 1) * kstep;
            const char* a2 = last ? nA : cA + (size_t)(t + 2) * kstep; const char* b2 = last ? nB : cB + (size_t)(t + 2) * kstep;
            const char* a3 = a2 + kstep; const char* b3 = b2 + kstep;
            PG8_LDB(B0, 0, 0); PG8_LDB(B1, 0, 1); PG8_SCHED; PG8_LDA(At, 0, 0); PG8_STAGE(PG8_SA(1, 1), a1 + hstepA, voffA);
            PG8_WAIT_V(8); PG8_WAIT_L(0); PG8_BAR; PG8_MMA(0, 0, At, B0); PG8_MMA(0, 1, At, B1); PG8_BAR; PG8_SCHED;
            PG8_LDA(At, 0, 1); PG8_STAGE(PG8_SB(0, 0), b2, voffB); PG8_STAGE(PG8_SB(0, 1), b2 + hstepB, voffB); PG8_STAGE(PG8_SA(0, 0), a2, voffA);
            PG8_WAIT_V(8); PG8_WAIT_L(0); PG8_BAR; PG8_MMA(1, 0, At, B0); PG8_MMA(1, 1, At, B1); PG8_BAR; PG8_SCHED;
            PG8_LDB(B0, 1, 0); PG8_LDB(B1, 1, 1); PG8_SCHED; PG8_LDA(At, 1, 0); PG8_STAGE(PG8_SA(0, 1), a2 + hstepA, voffA);
            PG8_WAIT_V(8); PG8_WAIT_L(0); PG8_BAR; PG8_MMA(0, 0, At, B0); PG8_MMA(0, 1, At, B1); PG8_BAR; PG8_SCHED;
            PG8_LDA(At, 1, 1); PG8_STAGE(PG8_SB(1, 0), b3, voffB); PG8_STAGE(PG8_SB(1, 1), b3 + hstepB, voffB); PG8_STAGE(PG8_SA(1, 0), a3, voffA);
            PG8_WAIT_V(8); PG8_WAIT_L(0); PG8_BAR; PG8_MMA(1, 0, At, B0); PG8_MMA(1, 1, At, B1); PG8_BAR; PG8_SCHED;
        }
        if (wr == 0) PG8_BAR;
        if (cur.last) E(acc, cur, wr, wc, fr, fq); else E.mid(acc, cur, wr, wc, fr, fq);
        if (!has_next) break;
        if (cur.last) {
#pragma unroll
            for (int a = 0; a < 2; ++a)
#pragma unroll
                for (int b = 0; b < 2; ++b)
#pragma unroll
                    for (int m = 0; m < 4; ++m)
#pragma unroll
                        for (int n = 0; n < 2; ++n) acc[a][b][m][n] = (f32x4){0.f, 0.f, 0.f, 0.f};
        }
        cur = nxt; cA = nA; cB = nB; ++ui;
        if (wr == 1) PG8_BAR;
    }
    PG8_WAIT_V(0);
    PG8_BAR;
#undef PG8_SA
#undef PG8_SB
#undef PG8_STAGE
#undef PG8_LDA
#undef PG8_LDB
#undef PG8_MMA
#undef PG8_WAIT_V
#undef PG8_WAIT_L
#undef PG8_BAR
#undef PG8_SCHED
}

typedef const f32x4 (&AccC)[2][2][4][2];
typedef f32x4 (&AccM)[2][2][4][2];
#define EPI_ROWS_BEGIN _Pragma("unroll") for (int ai = 0; ai < 2; ++ai) _Pragma("unroll") for (int m = 0; m < 4; ++m) { const int row = u.pm * 256 + ai * 128 + wr * 64 + m * 16 + fr;
#define EPI_ROWS_END }

#define EPI_NO_MID __device__ __forceinline__ void mid(AccM, const Unit&, int, int, int, int) const {}

struct EpiB16 {
    EPI_NO_MID
    static constexpr bool PERM = true;
    bf16* O; int ldc;
    __device__ __forceinline__ void operator()(AccC acc, const Unit& u, int wr, int wc, int fr, int fq) const {
        const int col0 = u.pn * 256 + wc * 32 + 8 * fq;
        EPI_ROWS_BEGIN
#pragma unroll
            for (int bj = 0; bj < 2; ++bj) { const f32x4 v0 = acc[ai][bj][m][0], v1 = acc[ai][bj][m][1]; const float f[8] = {v0[0], v0[1], v0[2], v0[3], v1[0], v1[1], v1[2], v1[3]};
                *(GAS v4u*)(O + (size_t)row * ldc + col0 + bj * 128) = pack8(f); }
        EPI_ROWS_END
    }
};
struct EpiHloc {
    EPI_NO_MID
    static constexpr bool PERM = false;
    float* O;
    __device__ __forceinline__ void operator()(AccC acc, const Unit& u, int wr, int wc, int fr, int fq) const {
        const int col0 = wc * 32 + 4 * fq; float* base = O + (size_t)u.aux * 512 * 256;
        EPI_ROWS_BEGIN
            float* rowp = base + (size_t)row * 256 + col0;
#pragma unroll
            for (int bj = 0; bj < 2; ++bj)
#pragma unroll
                for (int n = 0; n < 2; ++n) *(GAS f32x4*)(rowp + bj * 128 + n * 16) = acc[ai][bj][m][n];
        EPI_ROWS_END
    }
};
struct EpiWin {
    EPI_NO_MID
    static constexpr bool PERM = true;
    bf16 *XR, *XG, *UG, *Q, *Kb, *Vb, *G; float *outK, *outV;
    __device__ __forceinline__ void operator()(AccC acc, const Unit& u, int wr, int wc, int fr, int fq) const {
        const int pn = u.pn, seg = pn >> 2;
        const int cseg = (pn & 3) * 256 + wc * 32 + 8 * fq;
        EPI_ROWS_BEGIN
#pragma unroll
            for (int bj = 0; bj < 2; ++bj) {
                const f32x4 v0 = acc[ai][bj][m][0], v1 = acc[ai][bj][m][1];
                float f[8] = {v0[0], v0[1], v0[2], v0[3], v1[0], v1[1], v1[2], v1[3]};
                const int c = cseg + bj * 128;
                if (seg >= 6) {
#pragma unroll
                    for (int e = 0; e < 8; ++e) f[e] = fsigmoid(f[e]);
                    *(GAS v4u*)(G + (size_t)row * 6144 + (pn - 24) * 256 + wc * 32 + 8 * fq + bj * 128) = pack8(f);
                } else if (seg == 1) {
#pragma unroll
                    for (int e = 0; e < 8; ++e) f[e] = gelu_tanh(f[e]);
                    *(GAS v4u*)(XG + (size_t)row * 1024 + c) = pack8(f);
                } else if (seg == 2) {
                    const int g = c >> 4, m0 = c & 15;
                    *(GAS v4u*)(UG + ((size_t)g * 512 + (row >> 4)) * 256 + (row & 15) * 16 + m0) = pack8(f);
                } else {
                    bf16* dst = seg == 0 ? XR : (seg == 3 ? Q : (seg == 4 ? Kb : Vb));
                    *(GAS v4u*)(dst + (size_t)row * 1024 + c) = pack8(f);
                    if (seg >= 4 && row < CTXR) {
                        float* o = (seg == 4 ? outK : outV) + ((size_t)(row >> 8) * 4 * 256 + (row & 255)) * 1024 + c;
                        *(f32x4*)o = v0; *(GAS f32x4*)(o + 4) = v1;
                    }
                }
            }
        EPI_ROWS_END
    }
};
struct EpiRg {
    EPI_NO_MID
    static constexpr bool PERM = true;
    const bf16* XC; const float* gb; const float* sp; f32x2* AB;
    __device__ __forceinline__ void operator()(AccC acc, const Unit& u, int wr, int wc, int fr, int fq) const {
        const int h = u.aux >> 1, d = u.aux & 1, c0 = h * 128 + wc * 32 + 8 * fq;
        const GAS float* gbr = (const GAS float*)(gb + (d * 2 + 0) * 1024 + c0); const GAS float* gbi = (const GAS float*)(gb + (d * 2 + 1) * 1024 + c0); const GAS float* spp = (const GAS float*)(sp + d * 1024 + c0);
        EPI_ROWS_BEGIN
            float xc[8]; unpack8(*(const GAS v4u*)(XC + (size_t)row * 1024 + c0), xc);
            const f32x4 r0 = acc[ai][0][m][0], r1 = acc[ai][0][m][1], i0 = acc[ai][1][m][0], i1 = acc[ai][1][m][1];
            const float rr[8] = {r0[0], r0[1], r0[2], r0[3], r1[0], r1[1], r1[2], r1[3]}, ii[8] = {i0[0], i0[1], i0[2], i0[3], i1[0], i1[1], i1[2], i1[3]};
            f32x2* dst = AB + ((size_t)d * ROWS + row) * 1024 + c0;
#pragma unroll
            for (int e = 0; e < 8; e += 2) {
                f32x4 o;
#pragma unroll
                for (int q = 0; q < 2; ++q) {
                    const float r = fsigmoid(rr[e + q] + gbr[e + q]), ig = fsigmoid(ii[e + q] + gbi[e + q]);
                    const float la = -8.0f * r * spp[e + q]; const float a = __expf(la); const float mult = sqrtf(-expm1f(2.0f * la));
                    o[2 * q] = a; o[2 * q + 1] = mult * ig * xc[e + q];
                }
                *(GAS f32x4*)(dst + e) = o;
            }
            asm volatile("" ::: "memory");
        EPI_ROWS_END
    }
};
struct EpiS5Y {
    EPI_NO_MID
    static constexpr bool PERM = true;
    const bf16* UG; const float* dvec; bf16* ZS;
    __device__ __forceinline__ void operator()(AccC acc, const Unit& u, int wr, int wc, int fr, int fq) const {
        const int g = u.aux;
        EPI_ROWS_BEGIN
#pragma unroll
            for (int bj = 0; bj < 2; ++bj) {
                const int col = bj * 128 + wc * 32 + 8 * fq, t = col >> 4, n0 = col & 15;
                float uu[8]; unpack8(*(const GAS v4u*)(UG + ((size_t)g * 512 + row) * 256 + col), uu);
                const f32x4 v0 = acc[ai][bj][m][0], v1 = acc[ai][bj][m][1];
                float f[8] = {v0[0], v0[1], v0[2], v0[3], v1[0], v1[1], v1[2], v1[3]};
#pragma unroll
                for (int e = 0; e < 8; ++e) f[e] = gelu_tanh(f[e] + ((const GAS float*)dvec)[g * 16 + n0 + e] * uu[e]);
                *(GAS v4u*)(ZS + ((size_t)row * 16 + t) * 1024 + g * 16 + n0) = pack8(f);
            }
        EPI_ROWS_END
    }
};
struct EpiGlu {
    EPI_NO_MID
    static constexpr bool PERM = true;
    const bf16* ZS; bf16* Y;
    __device__ __forceinline__ void operator()(AccC acc, const Unit& u, int wr, int wc, int fr, int fq) const {
        const int col0 = u.pn * 256 + wc * 32 + 8 * fq;
        EPI_ROWS_BEGIN
#pragma unroll
            for (int bj = 0; bj < 2; ++bj) {
                float z[8]; unpack8(*(const GAS v4u*)(ZS + (size_t)row * 1024 + col0 + bj * 128), z);
                const f32x4 v0 = acc[ai][bj][m][0], v1 = acc[ai][bj][m][1];
                float f[8] = {v0[0], v0[1], v0[2], v0[3], v1[0], v1[1], v1[2], v1[3]};
#pragma unroll
                for (int e = 0; e < 8; ++e) f[e] = z[e] * fsigmoid(f[e]);
                *(GAS v4u*)(Y + (size_t)row * 1024 + col0 + bj * 128) = pack8(f);
            }
        EPI_ROWS_END
    }
};
struct EpiMerge {
    static constexpr bool PERM = true;
    const bf16* G; bf16* MM;
    __device__ __forceinline__ void mid(AccM acc, const Unit& u, int wr, int wc, int fr, int fq) const {
        const int col0 = u.pn * 256 + wc * 32 + 8 * fq, b = u.aux;
        EPI_ROWS_BEGIN
#pragma unroll
            for (int bj = 0; bj < 2; ++bj) {
                float ga[8], gn[8]; unpack8(*(const GAS v4u*)(G + (size_t)row * 6144 + b * 2048 + col0 + bj * 128), ga); unpack8(*(const GAS v4u*)(G + (size_t)row * 6144 + (b + 1) * 2048 + col0 + bj * 128), gn);
#pragma unroll
                for (int e = 0; e < 8; ++e) { const float rt = ga[e] * __builtin_amdgcn_rcpf(fmaxf(gn[e], 1e-30f)); acc[ai][bj][m][e >> 2][e & 3] *= rt; }
            }
        EPI_ROWS_END
    }
    __device__ __forceinline__ void operator()(AccC acc, const Unit& u, int wr, int wc, int fr, int fq) const {
        const int col0 = u.pn * 256 + wc * 32 + 8 * fq;
        EPI_ROWS_BEGIN
#pragma unroll
            for (int bj = 0; bj < 2; ++bj) {
                float g2[8]; unpack8(*(const GAS v4u*)(G + (size_t)row * 6144 + 2 * 2048 + col0 + bj * 128), g2);
                const f32x4 v0 = acc[ai][bj][m][0], v1 = acc[ai][bj][m][1];
                float f[8] = {v0[0], v0[1], v0[2], v0[3], v1[0], v1[1], v1[2], v1[3]};
#pragma unroll
                for (int e = 0; e < 8; ++e) f[e] *= g2[e];
                *(GAS v4u*)(MM + (size_t)row * 2048 + col0 + bj * 128) = pack8(f);
            }
        EPI_ROWS_END
    }
};
struct EpiSwiglu {
    EPI_NO_MID
    static constexpr bool PERM = true;
    bf16* FH;
    __device__ __forceinline__ void operator()(AccC acc, const Unit& u, int wr, int wc, int fr, int fq) const {
        const int col0 = u.pn * 128 + wc * 32 + 8 * fq;
        EPI_ROWS_BEGIN
            const f32x4 a0 = acc[ai][0][m][0], a1 = acc[ai][0][m][1], b0 = acc[ai][1][m][0], b1 = acc[ai][1][m][1];
            const float av[8] = {a0[0], a0[1], a0[2], a0[3], a1[0], a1[1], a1[2], a1[3]}, bv[8] = {b0[0], b0[1], b0[2], b0[3], b1[0], b1[1], b1[2], b1[3]};
            float f[8];
#pragma unroll
            for (int e = 0; e < 8; ++e) f[e] = av[e] * fsigmoid(av[e]) * bv[e];
            *(GAS v4u*)(FH + (size_t)row * FFH + col0) = pack8(f);
        EPI_ROWS_END
    }
};

struct SchedPlain {
    const char* A; const char* B; int nM, nN, G, c; size_t tA, tB; int dup;
    __device__ __forceinline__ bool next(int i, Unit& u) const { int pm, pn; const int q = i / (dup * DUP_GEMM), r = i - q * (dup * DUP_GEMM); long L = (long)q * G + c; const int nwg = nM * nN; if (L >= nwg) return false;
        if (r) L = (L + nwg / 2 + 8) % nwg;
        if (!tile_order(L, nM, nN, pm, pn)) return false; u.A = A + (size_t)pm * tA; u.B = B + (size_t)pn * tB; u.pm = pm; u.pn = pn; u.aux = 0; u.last = 1; return true; }
};
struct SchedMerge {
    const char* A0; const char* A1; const char* A2; const char* B; int G, c;
    __device__ __forceinline__ bool next(int i, Unit& u) const { const int ti = i / 3, b = i - ti * 3; int pm, pn; const int q = ti / (DUPG6 * DUP_GEMM), r = ti - q * (DUPG6 * DUP_GEMM); long L = (long)q * G + c; if (L >= 256) return false; if (r) L = (L + 136) % 256;
        if (!tile_order(L, 32, 8, pm, pn)) return false;
        const char* Ab = b == 0 ? A0 : (b == 1 ? A1 : A2); u.A = Ab + (size_t)pm * 256 * 1024 * 2; u.B = B + ((size_t)b * 2048 + pn * 256) * 1024 * 2; u.pm = pm; u.pn = pn; u.aux = b; u.last = (b == 2); return true; }
};
struct SchedS5E {
    const char* UG; const char* ET; int G, c;
    __device__ __forceinline__ bool next(int i, Unit& u) const { const int L = (i / DUP_S5) * G + c; if (L >= 128) return false; const int g = L >> 1, pm = L & 1;
        u.A = UG + ((size_t)g * 512 + pm * 256) * 256 * 2; u.B = ET + (size_t)g * 256 * 256 * 2; u.pm = pm; u.pn = 0; u.aux = g; u.last = 1; return true; }
};
struct SchedS5Y {
    const char* UG; const char* HIN; const char* MT; const char* FT; int G, c;
    __device__ __forceinline__ bool next(int i, Unit& u) const { const int ti = (i >> 1) / DUP_S5, part = i & 1, L = ti * G + c; if (L >= 128) return false; const int g = L >> 1, pm = L & 1;
        u.A = (part ? HIN : UG) + ((size_t)g * 512 + pm * 256) * 256 * 2; u.B = (part ? FT : MT) + (size_t)g * 256 * 256 * 2; u.pm = pm; u.pn = 0; u.aux = g; u.last = part; return true; }
};
struct SchedOne {
    const char* A0; const char* B0; const char* A1; const char* B1; int pm, aux, nparts;
    __device__ __forceinline__ bool next(int i, Unit& u) const { if (i >= nparts) return false; u.A = i ? A1 : A0; u.B = i ? B1 : B0; u.pm = pm; u.pn = 0; u.aux = aux; u.last = (i == nparts - 1); return true; }
};
struct SchedRg {
    const char* XC; const char* GWT; int G, c;
    __device__ __forceinline__ bool next(int i, Unit& u) const { const int L = (i / DUP_RGG) * G + c; if (L >= 512) return false; const int pm = L & 31, hd = L >> 5;
        u.A = XC + ((size_t)pm * 256 * 1024 + (hd >> 1) * 128) * 2; u.B = GWT + (size_t)hd * 256 * 128 * 2; u.pm = pm; u.pn = 0; u.aux = hd; u.last = 1; return true; }
};
}

namespace att {
using bf16x8 = __attribute__((ext_vector_type(8))) short;
using s16x4  = __attribute__((ext_vector_type(4))) short;
using f32x16 = __attribute__((ext_vector_type(16))) float;
using u32x4  = __attribute__((ext_vector_type(4))) unsigned;
constexpr int D = 128, NW = 8, QBLK = 32, KVBLK = 64, LD = 1024;
constexpr float SCALE = 0.088388347648318440f, THR = 8.f;
constexpr size_t SHM_V = KVBLK * D * 2, SHM_K = KVBLK * D * 2, SHM_ATTN = 2 * SHM_V + 2 * SHM_K + NW * 64 * 4;
constexpr int RPB_OFF = (int)SHM_ATTN + 256;
#define KSWZ(row, colB) ((row) * 256 + ((colB) ^ (((row) & 7) << 4)))
#define SBAR() __builtin_amdgcn_sched_barrier(0)
__device__ __forceinline__ int crow(int r, int hi) { return (r & 3) + 8 * (r >> 2) + 4 * hi; }
__device__ __forceinline__ unsigned cvtpk(float lo, float hi) { return pk2(lo, hi); }
__device__ __forceinline__ void partialSM(f32x16& p0, f32x16& p1, float& m_reg, float& mn, float& alpha) {
  constexpr float C = SCALE * 1.4426950408889634f;
  float pmax = p0[0]; for (int r = 1; r < 16; ++r) pmax = fmaxf(pmax, p0[r]); for (int r = 0; r < 16; ++r) pmax = fmaxf(pmax, p1[r]);
  { auto rr = __builtin_amdgcn_permlane32_swap(__float_as_uint(pmax), __float_as_uint(pmax), false, false);
    pmax = fmaxf(__uint_as_float(rr[0]), __uint_as_float(rr[1])); }
  if (__builtin_expect(__all(pmax - m_reg <= THR / SCALE), 1)) { mn = m_reg; alpha = 1.f; }
  else { mn = fmaxf(m_reg, pmax); alpha = __builtin_amdgcn_exp2f((m_reg - mn) * C); m_reg = mn; }
  float mnC = -mn * C;
  for (int r = 0; r < 16; ++r) p0[r] = fmaf(p0[r], C, mnC); for (int r = 0; r < 16; ++r) p1[r] = fmaf(p1[r], C, mnC);
  for (int r = 0; r < 16; ++r) p0[r] = __builtin_amdgcn_exp2f(p0[r]);
}
__device__ __forceinline__ void finishSM(f32x16& p0, f32x16& p1, float alpha, float& l_reg, bf16x8& pa0, bf16x8& pa1, bf16x8& pa2, bf16x8& pa3) {
  for (int r = 0; r < 16; ++r) p1[r] = __builtin_amdgcn_exp2f(p1[r]);
  float ps = 0; for (int r = 0; r < 16; ++r) ps += p0[r]; for (int r = 0; r < 16; ++r) ps += p1[r];
  { auto rr = __builtin_amdgcn_permlane32_swap(__float_as_uint(ps), __float_as_uint(ps), false, false);
    ps = __uint_as_float(rr[0]) + __uint_as_float(rr[1]); }
  l_reg = l_reg * alpha + ps;
#define PK4(P, BASE, OUT) do { unsigned a0 = cvtpk(P[BASE + 0], P[BASE + 1]), a1 = cvtpk(P[BASE + 2], P[BASE + 3]);   \
    unsigned b0 = cvtpk(P[BASE + 4], P[BASE + 5]), b1 = cvtpk(P[BASE + 6], P[BASE + 7]);                              \
    auto r0 = __builtin_amdgcn_permlane32_swap(a0, b0, false, false); auto r1 = __builtin_amdgcn_permlane32_swap(a1, b1, false, false); \
    u32x4 w = {r0[0], r1[0], r0[1], r1[1]}; OUT = *reinterpret_cast<bf16x8*>(&w); } while (0)
  PK4(p0, 0, pa0); PK4(p0, 8, pa1); PK4(p1, 0, pa2); PK4(p1, 8, pa3);
#undef PK4
}
__device__ __forceinline__ void qkt(f32x16& p0, f32x16& p1, const bf16* Ks, const bf16x8* qr, int r32, int hi) {
  p0 = f32x16{}; p1 = f32x16{};
  for (int d0 = 0; d0 < 8; ++d0) { int cb = (d0 * 16 + hi * 8) * 2;
    bf16x8 b0 = *reinterpret_cast<const bf16x8*>((const char*)Ks + KSWZ(r32, cb));
    bf16x8 b1 = *reinterpret_cast<const bf16x8*>((const char*)Ks + KSWZ(32 + r32, cb));
    p0 = __builtin_amdgcn_mfma_f32_32x32x16_bf16(b0, qr[d0], p0, 0, 0, 0);
    p1 = __builtin_amdgcn_mfma_f32_32x32x16_bf16(b1, qr[d0], p1, 0, 0, 0); }
}
__device__ __forceinline__ int v_st(int k, int c) { const int kk = (k & ~0xC) | ((k & 4) << 1) | ((k & 8) >> 1); return ((kk >> 3) * 4 + (c >> 5)) * 512 + ((kk & 7) * 32 + (c & 31)) * 2; }
__device__ __forceinline__ int v_rd_base(int lane) { return ((lane & 3) << 3) | (((lane >> 2) & 3) << 6) | (((lane >> 4) & 1) << 5) | (((lane >> 5) & 1) << 8); }
constexpr int v_rd_off(int d0, int ks, int half) { return d0 * 512 + ks * 4096 + half * 2048; }
template <int OFF> __device__ __forceinline__ s16x4 tr_read(int vb) {
  s16x4 r; asm volatile("ds_read_b64_tr_b16 %0, %1 offset:%2" : "=&v"(r) : "v"(vb), "i"(OFF) : "memory"); return r;
}
template <int D0> __device__ __forceinline__ void pv_one(f32x16& od, int vb, bf16x8 pa0, bf16x8 pa1, bf16x8 pa2, bf16x8 pa3) {
  const s16x4 l0 = tr_read<v_rd_off(D0, 0, 0)>(vb), h0 = tr_read<v_rd_off(D0, 0, 1)>(vb), l1 = tr_read<v_rd_off(D0, 1, 0)>(vb), h1 = tr_read<v_rd_off(D0, 1, 1)>(vb);
  const s16x4 l2 = tr_read<v_rd_off(D0, 2, 0)>(vb), h2 = tr_read<v_rd_off(D0, 2, 1)>(vb), l3 = tr_read<v_rd_off(D0, 3, 0)>(vb), h3 = tr_read<v_rd_off(D0, 3, 1)>(vb);
  asm volatile("s_waitcnt lgkmcnt(0)" ::: "memory"); SBAR();
#define PK(L, H) (bf16x8){L[0], L[1], L[2], L[3], H[0], H[1], H[2], H[3]}
  od = __builtin_amdgcn_mfma_f32_32x32x16_bf16(pa0, PK(l0, h0), od, 0, 0, 0);
  od = __builtin_amdgcn_mfma_f32_32x32x16_bf16(pa1, PK(l1, h1), od, 0, 0, 0);
  od = __builtin_amdgcn_mfma_f32_32x32x16_bf16(pa2, PK(l2, h2), od, 0, 0, 0);
  od = __builtin_amdgcn_mfma_f32_32x32x16_bf16(pa3, PK(l3, h3), od, 0, 0, 0);
#undef PK
}
__device__ __forceinline__ void pv_d0(f32x16* o, int vb, bf16x8 pa0, bf16x8 pa1, bf16x8 pa2, bf16x8 pa3) {
  pv_one<0>(o[0], vb, pa0, pa1, pa2, pa3); pv_one<1>(o[1], vb, pa0, pa1, pa2, pa3); pv_one<2>(o[2], vb, pa0, pa1, pa2, pa3); pv_one<3>(o[3], vb, pa0, pa1, pa2, pa3);
}
__device__ __forceinline__ void na_mask(f32x16& p0, f32x16& p1, int kr, int qr, int rs, int ws, const float* rpbl, int hi) {
  if (kr < rs || kr >= rs + 8) {
#pragma unroll
    for (int r = 0; r < 16; ++r) { p0[r] = -1e30f; p1[r] = -1e30f; }
  } else {
    const float* row = rpbl + (kr - qr + 7) * 31 + 4 * hi; const unsigned w0 = (unsigned)(4 * hi - ws);
#pragma unroll
    for (int r = 0; r < 16; ++r) {
      const int kc = (r & 3) + 8 * (r >> 2);
      const float b0 = row[kc], b1 = row[kc + 32];
      p0[r] = (w0 + (unsigned)kc < 16u) ? p0[r] + b0 : -1e30f; p1[r] = (w0 + (unsigned)(kc + 32) < 16u) ? p1[r] + b1 : -1e30f;
      if ((r & 3) == 3) SBAR();
    }
  }
}
template <bool NA, int SD>
__device__ __forceinline__ void attn_body(const bf16* __restrict__ Qb, const bf16* __restrict__ K0, const bf16* __restrict__ V0, const bf16* __restrict__ K1, const bf16* __restrict__ V1,
                                          bf16* __restrict__ Ob, const int NT, const int lo, const int rg, char* lds) {
  int tid_ = threadIdx.x; asm volatile("" : "+v"(tid_));
  const int tid = tid_, wid = tid >> 6, lane = tid & 63, r32 = lane & 31, hi = lane >> 5;
  bf16* V_lds = (bf16*)lds; bf16* K_lds = (bf16*)(lds + 2 * SHM_V);
  float* ws_ = (float*)(lds + 2 * SHM_V + 2 * SHM_K) + wid * 64; float* li_l = ws_; float* al_l = ws_ + 32;
  const int qrow = 4 * rg + (wid >> 1), qc = 32 * (wid & 1) + r32;
  const int rs = qrow - 4 < 0 ? 0 : (qrow - 4 > 8 ? 8 : qrow - 4), wsn = qc - 8 < 0 ? 0 : (qc - 8 > 48 ? 48 : qc - 8);
  const float* rpbl = (const float*)(lds + RPB_OFF) + 15 - qc;
  float m_reg = -1e30f, l_reg = 0; f32x16 o[4] = {}; bf16x8 qr[8];
  const bf16* Qw = Qb + (long)(wid * QBLK + r32) * LD + hi * 8;
#pragma unroll
  for (int d0 = 0; d0 < 8; ++d0) qr[d0] = *(const GAS bf16x8*)(Qw + d0 * 16);
  const int sr = tid >> 4, sc = (tid & 15) * 8, vst0 = v_st(sr, sc), vst1 = v_st(32 + sr, sc);
  const int vb0 = (int)(uintptr_t)V_lds + v_rd_base(lane);
  struct { bf16x8 vs0, vs1, ks0, ks1; } sr_[SD];
#define TILEK(t) ((NA && (t) >= 8) ? K1 + (long)((t) - 8) * 64 * LD : K0 + (long)(t) * 64 * LD)
#define TILEV(t) ((NA && (t) >= 8) ? V1 + (long)((t) - 8) * 64 * LD : V0 + (long)(t) * 64 * LD)
#define SLOAD(i, t) do { const bf16* kp_ = TILEK(t); const bf16* vp_ = TILEV(t); \
    sr_[i].vs0 = *(const GAS bf16x8*)(&vp_[(long)sr * LD + sc]); sr_[i].vs1 = *(const GAS bf16x8*)(&vp_[(long)(32 + sr) * LD + sc]); \
    sr_[i].ks0 = *(const GAS bf16x8*)(&kp_[(long)sr * LD + sc]); sr_[i].ks1 = *(const GAS bf16x8*)(&kp_[(long)(32 + sr) * LD + sc]); } while (0)
#define SWRITE(b, i) do { *(bf16x8*)((char*)V_lds + (b) * SHM_V + vst0) = sr_[i].vs0;          \
    *(bf16x8*)((char*)V_lds + (b) * SHM_V + vst1) = sr_[i].vs1; int kc = sc * 2;               \
    *(bf16x8*)((char*)K_lds + (b) * SHM_K + KSWZ(sr, kc)) = sr_[i].ks0;                       \
    *(bf16x8*)((char*)K_lds + (b) * SHM_K + KSWZ(32 + sr, kc)) = sr_[i].ks1; } while (0)
#define SWAIT() do { if constexpr (SD == 2) asm volatile("s_waitcnt vmcnt(4)" ::: "memory"); else asm volatile("s_waitcnt vmcnt(0)" ::: "memory"); } while (0)
#define RESC(a) do { if (__any((a) < 1.f)) { if (hi == 0) al_l[r32] = (a); asm volatile("s_waitcnt lgkmcnt(0)" ::: "memory"); \
    for (int d = 0; d < 4; ++d) for (int r = 0; r < 16; ++r) o[d][r] *= al_l[crow(r, hi)]; } } while (0)
#define MASK(P0, P1, t) do { if (NA && (t) >= 8) na_mask(P0, P1, lo + (t) - 8, qrow, rs, wsn, rpbl, hi); } while (0)
  f32x16 pA0, pA1, pB0, pB1; float mnA, mnB, alA, alB; bf16x8 pa0, pa1, pa2, pa3;
  constexpr int SE = 0, SO = SD - 1;
  SLOAD(SE, 0); asm volatile("s_waitcnt vmcnt(0)" ::: "memory"); SWRITE(0, SE); __syncthreads();
  qkt(pA0, pA1, K_lds, qr, r32, hi); partialSM(pA0, pA1, m_reg, mnA, alA);
  SLOAD(SO, 1); if constexpr (SD == 2) { if (2 < NT) SLOAD(SE, 2); }
  SWAIT(); SWRITE(1, SO); __syncthreads();
  for (int j = 1; j + 1 < NT; j += 2) {
    SBAR(); qkt(pB0, pB1, (bf16*)((char*)K_lds + SHM_K), qr, r32, hi); MASK(pB0, pB1, j);
    finishSM(pA0, pA1, alA, l_reg, pa0, pa1, pa2, pa3); SBAR();
    SLOAD(SO, j + SD); SBAR();
    pv_d0(o, vb0, pa0, pa1, pa2, pa3); partialSM(pB0, pB1, m_reg, mnB, alB);
    __syncthreads(); SWAIT(); SWRITE(0, SE);
    RESC(alB); __syncthreads();
    SBAR(); qkt(pA0, pA1, K_lds, qr, r32, hi); MASK(pA0, pA1, j + 1);
    finishSM(pB0, pB1, alB, l_reg, pa0, pa1, pa2, pa3); SBAR();
    if (SD == 1 || j + 3 < NT) SLOAD(SE, j + 1 + SD); SBAR();
    pv_d0(o, vb0 + (int)SHM_V, pa0, pa1, pa2, pa3); partialSM(pA0, pA1, m_reg, mnA, alA);
    __syncthreads(); SWAIT(); SWRITE(1, SO);
    RESC(alA); __syncthreads();
  }
  SBAR(); qkt(pB0, pB1, (bf16*)((char*)K_lds + SHM_K), qr, r32, hi); MASK(pB0, pB1, NT - 1);
  finishSM(pA0, pA1, alA, l_reg, pa0, pa1, pa2, pa3); SBAR();
  pv_d0(o, vb0, pa0, pa1, pa2, pa3); partialSM(pB0, pB1, m_reg, mnB, alB);
  __syncthreads(); RESC(alB);
  finishSM(pB0, pB1, alB, l_reg, pa0, pa1, pa2, pa3); SBAR();
  pv_d0(o, vb0 + (int)SHM_V, pa0, pa1, pa2, pa3);
  if (hi == 0) li_l[r32] = l_reg; asm volatile("s_waitcnt lgkmcnt(0)" ::: "memory");
  float rli[16];
#pragma unroll
  for (int r = 0; r < 16; ++r) rli[r] = __builtin_amdgcn_rcpf(li_l[crow(r, hi)]);
  bf16* Ow = Ob + (long)(wid * QBLK) * LD;
#pragma unroll
  for (int r = 0; r < 16; ++r) { int orow = crow(r, hi);
    for (int d0 = 0; d0 < 4; ++d0) *(GAS bf16*)(Ow + (long)orow * LD + d0 * 32 + r32) = (bf16)f2bf(o[d0][r] * rli[r]); }
  asm volatile("s_waitcnt vmcnt(0)" ::: "memory"); __syncthreads();
#undef TILEK
#undef TILEV
#undef SLOAD
#undef SWRITE
#undef SWAIT
#undef RESC
#undef MASK
}
}

constexpr int NWAVES = 8;
struct Args { const float* in[36]; float* out; unsigned char* ws; int ph_lo, ph_hi; };
struct Frame { LAS unsigned char* lds; char* ldsg; volatile LAS unsigned* MISC; int tid, lane, wave, vcu, G; };
constexpr int INTAB_OFF = MISC_OFF + 128;
__device__ __forceinline__ const float* ld_in(const LAS unsigned char* lds, int i) { const unsigned long long v = ((const LAS unsigned long long*)(lds + INTAB_OFF))[i];
    const unsigned lo = __builtin_amdgcn_readfirstlane((unsigned)v), hi = __builtin_amdgcn_readfirstlane((unsigned)(v >> 32)); return (const float*)(((unsigned long long)hi << 32) | lo); }
#define IN(i) ld_in(F.lds, (i))

__device__ __forceinline__ void transpose_item(const float* W, int N, int k0, int n0, bf16* WT, int ldo, int drow0, float* scr, int lane) {
    const int kr = lane >> 3, n4 = (lane & 7) * 4;
    f32x4 v[8];
#pragma unroll
    for (int i = 0; i < 8; ++i) v[i] = *(const GAS f32x4*)(W + (size_t)(k0 + kr + 8 * i) * N + n0 + n4);
#pragma unroll
    for (int i = 0; i < 8; ++i) { float* d = scr + (kr + 8 * i) * 33 + n4; d[0] = v[i].x; d[1] = v[i].y; d[2] = v[i].z; d[3] = v[i].w; }
    LDS_WAIT(); asm volatile("" ::: "memory");
    const int c = lane & 7;
#pragma unroll
    for (int j = 0; j < 4; ++j) { const int n = (lane >> 3) + 8 * j; const float* s = scr + (8 * c) * 33 + n;
        v4u o; o.x = pk2(s[0 * 33], s[1 * 33]); o.y = pk2(s[2 * 33], s[3 * 33]); o.z = pk2(s[4 * 33], s[5 * 33]); o.w = pk2(s[6 * 33], s[7 * 33]);
        *(GAS v4u*)(WT + (size_t)(drow0 + n) * ldo + k0 + 8 * c) = o; }
    LDS_WAIT(); asm volatile("" ::: "memory");
}

__device__ __forceinline__ int cv_of_row(int row) { return row < CTXR ? 0 : 1 + ((row - CTXR) >> 10); }

template <bool FIRST, bool HASNEXT>
__device__ __forceinline__ void resnorm_rows(const Frame& F, const float* xin0, const float* xin1, float* X, const bf16* Z, const float* gpost, const float* modGate  ,
                                             const float* gpre, const float* modShift, const float* modScale, bf16* H) {
    const int gw = F.vcu * NWAVES + F.wave, NGW = F.G * NWAVES;
    for (int row = gw; row < ROWS; row += NGW) {
        const int cv = cv_of_row(row);
        f32x4 x[8];
        if (FIRST) {
            const GAS f32x4* src = (const GAS f32x4*)(row < CTXR ? xin0 + (size_t)row * DM : xin1 + (size_t)(row - CTXR) * DM);
#pragma unroll
            for (int j = 0; j < 8; ++j) x[j] = src[2 * (F.lane + 64 * (j >> 1)) + (j & 1)];
        } else {
            const GAS v4u* zr = (const GAS v4u*)(Z + (size_t)row * DM); const GAS f32x4* xr = (const GAS f32x4*)(X + (size_t)row * DM);
            f32x4 z[8]; float ss = 0.f;
#pragma unroll
            for (int jj = 0; jj < 4; ++jj) { float f[8]; unpack8(zr[F.lane + 64 * jj], f); z[2 * jj] = (f32x4){f[0], f[1], f[2], f[3]}; z[2 * jj + 1] = (f32x4){f[4], f[5], f[6], f[7]}; }
#pragma unroll
            for (int j = 0; j < 8; ++j) ss += (z[j].x * z[j].x + z[j].y * z[j].y) + (z[j].z * z[j].z + z[j].w * z[j].w);
            const float rstd = rsqrtf(wave_sum(ss, F.lane) * (1.f / DM) + RMS_EPS);
#pragma unroll
            for (int j = 0; j < 8; ++j) { const int q = 2 * (F.lane + 64 * (j >> 1)) + (j & 1); const f32x4 gp = ((const GAS f32x4*)gpost)[q], gt = ((const GAS f32x4*)(modGate + (size_t)cv * 12288))[q];
                x[j] = xr[q] + gt * (z[j] * rstd * gp); }
        }
        { GAS f32x4* xo = (GAS f32x4*)(X + (size_t)row * DM);
#pragma unroll
          for (int j = 0; j < 8; ++j) xo[2 * (F.lane + 64 * (j >> 1)) + (j & 1)] = x[j]; }
        if (HASNEXT) {
            float ss = 0.f;
#pragma unroll
            for (int j = 0; j < 8; ++j) ss += (x[j].x * x[j].x + x[j].y * x[j].y) + (x[j].z * x[j].z + x[j].w * x[j].w);
            const float rstd = rsqrtf(wave_sum(ss, F.lane) * (1.f / DM) + RMS_EPS);
            GAS v4u* ho = (GAS v4u*)(H + (size_t)row * DM);
#pragma unroll
            for (int jj = 0; jj < 4; ++jj) { float f[8];
#pragma unroll
                for (int h = 0; h < 2; ++h) { const int q = 2 * (F.lane + 64 * jj) + h; const f32x4 g = ((const GAS f32x4*)gpre)[q], sh = ((const GAS f32x4*)(modShift + (size_t)cv * 12288))[q], sc = ((const GAS f32x4*)(modScale + (size_t)cv * 12288))[q];
                    const f32x4 hv = x[2 * jj + h] * rstd * g * (sc + 1.0f) + sh; f[4 * h] = hv.x; f[4 * h + 1] = hv.y; f[4 * h + 2] = hv.z; f[4 * h + 3] = hv.w; }
                ho[F.lane + 64 * jj] = pack8(f); }
        }
    }
}

__device__ __forceinline__ void s5_tables(const Frame& F, int l, int g, unsigned char* ws) {
    char* L = F.ldsg;
    f32x2* POW = (f32x2*)L;
    f32x2* BB = (f32x2*)(L + 17408);
    f32x2* CC = (f32x2*)(L + 17408 + 16384);
    float* KT = (float*)(L + 17408 + 32768);
    const int tid = F.tid;
    __syncthreads();
    if (tid < 128) {
        const int d = tid >> 6, p = tid & 63; const size_t li = ((size_t)(l * 2 + d) * 64 + g) * 64 + p;
        const float dt = expf(IN(22)[(l * 2 + d) * 64 + g]); const float lre = IN(20)[li], lim = IN(21)[li];
        const float er = expf(lre * dt); float sn, cs; sincosf(lim * dt, &sn, &cs);
        const float br = er * cs, bi = er * sn;
        const float nr = br - 1.0f, ni = bi, den = lre * lre + lim * lim;
        const float cr = (nr * lre + ni * lim) / den, ci = (ni * lre - nr * lim) / den;
        float pr = 1.f, pi = 0.f;
        for (int t = 0; t <= 16; ++t) { POW[(d * 64 + p) * 17 + t] = (f32x2){pr, pi}; const float nr2 = pr * br - pi * bi, ni2 = pr * bi + pi * br; pr = nr2; pi = ni2; }
        ((f32x2*)(ws + WS_LT))[li] = POW[(d * 64 + p) * 17 + 16];
        for (int m = 0; m < 16; ++m) { const float xr = IN(23)[li * 16 + m], xi = IN(24)[li * 16 + m]; BB[(d * 64 + p) * 16 + m] = (f32x2){cr * xr - ci * xi, cr * xi + ci * xr}; }
    }
    for (int i = tid; i < 2048; i += 512) { const int d = i >> 10, n = (i >> 6) & 15, p = i & 63; const size_t ci_ = (((size_t)(l * 2 + d) * 64 + g) * 16 + n) * 64 + p; CC[i] = (f32x2){IN(25)[ci_], IN(26)[ci_]}; }
    __syncthreads();
    for (int i = tid; i < 8192; i += 512) {
        const int d = i >> 12, tau = (i >> 8) & 15, n = (i >> 4) & 15, m = i & 15; float s = 0.f;
        for (int p = 0; p < 64; ++p) { const f32x2 c = CC[(d * 16 + n) * 64 + p], w = POW[(d * 64 + p) * 17 + tau], b = BB[(d * 64 + p) * 16 + m];
            const float tr = c.x * w.x - c.y * w.y, ti = c.x * w.y + c.y * w.x; s += tr * b.x - ti * b.y; }
        KT[i] = s;
    }
    __syncthreads();
    bf16* MT = (bf16*)(ws + WS_MT) + (size_t)(l * 64 + g) * 65536; bf16* ET = (bf16*)(ws + WS_ET) + (size_t)(l * 64 + g) * 65536; bf16* FT = (bf16*)(ws + WS_FT) + (size_t)(l * 64 + g) * 65536;
    for (int i = tid; i < 8192; i += 512) {
        const int rowi = i >> 5, k0 = (i & 31) * 8;
        { const int t = rowi >> 4, n = rowi & 15, s = k0 >> 4, m0 = k0 & 15; float f[8];
#pragma unroll
          for (int e = 0; e < 8; ++e) { float v = 0.f; if (s <= t) v += KT[((0 * 16 + (t - s)) * 16 + n) * 16 + m0 + e]; if (s >= t) v += KT[((1 * 16 + (s - t)) * 16 + n) * 16 + m0 + e]; f[e] = v; }
          *(GAS v4u*)(MT + (size_t)rowi * 256 + k0) = pack8(f); }
        { const int d = rowi >> 7, p = (rowi >> 1) & 63, c = rowi & 1, s = k0 >> 4, m0 = k0 & 15; float f[8];
          const f32x2 w = POW[(d * 64 + p) * 17 + (d == 0 ? 15 - s : s)];
#pragma unroll
          for (int e = 0; e < 8; ++e) { const f32x2 b = BB[(d * 64 + p) * 16 + m0 + e]; f[e] = c == 0 ? (w.x * b.x - w.y * b.y) : (w.x * b.y + w.y * b.x); }
          *(GAS v4u*)(ET + (size_t)rowi * 256 + k0) = pack8(f); }
        { const int t = rowi >> 4, n = rowi & 15; float f[8];
#pragma unroll
          for (int e = 0; e < 8; ++e) { const int k = k0 + e, d = k >> 7, p = (k >> 1) & 63, c = k & 1; const f32x2 cc = CC[(d * 16 + n) * 64 + p], w = POW[(d * 64 + p) * 17 + (d == 0 ? t + 1 : 16 - t)];
              f[e] = c == 0 ? (cc.x * w.x - cc.y * w.y) : -(cc.x * w.y + cc.y * w.x); }
          *(GAS v4u*)(FT + (size_t)rowi * 256 + k0) = pack8(f); }
    }
    __syncthreads();
}

constexpr int I_WIN = 32 * 384, I_GLU = 16 * 32, I_OUT = 16 * 64, I_WO = 32 * 64, I_FIN = 32 * 352, I_FOUT = 88 * 64, I_GW = 32 * 8;
constexpr int I_LAYER = I_WIN + I_GLU + 3 * I_OUT + I_WO + I_FIN + I_FOUT + I_GW;
__device__ __forceinline__ void weight_item(const Frame& F, unsigned char* ws, int l, int r, float* scr) {
    if (r < I_WIN) { const int kb = r / 384, nb = r % 384; transpose_item(IN(14) + (size_t)l * DM * INW, INW, kb * 64, nb * 32, (bf16*)(ws + WS_WINT) + (size_t)l * INW * DM, DM, nb * 32, scr, F.lane); return; } r -= I_WIN;
    if (r < I_GLU) { const int kb = r / 32, nb = r % 32; transpose_item(IN(28) + (size_t)l * 1024 * 1024, 1024, kb * 64, nb * 32, (bf16*)(ws + WS_GLUT) + (size_t)l * 1024 * 1024, 1024, nb * 32, scr, F.lane); return; } r -= I_GLU;
    if (r < 3 * I_OUT) { const int b = r / I_OUT, q = r % I_OUT, kb = q / 64, nb = q % 64; transpose_item(IN(30 + b) + (size_t)l * 1024 * DM, DM, kb * 64, nb * 32, (bf16*)(ws + WS_OUTT) + ((size_t)l * 3 + b) * DM * 1024, 1024, nb * 32, scr, F.lane); return; } r -= 3 * I_OUT;
    if (r < I_WO) { const int kb = r / 64, nb = r % 64; transpose_item(IN(33) + (size_t)l * DM * DM, DM, kb * 64, nb * 32, (bf16*)(ws + WS_WOT) + (size_t)l * DM * DM, DM, nb * 32, scr, F.lane); return; } r -= I_WO;
    if (r < I_FIN) { const int kb = r / 352, nb = r % 352; const int n0 = nb * 32, half = n0 >= FFH, j = n0 - half * FFH; const int drow = 256 * (j >> 7) + 128 * half + (j & 127);
        transpose_item(IN(34) + (size_t)l * DM * 2 * FFH, 2 * FFH, kb * 64, n0, (bf16*)(ws + WS_FINT) + (size_t)l * 2 * FFH * DM, DM, drow, scr, F.lane); return; } r -= I_FIN;
    if (r < I_FOUT) { const int kb = r / 64, nb = r % 64; transpose_item(IN(35) + (size_t)l * FFH * DM, DM, kb * 64, nb * 32, (bf16*)(ws + WS_FOUTT) + (size_t)l * DM * FFH, FFH, nb * 32, scr, F.lane); return; } r -= I_FOUT;
    { const int mi = r >> 3, q = r & 7, kb = q >> 2, nb = q & 3;
      const int d = mi >> 4, g = (mi >> 3) & 1, h = mi & 7;
      transpose_item(IN(17) + ((size_t)l * 32 + mi) * 128 * 128, 128, kb * 64, nb * 32, (bf16*)(ws + WS_GWT) + (((size_t)l * 8 + h) * 2 + d) * 256 * 128, 128, g * 128 + nb * 32, scr, F.lane); }
}
constexpr int QB = 16;
static_assert(I_LAYER % QB == 0, "queue batch");
constexpr int Q_P2 = 562 * QB, Q_P3 = 624 * QB, Q_P4 = 1374 * QB, Q_P5 = 1813 * QB, Q_P9 = I_LAYER;
constexpr int CW_Q = 8192;
__device__ __forceinline__ void pull_weight_items(const Frame& F, unsigned char* ws, int l, int upto) {
    if (l >= NL) return;
    unsigned* ctr = (unsigned*)(ws + WS_CTL) + CW_Q + 64 * l; float* scr = (float*)(F.ldsg + F.wave * 16384);
    const int upto_b = upto / QB;
    for (;;) {
        unsigned i = 0;
        if (F.lane == 0) asm volatile("global_atomic_add %0, %1, %2, off sc0\n\ts_waitcnt vmcnt(0)" : "=&v"(i) : "v"(ctr), "v"(1u) : "memory");
        i = (unsigned)__builtin_amdgcn_readfirstlane((int)i);
        if ((int)i >= upto_b) { if (F.lane == 0) asm volatile("global_atomic_sub %0, %1, off" :: "v"(ctr), "v"(1u) : "memory"); break; }
        for (int j = 0; j < QB; ++j) weight_item(F, ws, l, (int)i * QB + j, scr);
    }
}

constexpr int SQ_P5 = 6, SQ_P9 = 10, SQ_END = (SQ_P5 + SQ_P9) * 1024;
__device__ __forceinline__ void static_weight_items(const Frame& F, unsigned char* ws, int l, int c, int G, int k0, int nk) {
    if (l >= NL || G != 256 || c < 128) return;
    float* scr = (float*)(F.ldsg + F.wave * 16384); const int w = (c - 128) * 8 + F.wave;
    for (int k = 0; k < nk; ++k) weight_item(F, ws, l, (k0 + k) * 1024 + w, scr);
}

__global__ void __launch_bounds__(NWAVES * 64, 2) fwd_kernel(Args args) {
    extern __shared__ __attribute__((aligned(16))) unsigned char lds[];
    const int G0 = gridDim.x, c0 = (int)blockIdx.x;
    volatile LAS unsigned* MISC0 = (volatile LAS unsigned*)((LAS unsigned char*)lds + MISC_OFF);
    unsigned char* const ws0 = args.ws; float* const out0 = args.out;
    gu32* ctl = (gu32*)(ws0 + WS_CTL);
    for (int u = threadIdx.x; u < (LDS_BYTES - LDSCTL_OFF) / 4; u += NWAVES * 64) ((LAS unsigned*)((LAS unsigned char*)lds + LDSCTL_OFF))[u] = 0u;
    __syncthreads();
    if (threadIdx.x == 0) {
#pragma unroll
        for (int i = 0; i < 36; ++i) ((LAS unsigned long long*)((LAS unsigned char*)lds + INTAB_OFF))[i] = (unsigned long long)args.in[i]; }
    __syncthreads();
    XcdBarrier bar; bar.bar = (unsigned*)(ctl + CW_BAR); bar.x = 0; bar.st = nullptr;
    if (MK_N_LAUNCHES == 1) bar = xcd_barrier_post((unsigned*)(ctl + CW_BAR), MISC0 + 8);
    const int lo = args.ph_lo, hi = args.ph_hi;
    int ph = 0;
#ifndef PHMASK
#define PHMASK 0xFFFFFFFFu
#endif
#define PHASE_BEGIN(k) if (((PHMASK >> (k)) & 1u) && lo <= ph && ph < hi) { if ((k) == TSEL && threadIdx.x == 0) *(volatile LAS unsigned long long*)(MISC0 + 16) = __builtin_amdgcn_s_memrealtime(); unsigned char* ws = ws0; float* outp = out0; int tid_p = threadIdx.x, G = G0, c = c0; asm volatile("" : "+s"(ws), "+s"(outp), "+v"(tid_p), "+s"(G), "+s"(c)); const int vcu = (G % 8 == 0) ? (c % 8) * (G / 8) + c / 8 : c;     \
    Frame F; F.lds = (LAS unsigned char*)lds; F.ldsg = (char*)lds; F.MISC = (volatile LAS unsigned*)(F.lds + MISC_OFF); F.tid = tid_p; F.lane = tid_p & 63; F.wave = __builtin_amdgcn_readfirstlane(tid_p >> 6); F.G = G; F.vcu = vcu; \
    const int gw = vcu * NWAVES + F.wave, NGW = G * NWAVES, gt = vcu * 512 + F.tid, NGT = G * 512; (void)gw; (void)NGW; (void)gt; (void)NGT; \
    float* const X = outp + O_X; bf16* const Hb = (bf16*)(ws + WS_H); float* const MOD = (float*)(ws + WS_MOD); const float* const modl = MOD + (size_t)l_ * NCV * INW; (void)X; (void)Hb; (void)modl;
#define PHASE_END(k)   if (MK_N_LAUNCHES == 1 && ph + 1 < hi) { XcdBarrier b_ = bar; asm volatile("" : "+s"(b_.bar)); xcd_barrier(b_); } if ((k) == TSEL && threadIdx.x == 0) *(volatile LAS unsigned long long*)(MISC0 + 18) += __builtin_amdgcn_s_memrealtime() - *(volatile LAS unsigned long long*)(MISC0 + 16); } ++ph;
    int l_ = 0;

    PHASE_BEGIN(0)
    {
        for (int it = F.vcu; it < NL * 64; it += G) s5_tables(F, it >> 6, it & 63, ws);
        __syncthreads();
        { const float* lamp = IN(19); for (int i = gt; i < NL * 2 * 1024; i += NGT) ((float*)(ws + WS_SP))[i] = log1pf(expf(-lamp[i])); }
        float* scr = (float*)(F.ldsg + F.wave * 16384);
        { const int rest = (G == 256) ? I_LAYER - SQ_END : I_LAYER;
          for (int it = gw; it < I_LAYER + 3 * rest; it += NGW) { if (it < I_LAYER) weight_item(F, ws, 0, it, scr); else { const int q = it - I_LAYER, l = 1 + q / rest, r = q % rest; weight_item(F, ws, l, I_LAYER - rest + r, scr); } } }
        const float* ckp = IN(2); const float* cvp = IN(3);
        for (int i = gt; i < 2 * 1048576; i += NGT) { const int which = i >> 20, j = i & 1048575; const GAS f32x4* s = (const GAS f32x4*)(which ? cvp : ckp) + (size_t)j * 2; const f32x4 a0 = s[0], a1 = s[1];
            v4u o; o.x = pk2(a0.x, a0.y); o.y = pk2(a0.z, a0.w); o.z = pk2(a1.x, a1.y); o.w = pk2(a1.z, a1.w); ((GAS v4u*)(ws + (which ? WS_CV : WS_CK)))[j] = o; }
        const float* cctx = IN(7); const float* cvec = IN(6); const float* wmod = IN(8);
        for (int task = gt; task < 16 * NL * 3072; task += NGT) {
            const int n4 = task % 3072, l = (task / 3072) % NL, ks = task / (3072 * NL);
            f32x4 acc[NCV];
#pragma unroll
            for (int v = 0; v < NCV; ++v) acc[v] = (f32x4){0.f, 0.f, 0.f, 0.f};
            const GAS f32x4* wp = (const GAS f32x4*)(wmod + ((size_t)l * DM + ks * 128) * INW) + n4;
#pragma unroll 16
            for (int k = 0; k < 128; ++k) { const f32x4 w = wp[(size_t)k * (INW / 4)]; const int kk = ks * 128 + k;
#pragma unroll
                for (int v = 0; v < NCV; ++v) { const float cnd = v == 0 ? cctx[kk] : cvec[(v - 1) * DM + kk]; const float sl = cnd * fsigmoid(cnd); acc[v] += w * sl; } }
#pragma unroll
            for (int v = 0; v < NCV; ++v) ((f32x4*)(ws + WS_MODP))[(((size_t)ks * NL + l) * NCV + v) * 3072 + n4] = acc[v];
        }
    }
    PHASE_END(0)
    PHASE_BEGIN(1)
        const float* bmod = IN(9);
        for (int i = gt; i < NL * NCV * 3072; i += NGT) { const int n4 = i % 3072, v = (i / 3072) % NCV, l = i / (3072 * NCV);
            f32x4 s = ((const f32x4*)(bmod + (size_t)l * INW))[n4];
#pragma unroll
            for (int ks = 0; ks < 16; ++ks) s += ((const f32x4*)(ws + WS_MODP))[(((size_t)ks * NL + l) * NCV + v) * 3072 + n4];
            ((f32x4*)MOD)[i] = s; }
    PHASE_END(1)
    PHASE_BEGIN(2)
        resnorm_rows<true, true>(F, IN(0), IN(1), X, nullptr, nullptr, nullptr, IN(10), MOD + 0 * DM, MOD + 1 * DM, Hb);
    PHASE_END(2)

    for (int l = 0; l < DBG_NL; ++l) {
        l_ = l;
        PHASE_BEGIN(3)
        {   pg8::SchedPlain S{(const char*)Hb, (const char*)(ws + WS_WINT) + (size_t)l * INW * DM * 2, 32, 48, G, c, (size_t)256 * DM * 2, (size_t)256 * DM * 2, DUPG1};
            pg8::EpiWin E{(bf16*)(ws + WS_XR), (bf16*)(ws + WS_XG), (bf16*)(ws + WS_UG), (bf16*)(ws + WS_Q), (bf16*)(ws + WS_K), (bf16*)(ws + WS_V), (bf16*)(ws + WS_G),
                          outp + O_K + (size_t)l * 256 * 1024, outp + O_V + (size_t)l * 256 * 1024};
            pg8::gemm_phase(F.lds, DM, DM, DM, S, E); }
        PHASE_END(3)
        PHASE_BEGIN(4)
        {
            { const bf16* XR = (const bf16*)(ws + WS_XR); bf16* XC = (bf16*)(ws + WS_XC); const GAS float* cw = (const GAS float*)(IN(15) + (size_t)l * 4 * 1024); const GAS float* cb = (const GAS float*)(IN(16) + (size_t)l * 1024);
              for (int i_ = gt; i_ < ROWS * 128 * DUP_CONV; i_ += NGT) { const int i = i_ % (ROWS * 128); const int row = i >> 7, c8 = (i & 127) * 8;
                  const int s0 = row < CTXR ? (row & ~255) : (CTXR + ((row - CTXR) & ~1023)), s1 = row < CTXR ? s0 + 256 : s0 + 1024;
                  float acc[8];
#pragma unroll
                  for (int e = 0; e < 8; ++e) acc[e] = cb[c8 + e];
#pragma unroll
                  for (int k = 0; k < 4; ++k) { const int rr = row + k - 1; if (rr >= s0 && rr < s1) { float xv[8]; unpack8(*(const GAS v4u*)(XR + (size_t)rr * 1024 + c8), xv);
#pragma unroll
                      for (int e = 0; e < 8; ++e) acc[e] += cw[k * 1024 + c8 + e] * xv[e]; } }
                  *(GAS v4u*)(XC + (size_t)row * 1024 + c8) = pack8(acc); } }
            for (int L = c; L < 128 * DUP_S5; L += G) { const int g = (L & 127) >> 1, pm = L & 1;
                { pg8::SchedOne S{(const char*)(ws + WS_UG) + ((size_t)g * 512 + pm * 256) * 256 * 2, (const char*)(ws + WS_ET) + ((size_t)l * 64 + g) * 65536 * 2, nullptr, nullptr, pm, g, 1}; pg8::EpiHloc E{(float*)(ws + WS_HLOC)};
                  pg8::gemm_phase(F.lds, 256, 256, 256, S, E); }
                { const float* HLOC = (const float*)(ws + WS_HLOC); bf16* HIN = (bf16*)(ws + WS_HIN); const GAS f32x2* LT = (const GAS f32x2*)(ws + WS_LT) + (size_t)l * 2 * 64 * 64;
                  const int nseq = pm ? 4 : 16, nch = pm ? 64 : 16;
                  for (int i = F.tid; i < nseq * 128; i += 512) { const int p = i & 63, d = (i >> 6) & 1, sq = i >> 7; const int seq = pm ? 16 + sq : sq, ch0 = pm ? 256 + sq * 64 : sq * 16;
                      const f32x2 lam = LT[(d * 64 + g) * 64 + p]; float hr = 0.f, hi_ = 0.f;
                      if (pm) { const f32x2 h0 = ((const f32x2*)IN(5))[((((size_t)sq * 4 + l) * 2 + d) * 64 + g) * 64 + p]; hr = h0.x; hi_ = h0.y; }
                      for (int kb = 0; kb < nch; kb += 16) { f32x2 hl[16];
#pragma unroll
                          for (int j = 0; j < 16; ++j) { const int ch = d == 0 ? ch0 + kb + j : ch0 + nch - 1 - kb - j; hl[j] = *(const GAS f32x2*)(HLOC + ((size_t)g * 512 + ch) * 256 + d * 128 + p * 2); }
#pragma unroll
                          for (int j = 0; j < 16; ++j) { const int ch = d == 0 ? ch0 + kb + j : ch0 + nch - 1 - kb - j; *(GAS unsigned*)(HIN + ((size_t)g * 512 + ch) * 256 + d * 128 + p * 2) = pk2(hr, hi_);
                              const float nr = lam.x * hr - lam.y * hi_ + hl[j].x, ni = lam.x * hi_ + lam.y * hr + hl[j].y; hr = nr; hi_ = ni; } }
                      if (!pm) ((f32x2*)(outp + O_S5))[((((size_t)seq * 4 + l) * 2 + d) * 64 + g) * 64 + p] = (f32x2){hr, hi_}; }
                  VM_WAIT(); __syncthreads(); }
                { pg8::SchedOne S{(const char*)(ws + WS_UG) + ((size_t)g * 512 + pm * 256) * 256 * 2, (const char*)(ws + WS_MT) + ((size_t)l * 64 + g) * 65536 * 2,
                                  (const char*)(ws + WS_HIN) + ((size_t)g * 512 + pm * 256) * 256 * 2, (const char*)(ws + WS_FT) + ((size_t)l * 64 + g) * 65536 * 2, pm, g, 2};
                  pg8::EpiS5Y E{(const bf16*)(ws + WS_UG), IN(27) + (size_t)l * 1024, (bf16*)(ws + WS_ZS)};
                  pg8::gemm_phase(F.lds, 256, 256, 256, S, E); }
            }
            __syncthreads();
            { float* rp = (float*)(F.ldsg + att::RPB_OFF); const bf16* Qb = (const bf16*)(ws + WS_Q); const bf16* Kb = (const bf16*)(ws + WS_K); const bf16* Vb = (const bf16*)(ws + WS_V); bf16* Ob = (bf16*)(ws + WS_YNA);
              for (int u_ = (c + G / 2) % G; u_ < 256 * DUP_ATT; u_ += G) { const int u = u_ & 255;
                  if (u < 128) { const int b = u >> 5, h = (u >> 2) & 7, rg = u & 3; const int lo_ = rg == 0 ? 0 : (rg == 1 ? 0 : (rg == 2 ? 4 : 8)), NT = (rg == 0 || rg == 3) ? 16 : 20;
                      for (int i = F.tid; i < 465; i += 512) rp[i] = IN(29)[((size_t)l * 8 + h) * 465 + i] * (1.0f / att::SCALE);
                      __syncthreads();
                      const size_t qoff = (size_t)(CTXR + b * 1024 + rg * 256) * 1024 + h * 128, koff = (size_t)(CTXR + b * 1024 + lo_ * 64) * 1024 + h * 128, coff = ((size_t)(b * 4 + l) * 512) * 1024 + h * 128;
                      att::attn_body<true, 1>(Qb + qoff, (const bf16*)(ws + WS_CK) + coff, (const bf16*)(ws + WS_CV) + coff, Kb + koff, Vb + koff, Ob + qoff, NT, lo_, rg, F.ldsg);
                  } else { const int b = (u - 128) >> 3, h = (u - 128) & 7; const size_t off = (size_t)(b * 256) * 1024 + h * 128;
                      att::attn_body<false, 2>(Qb + off, Kb + off, Vb + off, Kb + off, Vb + off, Ob + off, 4, 0, 0, F.ldsg); }
              } }
        }
        PHASE_END(4)
        PHASE_BEGIN(5)
        {   { pg8::SchedRg S{(const char*)(ws + WS_XC), (const char*)(ws + WS_GWT) + (size_t)l * 8 * 2 * 256 * 128 * 2, G, c};
              pg8::EpiRg E{(const bf16*)(ws + WS_XC), IN(18) + (size_t)l * 4 * 1024, (const float*)(ws + WS_SP) + (size_t)l * 2048, (f32x2*)(ws + WS_AB)};
              pg8::gemm_phase(F.lds, 128, 1024, 128, S, E); }
            { pg8::SchedPlain S{(const char*)(ws + WS_ZS), (const char*)(ws + WS_GLUT) + (size_t)l * 1024 * 1024 * 2, 32, 4, G, c, (size_t)256 * 1024 * 2, (size_t)256 * 1024 * 2, 1};
              pg8::EpiGlu E{(const bf16*)(ws + WS_ZS), (bf16*)(ws + WS_YS5)};
              pg8::gemm_phase(F.lds, 1024, 1024, 1024, S, E); }
            __syncthreads(); static_weight_items(F, ws, l + 1, c, G, 0, SQ_P5);
        }
        PHASE_END(5)
        PHASE_BEGIN(6)
        {
            { const GAS f32x2* AB = (const GAS f32x2*)(ws + WS_AB); GAS float* HF = (GAS float*)(ws + WS_HF); const GAS bf16* XG = (const GAS bf16*)(ws + WS_XG); GAS bf16* YRG = (GAS bf16*)(ws + WS_YRG);
              float* cs = (float*)F.ldsg;
              for (int task_ = (c + G / 2) % G; task_ < 320 * DUP_SCAN; task_ += G) { const int task = task_ % 320;
                  const bool lat = task >= 64 && task < 128; const int ti = lat ? task - 64 : (task < 64 ? task : task - 64); const int seq = ti >> 4, cb = ti & 15;
                  const int L = lat ? 1024 : 256, row0 = lat ? CTXR + seq * 1024 : seq * 256, ch = cb * 64 + F.lane, len = L / 8, t0 = row0 + F.wave * len;
                  __syncthreads();
                  float pf = 1.f, hf = 0.f, pb = 1.f, hb = 0.f;
                  for (int tb = 0; tb < len; tb += 16) { f32x2 v[16];
#pragma unroll
                      for (int j = 0; j < 16; ++j) v[j] = AB[(size_t)(t0 + tb + j) * 1024 + ch];
#pragma unroll
                      for (int j = 0; j < 16; ++j) { hf = v[j].x * hf + v[j].y; pf *= v[j].x; } }
                  for (int tb = len - 16; tb >= 0; tb -= 16) { f32x2 v[16];
#pragma unroll
                      for (int j = 0; j < 16; ++j) v[j] = AB[((size_t)ROWS + t0 + tb + j) * 1024 + ch];
#pragma unroll
                      for (int j = 15; j >= 0; --j) { hb = v[j].x * hb + v[j].y; pb *= v[j].x; } }
                  cs[(F.wave * 4 + 0) * 64 + F.lane] = pf; cs[(F.wave * 4 + 1) * 64 + F.lane] = hf; cs[(F.wave * 4 + 2) * 64 + F.lane] = pb; cs[(F.wave * 4 + 3) * 64 + F.lane] = hb;
                  __syncthreads();
                  float cf = lat ? IN(4)[((size_t)(seq * 4 + l) * 2 + 0) * 1024 + ch] : 0.f, cbk = lat ? IN(4)[((size_t)(seq * 4 + l) * 2 + 1) * 1024 + ch] : 0.f;
                  for (int w = 0; w < F.wave; ++w) cf = cs[(w * 4 + 0) * 64 + F.lane] * cf + cs[(w * 4 + 1) * 64 + F.lane];
                  for (int w = 7; w > F.wave; --w) cbk = cs[(w * 4 + 2) * 64 + F.lane] * cbk + cs[(w * 4 + 3) * 64 + F.lane];
                  if (!lat) { if (F.wave == 7) outp[O_RG + ((size_t)(seq * 4 + l) * 2 + 0) * 1024 + ch] = pf * cf + hf; if (F.wave == 0) outp[O_RG + ((size_t)(seq * 4 + l) * 2 + 1) * 1024 + ch] = pb * cbk + hb; }
                  float h = cf;
                  for (int tb = 0; tb < len; tb += 16) { f32x2 v[16];
#pragma unroll
                      for (int j = 0; j < 16; ++j) v[j] = AB[(size_t)(t0 + tb + j) * 1024 + ch];
#pragma unroll
                      for (int j = 0; j < 16; ++j) { h = v[j].x * h + v[j].y; HF[(size_t)(t0 + tb + j) * 1024 + ch] = h; } }
                  VM_WAIT();
                  h = cbk;
                  for (int tb = len - 16; tb >= 0; tb -= 16) { f32x2 v[16]; float hfv[16]; bf16 xg[16];
#pragma unroll
                      for (int j = 0; j < 16; ++j) { const size_t o = (size_t)(t0 + tb + j) * 1024 + ch; v[j] = AB[(size_t)ROWS * 1024 + o]; hfv[j] = HF[o]; xg[j] = XG[o]; }
#pragma unroll
                      for (int j = 15; j >= 0; --j) { h = v[j].x * h + v[j].y; YRG[(size_t)(t0 + tb + j) * 1024 + ch] = (bf16)f2bf((hfv[j] + h) * bf2f(xg[j])); } }
              } }
        }
        PHASE_END(6)
        PHASE_BEGIN(8)
        {   pg8::SchedMerge S{(const char*)(ws + WS_YRG), (const char*)(ws + WS_YS5), (const char*)(ws + WS_YNA), (const char*)(ws + WS_OUTT) + (size_t)l * 3 * DM * 1024 * 2, G, c};
            pg8::EpiMerge E{(const bf16*)(ws + WS_G), (bf16*)(ws + WS_MM)};
            pg8::gemm_phase(F.lds, 1024, 1024, 1024, S, E); }
        PHASE_END(8)
        PHASE_BEGIN(9)
        {   pg8::SchedPlain S{(const char*)(ws + WS_MM), (const char*)(ws + WS_WOT) + (size_t)l * DM * DM * 2, 32, 8, G, c, (size_t)256 * DM * 2, (size_t)256 * DM * 2, 1};
            pg8::EpiB16 E{(bf16*)(ws + WS_Z), DM};
            pg8::gemm_phase(F.lds, DM, DM, DM, S, E); }
        PHASE_END(9)
        PHASE_BEGIN(10)
            resnorm_rows<false, true>(F, nullptr, nullptr, X, (const bf16*)(ws + WS_Z), IN(11) + (size_t)l * DM, modl + 2 * DM, IN(12) + (size_t)l * DM, modl + 3 * DM, modl + 4 * DM, Hb);
        PHASE_END(10)
        PHASE_BEGIN(11)
        {   pg8::SchedPlain S{(const char*)Hb, (const char*)(ws + WS_FINT) + (size_t)l * 2 * FFH * DM * 2, 32, 44, G, c, (size_t)256 * DM * 2, (size_t)256 * DM * 2, DUPG9};
            pg8::EpiSwiglu E{(bf16*)(ws + WS_FH)};
            pg8::gemm_phase(F.lds, DM, DM, DM, S, E);
            __syncthreads(); static_weight_items(F, ws, l + 1, c, G, SQ_P5, SQ_P9); }
        PHASE_END(11)
        PHASE_BEGIN(12)
        {   pg8::SchedPlain S{(const char*)(ws + WS_FH), (const char*)(ws + WS_FOUTT) + (size_t)l * DM * FFH * 2, 32, 8, G, c, (size_t)256 * FFH * 2, (size_t)256 * FFH * 2, DUPG10};
            pg8::EpiB16 E{(bf16*)(ws + WS_Z), DM};
            pg8::gemm_phase(F.lds, FFH, FFH, FFH, S, E); }
        PHASE_END(12)
        PHASE_BEGIN(13)
            if (l + 1 < NL) resnorm_rows<false, true>(F, nullptr, nullptr, X, (const bf16*)(ws + WS_Z), IN(13) + (size_t)l * DM, modl + 5 * DM, IN(10) + (size_t)(l + 1) * DM, modl + NCV * INW + 0 * DM, modl + NCV * INW + 1 * DM, Hb);
            else resnorm_rows<false, false>(F, nullptr, nullptr, X, (const bf16*)(ws + WS_Z), IN(13) + (size_t)l * DM, modl + 5 * DM, nullptr, nullptr, nullptr, Hb);
        PHASE_END(13)
    }
#if DBG_KEEP
    PHASE_BEGIN(14)
        for (size_t i = (size_t)gt; i < O_END; i += (size_t)NGT) {
            int r, lay = 0;
            if (i < O_K) r = i < O_K / 2 ? 0 : 1;
            else if (i < O_V) { r = 2; lay = (int)(((i - O_K) / (256 * 1024)) & 3); }
            else if (i < O_RG) { r = 3; lay = (int)(((i - O_V) / (256 * 1024)) & 3); }
            else if (i < O_S5) { r = 4; lay = (int)(((i - O_RG) / 2048) & 3); }
            else { r = 5; lay = (int)(((i - O_S5) / 16384) & 3); }
            const bool keep = ((DBG_KEEP >> r) & 1) && (r < 2 || ((DBG_LMASK >> lay) & 1));
            float v = keep ? 3.0f * outp[i] : 0.0f;
#if DBG_DUMP
            v = 0.f;
            if (i >= O_K && i < O_K + (size_t)ROWS * 1024) { const size_t j = i - O_K;
                if (DBG_DUMP == 1) v = bf2f(((const bf16*)(ws + WS_YNA))[j]);
                if (DBG_DUMP == 2) v = bf2f(((const bf16*)(ws + WS_YS5))[j]);
                if (DBG_DUMP == 3) v = bf2f(((const bf16*)(ws + WS_YRG))[j]);
                if (DBG_DUMP == 4) v = bf2f(((const bf16*)(ws + WS_ZS))[j]);
                if (DBG_DUMP == 5) v = bf2f(((const bf16*)(ws + WS_MM))[j]);
                if (DBG_DUMP == 6) v = ((const bf16*)(ws + WS_Z))[j];
                if (DBG_DUMP == 7) v = bf2f(((const bf16*)(ws + WS_FH))[j]);
                if (DBG_DUMP == 8) v = bf2f(((const bf16*)(ws + WS_H))[j]);
                if (DBG_DUMP == 9) v = bf2f(((const bf16*)(ws + WS_G))[j]);
                if (DBG_DUMP == 11) v = bf2f(((const bf16*)(ws + WS_G))[(size_t)8192 * 6144 + j]);
                if (DBG_DUMP == 10) v = bf2f(((const bf16*)(ws + WS_WINT))[(size_t)6144 * 2048 + j]);
            }
#endif
            outp[i] = v;
        }
    PHASE_END(14)
#endif
    if (TSEL >= 0 && blockIdx.x == 0 && threadIdx.x == 0) { const float us = (float)(*(volatile LAS unsigned long long*)(MISC0 + 18)) * 0.01f; out0[0] = exp2f(rintf(log2f(us) * 10.0f) * 0.1f); }
#undef PHASE_BEGIN
#undef PHASE_END
}
constexpr int N_PHASES = 3 + DBG_NL * 10 + (DBG_KEEP ? 1 : 0);

extern "C" void kernel_launch(void* const* d_in, const int* in_sizes, int n_in, void* d_out, int out_size, void* d_ws, size_t ws_size, hipStream_t stream) {
    static int grid = 0;
    if (grid == 0) {
        if (n_in != 36 || out_size != (int)O_END || ws_size < WS_END) { fprintf(stderr, "kernel_launch: unexpected shapes (n_in %d out %d ws %zu)\n", n_in, out_size, ws_size); grid = -1; return; }
        int dev = 0, cus = 0, per_cu = 0;
        if (hipGetDevice(&dev) != hipSuccess || hipDeviceGetAttribute(&cus, hipDeviceAttributeMultiprocessorCount, dev) != hipSuccess) { grid = -1; return; }
        if (hipFuncSetAttribute((const void*)fwd_kernel, hipFuncAttributeMaxDynamicSharedMemorySize, LDS_BYTES) != hipSuccess) { fprintf(stderr, "kernel_launch: hipFuncSetAttribute failed\n"); grid = -1; return; }
        if (hipOccupancyMaxActiveBlocksPerMultiprocessor(&per_cu, (const void*)fwd_kernel, NWAVES * 64, LDS_BYTES) != hipSuccess || per_cu < 1) { fprintf(stderr, "kernel_launch: occupancy query reports %d blocks per CU\n", per_cu); }
        (void)hipGetLastError();
        grid = cus;
    }
    if (grid < 0) return;
    if (hipMemsetAsync((char*)d_ws + WS_CTL, 0, CTL_ZERO_BYTES, stream) != hipSuccess) return;
    Args a{};
    for (int i = 0; i < 36; ++i) a.in[i] = (const float*)d_in[i];
    a.out = (float*)d_out; a.ws = (unsigned char*)d_ws;
    if (MK_N_LAUNCHES == 1) { a.ph_lo = 0; a.ph_hi = N_PHASES; hipLaunchKernelGGL(fwd_kernel, dim3(grid), dim3(NWAVES * 64), LDS_BYTES, stream, a); }
    else for (int p = 0; p < N_PHASES; ++p) { a.ph_lo = p; a.ph_hi = p + 1; hipLaunchKernelGGL(fwd_kernel, dim3(grid), dim3(NWAVES * 64), LDS_BYTES, stream, a); }
}
```

```cpp
#include <hip/hip_runtime.h>
#include <hip/hip_bf16.h>
#include <cstdio>
#include <cstdint>

#ifndef MK_N_LAUNCHES
#define MK_N_LAUNCHES 1
#endif
#ifndef DBG_KEEP
#define DBG_KEEP 0
#endif
#ifndef DUP_SCAN
#define DUP_SCAN 1
#endif
#ifndef DUP_ATT
#define DUP_ATT 1
#endif
#ifndef DUP_CARRY
#define DUP_CARRY 1
#endif
#ifndef DUP_CONV
#define DUP_CONV 1
#endif
#ifndef DUP_RGG
#define DUP_RGG 1
#endif
#ifndef DUP_S5
#define DUP_S5 1
#endif
#ifndef TSEL
#define TSEL (-1)
#endif
#ifndef DUPG1
#define DUPG1 1
#endif
#ifndef DUPG6
#define DUPG6 1
#endif
#ifndef DUPG9
#define DUPG9 1
#endif
#ifndef DUPG10
#define DUPG10 1
#endif
#ifndef DUP_GEMM
#define DUP_GEMM 1
#endif
#ifndef DUP_MASK
#define DUP_MASK 0u
#endif
#ifndef DBG_LMASK
#define DBG_LMASK 15
#endif
#ifndef DBG_DUMP
#define DBG_DUMP 0
#endif
#ifndef DBG_NL
#define DBG_NL 4
#endif

constexpr int DM = 2048, ROWS = 8192, CTXR = 4096, INW = 12288, FFH = 5632, NL = 4, W1K = 1024;
constexpr int NCV = 5;
constexpr float RMS_EPS = 1e-6f;
constexpr size_t MiB = 1u << 20;

constexpr size_t O_X = 0, O_K = 16777216, O_V = 33554432, O_RG = 50331648, O_S5 = 50462720, O_END = 51511296;

constexpr size_t WS_CTL = 0, CTL_ZERO_BYTES = 1 * MiB;
constexpr size_t WS_MODP = 1 * MiB;
constexpr size_t WS_MOD  = 17 * MiB;
constexpr size_t WS_SP   = 18 * MiB;
constexpr size_t WS_LT   = 18 * MiB + 65536;
constexpr size_t WS_GWT  = 19 * MiB;
constexpr size_t WS_WINT = 24 * MiB;
constexpr size_t WS_GLUT = 216 * MiB;
constexpr size_t WS_OUTT = 224 * MiB;
constexpr size_t WS_WOT  = 272 * MiB;
constexpr size_t WS_FINT = 304 * MiB;
constexpr size_t WS_FOUTT = 480 * MiB;
constexpr size_t WS_MT   = 568 * MiB;
constexpr size_t WS_ET   = 600 * MiB;
constexpr size_t WS_FT   = 632 * MiB;
constexpr size_t WS_CK   = 664 * MiB;
constexpr size_t WS_CV   = 680 * MiB;
constexpr size_t WS_H    = 696 * MiB;
constexpr size_t WS_XR   = 728 * MiB;
constexpr size_t WS_XG   = 744 * MiB;
constexpr size_t WS_XC   = 760 * MiB;
constexpr size_t WS_Q    = 776 * MiB;
constexpr size_t WS_K    = 792 * MiB;
constexpr size_t WS_V    = 808 * MiB;
constexpr size_t WS_YRG  = 824 * MiB;
constexpr size_t WS_YS5  = 840 * MiB;
constexpr size_t WS_YNA  = 856 * MiB;
constexpr size_t WS_ZS   = 872 * MiB;
constexpr size_t WS_UG   = 888 * MiB;
constexpr size_t WS_HIN  = 904 * MiB;
constexpr size_t WS_G    = 920 * MiB;
constexpr size_t WS_AB   = 1016 * MiB;
constexpr size_t WS_FH   = 1016 * MiB;
constexpr size_t WS_HF   = 1144 * MiB;
constexpr size_t WS_HLOC = 1176 * MiB;
constexpr size_t WS_Z    = 1144 * MiB;
constexpr size_t WS_MM   = 1208 * MiB;
constexpr size_t WS_XS   = 1240 * MiB;
constexpr size_t WS_END  = 1244 * MiB;

constexpr int CW_TMO = 0, CW_BAR = 4096;
constexpr int CW_SEAM = 16384, SEAM_BANK = 32 * 64;
#ifndef FUSE_NORM
#define FUSE_NORM 0
#endif

constexpr int RING_BYTES = 131072;
constexpr int LDSCTL_OFF = RING_BYTES, MISC_OFF = LDSCTL_OFF + 320;
constexpr int LDS_BYTES = 147456;

#define GAS __attribute__((address_space(1)))
#define LAS __attribute__((address_space(3)))
typedef unsigned short bf16;
typedef unsigned v4u __attribute__((ext_vector_type(4)));
typedef unsigned v2u __attribute__((ext_vector_type(2)));
typedef float f32x4 __attribute__((ext_vector_type(4)));
typedef float f32x2 __attribute__((ext_vector_type(2)));
typedef short bf16x8 __attribute__((ext_vector_type(8)));
typedef GAS unsigned gu32;
#define RLX_AGENT __ATOMIC_RELAXED, __HIP_MEMORY_SCOPE_AGENT
#define LDS_WAIT() asm volatile("s_waitcnt lgkmcnt(0)" ::: "memory")
#define VM_WAIT() asm volatile("s_waitcnt vmcnt(0)" ::: "memory")

__device__ __forceinline__ unsigned f2bf(float f) { unsigned u = __builtin_bit_cast(unsigned, f); return (u + 0x7fffu + ((u >> 16) & 1u)) >> 16; }
typedef __bf16 bf16x2_t __attribute__((ext_vector_type(2)));
__device__ __forceinline__ unsigned pk2(float lo, float hi) { const f32x2 v = {lo, hi}; const bf16x2_t b = __builtin_convertvector(v, bf16x2_t); return __builtin_bit_cast(unsigned, b); }
__device__ __forceinline__ float bflo(unsigned w) { return __builtin_bit_cast(float, w << 16); }
__device__ __forceinline__ float bfhi(unsigned w) { return __builtin_bit_cast(float, w & 0xffff0000u); }
__device__ __forceinline__ float bf2f(bf16 h) { return __builtin_bit_cast(float, (unsigned)h << 16); }
__device__ __forceinline__ float fsigmoid(float x) { return __builtin_amdgcn_rcpf(1.0f + __expf(-x)); }
__device__ __forceinline__ float gelu_tanh(float x) { const float y = 0.7978845608028654f * (x + 0.044715f * x * x * x); return x * __builtin_amdgcn_rcpf(1.0f + __expf(-2.0f * y)); }
__device__ __forceinline__ float wave_sum(float v, int lane) {
#pragma unroll
    for (int o = 1; o < 64; o <<= 1) v += __builtin_bit_cast(float, __builtin_amdgcn_ds_bpermute((lane ^ o) << 2, __builtin_bit_cast(int, v)));
    return v;
}
__device__ __forceinline__ void unpack8(const v4u w, float (&f)[8]) { f[0] = bflo(w.x); f[1] = bfhi(w.x); f[2] = bflo(w.y); f[3] = bfhi(w.y); f[4] = bflo(w.z); f[5] = bfhi(w.z); f[6] = bflo(w.w); f[7] = bfhi(w.w); }
__device__ __forceinline__ v4u pack8(const float (&f)[8]) { v4u w; w.x = pk2(f[0], f[1]); w.y = pk2(f[2], f[3]); w.z = pk2(f[4], f[5]); w.w = pk2(f[6], f[7]); return w; }

#define XB_TMO      128
#define XB_XCNT(j)  (256  + 64 * (j))
#define XB_XSUB(j)  (1280 + 64 * (j))
#define XB_XGEN(j)  (2304 + 64 * (j))
#define XB_TOP      3328
#define XB_TOPGEN   3392
#define XCD_BAR_WORDS 3456
#define XB_SPIN_CAP (1u << 18)
__device__ __forceinline__ unsigned xb_ld(unsigned* p)              { return __hip_atomic_load(p, __ATOMIC_RELAXED, __HIP_MEMORY_SCOPE_AGENT); }
__device__ __forceinline__ unsigned xb_add(unsigned* p, unsigned v) { return __hip_atomic_fetch_add(p, v, __ATOMIC_RELAXED, __HIP_MEMORY_SCOPE_AGENT); }
__device__ __forceinline__ unsigned xb_xcc_id() { return (unsigned)__builtin_amdgcn_s_getreg((3 << 11) | 20) & 0xFu; }
#define XB_SPIN(cond, bar) do { unsigned _sp = 0; while (cond) { __builtin_amdgcn_s_sleep(1); \
    if ((++_sp & 255u) == 0u) { if (xb_ld(&(bar)[XB_TMO])) break; if (_sp > XB_SPIN_CAP) { atomicAdd(&(bar)[XB_TMO], 1u); break; } } } } while (0)
struct XcdBarrier { unsigned* bar; unsigned x; volatile LAS unsigned* st; };
__device__ __forceinline__ XcdBarrier xcd_barrier_post(unsigned* bar, volatile LAS unsigned* st) {
    XcdBarrier b; b.bar = bar; b.x = xb_xcc_id(); b.st = st;
    if (threadIdx.x == 0) (void)xb_add(&bar[XB_XCNT(b.x)], 1u);
    return b;
}
__device__ __forceinline__ void xcd_barrier_complete(unsigned* bar, unsigned x, unsigned& nloc, unsigned& nx) {
    const unsigned G = gridDim.x * gridDim.y * gridDim.z;
    unsigned sum, cnt, mine, sp = 0u;
    for (;;) {
        sum = 0u; cnt = 0u; mine = 0u;
#pragma unroll
        for (unsigned j = 0; j < 16; ++j) { const unsigned c = xb_ld(&bar[XB_XCNT(j)]); sum += c; cnt += (c > 0u) ? 1u : 0u; mine = (j == x) ? c : mine; }
        if (sum == G) break;
        __builtin_amdgcn_s_sleep(1);
        if ((++sp & 255u) == 0u) { if (xb_ld(&bar[XB_TMO])) break; if (sp > XB_SPIN_CAP) { atomicAdd(&bar[XB_TMO], 1u); break; } }
    }
    nloc = mine > 0u ? mine : 1u; nx = cnt > 0u ? cnt : 1u;
}
__device__ __forceinline__ void xcd_barrier(const XcdBarrier& b) {
    asm volatile("s_waitcnt vmcnt(0)" ::: "memory");
    __syncthreads();
    int tid_b = threadIdx.x; asm volatile("" : "+v"(tid_b));
    if (tid_b == 0) {
        unsigned* bar = b.bar;
        __builtin_amdgcn_s_waitcnt(0);
        unsigned nloc = b.st[0], nx = b.st[1];
        if (nloc == 0u) { xcd_barrier_complete(bar, b.x, nloc, nx); b.st[0] = nloc; b.st[1] = nx; }
        const unsigned old = xb_add(&bar[XB_XSUB(b.x)], 1u);
        const unsigned gen = old / nloc;
        if (old + 1u == (gen + 1u) * nloc) {
            __builtin_amdgcn_fence(__ATOMIC_RELEASE, "agent");
            asm volatile("s_waitcnt vmcnt(0)" ::: "memory");
            const unsigned og = xb_add(&bar[XB_TOP], 1u);
            const unsigned tg = og / nx;
            if (og + 1u == (tg + 1u) * nx) xb_add(&bar[XB_TOPGEN], 1u);
            else XB_SPIN(xb_ld(&bar[XB_TOPGEN]) == tg, bar);
            __builtin_amdgcn_fence(__ATOMIC_ACQUIRE, "agent");
            xb_add(&bar[XB_XGEN(b.x)], 1u);
            asm volatile("s_waitcnt vmcnt(0)" ::: "memory");
        } else {
            XB_SPIN(xb_ld(&bar[XB_XGEN(b.x)]) == gen, bar);
            __builtin_amdgcn_fence(__ATOMIC_ACQUIRE, "agent");
            asm volatile("s_waitcnt vmcnt(0)" ::: "memory");
        }
    }
    __syncthreads();
}

namespace pg8 {
#define PG8_LAS __attribute__((address_space(3)))
constexpr int BM = 256, BK = 64, HALF = 128, HTB = HALF * BK * 2, STAGE_BYTES = 8 * HTB;
__host__ __device__ __forceinline__ int lds_byte(int r, int c) { const int st = (r >> 4) * 2 + (c >> 5), rr = r & 15, cc = c & 31, ob = rr * 64 + cc * 2; return st * 1024 + (ob ^ (((ob >> 9) & 1) << 5)); }
__host__ __device__ __forceinline__ void stage_rc(int b, int& R, int& C) { const int st = b / 1024, sb = b % 1024, swz = sb ^ (((sb >> 9) & 1) << 5); R = (st >> 1) * 16 + swz / 64; C = (st & 1) * 32 + (swz % 64) / 2; }
__host__ __device__ __forceinline__ int perm32(int rho) { const int n = rho >> 4, i = rho & 15; return 8 * (i >> 2) + 4 * n + (i & 3); }

struct Unit { const char* A; const char* B; int pm, pn, aux, last; };

__device__ __forceinline__ bool tile_order(long L, int nM, int nN, int& pm, int& pn) {
    const int nwg = nM * nN; if (L >= nwg) return false;
    int wgid = (int)L; { const int q = nwg / 8, r = nwg % 8, xcd = wgid % 8, off = wgid / 8; wgid = (xcd < r ? xcd * (q + 1) : r * (q + 1) + (xcd - r) * q) + off; }
    const int nig = 8 * nN, gid = wgid / nig, fm = gid * 8, gsz = (nM - fm) < 8 ? (nM - fm) : 8;
    pm = fm + ((wgid % nig) % gsz); pn = (wgid % nig) / gsz; return true;
}

typedef float f32x4 __attribute__((ext_vector_type(4)));
typedef short bf16x8 __attribute__((ext_vector_type(8)));

template <class Epi, class Sched>
__device__ __forceinline__ void gemm_phase(PG8_LAS unsigned char* lds, const int K, const int lda, const int ldb, const Sched& S, const Epi& E) {
    int tid_ = threadIdx.x; asm volatile("" : "+v"(tid_));
    const int tid = tid_, wid = __builtin_amdgcn_readfirstlane(tid >> 6), lane = tid & 63, wr = wid >> 2, wc = wid & 3, fr = lane & 15, fq = lane >> 4;
    const int nt = K / BK;
    unsigned voffA[2], voffB[2];
#pragma unroll
    for (int i = 0; i < 2; ++i) { int R, C; stage_rc(tid * 16 + i * 8192, R, C); const int Rb = Epi::PERM ? ((R & ~31) + perm32(R & 31)) : R;
        voffA[i] = (unsigned)(R * lda + C) * 2u; voffB[i] = (unsigned)(Rb * ldb + C) * 2u; }
    const size_t kstep = (size_t)(BK * 2);
    const size_t hstepA = (size_t)HALF * lda * 2, hstepB = (size_t)HALF * ldb * 2;
    const unsigned ldsw = (unsigned)wid * 1024u;
    const int aoff = lds_byte(wr * 64 + fr, fq * 8), boff = lds_byte(wc * 32 + fr, fq * 8);
#define PG8_SA(b, h) (((b) * 2 + (h)) * HTB)
#define PG8_SB(b, h) ((4 + (b) * 2 + (h)) * HTB)
#define PG8_STAGE(bufoff, gbase, voff) do { _Pragma("unroll") for (int _i = 0; _i < 2; ++_i) \
        __builtin_amdgcn_global_load_lds((const unsigned*)((const char*)(gbase) + (voff)[_i]), (PG8_LAS unsigned*)(lds + (bufoff) + ldsw + _i * 8192), 16, 0, 0); } while (0)
#define PG8_LDA(dst, b, h) do { _Pragma("unroll") for (int m = 0; m < 4; ++m) _Pragma("unroll") for (int k = 0; k < 2; ++k) dst[m][k] = *(const PG8_LAS bf16x8*)(lds + PG8_SA(b, h) + aoff + m * 2048 + k * 1024); } while (0)
#define PG8_LDB(dst, b, h) do { _Pragma("unroll") for (int n = 0; n < 2; ++n) _Pragma("unroll") for (int k = 0; k < 2; ++k) dst[n][k] = *(const PG8_LAS bf16x8*)(lds + PG8_SB(b, h) + boff + n * 2048 + k * 1024); } while (0)
#define PG8_MMA(ai, bj, At, Bt) do { __builtin_amdgcn_s_setprio(1); _Pragma("unroll") for (int m = 0; m < 4; ++m) _Pragma("unroll") for (int n = 0; n < 2; ++n) _Pragma("unroll") for (int k = 0; k < 2; ++k) \
        acc[ai][bj][m][n] = __builtin_amdgcn_mfma_f32_16x16x32_bf16(Bt[n][k], At[m][k], acc[ai][bj][m][n], 0, 0, 0); __builtin_amdgcn_s_setprio(0); } while (0)
#define PG8_WAIT_V(n) asm volatile("s_waitcnt vmcnt(" #n ")" ::: "memory")
#define PG8_WAIT_L(n) asm volatile("s_waitcnt lgkmcnt(" #n ")" ::: "memory")
#define PG8_BAR __builtin_amdgcn_s_barrier()
#define PG8_SCHED __builtin_amdgcn_sched_barrier(0)
    Unit cur, nxt; int ui = 0;
    if (!S.next(0, cur)) return;
    f32x4 acc[2][2][4][2];
#pragma unroll
    for (int a = 0; a < 2; ++a)
#pragma unroll
        for (int b = 0; b < 2; ++b)
#pragma unroll
            for (int m = 0; m < 4; ++m)
#pragma unroll
                for (int n = 0; n < 2; ++n) acc[a][b][m][n] = (f32x4){0.f, 0.f, 0.f, 0.f};
    bf16x8 At[4][2], B0[2][2], B1[2][2];
    const char* cA = cur.A; const char* cB = cur.B;
    PG8_STAGE(PG8_SB(0, 0), cB, voffB); PG8_STAGE(PG8_SB(0, 1), cB + hstepB, voffB); PG8_STAGE(PG8_SA(0, 0), cA, voffA); PG8_STAGE(PG8_SA(0, 1), cA + hstepA, voffA);
    if (wr == 1) PG8_BAR;
    PG8_WAIT_V(2); PG8_BAR;
    PG8_STAGE(PG8_SB(1, 0), cB + kstep, voffB); PG8_STAGE(PG8_SA(1, 0), cA + kstep, voffA); PG8_STAGE(PG8_SB(1, 1), cB + hstepB + kstep, voffB);
    PG8_WAIT_V(6); PG8_BAR;
    for (;;) {
        const bool has_next = S.next(ui + 1, nxt);
        const char* nA = has_next ? nxt.A : cA; const char* nB = has_next ? nxt.B : cB;
#pragma unroll 1
        for (int t = 0; t < nt; t += 2) {
            const bool last = (t == nt - 2);
            const char* a1 = cA + (size_t)(t + 1) * kstep;
            const char* a2 = last ? nA : cA + (size_t)(t + 2) * kstep; const char* b2 = last ? nB : cB + (size_t)(t + 2) * kstep;
            const char* a3 = a2 + kstep; const char* b3 = b2 + kstep;
            PG8_LDB(B0, 0, 0); PG8_LDB(B1, 0, 1); PG8_SCHED; PG8_LDA(At, 0, 0); PG8_STAGE(PG8_SA(1, 1), a1 + hstepA, voffA);
            PG8_WAIT_V(8); PG8_WAIT_L(0); PG8_BAR; PG8_MMA(0, 0, At, B0); PG8_MMA(0, 1, At, B1); PG8_BAR; PG8_SCHED;
            PG8_LDA(At, 0, 1); PG8_STAGE(PG8_SB(0, 0), b2, voffB); PG8_STAGE(PG8_SB(0, 1), b2 + hstepB, voffB); PG8_STAGE(PG8_SA(0, 0), a2, voffA);
            PG8_WAIT_V(8); PG8_WAIT_L(0); PG8_BAR; PG8_MMA(1, 0, At, B0); PG8_MMA(1, 1, At, B1); PG8_BAR; PG8_SCHED;
            PG8_LDB(B0, 1, 0); PG8_LDB(B1, 1, 1); PG8_SCHED; PG8_LDA(At, 1, 0); PG8_STAGE(PG8_SA(0, 1), a2 + hstepA, voffA);
            PG8_WAIT_V(8); PG8_WAIT_L(0); PG8_BAR; PG8_MMA(0, 0, At, B0); PG8_MMA(0, 1, At, B1); PG8_BAR; PG8_SCHED;
            PG8_LDA(At, 1, 1); PG8_STAGE(PG8_SB(1, 0), b3, voffB); PG8_STAGE(PG8_SB(1, 1), b3 + hstepB, voffB); PG8_STAGE(PG8_SA(1, 0), a3, voffA);
            PG8_WAIT_V(8); PG8_WAIT_L(0); PG8_BAR; PG8_MMA(1, 0, At, B0); PG8_MMA(1, 1, At, B1); PG8_BAR; PG8_SCHED;
        }
        if (wr == 0) PG8_BAR;
        if (cur.last) { if constexpr (!Epi::AFTER_DRAIN) E(acc, cur, wr, wc, fr, fq); } else E.mid(acc, cur, wr, wc, fr, fq);
        if (!has_next) break;
        if (cur.last) {
#pragma unroll
            for (int a = 0; a < 2; ++a)
#pragma unroll
                for (int b = 0; b < 2; ++b)
#pragma unroll
                    for (int m = 0; m < 4; ++m)
#pragma unroll
                        for (int n = 0; n < 2; ++n) acc[a][b][m][n] = (f32x4){0.f, 0.f, 0.f, 0.f};
        }
        cur = nxt; cA = nA; cB = nB; ++ui;
        if (wr == 1) PG8_BAR;
    }
    PG8_WAIT_V(0);
    PG8_BAR;
    if constexpr (Epi::AFTER_DRAIN) E.fused(acc, cur, wr, wc, fr, fq, lds, wid, lane);
#undef PG8_SA
#undef PG8_SB
#undef PG8_STAGE
#undef PG8_LDA
#undef PG8_LDB
#undef PG8_MMA
#undef PG8_WAIT_V
#undef PG8_WAIT_L
#undef PG8_BAR
#undef PG8_SCHED
}

typedef const f32x4 (&AccC)[2][2][4][2];
typedef f32x4 (&AccM)[2][2][4][2];
#define EPI_ROWS_BEGIN _Pragma("unroll") for (int ai = 0; ai < 2; ++ai) _Pragma("unroll") for (int m = 0; m < 4; ++m) { const int row = u.pm * 256 + ai * 128 + wr * 64 + m * 16 + fr;
#define EPI_ROWS_END }

#define EPI_NO_MID static constexpr bool AFTER_DRAIN = false; __device__ __forceinline__ void mid(AccM, const Unit&, int, int, int, int) const {} __device__ __forceinline__ void fused(AccM, const Unit&, int, int, int, int, PG8_LAS unsigned char*, int, int) const {}

struct EpiB16 {
    EPI_NO_MID
    static constexpr bool PERM = true;
    bf16* O; int ldc;
    __device__ __forceinline__ void operator()(AccC acc, const Unit& u, int wr, int wc, int fr, int fq) const {
        const int col0 = u.pn * 256 + wc * 32 + 8 * fq;
        EPI_ROWS_BEGIN
#pragma unroll
            for (int bj = 0; bj < 2; ++bj) { const f32x4 v0 = acc[ai][bj][m][0], v1 = acc[ai][bj][m][1]; const float f[8] = {v0[0], v0[1], v0[2], v0[3], v1[0], v1[1], v1[2], v1[3]};
                *(GAS v4u*)(O + (size_t)row * ldc + col0 + bj * 128) = pack8(f); }
        EPI_ROWS_END
    }
};
struct EpiHloc {
    EPI_NO_MID
    static constexpr bool PERM = false;
    float* O;
    __device__ __forceinline__ void operator()(AccC acc, const Unit& u, int wr, int wc, int fr, int fq) const {
        const int col0 = wc * 32 + 4 * fq; float* base = O + (size_t)u.aux * 512 * 256;
        EPI_ROWS_BEGIN
            float* rowp = base + (size_t)row * 256 + col0;
#pragma unroll
            for (int bj = 0; bj < 2; ++bj)
#pragma unroll
                for (int n = 0; n < 2; ++n) *(GAS f32x4*)(rowp + bj * 128 + n * 16) = acc[ai][bj][m][n];
        EPI_ROWS_END
    }
};
struct EpiWin {
    EPI_NO_MID
    static constexpr bool PERM = true;
    bf16 *XR, *XG, *UG, *Q, *Kb, *Vb, *G; float *outK, *outV;
    __device__ __forceinline__ void operator()(AccC acc, const Unit& u, int wr, int wc, int fr, int fq) const {
        const int pn = u.pn, seg = pn >> 2;
        const int cseg = (pn & 3) * 256 + wc * 32 + 8 * fq;
        EPI_ROWS_BEGIN
#pragma unroll
            for (int bj = 0; bj < 2; ++bj) {
                const f32x4 v0 = acc[ai][bj][m][0], v1 = acc[ai][bj][m][1];
                float f[8] = {v0[0], v0[1], v0[2], v0[3], v1[0], v1[1], v1[2], v1[3]};
                const int c = cseg + bj * 128;
                if (seg >= 6) {
#pragma unroll
                    for (int e = 0; e < 8; ++e) f[e] = fsigmoid(f[e]);
                    *(GAS v4u*)(G + (size_t)row * 6144 + (pn - 24) * 256 + wc * 32 + 8 * fq + bj * 128) = pack8(f);
                } else if (seg == 1) {
#pragma unroll
                    for (int e = 0; e < 8; ++e) f[e] = gelu_tanh(f[e]);
                    *(GAS v4u*)(XG + (size_t)row * 1024 + c) = pack8(f);
                } else if (seg == 2) {
                    const int g = c >> 4, m0 = c & 15;
                    *(GAS v4u*)(UG + ((size_t)g * 512 + (row >> 4)) * 256 + (row & 15) * 16 + m0) = pack8(f);
                } else {
                    bf16* dst = seg == 0 ? XR : (seg == 3 ? Q : (seg == 4 ? Kb : Vb));
                    *(GAS v4u*)(dst + (size_t)row * 1024 + c) = pack8(f);
                    if (seg >= 4 && row < CTXR) {
                        float* o = (seg == 4 ? outK : outV) + ((size_t)(row >> 8) * 4 * 256 + (row & 255)) * 1024 + c;
                        *(f32x4*)o = v0; *(GAS f32x4*)(o + 4) = v1;
                    }
                }
            }
        EPI_ROWS_END
    }
};
struct EpiRg {
    EPI_NO_MID
    static constexpr bool PERM = true;
    const bf16* XC; const float* gb; const float* sp; f32x2* AB;
    __device__ __forceinline__ void operator()(AccC acc, const Unit& u, int wr, int wc, int fr, int fq) const {
        const int h = u.aux >> 1, d = u.aux & 1, c0 = h * 128 + wc * 32 + 8 * fq;
        const GAS float* gbr = (const GAS float*)(gb + (d * 2 + 0) * 1024 + c0); const GAS float* gbi = (const GAS float*)(gb + (d * 2 + 1) * 1024 + c0); const GAS float* spp = (const GAS float*)(sp + d * 1024 + c0);
        EPI_ROWS_BEGIN
            float xc[8]; unpack8(*(const GAS v4u*)(XC + (size_t)row * 1024 + c0), xc);
            const f32x4 r0 = acc[ai][0][m][0], r1 = acc[ai][0][m][1], i0 = acc[ai][1][m][0], i1 = acc[ai][1][m][1];
            const float rr[8] = {r0[0], r0[1], r0[2], r0[3], r1[0], r1[1], r1[2], r1[3]}, ii[8] = {i0[0], i0[1], i0[2], i0[3], i1[0], i1[1], i1[2], i1[3]};
            unsigned* dst = (unsigned*)AB + ((size_t)d * ROWS + row) * 1024 + c0;
            v4u o0, o1; unsigned w[8];
#pragma unroll
            for (int e = 0; e < 8; ++e) {
                const float r = fsigmoid(rr[e] + gbr[e]), ig = fsigmoid(ii[e] + gbi[e]);
                const float la = -8.0f * r * spp[e]; const float a = __expf(la); const float om = 1.0f - a; const float mult = __builtin_amdgcn_sqrtf(om * (1.0f + a));
                w[e] = pk2(om, mult * ig * xc[e]);
            }
            o0.x = w[0]; o0.y = w[1]; o0.z = w[2]; o0.w = w[3]; o1.x = w[4]; o1.y = w[5]; o1.z = w[6]; o1.w = w[7];
            *(GAS v4u*)dst = o0; *(GAS v4u*)(dst + 4) = o1;
            asm volatile("" ::: "memory");
        EPI_ROWS_END
    }
};
struct EpiS5Y {
    EPI_NO_MID
    static constexpr bool PERM = true;
    const bf16* UG; const float* dvec; bf16* ZS;
    __device__ __forceinline__ void operator()(AccC acc, const Unit& u, int wr, int wc, int fr, int fq) const {
        const int g = u.aux;
        EPI_ROWS_BEGIN
#pragma unroll
            for (int bj = 0; bj < 2; ++bj) {
                const int col = bj * 128 + wc * 32 + 8 * fq, t = col >> 4, n0 = col & 15;
                float uu[8]; unpack8(*(const GAS v4u*)(UG + ((size_t)g * 512 + row) * 256 + col), uu);
                const f32x4 v0 = acc[ai][bj][m][0], v1 = acc[ai][bj][m][1];
                float f[8] = {v0[0], v0[1], v0[2], v0[3], v1[0], v1[1], v1[2], v1[3]};
#pragma unroll
                for (int e = 0; e < 8; ++e) f[e] = gelu_tanh(f[e] + ((const GAS float*)dvec)[g * 16 + n0 + e] * uu[e]);
                *(GAS v4u*)(ZS + ((size_t)row * 16 + t) * 1024 + g * 16 + n0) = pack8(f);
            }
        EPI_ROWS_END
    }
};
struct EpiGlu {
    EPI_NO_MID
    static constexpr bool PERM = true;
    const bf16* ZS; bf16* Y;
    __device__ __forceinline__ void operator()(AccC acc, const Unit& u, int wr, int wc, int fr, int fq) const {
        const int col0 = u.pn * 256 + wc * 32 + 8 * fq;
        EPI_ROWS_BEGIN
#pragma unroll
            for (int bj = 0; bj < 2; ++bj) {
                float z[8]; unpack8(*(const GAS v4u*)(ZS + (size_t)row * 1024 + col0 + bj * 128), z);
                const f32x4 v0 = acc[ai][bj][m][0], v1 = acc[ai][bj][m][1];
                float f[8] = {v0[0], v0[1], v0[2], v0[3], v1[0], v1[1], v1[2], v1[3]};
#pragma unroll
                for (int e = 0; e < 8; ++e) f[e] = z[e] * fsigmoid(f[e]);
                *(GAS v4u*)(Y + (size_t)row * 1024 + col0 + bj * 128) = pack8(f);
            }
        EPI_ROWS_END
    }
};
struct EpiMerge {
    static constexpr bool PERM = true, AFTER_DRAIN = false;
    __device__ __forceinline__ void fused(AccM, const Unit&, int, int, int, int, PG8_LAS unsigned char*, int, int) const {}
    const bf16* G; bf16* MM;
    __device__ __forceinline__ void mid(AccM acc, const Unit& u, int wr, int wc, int fr, int fq) const {
        const int col0 = u.pn * 256 + wc * 32 + 8 * fq, b = u.aux;
        EPI_ROWS_BEGIN
#pragma unroll
            for (int bj = 0; bj < 2; ++bj) {
                float ga[8], gn[8]; unpack8(*(const GAS v4u*)(G + (size_t)row * 6144 + b * 2048 + col0 + bj * 128), ga); unpack8(*(const GAS v4u*)(G + (size_t)row * 6144 + (b + 1) * 2048 + col0 + bj * 128), gn);
#pragma unroll
                for (int e = 0; e < 8; ++e) { const float rt = ga[e] * __builtin_amdgcn_rcpf(fmaxf(gn[e], 1e-30f)); acc[ai][bj][m][e >> 2][e & 3] *= rt; }
            }
        EPI_ROWS_END
    }
    __device__ __forceinline__ void operator()(AccC acc, const Unit& u, int wr, int wc, int fr, int fq) const {
        const int col0 = u.pn * 256 + wc * 32 + 8 * fq;
        EPI_ROWS_BEGIN
#pragma unroll
            for (int bj = 0; bj < 2; ++bj) {
                float g2[8]; unpack8(*(const GAS v4u*)(G + (size_t)row * 6144 + 2 * 2048 + col0 + bj * 128), g2);
                const f32x4 v0 = acc[ai][bj][m][0], v1 = acc[ai][bj][m][1];
                float f[8] = {v0[0], v0[1], v0[2], v0[3], v1[0], v1[1], v1[2], v1[3]};
#pragma unroll
                for (int e = 0; e < 8; ++e) f[e] *= g2[e];
                *(GAS v4u*)(MM + (size_t)row * 2048 + col0 + bj * 128) = pack8(f);
            }
        EPI_ROWS_END
    }
};
struct EpiSwiglu {
    EPI_NO_MID
    static constexpr bool PERM = true;
    bf16* FH;
    __device__ __forceinline__ void operator()(AccC acc, const Unit& u, int wr, int wc, int fr, int fq) const {
        const int col0 = u.pn * 128 + wc * 32 + 8 * fq;
        EPI_ROWS_BEGIN
            const f32x4 a0 = acc[ai][0][m][0], a1 = acc[ai][0][m][1], b0 = acc[ai][1][m][0], b1 = acc[ai][1][m][1];
            const float av[8] = {a0[0], a0[1], a0[2], a0[3], a1[0], a1[1], a1[2], a1[3]}, bv[8] = {b0[0], b0[1], b0[2], b0[3], b1[0], b1[1], b1[2], b1[3]};
            float f[8];
#pragma unroll
            for (int e = 0; e < 8; ++e) f[e] = av[e] * fsigmoid(av[e]) * bv[e];
            *(GAS v4u*)(FH + (size_t)row * FFH + col0) = pack8(f);
        EPI_ROWS_END
    }
};

struct PanelSS {
    float* slots; unsigned* cnt; unsigned* tmo;
    __device__ __forceinline__ void run(const f32x4 (&v)[2][2][4][2], const Unit& u, int wr, int wc, int fr, int fq, PG8_LAS unsigned char* lds, int wid, int lane) const {
        PG8_LAS float* P = (PG8_LAS float*)lds;
        PG8_LAS float* S = (PG8_LAS float*)(lds + 8192);
#pragma unroll
        for (int ai = 0; ai < 2; ++ai)
#pragma unroll
            for (int m = 0; m < 4; ++m) { float q = 0.f;
#pragma unroll
                for (int bj = 0; bj < 2; ++bj)
#pragma unroll
                    for (int n = 0; n < 2; ++n) { const f32x4 x = v[ai][bj][m][n]; q += (x[0] * x[0] + x[1] * x[1]) + (x[2] * x[2] + x[3] * x[3]); }
                q += __builtin_bit_cast(float, __builtin_amdgcn_ds_bpermute((lane ^ 16) << 2, __builtin_bit_cast(int, q)));
                q += __builtin_bit_cast(float, __builtin_amdgcn_ds_bpermute((lane ^ 32) << 2, __builtin_bit_cast(int, q)));
                if (fq == 0) P[(ai * 128 + wr * 64 + m * 16 + fr) * 4 + wc] = q; }
        asm volatile("s_waitcnt lgkmcnt(0)" ::: "memory"); __builtin_amdgcn_s_barrier(); asm volatile("" ::: "memory");
        const int row = wid * 32 + (lane & 31);
        if (lane < 32) { const float tot = (P[row * 4 + 0] + P[row * 4 + 1]) + (P[row * 4 + 2] + P[row * 4 + 3]);
            __hip_atomic_store(slots + ((size_t)(u.pm * 256 + row) * 8 + u.pn), tot, __ATOMIC_RELAXED, __HIP_MEMORY_SCOPE_AGENT); }
        asm volatile("s_waitcnt vmcnt(0)" ::: "memory");
        if (lane == 0) __hip_atomic_fetch_add(cnt + 64 * u.pm, 1u, __ATOMIC_RELAXED, __HIP_MEMORY_SCOPE_AGENT);
        if (wid == 0) {
            const unsigned long long t0 = __builtin_amdgcn_s_memrealtime();
            for (;;) {
                if ((unsigned)__builtin_amdgcn_readfirstlane(__hip_atomic_load(cnt + 64 * u.pm, __ATOMIC_RELAXED, __HIP_MEMORY_SCOPE_AGENT)) >= 64u) break;
                if (__builtin_amdgcn_s_memrealtime() - t0 > 2000000ull) { if (lane == 0) __hip_atomic_store(tmo, 1u, __ATOMIC_RELAXED, __HIP_MEMORY_SCOPE_AGENT); break; }
                __builtin_amdgcn_s_sleep(2);
            }
            __builtin_amdgcn_fence(__ATOMIC_ACQUIRE, "agent");
        }
        asm volatile("s_waitcnt vmcnt(0) lgkmcnt(0)" ::: "memory"); __builtin_amdgcn_s_barrier(); asm volatile("" ::: "memory");
        if (lane < 32) { const float* sl = slots + (size_t)(u.pm * 256 + row) * 8; float t = 0.f;
#pragma unroll
            for (int k = 0; k < 8; ++k) t += __hip_atomic_load(sl + k, __ATOMIC_RELAXED, __HIP_MEMORY_SCOPE_AGENT);
            S[row] = rsqrtf(t * (1.0f / 2048.0f) + 1e-6f); }
        asm volatile("s_waitcnt lgkmcnt(0)" ::: "memory"); __builtin_amdgcn_s_barrier(); asm volatile("" ::: "memory");
    }
};
struct EpiResNorm {
    static constexpr bool PERM = false, AFTER_DRAIN = true;
    float* X; bf16* H; const float* gpost; const float* modGate; const float* gpre; const float* modShift; const float* modScale; PanelSS st1, st2; int hasnext;
    __device__ __forceinline__ void mid(AccM, const Unit&, int, int, int, int) const {}
    __device__ __forceinline__ void operator()(AccC, const Unit&, int, int, int, int) const {}
    __device__ __forceinline__ void fused(AccM acc, const Unit& u, int wr, int wc, int fr, int fq, PG8_LAS unsigned char* lds, int wid, int lane) const {
        const PG8_LAS float* S = (const PG8_LAS float*)(lds + 8192);
        const int col0 = u.pn * 256 + wc * 32 + 4 * fq, cv = u.pm < 16 ? 0 : 1 + ((u.pm - 16) >> 2);
        st1.run(acc, u, wr, wc, fr, fq, lds, wid, lane);
#pragma unroll
        for (int ai = 0; ai < 2; ++ai)
#pragma unroll
            for (int m = 0; m < 4; ++m) { const int r = ai * 128 + wr * 64 + m * 16 + fr; const float r1 = S[r]; const size_t off = (size_t)(u.pm * 256 + r) * 2048 + col0;
#pragma unroll
                for (int bj = 0; bj < 2; ++bj)
#pragma unroll
                    for (int n = 0; n < 2; ++n) { const int c = bj * 128 + n * 16; const f32x4 xr = *(const GAS f32x4*)(X + off + c), gp = *(const GAS f32x4*)(gpost + col0 + c), gt = *(const GAS f32x4*)(modGate + (size_t)cv * 12288 + col0 + c);
                        acc[ai][bj][m][n] = xr + gt * (acc[ai][bj][m][n] * r1 * gp); }
                asm volatile("" : "+v"(acc[ai][0][m][0]), "+v"(acc[ai][0][m][1]), "+v"(acc[ai][1][m][0]), "+v"(acc[ai][1][m][1]));
                if (m & 1) asm volatile("" ::: "memory"); }
        if (hasnext) st2.run(acc, u, wr, wc, fr, fq, lds, wid, lane);
#pragma unroll
        for (int ai = 0; ai < 2; ++ai)
#pragma unroll
            for (int m = 0; m < 4; ++m) { const int r = ai * 128 + wr * 64 + m * 16 + fr; const float r2 = hasnext ? S[r] : 0.f; const size_t off = (size_t)(u.pm * 256 + r) * 2048 + col0;
#pragma unroll
                for (int bj = 0; bj < 2; ++bj)
#pragma unroll
                    for (int n = 0; n < 2; ++n) { const int c = bj * 128 + n * 16; const f32x4 x1 = acc[ai][bj][m][n]; *(GAS f32x4*)(X + off + c) = x1;
                        if (hasnext) { const f32x4 g = *(const GAS f32x4*)(gpre + col0 + c), sh = *(const GAS f32x4*)(modShift + (size_t)cv * 12288 + col0 + c), sc = *(const GAS f32x4*)(modScale + (size_t)cv * 12288 + col0 + c);
                            const f32x4 hv = x1 * r2 * g * (sc + 1.0f) + sh; v2u w; w.x = pk2(hv[0], hv[1]); w.y = pk2(hv[2], hv[3]); *(GAS v2u*)(H + off + c) = w; } }
                asm volatile("" ::: "memory"); }
    }
};

struct SchedPlain {
    const char* A; const char* B; int nM, nN, G, c; size_t tA, tB; int dup;
    __device__ __forceinline__ bool next(int i, Unit& u) const { int pm, pn; const int q = i / (dup * DUP_GEMM), r = i - q * (dup * DUP_GEMM); long L = (long)q * G + c; const int nwg = nM * nN; if (L >= nwg) return false;
        if (r) L = (L + nwg / 2 + 8) % nwg;
        if (!tile_order(L, nM, nN, pm, pn)) return false; u.A = A + (size_t)pm * tA; u.B = B + (size_t)pn * tB; u.pm = pm; u.pn = pn; u.aux = 0; u.last = 1; return true; }
};
struct SchedMerge {
    const char* A0; const char* A1; const char* A2; const char* B; int G, c;
    __device__ __forceinline__ bool next(int i, Unit& u) const { const int ti = i / 3, b = i - ti * 3; int pm, pn; const int q = ti / (DUPG6 * DUP_GEMM), r = ti - q * (DUPG6 * DUP_GEMM); long L = (long)q * G + c; if (L >= 256) return false; if (r) L = (L + 136) % 256;
        if (!tile_order(L, 32, 8, pm, pn)) return false;
        const char* Ab = b == 0 ? A0 : (b == 1 ? A1 : A2); u.A = Ab + (size_t)pm * 256 * 1024 * 2; u.B = B + ((size_t)b * 2048 + pn * 256) * 1024 * 2; u.pm = pm; u.pn = pn; u.aux = b; u.last = (b == 2); return true; }
};
struct SchedS5E {
    const char* UG; const char* ET; int G, c;
    __device__ __forceinline__ bool next(int i, Unit& u) const { const int L = (i / DUP_S5) * G + c; if (L >= 128) return false; const int g = L >> 1, pm = L & 1;
        u.A = UG + ((size_t)g * 512 + pm * 256) * 256 * 2; u.B = ET + (size_t)g * 256 * 256 * 2; u.pm = pm; u.pn = 0; u.aux = g; u.last = 1; return true; }
};
struct SchedS5Y {
    const char* UG; const char* HIN; const char* MT; const char* FT; int G, c;
    __device__ __forceinline__ bool next(int i, Unit& u) const { const int ti = (i >> 1) / DUP_S5, part = i & 1, L = ti * G + c; if (L >= 128) return false; const int g = L >> 1, pm = L & 1;
        u.A = (part ? HIN : UG) + ((size_t)g * 512 + pm * 256) * 256 * 2; u.B = (part ? FT : MT) + (size_t)g * 256 * 256 * 2; u.pm = pm; u.pn = 0; u.aux = g; u.last = part; return true; }
};
struct SchedOne {
    const char* A0; const char* B0; const char* A1; const char* B1; int pm, aux, nparts;
    __device__ __forceinline__ bool next(int i, Unit& u) const { if (i >= nparts) return false; u.A = i ? A1 : A0; u.B = i ? B1 : B0; u.pm = pm; u.pn = 0; u.aux = aux; u.last = (i == nparts - 1); return true; }
};
struct SchedRg {
    const char* XC; const char* GWT; int G, c;
    __device__ __forceinline__ bool next(int i, Unit& u) const { const int L = (i / DUP_RGG) * G + c; if (L >= 512) return false; const int pm = L & 31, hd = L >> 5;
        u.A = XC + ((size_t)pm * 256 * 1024 + (hd >> 1) * 128) * 2; u.B = GWT + (size_t)hd * 256 * 128 * 2; u.pm = pm; u.pn = 0; u.aux = hd; u.last = 1; return true; }
};
}

namespace att {
using bf16x8 = __attribute__((ext_vector_type(8))) short;
using s16x4  = __attribute__((ext_vector_type(4))) short;
using f32x16 = __attribute__((ext_vector_type(16))) float;
using u32x4  = __attribute__((ext_vector_type(4))) unsigned;
constexpr int D = 128, NW = 8, QBLK = 32, KVBLK = 64, LD = 1024;
constexpr float SCALE = 0.088388347648318440f, THR = 8.f;
constexpr size_t SHM_V = KVBLK * D * 2, SHM_K = KVBLK * D * 2, SHM_ATTN = 2 * SHM_V + 2 * SHM_K + NW * 64 * 4;
constexpr int RPB_OFF = (int)SHM_ATTN + 256;
#define KSWZ(row, colB) ((row) * 256 + ((colB) ^ (((row) & 7) << 4)))
#define SBAR() __builtin_amdgcn_sched_barrier(0)
__device__ __forceinline__ int crow(int r, int hi) { return (r & 3) + 8 * (r >> 2) + 4 * hi; }
__device__ __forceinline__ unsigned cvtpk(float lo, float hi) { return pk2(lo, hi); }
__device__ __forceinline__ void partialSM(f32x16& p0, f32x16& p1, float& m_reg, float& mn, float& alpha) {
  constexpr float C = SCALE * 1.4426950408889634f;
  float pmax = p0[0]; for (int r = 1; r < 16; ++r) pmax = fmaxf(pmax, p0[r]); for (int r = 0; r < 16; ++r) pmax = fmaxf(pmax, p1[r]);
  { auto rr = __builtin_amdgcn_permlane32_swap(__float_as_uint(pmax), __float_as_uint(pmax), false, false);
    pmax = fmaxf(__uint_as_float(rr[0]), __uint_as_float(rr[1])); }
  if (__builtin_expect(__all(pmax - m_reg <= THR / SCALE), 1)) { mn = m_reg; alpha = 1.f; }
  else { mn = fmaxf(m_reg, pmax); alpha = __builtin_amdgcn_exp2f((m_reg - mn) * C); m_reg = mn; }
  float mnC = -mn * C;
  for (int r = 0; r < 16; ++r) p0[r] = fmaf(p0[r], C, mnC); for (int r = 0; r < 16; ++r) p1[r] = fmaf(p1[r], C, mnC);
  for (int r = 0; r < 16; ++r) p0[r] = __builtin_amdgcn_exp2f(p0[r]);
}
__device__ __forceinline__ void finishSM(f32x16& p0, f32x16& p1, float alpha, float& l_reg, bf16x8& pa0, bf16x8& pa1, bf16x8& pa2, bf16x8& pa3) {
  for (int r = 0; r < 16; ++r) p1[r] = __builtin_amdgcn_exp2f(p1[r]);
  float ps = 0; for (int r = 0; r < 16; ++r) ps += p0[r]; for (int r = 0; r < 16; ++r) ps += p1[r];
  { auto rr = __builtin_amdgcn_permlane32_swap(__float_as_uint(ps), __float_as_uint(ps), false, false);
    ps = __uint_as_float(rr[0]) + __uint_as_float(rr[1]); }
  l_reg = l_reg * alpha + ps;
#define PK4(P, BASE, OUT) do { unsigned a0 = cvtpk(P[BASE + 0], P[BASE + 1]), a1 = cvtpk(P[BASE + 2], P[BASE + 3]);   \
    unsigned b0 = cvtpk(P[BASE + 4], P[BASE + 5]), b1 = cvtpk(P[BASE + 6], P[BASE + 7]);                              \
    auto r0 = __builtin_amdgcn_permlane32_swap(a0, b0, false, false); auto r1 = __builtin_amdgcn_permlane32_swap(a1, b1, false, false); \
    u32x4 w = {r0[0], r1[0], r0[1], r1[1]}; OUT = *reinterpret_cast<bf16x8*>(&w); } while (0)
  PK4(p0, 0, pa0); PK4(p0, 8, pa1); PK4(p1, 0, pa2); PK4(p1, 8, pa3);
#undef PK4
}
__device__ __forceinline__ void qkt(f32x16& p0, f32x16& p1, const bf16* Ks, const bf16x8* qr, int r32, int hi) {
  p0 = f32x16{}; p1 = f32x16{};
  for (int d0 = 0; d0 < 8; ++d0) { int cb = (d0 * 16 + hi * 8) * 2;
    bf16x8 b0 = *reinterpret_cast<const bf16x8*>((const char*)Ks + KSWZ(r32, cb));
    bf16x8 b1 = *reinterpret_cast<const bf16x8*>((const char*)Ks + KSWZ(32 + r32, cb));
    p0 = __builtin_amdgcn_mfma_f32_32x32x16_bf16(b0, qr[d0], p0, 0, 0, 0);
    p1 = __builtin_amdgcn_mfma_f32_32x32x16_bf16(b1, qr[d0], p1, 0, 0, 0); }
}
__device__ __forceinline__ int v_st(int k, int c) { const int kk = (k & ~0xC) | ((k & 4) << 1) | ((k & 8) >> 1); return ((kk >> 3) * 4 + (c >> 5)) * 512 + ((kk & 7) * 32 + (c & 31)) * 2; }
__device__ __forceinline__ int v_rd_base(int lane) { return ((lane & 3) << 3) | (((lane >> 2) & 3) << 6) | (((lane >> 4) & 1) << 5) | (((lane >> 5) & 1) << 8); }
constexpr int v_rd_off(int d0, int ks, int half) { return d0 * 512 + ks * 4096 + half * 2048; }
template <int OFF> __device__ __forceinline__ s16x4 tr_read(int vb) {
  s16x4 r; asm volatile("ds_read_b64_tr_b16 %0, %1 offset:%2" : "=&v"(r) : "v"(vb), "i"(OFF) : "memory"); return r;
}
template <int D0> __device__ __forceinline__ void pv_one(f32x16& od, int vb, bf16x8 pa0, bf16x8 pa1, bf16x8 pa2, bf16x8 pa3) {
  const s16x4 l0 = tr_read<v_rd_off(D0, 0, 0)>(vb), h0 = tr_read<v_rd_off(D0, 0, 1)>(vb), l1 = tr_read<v_rd_off(D0, 1, 0)>(vb), h1 = tr_read<v_rd_off(D0, 1, 1)>(vb);
  const s16x4 l2 = tr_read<v_rd_off(D0, 2, 0)>(vb), h2 = tr_read<v_rd_off(D0, 2, 1)>(vb), l3 = tr_read<v_rd_off(D0, 3, 0)>(vb), h3 = tr_read<v_rd_off(D0, 3, 1)>(vb);
  asm volatile("s_waitcnt lgkmcnt(0)" ::: "memory"); SBAR();
#define PK(L, H) (bf16x8){L[0], L[1], L[2], L[3], H[0], H[1], H[2], H[3]}
  od = __builtin_amdgcn_mfma_f32_32x32x16_bf16(pa0, PK(l0, h0), od, 0, 0, 0);
  od = __builtin_amdgcn_mfma_f32_32x32x16_bf16(pa1, PK(l1, h1), od, 0, 0, 0);
  od = __builtin_amdgcn_mfma_f32_32x32x16_bf16(pa2, PK(l2, h2), od, 0, 0, 0);
  od = __builtin_amdgcn_mfma_f32_32x32x16_bf16(pa3, PK(l3, h3), od, 0, 0, 0);
#undef PK
}
__device__ __forceinline__ void pv_d0(f32x16* o, int vb, bf16x8 pa0, bf16x8 pa1, bf16x8 pa2, bf16x8 pa3) {
  pv_one<0>(o[0], vb, pa0, pa1, pa2, pa3); pv_one<1>(o[1], vb, pa0, pa1, pa2, pa3); pv_one<2>(o[2], vb, pa0, pa1, pa2, pa3); pv_one<3>(o[3], vb, pa0, pa1, pa2, pa3);
}
__device__ __forceinline__ void na_mask(f32x16& p0, f32x16& p1, int kr, int qr, int rs, int ws, const float* rpbl, int hi) {
  if (kr < rs || kr >= rs + 8) {
#pragma unroll
    for (int r = 0; r < 16; ++r) { p0[r] = -1e30f; p1[r] = -1e30f; }
  } else {
    const float* row = rpbl + (kr - qr + 7) * 31 + 4 * hi; const unsigned w0 = (unsigned)(4 * hi - ws);
#pragma unroll
    for (int r = 0; r < 16; ++r) {
      const int kc = (r & 3) + 8 * (r >> 2);
      const float b0 = row[kc], b1 = row[kc + 32];
      p0[r] = (w0 + (unsigned)kc < 16u) ? p0[r] + b0 : -1e30f; p1[r] = (w0 + (unsigned)(kc + 32) < 16u) ? p1[r] + b1 : -1e30f;
      if ((r & 3) == 3) SBAR();
    }
  }
}
template <bool NA, int SD>
__device__ __forceinline__ void attn_body(const bf16* __restrict__ Qb, const bf16* __restrict__ K0, const bf16* __restrict__ V0, const bf16* __restrict__ K1, const bf16* __restrict__ V1,
                                          bf16* __restrict__ Ob, const int NT, const int lo, const int rg, char* lds) {
  int tid_ = threadIdx.x; asm volatile("" : "+v"(tid_));
  const int tid = tid_, wid = tid >> 6, lane = tid & 63, r32 = lane & 31, hi = lane >> 5;
  bf16* V_lds = (bf16*)lds; bf16* K_lds = (bf16*)(lds + 2 * SHM_V);
  float* ws_ = (float*)(lds + 2 * SHM_V + 2 * SHM_K) + wid * 64; float* li_l = ws_; float* al_l = ws_ + 32;
  const int qrow = 4 * rg + (wid >> 1), qc = 32 * (wid & 1) + r32;
  const int rs = qrow - 4 < 0 ? 0 : (qrow - 4 > 8 ? 8 : qrow - 4), wsn = qc - 8 < 0 ? 0 : (qc - 8 > 48 ? 48 : qc - 8);
  const float* rpbl = (const float*)(lds + RPB_OFF) + 15 - qc;
  float m_reg = -1e30f, l_reg = 0; f32x16 o[4] = {}; bf16x8 qr[8];
  const bf16* Qw = Qb + (long)(wid * QBLK + r32) * LD + hi * 8;
#pragma unroll
  for (int d0 = 0; d0 < 8; ++d0) qr[d0] = *(const GAS bf16x8*)(Qw + d0 * 16);
  const int sr = tid >> 4, sc = (tid & 15) * 8, vst0 = v_st(sr, sc), vst1 = v_st(32 + sr, sc);
  const int vb0 = (int)(uintptr_t)V_lds + v_rd_base(lane);
  struct { bf16x8 vs0, vs1, ks0, ks1; } sr_[SD];
#define TILEK(t) ((NA && (t) >= 8) ? K1 + (long)((t) - 8) * 64 * LD : K0 + (long)(t) * 64 * LD)
#define TILEV(t) ((NA && (t) >= 8) ? V1 + (long)((t) - 8) * 64 * LD : V0 + (long)(t) * 64 * LD)
#define SLOAD(i, t) do { const bf16* kp_ = TILEK(t); const bf16* vp_ = TILEV(t); \
    sr_[i].vs0 = *(const GAS bf16x8*)(&vp_[(long)sr * LD + sc]); sr_[i].vs1 = *(const GAS bf16x8*)(&vp_[(long)(32 + sr) * LD + sc]); \
    sr_[i].ks0 = *(const GAS bf16x8*)(&kp_[(long)sr * LD + sc]); sr_[i].ks1 = *(const GAS bf16x8*)(&kp_[(long)(32 + sr) * LD + sc]); } while (0)
#define SWRITE(b, i) do { *(bf16x8*)((char*)V_lds + (b) * SHM_V + vst0) = sr_[i].vs0;          \
    *(bf16x8*)((char*)V_lds + (b) * SHM_V + vst1) = sr_[i].vs1; int kc = sc * 2;               \
    *(bf16x8*)((char*)K_lds + (b) * SHM_K + KSWZ(sr, kc)) = sr_[i].ks0;                       \
    *(bf16x8*)((char*)K_lds + (b) * SHM_K + KSWZ(32 + sr, kc)) = sr_[i].ks1; } while (0)
#define SWAIT() do { if constexpr (SD == 2) asm volatile("s_waitcnt vmcnt(4)" ::: "memory"); else asm volatile("s_waitcnt vmcnt(0)" ::: "memory"); } while (0)
#define RESC(a) do { if (__any((a) < 1.f)) { if (hi == 0) al_l[r32] = (a); asm volatile("s_waitcnt lgkmcnt(0)" ::: "memory"); \
    for (int d = 0; d < 4; ++d) for (int r = 0; r < 16; ++r) o[d][r] *= al_l[crow(r, hi)]; } } while (0)
#define MASK(P0, P1, t) do { if (NA && (t) >= 8) na_mask(P0, P1, lo + (t) - 8, qrow, rs, wsn, rpbl, hi); } while (0)
  f32x16 pA0, pA1, pB0, pB1; float mnA, mnB, alA, alB; bf16x8 pa0, pa1, pa2, pa3;
  constexpr int SE = 0, SO = SD - 1;
  SLOAD(SE, 0); asm volatile("s_waitcnt vmcnt(0)" ::: "memory"); SWRITE(0, SE); __syncthreads();
  qkt(pA0, pA1, K_lds, qr, r32, hi); partialSM(pA0, pA1, m_reg, mnA, alA);
  SLOAD(SO, 1); if constexpr (SD == 2) { if (2 < NT) SLOAD(SE, 2); }
  SWAIT(); SWRITE(1, SO); __syncthreads();
  for (int j = 1; j + 1 < NT; j += 2) {
    SBAR(); qkt(pB0, pB1, (bf16*)((char*)K_lds + SHM_K), qr, r32, hi); MASK(pB0, pB1, j);
    finishSM(pA0, pA1, alA, l_reg, pa0, pa1, pa2, pa3); SBAR();
    SLOAD(SO, j + SD); SBAR();
    pv_d0(o, vb0, pa0, pa1, pa2, pa3); partialSM(pB0, pB1, m_reg, mnB, alB);
    __syncthreads(); SWAIT(); SWRITE(0, SE);
    RESC(alB); __syncthreads();
    SBAR(); qkt(pA0, pA1, K_lds, qr, r32, hi); MASK(pA0, pA1, j + 1);
    finishSM(pB0, pB1, alB, l_reg, pa0, pa1, pa2, pa3); SBAR();
    if (SD == 1 || j + 3 < NT) SLOAD(SE, j + 1 + SD); SBAR();
    pv_d0(o, vb0 + (int)SHM_V, pa0, pa1, pa2, pa3); partialSM(pA0, pA1, m_reg, mnA, alA);
    __syncthreads(); SWAIT(); SWRITE(1, SO);
    RESC(alA); __syncthreads();
  }
  SBAR(); qkt(pB0, pB1, (bf16*)((char*)K_lds + SHM_K), qr, r32, hi); MASK(pB0, pB1, NT - 1);
  finishSM(pA0, pA1, alA, l_reg, pa0, pa1, pa2, pa3); SBAR();
  pv_d0(o, vb0, pa0, pa1, pa2, pa3); partialSM(pB0, pB1, m_reg, mnB, alB);
  __syncthreads(); RESC(alB);
  finishSM(pB0, pB1, alB, l_reg, pa0, pa1, pa2, pa3); SBAR();
  pv_d0(o, vb0 + (int)SHM_V, pa0, pa1, pa2, pa3);
  if (hi == 0) li_l[r32] = l_reg; asm volatile("s_waitcnt lgkmcnt(0)" ::: "memory");
  float rli[16];
#pragma unroll
  for (int r = 0; r < 16; ++r) rli[r] = __builtin_amdgcn_rcpf(li_l[crow(r, hi)]);
  bf16* Ow = Ob + (long)(wid * QBLK) * LD;
#pragma unroll
  for (int r = 0; r < 16; ++r) { int orow = crow(r, hi);
    for (int d0 = 0; d0 < 4; ++d0) *(GAS bf16*)(Ow + (long)orow * LD + d0 * 32 + r32) = (bf16)f2bf(o[d0][r] * rli[r]); }
  asm volatile("s_waitcnt vmcnt(0)" ::: "memory"); __syncthreads();
#undef TILEK
#undef TILEV
#undef SLOAD
#undef SWRITE
#undef SWAIT
#undef RESC
#undef MASK
}
}

constexpr int NWAVES = 8;
struct Args { const float* in[36]; float* out; unsigned char* ws; int ph_lo, ph_hi; };
struct Frame { LAS unsigned char* lds; char* ldsg; volatile LAS unsigned* MISC; int tid, lane, wave, vcu, G; };
constexpr int INTAB_OFF = MISC_OFF + 128;
__device__ __forceinline__ const float* ld_in(const LAS unsigned char* lds, int i) { const unsigned long long v = ((const LAS unsigned long long*)(lds + INTAB_OFF))[i];
    const unsigned lo = __builtin_amdgcn_readfirstlane((unsigned)v), hi = __builtin_amdgcn_readfirstlane((unsigned)(v >> 32)); return (const float*)(((unsigned long long)hi << 32) | lo); }
#define IN(i) ld_in(F.lds, (i))

__device__ __forceinline__ void transpose_item(const float* W, int N, int k0, int n0, bf16* WT, int ldo, int drow0, float* scr, int lane) {
    const int kr = lane >> 3, n4 = (lane & 7) * 4;
    f32x4 v[8];
#pragma unroll
    for (int i = 0; i < 8; ++i) v[i] = *(const GAS f32x4*)(W + (size_t)(k0 + kr + 8 * i) * N + n0 + n4);
#pragma unroll
    for (int i = 0; i < 8; ++i) { float* d = scr + (kr + 8 * i) * 33 + n4; d[0] = v[i].x; d[1] = v[i].y; d[2] = v[i].z; d[3] = v[i].w; }
    LDS_WAIT(); asm volatile("" ::: "memory");
    const int c = lane & 7;
#pragma unroll
    for (int j = 0; j < 4; ++j) { const int n = (lane >> 3) + 8 * j; const float* s = scr + (8 * c) * 33 + n;
        v4u o; o.x = pk2(s[0 * 33], s[1 * 33]); o.y = pk2(s[2 * 33], s[3 * 33]); o.z = pk2(s[4 * 33], s[5 * 33]); o.w = pk2(s[6 * 33], s[7 * 33]);
        *(GAS v4u*)(WT + (size_t)(drow0 + n) * ldo + k0 + 8 * c) = o; }
    LDS_WAIT(); asm volatile("" ::: "memory");
}

__device__ __forceinline__ int cv_of_row(int row) { return row < CTXR ? 0 : 1 + ((row - CTXR) >> 10); }

template <bool FIRST, bool HASNEXT>
__device__ __forceinline__ void resnorm_rows(const Frame& F, const float* xin0, const float* xin1, float* X, const bf16* Z, const float* gpost, const float* modGate  ,
                                             const float* gpre, const float* modShift, const float* modScale, bf16* H) {
    const int gw = F.vcu * NWAVES + F.wave, NGW = F.G * NWAVES;
    for (int row = gw; row < ROWS; row += NGW) {
        const int cv = cv_of_row(row);
        f32x4 x[8];
        if (FIRST) {
            const GAS f32x4* src = (const GAS f32x4*)(row < CTXR ? xin0 + (size_t)row * DM : xin1 + (size_t)(row - CTXR) * DM);
#pragma unroll
            for (int j = 0; j < 8; ++j) x[j] = src[2 * (F.lane + 64 * (j >> 1)) + (j & 1)];
        } else {
            const GAS v4u* zr = (const GAS v4u*)(Z + (size_t)row * DM); const GAS f32x4* xr = (const GAS f32x4*)(X + (size_t)row * DM);
            f32x4 z[8]; float ss = 0.f;
#pragma unroll
            for (int jj = 0; jj < 4; ++jj) { float f[8]; unpack8(zr[F.lane + 64 * jj], f); z[2 * jj] = (f32x4){f[0], f[1], f[2], f[3]}; z[2 * jj + 1] = (f32x4){f[4], f[5], f[6], f[7]}; }
#pragma unroll
            for (int j = 0; j < 8; ++j) ss += (z[j].x * z[j].x + z[j].y * z[j].y) + (z[j].z * z[j].z + z[j].w * z[j].w);
            const float rstd = rsqrtf(wave_sum(ss, F.lane) * (1.f / DM) + RMS_EPS);
#pragma unroll
            for (int j = 0; j < 8; ++j) { const int q = 2 * (F.lane + 64 * (j >> 1)) + (j & 1); const f32x4 gp = ((const GAS f32x4*)gpost)[q], gt = ((const GAS f32x4*)(modGate + (size_t)cv * 12288))[q];
                x[j] = xr[q] + gt * (z[j] * rstd * gp); }
        }
        { GAS f32x4* xo = (GAS f32x4*)(X + (size_t)row * DM);
#pragma unroll
          for (int j = 0; j < 8; ++j) xo[2 * (F.lane + 64 * (j >> 1)) + (j & 1)] = x[j]; }
        if (HASNEXT) {
            float ss = 0.f;
#pragma unroll
            for (int j = 0; j < 8; ++j) ss += (x[j].x * x[j].x + x[j].y * x[j].y) + (x[j].z * x[j].z + x[j].w * x[j].w);
            const float rstd = rsqrtf(wave_sum(ss, F.lane) * (1.f / DM) + RMS_EPS);
            GAS v4u* ho = (GAS v4u*)(H + (size_t)row * DM);
#pragma unroll
            for (int jj = 0; jj < 4; ++jj) { float f[8];
#pragma unroll
                for (int h = 0; h < 2; ++h) { const int q = 2 * (F.lane + 64 * jj) + h; const f32x4 g = ((const GAS f32x4*)gpre)[q], sh = ((const GAS f32x4*)(modShift + (size_t)cv * 12288))[q], sc = ((const GAS f32x4*)(modScale + (size_t)cv * 12288))[q];
                    const f32x4 hv = x[2 * jj + h] * rstd * g * (sc + 1.0f) + sh; f[4 * h] = hv.x; f[4 * h + 1] = hv.y; f[4 * h + 2] = hv.z; f[4 * h + 3] = hv.w; }
                ho[F.lane + 64 * jj] = pack8(f); }
        }
    }
}

__device__ __forceinline__ void s5_tables(const Frame& F, int l, int g, unsigned char* ws) {
    char* L = F.ldsg;
    f32x2* POW = (f32x2*)L;
    f32x2* BB = (f32x2*)(L + 17408);
    f32x2* CC = (f32x2*)(L + 17408 + 16384);
    float* KT = (float*)(L + 17408 + 32768);
    const int tid = F.tid;
    __syncthreads();
    if (tid < 128) {
        const int d = tid >> 6, p = tid & 63; const size_t li = ((size_t)(l * 2 + d) * 64 + g) * 64 + p;
        const float dt = expf(IN(22)[(l * 2 + d) * 64 + g]); const float lre = IN(20)[li], lim = IN(21)[li];
        const float er = expf(lre * dt); float sn, cs; sincosf(lim * dt, &sn, &cs);
        const float br = er * cs, bi = er * sn;
        const float nr = br - 1.0f, ni = bi, den = lre * lre + lim * lim;
        const float cr = (nr * lre + ni * lim) / den, ci = (ni * lre - nr * lim) / den;
        float pr = 1.f, pi = 0.f;
        for (int t = 0; t <= 16; ++t) { POW[(d * 64 + p) * 17 + t] = (f32x2){pr, pi}; const float nr2 = pr * br - pi * bi, ni2 = pr * bi + pi * br; pr = nr2; pi = ni2; }
        ((f32x2*)(ws + WS_LT))[li] = POW[(d * 64 + p) * 17 + 16];
        for (int m = 0; m < 16; ++m) { const float xr = IN(23)[li * 16 + m], xi = IN(24)[li * 16 + m]; BB[(d * 64 + p) * 16 + m] = (f32x2){cr * xr - ci * xi, cr * xi + ci * xr}; }
    }
    for (int i = tid; i < 2048; i += 512) { const int d = i >> 10, n = (i >> 6) & 15, p = i & 63; const size_t ci_ = (((size_t)(l * 2 + d) * 64 + g) * 16 + n) * 64 + p; CC[i] = (f32x2){IN(25)[ci_], IN(26)[ci_]}; }
    __syncthreads();
    for (int i = tid; i < 8192; i += 512) {
        const int d = i >> 12, tau = (i >> 8) & 15, n = (i >> 4) & 15, m = i & 15; float s = 0.f;
        for (int p = 0; p < 64; ++p) { const f32x2 c = CC[(d * 16 + n) * 64 + p], w = POW[(d * 64 + p) * 17 + tau], b = BB[(d * 64 + p) * 16 + m];
            const float tr = c.x * w.x - c.y * w.y, ti = c.x * w.y + c.y * w.x; s += tr * b.x - ti * b.y; }
        KT[i] = s;
    }
    __syncthreads();
    bf16* MT = (bf16*)(ws + WS_MT) + (size_t)(l * 64 + g) * 65536; bf16* ET = (bf16*)(ws + WS_ET) + (size_t)(l * 64 + g) * 65536; bf16* FT = (bf16*)(ws + WS_FT) + (size_t)(l * 64 + g) * 65536;
    for (int i = tid; i < 8192; i += 512) {
        const int rowi = i >> 5, k0 = (i & 31) * 8;
        { const int t = rowi >> 4, n = rowi & 15, s = k0 >> 4, m0 = k0 & 15; float f[8];
#pragma unroll
          for (int e = 0; e < 8; ++e) { float v = 0.f; if (s <= t) v += KT[((0 * 16 + (t - s)) * 16 + n) * 16 + m0 + e]; if (s >= t) v += KT[((1 * 16 + (s - t)) * 16 + n) * 16 + m0 + e]; f[e] = v; }
          *(GAS v4u*)(MT + (size_t)rowi * 256 + k0) = pack8(f); }
        { const int d = rowi >> 7, p = (rowi >> 1) & 63, c = rowi & 1, s = k0 >> 4, m0 = k0 & 15; float f[8];
          const f32x2 w = POW[(d * 64 + p) * 17 + (d == 0 ? 15 - s : s)];
#pragma unroll
          for (int e = 0; e < 8; ++e) { const f32x2 b = BB[(d * 64 + p) * 16 + m0 + e]; f[e] = c == 0 ? (w.x * b.x - w.y * b.y) : (w.x * b.y + w.y * b.x); }
          *(GAS v4u*)(ET + (size_t)rowi * 256 + k0) = pack8(f); }
        { const int t = rowi >> 4, n = rowi & 15; float f[8];
#pragma unroll
          for (int e = 0; e < 8; ++e) { const int k = k0 + e, d = k >> 7, p = (k >> 1) & 63, c = k & 1; const f32x2 cc = CC[(d * 16 + n) * 64 + p], w = POW[(d * 64 + p) * 17 + (d == 0 ? t + 1 : 16 - t)];
              f[e] = c == 0 ? (cc.x * w.x - cc.y * w.y) : -(cc.x * w.y + cc.y * w.x); }
          *(GAS v4u*)(FT + (size_t)rowi * 256 + k0) = pack8(f); }
    }
    __syncthreads();
}

constexpr int I_WIN = 32 * 384, I_GLU = 16 * 32, I_OUT = 16 * 64, I_WO = 32 * 64, I_FIN = 32 * 352, I_FOUT = 88 * 64, I_GW = 32 * 8;
constexpr int I_LAYER = I_WIN + I_GLU + 3 * I_OUT + I_WO + I_FIN + I_FOUT + I_GW;
__device__ __forceinline__ void weight_item(const Frame& F, unsigned char* ws, int l, int r, float* scr) {
    if (r < I_WIN) { const int kb = r / 384, nb = r % 384; transpose_item(IN(14) + (size_t)l * DM * INW, INW, kb * 64, nb * 32, (bf16*)(ws + WS_WINT) + (size_t)l * INW * DM, DM, nb * 32, scr, F.lane); return; } r -= I_WIN;
    if (r < I_GLU) { const int kb = r / 32, nb = r % 32; transpose_item(IN(28) + (size_t)l * 1024 * 1024, 1024, kb * 64, nb * 32, (bf16*)(ws + WS_GLUT) + (size_t)l * 1024 * 1024, 1024, nb * 32, scr, F.lane); return; } r -= I_GLU;
    if (r < 3 * I_OUT) { const int b = r / I_OUT, q = r % I_OUT, kb = q / 64, nb = q % 64; transpose_item(IN(30 + b) + (size_t)l * 1024 * DM, DM, kb * 64, nb * 32, (bf16*)(ws + WS_OUTT) + ((size_t)l * 3 + b) * DM * 1024, 1024, nb * 32, scr, F.lane); return; } r -= 3 * I_OUT;
    if (r < I_WO) { const int kb = r / 64, nb = r % 64; transpose_item(IN(33) + (size_t)l * DM * DM, DM, kb * 64, nb * 32, (bf16*)(ws + WS_WOT) + (size_t)l * DM * DM, DM, nb * 32, scr, F.lane); return; } r -= I_WO;
    if (r < I_FIN) { const int kb = r / 352, nb = r % 352; const int n0 = nb * 32, half = n0 >= FFH, j = n0 - half * FFH; const int drow = 256 * (j >> 7) + 128 * half + (j & 127);
        transpose_item(IN(34) + (size_t)l * DM * 2 * FFH, 2 * FFH, kb * 64, n0, (bf16*)(ws + WS_FINT) + (size_t)l * 2 * FFH * DM, DM, drow, scr, F.lane); return; } r -= I_FIN;
    if (r < I_FOUT) { const int kb = r / 64, nb = r % 64; transpose_item(IN(35) + (size_t)l * FFH * DM, DM, kb * 64, nb * 32, (bf16*)(ws + WS_FOUTT) + (size_t)l * DM * FFH, FFH, nb * 32, scr, F.lane); return; } r -= I_FOUT;
    { const int mi = r >> 3, q = r & 7, kb = q >> 2, nb = q & 3;
      const int d = mi >> 4, g = (mi >> 3) & 1, h = mi & 7;
      transpose_item(IN(17) + ((size_t)l * 32 + mi) * 128 * 128, 128, kb * 64, nb * 32, (bf16*)(ws + WS_GWT) + (((size_t)l * 8 + h) * 2 + d) * 256 * 128, 128, g * 128 + nb * 32, scr, F.lane); }
}
constexpr int QB = 16;
static_assert(I_LAYER % QB == 0, "queue batch");
constexpr int Q_P2 = 562 * QB, Q_P3 = 624 * QB, Q_P4 = 1374 * QB, Q_P5 = 1813 * QB, Q_P9 = I_LAYER;
constexpr int CW_Q = 8192;
__device__ __forceinline__ void pull_weight_items(const Frame& F, unsigned char* ws, int l, int upto) {
    if (l >= NL) return;
    unsigned* ctr = (unsigned*)(ws + WS_CTL) + CW_Q + 64 * l; float* scr = (float*)(F.ldsg + F.wave * 16384);
    const int upto_b = upto / QB;
    for (;;) {
        unsigned i = 0;
        if (F.lane == 0) asm volatile("global_atomic_add %0, %1, %2, off sc0\n\ts_waitcnt vmcnt(0)" : "=&v"(i) : "v"(ctr), "v"(1u) : "memory");
        i = (unsigned)__builtin_amdgcn_readfirstlane((int)i);
        if ((int)i >= upto_b) { if (F.lane == 0) asm volatile("global_atomic_sub %0, %1, off" :: "v"(ctr), "v"(1u) : "memory"); break; }
        for (int j = 0; j < QB; ++j) weight_item(F, ws, l, (int)i * QB + j, scr);
    }
}

constexpr int SQ_P5 = 6, SQ_P9 = 10, SQ_END = (SQ_P5 + SQ_P9) * 1024;
__device__ __forceinline__ void static_weight_items(const Frame& F, unsigned char* ws, int l, int c, int G, int k0, int nk) {
    if (l >= NL || G != 256 || c < 128) return;
    float* scr = (float*)(F.ldsg + F.wave * 16384); const int w = (c - 128) * 8 + F.wave;
    for (int k = 0; k < nk; ++k) weight_item(F, ws, l, (k0 + k) * 1024 + w, scr);
}

__global__ void __launch_bounds__(NWAVES * 64, 2) fwd_kernel(Args args) {
    extern __shared__ __attribute__((aligned(16))) unsigned char lds[];
    const int G0 = gridDim.x, c0 = (int)blockIdx.x;
    volatile LAS unsigned* MISC0 = (volatile LAS unsigned*)((LAS unsigned char*)lds + MISC_OFF);
    unsigned char* const ws0 = args.ws; float* const out0 = args.out;
    gu32* ctl = (gu32*)(ws0 + WS_CTL);
    for (int u = threadIdx.x; u < (LDS_BYTES - LDSCTL_OFF) / 4; u += NWAVES * 64) ((LAS unsigned*)((LAS unsigned char*)lds + LDSCTL_OFF))[u] = 0u;
    __syncthreads();
    if (threadIdx.x == 0) {
#pragma unroll
        for (int i = 0; i < 36; ++i) ((LAS unsigned long long*)((LAS unsigned char*)lds + INTAB_OFF))[i] = (unsigned long long)args.in[i]; }
    __syncthreads();
    XcdBarrier bar; bar.bar = (unsigned*)(ctl + CW_BAR); bar.x = 0; bar.st = nullptr;
    if (MK_N_LAUNCHES == 1) bar = xcd_barrier_post((unsigned*)(ctl + CW_BAR), MISC0 + 8);
    const int lo = args.ph_lo, hi = args.ph_hi;
    int ph = 0;
#ifndef PHMASK
#define PHMASK 0xFFFFFFFFu
#endif
#define PHASE_BEGIN(k) if (((PHMASK >> (k)) & 1u) && lo <= ph && ph < hi) { if ((k) == TSEL && threadIdx.x == 0) *(volatile LAS unsigned long long*)(MISC0 + 16) = __builtin_amdgcn_s_memrealtime(); unsigned char* ws = ws0; float* outp = out0; int tid_p = threadIdx.x, G = G0, c = c0; asm volatile("" : "+s"(ws), "+s"(outp), "+v"(tid_p), "+s"(G), "+s"(c)); const int vcu = (G % 8 == 0) ? (c % 8) * (G / 8) + c / 8 : c;     \
    Frame F; F.lds = (LAS unsigned char*)lds; F.ldsg = (char*)lds; F.MISC = (volatile LAS unsigned*)(F.lds + MISC_OFF); F.tid = tid_p; F.lane = tid_p & 63; F.wave = __builtin_amdgcn_readfirstlane(tid_p >> 6); F.G = G; F.vcu = vcu; \
    const int gw = vcu * NWAVES + F.wave, NGW = G * NWAVES, gt = vcu * 512 + F.tid, NGT = G * 512; (void)gw; (void)NGW; (void)gt; (void)NGT; \
    float* const X = outp + O_X; bf16* const Hb = (bf16*)(ws + WS_H); float* const MOD = (float*)(ws + WS_MOD); const float* const modl = MOD + (size_t)l_ * NCV * INW; (void)X; (void)Hb; (void)modl;
#define PHASE_END(k)   if (MK_N_LAUNCHES == 1 && ph + 1 < hi) { XcdBarrier b_ = bar; asm volatile("" : "+s"(b_.bar)); xcd_barrier(b_); } if ((k) == TSEL && threadIdx.x == 0) *(volatile LAS unsigned long long*)(MISC0 + 18) += __builtin_amdgcn_s_memrealtime() - *(volatile LAS unsigned long long*)(MISC0 + 16); } ++ph;
    int l_ = 0;

    PHASE_BEGIN(0)
    {
        for (int it = F.vcu; it < NL * 64; it += G) s5_tables(F, it >> 6, it & 63, ws);
        __syncthreads();
        { const float* lamp = IN(19); for (int i = gt; i < NL * 2 * 1024; i += NGT) ((float*)(ws + WS_SP))[i] = log1pf(expf(-lamp[i])); }
        float* scr = (float*)(F.ldsg + F.wave * 16384);
        { const int rest = (G == 256) ? I_LAYER - SQ_END : I_LAYER;
          for (int it = gw; it < I_LAYER + 3 * rest; it += NGW) { if (it < I_LAYER) weight_item(F, ws, 0, it, scr); else { const int q = it - I_LAYER, l = 1 + q / rest, r = q % rest; weight_item(F, ws, l, I_LAYER - rest + r, scr); } } }
        const float* ckp = IN(2); const float* cvp = IN(3);
        for (int i0 = gt; i0 < 2 * 1048576; i0 += 4 * NGT) { f32x4 a0[4], a1[4];
#pragma unroll
            for (int q = 0; q < 4; ++q) { const int i = i0 + q * NGT; if (i < 2 * 1048576) { const int which = i >> 20, j = i & 1048575; const GAS f32x4* s = (const GAS f32x4*)(which ? cvp : ckp) + (size_t)j * 2; a0[q] = s[0]; a1[q] = s[1]; } }
#pragma unroll
            for (int q = 0; q < 4; ++q) { const int i = i0 + q * NGT; if (i < 2 * 1048576) { const int which = i >> 20, j = i & 1048575;
                v4u o; o.x = pk2(a0[q].x, a0[q].y); o.y = pk2(a0[q].z, a0[q].w); o.z = pk2(a1[q].x, a1[q].y); o.w = pk2(a1[q].z, a1[q].w); ((GAS v4u*)(ws + (which ? WS_CV : WS_CK)))[j] = o; } } }
        const float* cctx = IN(7); const float* cvec = IN(6); const float* wmod = IN(8);
        for (int task = gt; task < 16 * NL * 3072; task += NGT) {
            const int n4 = task % 3072, l = (task / 3072) % NL, ks = task / (3072 * NL);
            f32x4 acc[NCV];
#pragma unroll
            for (int v = 0; v < NCV; ++v) acc[v] = (f32x4){0.f, 0.f, 0.f, 0.f};
            const GAS f32x4* wp = (const GAS f32x4*)(wmod + ((size_t)l * DM + ks * 128) * INW) + n4;
            for (int kb = 0; kb < 128; kb += 16) { f32x4 w[16];
#pragma unroll
                for (int j = 0; j < 16; ++j) w[j] = wp[(size_t)(kb + j) * (INW / 4)];
#pragma unroll
                for (int j = 0; j < 16; ++j) { const int kk = ks * 128 + kb + j;
#pragma unroll
                    for (int v = 0; v < NCV; ++v) { const float cnd = v == 0 ? cctx[kk] : cvec[(v - 1) * DM + kk]; const float sl = cnd * fsigmoid(cnd); acc[v] += w[j] * sl; } } }
#pragma unroll
            for (int v = 0; v < NCV; ++v) ((f32x4*)(ws + WS_MODP))[(((size_t)ks * NL + l) * NCV + v) * 3072 + n4] = acc[v];
        }
    }
    PHASE_END(0)
    PHASE_BEGIN(1)
        const float* bmod = IN(9);
        for (int i = gt; i < NL * NCV * 3072; i += NGT) { const int n4 = i % 3072, v = (i / 3072) % NCV, l = i / (3072 * NCV);
            f32x4 s = ((const f32x4*)(bmod + (size_t)l * INW))[n4];
            f32x4 pp[16];
#pragma unroll
            for (int ks = 0; ks < 16; ++ks) pp[ks] = ((const GAS f32x4*)(ws + WS_MODP))[(((size_t)ks * NL + l) * NCV + v) * 3072 + n4];
#pragma unroll
            for (int ks = 0; ks < 16; ++ks) s += pp[ks];
            ((f32x4*)MOD)[i] = s; }
    PHASE_END(1)
    PHASE_BEGIN(2)
        resnorm_rows<true, true>(F, IN(0), IN(1), X, nullptr, nullptr, nullptr, IN(10), MOD + 0 * DM, MOD + 1 * DM, Hb);
    PHASE_END(2)

    for (int l = 0; l < DBG_NL; ++l) {
        l_ = l;
        PHASE_BEGIN(3)
        {   pg8::SchedPlain S{(const char*)Hb, (const char*)(ws + WS_WINT) + (size_t)l * INW * DM * 2, 32, 48, G, c, (size_t)256 * DM * 2, (size_t)256 * DM * 2, DUPG1};
            pg8::EpiWin E{(bf16*)(ws + WS_XR), (bf16*)(ws + WS_XG), (bf16*)(ws + WS_UG), (bf16*)(ws + WS_Q), (bf16*)(ws + WS_K), (bf16*)(ws + WS_V), (bf16*)(ws + WS_G),
                          outp + O_K + (size_t)l * 256 * 1024, outp + O_V + (size_t)l * 256 * 1024};
            pg8::gemm_phase(F.lds, DM, DM, DM, S, E); }
        PHASE_END(3)
        PHASE_BEGIN(4)
        {
            { const bf16* XR = (const bf16*)(ws + WS_XR); bf16* XC = (bf16*)(ws + WS_XC); const GAS float* cw = (const GAS float*)(IN(15) + (size_t)l * 4 * 1024); const GAS float* cb = (const GAS float*)(IN(16) + (size_t)l * 1024);
              for (int i_ = gt; i_ < ROWS * 128 * DUP_CONV; i_ += NGT) { const int i = i_ % (ROWS * 128); const int row = i >> 7, c8 = (i & 127) * 8;
                  const int s0 = row < CTXR ? (row & ~255) : (CTXR + ((row - CTXR) & ~1023)), s1 = row < CTXR ? s0 + 256 : s0 + 1024;
                  float acc[8];
#pragma unroll
                  for (int e = 0; e < 8; ++e) acc[e] = cb[c8 + e];
#pragma unroll
                  for (int k = 0; k < 4; ++k) { const int rr = row + k - 1; if (rr >= s0 && rr < s1) { float xv[8]; unpack8(*(const GAS v4u*)(XR + (size_t)rr * 1024 + c8), xv);
#pragma unroll
                      for (int e = 0; e < 8; ++e) acc[e] += cw[k * 1024 + c8 + e] * xv[e]; } }
                  *(GAS v4u*)(XC + (size_t)row * 1024 + c8) = pack8(acc); } }
            for (int L = c; L < 128 * DUP_S5; L += G) { const int g = (L & 127) >> 1, pm = L & 1;
                { pg8::SchedOne S{(const char*)(ws + WS_UG) + ((size_t)g * 512 + pm * 256) * 256 * 2, (const char*)(ws + WS_ET) + ((size_t)l * 64 + g) * 65536 * 2, nullptr, nullptr, pm, g, 1}; pg8::EpiHloc E{(float*)(ws + WS_HLOC)};
                  pg8::gemm_phase(F.lds, 256, 256, 256, S, E); }
                { const float* HLOC = (const float*)(ws + WS_HLOC); bf16* HIN = (bf16*)(ws + WS_HIN); const GAS f32x2* LT = (const GAS f32x2*)(ws + WS_LT) + (size_t)l * 2 * 64 * 64;
                  const int nseq = pm ? 4 : 16, nch = pm ? 64 : 16;
                  for (int i = F.tid; i < nseq * 128; i += 512) { const int p = i & 63, d = (i >> 6) & 1, sq = i >> 7; const int seq = pm ? 16 + sq : sq, ch0 = pm ? 256 + sq * 64 : sq * 16;
                      const f32x2 lam = LT[(d * 64 + g) * 64 + p]; float hr = 0.f, hi_ = 0.f;
                      if (pm) { const f32x2 h0 = ((const f32x2*)IN(5))[((((size_t)sq * 4 + l) * 2 + d) * 64 + g) * 64 + p]; hr = h0.x; hi_ = h0.y; }
                      for (int kb = 0; kb < nch; kb += 16) { f32x2 hl[16];
#pragma unroll
                          for (int j = 0; j < 16; ++j) { const int ch = d == 0 ? ch0 + kb + j : ch0 + nch - 1 - kb - j; hl[j] = *(const GAS f32x2*)(HLOC + ((size_t)g * 512 + ch) * 256 + d * 128 + p * 2); }
#pragma unroll
                          for (int j = 0; j < 16; ++j) { const int ch = d == 0 ? ch0 + kb + j : ch0 + nch - 1 - kb - j; *(GAS unsigned*)(HIN + ((size_t)g * 512 + ch) * 256 + d * 128 + p * 2) = pk2(hr, hi_);
                              const float nr = lam.x * hr - lam.y * hi_ + hl[j].x, ni = lam.x * hi_ + lam.y * hr + hl[j].y; hr = nr; hi_ = ni; } }
                      if (!pm) ((f32x2*)(outp + O_S5))[((((size_t)seq * 4 + l) * 2 + d) * 64 + g) * 64 + p] = (f32x2){hr, hi_}; }
                  VM_WAIT(); __syncthreads(); }
                { pg8::SchedOne S{(const char*)(ws + WS_UG) + ((size_t)g * 512 + pm * 256) * 256 * 2, (const char*)(ws + WS_MT) + ((size_t)l * 64 + g) * 65536 * 2,
                                  (const char*)(ws + WS_HIN) + ((size_t)g * 512 + pm * 256) * 256 * 2, (const char*)(ws + WS_FT) + ((size_t)l * 64 + g) * 65536 * 2, pm, g, 2};
                  pg8::EpiS5Y E{(const bf16*)(ws + WS_UG), IN(27) + (size_t)l * 1024, (bf16*)(ws + WS_ZS)};
                  pg8::gemm_phase(F.lds, 256, 256, 256, S, E); }
            }
            __syncthreads();
            { float* rp = (float*)(F.ldsg + att::RPB_OFF); const bf16* Qb = (const bf16*)(ws + WS_Q); const bf16* Kb = (const bf16*)(ws + WS_K); const bf16* Vb = (const bf16*)(ws + WS_V); bf16* Ob = (bf16*)(ws + WS_YNA);
              for (int u_ = (c + G / 2) % G; u_ < 256 * DUP_ATT; u_ += G) { const int u = u_ & 255;
                  if (u < 128) { const int b = u >> 5, h = (u >> 2) & 7, rg = u & 3; const int lo_ = rg == 0 ? 0 : (rg == 1 ? 0 : (rg == 2 ? 4 : 8)), NT = (rg == 0 || rg == 3) ? 16 : 20;
                      for (int i = F.tid; i < 465; i += 512) rp[i] = IN(29)[((size_t)l * 8 + h) * 465 + i] * (1.0f / att::SCALE);
                      __syncthreads();
                      const size_t qoff = (size_t)(CTXR + b * 1024 + rg * 256) * 1024 + h * 128, koff = (size_t)(CTXR + b * 1024 + lo_ * 64) * 1024 + h * 128, coff = ((size_t)(b * 4 + l) * 512) * 1024 + h * 128;
                      att::attn_body<true, 1>(Qb + qoff, (const bf16*)(ws + WS_CK) + coff, (const bf16*)(ws + WS_CV) + coff, Kb + koff, Vb + koff, Ob + qoff, NT, lo_, rg, F.ldsg);
                  } else { const int b = (u - 128) >> 3, h = (u - 128) & 7; const size_t off = (size_t)(b * 256) * 1024 + h * 128;
                      att::attn_body<false, 2>(Qb + off, Kb + off, Vb + off, Kb + off, Vb + off, Ob + off, 4, 0, 0, F.ldsg); }
              } }
        }
        PHASE_END(4)
        PHASE_BEGIN(5)
        {   { pg8::SchedRg S{(const char*)(ws + WS_XC), (const char*)(ws + WS_GWT) + (size_t)l * 8 * 2 * 256 * 128 * 2, G, c};
              pg8::EpiRg E{(const bf16*)(ws + WS_XC), IN(18) + (size_t)l * 4 * 1024, (const float*)(ws + WS_SP) + (size_t)l * 2048, (f32x2*)(ws + WS_AB)};
              pg8::gemm_phase(F.lds, 128, 1024, 128, S, E); }
            { pg8::SchedPlain S{(const char*)(ws + WS_ZS), (const char*)(ws + WS_GLUT) + (size_t)l * 1024 * 1024 * 2, 32, 4, G, c, (size_t)256 * 1024 * 2, (size_t)256 * 1024 * 2, 1};
              pg8::EpiGlu E{(const bf16*)(ws + WS_ZS), (bf16*)(ws + WS_YS5)};
              pg8::gemm_phase(F.lds, 1024, 1024, 1024, S, E); }
            __syncthreads(); static_weight_items(F, ws, l + 1, c, G, 0, SQ_P5);
        }
        PHASE_END(5)
        PHASE_BEGIN(6)
        {
            { const GAS unsigned* AB = (const GAS unsigned*)(ws + WS_AB); GAS float* HF = (GAS float*)(ws + WS_HF); const GAS bf16* XG = (const GAS bf16*)(ws + WS_XG); GAS bf16* YRG = (GAS bf16*)(ws + WS_YRG);
              float* cs = (float*)F.ldsg;
              for (int task_ = (c + G / 2) % G; task_ < 320 * DUP_SCAN; task_ += G) { const int task = task_ % 320;
                  const bool lat = task >= 64 && task < 128; const int ti = lat ? task - 64 : (task < 64 ? task : task - 64); const int seq = ti >> 4, cb = ti & 15;
                  const int L = lat ? 1024 : 256, row0 = lat ? CTXR + seq * 1024 : seq * 256, ch = cb * 64 + F.lane, len = L / 8, t0 = row0 + F.wave * len;
                  __syncthreads();
                  float pf = 1.f, hf = 0.f, pb = 1.f, hb = 0.f;
                  for (int tb = 0; tb < len; tb += 16) { unsigned v[16];
#pragma unroll
                      for (int j = 0; j < 16; ++j) v[j] = AB[(size_t)(t0 + tb + j) * 1024 + ch];
#pragma unroll
                      for (int j = 0; j < 16; ++j) { const float a = 1.0f - bflo(v[j]); hf = a * hf + bfhi(v[j]); pf *= a; } }
                  for (int tb = len - 16; tb >= 0; tb -= 16) { unsigned v[16];
#pragma unroll
                      for (int j = 0; j < 16; ++j) v[j] = AB[((size_t)ROWS + t0 + tb + j) * 1024 + ch];
#pragma unroll
                      for (int j = 15; j >= 0; --j) { const float a = 1.0f - bflo(v[j]); hb = a * hb + bfhi(v[j]); pb *= a; } }
                  cs[(F.wave * 4 + 0) * 64 + F.lane] = pf; cs[(F.wave * 4 + 1) * 64 + F.lane] = hf; cs[(F.wave * 4 + 2) * 64 + F.lane] = pb; cs[(F.wave * 4 + 3) * 64 + F.lane] = hb;
                  __syncthreads();
                  float cf = lat ? IN(4)[((size_t)(seq * 4 + l) * 2 + 0) * 1024 + ch] : 0.f, cbk = lat ? IN(4)[((size_t)(seq * 4 + l) * 2 + 1) * 1024 + ch] : 0.f;
                  for (int w = 0; w < F.wave; ++w) cf = cs[(w * 4 + 0) * 64 + F.lane] * cf + cs[(w * 4 + 1) * 64 + F.lane];
                  for (int w = 7; w > F.wave; --w) cbk = cs[(w * 4 + 2) * 64 + F.lane] * cbk + cs[(w * 4 + 3) * 64 + F.lane];
                  if (!lat) { if (F.wave == 7) outp[O_RG + ((size_t)(seq * 4 + l) * 2 + 0) * 1024 + ch] = pf * cf + hf; if (F.wave == 0) outp[O_RG + ((size_t)(seq * 4 + l) * 2 + 1) * 1024 + ch] = pb * cbk + hb; }
                  float h = cf;
                  for (int tb = 0; tb < len; tb += 16) { unsigned v[16];
#pragma unroll
                      for (int j = 0; j < 16; ++j) v[j] = AB[(size_t)(t0 + tb + j) * 1024 + ch];
#pragma unroll
                      for (int j = 0; j < 16; ++j) { h = (1.0f - bflo(v[j])) * h + bfhi(v[j]); HF[(size_t)(t0 + tb + j) * 1024 + ch] = h; } }
                  VM_WAIT();
                  h = cbk;
                  for (int tb = len - 16; tb >= 0; tb -= 16) { unsigned v[16]; float hfv[16]; bf16 xg[16];
#pragma unroll
                      for (int j = 0; j < 16; ++j) { const size_t o = (size_t)(t0 + tb + j) * 1024 + ch; v[j] = AB[(size_t)ROWS * 1024 + o]; hfv[j] = HF[o]; xg[j] = XG[o]; }
#pragma unroll
                      for (int j = 15; j >= 0; --j) { h = (1.0f - bflo(v[j])) * h + bfhi(v[j]); YRG[(size_t)(t0 + tb + j) * 1024 + ch] = (bf16)f2bf((hfv[j] + h) * bf2f(xg[j])); } }
              } }
        }
        PHASE_END(6)
        PHASE_BEGIN(8)
        {   pg8::SchedMerge S{(const char*)(ws + WS_YRG), (const char*)(ws + WS_YS5), (const char*)(ws + WS_YNA), (const char*)(ws + WS_OUTT) + (size_t)l * 3 * DM * 1024 * 2, G, c};
            pg8::EpiMerge E{(const bf16*)(ws + WS_G), (bf16*)(ws + WS_MM)};
            pg8::gemm_phase(F.lds, 1024, 1024, 1024, S, E); }
        PHASE_END(8)
#if FUSE_NORM
        PHASE_BEGIN(9)
        {   pg8::SchedPlain S{(const char*)(ws + WS_MM), (const char*)(ws + WS_WOT) + (size_t)l * DM * DM * 2, 32, 8, G, c, (size_t)256 * DM * 2, (size_t)256 * DM * 2, 1};
            unsigned* ctlw = (unsigned*)(ws + WS_CTL); const int b0 = (l * 2 + 0) * 2;
            pg8::PanelSS s1{(float*)(ws + WS_XS) + (size_t)b0 * 65536, ctlw + CW_SEAM + b0 * SEAM_BANK, ctlw + CW_TMO}, s2{(float*)(ws + WS_XS) + (size_t)(b0 + 1) * 65536, ctlw + CW_SEAM + (b0 + 1) * SEAM_BANK, ctlw + CW_TMO};
            pg8::EpiResNorm E{X, Hb, IN(11) + (size_t)l * DM, modl + 2 * DM, IN(12) + (size_t)l * DM, modl + 3 * DM, modl + 4 * DM, s1, s2, 1};
            pg8::gemm_phase(F.lds, DM, DM, DM, S, E); }
        PHASE_END(9)
#else
        PHASE_BEGIN(9)
        {   pg8::SchedPlain S{(const char*)(ws + WS_MM), (const char*)(ws + WS_WOT) + (size_t)l * DM * DM * 2, 32, 8, G, c, (size_t)256 * DM * 2, (size_t)256 * DM * 2, 1};
            pg8::EpiB16 E{(bf16*)(ws + WS_Z), DM};
            pg8::gemm_phase(F.lds, DM, DM, DM, S, E); }
        PHASE_END(9)
        PHASE_BEGIN(10)
            resnorm_rows<false, true>(F, nullptr, nullptr, X, (const bf16*)(ws + WS_Z), IN(11) + (size_t)l * DM, modl + 2 * DM, IN(12) + (size_t)l * DM, modl + 3 * DM, modl + 4 * DM, Hb);
        PHASE_END(10)
#endif
        PHASE_BEGIN(11)
        {   pg8::SchedPlain S{(const char*)Hb, (const char*)(ws + WS_FINT) + (size_t)l * 2 * FFH * DM * 2, 32, 44, G, c, (size_t)256 * DM * 2, (size_t)256 * DM * 2, DUPG9};
            pg8::EpiSwiglu E{(bf16*)(ws + WS_FH)};
            pg8::gemm_phase(F.lds, DM, DM, DM, S, E);
            __syncthreads(); static_weight_items(F, ws, l + 1, c, G, SQ_P5, SQ_P9); }
        PHASE_END(11)
#if FUSE_NORM
        PHASE_BEGIN(12)
        {   pg8::SchedPlain S{(const char*)(ws + WS_FH), (const char*)(ws + WS_FOUTT) + (size_t)l * DM * FFH * 2, 32, 8, G, c, (size_t)256 * FFH * 2, (size_t)256 * FFH * 2, DUPG10};
            unsigned* ctlw = (unsigned*)(ws + WS_CTL); const int b0 = (l * 2 + 1) * 2; const int ln = l + 1 < NL ? l + 1 : l;
            pg8::PanelSS s1{(float*)(ws + WS_XS) + (size_t)b0 * 65536, ctlw + CW_SEAM + b0 * SEAM_BANK, ctlw + CW_TMO}, s2{(float*)(ws + WS_XS) + (size_t)(b0 + 1) * 65536, ctlw + CW_SEAM + (b0 + 1) * SEAM_BANK, ctlw + CW_TMO};
            pg8::EpiResNorm E{X, Hb, IN(13) + (size_t)l * DM, modl + 5 * DM, IN(10) + (size_t)ln * DM, MOD + (size_t)ln * NCV * INW + 0 * DM, MOD + (size_t)ln * NCV * INW + 1 * DM, s1, s2, (l + 1 < NL) ? 1 : 0};
            pg8::gemm_phase(F.lds, FFH, FFH, FFH, S, E); }
        PHASE_END(12)
#else
        PHASE_BEGIN(12)
        {   pg8::SchedPlain S{(const char*)(ws + WS_FH), (const char*)(ws + WS_FOUTT) + (size_t)l * DM * FFH * 2, 32, 8, G, c, (size_t)256 * FFH * 2, (size_t)256 * FFH * 2, DUPG10};
            pg8::EpiB16 E{(bf16*)(ws + WS_Z), DM};
            pg8::gemm_phase(F.lds, FFH, FFH, FFH, S, E); }
        PHASE_END(12)
        PHASE_BEGIN(13)
            if (l + 1 < NL) resnorm_rows<false, true>(F, nullptr, nullptr, X, (const bf16*)(ws + WS_Z), IN(13) + (size_t)l * DM, modl + 5 * DM, IN(10) + (size_t)(l + 1) * DM, modl + NCV * INW + 0 * DM, modl + NCV * INW + 1 * DM, Hb);
            else resnorm_rows<false, false>(F, nullptr, nullptr, X, (const bf16*)(ws + WS_Z), IN(13) + (size_t)l * DM, modl + 5 * DM, nullptr, nullptr, nullptr, Hb);
        PHASE_END(13)
#endif
    }
#if DBG_KEEP
    PHASE_BEGIN(14)
        for (size_t i = (size_t)gt; i < O_END; i += (size_t)NGT) {
            int r, lay = 0;
            if (i < O_K) r = i < O_K / 2 ? 0 : 1;
            else if (i < O_V) { r = 2; lay = (int)(((i - O_K) / (256 * 1024)) & 3); }
            else if (i < O_RG) { r = 3; lay = (int)(((i - O_V) / (256 * 1024)) & 3); }
            else if (i < O_S5) { r = 4; lay = (int)(((i - O_RG) / 2048) & 3); }
            else { r = 5; lay = (int)(((i - O_S5) / 16384) & 3); }
            const bool keep = ((DBG_KEEP >> r) & 1) && (r < 2 || ((DBG_LMASK >> lay) & 1));
            float v = keep ? 3.0f * outp[i] : 0.0f;
#if DBG_DUMP
            v = 0.f;
            if (i >= O_K && i < O_K + (size_t)ROWS * 1024) { const size_t j = i - O_K;
                if (DBG_DUMP == 1) v = bf2f(((const bf16*)(ws + WS_YNA))[j]);
                if (DBG_DUMP == 2) v = bf2f(((const bf16*)(ws + WS_YS5))[j]);
                if (DBG_DUMP == 3) v = bf2f(((const bf16*)(ws + WS_YRG))[j]);
                if (DBG_DUMP == 4) v = bf2f(((const bf16*)(ws + WS_ZS))[j]);
                if (DBG_DUMP == 5) v = bf2f(((const bf16*)(ws + WS_MM))[j]);
                if (DBG_DUMP == 6) v = ((const bf16*)(ws + WS_Z))[j];
                if (DBG_DUMP == 7) v = bf2f(((const bf16*)(ws + WS_FH))[j]);
                if (DBG_DUMP == 8) v = bf2f(((const bf16*)(ws + WS_H))[j]);
                if (DBG_DUMP == 9) v = bf2f(((const bf16*)(ws + WS_G))[j]);
                if (DBG_DUMP == 11) v = bf2f(((const bf16*)(ws + WS_G))[(size_t)8192 * 6144 + j]);
                if (DBG_DUMP == 10) v = bf2f(((const bf16*)(ws + WS_WINT))[(size_t)6144 * 2048 + j]);
            }
#endif
            outp[i] = v;
        }
    PHASE_END(14)
#endif
    if (TSEL >= 0 && blockIdx.x == 0 && threadIdx.x == 0) { const float us = (float)(*(volatile LAS unsigned long long*)(MISC0 + 18)) * 0.01f; out0[0] = exp2f(rintf(log2f(us) * 10.0f) * 0.1f); }
#undef PHASE_BEGIN
#undef PHASE_END
}
constexpr int N_PHASES = 3 + DBG_NL * (FUSE_NORM ? 8 : 10) + (DBG_KEEP ? 1 : 0);

extern "C" void kernel_launch(void* const* d_in, const int* in_sizes, int n_in, void* d_out, int out_size, void* d_ws, size_t ws_size, hipStream_t stream) {
    static int grid = 0;
    if (grid == 0) {
        if (n_in != 36 || out_size != (int)O_END || ws_size < WS_END) { fprintf(stderr, "kernel_launch: unexpected shapes (n_in %d out %d ws %zu)\n", n_in, out_size, ws_size); grid = -1; return; }
        int dev = 0, cus = 0, per_cu = 0;
        if (hipGetDevice(&dev) != hipSuccess || hipDeviceGetAttribute(&cus, hipDeviceAttributeMultiprocessorCount, dev) != hipSuccess) { grid = -1; return; }
        if (hipFuncSetAttribute((const void*)fwd_kernel, hipFuncAttributeMaxDynamicSharedMemorySize, LDS_BYTES) != hipSuccess) { fprintf(stderr, "kernel_launch: hipFuncSetAttribute failed\n"); grid = -1; return; }
        if (hipOccupancyMaxActiveBlocksPerMultiprocessor(&per_cu, (const void*)fwd_kernel, NWAVES * 64, LDS_BYTES) != hipSuccess || per_cu < 1) { fprintf(stderr, "kernel_launch: occupancy query reports %d blocks per CU\n", per_cu); }
        (void)hipGetLastError();
        grid = cus;
        if (FUSE_NORM && cus != 256) { fprintf(stderr, "kernel_launch: the fused residual+norm epilogues need exactly 256 workgroups (one 256x256 tile each); build with -DFUSE_NORM=0 for %d CUs\n", cus); grid = -1; return; }
    }
    if (grid < 0) return;
    if (hipMemsetAsync((char*)d_ws + WS_CTL, 0, CTL_ZERO_BYTES, stream) != hipSuccess) return;
    Args a{};
    for (int i = 0; i < 36; ++i) a.in[i] = (const float*)d_in[i];
    a.out = (float*)d_out; a.ws = (unsigned char*)d_ws;
    if (MK_N_LAUNCHES == 1) { a.ph_lo = 0; a.ph_hi = N_PHASES; hipLaunchKernelGGL(fwd_kernel, dim3(grid), dim3(NWAVES * 64), LDS_BYTES, stream, a); }
    else for (int p = 0; p < N_PHASES; ++p) { a.ph_lo = p; a.ph_hi = p + 1; hipLaunchKernelGGL(fwd_kernel, dim3(grid), dim3(NWAVES * 64), LDS_BYTES, stream, a); }
}
```

```cpp
#include <hip/hip_runtime.h>
#include <hip/hip_bf16.h>
#include <cstdio>
#include <cstdint>

#ifndef MK_N_LAUNCHES
#define MK_N_LAUNCHES 1
#endif
#ifndef DBG_KEEP
#define DBG_KEEP 0
#endif
#ifndef DUP_SCAN
#define DUP_SCAN 1
#endif
#ifndef DUP_ATT
#define DUP_ATT 1
#endif
#ifndef DUP_CARRY
#define DUP_CARRY 1
#endif
#ifndef DUP_CONV
#define DUP_CONV 1
#endif
#ifndef DUP_RGG
#define DUP_RGG 1
#endif
#ifndef DUP_S5
#define DUP_S5 1
#endif
#ifndef TSEL
#define TSEL (-1)
#endif
#ifndef DUPG1
#define DUPG1 1
#endif
#ifndef DUPG6
#define DUPG6 1
#endif
#ifndef DUPG9
#define DUPG9 1
#endif
#ifndef DUPG10
#define DUPG10 1
#endif
#ifndef DUP_GEMM
#define DUP_GEMM 1
#endif
#ifndef DUP_MASK
#define DUP_MASK 0u
#endif
#ifndef DBG_LMASK
#define DBG_LMASK 15
#endif
#ifndef DBG_DUMP
#define DBG_DUMP 0
#endif
#ifndef DBG_NL
#define DBG_NL 4
#endif

constexpr int DM = 2048, ROWS = 8192, CTXR = 4096, INW = 12288, FFH = 5632, NL = 4, W1K = 1024;
constexpr int NCV = 5;
constexpr float RMS_EPS = 1e-6f;
constexpr size_t MiB = 1u << 20;

constexpr size_t O_X = 0, O_K = 16777216, O_V = 33554432, O_RG = 50331648, O_S5 = 50462720, O_END = 51511296;

constexpr size_t WS_CTL = 0, CTL_ZERO_BYTES = 1 * MiB;
constexpr size_t WS_MODP = 1 * MiB;
constexpr size_t WS_MOD  = 17 * MiB;
constexpr size_t WS_SP   = 18 * MiB;
constexpr size_t WS_LT   = 18 * MiB + 65536;
constexpr size_t WS_GWT  = 19 * MiB;
constexpr size_t WS_WINT = 24 * MiB;
constexpr size_t WS_GLUT = 216 * MiB;
constexpr size_t WS_OUTT = 224 * MiB;
constexpr size_t WS_WOT  = 272 * MiB;
constexpr size_t WS_FINT = 304 * MiB;
constexpr size_t WS_FOUTT = 480 * MiB;
constexpr size_t WS_MT   = 568 * MiB;
constexpr size_t WS_ET   = 600 * MiB;
constexpr size_t WS_FT   = 632 * MiB;
constexpr size_t WS_CK   = 664 * MiB;
constexpr size_t WS_CV   = 680 * MiB;
constexpr size_t WS_H    = 696 * MiB;
constexpr size_t WS_XR   = 728 * MiB;
constexpr size_t WS_XG   = 744 * MiB;
constexpr size_t WS_XC   = 760 * MiB;
constexpr size_t WS_Q    = 776 * MiB;
constexpr size_t WS_K    = 792 * MiB;
constexpr size_t WS_V    = 808 * MiB;
constexpr size_t WS_YRG  = 824 * MiB;
constexpr size_t WS_YS5  = 840 * MiB;
constexpr size_t WS_YNA  = 856 * MiB;
constexpr size_t WS_ZS   = 872 * MiB;
constexpr size_t WS_UG   = 888 * MiB;
constexpr size_t WS_HIN  = 904 * MiB;
constexpr size_t WS_G    = 920 * MiB;
constexpr size_t WS_AB   = 1016 * MiB;
constexpr size_t WS_FH   = 1016 * MiB;
constexpr size_t WS_HF   = 1144 * MiB;
constexpr size_t WS_HLOC = 1176 * MiB;
constexpr size_t WS_Z    = 1144 * MiB;
constexpr size_t WS_MM   = 1208 * MiB;
constexpr size_t WS_XS   = 1240 * MiB;
constexpr size_t WS_END  = 1244 * MiB;

constexpr int CW_TMO = 0, CW_BAR = 4096;
constexpr int CW_SEAM = 16384, SEAM_BANK = 32 * 64;
#ifndef FUSE_NORM
#define FUSE_NORM 0
#endif

constexpr int RING_BYTES = 131072;
constexpr int LDSCTL_OFF = RING_BYTES, MISC_OFF = LDSCTL_OFF + 320;
constexpr int LDS_BYTES = 147456;

#define GAS __attribute__((address_space(1)))
#define LAS __attribute__((address_space(3)))
typedef unsigned short bf16;
typedef unsigned v4u __attribute__((ext_vector_type(4)));
typedef unsigned v2u __attribute__((ext_vector_type(2)));
typedef float f32x4 __attribute__((ext_vector_type(4)));
typedef float f32x2 __attribute__((ext_vector_type(2)));
typedef short bf16x8 __attribute__((ext_vector_type(8)));
typedef GAS unsigned gu32;
#define RLX_AGENT __ATOMIC_RELAXED, __HIP_MEMORY_SCOPE_AGENT
#define LDS_WAIT() asm volatile("s_waitcnt lgkmcnt(0)" ::: "memory")
#define VM_WAIT() asm volatile("s_waitcnt vmcnt(0)" ::: "memory")

__device__ __forceinline__ unsigned f2bf(float f) { unsigned u = __builtin_bit_cast(unsigned, f); return (u + 0x7fffu + ((u >> 16) & 1u)) >> 16; }
typedef __bf16 bf16x2_t __attribute__((ext_vector_type(2)));
__device__ __forceinline__ unsigned pk2(float lo, float hi) { const f32x2 v = {lo, hi}; const bf16x2_t b = __builtin_convertvector(v, bf16x2_t); return __builtin_bit_cast(unsigned, b); }
__device__ __forceinline__ float bflo(unsigned w) { return __builtin_bit_cast(float, w << 16); }
__device__ __forceinline__ float bfhi(unsigned w) { return __builtin_bit_cast(float, w & 0xffff0000u); }
__device__ __forceinline__ float bf2f(bf16 h) { return __builtin_bit_cast(float, (unsigned)h << 16); }
__device__ __forceinline__ float fsigmoid(float x) { return __builtin_amdgcn_rcpf(1.0f + __expf(-x)); }
__device__ __forceinline__ float gelu_tanh(float x) { const float y = 0.7978845608028654f * (x + 0.044715f * x * x * x); return x * __builtin_amdgcn_rcpf(1.0f + __expf(-2.0f * y)); }
__device__ __forceinline__ float wave_sum(float v, int lane) {
#pragma unroll
    for (int o = 1; o < 64; o <<= 1) v += __builtin_bit_cast(float, __builtin_amdgcn_ds_bpermute((lane ^ o) << 2, __builtin_bit_cast(int, v)));
    return v;
}
__device__ __forceinline__ void unpack8(const v4u w, float (&f)[8]) { f[0] = bflo(w.x); f[1] = bfhi(w.x); f[2] = bflo(w.y); f[3] = bfhi(w.y); f[4] = bflo(w.z); f[5] = bfhi(w.z); f[6] = bflo(w.w); f[7] = bfhi(w.w); }
__device__ __forceinline__ v4u pack8(const float (&f)[8]) { v4u w; w.x = pk2(f[0], f[1]); w.y = pk2(f[2], f[3]); w.z = pk2(f[4], f[5]); w.w = pk2(f[6], f[7]); return w; }

#define XB_TMO      128
#define XB_XCNT(j)  (256  + 64 * (j))
#define XB_XSUB(j)  (1280 + 64 * (j))
#define XB_XGEN(j)  (2304 + 64 * (j))
#define XB_TOP      3328
#define XB_TOPGEN   3392
#define XCD_BAR_WORDS 3456
#define XB_SPIN_CAP (1u << 18)
__device__ __forceinline__ unsigned xb_ld(unsigned* p)              { return __hip_atomic_load(p, __ATOMIC_RELAXED, __HIP_MEMORY_SCOPE_AGENT); }
__device__ __forceinline__ unsigned xb_add(unsigned* p, unsigned v) { return __hip_atomic_fetch_add(p, v, __ATOMIC_RELAXED, __HIP_MEMORY_SCOPE_AGENT); }
__device__ __forceinline__ unsigned xb_xcc_id() { return (unsigned)__builtin_amdgcn_s_getreg((3 << 11) | 20) & 0xFu; }
#define XB_SPIN(cond, bar) do { unsigned _sp = 0; while (cond) { __builtin_amdgcn_s_sleep(1); \
    if ((++_sp & 255u) == 0u) { if (xb_ld(&(bar)[XB_TMO])) break; if (_sp > XB_SPIN_CAP) { atomicAdd(&(bar)[XB_TMO], 1u); break; } } } } while (0)
struct XcdBarrier { unsigned* bar; unsigned x; volatile LAS unsigned* st; };
__device__ __forceinline__ XcdBarrier xcd_barrier_post(unsigned* bar, volatile LAS unsigned* st) {
    XcdBarrier b; b.bar = bar; b.x = xb_xcc_id(); b.st = st;
    if (threadIdx.x == 0) (void)xb_add(&bar[XB_XCNT(b.x)], 1u);
    return b;
}
__device__ __forceinline__ void xcd_barrier_complete(unsigned* bar, unsigned x, unsigned& nloc, unsigned& nx) {
    const unsigned G = gridDim.x * gridDim.y * gridDim.z;
    unsigned sum, cnt, mine, sp = 0u;
    for (;;) {
        sum = 0u; cnt = 0u; mine = 0u;
#pragma unroll
        for (unsigned j = 0; j < 16; ++j) { const unsigned c = xb_ld(&bar[XB_XCNT(j)]); sum += c; cnt += (c > 0u) ? 1u : 0u; mine = (j == x) ? c : mine; }
        if (sum == G) break;
        __builtin_amdgcn_s_sleep(1);
        if ((++sp & 255u) == 0u) { if (xb_ld(&bar[XB_TMO])) break; if (sp > XB_SPIN_CAP) { atomicAdd(&bar[XB_TMO], 1u); break; } }
    }
    nloc = mine > 0u ? mine : 1u; nx = cnt > 0u ? cnt : 1u;
}
__device__ __forceinline__ void xcd_barrier(const XcdBarrier& b) {
    asm volatile("s_waitcnt vmcnt(0)" ::: "memory");
    __syncthreads();
    int tid_b = threadIdx.x; asm volatile("" : "+v"(tid_b));
    if (tid_b == 0) {
        unsigned* bar = b.bar;
        __builtin_amdgcn_s_waitcnt(0);
        unsigned nloc = b.st[0], nx = b.st[1];
        if (nloc == 0u) { xcd_barrier_complete(bar, b.x, nloc, nx); b.st[0] = nloc; b.st[1] = nx; }
        const unsigned old = xb_add(&bar[XB_XSUB(b.x)], 1u);
        const unsigned gen = old / nloc;
        if (old + 1u == (gen + 1u) * nloc) {
            __builtin_amdgcn_fence(__ATOMIC_RELEASE, "agent");
            asm volatile("s_waitcnt vmcnt(0)" ::: "memory");
            const unsigned og = xb_add(&bar[XB_TOP], 1u);
            const unsigned tg = og / nx;
            if (og + 1u == (tg + 1u) * nx) xb_add(&bar[XB_TOPGEN], 1u);
            else XB_SPIN(xb_ld(&bar[XB_TOPGEN]) == tg, bar);
            __builtin_amdgcn_fence(__ATOMIC_ACQUIRE, "agent");
            xb_add(&bar[XB_XGEN(b.x)], 1u);
            asm volatile("s_waitcnt vmcnt(0)" ::: "memory");
        } else {
            XB_SPIN(xb_ld(&bar[XB_XGEN(b.x)]) == gen, bar);
            __builtin_amdgcn_fence(__ATOMIC_ACQUIRE, "agent");
            asm volatile("s_waitcnt vmcnt(0)" ::: "memory");
        }
    }
    __syncthreads();
}

namespace pg8 {
#define PG8_LAS __attribute__((address_space(3)))
constexpr int BM = 256, BK = 64, HALF = 128, HTB = HALF * BK * 2, STAGE_BYTES = 8 * HTB;
__host__ __device__ __forceinline__ int lds_byte(int r, int c) { const int st = (r >> 4) * 2 + (c >> 5), rr = r & 15, cc = c & 31, ob = rr * 64 + cc * 2; return st * 1024 + (ob ^ (((ob >> 9) & 1) << 5)); }
__host__ __device__ __forceinline__ void stage_rc(int b, int& R, int& C) { const int st = b / 1024, sb = b % 1024, swz = sb ^ (((sb >> 9) & 1) << 5); R = (st >> 1) * 16 + swz / 64; C = (st & 1) * 32 + (swz % 64) / 2; }
__host__ __device__ __forceinline__ int perm32(int rho) { const int n = rho >> 4, i = rho & 15; return 8 * (i >> 2) + 4 * n + (i & 3); }

struct Unit { const char* A; const char* B; int pm, pn, aux, last; };

__device__ __forceinline__ bool tile_order(long L, int nM, int nN, int& pm, int& pn) {
    const int nwg = nM * nN; if (L >= nwg) return false;
    int wgid = (int)L; { const int q = nwg / 8, r = nwg % 8, xcd = wgid % 8, off = wgid / 8; wgid = (xcd < r ? xcd * (q + 1) : r * (q + 1) + (xcd - r) * q) + off; }
    const int nig = 8 * nN, gid = wgid / nig, fm = gid * 8, gsz = (nM - fm) < 8 ? (nM - fm) : 8;
    pm = fm + ((wgid % nig) % gsz); pn = (wgid % nig) / gsz; return true;
}

typedef float f32x4 __attribute__((ext_vector_type(4)));
typedef short bf16x8 __attribute__((ext_vector_type(8)));

template <class Epi, class Sched>
__device__ __forceinline__ void gemm_phase(PG8_LAS unsigned char* lds, const int K, const int lda, const int ldb, const Sched& S, const Epi& E) {
    int tid_ = threadIdx.x; asm volatile("" : "+v"(tid_));
    const int tid = tid_, wid = __builtin_amdgcn_readfirstlane(tid >> 6), lane = tid & 63, wr = wid >> 2, wc = wid & 3, fr = lane & 15, fq = lane >> 4;
    const int nt = K / BK;
    unsigned voffA[2], voffB[2];
#pragma unroll
    for (int i = 0; i < 2; ++i) { int R, C; stage_rc(tid * 16 + i * 8192, R, C); const int Rb = Epi::PERM ? ((R & ~31) + perm32(R & 31)) : R;
        voffA[i] = (unsigned)(R * lda + C) * 2u; voffB[i] = (unsigned)(Rb * ldb + C) * 2u; }
    const size_t kstep = (size_t)(BK * 2);
    const size_t hstepA = (size_t)HALF * lda * 2, hstepB = (size_t)HALF * ldb * 2;
    const unsigned ldsw = (unsigned)wid * 1024u;
    const int aoff = lds_byte(wr * 64 + fr, fq * 8), boff = lds_byte(wc * 32 + fr, fq * 8);
#define PG8_SA(b, h) (((b) * 2 + (h)) * HTB)
#define PG8_SB(b, h) ((4 + (b) * 2 + (h)) * HTB)
#define PG8_STAGE(bufoff, gbase, voff) do { _Pragma("unroll") for (int _i = 0; _i < 2; ++_i) \
        __builtin_amdgcn_global_load_lds((const unsigned*)((const char*)(gbase) + (voff)[_i]), (PG8_LAS unsigned*)(lds + (bufoff) + ldsw + _i * 8192), 16, 0, 0); } while (0)
#define PG8_LDA(dst, b, h) do { _Pragma("unroll") for (int m = 0; m < 4; ++m) _Pragma("unroll") for (int k = 0; k < 2; ++k) dst[m][k] = *(const PG8_LAS bf16x8*)(lds + PG8_SA(b, h) + aoff + m * 2048 + k * 1024); } while (0)
#define PG8_LDB(dst, b, h) do { _Pragma("unroll") for (int n = 0; n < 2; ++n) _Pragma("unroll") for (int k = 0; k < 2; ++k) dst[n][k] = *(const PG8_LAS bf16x8*)(lds + PG8_SB(b, h) + boff + n * 2048 + k * 1024); } while (0)
#define PG8_MMA(ai, bj, At, Bt) do { __builtin_amdgcn_s_setprio(1); _Pragma("unroll") for (int m = 0; m < 4; ++m) _Pragma("unroll") for (int n = 0; n < 2; ++n) _Pragma("unroll") for (int k = 0; k < 2; ++k) \
        acc[ai][bj][m][n] = __builtin_amdgcn_mfma_f32_16x16x32_bf16(Bt[n][k], At[m][k], acc[ai][bj][m][n], 0, 0, 0); __builtin_amdgcn_s_setprio(0); } while (0)
#define PG8_WAIT_V(n) asm volatile("s_waitcnt vmcnt(" #n ")" ::: "memory")
#define PG8_WAIT_L(n) asm volatile("s_waitcnt lgkmcnt(" #n ")" ::: "memory")
#define PG8_BAR __builtin_amdgcn_s_barrier()
#define PG8_SCHED __builtin_amdgcn_sched_barrier(0)
    Unit cur, nxt; int ui = 0;
    if (!S.next(0, cur)) return;
    f32x4 acc[2][2][4][2];
#pragma unroll
    for (int a = 0; a < 2; ++a)
#pragma unroll
        for (int b = 0; b < 2; ++b)
#pragma unroll
            for (int m = 0; m < 4; ++m)
#pragma unroll
                for (int n = 0; n < 2; ++n) acc[a][b][m][n] = (f32x4){0.f, 0.f, 0.f, 0.f};
    bf16x8 At[4][2], B0[2][2], B1[2][2];
    const char* cA = cur.A; const char* cB = cur.B;
    PG8_STAGE(PG8_SB(0, 0), cB, voffB); PG8_STAGE(PG8_SB(0, 1), cB + hstepB, voffB); PG8_STAGE(PG8_SA(0, 0), cA, voffA); PG8_STAGE(PG8_SA(0, 1), cA + hstepA, voffA);
    if (wr == 1) PG8_BAR;
    PG8_WAIT_V(2); PG8_BAR;
    PG8_STAGE(PG8_SB(1, 0), cB + kstep, voffB); PG8_STAGE(PG8_SA(1, 0), cA + kstep, voffA); PG8_STAGE(PG8_SB(1, 1), cB + hstepB + kstep, voffB);
    PG8_WAIT_V(6); PG8_BAR;
    for (;;) {
        const bool has_next = S.next(ui + 1, nxt);
        const char* nA = has_next ? nxt.A : cA; const char* nB = has_next ? nxt.B : cB;
#pragma unroll 1
        for (int t = 0; t < nt; t += 2) {
            const bool last = (t == nt - 2);
            const char* a1 = cA + (size_t)(t + 1) * kstep;
            const char* a2 = last ? nA : cA + (size_t)(t + 2) * kstep; const char* b2 = last ? nB : cB + (size_t)(t + 2) * kstep;
            const char* a3 = a2 + kstep; const char* b3 = b2 + kstep;
            PG8_LDB(B0, 0, 0); PG8_LDB(B1, 0, 1); PG8_SCHED; PG8_LDA(At, 0, 0); PG8_STAGE(PG8_SA(1, 1), a1 + hstepA, voffA);
            PG8_WAIT_V(8); PG8_WAIT_L(0); PG8_BAR; PG8_MMA(0, 0, At, B0); PG8_MMA(0, 1, At, B1); PG8_BAR; PG8_SCHED;
            PG8_LDA(At, 0, 1); PG8_STAGE(PG8_SB(0, 0), b2, voffB); PG8_STAGE(PG8_SB(0, 1), b2 + hstepB, voffB); PG8_STAGE(PG8_SA(0, 0), a2, voffA);
            PG8_WAIT_V(8); PG8_WAIT_L(0); PG8_BAR; PG8_MMA(1, 0, At, B0); PG8_MMA(1, 1, At, B1); PG8_BAR; PG8_SCHED;
            PG8_LDB(B0, 1, 0); PG8_LDB(B1, 1, 1); PG8_SCHED; PG8_LDA(At, 1, 0); PG8_STAGE(PG8_SA(0, 1), a2 + hstepA, voffA);
            PG8_WAIT_V(8); PG8_WAIT_L(0); PG8_BAR; PG8_MMA(0, 0, At, B0); PG8_MMA(0, 1, At, B1); PG8_BAR; PG8_SCHED;
            PG8_LDA(At, 1, 1); PG8_STAGE(PG8_SB(1, 0), b3, voffB); PG8_STAGE(PG8_SB(1, 1), b3 + hstepB, voffB); PG8_STAGE(PG8_SA(1, 0), a3, voffA);
            PG8_WAIT_V(8); PG8_WAIT_L(0); PG8_BAR; PG8_MMA(1, 0, At, B0); PG8_MMA(1, 1, At, B1); PG8_BAR; PG8_SCHED;
        }
        if (wr == 0) PG8_BAR;
        if (cur.last) { if constexpr (!Epi::AFTER_DRAIN) E(acc, cur, wr, wc, fr, fq); } else E.mid(acc, cur, wr, wc, fr, fq);
        if (!has_next) break;
        if (cur.last) {
#pragma unroll
            for (int a = 0; a < 2; ++a)
#pragma unroll
                for (int b = 0; b < 2; ++b)
#pragma unroll
                    for (int m = 0; m < 4; ++m)
#pragma unroll
                        for (int n = 0; n < 2; ++n) acc[a][b][m][n] = (f32x4){0.f, 0.f, 0.f, 0.f};
        }
        cur = nxt; cA = nA; cB = nB; ++ui;
        if (wr == 1) PG8_BAR;
    }
    PG8_WAIT_V(0);
    PG8_BAR;
    if constexpr (Epi::AFTER_DRAIN) E.fused(acc, cur, wr, wc, fr, fq, lds, wid, lane);
#undef PG8_SA
#undef PG8_SB
#undef PG8_STAGE
#undef PG8_LDA
#undef PG8_LDB
#undef PG8_MMA
#undef PG8_WAIT_V
#undef PG8_WAIT_L
#undef PG8_BAR
#undef PG8_SCHED
}

typedef const f32x4 (&AccC)[2][2][4][2];
typedef f32x4 (&AccM)[2][2][4][2];
#define EPI_ROWS_BEGIN _Pragma("unroll") for (int ai = 0; ai < 2; ++ai) _Pragma("unroll") for (int m = 0; m < 4; ++m) { const int row = u.pm * 256 + ai * 128 + wr * 64 + m * 16 + fr;
#define EPI_ROWS_END }

#define EPI_NO_MID static constexpr bool AFTER_DRAIN = false; __device__ __forceinline__ void mid(AccM, const Unit&, int, int, int, int) const {} __device__ __forceinline__ void fused(AccM, const Unit&, int, int, int, int, PG8_LAS unsigned char*, int, int) const {}

struct EpiB16 {
    EPI_NO_MID
    static constexpr bool PERM = true;
    bf16* O; int ldc;
    __device__ __forceinline__ void operator()(AccC acc, const Unit& u, int wr, int wc, int fr, int fq) const {
        const int col0 = u.pn * 256 + wc * 32 + 8 * fq;
        EPI_ROWS_BEGIN
#pragma unroll
            for (int bj = 0; bj < 2; ++bj) { const f32x4 v0 = acc[ai][bj][m][0], v1 = acc[ai][bj][m][1]; const float f[8] = {v0[0], v0[1], v0[2], v0[3], v1[0], v1[1], v1[2], v1[3]};
                *(GAS v4u*)(O + (size_t)row * ldc + col0 + bj * 128) = pack8(f); }
        EPI_ROWS_END
    }
};
struct EpiHloc {
    EPI_NO_MID
    static constexpr bool PERM = false;
    float* O;
    __device__ __forceinline__ void operator()(AccC acc, const Unit& u, int wr, int wc, int fr, int fq) const {
        const int col0 = wc * 32 + 4 * fq; float* base = O + (size_t)u.aux * 512 * 256;
        EPI_ROWS_BEGIN
            float* rowp = base + (size_t)row * 256 + col0;
#pragma unroll
            for (int bj = 0; bj < 2; ++bj)
#pragma unroll
                for (int n = 0; n < 2; ++n) *(GAS f32x4*)(rowp + bj * 128 + n * 16) = acc[ai][bj][m][n];
        EPI_ROWS_END
    }
};
struct EpiWin {
    EPI_NO_MID
    static constexpr bool PERM = true;
    bf16 *XR, *XG, *UG, *Q, *Kb, *Vb, *G; float *outK, *outV;
    __device__ __forceinline__ void operator()(AccC acc, const Unit& u, int wr, int wc, int fr, int fq) const {
        const int pn = u.pn, seg = pn >> 2;
        const int cseg = (pn & 3) * 256 + wc * 32 + 8 * fq;
        EPI_ROWS_BEGIN
#pragma unroll
            for (int bj = 0; bj < 2; ++bj) {
                const f32x4 v0 = acc[ai][bj][m][0], v1 = acc[ai][bj][m][1];
                float f[8] = {v0[0], v0[1], v0[2], v0[3], v1[0], v1[1], v1[2], v1[3]};
                const int c = cseg + bj * 128;
                if (seg >= 6) {
#pragma unroll
                    for (int e = 0; e < 8; ++e) f[e] = fsigmoid(f[e]);
                    *(GAS v4u*)(G + (size_t)row * 6144 + (pn - 24) * 256 + wc * 32 + 8 * fq + bj * 128) = pack8(f);
                } else if (seg == 1) {
#pragma unroll
                    for (int e = 0; e < 8; ++e) f[e] = gelu_tanh(f[e]);
                    *(GAS v4u*)(XG + (size_t)row * 1024 + c) = pack8(f);
                } else if (seg == 2) {
                    const int g = c >> 4, m0 = c & 15;
                    *(GAS v4u*)(UG + ((size_t)g * 512 + (row >> 4)) * 256 + (row & 15) * 16 + m0) = pack8(f);
                } else {
                    bf16* dst = seg == 0 ? XR : (seg == 3 ? Q : (seg == 4 ? Kb : Vb));
                    *(GAS v4u*)(dst + (size_t)row * 1024 + c) = pack8(f);
                    if (seg >= 4 && row < CTXR) {
                        float* o = (seg == 4 ? outK : outV) + ((size_t)(row >> 8) * 4 * 256 + (row & 255)) * 1024 + c;
                        *(f32x4*)o = v0; *(GAS f32x4*)(o + 4) = v1;
                    }
                }
            }
        EPI_ROWS_END
    }
};
struct EpiRg {
    EPI_NO_MID
    static constexpr bool PERM = true;
    const bf16* XC; const float* gb; const float* sp; f32x2* AB;
    __device__ __forceinline__ void operator()(AccC acc, const Unit& u, int wr, int wc, int fr, int fq) const {
        const int h = u.aux >> 1, d = u.aux & 1, c0 = h * 128 + wc * 32 + 8 * fq;
        const GAS float* gbr = (const GAS float*)(gb + (d * 2 + 0) * 1024 + c0); const GAS float* gbi = (const GAS float*)(gb + (d * 2 + 1) * 1024 + c0); const GAS float* spp = (const GAS float*)(sp + d * 1024 + c0);
        EPI_ROWS_BEGIN
            float xc[8]; unpack8(*(const GAS v4u*)(XC + (size_t)row * 1024 + c0), xc);
            const f32x4 r0 = acc[ai][0][m][0], r1 = acc[ai][0][m][1], i0 = acc[ai][1][m][0], i1 = acc[ai][1][m][1];
            const float rr[8] = {r0[0], r0[1], r0[2], r0[3], r1[0], r1[1], r1[2], r1[3]}, ii[8] = {i0[0], i0[1], i0[2], i0[3], i1[0], i1[1], i1[2], i1[3]};
            unsigned* dst = (unsigned*)AB + ((size_t)d * ROWS + row) * 1024 + c0;
            v4u o0, o1; unsigned w[8];
#pragma unroll
            for (int e = 0; e < 8; ++e) {
                const float r = fsigmoid(rr[e] + gbr[e]), ig = fsigmoid(ii[e] + gbi[e]);
                const float la = -8.0f * r * spp[e]; const float a = __expf(la); const float om = 1.0f - a; const float mult = __builtin_amdgcn_sqrtf(om * (1.0f + a));
                w[e] = pk2(om, mult * ig * xc[e]);
            }
            o0.x = w[0]; o0.y = w[1]; o0.z = w[2]; o0.w = w[3]; o1.x = w[4]; o1.y = w[5]; o1.z = w[6]; o1.w = w[7];
            *(GAS v4u*)dst = o0; *(GAS v4u*)(dst + 4) = o1;
            asm volatile("" ::: "memory");
        EPI_ROWS_END
    }
};
struct EpiS5Y {
    EPI_NO_MID
    static constexpr bool PERM = true;
    const bf16* UG; const float* dvec; bf16* ZS;
    __device__ __forceinline__ void operator()(AccC acc, const Unit& u, int wr, int wc, int fr, int fq) const {
        const int g = u.aux;
        EPI_ROWS_BEGIN
#pragma unroll
            for (int bj = 0; bj < 2; ++bj) {
                const int col = bj * 128 + wc * 32 + 8 * fq, t = col >> 4, n0 = col & 15;
                float uu[8]; unpack8(*(const GAS v4u*)(UG + ((size_t)g * 512 + row) * 256 + col), uu);
                const f32x4 v0 = acc[ai][bj][m][0], v1 = acc[ai][bj][m][1];
                float f[8] = {v0[0], v0[1], v0[2], v0[3], v1[0], v1[1], v1[2], v1[3]};
#pragma unroll
                for (int e = 0; e < 8; ++e) f[e] = gelu_tanh(f[e] + ((const GAS float*)dvec)[g * 16 + n0 + e] * uu[e]);
                *(GAS v4u*)(ZS + ((size_t)row * 16 + t) * 1024 + g * 16 + n0) = pack8(f);
            }
        EPI_ROWS_END
    }
};
struct EpiGlu {
    EPI_NO_MID
    static constexpr bool PERM = true;
    const bf16* ZS; bf16* Y;
    __device__ __forceinline__ void operator()(AccC acc, const Unit& u, int wr, int wc, int fr, int fq) const {
        const int col0 = u.pn * 256 + wc * 32 + 8 * fq;
        EPI_ROWS_BEGIN
#pragma unroll
            for (int bj = 0; bj < 2; ++bj) {
                float z[8]; unpack8(*(const GAS v4u*)(ZS + (size_t)row * 1024 + col0 + bj * 128), z);
                const f32x4 v0 = acc[ai][bj][m][0], v1 = acc[ai][bj][m][1];
                float f[8] = {v0[0], v0[1], v0[2], v0[3], v1[0], v1[1], v1[2], v1[3]};
#pragma unroll
                for (int e = 0; e < 8; ++e) f[e] = z[e] * fsigmoid(f[e]);
                *(GAS v4u*)(Y + (size_t)row * 1024 + col0 + bj * 128) = pack8(f);
            }
        EPI_ROWS_END
    }
};
struct EpiMerge {
    static constexpr bool PERM = true, AFTER_DRAIN = false;
    __device__ __forceinline__ void fused(AccM, const Unit&, int, int, int, int, PG8_LAS unsigned char*, int, int) const {}
    const bf16* G; bf16* MM;
    __device__ __forceinline__ void mid(AccM acc, const Unit& u, int wr, int wc, int fr, int fq) const {
        const int col0 = u.pn * 256 + wc * 32 + 8 * fq, b = u.aux;
        EPI_ROWS_BEGIN
#pragma unroll
            for (int bj = 0; bj < 2; ++bj) {
                float ga[8], gn[8]; unpack8(*(const GAS v4u*)(G + (size_t)row * 6144 + b * 2048 + col0 + bj * 128), ga); unpack8(*(const GAS v4u*)(G + (size_t)row * 6144 + (b + 1) * 2048 + col0 + bj * 128), gn);
#pragma unroll
                for (int e = 0; e < 8; ++e) { const float rt = ga[e] * __builtin_amdgcn_rcpf(fmaxf(gn[e], 1e-30f)); acc[ai][bj][m][e >> 2][e & 3] *= rt; }
            }
        EPI_ROWS_END
    }
    __device__ __forceinline__ void operator()(AccC acc, const Unit& u, int wr, int wc, int fr, int fq) const {
        const int col0 = u.pn * 256 + wc * 32 + 8 * fq;
        EPI_ROWS_BEGIN
#pragma unroll
            for (int bj = 0; bj < 2; ++bj) {
                float g2[8]; unpack8(*(const GAS v4u*)(G + (size_t)row * 6144 + 2 * 2048 + col0 + bj * 128), g2);
                const f32x4 v0 = acc[ai][bj][m][0], v1 = acc[ai][bj][m][1];
                float f[8] = {v0[0], v0[1], v0[2], v0[3], v1[0], v1[1], v1[2], v1[3]};
#pragma unroll
                for (int e = 0; e < 8; ++e) f[e] *= g2[e];
                *(GAS v4u*)(MM + (size_t)row * 2048 + col0 + bj * 128) = pack8(f);
            }
        EPI_ROWS_END
    }
};
struct EpiSwiglu {
    EPI_NO_MID
    static constexpr bool PERM = true;
    bf16* FH;
    __device__ __forceinline__ void operator()(AccC acc, const Unit& u, int wr, int wc, int fr, int fq) const {
        const int col0 = u.pn * 128 + wc * 32 + 8 * fq;
        EPI_ROWS_BEGIN
            const f32x4 a0 = acc[ai][0][m][0], a1 = acc[ai][0][m][1], b0 = acc[ai][1][m][0], b1 = acc[ai][1][m][1];
            const float av[8] = {a0[0], a0[1], a0[2], a0[3], a1[0], a1[1], a1[2], a1[3]}, bv[8] = {b0[0], b0[1], b0[2], b0[3], b1[0], b1[1], b1[2], b1[3]};
            float f[8];
#pragma unroll
            for (int e = 0; e < 8; ++e) f[e] = av[e] * fsigmoid(av[e]) * bv[e];
            *(GAS v4u*)(FH + (size_t)row * FFH + col0) = pack8(f);
        EPI_ROWS_END
    }
};

struct PanelSS {
    float* slots; unsigned* cnt; unsigned* tmo;
    __device__ __forceinline__ void run(const f32x4 (&v)[2][2][4][2], const Unit& u, int wr, int wc, int fr, int fq, PG8_LAS unsigned char* lds, int wid, int lane) const {
        PG8_LAS float* P = (PG8_LAS float*)lds;
        PG8_LAS float* S = (PG8_LAS float*)(lds + 8192);
#pragma unroll
        for (int ai = 0; ai < 2; ++ai)
#pragma unroll
            for (int m = 0; m < 4; ++m) { float q = 0.f;
#pragma unroll
                for (int bj = 0; bj < 2; ++bj)
#pragma unroll
                    for (int n = 0; n < 2; ++n) { const f32x4 x = v[ai][bj][m][n]; q += (x[0] * x[0] + x[1] * x[1]) + (x[2] * x[2] + x[3] * x[3]); }
                q += __builtin_bit_cast(float, __builtin_amdgcn_ds_bpermute((lane ^ 16) << 2, __builtin_bit_cast(int, q)));
                q += __builtin_bit_cast(float, __builtin_amdgcn_ds_bpermute((lane ^ 32) << 2, __builtin_bit_cast(int, q)));
                if (fq == 0) P[(ai * 128 + wr * 64 + m * 16 + fr) * 4 + wc] = q; }
        asm volatile("s_waitcnt lgkmcnt(0)" ::: "memory"); __builtin_amdgcn_s_barrier(); asm volatile("" ::: "memory");
        const int row = wid * 32 + (lane & 31);
        if (lane < 32) { const float tot = (P[row * 4 + 0] + P[row * 4 + 1]) + (P[row * 4 + 2] + P[row * 4 + 3]);
            __hip_atomic_store(slots + ((size_t)(u.pm * 256 + row) * 8 + u.pn), tot, __ATOMIC_RELAXED, __HIP_MEMORY_SCOPE_AGENT); }
        asm volatile("s_waitcnt vmcnt(0)" ::: "memory");
        if (lane == 0) __hip_atomic_fetch_add(cnt + 64 * u.pm, 1u, __ATOMIC_RELAXED, __HIP_MEMORY_SCOPE_AGENT);
        if (wid == 0) {
            const unsigned long long t0 = __builtin_amdgcn_s_memrealtime();
            for (;;) {
                if ((unsigned)__builtin_amdgcn_readfirstlane(__hip_atomic_load(cnt + 64 * u.pm, __ATOMIC_RELAXED, __HIP_MEMORY_SCOPE_AGENT)) >= 64u) break;
                if (__builtin_amdgcn_s_memrealtime() - t0 > 2000000ull) { if (lane == 0) __hip_atomic_store(tmo, 1u, __ATOMIC_RELAXED, __HIP_MEMORY_SCOPE_AGENT); break; }
                __builtin_amdgcn_s_sleep(2);
            }
            __builtin_amdgcn_fence(__ATOMIC_ACQUIRE, "agent");
        }
        asm volatile("s_waitcnt vmcnt(0) lgkmcnt(0)" ::: "memory"); __builtin_amdgcn_s_barrier(); asm volatile("" ::: "memory");
        if (lane < 32) { const float* sl = slots + (size_t)(u.pm * 256 + row) * 8; float t = 0.f;
#pragma unroll
            for (int k = 0; k < 8; ++k) t += __hip_atomic_load(sl + k, __ATOMIC_RELAXED, __HIP_MEMORY_SCOPE_AGENT);
            S[row] = rsqrtf(t * (1.0f / 2048.0f) + 1e-6f); }
        asm volatile("s_waitcnt lgkmcnt(0)" ::: "memory"); __builtin_amdgcn_s_barrier(); asm volatile("" ::: "memory");
    }
};
struct EpiResNorm {
    static constexpr bool PERM = false, AFTER_DRAIN = true;
    float* X; bf16* H; const float* gpost; const float* modGate; const float* gpre; const float* modShift; const float* modScale; PanelSS st1, st2; int hasnext;
    __device__ __forceinline__ void mid(AccM, const Unit&, int, int, int, int) const {}
    __device__ __forceinline__ void operator()(AccC, const Unit&, int, int, int, int) const {}
    __device__ __forceinline__ void fused(AccM acc, const Unit& u, int wr, int wc, int fr, int fq, PG8_LAS unsigned char* lds, int wid, int lane) const {
        const PG8_LAS float* S = (const PG8_LAS float*)(lds + 8192);
        const int col0 = u.pn * 256 + wc * 32 + 4 * fq, cv = u.pm < 16 ? 0 : 1 + ((u.pm - 16) >> 2);
        st1.run(acc, u, wr, wc, fr, fq, lds, wid, lane);
#pragma unroll
        for (int ai = 0; ai < 2; ++ai)
#pragma unroll
            for (int m = 0; m < 4; ++m) { const int r = ai * 128 + wr * 64 + m * 16 + fr; const float r1 = S[r]; const size_t off = (size_t)(u.pm * 256 + r) * 2048 + col0;
#pragma unroll
                for (int bj = 0; bj < 2; ++bj)
#pragma unroll
                    for (int n = 0; n < 2; ++n) { const int c = bj * 128 + n * 16; const f32x4 xr = *(const GAS f32x4*)(X + off + c), gp = *(const GAS f32x4*)(gpost + col0 + c), gt = *(const GAS f32x4*)(modGate + (size_t)cv * 12288 + col0 + c);
                        acc[ai][bj][m][n] = xr + gt * (acc[ai][bj][m][n] * r1 * gp); }
                asm volatile("" : "+v"(acc[ai][0][m][0]), "+v"(acc[ai][0][m][1]), "+v"(acc[ai][1][m][0]), "+v"(acc[ai][1][m][1]));
                if (m & 1) asm volatile("" ::: "memory"); }
        if (hasnext) st2.run(acc, u, wr, wc, fr, fq, lds, wid, lane);
#pragma unroll
        for (int ai = 0; ai < 2; ++ai)
#pragma unroll
            for (int m = 0; m < 4; ++m) { const int r = ai * 128 + wr * 64 + m * 16 + fr; const float r2 = hasnext ? S[r] : 0.f; const size_t off = (size_t)(u.pm * 256 + r) * 2048 + col0;
#pragma unroll
                for (int bj = 0; bj < 2; ++bj)
#pragma unroll
                    for (int n = 0; n < 2; ++n) { const int c = bj * 128 + n * 16; const f32x4 x1 = acc[ai][bj][m][n]; *(GAS f32x4*)(X + off + c) = x1;
                        if (hasnext) { const f32x4 g = *(const GAS f32x4*)(gpre + col0 + c), sh = *(const GAS f32x4*)(modShift + (size_t)cv * 12288 + col0 + c), sc = *(const GAS f32x4*)(modScale + (size_t)cv * 12288 + col0 + c);
                            const f32x4 hv = x1 * r2 * g * (sc + 1.0f) + sh; v2u w; w.x = pk2(hv[0], hv[1]); w.y = pk2(hv[2], hv[3]); *(GAS v2u*)(H + off + c) = w; } }
                asm volatile("" ::: "memory"); }
    }
};

struct SchedPlain {
    const char* A; const char* B; int nM, nN, G, c; size_t tA, tB; int dup;
    __device__ __forceinline__ bool next(int i, Unit& u) const { int pm, pn; const int q = i / (dup * DUP_GEMM), r = i - q * (dup * DUP_GEMM); long L = (long)q * G + c; const int nwg = nM * nN; if (L >= nwg) return false;
        if (r) L = (L + nwg / 2 + 8) % nwg;
        if (!tile_order(L, nM, nN, pm, pn)) return false; u.A = A + (size_t)pm * tA; u.B = B + (size_t)pn * tB; u.pm = pm; u.pn = pn; u.aux = 0; u.last = 1; return true; }
};
struct SchedMerge {
    const char* A0; const char* A1; const char* A2; const char* B; int G, c;
    __device__ __forceinline__ bool next(int i, Unit& u) const { const int ti = i / 3, b = i - ti * 3; int pm, pn; const int q = ti / (DUPG6 * DUP_GEMM), r = ti - q * (DUPG6 * DUP_GEMM); long L = (long)q * G + c; if (L >= 256) return false; if (r) L = (L + 136) % 256;
        if (!tile_order(L, 32, 8, pm, pn)) return false;
        const char* Ab = b == 0 ? A0 : (b == 1 ? A1 : A2); u.A = Ab + (size_t)pm * 256 * 1024 * 2; u.B = B + ((size_t)b * 2048 + pn * 256) * 1024 * 2; u.pm = pm; u.pn = pn; u.aux = b; u.last = (b == 2); return true; }
};
struct SchedS5E {
    const char* UG; const char* ET; int G, c;
    __device__ __forceinline__ bool next(int i, Unit& u) const { const int L = (i / DUP_S5) * G + c; if (L >= 128) return false; const int g = L >> 1, pm = L & 1;
        u.A = UG + ((size_t)g * 512 + pm * 256) * 256 * 2; u.B = ET + (size_t)g * 256 * 256 * 2; u.pm = pm; u.pn = 0; u.aux = g; u.last = 1; return true; }
};
struct SchedS5Y {
    const char* UG; const char* HIN; const char* MT; const char* FT; int G, c;
    __device__ __forceinline__ bool next(int i, Unit& u) const { const int ti = (i >> 1) / DUP_S5, part = i & 1, L = ti * G + c; if (L >= 128) return false; const int g = L >> 1, pm = L & 1;
        u.A = (part ? HIN : UG) + ((size_t)g * 512 + pm * 256) * 256 * 2; u.B = (part ? FT : MT) + (size_t)g * 256 * 256 * 2; u.pm = pm; u.pn = 0; u.aux = g; u.last = part; return true; }
};
struct SchedOne {
    const char* A0; const char* B0; const char* A1; const char* B1; int pm, aux, nparts;
    __device__ __forceinline__ bool next(int i, Unit& u) const { if (i >= nparts) return false; u.A = i ? A1 : A0; u.B = i ? B1 : B0; u.pm = pm; u.pn = 0; u.aux = aux; u.last = (i == nparts - 1); return true; }
};
struct SchedRg {
    const char* XC; const char* GWT; int G, c;
    __device__ __forceinline__ bool next(int i, Unit& u) const { const int L = (i / DUP_RGG) * G + c; if (L >= 512) return false; const int pm = L & 31, hd = L >> 5;
        u.A = XC + ((size_t)pm * 256 * 1024 + (hd >> 1) * 128) * 2; u.B = GWT + (size_t)hd * 256 * 128 * 2; u.pm = pm; u.pn = 0; u.aux = hd; u.last = 1; return true; }
};
}

namespace att {
using bf16x8 = __attribute__((ext_vector_type(8))) short;
using s16x4  = __attribute__((ext_vector_type(4))) short;
using f32x16 = __attribute__((ext_vector_type(16))) float;
using u32x4  = __attribute__((ext_vector_type(4))) unsigned;
constexpr int D = 128, NW = 8, QBLK = 32, KVBLK = 64, LD = 1024;
constexpr float SCALE = 0.088388347648318440f, THR = 8.f;
constexpr size_t SHM_V = KVBLK * D * 2, SHM_K = KVBLK * D * 2, SHM_ATTN = 2 * SHM_V + 2 * SHM_K + NW * 64 * 4;
constexpr int RPB_OFF = (int)SHM_ATTN + 256;
#define KSWZ(row, colB) ((row) * 256 + ((colB) ^ (((row) & 7) << 4)))
#define SBAR() __builtin_amdgcn_sched_barrier(0)
__device__ __forceinline__ int crow(int r, int hi) { return (r & 3) + 8 * (r >> 2) + 4 * hi; }
__device__ __forceinline__ unsigned cvtpk(float lo, float hi) { return pk2(lo, hi); }
__device__ __forceinline__ void partialSM(f32x16& p0, f32x16& p1, float& m_reg, float& mn, float& alpha) {
  constexpr float C = SCALE * 1.4426950408889634f;
  float pmax = p0[0]; for (int r = 1; r < 16; ++r) pmax = fmaxf(pmax, p0[r]); for (int r = 0; r < 16; ++r) pmax = fmaxf(pmax, p1[r]);
  { auto rr = __builtin_amdgcn_permlane32_swap(__float_as_uint(pmax), __float_as_uint(pmax), false, false);
    pmax = fmaxf(__uint_as_float(rr[0]), __uint_as_float(rr[1])); }
  if (__builtin_expect(__all(pmax - m_reg <= THR / SCALE), 1)) { mn = m_reg; alpha = 1.f; }
  else { mn = fmaxf(m_reg, pmax); alpha = __builtin_amdgcn_exp2f((m_reg - mn) * C); m_reg = mn; }
  float mnC = -mn * C;
  for (int r = 0; r < 16; ++r) p0[r] = fmaf(p0[r], C, mnC); for (int r = 0; r < 16; ++r) p1[r] = fmaf(p1[r], C, mnC);
  for (int r = 0; r < 16; ++r) p0[r] = __builtin_amdgcn_exp2f(p0[r]);
}
__device__ __forceinline__ void finishSM(f32x16& p0, f32x16& p1, float alpha, float& l_reg, bf16x8& pa0, bf16x8& pa1, bf16x8& pa2, bf16x8& pa3) {
  for (int r = 0; r < 16; ++r) p1[r] = __builtin_amdgcn_exp2f(p1[r]);
  float ps = 0; for (int r = 0; r < 16; ++r) ps += p0[r]; for (int r = 0; r < 16; ++r) ps += p1[r];
  { auto rr = __builtin_amdgcn_permlane32_swap(__float_as_uint(ps), __float_as_uint(ps), false, false);
    ps = __uint_as_float(rr[0]) + __uint_as_float(rr[1]); }
  l_reg = l_reg * alpha + ps;
#define PK4(P, BASE, OUT) do { unsigned a0 = cvtpk(P[BASE + 0], P[BASE + 1]), a1 = cvtpk(P[BASE + 2], P[BASE + 3]);   \
    unsigned b0 = cvtpk(P[BASE + 4], P[BASE + 5]), b1 = cvtpk(P[BASE + 6], P[BASE + 7]);                              \
    auto r0 = __builtin_amdgcn_permlane32_swap(a0, b0, false, false); auto r1 = __builtin_amdgcn_permlane32_swap(a1, b1, false, false); \
    u32x4 w = {r0[0], r1[0], r0[1], r1[1]}; OUT = *reinterpret_cast<bf16x8*>(&w); } while (0)
  PK4(p0, 0, pa0); PK4(p0, 8, pa1); PK4(p1, 0, pa2); PK4(p1, 8, pa3);
#undef PK4
}
__device__ __forceinline__ void qkt(f32x16& p0, f32x16& p1, const bf16* Ks, const bf16x8* qr, int r32, int hi) {
  p0 = f32x16{}; p1 = f32x16{};
  for (int d0 = 0; d0 < 8; ++d0) { int cb = (d0 * 16 + hi * 8) * 2;
    bf16x8 b0 = *reinterpret_cast<const bf16x8*>((const char*)Ks + KSWZ(r32, cb));
    bf16x8 b1 = *reinterpret_cast<const bf16x8*>((const char*)Ks + KSWZ(32 + r32, cb));
    p0 = __builtin_amdgcn_mfma_f32_32x32x16_bf16(b0, qr[d0], p0, 0, 0, 0);
    p1 = __builtin_amdgcn_mfma_f32_32x32x16_bf16(b1, qr[d0], p1, 0, 0, 0); }
}
__device__ __forceinline__ int v_st(int k, int c) { const int kk = (k & ~0xC) | ((k & 4) << 1) | ((k & 8) >> 1); return ((kk >> 3) * 4 + (c >> 5)) * 512 + ((kk & 7) * 32 + (c & 31)) * 2; }
__device__ __forceinline__ int v_rd_base(int lane) { return ((lane & 3) << 3) | (((lane >> 2) & 3) << 6) | (((lane >> 4) & 1) << 5) | (((lane >> 5) & 1) << 8); }
constexpr int v_rd_off(int d0, int ks, int half) { return d0 * 512 + ks * 4096 + half * 2048; }
template <int OFF> __device__ __forceinline__ s16x4 tr_read(int vb) {
  s16x4 r; asm volatile("ds_read_b64_tr_b16 %0, %1 offset:%2" : "=&v"(r) : "v"(vb), "i"(OFF) : "memory"); return r;
}
template <int D0> __device__ __forceinline__ void pv_one(f32x16& od, int vb, bf16x8 pa0, bf16x8 pa1, bf16x8 pa2, bf16x8 pa3) {
  const s16x4 l0 = tr_read<v_rd_off(D0, 0, 0)>(vb), h0 = tr_read<v_rd_off(D0, 0, 1)>(vb), l1 = tr_read<v_rd_off(D0, 1, 0)>(vb), h1 = tr_read<v_rd_off(D0, 1, 1)>(vb);
  const s16x4 l2 = tr_read<v_rd_off(D0, 2, 0)>(vb), h2 = tr_read<v_rd_off(D0, 2, 1)>(vb), l3 = tr_read<v_rd_off(D0, 3, 0)>(vb), h3 = tr_read<v_rd_off(D0, 3, 1)>(vb);
  asm volatile("s_waitcnt lgkmcnt(0)" ::: "memory"); SBAR();
#define PK(L, H) (bf16x8){L[0], L[1], L[2], L[3], H[0], H[1], H[2], H[3]}
  od = __builtin_amdgcn_mfma_f32_32x32x16_bf16(pa0, PK(l0, h0), od, 0, 0, 0);
  od = __builtin_amdgcn_mfma_f32_32x32x16_bf16(pa1, PK(l1, h1), od, 0, 0, 0);
  od = __builtin_amdgcn_mfma_f32_32x32x16_bf16(pa2, PK(l2, h2), od, 0, 0, 0);
  od = __builtin_amdgcn_mfma_f32_32x32x16_bf16(pa3, PK(l3, h3), od, 0, 0, 0);
#undef PK
}
__device__ __forceinline__ void pv_d0(f32x16* o, int vb, bf16x8 pa0, bf16x8 pa1, bf16x8 pa2, bf16x8 pa3) {
  pv_one<0>(o[0], vb, pa0, pa1, pa2, pa3); pv_one<1>(o[1], vb, pa0, pa1, pa2, pa3); pv_one<2>(o[2], vb, pa0, pa1, pa2, pa3); pv_one<3>(o[3], vb, pa0, pa1, pa2, pa3);
}
__device__ __forceinline__ void na_mask(f32x16& p0, f32x16& p1, int kr, int qr, int rs, int ws, const float* rpbl, int hi) {
  if (kr < rs || kr >= rs + 8) {
#pragma unroll
    for (int r = 0; r < 16; ++r) { p0[r] = -1e30f; p1[r] = -1e30f; }
  } else {
    const float* row = rpbl + (kr - qr + 7) * 31 + 4 * hi; const unsigned w0 = (unsigned)(4 * hi - ws);
#pragma unroll
    for (int r = 0; r < 16; ++r) {
      const int kc = (r & 3) + 8 * (r >> 2);
      const float b0 = row[kc], b1 = row[kc + 32];
      p0[r] = (w0 + (unsigned)kc < 16u) ? p0[r] + b0 : -1e30f; p1[r] = (w0 + (unsigned)(kc + 32) < 16u) ? p1[r] + b1 : -1e30f;
      if ((r & 3) == 3) SBAR();
    }
  }
}
template <bool NA, int SD>
__device__ __forceinline__ void attn_body(const bf16* __restrict__ Qb, const bf16* __restrict__ K0, const bf16* __restrict__ V0, const bf16* __restrict__ K1, const bf16* __restrict__ V1,
                                          bf16* __restrict__ Ob, const int NT, const int lo, const int rg, char* lds) {
  int tid_ = threadIdx.x; asm volatile("" : "+v"(tid_));
  const int tid = tid_, wid = tid >> 6, lane = tid & 63, r32 = lane & 31, hi = lane >> 5;
  bf16* V_lds = (bf16*)lds; bf16* K_lds = (bf16*)(lds + 2 * SHM_V);
  float* ws_ = (float*)(lds + 2 * SHM_V + 2 * SHM_K) + wid * 64; float* li_l = ws_; float* al_l = ws_ + 32;
  const int qrow = 4 * rg + (wid >> 1), qc = 32 * (wid & 1) + r32;
  const int rs = qrow - 4 < 0 ? 0 : (qrow - 4 > 8 ? 8 : qrow - 4), wsn = qc - 8 < 0 ? 0 : (qc - 8 > 48 ? 48 : qc - 8);
  const float* rpbl = (const float*)(lds + RPB_OFF) + 15 - qc;
  float m_reg = -1e30f, l_reg = 0; f32x16 o[4] = {}; bf16x8 qr[8];
  const bf16* Qw = Qb + (long)(wid * QBLK + r32) * LD + hi * 8;
#pragma unroll
  for (int d0 = 0; d0 < 8; ++d0) qr[d0] = *(const GAS bf16x8*)(Qw + d0 * 16);
  const int sr = tid >> 4, sc = (tid & 15) * 8, vst0 = v_st(sr, sc), vst1 = v_st(32 + sr, sc);
  const int vb0 = (int)(uintptr_t)V_lds + v_rd_base(lane);
  struct { bf16x8 vs0, vs1, ks0, ks1; } sr_[SD];
#define TILEK(t) ((NA && (t) >= 8) ? K1 + (long)((t) - 8) * 64 * LD : K0 + (long)(t) * 64 * LD)
#define TILEV(t) ((NA && (t) >= 8) ? V1 + (long)((t) - 8) * 64 * LD : V0 + (long)(t) * 64 * LD)
#define SLOAD(i, t) do { const bf16* kp_ = TILEK(t); const bf16* vp_ = TILEV(t); \
    sr_[i].vs0 = *(const GAS bf16x8*)(&vp_[(long)sr * LD + sc]); sr_[i].vs1 = *(const GAS bf16x8*)(&vp_[(long)(32 + sr) * LD + sc]); \
    sr_[i].ks0 = *(const GAS bf16x8*)(&kp_[(long)sr * LD + sc]); sr_[i].ks1 = *(const GAS bf16x8*)(&kp_[(long)(32 + sr) * LD + sc]); } while (0)
#define SWRITE(b, i) do { *(bf16x8*)((char*)V_lds + (b) * SHM_V + vst0) = sr_[i].vs0;          \
    *(bf16x8*)((char*)V_lds + (b) * SHM_V + vst1) = sr_[i].vs1; int kc = sc * 2;               \
    *(bf16x8*)((char*)K_lds + (b) * SHM_K + KSWZ(sr, kc)) = sr_[i].ks0;                       \
    *(bf16x8*)((char*)K_lds + (b) * SHM_K + KSWZ(32 + sr, kc)) = sr_[i].ks1; } while (0)
#define SWAIT() do { if constexpr (SD == 2) asm volatile("s_waitcnt vmcnt(4)" ::: "memory"); else asm volatile("s_waitcnt vmcnt(0)" ::: "memory"); } while (0)
#define RESC(a) do { if (__any((a) < 1.f)) { if (hi == 0) al_l[r32] = (a); asm volatile("s_waitcnt lgkmcnt(0)" ::: "memory"); \
    for (int d = 0; d < 4; ++d) for (int r = 0; r < 16; ++r) o[d][r] *= al_l[crow(r, hi)]; } } while (0)
#define MASK(P0, P1, t) do { if (NA && (t) >= 8) na_mask(P0, P1, lo + (t) - 8, qrow, rs, wsn, rpbl, hi); } while (0)
  f32x16 pA0, pA1, pB0, pB1; float mnA, mnB, alA, alB; bf16x8 pa0, pa1, pa2, pa3;
  constexpr int SE = 0, SO = SD - 1;
  SLOAD(SE, 0); asm volatile("s_waitcnt vmcnt(0)" ::: "memory"); SWRITE(0, SE); __syncthreads();
  qkt(pA0, pA1, K_lds, qr, r32, hi); partialSM(pA0, pA1, m_reg, mnA, alA);
  SLOAD(SO, 1); if constexpr (SD == 2) { if (2 < NT) SLOAD(SE, 2); }
  SWAIT(); SWRITE(1, SO); __syncthreads();
  for (int j = 1; j + 1 < NT; j += 2) {
    SBAR(); qkt(pB0, pB1, (bf16*)((char*)K_lds + SHM_K), qr, r32, hi); MASK(pB0, pB1, j);
    finishSM(pA0, pA1, alA, l_reg, pa0, pa1, pa2, pa3); SBAR();
    SLOAD(SO, j + SD); SBAR();
    pv_d0(o, vb0, pa0, pa1, pa2, pa3); partialSM(pB0, pB1, m_reg, mnB, alB);
    __syncthreads(); SWAIT(); SWRITE(0, SE);
    RESC(alB); __syncthreads();
    SBAR(); qkt(pA0, pA1, K_lds, qr, r32, hi); MASK(pA0, pA1, j + 1);
    finishSM(pB0, pB1, alB, l_reg, pa0, pa1, pa2, pa3); SBAR();
    if (SD == 1 || j + 3 < NT) SLOAD(SE, j + 1 + SD); SBAR();
    pv_d0(o, vb0 + (int)SHM_V, pa0, pa1, pa2, pa3); partialSM(pA0, pA1, m_reg, mnA, alA);
    __syncthreads(); SWAIT(); SWRITE(1, SO);
    RESC(alA); __syncthreads();
  }
  SBAR(); qkt(pB0, pB1, (bf16*)((char*)K_lds + SHM_K), qr, r32, hi); MASK(pB0, pB1, NT - 1);
  finishSM(pA0, pA1, alA, l_reg, pa0, pa1, pa2, pa3); SBAR();
  pv_d0(o, vb0, pa0, pa1, pa2, pa3); partialSM(pB0, pB1, m_reg, mnB, alB);
  __syncthreads(); RESC(alB);
  finishSM(pB0, pB1, alB, l_reg, pa0, pa1, pa2, pa3); SBAR();
  pv_d0(o, vb0 + (int)SHM_V, pa0, pa1, pa2, pa3);
  if (hi == 0) li_l[r32] = l_reg; asm volatile("s_waitcnt lgkmcnt(0)" ::: "memory");
  float rli[16];
#pragma unroll
  for (int r = 0; r < 16; ++r) rli[r] = __builtin_amdgcn_rcpf(li_l[crow(r, hi)]);
  bf16* Ow = Ob + (long)(wid * QBLK) * LD;
#pragma unroll
  for (int r = 0; r < 16; ++r) { int orow = crow(r, hi);
    for (int d0 = 0; d0 < 4; ++d0) *(GAS bf16*)(Ow + (long)orow * LD + d0 * 32 + r32) = (bf16)f2bf(o[d0][r] * rli[r]); }
  asm volatile("s_waitcnt vmcnt(0)" ::: "memory"); __syncthreads();
#undef TILEK
#undef TILEV
#undef SLOAD
#undef SWRITE
#undef SWAIT
#undef RESC
#undef MASK
}
}

constexpr int NWAVES = 8;
struct Args { const float* in[36]; float* out; unsigned char* ws; int ph_lo, ph_hi; };
struct Frame { LAS unsigned char* lds; char* ldsg; volatile LAS unsigned* MISC; int tid, lane, wave, vcu, G; };
constexpr int INTAB_OFF = MISC_OFF + 128;
__device__ __forceinline__ const float* ld_in(const LAS unsigned char* lds, int i) { const unsigned long long v = ((const LAS unsigned long long*)(lds + INTAB_OFF))[i];
    const unsigned lo = __builtin_amdgcn_readfirstlane((unsigned)v), hi = __builtin_amdgcn_readfirstlane((unsigned)(v >> 32)); return (const float*)(((unsigned long long)hi << 32) | lo); }
#define IN(i) ld_in(F.lds, (i))

__device__ __forceinline__ void transpose_item(const float* W, int N, int k0, int n0, bf16* WT, int ldo, int drow0, float* scr, int lane) {
    const int kr = lane >> 3, n4 = (lane & 7) * 4;
    f32x4 v[8];
#pragma unroll
    for (int i = 0; i < 8; ++i) v[i] = *(const GAS f32x4*)(W + (size_t)(k0 + kr + 8 * i) * N + n0 + n4);
#pragma unroll
    for (int i = 0; i < 8; ++i) { float* d = scr + (kr + 8 * i) * 33 + n4; d[0] = v[i].x; d[1] = v[i].y; d[2] = v[i].z; d[3] = v[i].w; }
    LDS_WAIT(); asm volatile("" ::: "memory");
    const int c = lane & 7;
#pragma unroll
    for (int j = 0; j < 4; ++j) { const int n = (lane >> 3) + 8 * j; const float* s = scr + (8 * c) * 33 + n;
        v4u o; o.x = pk2(s[0 * 33], s[1 * 33]); o.y = pk2(s[2 * 33], s[3 * 33]); o.z = pk2(s[4 * 33], s[5 * 33]); o.w = pk2(s[6 * 33], s[7 * 33]);
        *(GAS v4u*)(WT + (size_t)(drow0 + n) * ldo + k0 + 8 * c) = o; }
    LDS_WAIT(); asm volatile("" ::: "memory");
}

__device__ __forceinline__ int cv_of_row(int row) { return row < CTXR ? 0 : 1 + ((row - CTXR) >> 10); }

template <bool FIRST, bool HASNEXT>
__device__ __forceinline__ void resnorm_rows(const Frame& F, const float* xin0, const float* xin1, float* X, const bf16* Z, const float* gpost, const float* modGate  ,
                                             const float* gpre, const float* modShift, const float* modScale, bf16* H) {
    const int gw = F.vcu * NWAVES + F.wave, NGW = F.G * NWAVES;
    for (int row = gw; row < ROWS; row += NGW) {
        const int cv = cv_of_row(row);
        f32x4 x[8];
        if (FIRST) {
            const GAS f32x4* src = (const GAS f32x4*)(row < CTXR ? xin0 + (size_t)row * DM : xin1 + (size_t)(row - CTXR) * DM);
#pragma unroll
            for (int j = 0; j < 8; ++j) x[j] = src[2 * (F.lane + 64 * (j >> 1)) + (j & 1)];
        } else {
            const GAS v4u* zr = (const GAS v4u*)(Z + (size_t)row * DM); const GAS f32x4* xr = (const GAS f32x4*)(X + (size_t)row * DM);
            f32x4 z[8]; float ss = 0.f;
#pragma unroll
            for (int jj = 0; jj < 4; ++jj) { float f[8]; unpack8(zr[F.lane + 64 * jj], f); z[2 * jj] = (f32x4){f[0], f[1], f[2], f[3]}; z[2 * jj + 1] = (f32x4){f[4], f[5], f[6], f[7]}; }
#pragma unroll
            for (int j = 0; j < 8; ++j) ss += (z[j].x * z[j].x + z[j].y * z[j].y) + (z[j].z * z[j].z + z[j].w * z[j].w);
            const float rstd = rsqrtf(wave_sum(ss, F.lane) * (1.f / DM) + RMS_EPS);
#pragma unroll
            for (int j = 0; j < 8; ++j) { const int q = 2 * (F.lane + 64 * (j >> 1)) + (j & 1); const f32x4 gp = ((const GAS f32x4*)gpost)[q], gt = ((const GAS f32x4*)(modGate + (size_t)cv * 12288))[q];
                x[j] = xr[q] + gt * (z[j] * rstd * gp); }
        }
        { GAS f32x4* xo = (GAS f32x4*)(X + (size_t)row * DM);
#pragma unroll
          for (int j = 0; j < 8; ++j) xo[2 * (F.lane + 64 * (j >> 1)) + (j & 1)] = x[j]; }
        if (HASNEXT) {
            float ss = 0.f;
#pragma unroll
            for (int j = 0; j < 8; ++j) ss += (x[j].x * x[j].x + x[j].y * x[j].y) + (x[j].z * x[j].z + x[j].w * x[j].w);
            const float rstd = rsqrtf(wave_sum(ss, F.lane) * (1.f / DM) + RMS_EPS);
            GAS v4u* ho = (GAS v4u*)(H + (size_t)row * DM);
#pragma unroll
            for (int jj = 0; jj < 4; ++jj) { float f[8];
#pragma unroll
                for (int h = 0; h < 2; ++h) { const int q = 2 * (F.lane + 64 * jj) + h; const f32x4 g = ((const GAS f32x4*)gpre)[q], sh = ((const GAS f32x4*)(modShift + (size_t)cv * 12288))[q], sc = ((const GAS f32x4*)(modScale + (size_t)cv * 12288))[q];
                    const f32x4 hv = x[2 * jj + h] * rstd * g * (sc + 1.0f) + sh; f[4 * h] = hv.x; f[4 * h + 1] = hv.y; f[4 * h + 2] = hv.z; f[4 * h + 3] = hv.w; }
                ho[F.lane + 64 * jj] = pack8(f); }
        }
    }
}

__device__ __forceinline__ void s5_tables(const Frame& F, int l, int g, unsigned char* ws) {
    char* L = F.ldsg;
    f32x2* POW = (f32x2*)L;
    f32x2* BB = (f32x2*)(L + 17408);
    f32x2* CC = (f32x2*)(L + 17408 + 16384);
    float* KT = (float*)(L + 17408 + 32768);
    const int tid = F.tid;
    __syncthreads();
    if (tid < 128) {
        const int d = tid >> 6, p = tid & 63; const size_t li = ((size_t)(l * 2 + d) * 64 + g) * 64 + p;
        const float dt = expf(IN(22)[(l * 2 + d) * 64 + g]); const float lre = IN(20)[li], lim = IN(21)[li];
        const float er = expf(lre * dt); float sn, cs; sincosf(lim * dt, &sn, &cs);
        const float br = er * cs, bi = er * sn;
        const float nr = br - 1.0f, ni = bi, den = lre * lre + lim * lim;
        const float cr = (nr * lre + ni * lim) / den, ci = (ni * lre - nr * lim) / den;
        float pr = 1.f, pi = 0.f;
        for (int t = 0; t <= 16; ++t) { POW[(d * 64 + p) * 17 + t] = (f32x2){pr, pi}; const float nr2 = pr * br - pi * bi, ni2 = pr * bi + pi * br; pr = nr2; pi = ni2; }
        ((f32x2*)(ws + WS_LT))[li] = POW[(d * 64 + p) * 17 + 16];
        { f32x4 vr[4], vi[4]; const GAS f32x4* pr4 = (const GAS f32x4*)(IN(23) + li * 16); const GAS f32x4* pi4 = (const GAS f32x4*)(IN(24) + li * 16);
#pragma unroll
          for (int q = 0; q < 4; ++q) { vr[q] = pr4[q]; vi[q] = pi4[q]; }
#pragma unroll
          for (int m = 0; m < 16; ++m) { const float xr = vr[m >> 2][m & 3], xi = vi[m >> 2][m & 3]; BB[(d * 64 + p) * 16 + m] = (f32x2){cr * xr - ci * xi, cr * xi + ci * xr}; } }
    }
    for (int i = tid; i < 2048; i += 512) { const int d = i >> 10, n = (i >> 6) & 15, p = i & 63; const size_t ci_ = (((size_t)(l * 2 + d) * 64 + g) * 16 + n) * 64 + p; CC[i] = (f32x2){IN(25)[ci_], IN(26)[ci_]}; }
    __syncthreads();
    {
        const int d = tid >> 8, n = (tid >> 4) & 15, m = tid & 15; float acc[16];
#pragma unroll
        for (int t = 0; t < 16; ++t) acc[t] = 0.f;
        for (int p = 0; p < 64; ++p) { const f32x2 c = CC[(d * 16 + n) * 64 + p], b = BB[(d * 64 + p) * 16 + m]; const float cbr = c.x * b.x - c.y * b.y, cbi = c.x * b.y + c.y * b.x;
#pragma unroll
            for (int t = 0; t < 16; ++t) { const f32x2 w = POW[(d * 64 + p) * 17 + t]; acc[t] += cbr * w.x - cbi * w.y; } }
#pragma unroll
        for (int t = 0; t < 16; ++t) KT[((d * 16 + t) * 16 + n) * 16 + m] = acc[t];
    }
    __syncthreads();
    bf16* MT = (bf16*)(ws + WS_MT) + (size_t)(l * 64 + g) * 65536; bf16* ET = (bf16*)(ws + WS_ET) + (size_t)(l * 64 + g) * 65536; bf16* FT = (bf16*)(ws + WS_FT) + (size_t)(l * 64 + g) * 65536;
    for (int i = tid; i < 8192; i += 512) {
        const int rowi = i >> 5, k0 = (i & 31) * 8;
        { const int t = rowi >> 4, n = rowi & 15, s = k0 >> 4, m0 = k0 & 15; float f[8];
#pragma unroll
          for (int e = 0; e < 8; ++e) { float v = 0.f; if (s <= t) v += KT[((0 * 16 + (t - s)) * 16 + n) * 16 + m0 + e]; if (s >= t) v += KT[((1 * 16 + (s - t)) * 16 + n) * 16 + m0 + e]; f[e] = v; }
          *(GAS v4u*)(MT + (size_t)rowi * 256 + k0) = pack8(f); }
        { const int d = rowi >> 7, p = (rowi >> 1) & 63, c = rowi & 1, s = k0 >> 4, m0 = k0 & 15; float f[8];
          const f32x2 w = POW[(d * 64 + p) * 17 + (d == 0 ? 15 - s : s)];
#pragma unroll
          for (int e = 0; e < 8; ++e) { const f32x2 b = BB[(d * 64 + p) * 16 + m0 + e]; f[e] = c == 0 ? (w.x * b.x - w.y * b.y) : (w.x * b.y + w.y * b.x); }
          *(GAS v4u*)(ET + (size_t)rowi * 256 + k0) = pack8(f); }
        { const int t = rowi >> 4, n = rowi & 15; float f[8];
#pragma unroll
          for (int e = 0; e < 8; ++e) { const int k = k0 + e, d = k >> 7, p = (k >> 1) & 63, c = k & 1; const f32x2 cc = CC[(d * 16 + n) * 64 + p], w = POW[(d * 64 + p) * 17 + (d == 0 ? t + 1 : 16 - t)];
              f[e] = c == 0 ? (cc.x * w.x - cc.y * w.y) : -(cc.x * w.y + cc.y * w.x); }
          *(GAS v4u*)(FT + (size_t)rowi * 256 + k0) = pack8(f); }
    }
    __syncthreads();
}

constexpr int I_WIN = 32 * 384, I_GLU = 16 * 32, I_OUT = 16 * 64, I_WO = 32 * 64, I_FIN = 32 * 352, I_FOUT = 88 * 64, I_GW = 32 * 8;
constexpr int I_LAYER = I_WIN + I_GLU + 3 * I_OUT + I_WO + I_FIN + I_FOUT + I_GW;
__device__ __forceinline__ void weight_item(const Frame& F, unsigned char* ws, int l, int r, float* scr) {
    if (r < I_WIN) { const int kb = r / 384, nb = r % 384; transpose_item(IN(14) + (size_t)l * DM * INW, INW, kb * 64, nb * 32, (bf16*)(ws + WS_WINT) + (size_t)l * INW * DM, DM, nb * 32, scr, F.lane); return; } r -= I_WIN;
    if (r < I_GLU) { const int kb = r / 32, nb = r % 32; transpose_item(IN(28) + (size_t)l * 1024 * 1024, 1024, kb * 64, nb * 32, (bf16*)(ws + WS_GLUT) + (size_t)l * 1024 * 1024, 1024, nb * 32, scr, F.lane); return; } r -= I_GLU;
    if (r < 3 * I_OUT) { const int b = r / I_OUT, q = r % I_OUT, kb = q / 64, nb = q % 64; transpose_item(IN(30 + b) + (size_t)l * 1024 * DM, DM, kb * 64, nb * 32, (bf16*)(ws + WS_OUTT) + ((size_t)l * 3 + b) * DM * 1024, 1024, nb * 32, scr, F.lane); return; } r -= 3 * I_OUT;
    if (r < I_WO) { const int kb = r / 64, nb = r % 64; transpose_item(IN(33) + (size_t)l * DM * DM, DM, kb * 64, nb * 32, (bf16*)(ws + WS_WOT) + (size_t)l * DM * DM, DM, nb * 32, scr, F.lane); return; } r -= I_WO;
    if (r < I_FIN) { const int kb = r / 352, nb = r % 352; const int n0 = nb * 32, half = n0 >= FFH, j = n0 - half * FFH; const int drow = 256 * (j >> 7) + 128 * half + (j & 127);
        transpose_item(IN(34) + (size_t)l * DM * 2 * FFH, 2 * FFH, kb * 64, n0, (bf16*)(ws + WS_FINT) + (size_t)l * 2 * FFH * DM, DM, drow, scr, F.lane); return; } r -= I_FIN;
    if (r < I_FOUT) { const int kb = r / 64, nb = r % 64; transpose_item(IN(35) + (size_t)l * FFH * DM, DM, kb * 64, nb * 32, (bf16*)(ws + WS_FOUTT) + (size_t)l * DM * FFH, FFH, nb * 32, scr, F.lane); return; } r -= I_FOUT;
    { const int mi = r >> 3, q = r & 7, kb = q >> 2, nb = q & 3;
      const int d = mi >> 4, g = (mi >> 3) & 1, h = mi & 7;
      transpose_item(IN(17) + ((size_t)l * 32 + mi) * 128 * 128, 128, kb * 64, nb * 32, (bf16*)(ws + WS_GWT) + (((size_t)l * 8 + h) * 2 + d) * 256 * 128, 128, g * 128 + nb * 32, scr, F.lane); }
}
constexpr int QB = 16;
static_assert(I_LAYER % QB == 0, "queue batch");
constexpr int Q_P2 = 562 * QB, Q_P3 = 624 * QB, Q_P4 = 1374 * QB, Q_P5 = 1813 * QB, Q_P9 = I_LAYER;
constexpr int CW_Q = 8192;
__device__ __forceinline__ void pull_weight_items(const Frame& F, unsigned char* ws, int l, int upto) {
    if (l >= NL) return;
    unsigned* ctr = (unsigned*)(ws + WS_CTL) + CW_Q + 64 * l; float* scr = (float*)(F.ldsg + F.wave * 16384);
    const int upto_b = upto / QB;
    for (;;) {
        unsigned i = 0;
        if (F.lane == 0) asm volatile("global_atomic_add %0, %1, %2, off sc0\n\ts_waitcnt vmcnt(0)" : "=&v"(i) : "v"(ctr), "v"(1u) : "memory");
        i = (unsigned)__builtin_amdgcn_readfirstlane((int)i);
        if ((int)i >= upto_b) { if (F.lane == 0) asm volatile("global_atomic_sub %0, %1, off" :: "v"(ctr), "v"(1u) : "memory"); break; }
        for (int j = 0; j < QB; ++j) weight_item(F, ws, l, (int)i * QB + j, scr);
    }
}

constexpr int SQ_P5 = 6, SQ_P9 = 10, SQ_END = (SQ_P5 + SQ_P9) * 1024;
__device__ __forceinline__ void static_weight_items(const Frame& F, unsigned char* ws, int l, int c, int G, int k0, int nk) {
    if (l >= NL || G != 256 || c < 128) return;
    float* scr = (float*)(F.ldsg + F.wave * 16384); const int w = (c - 128) * 8 + F.wave;
    for (int k = 0; k < nk; ++k) weight_item(F, ws, l, (k0 + k) * 1024 + w, scr);
}

__global__ void __launch_bounds__(NWAVES * 64, 2) fwd_kernel(Args args) {
    extern __shared__ __attribute__((aligned(16))) unsigned char lds[];
    const int G0 = gridDim.x, c0 = (int)blockIdx.x;
    volatile LAS unsigned* MISC0 = (volatile LAS unsigned*)((LAS unsigned char*)lds + MISC_OFF);
    unsigned char* const ws0 = args.ws; float* const out0 = args.out;
    gu32* ctl = (gu32*)(ws0 + WS_CTL);
    for (int u = threadIdx.x; u < (LDS_BYTES - LDSCTL_OFF) / 4; u += NWAVES * 64) ((LAS unsigned*)((LAS unsigned char*)lds + LDSCTL_OFF))[u] = 0u;
    __syncthreads();
    if (threadIdx.x == 0) {
#pragma unroll
        for (int i = 0; i < 36; ++i) ((LAS unsigned long long*)((LAS unsigned char*)lds + INTAB_OFF))[i] = (unsigned long long)args.in[i]; }
    __syncthreads();
    XcdBarrier bar; bar.bar = (unsigned*)(ctl + CW_BAR); bar.x = 0; bar.st = nullptr;
    if (MK_N_LAUNCHES == 1) bar = xcd_barrier_post((unsigned*)(ctl + CW_BAR), MISC0 + 8);
    const int lo = args.ph_lo, hi = args.ph_hi;
    int ph = 0;
#ifndef PHMASK
#define PHMASK 0xFFFFFFFFu
#endif
#define PHASE_BEGIN(k) if (((PHMASK >> (k)) & 1u) && lo <= ph && ph < hi) { if ((k) == TSEL && threadIdx.x == 0) *(volatile LAS unsigned long long*)(MISC0 + 16) = __builtin_amdgcn_s_memrealtime(); unsigned char* ws = ws0; float* outp = out0; int tid_p = threadIdx.x, G = G0, c = c0; asm volatile("" : "+s"(ws), "+s"(outp), "+v"(tid_p), "+s"(G), "+s"(c)); const int vcu = (G % 8 == 0) ? (c % 8) * (G / 8) + c / 8 : c;     \
    Frame F; F.lds = (LAS unsigned char*)lds; F.ldsg = (char*)lds; F.MISC = (volatile LAS unsigned*)(F.lds + MISC_OFF); F.tid = tid_p; F.lane = tid_p & 63; F.wave = __builtin_amdgcn_readfirstlane(tid_p >> 6); F.G = G; F.vcu = vcu; \
    const int gw = vcu * NWAVES + F.wave, NGW = G * NWAVES, gt = vcu * 512 + F.tid, NGT = G * 512; (void)gw; (void)NGW; (void)gt; (void)NGT; \
    float* const X = outp + O_X; bf16* const Hb = (bf16*)(ws + WS_H); float* const MOD = (float*)(ws + WS_MOD); const float* const modl = MOD + (size_t)l_ * NCV * INW; (void)X; (void)Hb; (void)modl;
#define PHASE_END(k)   if (MK_N_LAUNCHES == 1 && ph + 1 < hi) { XcdBarrier b_ = bar; asm volatile("" : "+s"(b_.bar)); xcd_barrier(b_); } if ((k) == TSEL && threadIdx.x == 0) *(volatile LAS unsigned long long*)(MISC0 + 18) += __builtin_amdgcn_s_memrealtime() - *(volatile LAS unsigned long long*)(MISC0 + 16); } ++ph;
    int l_ = 0;

    PHASE_BEGIN(0)
    {
        for (int it = F.vcu; it < NL * 64; it += G) s5_tables(F, it >> 6, it & 63, ws);
        __syncthreads();
        { const float* lamp = IN(19); for (int i = gt; i < NL * 2 * 1024; i += NGT) ((float*)(ws + WS_SP))[i] = log1pf(expf(-lamp[i])); }
        float* scr = (float*)(F.ldsg + F.wave * 16384);
        { const int rest = (G == 256) ? I_LAYER - SQ_END : I_LAYER;
          for (int it = gw; it < I_LAYER + 3 * rest; it += NGW) { if (it < I_LAYER) weight_item(F, ws, 0, it, scr); else { const int q = it - I_LAYER, l = 1 + q / rest, r = q % rest; weight_item(F, ws, l, I_LAYER - rest + r, scr); } } }
        const float* ckp = IN(2); const float* cvp = IN(3);
        for (int i0 = gt; i0 < 2 * 1048576; i0 += 4 * NGT) { f32x4 a0[4], a1[4];
#pragma unroll
            for (int q = 0; q < 4; ++q) { const int i = i0 + q * NGT; if (i < 2 * 1048576) { const int which = i >> 20, j = i & 1048575; const GAS f32x4* s = (const GAS f32x4*)(which ? cvp : ckp) + (size_t)j * 2; a0[q] = s[0]; a1[q] = s[1]; } }
#pragma unroll
            for (int q = 0; q < 4; ++q) { const int i = i0 + q * NGT; if (i < 2 * 1048576) { const int which = i >> 20, j = i & 1048575;
                v4u o; o.x = pk2(a0[q].x, a0[q].y); o.y = pk2(a0[q].z, a0[q].w); o.z = pk2(a1[q].x, a1[q].y); o.w = pk2(a1[q].z, a1[q].w); ((GAS v4u*)(ws + (which ? WS_CV : WS_CK)))[j] = o; } } }
        const float* cctx = IN(7); const float* cvec = IN(6); const float* wmod = IN(8);
        for (int task = gt; task < 16 * NL * 3072; task += NGT) {
            const int n4 = task % 3072, l = (task / 3072) % NL, ks = task / (3072 * NL);
            f32x4 acc[NCV];
#pragma unroll
            for (int v = 0; v < NCV; ++v) acc[v] = (f32x4){0.f, 0.f, 0.f, 0.f};
            const GAS f32x4* wp = (const GAS f32x4*)(wmod + ((size_t)l * DM + ks * 128) * INW) + n4;
            for (int kb = 0; kb < 128; kb += 16) { f32x4 w[16];
#pragma unroll
                for (int j = 0; j < 16; ++j) w[j] = wp[(size_t)(kb + j) * (INW / 4)];
#pragma unroll
                for (int j = 0; j < 16; ++j) { const int kk = ks * 128 + kb + j;
#pragma unroll
                    for (int v = 0; v < NCV; ++v) { const float cnd = v == 0 ? cctx[kk] : cvec[(v - 1) * DM + kk]; const float sl = cnd * fsigmoid(cnd); acc[v] += w[j] * sl; } } }
#pragma unroll
            for (int v = 0; v < NCV; ++v) ((f32x4*)(ws + WS_MODP))[(((size_t)ks * NL + l) * NCV + v) * 3072 + n4] = acc[v];
        }
    }
    PHASE_END(0)
    PHASE_BEGIN(1)
        const float* bmod = IN(9);
        for (int i = gt; i < NL * NCV * 3072; i += NGT) { const int n4 = i % 3072, v = (i / 3072) % NCV, l = i / (3072 * NCV);
            f32x4 s = ((const f32x4*)(bmod + (size_t)l * INW))[n4];
            f32x4 pp[16];
#pragma unroll
            for (int ks = 0; ks < 16; ++ks) pp[ks] = ((const GAS f32x4*)(ws + WS_MODP))[(((size_t)ks * NL + l) * NCV + v) * 3072 + n4];
#pragma unroll
            for (int ks = 0; ks < 16; ++ks) s += pp[ks];
            ((f32x4*)MOD)[i] = s; }
    PHASE_END(1)
    PHASE_BEGIN(2)
        resnorm_rows<true, true>(F, IN(0), IN(1), X, nullptr, nullptr, nullptr, IN(10), MOD + 0 * DM, MOD + 1 * DM, Hb);
    PHASE_END(2)

    for (int l = 0; l < DBG_NL; ++l) {
        l_ = l;
        PHASE_BEGIN(3)
        {   pg8::SchedPlain S{(const char*)Hb, (const char*)(ws + WS_WINT) + (size_t)l * INW * DM * 2, 32, 48, G, c, (size_t)256 * DM * 2, (size_t)256 * DM * 2, DUPG1};
            pg8::EpiWin E{(bf16*)(ws + WS_XR), (bf16*)(ws + WS_XG), (bf16*)(ws + WS_UG), (bf16*)(ws + WS_Q), (bf16*)(ws + WS_K), (bf16*)(ws + WS_V), (bf16*)(ws + WS_G),
                          outp + O_K + (size_t)l * 256 * 1024, outp + O_V + (size_t)l * 256 * 1024};
            pg8::gemm_phase(F.lds, DM, DM, DM, S, E); }
        PHASE_END(3)
        PHASE_BEGIN(4)
        {
            { const bf16* XR = (const bf16*)(ws + WS_XR); bf16* XC = (bf16*)(ws + WS_XC); const GAS float* cw = (const GAS float*)(IN(15) + (size_t)l * 4 * 1024); const GAS float* cb = (const GAS float*)(IN(16) + (size_t)l * 1024);
              for (int i_ = gt; i_ < ROWS * 128 * DUP_CONV; i_ += NGT) { const int i = i_ % (ROWS * 128); const int row = i >> 7, c8 = (i & 127) * 8;
                  const int s0 = row < CTXR ? (row & ~255) : (CTXR + ((row - CTXR) & ~1023)), s1 = row < CTXR ? s0 + 256 : s0 + 1024;
                  v4u xw[4];
#pragma unroll
                  for (int k = 0; k < 4; ++k) { int rr = row + k - 1; rr = rr < s0 ? s0 : (rr >= s1 ? s1 - 1 : rr); xw[k] = *(const GAS v4u*)(XR + (size_t)rr * 1024 + c8); }
                  f32x4 cw0[4], cw1[4]; const f32x4 cb0 = *(const GAS f32x4*)(cb + c8), cb1 = *(const GAS f32x4*)(cb + c8 + 4);
#pragma unroll
                  for (int k = 0; k < 4; ++k) { cw0[k] = *(const GAS f32x4*)(cw + k * 1024 + c8); cw1[k] = *(const GAS f32x4*)(cw + k * 1024 + c8 + 4); }
                  float acc[8] = {cb0[0], cb0[1], cb0[2], cb0[3], cb1[0], cb1[1], cb1[2], cb1[3]};
#pragma unroll
                  for (int k = 0; k < 4; ++k) { const int rr = row + k - 1; const float ok = (rr >= s0 && rr < s1) ? 1.0f : 0.0f; float xv[8]; unpack8(xw[k], xv);
#pragma unroll
                      for (int e = 0; e < 8; ++e) acc[e] += ok * (e < 4 ? cw0[k][e] : cw1[k][e - 4]) * xv[e]; }
                  *(GAS v4u*)(XC + (size_t)row * 1024 + c8) = pack8(acc); } }
            for (int L = c; L < 128 * DUP_S5; L += G) { const int g = (L & 127) >> 1, pm = L & 1;
                { pg8::SchedOne S{(const char*)(ws + WS_UG) + ((size_t)g * 512 + pm * 256) * 256 * 2, (const char*)(ws + WS_ET) + ((size_t)l * 64 + g) * 65536 * 2, nullptr, nullptr, pm, g, 1}; pg8::EpiHloc E{(float*)(ws + WS_HLOC)};
                  pg8::gemm_phase(F.lds, 256, 256, 256, S, E); }
                { const float* HLOC = (const float*)(ws + WS_HLOC); bf16* HIN = (bf16*)(ws + WS_HIN); const GAS f32x2* LT = (const GAS f32x2*)(ws + WS_LT) + (size_t)l * 2 * 64 * 64;
                  const int nseq = pm ? 4 : 16, nch = pm ? 64 : 16;
                  for (int i = F.tid; i < nseq * 128; i += 512) { const int p = i & 63, d = (i >> 6) & 1, sq = i >> 7; const int seq = pm ? 16 + sq : sq, ch0 = pm ? 256 + sq * 64 : sq * 16;
                      const f32x2 lam = LT[(d * 64 + g) * 64 + p]; float hr = 0.f, hi_ = 0.f;
                      if (pm) { const f32x2 h0 = ((const f32x2*)IN(5))[((((size_t)sq * 4 + l) * 2 + d) * 64 + g) * 64 + p]; hr = h0.x; hi_ = h0.y; }
                      for (int kb = 0; kb < nch; kb += 16) { f32x2 hl[16];
#pragma unroll
                          for (int j = 0; j < 16; ++j) { const int ch = d == 0 ? ch0 + kb + j : ch0 + nch - 1 - kb - j; hl[j] = *(const GAS f32x2*)(HLOC + ((size_t)g * 512 + ch) * 256 + d * 128 + p * 2); }
#pragma unroll
                          for (int j = 0; j < 16; ++j) { const int ch = d == 0 ? ch0 + kb + j : ch0 + nch - 1 - kb - j; *(GAS unsigned*)(HIN + ((size_t)g * 512 + ch) * 256 + d * 128 + p * 2) = pk2(hr, hi_);
                              const float nr = lam.x * hr - lam.y * hi_ + hl[j].x, ni = lam.x * hi_ + lam.y * hr + hl[j].y; hr = nr; hi_ = ni; } }
                      if (!pm) ((f32x2*)(outp + O_S5))[((((size_t)seq * 4 + l) * 2 + d) * 64 + g) * 64 + p] = (f32x2){hr, hi_}; }
                  VM_WAIT(); __syncthreads(); }
                { pg8::SchedOne S{(const char*)(ws + WS_UG) + ((size_t)g * 512 + pm * 256) * 256 * 2, (const char*)(ws + WS_MT) + ((size_t)l * 64 + g) * 65536 * 2,
                                  (const char*)(ws + WS_HIN) + ((size_t)g * 512 + pm * 256) * 256 * 2, (const char*)(ws + WS_FT) + ((size_t)l * 64 + g) * 65536 * 2, pm, g, 2};
                  pg8::EpiS5Y E{(const bf16*)(ws + WS_UG), IN(27) + (size_t)l * 1024, (bf16*)(ws + WS_ZS)};
                  pg8::gemm_phase(F.lds, 256, 256, 256, S, E); }
            }
            __syncthreads();
            { float* rp = (float*)(F.ldsg + att::RPB_OFF); const bf16* Qb = (const bf16*)(ws + WS_Q); const bf16* Kb = (const bf16*)(ws + WS_K); const bf16* Vb = (const bf16*)(ws + WS_V); bf16* Ob = (bf16*)(ws + WS_YNA);
              for (int u_ = (c + G / 2) % G; u_ < 256 * DUP_ATT; u_ += G) { const int u = u_ & 255;
                  if (u < 128) { const int b = u >> 5, h = (u >> 2) & 7, rg = u & 3; const int lo_ = rg == 0 ? 0 : (rg == 1 ? 0 : (rg == 2 ? 4 : 8)), NT = (rg == 0 || rg == 3) ? 16 : 20;
                      for (int i = F.tid; i < 465; i += 512) rp[i] = IN(29)[((size_t)l * 8 + h) * 465 + i] * (1.0f / att::SCALE);
                      __syncthreads();
                      const size_t qoff = (size_t)(CTXR + b * 1024 + rg * 256) * 1024 + h * 128, koff = (size_t)(CTXR + b * 1024 + lo_ * 64) * 1024 + h * 128, coff = ((size_t)(b * 4 + l) * 512) * 1024 + h * 128;
                      att::attn_body<true, 1>(Qb + qoff, (const bf16*)(ws + WS_CK) + coff, (const bf16*)(ws + WS_CV) + coff, Kb + koff, Vb + koff, Ob + qoff, NT, lo_, rg, F.ldsg);
                  } else { const int b = (u - 128) >> 3, h = (u - 128) & 7; const size_t off = (size_t)(b * 256) * 1024 + h * 128;
                      att::attn_body<false, 2>(Qb + off, Kb + off, Vb + off, Kb + off, Vb + off, Ob + off, 4, 0, 0, F.ldsg); }
              } }
        }
        PHASE_END(4)
        PHASE_BEGIN(5)
        {   { pg8::SchedRg S{(const char*)(ws + WS_XC), (const char*)(ws + WS_GWT) + (size_t)l * 8 * 2 * 256 * 128 * 2, G, c};
              pg8::EpiRg E{(const bf16*)(ws + WS_XC), IN(18) + (size_t)l * 4 * 1024, (const float*)(ws + WS_SP) + (size_t)l * 2048, (f32x2*)(ws + WS_AB)};
              pg8::gemm_phase(F.lds, 128, 1024, 128, S, E); }
            { pg8::SchedPlain S{(const char*)(ws + WS_ZS), (const char*)(ws + WS_GLUT) + (size_t)l * 1024 * 1024 * 2, 32, 4, G, c, (size_t)256 * 1024 * 2, (size_t)256 * 1024 * 2, 1};
              pg8::EpiGlu E{(const bf16*)(ws + WS_ZS), (bf16*)(ws + WS_YS5)};
              pg8::gemm_phase(F.lds, 1024, 1024, 1024, S, E); }
            __syncthreads(); static_weight_items(F, ws, l + 1, c, G, 0, SQ_P5);
        }
        PHASE_END(5)
        PHASE_BEGIN(6)
        {
            { const GAS unsigned* AB = (const GAS unsigned*)(ws + WS_AB); GAS float* HF = (GAS float*)(ws + WS_HF); const GAS bf16* XG = (const GAS bf16*)(ws + WS_XG); GAS bf16* YRG = (GAS bf16*)(ws + WS_YRG);
              float* cs = (float*)F.ldsg;
              for (int task_ = (c + G / 2) % G; task_ < 320 * DUP_SCAN; task_ += G) { const int task = task_ % 320;
                  const bool lat = task >= 64 && task < 128; const int ti = lat ? task - 64 : (task < 64 ? task : task - 64); const int seq = ti >> 4, cb = ti & 15;
                  const int L = lat ? 1024 : 256, row0 = lat ? CTXR + seq * 1024 : seq * 256, ch = cb * 64 + F.lane, len = L / 8, t0 = row0 + F.wave * len;
                  __syncthreads();
                  float pf = 1.f, hf = 0.f, pb = 1.f, hb = 0.f;
                  for (int tb = 0; tb < len; tb += 16) { unsigned v[16];
#pragma unroll
                      for (int j = 0; j < 16; ++j) v[j] = AB[(size_t)(t0 + tb + j) * 1024 + ch];
#pragma unroll
                      for (int j = 0; j < 16; ++j) { const float a = 1.0f - bflo(v[j]); hf = a * hf + bfhi(v[j]); pf *= a; } }
                  for (int tb = len - 16; tb >= 0; tb -= 16) { unsigned v[16];
#pragma unroll
                      for (int j = 0; j < 16; ++j) v[j] = AB[((size_t)ROWS + t0 + tb + j) * 1024 + ch];
#pragma unroll
                      for (int j = 15; j >= 0; --j) { const float a = 1.0f - bflo(v[j]); hb = a * hb + bfhi(v[j]); pb *= a; } }
                  cs[(F.wave * 4 + 0) * 64 + F.lane] = pf; cs[(F.wave * 4 + 1) * 64 + F.lane] = hf; cs[(F.wave * 4 + 2) * 64 + F.lane] = pb; cs[(F.wave * 4 + 3) * 64 + F.lane] = hb;
                  __syncthreads();
                  float cf = lat ? IN(4)[((size_t)(seq * 4 + l) * 2 + 0) * 1024 + ch] : 0.f, cbk = lat ? IN(4)[((size_t)(seq * 4 + l) * 2 + 1) * 1024 + ch] : 0.f;
                  for (int w = 0; w < F.wave; ++w) cf = cs[(w * 4 + 0) * 64 + F.lane] * cf + cs[(w * 4 + 1) * 64 + F.lane];
                  for (int w = 7; w > F.wave; --w) cbk = cs[(w * 4 + 2) * 64 + F.lane] * cbk + cs[(w * 4 + 3) * 64 + F.lane];
                  if (!lat) { if (F.wave == 7) outp[O_RG + ((size_t)(seq * 4 + l) * 2 + 0) * 1024 + ch] = pf * cf + hf; if (F.wave == 0) outp[O_RG + ((size_t)(seq * 4 + l) * 2 + 1) * 1024 + ch] = pb * cbk + hb; }
                  float h = cf;
                  for (int tb = 0; tb < len; tb += 16) { unsigned v[16];
#pragma unroll
                      for (int j = 0; j < 16; ++j) v[j] = AB[(size_t)(t0 + tb + j) * 1024 + ch];
#pragma unroll
                      for (int j = 0; j < 16; ++j) { h = (1.0f - bflo(v[j])) * h + bfhi(v[j]); HF[(size_t)(t0 + tb + j) * 1024 + ch] = h; } }
                  VM_WAIT();
                  h = cbk;
                  for (int tb = len - 16; tb >= 0; tb -= 16) { unsigned v[16]; float hfv[16]; bf16 xg[16];
#pragma unroll
                      for (int j = 0; j < 16; ++j) { const size_t o = (size_t)(t0 + tb + j) * 1024 + ch; v[j] = AB[(size_t)ROWS * 1024 + o]; hfv[j] = HF[o]; xg[j] = XG[o]; }
#pragma unroll
                      for (int j = 15; j >= 0; --j) { h = (1.0f - bflo(v[j])) * h + bfhi(v[j]); YRG[(size_t)(t0 + tb + j) * 1024 + ch] = (bf16)f2bf((hfv[j] + h) * bf2f(xg[j])); } }
              } }
        }
        PHASE_END(6)
        PHASE_BEGIN(8)
        {   pg8::SchedMerge S{(const char*)(ws + WS_YRG), (const char*)(ws + WS_YS5), (const char*)(ws + WS_YNA), (const char*)(ws + WS_OUTT) + (size_t)l * 3 * DM * 1024 * 2, G, c};
            pg8::EpiMerge E{(const bf16*)(ws + WS_G), (bf16*)(ws + WS_MM)};
            pg8::gemm_phase(F.lds, 1024, 1024, 1024, S, E); }
        PHASE_END(8)
#if FUSE_NORM
        PHASE_BEGIN(9)
        {   pg8::SchedPlain S{(const char*)(ws + WS_MM), (const char*)(ws + WS_WOT) + (size_t)l * DM * DM * 2, 32, 8, G, c, (size_t)256 * DM * 2, (size_t)256 * DM * 2, 1};
            unsigned* ctlw = (unsigned*)(ws + WS_CTL); const int b0 = (l * 2 + 0) * 2;
            pg8::PanelSS s1{(float*)(ws + WS_XS) + (size_t)b0 * 65536, ctlw + CW_SEAM + b0 * SEAM_BANK, ctlw + CW_TMO}, s2{(float*)(ws + WS_XS) + (size_t)(b0 + 1) * 65536, ctlw + CW_SEAM + (b0 + 1) * SEAM_BANK, ctlw + CW_TMO};
            pg8::EpiResNorm E{X, Hb, IN(11) + (size_t)l * DM, modl + 2 * DM, IN(12) + (size_t)l * DM, modl + 3 * DM, modl + 4 * DM, s1, s2, 1};
            pg8::gemm_phase(F.lds, DM, DM, DM, S, E); }
        PHASE_END(9)
#else
        PHASE_BEGIN(9)
        {   pg8::SchedPlain S{(const char*)(ws + WS_MM), (const char*)(ws + WS_WOT) + (size_t)l * DM * DM * 2, 32, 8, G, c, (size_t)256 * DM * 2, (size_t)256 * DM * 2, 1};
            pg8::EpiB16 E{(bf16*)(ws + WS_Z), DM};
            pg8::gemm_phase(F.lds, DM, DM, DM, S, E); }
        PHASE_END(9)
        PHASE_BEGIN(10)
            resnorm_rows<false, true>(F, nullptr, nullptr, X, (const bf16*)(ws + WS_Z), IN(11) + (size_t)l * DM, modl + 2 * DM, IN(12) + (size_t)l * DM, modl + 3 * DM, modl + 4 * DM, Hb);
        PHASE_END(10)
#endif
        PHASE_BEGIN(11)
        {   pg8::SchedPlain S{(const char*)Hb, (const char*)(ws + WS_FINT) + (size_t)l * 2 * FFH * DM * 2, 32, 44, G, c, (size_t)256 * DM * 2, (size_t)256 * DM * 2, DUPG9};
            pg8::EpiSwiglu E{(bf16*)(ws + WS_FH)};
            pg8::gemm_phase(F.lds, DM, DM, DM, S, E);
            __syncthreads(); static_weight_items(F, ws, l + 1, c, G, SQ_P5, SQ_P9); }
        PHASE_END(11)
#if FUSE_NORM
        PHASE_BEGIN(12)
        {   pg8::SchedPlain S{(const char*)(ws + WS_FH), (const char*)(ws + WS_FOUTT) + (size_t)l * DM * FFH * 2, 32, 8, G, c, (size_t)256 * FFH * 2, (size_t)256 * FFH * 2, DUPG10};
            unsigned* ctlw = (unsigned*)(ws + WS_CTL); const int b0 = (l * 2 + 1) * 2; const int ln = l + 1 < NL ? l + 1 : l;
            pg8::PanelSS s1{(float*)(ws + WS_XS) + (size_t)b0 * 65536, ctlw + CW_SEAM + b0 * SEAM_BANK, ctlw + CW_TMO}, s2{(float*)(ws + WS_XS) + (size_t)(b0 + 1) * 65536, ctlw + CW_SEAM + (b0 + 1) * SEAM_BANK, ctlw + CW_TMO};
            pg8::EpiResNorm E{X, Hb, IN(13) + (size_t)l * DM, modl + 5 * DM, IN(10) + (size_t)ln * DM, MOD + (size_t)ln * NCV * INW + 0 * DM, MOD + (size_t)ln * NCV * INW + 1 * DM, s1, s2, (l + 1 < NL) ? 1 : 0};
            pg8::gemm_phase(F.lds, FFH, FFH, FFH, S, E); }
        PHASE_END(12)
#else
        PHASE_BEGIN(12)
        {   pg8::SchedPlain S{(const char*)(ws + WS_FH), (const char*)(ws + WS_FOUTT) + (size_t)l * DM * FFH * 2, 32, 8, G, c, (size_t)256 * FFH * 2, (size_t)256 * FFH * 2, DUPG10};
            pg8::EpiB16 E{(bf16*)(ws + WS_Z), DM};
            pg8::gemm_phase(F.lds, FFH, FFH, FFH, S, E); }
        PHASE_END(12)
        PHASE_BEGIN(13)
            if (l + 1 < NL) resnorm_rows<false, true>(F, nullptr, nullptr, X, (const bf16*)(ws + WS_Z), IN(13) + (size_t)l * DM, modl + 5 * DM, IN(10) + (size_t)(l + 1) * DM, modl + NCV * INW + 0 * DM, modl + NCV * INW + 1 * DM, Hb);
            else resnorm_rows<false, false>(F, nullptr, nullptr, X, (const bf16*)(ws + WS_Z), IN(13) + (size_t)l * DM, modl + 5 * DM, nullptr, nullptr, nullptr, Hb);
        PHASE_END(13)
#endif
    }
#if DBG_KEEP
    PHASE_BEGIN(14)
        for (size_t i = (size_t)gt; i < O_END; i += (size_t)NGT) {
            int r, lay = 0;
            if (i < O_K) r = i < O_K / 2 ? 0 : 1;
            else if (i < O_V) { r = 2; lay = (int)(((i - O_K) / (256 * 1024)) & 3); }
            else if (i < O_RG) { r = 3; lay = (int)(((i - O_V) / (256 * 1024)) & 3); }
            else if (i < O_S5) { r = 4; lay = (int)(((i - O_RG) / 2048) & 3); }
            else { r = 5; lay = (int)(((i - O_S5) / 16384) & 3); }
            const bool keep = ((DBG_KEEP >> r) & 1) && (r < 2 || ((DBG_LMASK >> lay) & 1));
            float v = keep ? 3.0f * outp[i] : 0.0f;
#if DBG_DUMP
            v = 0.f;
            if (i >= O_K && i < O_K + (size_t)ROWS * 1024) { const size_t j = i - O_K;
                if (DBG_DUMP == 1) v = bf2f(((const bf16*)(ws + WS_YNA))[j]);
                if (DBG_DUMP == 2) v = bf2f(((const bf16*)(ws + WS_YS5))[j]);
                if (DBG_DUMP == 3) v = bf2f(((const bf16*)(ws + WS_YRG))[j]);
                if (DBG_DUMP == 4) v = bf2f(((const bf16*)(ws + WS_ZS))[j]);
                if (DBG_DUMP == 5) v = bf2f(((const bf16*)(ws + WS_MM))[j]);
                if (DBG_DUMP == 6) v = ((const bf16*)(ws + WS_Z))[j];
                if (DBG_DUMP == 7) v = bf2f(((const bf16*)(ws + WS_FH))[j]);
                if (DBG_DUMP == 8) v = bf2f(((const bf16*)(ws + WS_H))[j]);
                if (DBG_DUMP == 9) v = bf2f(((const bf16*)(ws + WS_G))[j]);
                if (DBG_DUMP == 11) v = bf2f(((const bf16*)(ws + WS_G))[(size_t)8192 * 6144 + j]);
                if (DBG_DUMP == 10) v = bf2f(((const bf16*)(ws + WS_WINT))[(size_t)6144 * 2048 + j]);
            }
#endif
            outp[i] = v;
        }
    PHASE_END(14)
#endif
    if (TSEL >= 0 && blockIdx.x == 0 && threadIdx.x == 0) { const float us = (float)(*(volatile LAS unsigned long long*)(MISC0 + 18)) * 0.01f; out0[0] = exp2f(rintf(log2f(us) * 10.0f) * 0.1f); }
#undef PHASE_BEGIN
#undef PHASE_END
}
constexpr int N_PHASES = 3 + DBG_NL * (FUSE_NORM ? 8 : 10) + (DBG_KEEP ? 1 : 0);

extern "C" void kernel_launch(void* const* d_in, const int* in_sizes, int n_in, void* d_out, int out_size, void* d_ws, size_t ws_size, hipStream_t stream) {
    static int grid = 0;
    if (grid == 0) {
        if (n_in != 36 || out_size != (int)O_END || ws_size < WS_END) { fprintf(stderr, "kernel_launch: unexpected shapes (n_in %d out %d ws %zu)\n", n_in, out_size, ws_size); grid = -1; return; }
        int dev = 0, cus = 0, per_cu = 0;
        if (hipGetDevice(&dev) != hipSuccess || hipDeviceGetAttribute(&cus, hipDeviceAttributeMultiprocessorCount, dev) != hipSuccess) { grid = -1; return; }
        if (hipFuncSetAttribute((const void*)fwd_kernel, hipFuncAttributeMaxDynamicSharedMemorySize, LDS_BYTES) != hipSuccess) { fprintf(stderr, "kernel_launch: hipFuncSetAttribute failed\n"); grid = -1; return; }
        if (hipOccupancyMaxActiveBlocksPerMultiprocessor(&per_cu, (const void*)fwd_kernel, NWAVES * 64, LDS_BYTES) != hipSuccess || per_cu < 1) { fprintf(stderr, "kernel_launch: occupancy query reports %d blocks per CU\n", per_cu); }
        (void)hipGetLastError();
        grid = cus;
        if (FUSE_NORM && cus != 256) { fprintf(stderr, "kernel_launch: the fused residual+norm epilogues need exactly 256 workgroups (one 256x256 tile each); build with -DFUSE_NORM=0 for %d CUs\n", cus); grid = -1; return; }
    }
    if (grid < 0) return;
    if (hipMemsetAsync((char*)d_ws + WS_CTL, 0, CTL_ZERO_BYTES, stream) != hipSuccess) return;
    Args a{};
    for (int i = 0; i < 36; ++i) a.in[i] = (const float*)d_in[i];
    a.out = (float*)d_out; a.ws = (unsigned char*)d_ws;
    if (MK_N_LAUNCHES == 1) { a.ph_lo = 0; a.ph_hi = N_PHASES; hipLaunchKernelGGL(fwd_kernel, dim3(grid), dim3(NWAVES * 64), LDS_BYTES, stream, a); }
    else for (int p = 0; p < N_PHASES; ++p) { a.ph_lo = p; a.ph_hi = p + 1; hipLaunchKernelGGL(fwd_kernel, dim3(grid), dim3(NWAVES * 64), LDS_BYTES, stream, a); }
}
```

```cpp
#include <hip/hip_runtime.h>
#include <hip/hip_bf16.h>
#include <cstdio>
#include <cstdint>

#ifndef MK_N_LAUNCHES
#define MK_N_LAUNCHES 1
#endif
#ifndef DBG_KEEP
#define DBG_KEEP 0
#endif
#ifndef DUP_SCAN
#define DUP_SCAN 1
#endif
#ifndef DUP_ATT
#define DUP_ATT 1
#endif
#ifndef DUP_CARRY
#define DUP_CARRY 1
#endif
#ifndef DUP_CONV
#define DUP_CONV 1
#endif
#ifndef DUP_RGG
#define DUP_RGG 1
#endif
#ifndef DUP_S5
#define DUP_S5 1
#endif
#ifndef TSEL
#define TSEL (-1)
#endif
#ifndef DUPG1
#define DUPG1 1
#endif
#ifndef DUPG6
#define DUPG6 1
#endif
#ifndef DUPG9
#define DUPG9 1
#endif
#ifndef DUPG10
#define DUPG10 1
#endif
#ifndef DUP_GEMM
#define DUP_GEMM 1
#endif
#ifndef DUP_MASK
#define DUP_MASK 0u
#endif
#ifndef DBG_LMASK
#define DBG_LMASK 15
#endif
#ifndef DBG_DUMP
#define DBG_DUMP 0
#endif
#ifndef DBG_NL
#define DBG_NL 4
#endif

constexpr int DM = 2048, ROWS = 8192, CTXR = 4096, INW = 12288, FFH = 5632, NL = 4, W1K = 1024;
constexpr int NCV = 5;
constexpr float RMS_EPS = 1e-6f;
constexpr size_t MiB = 1u << 20;

constexpr size_t O_X = 0, O_K = 16777216, O_V = 33554432, O_RG = 50331648, O_S5 = 50462720, O_END = 51511296;

constexpr size_t WS_CTL = 0, CTL_ZERO_BYTES = 1 * MiB;
constexpr size_t WS_MODP = 1 * MiB;
constexpr size_t WS_MOD  = 17 * MiB;
constexpr size_t WS_SP   = 18 * MiB;
constexpr size_t WS_LT   = 18 * MiB + 65536;
constexpr size_t WS_GWT  = 19 * MiB;
constexpr size_t WS_WINT = 24 * MiB;
constexpr size_t WS_GLUT = 216 * MiB;
constexpr size_t WS_OUTT = 224 * MiB;
constexpr size_t WS_WOT  = 272 * MiB;
constexpr size_t WS_FINT = 304 * MiB;
constexpr size_t WS_FOUTT = 480 * MiB;
constexpr size_t WS_MT   = 568 * MiB;
constexpr size_t WS_ET   = 600 * MiB;
constexpr size_t WS_FT   = 632 * MiB;
constexpr size_t WS_CK   = 664 * MiB;
constexpr size_t WS_CV   = 680 * MiB;
constexpr size_t WS_H    = 696 * MiB;
constexpr size_t WS_XR   = 728 * MiB;
constexpr size_t WS_XG   = 744 * MiB;
constexpr size_t WS_XC   = 760 * MiB;
constexpr size_t WS_Q    = 776 * MiB;
constexpr size_t WS_K    = 792 * MiB;
constexpr size_t WS_V    = 808 * MiB;
constexpr size_t WS_YRG  = 824 * MiB;
constexpr size_t WS_YS5  = 840 * MiB;
constexpr size_t WS_YNA  = 856 * MiB;
constexpr size_t WS_ZS   = 872 * MiB;
constexpr size_t WS_UG   = 888 * MiB;
constexpr size_t WS_HIN  = 904 * MiB;
constexpr size_t WS_G    = 920 * MiB;
constexpr size_t WS_AB   = 1016 * MiB;
constexpr size_t WS_FH   = 1016 * MiB;
constexpr size_t WS_HF   = 1144 * MiB;
constexpr size_t WS_HLOC = 1176 * MiB;
constexpr size_t WS_Z    = 1144 * MiB;
constexpr size_t WS_MM   = 1208 * MiB;
constexpr size_t WS_XS   = 1240 * MiB;
constexpr size_t WS_XB   = 1244 * MiB;
constexpr size_t WS_END  = 1276 * MiB;

constexpr int CW_TMO = 0, CW_BAR = 4096;
constexpr int CW_SEAM = 16384, SEAM_BANK = 32 * 64;
#ifndef XRES_BF16
#define XRES_BF16 1
#endif
#ifndef FUSE_NORM
#define FUSE_NORM 0
#endif

constexpr int RING_BYTES = 131072;
constexpr int LDSCTL_OFF = RING_BYTES, MISC_OFF = LDSCTL_OFF + 320;
constexpr int LDS_BYTES = 147456;

#define GAS __attribute__((address_space(1)))
#define LAS __attribute__((address_space(3)))
typedef unsigned short bf16;
typedef unsigned v4u __attribute__((ext_vector_type(4)));
typedef unsigned v2u __attribute__((ext_vector_type(2)));
typedef float f32x4 __attribute__((ext_vector_type(4)));
typedef float f32x2 __attribute__((ext_vector_type(2)));
typedef short bf16x8 __attribute__((ext_vector_type(8)));
typedef GAS unsigned gu32;
#define RLX_AGENT __ATOMIC_RELAXED, __HIP_MEMORY_SCOPE_AGENT
#define LDS_WAIT() asm volatile("s_waitcnt lgkmcnt(0)" ::: "memory")
#define VM_WAIT() asm volatile("s_waitcnt vmcnt(0)" ::: "memory")

__device__ __forceinline__ unsigned f2bf(float f) { unsigned u = __builtin_bit_cast(unsigned, f); return (u + 0x7fffu + ((u >> 16) & 1u)) >> 16; }
typedef __bf16 bf16x2_t __attribute__((ext_vector_type(2)));
__device__ __forceinline__ unsigned pk2(float lo, float hi) { const f32x2 v = {lo, hi}; const bf16x2_t b = __builtin_convertvector(v, bf16x2_t); return __builtin_bit_cast(unsigned, b); }
__device__ __forceinline__ float bflo(unsigned w) { return __builtin_bit_cast(float, w << 16); }
__device__ __forceinline__ float bfhi(unsigned w) { return __builtin_bit_cast(float, w & 0xffff0000u); }
__device__ __forceinline__ float bf2f(bf16 h) { return __builtin_bit_cast(float, (unsigned)h << 16); }
__device__ __forceinline__ float fsigmoid(float x) { return __builtin_amdgcn_rcpf(1.0f + __expf(-x)); }
__device__ __forceinline__ float gelu_tanh(float x) { const float y = 0.7978845608028654f * (x + 0.044715f * x * x * x); return x * __builtin_amdgcn_rcpf(1.0f + __expf(-2.0f * y)); }
__device__ __forceinline__ float wave_sum(float v, int lane) {
#pragma unroll
    for (int o = 1; o < 64; o <<= 1) v += __builtin_bit_cast(float, __builtin_amdgcn_ds_bpermute((lane ^ o) << 2, __builtin_bit_cast(int, v)));
    return v;
}
__device__ __forceinline__ void unpack8(const v4u w, float (&f)[8]) { f[0] = bflo(w.x); f[1] = bfhi(w.x); f[2] = bflo(w.y); f[3] = bfhi(w.y); f[4] = bflo(w.z); f[5] = bfhi(w.z); f[6] = bflo(w.w); f[7] = bfhi(w.w); }
__device__ __forceinline__ v4u pack8(const float (&f)[8]) { v4u w; w.x = pk2(f[0], f[1]); w.y = pk2(f[2], f[3]); w.z = pk2(f[4], f[5]); w.w = pk2(f[6], f[7]); return w; }

#define XB_TMO      128
#define XB_XCNT(j)  (256  + 64 * (j))
#define XB_XSUB(j)  (1280 + 64 * (j))
#define XB_XGEN(j)  (2304 + 64 * (j))
#define XB_TOP      3328
#define XB_TOPGEN   3392
#define XCD_BAR_WORDS 3456
#define XB_SPIN_CAP (1u << 18)
__device__ __forceinline__ unsigned xb_ld(unsigned* p)              { return __hip_atomic_load(p, __ATOMIC_RELAXED, __HIP_MEMORY_SCOPE_AGENT); }
__device__ __forceinline__ unsigned xb_add(unsigned* p, unsigned v) { return __hip_atomic_fetch_add(p, v, __ATOMIC_RELAXED, __HIP_MEMORY_SCOPE_AGENT); }
__device__ __forceinline__ unsigned xb_xcc_id() { return (unsigned)__builtin_amdgcn_s_getreg((3 << 11) | 20) & 0xFu; }
#define XB_SPIN(cond, bar) do { unsigned _sp = 0; while (cond) { __builtin_amdgcn_s_sleep(1); \
    if ((++_sp & 255u) == 0u) { if (xb_ld(&(bar)[XB_TMO])) break; if (_sp > XB_SPIN_CAP) { atomicAdd(&(bar)[XB_TMO], 1u); break; } } } } while (0)
struct XcdBarrier { unsigned* bar; unsigned x; volatile LAS unsigned* st; };
__device__ __forceinline__ XcdBarrier xcd_barrier_post(unsigned* bar, volatile LAS unsigned* st) {
    XcdBarrier b; b.bar = bar; b.x = xb_xcc_id(); b.st = st;
    if (threadIdx.x == 0) (void)xb_add(&bar[XB_XCNT(b.x)], 1u);
    return b;
}
__device__ __forceinline__ void xcd_barrier_complete(unsigned* bar, unsigned x, unsigned& nloc, unsigned& nx) {
    const unsigned G = gridDim.x * gridDim.y * gridDim.z;
    unsigned sum, cnt, mine, sp = 0u;
    for (;;) {
        sum = 0u; cnt = 0u; mine = 0u;
#pragma unroll
        for (unsigned j = 0; j < 16; ++j) { const unsigned c = xb_ld(&bar[XB_XCNT(j)]); sum += c; cnt += (c > 0u) ? 1u : 0u; mine = (j == x) ? c : mine; }
        if (sum == G) break;
        __builtin_amdgcn_s_sleep(1);
        if ((++sp & 255u) == 0u) { if (xb_ld(&bar[XB_TMO])) break; if (sp > XB_SPIN_CAP) { atomicAdd(&bar[XB_TMO], 1u); break; } }
    }
    nloc = mine > 0u ? mine : 1u; nx = cnt > 0u ? cnt : 1u;
}
__device__ __forceinline__ void xcd_barrier(const XcdBarrier& b) {
    asm volatile("s_waitcnt vmcnt(0)" ::: "memory");
    __syncthreads();
    int tid_b = threadIdx.x; asm volatile("" : "+v"(tid_b));
    if (tid_b == 0) {
        unsigned* bar = b.bar;
        __builtin_amdgcn_s_waitcnt(0);
        unsigned nloc = b.st[0], nx = b.st[1];
        if (nloc == 0u) { xcd_barrier_complete(bar, b.x, nloc, nx); b.st[0] = nloc; b.st[1] = nx; }
        const unsigned old = xb_add(&bar[XB_XSUB(b.x)], 1u);
        const unsigned gen = old / nloc;
        if (old + 1u == (gen + 1u) * nloc) {
            __builtin_amdgcn_fence(__ATOMIC_RELEASE, "agent");
            asm volatile("s_waitcnt vmcnt(0)" ::: "memory");
            const unsigned og = xb_add(&bar[XB_TOP], 1u);
            const unsigned tg = og / nx;
            if (og + 1u == (tg + 1u) * nx) xb_add(&bar[XB_TOPGEN], 1u);
            else XB_SPIN(xb_ld(&bar[XB_TOPGEN]) == tg, bar);
            __builtin_amdgcn_fence(__ATOMIC_ACQUIRE, "agent");
            xb_add(&bar[XB_XGEN(b.x)], 1u);
            asm volatile("s_waitcnt vmcnt(0)" ::: "memory");
        } else {
            XB_SPIN(xb_ld(&bar[XB_XGEN(b.x)]) == gen, bar);
            __builtin_amdgcn_fence(__ATOMIC_ACQUIRE, "agent");
            asm volatile("s_waitcnt vmcnt(0)" ::: "memory");
        }
    }
    __syncthreads();
}

namespace pg8 {
#define PG8_LAS __attribute__((address_space(3)))
constexpr int BM = 256, BK = 64, HALF = 128, HTB = HALF * BK * 2, STAGE_BYTES = 8 * HTB;
__host__ __device__ __forceinline__ int lds_byte(int r, int c) { const int st = (r >> 4) * 2 + (c >> 5), rr = r & 15, cc = c & 31, ob = rr * 64 + cc * 2; return st * 1024 + (ob ^ (((ob >> 9) & 1) << 5)); }
__host__ __device__ __forceinline__ void stage_rc(int b, int& R, int& C) { const int st = b / 1024, sb = b % 1024, swz = sb ^ (((sb >> 9) & 1) << 5); R = (st >> 1) * 16 + swz / 64; C = (st & 1) * 32 + (swz % 64) / 2; }
__host__ __device__ __forceinline__ int perm32(int rho) { const int n = rho >> 4, i = rho & 15; return 8 * (i >> 2) + 4 * n + (i & 3); }

struct Unit { const char* A; const char* B; int pm, pn, aux, last; };

__device__ __forceinline__ bool tile_order(long L, int nM, int nN, int& pm, int& pn) {
    const int nwg = nM * nN; if (L >= nwg) return false;
    int wgid = (int)L; { const int q = nwg / 8, r = nwg % 8, xcd = wgid % 8, off = wgid / 8; wgid = (xcd < r ? xcd * (q + 1) : r * (q + 1) + (xcd - r) * q) + off; }
    const int nig = 8 * nN, gid = wgid / nig, fm = gid * 8, gsz = (nM - fm) < 8 ? (nM - fm) : 8;
    pm = fm + ((wgid % nig) % gsz); pn = (wgid % nig) / gsz; return true;
}

typedef float f32x4 __attribute__((ext_vector_type(4)));
typedef short bf16x8 __attribute__((ext_vector_type(8)));

template <class Epi, class Sched>
__device__ __forceinline__ void gemm_phase(PG8_LAS unsigned char* lds, const int K, const int lda, const int ldb, const Sched& S, const Epi& E) {
    int tid_ = threadIdx.x; asm volatile("" : "+v"(tid_));
    const int tid = tid_, wid = __builtin_amdgcn_readfirstlane(tid >> 6), lane = tid & 63, wr = wid >> 2, wc = wid & 3, fr = lane & 15, fq = lane >> 4;
    const int nt = K / BK;
    unsigned voffA[2], voffB[2];
#pragma unroll
    for (int i = 0; i < 2; ++i) { int R, C; stage_rc(tid * 16 + i * 8192, R, C); const int Rb = Epi::PERM ? ((R & ~31) + perm32(R & 31)) : R;
        voffA[i] = (unsigned)(R * lda + C) * 2u; voffB[i] = (unsigned)(Rb * ldb + C) * 2u; }
    const size_t kstep = (size_t)(BK * 2);
    const size_t hstepA = (size_t)HALF * lda * 2, hstepB = (size_t)HALF * ldb * 2;
    const unsigned ldsw = (unsigned)wid * 1024u;
    const int aoff = lds_byte(wr * 64 + fr, fq * 8), boff = lds_byte(wc * 32 + fr, fq * 8);
#define PG8_SA(b, h) (((b) * 2 + (h)) * HTB)
#define PG8_SB(b, h) ((4 + (b) * 2 + (h)) * HTB)
#define PG8_STAGE(bufoff, gbase, voff) do { _Pragma("unroll") for (int _i = 0; _i < 2; ++_i) \
        __builtin_amdgcn_global_load_lds((const unsigned*)((const char*)(gbase) + (voff)[_i]), (PG8_LAS unsigned*)(lds + (bufoff) + ldsw + _i * 8192), 16, 0, 0); } while (0)
#define PG8_LDA(dst, b, h) do { _Pragma("unroll") for (int m = 0; m < 4; ++m) _Pragma("unroll") for (int k = 0; k < 2; ++k) dst[m][k] = *(const PG8_LAS bf16x8*)(lds + PG8_SA(b, h) + aoff + m * 2048 + k * 1024); } while (0)
#define PG8_LDB(dst, b, h) do { _Pragma("unroll") for (int n = 0; n < 2; ++n) _Pragma("unroll") for (int k = 0; k < 2; ++k) dst[n][k] = *(const PG8_LAS bf16x8*)(lds + PG8_SB(b, h) + boff + n * 2048 + k * 1024); } while (0)
#define PG8_MMA(ai, bj, At, Bt) do { __builtin_amdgcn_s_setprio(1); _Pragma("unroll") for (int m = 0; m < 4; ++m) _Pragma("unroll") for (int n = 0; n < 2; ++n) _Pragma("unroll") for (int k = 0; k < 2; ++k) \
        acc[ai][bj][m][n] = __builtin_amdgcn_mfma_f32_16x16x32_bf16(Bt[n][k], At[m][k], acc[ai][bj][m][n], 0, 0, 0); __builtin_amdgcn_s_setprio(0); } while (0)
#define PG8_WAIT_V(n) asm volatile("s_waitcnt vmcnt(" #n ")" ::: "memory")
#define PG8_WAIT_L(n) asm volatile("s_waitcnt lgkmcnt(" #n ")" ::: "memory")
#define PG8_BAR __builtin_amdgcn_s_barrier()
#define PG8_SCHED __builtin_amdgcn_sched_barrier(0)
    Unit cur, nxt; int ui = 0;
    if (!S.next(0, cur)) return;
    f32x4 acc[2][2][4][2];
#pragma unroll
    for (int a = 0; a < 2; ++a)
#pragma unroll
        for (int b = 0; b < 2; ++b)
#pragma unroll
            for (int m = 0; m < 4; ++m)
#pragma unroll
                for (int n = 0; n < 2; ++n) acc[a][b][m][n] = (f32x4){0.f, 0.f, 0.f, 0.f};
    bf16x8 At[4][2], B0[2][2], B1[2][2];
    const char* cA = cur.A; const char* cB = cur.B;
    PG8_STAGE(PG8_SB(0, 0), cB, voffB); PG8_STAGE(PG8_SB(0, 1), cB + hstepB, voffB); PG8_STAGE(PG8_SA(0, 0), cA, voffA); PG8_STAGE(PG8_SA(0, 1), cA + hstepA, voffA);
    if (wr == 1) PG8_BAR;
    PG8_WAIT_V(2); PG8_BAR;
    PG8_STAGE(PG8_SB(1, 0), cB + kstep, voffB); PG8_STAGE(PG8_SA(1, 0), cA + kstep, voffA); PG8_STAGE(PG8_SB(1, 1), cB + hstepB + kstep, voffB);
    PG8_WAIT_V(6); PG8_BAR;
    for (;;) {
        const bool has_next = S.next(ui + 1, nxt);
        const char* nA = has_next ? nxt.A : cA; const char* nB = has_next ? nxt.B : cB;
#pragma unroll 1
        for (int t = 0; t < nt; t += 2) {
            const bool last = (t == nt - 2);
            const char* a1 = cA + (size_t)(t + 1) * kstep;
            const char* a2 = last ? nA : cA + (size_t)(t + 2) * kstep; const char* b2 = last ? nB : cB + (size_t)(t + 2) * kstep;
            const char* a3 = a2 + kstep; const char* b3 = b2 + kstep;
            PG8_LDB(B0, 0, 0); PG8_LDB(B1, 0, 1); PG8_SCHED; PG8_LDA(At, 0, 0); PG8_STAGE(PG8_SA(1, 1), a1 + hstepA, voffA);
            PG8_WAIT_V(8); PG8_WAIT_L(0); PG8_BAR; PG8_MMA(0, 0, At, B0); PG8_MMA(0, 1, At, B1); PG8_BAR; PG8_SCHED;
            PG8_LDA(At, 0, 1); PG8_STAGE(PG8_SB(0, 0), b2, voffB); PG8_STAGE(PG8_SB(0, 1), b2 + hstepB, voffB); PG8_STAGE(PG8_SA(0, 0), a2, voffA);
            PG8_WAIT_V(8); PG8_WAIT_L(0); PG8_BAR; PG8_MMA(1, 0, At, B0); PG8_MMA(1, 1, At, B1); PG8_BAR; PG8_SCHED;
            PG8_LDB(B0, 1, 0); PG8_LDB(B1, 1, 1); PG8_SCHED; PG8_LDA(At, 1, 0); PG8_STAGE(PG8_SA(0, 1), a2 + hstepA, voffA);
            PG8_WAIT_V(8); PG8_WAIT_L(0); PG8_BAR; PG8_MMA(0, 0, At, B0); PG8_MMA(0, 1, At, B1); PG8_BAR; PG8_SCHED;
            PG8_LDA(At, 1, 1); PG8_STAGE(PG8_SB(1, 0), b3, voffB); PG8_STAGE(PG8_SB(1, 1), b3 + hstepB, voffB); PG8_STAGE(PG8_SA(1, 0), a3, voffA);
            PG8_WAIT_V(8); PG8_WAIT_L(0); PG8_BAR; PG8_MMA(1, 0, At, B0); PG8_MMA(1, 1, At, B1); PG8_BAR; PG8_SCHED;
        }
        if (wr == 0) PG8_BAR;
        if (cur.last) { if constexpr (!Epi::AFTER_DRAIN) E(acc, cur, wr, wc, fr, fq); } else E.mid(acc, cur, wr, wc, fr, fq);
        if (!has_next) break;
        if (cur.last) {
#pragma unroll
            for (int a = 0; a < 2; ++a)
#pragma unroll
                for (int b = 0; b < 2; ++b)
#pragma unroll
                    for (int m = 0; m < 4; ++m)
#pragma unroll
                        for (int n = 0; n < 2; ++n) acc[a][b][m][n] = (f32x4){0.f, 0.f, 0.f, 0.f};
        }
        cur = nxt; cA = nA; cB = nB; ++ui;
        if (wr == 1) PG8_BAR;
    }
    PG8_WAIT_V(0);
    PG8_BAR;
    if constexpr (Epi::AFTER_DRAIN) E.fused(acc, cur, wr, wc, fr, fq, lds, wid, lane);
#undef PG8_SA
#undef PG8_SB
#undef PG8_STAGE
#undef PG8_LDA
#undef PG8_LDB
#undef PG8_MMA
#undef PG8_WAIT_V
#undef PG8_WAIT_L
#undef PG8_BAR
#undef PG8_SCHED
}

typedef const f32x4 (&AccC)[2][2][4][2];
typedef f32x4 (&AccM)[2][2][4][2];
#define EPI_ROWS_BEGIN _Pragma("unroll") for (int ai = 0; ai < 2; ++ai) _Pragma("unroll") for (int m = 0; m < 4; ++m) { const int row = u.pm * 256 + ai * 128 + wr * 64 + m * 16 + fr;
#define EPI_ROWS_END }

#define EPI_NO_MID static constexpr bool AFTER_DRAIN = false; __device__ __forceinline__ void mid(AccM, const Unit&, int, int, int, int) const {} __device__ __forceinline__ void fused(AccM, const Unit&, int, int, int, int, PG8_LAS unsigned char*, int, int) const {}

struct EpiB16 {
    EPI_NO_MID
    static constexpr bool PERM = true;
    bf16* O; int ldc;
    __device__ __forceinline__ void operator()(AccC acc, const Unit& u, int wr, int wc, int fr, int fq) const {
        const int col0 = u.pn * 256 + wc * 32 + 8 * fq;
        EPI_ROWS_BEGIN
#pragma unroll
            for (int bj = 0; bj < 2; ++bj) { const f32x4 v0 = acc[ai][bj][m][0], v1 = acc[ai][bj][m][1]; const float f[8] = {v0[0], v0[1], v0[2], v0[3], v1[0], v1[1], v1[2], v1[3]};
                *(GAS v4u*)(O + (size_t)row * ldc + col0 + bj * 128) = pack8(f); }
        EPI_ROWS_END
    }
};
struct EpiHloc {
    EPI_NO_MID
    static constexpr bool PERM = false;
    float* O;
    __device__ __forceinline__ void operator()(AccC acc, const Unit& u, int wr, int wc, int fr, int fq) const {
        const int col0 = wc * 32 + 4 * fq; float* base = O + (size_t)u.aux * 512 * 256;
        EPI_ROWS_BEGIN
            float* rowp = base + (size_t)row * 256 + col0;
#pragma unroll
            for (int bj = 0; bj < 2; ++bj)
#pragma unroll
                for (int n = 0; n < 2; ++n) *(GAS f32x4*)(rowp + bj * 128 + n * 16) = acc[ai][bj][m][n];
        EPI_ROWS_END
    }
};
struct EpiWin {
    EPI_NO_MID
    static constexpr bool PERM = true;
    bf16 *XR, *XG, *UG, *Q, *Kb, *Vb, *G; float *outK, *outV;
    __device__ __forceinline__ void operator()(AccC acc, const Unit& u, int wr, int wc, int fr, int fq) const {
        const int pn = u.pn, seg = pn >> 2;
        const int cseg = (pn & 3) * 256 + wc * 32 + 8 * fq;
        EPI_ROWS_BEGIN
#pragma unroll
            for (int bj = 0; bj < 2; ++bj) {
                const f32x4 v0 = acc[ai][bj][m][0], v1 = acc[ai][bj][m][1];
                float f[8] = {v0[0], v0[1], v0[2], v0[3], v1[0], v1[1], v1[2], v1[3]};
                const int c = cseg + bj * 128;
                if (seg >= 6) {
#pragma unroll
                    for (int e = 0; e < 8; ++e) f[e] = fsigmoid(f[e]);
                    *(GAS v4u*)(G + (size_t)row * 6144 + (pn - 24) * 256 + wc * 32 + 8 * fq + bj * 128) = pack8(f);
                } else if (seg == 1) {
#pragma unroll
                    for (int e = 0; e < 8; ++e) f[e] = gelu_tanh(f[e]);
                    *(GAS v4u*)(XG + (size_t)row * 1024 + c) = pack8(f);
                } else if (seg == 2) {
                    const int g = c >> 4, m0 = c & 15;
                    *(GAS v4u*)(UG + ((size_t)g * 512 + (row >> 4)) * 256 + (row & 15) * 16 + m0) = pack8(f);
                } else {
                    bf16* dst = seg == 0 ? XR : (seg == 3 ? Q : (seg == 4 ? Kb : Vb));
                    *(GAS v4u*)(dst + (size_t)row * 1024 + c) = pack8(f);
                    if (seg >= 4 && row < CTXR) {
                        float* o = (seg == 4 ? outK : outV) + ((size_t)(row >> 8) * 4 * 256 + (row & 255)) * 1024 + c;
                        *(f32x4*)o = v0; *(GAS f32x4*)(o + 4) = v1;
                    }
                }
            }
        EPI_ROWS_END
    }
};
struct EpiRg {
    EPI_NO_MID
    static constexpr bool PERM = true;
    const bf16* XC; const float* gb; const float* sp; f32x2* AB;
    __device__ __forceinline__ void operator()(AccC acc, const Unit& u, int wr, int wc, int fr, int fq) const {
        const int h = u.aux >> 1, d = u.aux & 1, c0 = h * 128 + wc * 32 + 8 * fq;
        const GAS float* gbr = (const GAS float*)(gb + (d * 2 + 0) * 1024 + c0); const GAS float* gbi = (const GAS float*)(gb + (d * 2 + 1) * 1024 + c0); const GAS float* spp = (const GAS float*)(sp + d * 1024 + c0);
        EPI_ROWS_BEGIN
            float xc[8]; unpack8(*(const GAS v4u*)(XC + (size_t)row * 1024 + c0), xc);
            const f32x4 r0 = acc[ai][0][m][0], r1 = acc[ai][0][m][1], i0 = acc[ai][1][m][0], i1 = acc[ai][1][m][1];
            const float rr[8] = {r0[0], r0[1], r0[2], r0[3], r1[0], r1[1], r1[2], r1[3]}, ii[8] = {i0[0], i0[1], i0[2], i0[3], i1[0], i1[1], i1[2], i1[3]};
            unsigned* dst = (unsigned*)AB + ((size_t)d * ROWS + row) * 1024 + c0;
            v4u o0, o1; unsigned w[8];
#pragma unroll
            for (int e = 0; e < 8; ++e) {
                const float r = fsigmoid(rr[e] + gbr[e]), ig = fsigmoid(ii[e] + gbi[e]);
                const float la = -8.0f * r * spp[e]; const float a = __expf(la); const float om = 1.0f - a; const float mult = __builtin_amdgcn_sqrtf(om * (1.0f + a));
                w[e] = pk2(om, mult * ig * xc[e]);
            }
            o0.x = w[0]; o0.y = w[1]; o0.z = w[2]; o0.w = w[3]; o1.x = w[4]; o1.y = w[5]; o1.z = w[6]; o1.w = w[7];
            *(GAS v4u*)dst = o0; *(GAS v4u*)(dst + 4) = o1;
            asm volatile("" ::: "memory");
        EPI_ROWS_END
    }
};
struct EpiS5Y {
    EPI_NO_MID
    static constexpr bool PERM = true;
    const bf16* UG; const float* dvec; bf16* ZS;
    __device__ __forceinline__ void operator()(AccC acc, const Unit& u, int wr, int wc, int fr, int fq) const {
        const int g = u.aux;
        EPI_ROWS_BEGIN
#pragma unroll
            for (int bj = 0; bj < 2; ++bj) {
                const int col = bj * 128 + wc * 32 + 8 * fq, t = col >> 4, n0 = col & 15;
                float uu[8]; unpack8(*(const GAS v4u*)(UG + ((size_t)g * 512 + row) * 256 + col), uu);
                const f32x4 v0 = acc[ai][bj][m][0], v1 = acc[ai][bj][m][1];
                float f[8] = {v0[0], v0[1], v0[2], v0[3], v1[0], v1[1], v1[2], v1[3]};
#pragma unroll
                for (int e = 0; e < 8; ++e) f[e] = gelu_tanh(f[e] + ((const GAS float*)dvec)[g * 16 + n0 + e] * uu[e]);
                *(GAS v4u*)(ZS + ((size_t)row * 16 + t) * 1024 + g * 16 + n0) = pack8(f);
            }
        EPI_ROWS_END
    }
};
struct EpiGlu {
    EPI_NO_MID
    static constexpr bool PERM = true;
    const bf16* ZS; bf16* Y;
    __device__ __forceinline__ void operator()(AccC acc, const Unit& u, int wr, int wc, int fr, int fq) const {
        const int col0 = u.pn * 256 + wc * 32 + 8 * fq;
        EPI_ROWS_BEGIN
#pragma unroll
            for (int bj = 0; bj < 2; ++bj) {
                float z[8]; unpack8(*(const GAS v4u*)(ZS + (size_t)row * 1024 + col0 + bj * 128), z);
                const f32x4 v0 = acc[ai][bj][m][0], v1 = acc[ai][bj][m][1];
                float f[8] = {v0[0], v0[1], v0[2], v0[3], v1[0], v1[1], v1[2], v1[3]};
#pragma unroll
                for (int e = 0; e < 8; ++e) f[e] = z[e] * fsigmoid(f[e]);
                *(GAS v4u*)(Y + (size_t)row * 1024 + col0 + bj * 128) = pack8(f);
            }
        EPI_ROWS_END
    }
};
struct EpiMerge {
    static constexpr bool PERM = true, AFTER_DRAIN = false;
    __device__ __forceinline__ void fused(AccM, const Unit&, int, int, int, int, PG8_LAS unsigned char*, int, int) const {}
    const bf16* G; bf16* MM;
    __device__ __forceinline__ void mid(AccM acc, const Unit& u, int wr, int wc, int fr, int fq) const {
        const int col0 = u.pn * 256 + wc * 32 + 8 * fq, b = u.aux;
        EPI_ROWS_BEGIN
#pragma unroll
            for (int bj = 0; bj < 2; ++bj) {
                float ga[8], gn[8]; unpack8(*(const GAS v4u*)(G + (size_t)row * 6144 + b * 2048 + col0 + bj * 128), ga); unpack8(*(const GAS v4u*)(G + (size_t)row * 6144 + (b + 1) * 2048 + col0 + bj * 128), gn);
#pragma unroll
                for (int e = 0; e < 8; ++e) { const float rt = ga[e] * __builtin_amdgcn_rcpf(fmaxf(gn[e], 1e-30f)); acc[ai][bj][m][e >> 2][e & 3] *= rt; }
            }
        EPI_ROWS_END
    }
    __device__ __forceinline__ void operator()(AccC acc, const Unit& u, int wr, int wc, int fr, int fq) const {
        const int col0 = u.pn * 256 + wc * 32 + 8 * fq;
        EPI_ROWS_BEGIN
#pragma unroll
            for (int bj = 0; bj < 2; ++bj) {
                float g2[8]; unpack8(*(const GAS v4u*)(G + (size_t)row * 6144 + 2 * 2048 + col0 + bj * 128), g2);
                const f32x4 v0 = acc[ai][bj][m][0], v1 = acc[ai][bj][m][1];
                float f[8] = {v0[0], v0[1], v0[2], v0[3], v1[0], v1[1], v1[2], v1[3]};
#pragma unroll
                for (int e = 0; e < 8; ++e) f[e] *= g2[e];
                *(GAS v4u*)(MM + (size_t)row * 2048 + col0 + bj * 128) = pack8(f);
            }
        EPI_ROWS_END
    }
};
struct EpiSwiglu {
    EPI_NO_MID
    static constexpr bool PERM = true;
    bf16* FH;
    __device__ __forceinline__ void operator()(AccC acc, const Unit& u, int wr, int wc, int fr, int fq) const {
        const int col0 = u.pn * 128 + wc * 32 + 8 * fq;
        EPI_ROWS_BEGIN
            const f32x4 a0 = acc[ai][0][m][0], a1 = acc[ai][0][m][1], b0 = acc[ai][1][m][0], b1 = acc[ai][1][m][1];
            const float av[8] = {a0[0], a0[1], a0[2], a0[3], a1[0], a1[1], a1[2], a1[3]}, bv[8] = {b0[0], b0[1], b0[2], b0[3], b1[0], b1[1], b1[2], b1[3]};
            float f[8];
#pragma unroll
            for (int e = 0; e < 8; ++e) f[e] = av[e] * fsigmoid(av[e]) * bv[e];
            *(GAS v4u*)(FH + (size_t)row * FFH + col0) = pack8(f);
        EPI_ROWS_END
    }
};

struct PanelSS {
    float* slots; unsigned* cnt; unsigned* tmo;
    __device__ __forceinline__ void run(const f32x4 (&v)[2][2][4][2], const Unit& u, int wr, int wc, int fr, int fq, PG8_LAS unsigned char* lds, int wid, int lane) const {
        PG8_LAS float* P = (PG8_LAS float*)lds;
        PG8_LAS float* S = (PG8_LAS float*)(lds + 8192);
#pragma unroll
        for (int ai = 0; ai < 2; ++ai)
#pragma unroll
            for (int m = 0; m < 4; ++m) { float q = 0.f;
#pragma unroll
                for (int bj = 0; bj < 2; ++bj)
#pragma unroll
                    for (int n = 0; n < 2; ++n) { const f32x4 x = v[ai][bj][m][n]; q += (x[0] * x[0] + x[1] * x[1]) + (x[2] * x[2] + x[3] * x[3]); }
                q += __builtin_bit_cast(float, __builtin_amdgcn_ds_bpermute((lane ^ 16) << 2, __builtin_bit_cast(int, q)));
                q += __builtin_bit_cast(float, __builtin_amdgcn_ds_bpermute((lane ^ 32) << 2, __builtin_bit_cast(int, q)));
                if (fq == 0) P[(ai * 128 + wr * 64 + m * 16 + fr) * 4 + wc] = q; }
        asm volatile("s_waitcnt lgkmcnt(0)" ::: "memory"); __builtin_amdgcn_s_barrier(); asm volatile("" ::: "memory");
        const int row = wid * 32 + (lane & 31);
        if (lane < 32) { const float tot = (P[row * 4 + 0] + P[row * 4 + 1]) + (P[row * 4 + 2] + P[row * 4 + 3]);
            __hip_atomic_store(slots + ((size_t)(u.pm * 256 + row) * 8 + u.pn), tot, __ATOMIC_RELAXED, __HIP_MEMORY_SCOPE_AGENT); }
        asm volatile("s_waitcnt vmcnt(0)" ::: "memory");
        if (lane == 0) __hip_atomic_fetch_add(cnt + 64 * u.pm, 1u, __ATOMIC_RELAXED, __HIP_MEMORY_SCOPE_AGENT);
        if (wid == 0) {
            const unsigned long long t0 = __builtin_amdgcn_s_memrealtime();
            for (;;) {
                if ((unsigned)__builtin_amdgcn_readfirstlane(__hip_atomic_load(cnt + 64 * u.pm, __ATOMIC_RELAXED, __HIP_MEMORY_SCOPE_AGENT)) >= 64u) break;
                if (__builtin_amdgcn_s_memrealtime() - t0 > 2000000ull) { if (lane == 0) __hip_atomic_store(tmo, 1u, __ATOMIC_RELAXED, __HIP_MEMORY_SCOPE_AGENT); break; }
                __builtin_amdgcn_s_sleep(2);
            }
            __builtin_amdgcn_fence(__ATOMIC_ACQUIRE, "agent");
        }
        asm volatile("s_waitcnt vmcnt(0) lgkmcnt(0)" ::: "memory"); __builtin_amdgcn_s_barrier(); asm volatile("" ::: "memory");
        if (lane < 32) { const float* sl = slots + (size_t)(u.pm * 256 + row) * 8; float t = 0.f;
#pragma unroll
            for (int k = 0; k < 8; ++k) t += __hip_atomic_load(sl + k, __ATOMIC_RELAXED, __HIP_MEMORY_SCOPE_AGENT);
            S[row] = rsqrtf(t * (1.0f / 2048.0f) + 1e-6f); }
        asm volatile("s_waitcnt lgkmcnt(0)" ::: "memory"); __builtin_amdgcn_s_barrier(); asm volatile("" ::: "memory");
    }
};
struct EpiResNorm {
    static constexpr bool PERM = false, AFTER_DRAIN = true;
    float* X; bf16* H; const float* gpost; const float* modGate; const float* gpre; const float* modShift; const float* modScale; PanelSS st1, st2; int hasnext;
    __device__ __forceinline__ void mid(AccM, const Unit&, int, int, int, int) const {}
    __device__ __forceinline__ void operator()(AccC, const Unit&, int, int, int, int) const {}
    __device__ __forceinline__ void fused(AccM acc, const Unit& u, int wr, int wc, int fr, int fq, PG8_LAS unsigned char* lds, int wid, int lane) const {
        const PG8_LAS float* S = (const PG8_LAS float*)(lds + 8192);
        const int col0 = u.pn * 256 + wc * 32 + 4 * fq, cv = u.pm < 16 ? 0 : 1 + ((u.pm - 16) >> 2);
        st1.run(acc, u, wr, wc, fr, fq, lds, wid, lane);
#pragma unroll
        for (int ai = 0; ai < 2; ++ai)
#pragma unroll
            for (int m = 0; m < 4; ++m) { const int r = ai * 128 + wr * 64 + m * 16 + fr; const float r1 = S[r]; const size_t off = (size_t)(u.pm * 256 + r) * 2048 + col0;
#pragma unroll
                for (int bj = 0; bj < 2; ++bj)
#pragma unroll
                    for (int n = 0; n < 2; ++n) { const int c = bj * 128 + n * 16; const f32x4 xr = *(const GAS f32x4*)(X + off + c), gp = *(const GAS f32x4*)(gpost + col0 + c), gt = *(const GAS f32x4*)(modGate + (size_t)cv * 12288 + col0 + c);
                        acc[ai][bj][m][n] = xr + gt * (acc[ai][bj][m][n] * r1 * gp); }
                asm volatile("" : "+v"(acc[ai][0][m][0]), "+v"(acc[ai][0][m][1]), "+v"(acc[ai][1][m][0]), "+v"(acc[ai][1][m][1]));
                if (m & 1) asm volatile("" ::: "memory"); }
        if (hasnext) st2.run(acc, u, wr, wc, fr, fq, lds, wid, lane);
#pragma unroll
        for (int ai = 0; ai < 2; ++ai)
#pragma unroll
            for (int m = 0; m < 4; ++m) { const int r = ai * 128 + wr * 64 + m * 16 + fr; const float r2 = hasnext ? S[r] : 0.f; const size_t off = (size_t)(u.pm * 256 + r) * 2048 + col0;
#pragma unroll
                for (int bj = 0; bj < 2; ++bj)
#pragma unroll
                    for (int n = 0; n < 2; ++n) { const int c = bj * 128 + n * 16; const f32x4 x1 = acc[ai][bj][m][n]; *(GAS f32x4*)(X + off + c) = x1;
                        if (hasnext) { const f32x4 g = *(const GAS f32x4*)(gpre + col0 + c), sh = *(const GAS f32x4*)(modShift + (size_t)cv * 12288 + col0 + c), sc = *(const GAS f32x4*)(modScale + (size_t)cv * 12288 + col0 + c);
                            const f32x4 hv = x1 * r2 * g * (sc + 1.0f) + sh; v2u w; w.x = pk2(hv[0], hv[1]); w.y = pk2(hv[2], hv[3]); *(GAS v2u*)(H + off + c) = w; } }
                asm volatile("" ::: "memory"); }
    }
};

struct SchedPlain {
    const char* A; const char* B; int nM, nN, G, c; size_t tA, tB; int dup;
    __device__ __forceinline__ bool next(int i, Unit& u) const { int pm, pn; const int q = i / (dup * DUP_GEMM), r = i - q * (dup * DUP_GEMM); long L = (long)q * G + c; const int nwg = nM * nN; if (L >= nwg) return false;
        if (r) L = (L + nwg / 2 + 8) % nwg;
        if (!tile_order(L, nM, nN, pm, pn)) return false; u.A = A + (size_t)pm * tA; u.B = B + (size_t)pn * tB; u.pm = pm; u.pn = pn; u.aux = 0; u.last = 1; return true; }
};
struct SchedMerge {
    const char* A0; const char* A1; const char* A2; const char* B; int G, c;
    __device__ __forceinline__ bool next(int i, Unit& u) const { const int ti = i / 3, b = i - ti * 3; int pm, pn; const int q = ti / (DUPG6 * DUP_GEMM), r = ti - q * (DUPG6 * DUP_GEMM); long L = (long)q * G + c; if (L >= 256) return false; if (r) L = (L + 136) % 256;
        if (!tile_order(L, 32, 8, pm, pn)) return false;
        const char* Ab = b == 0 ? A0 : (b == 1 ? A1 : A2); u.A = Ab + (size_t)pm * 256 * 1024 * 2; u.B = B + ((size_t)b * 2048 + pn * 256) * 1024 * 2; u.pm = pm; u.pn = pn; u.aux = b; u.last = (b == 2); return true; }
};
struct SchedS5E {
    const char* UG; const char* ET; int G, c;
    __device__ __forceinline__ bool next(int i, Unit& u) const { const int L = (i / DUP_S5) * G + c; if (L >= 128) return false; const int g = L >> 1, pm = L & 1;
        u.A = UG + ((size_t)g * 512 + pm * 256) * 256 * 2; u.B = ET + (size_t)g * 256 * 256 * 2; u.pm = pm; u.pn = 0; u.aux = g; u.last = 1; return true; }
};
struct SchedS5Y {
    const char* UG; const char* HIN; const char* MT; const char* FT; int G, c;
    __device__ __forceinline__ bool next(int i, Unit& u) const { const int ti = (i >> 1) / DUP_S5, part = i & 1, L = ti * G + c; if (L >= 128) return false; const int g = L >> 1, pm = L & 1;
        u.A = (part ? HIN : UG) + ((size_t)g * 512 + pm * 256) * 256 * 2; u.B = (part ? FT : MT) + (size_t)g * 256 * 256 * 2; u.pm = pm; u.pn = 0; u.aux = g; u.last = part; return true; }
};
struct SchedOne {
    const char* A0; const char* B0; const char* A1; const char* B1; int pm, aux, nparts;
    __device__ __forceinline__ bool next(int i, Unit& u) const { if (i >= nparts) return false; u.A = i ? A1 : A0; u.B = i ? B1 : B0; u.pm = pm; u.pn = 0; u.aux = aux; u.last = (i == nparts - 1); return true; }
};
struct SchedRg {
    const char* XC; const char* GWT; int G, c;
    __device__ __forceinline__ bool next(int i, Unit& u) const { const int L = (i / DUP_RGG) * G + c; if (L >= 512) return false; const int pm = L & 31, hd = L >> 5;
        u.A = XC + ((size_t)pm * 256 * 1024 + (hd >> 1) * 128) * 2; u.B = GWT + (size_t)hd * 256 * 128 * 2; u.pm = pm; u.pn = 0; u.aux = hd; u.last = 1; return true; }
};
}

namespace att {
using bf16x8 = __attribute__((ext_vector_type(8))) short;
using s16x4  = __attribute__((ext_vector_type(4))) short;
using f32x16 = __attribute__((ext_vector_type(16))) float;
using u32x4  = __attribute__((ext_vector_type(4))) unsigned;
constexpr int D = 128, NW = 8, QBLK = 32, KVBLK = 64, LD = 1024;
constexpr float SCALE = 0.088388347648318440f, THR = 8.f;
constexpr size_t SHM_V = KVBLK * D * 2, SHM_K = KVBLK * D * 2, SHM_ATTN = 2 * SHM_V + 2 * SHM_K + NW * 64 * 4;
constexpr int RPB_OFF = (int)SHM_ATTN + 256;
#define KSWZ(row, colB) ((row) * 256 + ((colB) ^ (((row) & 7) << 4)))
#define SBAR() __builtin_amdgcn_sched_barrier(0)
__device__ __forceinline__ int crow(int r, int hi) { return (r & 3) + 8 * (r >> 2) + 4 * hi; }
__device__ __forceinline__ unsigned cvtpk(float lo, float hi) { return pk2(lo, hi); }
__device__ __forceinline__ void partialSM(f32x16& p0, f32x16& p1, float& m_reg, float& mn, float& alpha) {
  constexpr float C = SCALE * 1.4426950408889634f;
  float pmax = p0[0]; for (int r = 1; r < 16; ++r) pmax = fmaxf(pmax, p0[r]); for (int r = 0; r < 16; ++r) pmax = fmaxf(pmax, p1[r]);
  { auto rr = __builtin_amdgcn_permlane32_swap(__float_as_uint(pmax), __float_as_uint(pmax), false, false);
    pmax = fmaxf(__uint_as_float(rr[0]), __uint_as_float(rr[1])); }
  if (__builtin_expect(__all(pmax - m_reg <= THR / SCALE), 1)) { mn = m_reg; alpha = 1.f; }
  else { mn = fmaxf(m_reg, pmax); alpha = __builtin_amdgcn_exp2f((m_reg - mn) * C); m_reg = mn; }
  float mnC = -mn * C;
  for (int r = 0; r < 16; ++r) p0[r] = fmaf(p0[r], C, mnC); for (int r = 0; r < 16; ++r) p1[r] = fmaf(p1[r], C, mnC);
  for (int r = 0; r < 16; ++r) p0[r] = __builtin_amdgcn_exp2f(p0[r]);
}
__device__ __forceinline__ void finishSM(f32x16& p0, f32x16& p1, float alpha, float& l_reg, bf16x8& pa0, bf16x8& pa1, bf16x8& pa2, bf16x8& pa3) {
  for (int r = 0; r < 16; ++r) p1[r] = __builtin_amdgcn_exp2f(p1[r]);
  float ps = 0; for (int r = 0; r < 16; ++r) ps += p0[r]; for (int r = 0; r < 16; ++r) ps += p1[r];
  { auto rr = __builtin_amdgcn_permlane32_swap(__float_as_uint(ps), __float_as_uint(ps), false, false);
    ps = __uint_as_float(rr[0]) + __uint_as_float(rr[1]); }
  l_reg = l_reg * alpha + ps;
#define PK4(P, BASE, OUT) do { unsigned a0 = cvtpk(P[BASE + 0], P[BASE + 1]), a1 = cvtpk(P[BASE + 2], P[BASE + 3]);   \
    unsigned b0 = cvtpk(P[BASE + 4], P[BASE + 5]), b1 = cvtpk(P[BASE + 6], P[BASE + 7]);                              \
    auto r0 = __builtin_amdgcn_permlane32_swap(a0, b0, false, false); auto r1 = __builtin_amdgcn_permlane32_swap(a1, b1, false, false); \
    u32x4 w = {r0[0], r1[0], r0[1], r1[1]}; OUT = *reinterpret_cast<bf16x8*>(&w); } while (0)
  PK4(p0, 0, pa0); PK4(p0, 8, pa1); PK4(p1, 0, pa2); PK4(p1, 8, pa3);
#undef PK4
}
__device__ __forceinline__ void qkt(f32x16& p0, f32x16& p1, const bf16* Ks, const bf16x8* qr, int r32, int hi) {
  p0 = f32x16{}; p1 = f32x16{};
  for (int d0 = 0; d0 < 8; ++d0) { int cb = (d0 * 16 + hi * 8) * 2;
    bf16x8 b0 = *reinterpret_cast<const bf16x8*>((const char*)Ks + KSWZ(r32, cb));
    bf16x8 b1 = *reinterpret_cast<const bf16x8*>((const char*)Ks + KSWZ(32 + r32, cb));
    p0 = __builtin_amdgcn_mfma_f32_32x32x16_bf16(b0, qr[d0], p0, 0, 0, 0);
    p1 = __builtin_amdgcn_mfma_f32_32x32x16_bf16(b1, qr[d0], p1, 0, 0, 0); }
}
__device__ __forceinline__ int v_st(int k, int c) { const int kk = (k & ~0xC) | ((k & 4) << 1) | ((k & 8) >> 1); return ((kk >> 3) * 4 + (c >> 5)) * 512 + ((kk & 7) * 32 + (c & 31)) * 2; }
__device__ __forceinline__ int v_rd_base(int lane) { return ((lane & 3) << 3) | (((lane >> 2) & 3) << 6) | (((lane >> 4) & 1) << 5) | (((lane >> 5) & 1) << 8); }
constexpr int v_rd_off(int d0, int ks, int half) { return d0 * 512 + ks * 4096 + half * 2048; }
template <int OFF> __device__ __forceinline__ s16x4 tr_read(int vb) {
  s16x4 r; asm volatile("ds_read_b64_tr_b16 %0, %1 offset:%2" : "=&v"(r) : "v"(vb), "i"(OFF) : "memory"); return r;
}
template <int D0> __device__ __forceinline__ void pv_one(f32x16& od, int vb, bf16x8 pa0, bf16x8 pa1, bf16x8 pa2, bf16x8 pa3) {
  const s16x4 l0 = tr_read<v_rd_off(D0, 0, 0)>(vb), h0 = tr_read<v_rd_off(D0, 0, 1)>(vb), l1 = tr_read<v_rd_off(D0, 1, 0)>(vb), h1 = tr_read<v_rd_off(D0, 1, 1)>(vb);
  const s16x4 l2 = tr_read<v_rd_off(D0, 2, 0)>(vb), h2 = tr_read<v_rd_off(D0, 2, 1)>(vb), l3 = tr_read<v_rd_off(D0, 3, 0)>(vb), h3 = tr_read<v_rd_off(D0, 3, 1)>(vb);
  asm volatile("s_waitcnt lgkmcnt(0)" ::: "memory"); SBAR();
#define PK(L, H) (bf16x8){L[0], L[1], L[2], L[3], H[0], H[1], H[2], H[3]}
  od = __builtin_amdgcn_mfma_f32_32x32x16_bf16(pa0, PK(l0, h0), od, 0, 0, 0);
  od = __builtin_amdgcn_mfma_f32_32x32x16_bf16(pa1, PK(l1, h1), od, 0, 0, 0);
  od = __builtin_amdgcn_mfma_f32_32x32x16_bf16(pa2, PK(l2, h2), od, 0, 0, 0);
  od = __builtin_amdgcn_mfma_f32_32x32x16_bf16(pa3, PK(l3, h3), od, 0, 0, 0);
#undef PK
}
__device__ __forceinline__ void pv_d0(f32x16* o, int vb, bf16x8 pa0, bf16x8 pa1, bf16x8 pa2, bf16x8 pa3) {
  pv_one<0>(o[0], vb, pa0, pa1, pa2, pa3); pv_one<1>(o[1], vb, pa0, pa1, pa2, pa3); pv_one<2>(o[2], vb, pa0, pa1, pa2, pa3); pv_one<3>(o[3], vb, pa0, pa1, pa2, pa3);
}
__device__ __forceinline__ void na_mask(f32x16& p0, f32x16& p1, int kr, int qr, int rs, int ws, const float* rpbl, int hi) {
  if (kr < rs || kr >= rs + 8) {
#pragma unroll
    for (int r = 0; r < 16; ++r) { p0[r] = -1e30f; p1[r] = -1e30f; }
  } else {
    const float* row = rpbl + (kr - qr + 7) * 31 + 4 * hi; const unsigned w0 = (unsigned)(4 * hi - ws);
#pragma unroll
    for (int r = 0; r < 16; ++r) {
      const int kc = (r & 3) + 8 * (r >> 2);
      const float b0 = row[kc], b1 = row[kc + 32];
      p0[r] = (w0 + (unsigned)kc < 16u) ? p0[r] + b0 : -1e30f; p1[r] = (w0 + (unsigned)(kc + 32) < 16u) ? p1[r] + b1 : -1e30f;
      if ((r & 3) == 3) SBAR();
    }
  }
}
template <bool NA, int SD>
__device__ __forceinline__ void attn_body(const bf16* __restrict__ Qb, const bf16* __restrict__ K0, const bf16* __restrict__ V0, const bf16* __restrict__ K1, const bf16* __restrict__ V1,
                                          bf16* __restrict__ Ob, const int NT, const int lo, const int rg, char* lds) {
  int tid_ = threadIdx.x; asm volatile("" : "+v"(tid_));
  const int tid = tid_, wid = tid >> 6, lane = tid & 63, r32 = lane & 31, hi = lane >> 5;
  bf16* V_lds = (bf16*)lds; bf16* K_lds = (bf16*)(lds + 2 * SHM_V);
  float* ws_ = (float*)(lds + 2 * SHM_V + 2 * SHM_K) + wid * 64; float* li_l = ws_; float* al_l = ws_ + 32;
  const int qrow = 4 * rg + (wid >> 1), qc = 32 * (wid & 1) + r32;
  const int rs = qrow - 4 < 0 ? 0 : (qrow - 4 > 8 ? 8 : qrow - 4), wsn = qc - 8 < 0 ? 0 : (qc - 8 > 48 ? 48 : qc - 8);
  const float* rpbl = (const float*)(lds + RPB_OFF) + 15 - qc;
  float m_reg = -1e30f, l_reg = 0; f32x16 o[4] = {}; bf16x8 qr[8];
  const bf16* Qw = Qb + (long)(wid * QBLK + r32) * LD + hi * 8;
#pragma unroll
  for (int d0 = 0; d0 < 8; ++d0) qr[d0] = *(const GAS bf16x8*)(Qw + d0 * 16);
  const int sr = tid >> 4, sc = (tid & 15) * 8, vst0 = v_st(sr, sc), vst1 = v_st(32 + sr, sc);
  const int vb0 = (int)(uintptr_t)V_lds + v_rd_base(lane);
  struct { bf16x8 vs0, vs1, ks0, ks1; } sr_[SD];
#define TILEK(t) ((NA && (t) >= 8) ? K1 + (long)((t) - 8) * 64 * LD : K0 + (long)(t) * 64 * LD)
#define TILEV(t) ((NA && (t) >= 8) ? V1 + (long)((t) - 8) * 64 * LD : V0 + (long)(t) * 64 * LD)
#define SLOAD(i, t) do { const bf16* kp_ = TILEK(t); const bf16* vp_ = TILEV(t); \
    sr_[i].vs0 = *(const GAS bf16x8*)(&vp_[(long)sr * LD + sc]); sr_[i].vs1 = *(const GAS bf16x8*)(&vp_[(long)(32 + sr) * LD + sc]); \
    sr_[i].ks0 = *(const GAS bf16x8*)(&kp_[(long)sr * LD + sc]); sr_[i].ks1 = *(const GAS bf16x8*)(&kp_[(long)(32 + sr) * LD + sc]); } while (0)
#define SWRITE(b, i) do { *(bf16x8*)((char*)V_lds + (b) * SHM_V + vst0) = sr_[i].vs0;          \
    *(bf16x8*)((char*)V_lds + (b) * SHM_V + vst1) = sr_[i].vs1; int kc = sc * 2;               \
    *(bf16x8*)((char*)K_lds + (b) * SHM_K + KSWZ(sr, kc)) = sr_[i].ks0;                       \
    *(bf16x8*)((char*)K_lds + (b) * SHM_K + KSWZ(32 + sr, kc)) = sr_[i].ks1; } while (0)
#define SWAIT() do { if constexpr (SD == 2) asm volatile("s_waitcnt vmcnt(4)" ::: "memory"); else asm volatile("s_waitcnt vmcnt(0)" ::: "memory"); } while (0)
#define RESC(a) do { if (__any((a) < 1.f)) { if (hi == 0) al_l[r32] = (a); asm volatile("s_waitcnt lgkmcnt(0)" ::: "memory"); \
    for (int d = 0; d < 4; ++d) for (int r = 0; r < 16; ++r) o[d][r] *= al_l[crow(r, hi)]; } } while (0)
#define MASK(P0, P1, t) do { if (NA && (t) >= 8) na_mask(P0, P1, lo + (t) - 8, qrow, rs, wsn, rpbl, hi); } while (0)
  f32x16 pA0, pA1, pB0, pB1; float mnA, mnB, alA, alB; bf16x8 pa0, pa1, pa2, pa3;
  constexpr int SE = 0, SO = SD - 1;
  SLOAD(SE, 0); asm volatile("s_waitcnt vmcnt(0)" ::: "memory"); SWRITE(0, SE); __syncthreads();
  qkt(pA0, pA1, K_lds, qr, r32, hi); partialSM(pA0, pA1, m_reg, mnA, alA);
  SLOAD(SO, 1); if constexpr (SD == 2) { if (2 < NT) SLOAD(SE, 2); }
  SWAIT(); SWRITE(1, SO); __syncthreads();
  for (int j = 1; j + 1 < NT; j += 2) {
    SBAR(); qkt(pB0, pB1, (bf16*)((char*)K_lds + SHM_K), qr, r32, hi); MASK(pB0, pB1, j);
    finishSM(pA0, pA1, alA, l_reg, pa0, pa1, pa2, pa3); SBAR();
    SLOAD(SO, j + SD); SBAR();
    pv_d0(o, vb0, pa0, pa1, pa2, pa3); partialSM(pB0, pB1, m_reg, mnB, alB);
    __syncthreads(); SWAIT(); SWRITE(0, SE);
    RESC(alB); __syncthreads();
    SBAR(); qkt(pA0, pA1, K_lds, qr, r32, hi); MASK(pA0, pA1, j + 1);
    finishSM(pB0, pB1, alB, l_reg, pa0, pa1, pa2, pa3); SBAR();
    if (SD == 1 || j + 3 < NT) SLOAD(SE, j + 1 + SD); SBAR();
    pv_d0(o, vb0 + (int)SHM_V, pa0, pa1, pa2, pa3); partialSM(pA0, pA1, m_reg, mnA, alA);
    __syncthreads(); SWAIT(); SWRITE(1, SO);
    RESC(alA); __syncthreads();
  }
  SBAR(); qkt(pB0, pB1, (bf16*)((char*)K_lds + SHM_K), qr, r32, hi); MASK(pB0, pB1, NT - 1);
  finishSM(pA0, pA1, alA, l_reg, pa0, pa1, pa2, pa3); SBAR();
  pv_d0(o, vb0, pa0, pa1, pa2, pa3); partialSM(pB0, pB1, m_reg, mnB, alB);
  __syncthreads(); RESC(alB);
  finishSM(pB0, pB1, alB, l_reg, pa0, pa1, pa2, pa3); SBAR();
  pv_d0(o, vb0 + (int)SHM_V, pa0, pa1, pa2, pa3);
  if (hi == 0) li_l[r32] = l_reg; asm volatile("s_waitcnt lgkmcnt(0)" ::: "memory");
  float rli[16];
#pragma unroll
  for (int r = 0; r < 16; ++r) rli[r] = __builtin_amdgcn_rcpf(li_l[crow(r, hi)]);
  bf16* Ow = Ob + (long)(wid * QBLK) * LD;
#pragma unroll
  for (int r = 0; r < 16; ++r) { int orow = crow(r, hi);
    for (int d0 = 0; d0 < 4; ++d0) *(GAS bf16*)(Ow + (long)orow * LD + d0 * 32 + r32) = (bf16)f2bf(o[d0][r] * rli[r]); }
  asm volatile("s_waitcnt vmcnt(0)" ::: "memory"); __syncthreads();
#undef TILEK
#undef TILEV
#undef SLOAD
#undef SWRITE
#undef SWAIT
#undef RESC
#undef MASK
}
}

constexpr int NWAVES = 8;
struct Args { const float* in[36]; float* out; unsigned char* ws; int ph_lo, ph_hi; };
struct Frame { LAS unsigned char* lds; char* ldsg; volatile LAS unsigned* MISC; int tid, lane, wave, vcu, G; };
constexpr int INTAB_OFF = MISC_OFF + 128;
__device__ __forceinline__ const float* ld_in(const LAS unsigned char* lds, int i) { const unsigned long long v = ((const LAS unsigned long long*)(lds + INTAB_OFF))[i];
    const unsigned lo = __builtin_amdgcn_readfirstlane((unsigned)v), hi = __builtin_amdgcn_readfirstlane((unsigned)(v >> 32)); return (const float*)(((unsigned long long)hi << 32) | lo); }
#define IN(i) ld_in(F.lds, (i))

__device__ __forceinline__ void transpose_item(const float* W, int N, int k0, int n0, bf16* WT, int ldo, int drow0, float* scr, int lane) {
    const int kr = lane >> 3, n4 = (lane & 7) * 4;
    f32x4 v[8];
#pragma unroll
    for (int i = 0; i < 8; ++i) v[i] = *(const GAS f32x4*)(W + (size_t)(k0 + kr + 8 * i) * N + n0 + n4);
#pragma unroll
    for (int i = 0; i < 8; ++i) { float* d = scr + (kr + 8 * i) * 33 + n4; d[0] = v[i].x; d[1] = v[i].y; d[2] = v[i].z; d[3] = v[i].w; }
    LDS_WAIT(); asm volatile("" ::: "memory");
    const int c = lane & 7;
#pragma unroll
    for (int j = 0; j < 4; ++j) { const int n = (lane >> 3) + 8 * j; const float* s = scr + (8 * c) * 33 + n;
        v4u o; o.x = pk2(s[0 * 33], s[1 * 33]); o.y = pk2(s[2 * 33], s[3 * 33]); o.z = pk2(s[4 * 33], s[5 * 33]); o.w = pk2(s[6 * 33], s[7 * 33]);
        *(GAS v4u*)(WT + (size_t)(drow0 + n) * ldo + k0 + 8 * c) = o; }
    LDS_WAIT(); asm volatile("" ::: "memory");
}

__device__ __forceinline__ int cv_of_row(int row) { return row < CTXR ? 0 : 1 + ((row - CTXR) >> 10); }

template <bool FIRST, bool HASNEXT, bool XIN16, bool XOUT16>
__device__ __forceinline__ void resnorm_rows(const Frame& F, const float* xin0, const float* xin1, float* X, bf16* XB, const bf16* Z, const float* gpost, const float* modGate  ,
                                             const float* gpre, const float* modShift, const float* modScale, bf16* H) {
    const int gw = F.vcu * NWAVES + F.wave, NGW = F.G * NWAVES;
    for (int row = gw; row < ROWS; row += NGW) {
        const int cv = cv_of_row(row);
        f32x4 x[8];
        if (FIRST) {
            const GAS f32x4* src = (const GAS f32x4*)(row < CTXR ? xin0 + (size_t)row * DM : xin1 + (size_t)(row - CTXR) * DM);
#pragma unroll
            for (int j = 0; j < 8; ++j) x[j] = src[2 * (F.lane + 64 * (j >> 1)) + (j & 1)];
        } else {
            const GAS v4u* zr = (const GAS v4u*)(Z + (size_t)row * DM); const GAS f32x4* xr = (const GAS f32x4*)(X + (size_t)row * DM); const GAS v4u* xb = (const GAS v4u*)(XB + (size_t)row * DM);
            f32x4 xo_[8];
            if (XIN16) {
#pragma unroll
                for (int jj = 0; jj < 4; ++jj) { float f[8]; unpack8(xb[F.lane + 64 * jj], f); xo_[2 * jj] = (f32x4){f[0], f[1], f[2], f[3]}; xo_[2 * jj + 1] = (f32x4){f[4], f[5], f[6], f[7]}; }
            } else {
#pragma unroll
                for (int j = 0; j < 8; ++j) xo_[j] = xr[2 * (F.lane + 64 * (j >> 1)) + (j & 1)];
            }
            f32x4 z[8]; float ss = 0.f;
#pragma unroll
            for (int jj = 0; jj < 4; ++jj) { float f[8]; unpack8(zr[F.lane + 64 * jj], f); z[2 * jj] = (f32x4){f[0], f[1], f[2], f[3]}; z[2 * jj + 1] = (f32x4){f[4], f[5], f[6], f[7]}; }
#pragma unroll
            for (int j = 0; j < 8; ++j) ss += (z[j].x * z[j].x + z[j].y * z[j].y) + (z[j].z * z[j].z + z[j].w * z[j].w);
            const float rstd = rsqrtf(wave_sum(ss, F.lane) * (1.f / DM) + RMS_EPS);
#pragma unroll
            for (int j = 0; j < 8; ++j) { const int q = 2 * (F.lane + 64 * (j >> 1)) + (j & 1); const f32x4 gp = ((const GAS f32x4*)gpost)[q], gt = ((const GAS f32x4*)(modGate + (size_t)cv * 12288))[q];
                x[j] = xo_[j] + gt * (z[j] * rstd * gp); }
        }
        if (XOUT16) { GAS v4u* xo = (GAS v4u*)(XB + (size_t)row * DM);
#pragma unroll
          for (int jj = 0; jj < 4; ++jj) { const float f[8] = {x[2 * jj].x, x[2 * jj].y, x[2 * jj].z, x[2 * jj].w, x[2 * jj + 1].x, x[2 * jj + 1].y, x[2 * jj + 1].z, x[2 * jj + 1].w}; xo[F.lane + 64 * jj] = pack8(f); }
        } else { GAS f32x4* xo = (GAS f32x4*)(X + (size_t)row * DM);
#pragma unroll
          for (int j = 0; j < 8; ++j) xo[2 * (F.lane + 64 * (j >> 1)) + (j & 1)] = x[j]; }
        if (HASNEXT) {
            float ss = 0.f;
#pragma unroll
            for (int j = 0; j < 8; ++j) ss += (x[j].x * x[j].x + x[j].y * x[j].y) + (x[j].z * x[j].z + x[j].w * x[j].w);
            const float rstd = rsqrtf(wave_sum(ss, F.lane) * (1.f / DM) + RMS_EPS);
            GAS v4u* ho = (GAS v4u*)(H + (size_t)row * DM);
#pragma unroll
            for (int jj = 0; jj < 4; ++jj) { float f[8];
#pragma unroll
                for (int h = 0; h < 2; ++h) { const int q = 2 * (F.lane + 64 * jj) + h; const f32x4 g = ((const GAS f32x4*)gpre)[q], sh = ((const GAS f32x4*)(modShift + (size_t)cv * 12288))[q], sc = ((const GAS f32x4*)(modScale + (size_t)cv * 12288))[q];
                    const f32x4 hv = x[2 * jj + h] * rstd * g * (sc + 1.0f) + sh; f[4 * h] = hv.x; f[4 * h + 1] = hv.y; f[4 * h + 2] = hv.z; f[4 * h + 3] = hv.w; }
                ho[F.lane + 64 * jj] = pack8(f); }
        }
    }
}

__device__ __forceinline__ void s5_tables(const Frame& F, int l, int g, unsigned char* ws) {
    char* L = F.ldsg;
    f32x2* POW = (f32x2*)L;
    f32x2* BB = (f32x2*)(L + 17408);
    f32x2* CC = (f32x2*)(L + 17408 + 16384);
    float* KT = (float*)(L + 17408 + 32768);
    const int tid = F.tid;
    __syncthreads();
    if (tid < 128) {
        const int d = tid >> 6, p = tid & 63; const size_t li = ((size_t)(l * 2 + d) * 64 + g) * 64 + p;
        const float dt = expf(IN(22)[(l * 2 + d) * 64 + g]); const float lre = IN(20)[li], lim = IN(21)[li];
        const float er = expf(lre * dt); float sn, cs; sincosf(lim * dt, &sn, &cs);
        const float br = er * cs, bi = er * sn;
        const float nr = br - 1.0f, ni = bi, den = lre * lre + lim * lim;
        const float cr = (nr * lre + ni * lim) / den, ci = (ni * lre - nr * lim) / den;
        float pr = 1.f, pi = 0.f;
        for (int t = 0; t <= 16; ++t) { POW[(d * 64 + p) * 17 + t] = (f32x2){pr, pi}; const float nr2 = pr * br - pi * bi, ni2 = pr * bi + pi * br; pr = nr2; pi = ni2; }
        ((f32x2*)(ws + WS_LT))[li] = POW[(d * 64 + p) * 17 + 16];
        { f32x4 vr[4], vi[4]; const GAS f32x4* pr4 = (const GAS f32x4*)(IN(23) + li * 16); const GAS f32x4* pi4 = (const GAS f32x4*)(IN(24) + li * 16);
#pragma unroll
          for (int q = 0; q < 4; ++q) { vr[q] = pr4[q]; vi[q] = pi4[q]; }
#pragma unroll
          for (int m = 0; m < 16; ++m) { const float xr = vr[m >> 2][m & 3], xi = vi[m >> 2][m & 3]; BB[(d * 64 + p) * 16 + m] = (f32x2){cr * xr - ci * xi, cr * xi + ci * xr}; } }
    }
    for (int i = tid; i < 2048; i += 512) { const int d = i >> 10, n = (i >> 6) & 15, p = i & 63; const size_t ci_ = (((size_t)(l * 2 + d) * 64 + g) * 16 + n) * 64 + p; CC[i] = (f32x2){IN(25)[ci_], IN(26)[ci_]}; }
    __syncthreads();
    {
        const int d = tid >> 8, n = (tid >> 4) & 15, m = tid & 15; float acc[16];
#pragma unroll
        for (int t = 0; t < 16; ++t) acc[t] = 0.f;
        for (int p = 0; p < 64; ++p) { const f32x2 c = CC[(d * 16 + n) * 64 + p], b = BB[(d * 64 + p) * 16 + m]; const float cbr = c.x * b.x - c.y * b.y, cbi = c.x * b.y + c.y * b.x;
#pragma unroll
            for (int t = 0; t < 16; ++t) { const f32x2 w = POW[(d * 64 + p) * 17 + t]; acc[t] += cbr * w.x - cbi * w.y; } }
#pragma unroll
        for (int t = 0; t < 16; ++t) KT[((d * 16 + t) * 16 + n) * 16 + m] = acc[t];
    }
    __syncthreads();
    bf16* MT = (bf16*)(ws + WS_MT) + (size_t)(l * 64 + g) * 65536; bf16* ET = (bf16*)(ws + WS_ET) + (size_t)(l * 64 + g) * 65536; bf16* FT = (bf16*)(ws + WS_FT) + (size_t)(l * 64 + g) * 65536;
    for (int i = tid; i < 8192; i += 512) {
        const int rowi = i >> 5, k0 = (i & 31) * 8;
        { const int t = rowi >> 4, n = rowi & 15, s = k0 >> 4, m0 = k0 & 15; float f[8];
#pragma unroll
          for (int e = 0; e < 8; ++e) { float v = 0.f; if (s <= t) v += KT[((0 * 16 + (t - s)) * 16 + n) * 16 + m0 + e]; if (s >= t) v += KT[((1 * 16 + (s - t)) * 16 + n) * 16 + m0 + e]; f[e] = v; }
          *(GAS v4u*)(MT + (size_t)rowi * 256 + k0) = pack8(f); }
        { const int d = rowi >> 7, p = (rowi >> 1) & 63, c = rowi & 1, s = k0 >> 4, m0 = k0 & 15; float f[8];
          const f32x2 w = POW[(d * 64 + p) * 17 + (d == 0 ? 15 - s : s)];
#pragma unroll
          for (int e = 0; e < 8; ++e) { const f32x2 b = BB[(d * 64 + p) * 16 + m0 + e]; f[e] = c == 0 ? (w.x * b.x - w.y * b.y) : (w.x * b.y + w.y * b.x); }
          *(GAS v4u*)(ET + (size_t)rowi * 256 + k0) = pack8(f); }
        { const int t = rowi >> 4, n = rowi & 15; float f[8];
#pragma unroll
          for (int e = 0; e < 8; ++e) { const int k = k0 + e, d = k >> 7, p = (k >> 1) & 63, c = k & 1; const f32x2 cc = CC[(d * 16 + n) * 64 + p], w = POW[(d * 64 + p) * 17 + (d == 0 ? t + 1 : 16 - t)];
              f[e] = c == 0 ? (cc.x * w.x - cc.y * w.y) : -(cc.x * w.y + cc.y * w.x); }
          *(GAS v4u*)(FT + (size_t)rowi * 256 + k0) = pack8(f); }
    }
    __syncthreads();
}

constexpr int I_WIN = 32 * 384, I_GLU = 16 * 32, I_OUT = 16 * 64, I_WO = 32 * 64, I_FIN = 32 * 352, I_FOUT = 88 * 64, I_GW = 32 * 8;
constexpr int I_LAYER = I_WIN + I_GLU + 3 * I_OUT + I_WO + I_FIN + I_FOUT + I_GW;
__device__ __forceinline__ void weight_item(const Frame& F, unsigned char* ws, int l, int r, float* scr) {
    if (r < I_WIN) { const int kb = r / 384, nb = r % 384; transpose_item(IN(14) + (size_t)l * DM * INW, INW, kb * 64, nb * 32, (bf16*)(ws + WS_WINT) + (size_t)l * INW * DM, DM, nb * 32, scr, F.lane); return; } r -= I_WIN;
    if (r < I_GLU) { const int kb = r / 32, nb = r % 32; transpose_item(IN(28) + (size_t)l * 1024 * 1024, 1024, kb * 64, nb * 32, (bf16*)(ws + WS_GLUT) + (size_t)l * 1024 * 1024, 1024, nb * 32, scr, F.lane); return; } r -= I_GLU;
    if (r < 3 * I_OUT) { const int b = r / I_OUT, q = r % I_OUT, kb = q / 64, nb = q % 64; transpose_item(IN(30 + b) + (size_t)l * 1024 * DM, DM, kb * 64, nb * 32, (bf16*)(ws + WS_OUTT) + ((size_t)l * 3 + b) * DM * 1024, 1024, nb * 32, scr, F.lane); return; } r -= 3 * I_OUT;
    if (r < I_WO) { const int kb = r / 64, nb = r % 64; transpose_item(IN(33) + (size_t)l * DM * DM, DM, kb * 64, nb * 32, (bf16*)(ws + WS_WOT) + (size_t)l * DM * DM, DM, nb * 32, scr, F.lane); return; } r -= I_WO;
    if (r < I_FIN) { const int kb = r / 352, nb = r % 352; const int n0 = nb * 32, half = n0 >= FFH, j = n0 - half * FFH; const int drow = 256 * (j >> 7) + 128 * half + (j & 127);
        transpose_item(IN(34) + (size_t)l * DM * 2 * FFH, 2 * FFH, kb * 64, n0, (bf16*)(ws + WS_FINT) + (size_t)l * 2 * FFH * DM, DM, drow, scr, F.lane); return; } r -= I_FIN;
    if (r < I_FOUT) { const int kb = r / 64, nb = r % 64; transpose_item(IN(35) + (size_t)l * FFH * DM, DM, kb * 64, nb * 32, (bf16*)(ws + WS_FOUTT) + (size_t)l * DM * FFH, FFH, nb * 32, scr, F.lane); return; } r -= I_FOUT;
    { const int mi = r >> 3, q = r & 7, kb = q >> 2, nb = q & 3;
      const int d = mi >> 4, g = (mi >> 3) & 1, h = mi & 7;
      transpose_item(IN(17) + ((size_t)l * 32 + mi) * 128 * 128, 128, kb * 64, nb * 32, (bf16*)(ws + WS_GWT) + (((size_t)l * 8 + h) * 2 + d) * 256 * 128, 128, g * 128 + nb * 32, scr, F.lane); }
}
constexpr int QB = 16;
static_assert(I_LAYER % QB == 0, "queue batch");
constexpr int Q_P2 = 562 * QB, Q_P3 = 624 * QB, Q_P4 = 1374 * QB, Q_P5 = 1813 * QB, Q_P9 = I_LAYER;
constexpr int CW_Q = 8192;
__device__ __forceinline__ void pull_weight_items(const Frame& F, unsigned char* ws, int l, int upto) {
    if (l >= NL) return;
    unsigned* ctr = (unsigned*)(ws + WS_CTL) + CW_Q + 64 * l; float* scr = (float*)(F.ldsg + F.wave * 16384);
    const int upto_b = upto / QB;
    for (;;) {
        unsigned i = 0;
        if (F.lane == 0) asm volatile("global_atomic_add %0, %1, %2, off sc0\n\ts_waitcnt vmcnt(0)" : "=&v"(i) : "v"(ctr), "v"(1u) : "memory");
        i = (unsigned)__builtin_amdgcn_readfirstlane((int)i);
        if ((int)i >= upto_b) { if (F.lane == 0) asm volatile("global_atomic_sub %0, %1, off" :: "v"(ctr), "v"(1u) : "memory"); break; }
        for (int j = 0; j < QB; ++j) weight_item(F, ws, l, (int)i * QB + j, scr);
    }
}

constexpr int SQ_P5 = 6, SQ_P9 = 10, SQ_END = (SQ_P5 + SQ_P9) * 1024;
__device__ __forceinline__ void static_weight_items(const Frame& F, unsigned char* ws, int l, int c, int G, int k0, int nk) {
    if (l >= NL || G != 256 || c < 128) return;
    float* scr = (float*)(F.ldsg + F.wave * 16384); const int w = (c - 128) * 8 + F.wave;
    for (int k = 0; k < nk; ++k) weight_item(F, ws, l, (k0 + k) * 1024 + w, scr);
}

__global__ void __launch_bounds__(NWAVES * 64, 2) fwd_kernel(Args args) {
    extern __shared__ __attribute__((aligned(16))) unsigned char lds[];
    const int G0 = gridDim.x, c0 = (int)blockIdx.x;
    volatile LAS unsigned* MISC0 = (volatile LAS unsigned*)((LAS unsigned char*)lds + MISC_OFF);
    unsigned char* const ws0 = args.ws; float* const out0 = args.out;
    gu32* ctl = (gu32*)(ws0 + WS_CTL);
    for (int u = threadIdx.x; u < (LDS_BYTES - LDSCTL_OFF) / 4; u += NWAVES * 64) ((LAS unsigned*)((LAS unsigned char*)lds + LDSCTL_OFF))[u] = 0u;
    __syncthreads();
    if (threadIdx.x == 0) {
#pragma unroll
        for (int i = 0; i < 36; ++i) ((LAS unsigned long long*)((LAS unsigned char*)lds + INTAB_OFF))[i] = (unsigned long long)args.in[i]; }
    __syncthreads();
    XcdBarrier bar; bar.bar = (unsigned*)(ctl + CW_BAR); bar.x = 0; bar.st = nullptr;
    if (MK_N_LAUNCHES == 1) bar = xcd_barrier_post((unsigned*)(ctl + CW_BAR), MISC0 + 8);
    const int lo = args.ph_lo, hi = args.ph_hi;
    int ph = 0;
#ifndef PHMASK
#define PHMASK 0xFFFFFFFFu
#endif
#define PHASE_BEGIN(k) if (((PHMASK >> (k)) & 1u) && lo <= ph && ph < hi) { if ((k) == TSEL && threadIdx.x == 0) *(volatile LAS unsigned long long*)(MISC0 + 16) = __builtin_amdgcn_s_memrealtime(); unsigned char* ws = ws0; float* outp = out0; int tid_p = threadIdx.x, G = G0, c = c0; asm volatile("" : "+s"(ws), "+s"(outp), "+v"(tid_p), "+s"(G), "+s"(c)); const int vcu = (G % 8 == 0) ? (c % 8) * (G / 8) + c / 8 : c;     \
    Frame F; F.lds = (LAS unsigned char*)lds; F.ldsg = (char*)lds; F.MISC = (volatile LAS unsigned*)(F.lds + MISC_OFF); F.tid = tid_p; F.lane = tid_p & 63; F.wave = __builtin_amdgcn_readfirstlane(tid_p >> 6); F.G = G; F.vcu = vcu; \
    const int gw = vcu * NWAVES + F.wave, NGW = G * NWAVES, gt = vcu * 512 + F.tid, NGT = G * 512; (void)gw; (void)NGW; (void)gt; (void)NGT; \
    float* const X = outp + O_X; bf16* const Hb = (bf16*)(ws + WS_H); float* const MOD = (float*)(ws + WS_MOD); const float* const modl = MOD + (size_t)l_ * NCV * INW; (void)X; (void)Hb; (void)modl;
#define PHASE_END(k)   if (MK_N_LAUNCHES == 1 && ph + 1 < hi) { XcdBarrier b_ = bar; asm volatile("" : "+s"(b_.bar)); xcd_barrier(b_); } if ((k) == TSEL && threadIdx.x == 0) *(volatile LAS unsigned long long*)(MISC0 + 18) += __builtin_amdgcn_s_memrealtime() - *(volatile LAS unsigned long long*)(MISC0 + 16); } ++ph;
    int l_ = 0;

    PHASE_BEGIN(0)
    {
        for (int it = F.vcu; it < NL * 64; it += G) s5_tables(F, it >> 6, it & 63, ws);
        __syncthreads();
        { const float* lamp = IN(19); for (int i = gt; i < NL * 2 * 1024; i += NGT) ((float*)(ws + WS_SP))[i] = log1pf(expf(-lamp[i])); }
        float* scr = (float*)(F.ldsg + F.wave * 16384);
        { const int rest = (G == 256) ? I_LAYER - SQ_END : I_LAYER;
          for (int it = gw; it < I_LAYER + 3 * rest; it += NGW) { if (it < I_LAYER) weight_item(F, ws, 0, it, scr); else { const int q = it - I_LAYER, l = 1 + q / rest, r = q % rest; weight_item(F, ws, l, I_LAYER - rest + r, scr); } } }
        const float* ckp = IN(2); const float* cvp = IN(3);
        for (int i0 = gt; i0 < 2 * 1048576; i0 += 4 * NGT) { f32x4 a0[4], a1[4];
#pragma unroll
            for (int q = 0; q < 4; ++q) { const int i = i0 + q * NGT; if (i < 2 * 1048576) { const int which = i >> 20, j = i & 1048575; const GAS f32x4* s = (const GAS f32x4*)(which ? cvp : ckp) + (size_t)j * 2; a0[q] = s[0]; a1[q] = s[1]; } }
#pragma unroll
            for (int q = 0; q < 4; ++q) { const int i = i0 + q * NGT; if (i < 2 * 1048576) { const int which = i >> 20, j = i & 1048575;
                v4u o; o.x = pk2(a0[q].x, a0[q].y); o.y = pk2(a0[q].z, a0[q].w); o.z = pk2(a1[q].x, a1[q].y); o.w = pk2(a1[q].z, a1[q].w); ((GAS v4u*)(ws + (which ? WS_CV : WS_CK)))[j] = o; } } }
        const float* cctx = IN(7); const float* cvec = IN(6); const float* wmod = IN(8);
        for (int task = gt; task < 16 * NL * 3072; task += NGT) {
            const int n4 = task % 3072, l = (task / 3072) % NL, ks = task / (3072 * NL);
            f32x4 acc[NCV];
#pragma unroll
            for (int v = 0; v < NCV; ++v) acc[v] = (f32x4){0.f, 0.f, 0.f, 0.f};
            const GAS f32x4* wp = (const GAS f32x4*)(wmod + ((size_t)l * DM + ks * 128) * INW) + n4;
            for (int kb = 0; kb < 128; kb += 16) { f32x4 w[16];
#pragma unroll
                for (int j = 0; j < 16; ++j) w[j] = wp[(size_t)(kb + j) * (INW / 4)];
#pragma unroll
                for (int j = 0; j < 16; ++j) { const int kk = ks * 128 + kb + j;
#pragma unroll
                    for (int v = 0; v < NCV; ++v) { const float cnd = v == 0 ? cctx[kk] : cvec[(v - 1) * DM + kk]; const float sl = cnd * fsigmoid(cnd); acc[v] += w[j] * sl; } } }
#pragma unroll
            for (int v = 0; v < NCV; ++v) ((f32x4*)(ws + WS_MODP))[(((size_t)ks * NL + l) * NCV + v) * 3072 + n4] = acc[v];
        }
    }
    PHASE_END(0)
    PHASE_BEGIN(1)
        const float* bmod = IN(9);
        for (int i = gt; i < NL * NCV * 3072; i += NGT) { const int n4 = i % 3072, v = (i / 3072) % NCV, l = i / (3072 * NCV);
            f32x4 s = ((const f32x4*)(bmod + (size_t)l * INW))[n4];
            f32x4 pp[16];
#pragma unroll
            for (int ks = 0; ks < 16; ++ks) pp[ks] = ((const GAS f32x4*)(ws + WS_MODP))[(((size_t)ks * NL + l) * NCV + v) * 3072 + n4];
#pragma unroll
            for (int ks = 0; ks < 16; ++ks) s += pp[ks];
            ((f32x4*)MOD)[i] = s; }
    PHASE_END(1)
    PHASE_BEGIN(2)
        resnorm_rows<true, true, false, XRES_BF16 != 0>(F, IN(0), IN(1), X, (bf16*)(ws + WS_XB), nullptr, nullptr, nullptr, IN(10), MOD + 0 * DM, MOD + 1 * DM, Hb);
    PHASE_END(2)

    for (int l = 0; l < DBG_NL; ++l) {
        l_ = l;
        PHASE_BEGIN(3)
        {   pg8::SchedPlain S{(const char*)Hb, (const char*)(ws + WS_WINT) + (size_t)l * INW * DM * 2, 32, 48, G, c, (size_t)256 * DM * 2, (size_t)256 * DM * 2, DUPG1};
            pg8::EpiWin E{(bf16*)(ws + WS_XR), (bf16*)(ws + WS_XG), (bf16*)(ws + WS_UG), (bf16*)(ws + WS_Q), (bf16*)(ws + WS_K), (bf16*)(ws + WS_V), (bf16*)(ws + WS_G),
                          outp + O_K + (size_t)l * 256 * 1024, outp + O_V + (size_t)l * 256 * 1024};
            pg8::gemm_phase(F.lds, DM, DM, DM, S, E); }
        PHASE_END(3)
        PHASE_BEGIN(4)
        {
            { const bf16* XR = (const bf16*)(ws + WS_XR); bf16* XC = (bf16*)(ws + WS_XC); const GAS float* cw = (const GAS float*)(IN(15) + (size_t)l * 4 * 1024); const GAS float* cb = (const GAS float*)(IN(16) + (size_t)l * 1024);
              for (int i_ = gt; i_ < ROWS * 128 * DUP_CONV; i_ += NGT) { const int i = i_ % (ROWS * 128); const int row = i >> 7, c8 = (i & 127) * 8;
                  const int s0 = row < CTXR ? (row & ~255) : (CTXR + ((row - CTXR) & ~1023)), s1 = row < CTXR ? s0 + 256 : s0 + 1024;
                  v4u xw[4];
#pragma unroll
                  for (int k = 0; k < 4; ++k) { int rr = row + k - 1; rr = rr < s0 ? s0 : (rr >= s1 ? s1 - 1 : rr); xw[k] = *(const GAS v4u*)(XR + (size_t)rr * 1024 + c8); }
                  f32x4 cw0[4], cw1[4]; const f32x4 cb0 = *(const GAS f32x4*)(cb + c8), cb1 = *(const GAS f32x4*)(cb + c8 + 4);
#pragma unroll
                  for (int k = 0; k < 4; ++k) { cw0[k] = *(const GAS f32x4*)(cw + k * 1024 + c8); cw1[k] = *(const GAS f32x4*)(cw + k * 1024 + c8 + 4); }
                  float acc[8] = {cb0[0], cb0[1], cb0[2], cb0[3], cb1[0], cb1[1], cb1[2], cb1[3]};
#pragma unroll
                  for (int k = 0; k < 4; ++k) { const int rr = row + k - 1; const float ok = (rr >= s0 && rr < s1) ? 1.0f : 0.0f; float xv[8]; unpack8(xw[k], xv);
#pragma unroll
                      for (int e = 0; e < 8; ++e) acc[e] += ok * (e < 4 ? cw0[k][e] : cw1[k][e - 4]) * xv[e]; }
                  *(GAS v4u*)(XC + (size_t)row * 1024 + c8) = pack8(acc); } }
            for (int L = c; L < 128 * DUP_S5; L += G) { const int g = (L & 127) >> 1, pm = L & 1;
                { pg8::SchedOne S{(const char*)(ws + WS_UG) + ((size_t)g * 512 + pm * 256) * 256 * 2, (const char*)(ws + WS_ET) + ((size_t)l * 64 + g) * 65536 * 2, nullptr, nullptr, pm, g, 1}; pg8::EpiHloc E{(float*)(ws + WS_HLOC)};
                  pg8::gemm_phase(F.lds, 256, 256, 256, S, E); }
                { const float* HLOC = (const float*)(ws + WS_HLOC); bf16* HIN = (bf16*)(ws + WS_HIN); const GAS f32x2* LT = (const GAS f32x2*)(ws + WS_LT) + (size_t)l * 2 * 64 * 64;
                  const int nseq = pm ? 4 : 16, nch = pm ? 64 : 16;
                  for (int i = F.tid; i < nseq * 128; i += 512) { const int p = i & 63, d = (i >> 6) & 1, sq = i >> 7; const int seq = pm ? 16 + sq : sq, ch0 = pm ? 256 + sq * 64 : sq * 16;
                      const f32x2 lam = LT[(d * 64 + g) * 64 + p]; float hr = 0.f, hi_ = 0.f;
                      if (pm) { const f32x2 h0 = ((const f32x2*)IN(5))[((((size_t)sq * 4 + l) * 2 + d) * 64 + g) * 64 + p]; hr = h0.x; hi_ = h0.y; }
                      for (int kb = 0; kb < nch; kb += 16) { f32x2 hl[16];
#pragma unroll
                          for (int j = 0; j < 16; ++j) { const int ch = d == 0 ? ch0 + kb + j : ch0 + nch - 1 - kb - j; hl[j] = *(const GAS f32x2*)(HLOC + ((size_t)g * 512 + ch) * 256 + d * 128 + p * 2); }
#pragma unroll
                          for (int j = 0; j < 16; ++j) { const int ch = d == 0 ? ch0 + kb + j : ch0 + nch - 1 - kb - j; *(GAS unsigned*)(HIN + ((size_t)g * 512 + ch) * 256 + d * 128 + p * 2) = pk2(hr, hi_);
                              const float nr = lam.x * hr - lam.y * hi_ + hl[j].x, ni = lam.x * hi_ + lam.y * hr + hl[j].y; hr = nr; hi_ = ni; } }
                      if (!pm) ((f32x2*)(outp + O_S5))[((((size_t)seq * 4 + l) * 2 + d) * 64 + g) * 64 + p] = (f32x2){hr, hi_}; }
                  VM_WAIT(); __syncthreads(); }
                { pg8::SchedOne S{(const char*)(ws + WS_UG) + ((size_t)g * 512 + pm * 256) * 256 * 2, (const char*)(ws + WS_MT) + ((size_t)l * 64 + g) * 65536 * 2,
                                  (const char*)(ws + WS_HIN) + ((size_t)g * 512 + pm * 256) * 256 * 2, (const char*)(ws + WS_FT) + ((size_t)l * 64 + g) * 65536 * 2, pm, g, 2};
                  pg8::EpiS5Y E{(const bf16*)(ws + WS_UG), IN(27) + (size_t)l * 1024, (bf16*)(ws + WS_ZS)};
                  pg8::gemm_phase(F.lds, 256, 256, 256, S, E); }
            }
            __syncthreads();
            { float* rp = (float*)(F.ldsg + att::RPB_OFF); const bf16* Qb = (const bf16*)(ws + WS_Q); const bf16* Kb = (const bf16*)(ws + WS_K); const bf16* Vb = (const bf16*)(ws + WS_V); bf16* Ob = (bf16*)(ws + WS_YNA);
              for (int u_ = (c + G / 2) % G; u_ < 256 * DUP_ATT; u_ += G) { const int u = u_ & 255;
                  if (u < 128) { const int b = u >> 5, h = (u >> 2) & 7, rg = u & 3; const int lo_ = rg == 0 ? 0 : (rg == 1 ? 0 : (rg == 2 ? 4 : 8)), NT = (rg == 0 || rg == 3) ? 16 : 20;
                      for (int i = F.tid; i < 465; i += 512) rp[i] = IN(29)[((size_t)l * 8 + h) * 465 + i] * (1.0f / att::SCALE);
                      __syncthreads();
                      const size_t qoff = (size_t)(CTXR + b * 1024 + rg * 256) * 1024 + h * 128, koff = (size_t)(CTXR + b * 1024 + lo_ * 64) * 1024 + h * 128, coff = ((size_t)(b * 4 + l) * 512) * 1024 + h * 128;
                      att::attn_body<true, 1>(Qb + qoff, (const bf16*)(ws + WS_CK) + coff, (const bf16*)(ws + WS_CV) + coff, Kb + koff, Vb + koff, Ob + qoff, NT, lo_, rg, F.ldsg);
                  } else { const int b = (u - 128) >> 3, h = (u - 128) & 7; const size_t off = (size_t)(b * 256) * 1024 + h * 128;
                      att::attn_body<false, 2>(Qb + off, Kb + off, Vb + off, Kb + off, Vb + off, Ob + off, 4, 0, 0, F.ldsg); }
              } }
        }
        PHASE_END(4)
        PHASE_BEGIN(5)
        {   { pg8::SchedRg S{(const char*)(ws + WS_XC), (const char*)(ws + WS_GWT) + (size_t)l * 8 * 2 * 256 * 128 * 2, G, c};
              pg8::EpiRg E{(const bf16*)(ws + WS_XC), IN(18) + (size_t)l * 4 * 1024, (const float*)(ws + WS_SP) + (size_t)l * 2048, (f32x2*)(ws + WS_AB)};
              pg8::gemm_phase(F.lds, 128, 1024, 128, S, E); }
            { pg8::SchedPlain S{(const char*)(ws + WS_ZS), (const char*)(ws + WS_GLUT) + (size_t)l * 1024 * 1024 * 2, 32, 4, G, c, (size_t)256 * 1024 * 2, (size_t)256 * 1024 * 2, 1};
              pg8::EpiGlu E{(const bf16*)(ws + WS_ZS), (bf16*)(ws + WS_YS5)};
              pg8::gemm_phase(F.lds, 1024, 1024, 1024, S, E); }
            __syncthreads(); static_weight_items(F, ws, l + 1, c, G, 0, SQ_P5);
        }
        PHASE_END(5)
        PHASE_BEGIN(6)
        {
            { const GAS unsigned* AB = (const GAS unsigned*)(ws + WS_AB); GAS float* HF = (GAS float*)(ws + WS_HF); const GAS bf16* XG = (const GAS bf16*)(ws + WS_XG); GAS bf16* YRG = (GAS bf16*)(ws + WS_YRG);
              float* cs = (float*)F.ldsg;
              for (int task_ = (c + G / 2) % G; task_ < 320 * DUP_SCAN; task_ += G) { const int task = task_ % 320;
                  const bool lat = task >= 64 && task < 128; const int ti = lat ? task - 64 : (task < 64 ? task : task - 64); const int seq = ti >> 4, cb = ti & 15;
                  const int L = lat ? 1024 : 256, row0 = lat ? CTXR + seq * 1024 : seq * 256, ch = cb * 64 + F.lane, len = L / 8, t0 = row0 + F.wave * len;
                  __syncthreads();
                  float pf = 1.f, hf = 0.f, pb = 1.f, hb = 0.f;
                  for (int tb = 0; tb < len; tb += 16) { unsigned v[16];
#pragma unroll
                      for (int j = 0; j < 16; ++j) v[j] = AB[(size_t)(t0 + tb + j) * 1024 + ch];
#pragma unroll
                      for (int j = 0; j < 16; ++j) { const float a = 1.0f - bflo(v[j]); hf = a * hf + bfhi(v[j]); pf *= a; } }
                  for (int tb = len - 16; tb >= 0; tb -= 16) { unsigned v[16];
#pragma unroll
                      for (int j = 0; j < 16; ++j) v[j] = AB[((size_t)ROWS + t0 + tb + j) * 1024 + ch];
#pragma unroll
                      for (int j = 15; j >= 0; --j) { const float a = 1.0f - bflo(v[j]); hb = a * hb + bfhi(v[j]); pb *= a; } }
                  cs[(F.wave * 4 + 0) * 64 + F.lane] = pf; cs[(F.wave * 4 + 1) * 64 + F.lane] = hf; cs[(F.wave * 4 + 2) * 64 + F.lane] = pb; cs[(F.wave * 4 + 3) * 64 + F.lane] = hb;
                  __syncthreads();
                  float cf = lat ? IN(4)[((size_t)(seq * 4 + l) * 2 + 0) * 1024 + ch] : 0.f, cbk = lat ? IN(4)[((size_t)(seq * 4 + l) * 2 + 1) * 1024 + ch] : 0.f;
                  for (int w = 0; w < F.wave; ++w) cf = cs[(w * 4 + 0) * 64 + F.lane] * cf + cs[(w * 4 + 1) * 64 + F.lane];
                  for (int w = 7; w > F.wave; --w) cbk = cs[(w * 4 + 2) * 64 + F.lane] * cbk + cs[(w * 4 + 3) * 64 + F.lane];
                  if (!lat) { if (F.wave == 7) outp[O_RG + ((size_t)(seq * 4 + l) * 2 + 0) * 1024 + ch] = pf * cf + hf; if (F.wave == 0) outp[O_RG + ((size_t)(seq * 4 + l) * 2 + 1) * 1024 + ch] = pb * cbk + hb; }
                  float h = cf;
                  for (int tb = 0; tb < len; tb += 16) { unsigned v[16];
#pragma unroll
                      for (int j = 0; j < 16; ++j) v[j] = AB[(size_t)(t0 + tb + j) * 1024 + ch];
#pragma unroll
                      for (int j = 0; j < 16; ++j) { h = (1.0f - bflo(v[j])) * h + bfhi(v[j]); HF[(size_t)(t0 + tb + j) * 1024 + ch] = h; } }
                  VM_WAIT();
                  h = cbk;
                  for (int tb = len - 16; tb >= 0; tb -= 16) { unsigned v[16]; float hfv[16]; bf16 xg[16];
#pragma unroll
                      for (int j = 0; j < 16; ++j) { const size_t o = (size_t)(t0 + tb + j) * 1024 + ch; v[j] = AB[(size_t)ROWS * 1024 + o]; hfv[j] = HF[o]; xg[j] = XG[o]; }
#pragma unroll
                      for (int j = 15; j >= 0; --j) { h = (1.0f - bflo(v[j])) * h + bfhi(v[j]); YRG[(size_t)(t0 + tb + j) * 1024 + ch] = (bf16)f2bf((hfv[j] + h) * bf2f(xg[j])); } }
              } }
        }
        PHASE_END(6)
        PHASE_BEGIN(8)
        {   pg8::SchedMerge S{(const char*)(ws + WS_YRG), (const char*)(ws + WS_YS5), (const char*)(ws + WS_YNA), (const char*)(ws + WS_OUTT) + (size_t)l * 3 * DM * 1024 * 2, G, c};
            pg8::EpiMerge E{(const bf16*)(ws + WS_G), (bf16*)(ws + WS_MM)};
            pg8::gemm_phase(F.lds, 1024, 1024, 1024, S, E); }
        PHASE_END(8)
#if FUSE_NORM
        PHASE_BEGIN(9)
        {   pg8::SchedPlain S{(const char*)(ws + WS_MM), (const char*)(ws + WS_WOT) + (size_t)l * DM * DM * 2, 32, 8, G, c, (size_t)256 * DM * 2, (size_t)256 * DM * 2, 1};
            unsigned* ctlw = (unsigned*)(ws + WS_CTL); const int b0 = (l * 2 + 0) * 2;
            pg8::PanelSS s1{(float*)(ws + WS_XS) + (size_t)b0 * 65536, ctlw + CW_SEAM + b0 * SEAM_BANK, ctlw + CW_TMO}, s2{(float*)(ws + WS_XS) + (size_t)(b0 + 1) * 65536, ctlw + CW_SEAM + (b0 + 1) * SEAM_BANK, ctlw + CW_TMO};
            pg8::EpiResNorm E{X, Hb, IN(11) + (size_t)l * DM, modl + 2 * DM, IN(12) + (size_t)l * DM, modl + 3 * DM, modl + 4 * DM, s1, s2, 1};
            pg8::gemm_phase(F.lds, DM, DM, DM, S, E); }
        PHASE_END(9)
#else
        PHASE_BEGIN(9)
        {   pg8::SchedPlain S{(const char*)(ws + WS_MM), (const char*)(ws + WS_WOT) + (size_t)l * DM * DM * 2, 32, 8, G, c, (size_t)256 * DM * 2, (size_t)256 * DM * 2, 1};
            pg8::EpiB16 E{(bf16*)(ws + WS_Z), DM};
            pg8::gemm_phase(F.lds, DM, DM, DM, S, E); }
        PHASE_END(9)
        PHASE_BEGIN(10)
            resnorm_rows<false, true, XRES_BF16 != 0, XRES_BF16 != 0>(F, nullptr, nullptr, X, (bf16*)(ws + WS_XB), (const bf16*)(ws + WS_Z), IN(11) + (size_t)l * DM, modl + 2 * DM, IN(12) + (size_t)l * DM, modl + 3 * DM, modl + 4 * DM, Hb);
        PHASE_END(10)
#endif
        PHASE_BEGIN(11)
        {   pg8::SchedPlain S{(const char*)Hb, (const char*)(ws + WS_FINT) + (size_t)l * 2 * FFH * DM * 2, 32, 44, G, c, (size_t)256 * DM * 2, (size_t)256 * DM * 2, DUPG9};
            pg8::EpiSwiglu E{(bf16*)(ws + WS_FH)};
            pg8::gemm_phase(F.lds, DM, DM, DM, S, E);
            __syncthreads(); static_weight_items(F, ws, l + 1, c, G, SQ_P5, SQ_P9); }
        PHASE_END(11)
#if FUSE_NORM
        PHASE_BEGIN(12)
        {   pg8::SchedPlain S{(const char*)(ws + WS_FH), (const char*)(ws + WS_FOUTT) + (size_t)l * DM * FFH * 2, 32, 8, G, c, (size_t)256 * FFH * 2, (size_t)256 * FFH * 2, DUPG10};
            unsigned* ctlw = (unsigned*)(ws + WS_CTL); const int b0 = (l * 2 + 1) * 2; const int ln = l + 1 < NL ? l + 1 : l;
            pg8::PanelSS s1{(float*)(ws + WS_XS) + (size_t)b0 * 65536, ctlw + CW_SEAM + b0 * SEAM_BANK, ctlw + CW_TMO}, s2{(float*)(ws + WS_XS) + (size_t)(b0 + 1) * 65536, ctlw + CW_SEAM + (b0 + 1) * SEAM_BANK, ctlw + CW_TMO};
            pg8::EpiResNorm E{X, Hb, IN(13) + (size_t)l * DM, modl + 5 * DM, IN(10) + (size_t)ln * DM, MOD + (size_t)ln * NCV * INW + 0 * DM, MOD + (size_t)ln * NCV * INW + 1 * DM, s1, s2, (l + 1 < NL) ? 1 : 0};
            pg8::gemm_phase(F.lds, FFH, FFH, FFH, S, E); }
        PHASE_END(12)
#else
        PHASE_BEGIN(12)
        {   pg8::SchedPlain S{(const char*)(ws + WS_FH), (const char*)(ws + WS_FOUTT) + (size_t)l * DM * FFH * 2, 32, 8, G, c, (size_t)256 * FFH * 2, (size_t)256 * FFH * 2, DUPG10};
            pg8::EpiB16 E{(bf16*)(ws + WS_Z), DM};
            pg8::gemm_phase(F.lds, FFH, FFH, FFH, S, E); }
        PHASE_END(12)
        PHASE_BEGIN(13)
            if (l + 1 < NL) resnorm_rows<false, true, XRES_BF16 != 0, XRES_BF16 != 0>(F, nullptr, nullptr, X, (bf16*)(ws + WS_XB), (const bf16*)(ws + WS_Z), IN(13) + (size_t)l * DM, modl + 5 * DM, IN(10) + (size_t)(l + 1) * DM, modl + NCV * INW + 0 * DM, modl + NCV * INW + 1 * DM, Hb);
            else resnorm_rows<false, false, XRES_BF16 != 0, false>(F, nullptr, nullptr, X, (bf16*)(ws + WS_XB), (const bf16*)(ws + WS_Z), IN(13) + (size_t)l * DM, modl + 5 * DM, nullptr, nullptr, nullptr, Hb);
        PHASE_END(13)
#endif
    }
#if DBG_KEEP
    PHASE_BEGIN(14)
        for (size_t i = (size_t)gt; i < O_END; i += (size_t)NGT) {
            int r, lay = 0;
            if (i < O_K) r = i < O_K / 2 ? 0 : 1;
            else if (i < O_V) { r = 2; lay = (int)(((i - O_K) / (256 * 1024)) & 3); }
            else if (i < O_RG) { r = 3; lay = (int)(((i - O_V) / (256 * 1024)) & 3); }
            else if (i < O_S5) { r = 4; lay = (int)(((i - O_RG) / 2048) & 3); }
            else { r = 5; lay = (int)(((i - O_S5) / 16384) & 3); }
            const bool keep = ((DBG_KEEP >> r) & 1) && (r < 2 || ((DBG_LMASK >> lay) & 1));
            float v = keep ? 3.0f * outp[i] : 0.0f;
#if DBG_DUMP
            v = 0.f;
            if (i >= O_K && i < O_K + (size_t)ROWS * 1024) { const size_t j = i - O_K;
                if (DBG_DUMP == 1) v = bf2f(((const bf16*)(ws + WS_YNA))[j]);
                if (DBG_DUMP == 2) v = bf2f(((const bf16*)(ws + WS_YS5))[j]);
                if (DBG_DUMP == 3) v = bf2f(((const bf16*)(ws + WS_YRG))[j]);
                if (DBG_DUMP == 4) v = bf2f(((const bf16*)(ws + WS_ZS))[j]);
                if (DBG_DUMP == 5) v = bf2f(((const bf16*)(ws + WS_MM))[j]);
                if (DBG_DUMP == 6) v = ((const bf16*)(ws + WS_Z))[j];
                if (DBG_DUMP == 7) v = bf2f(((const bf16*)(ws + WS_FH))[j]);
                if (DBG_DUMP == 8) v = bf2f(((const bf16*)(ws + WS_H))[j]);
                if (DBG_DUMP == 9) v = bf2f(((const bf16*)(ws + WS_G))[j]);
                if (DBG_DUMP == 11) v = bf2f(((const bf16*)(ws + WS_G))[(size_t)8192 * 6144 + j]);
                if (DBG_DUMP == 10) v = bf2f(((const bf16*)(ws + WS_WINT))[(size_t)6144 * 2048 + j]);
            }
#endif
            outp[i] = v;
        }
    PHASE_END(14)
#endif
    if (TSEL >= 0 && blockIdx.x == 0 && threadIdx.x == 0) { const float us = (float)(*(volatile LAS unsigned long long*)(MISC0 + 18)) * 0.01f; out0[0] = exp2f(rintf(log2f(us) * 10.0f) * 0.1f); }
#undef PHASE_BEGIN
#undef PHASE_END
}
constexpr int N_PHASES = 3 + DBG_NL * (FUSE_NORM ? 8 : 10) + (DBG_KEEP ? 1 : 0);

extern "C" void kernel_launch(void* const* d_in, const int* in_sizes, int n_in, void* d_out, int out_size, void* d_ws, size_t ws_size, hipStream_t stream) {
    static int grid = 0;
    if (grid == 0) {
        if (n_in != 36 || out_size != (int)O_END || ws_size < WS_END) { fprintf(stderr, "kernel_launch: unexpected shapes (n_in %d out %d ws %zu)\n", n_in, out_size, ws_size); grid = -1; return; }
        int dev = 0, cus = 0, per_cu = 0;
        if (hipGetDevice(&dev) != hipSuccess || hipDeviceGetAttribute(&cus, hipDeviceAttributeMultiprocessorCount, dev) != hipSuccess) { grid = -1; return; }
        if (hipFuncSetAttribute((const void*)fwd_kernel, hipFuncAttributeMaxDynamicSharedMemorySize, LDS_BYTES) != hipSuccess) { fprintf(stderr, "kernel_launch: hipFuncSetAttribute failed\n"); grid = -1; return; }
        if (hipOccupancyMaxActiveBlocksPerMultiprocessor(&per_cu, (const void*)fwd_kernel, NWAVES * 64, LDS_BYTES) != hipSuccess || per_cu < 1) { fprintf(stderr, "kernel_launch: occupancy query reports %d blocks per CU\n", per_cu); }
        (void)hipGetLastError();
        grid = cus;
        if (FUSE_NORM && cus != 256) { fprintf(stderr, "kernel_launch: the fused residual+norm epilogues need exactly 256 workgroups (one 256x256 tile each); build with -DFUSE_NORM=0 for %d CUs\n", cus); grid = -1; return; }
    }
    if (grid < 0) return;
    if (hipMemsetAsync((char*)d_ws + WS_CTL, 0, CTL_ZERO_BYTES, stream) != hipSuccess) return;
    Args a{};
    for (int i = 0; i < 36; ++i) a.in[i] = (const float*)d_in[i];
    a.out = (float*)d_out; a.ws = (unsigned char*)d_ws;
    if (MK_N_LAUNCHES == 1) { a.ph_lo = 0; a.ph_hi = N_PHASES; hipLaunchKernelGGL(fwd_kernel, dim3(grid), dim3(NWAVES * 64), LDS_BYTES, stream, a); }
    else for (int p = 0; p < N_PHASES; ++p) { a.ph_lo = p; a.ph_hi = p + 1; hipLaunchKernelGGL(fwd_kernel, dim3(grid), dim3(NWAVES * 64), LDS_BYTES, stream, a); }
}
```

```cpp
#include <hip/hip_runtime.h>
#include <hip/hip_bf16.h>
#include <cstdio>
#include <cstdint>

#ifndef MK_N_LAUNCHES
#define MK_N_LAUNCHES 1
#endif
#ifndef DBG_KEEP
#define DBG_KEEP 0
#endif
#ifndef DUP_SCAN
#define DUP_SCAN 1
#endif
#ifndef DUP_ATT
#define DUP_ATT 1
#endif
#ifndef DUP_CARRY
#define DUP_CARRY 1
#endif
#ifndef DUP_CONV
#define DUP_CONV 1
#endif
#ifndef DUP_RGG
#define DUP_RGG 1
#endif
#ifndef DUP_S5
#define DUP_S5 1
#endif
#ifndef TSEL
#define TSEL (-1)
#endif
#ifndef DUPG1
#define DUPG1 1
#endif
#ifndef DUPG6
#define DUPG6 1
#endif
#ifndef DUPG9
#define DUPG9 1
#endif
#ifndef DUPG10
#define DUPG10 1
#endif
#ifndef DUP_GEMM
#define DUP_GEMM 1
#endif
#ifndef DUP_MASK
#define DUP_MASK 0u
#endif
#ifndef DBG_LMASK
#define DBG_LMASK 15
#endif
#ifndef DBG_DUMP
#define DBG_DUMP 0
#endif
#ifndef DBG_NL
#define DBG_NL 4
#endif

constexpr int DM = 2048, ROWS = 8192, CTXR = 4096, INW = 12288, FFH = 5632, NL = 4, W1K = 1024;
constexpr int NCV = 5;
constexpr float RMS_EPS = 1e-6f;
constexpr size_t MiB = 1u << 20;

constexpr size_t O_X = 0, O_K = 16777216, O_V = 33554432, O_RG = 50331648, O_S5 = 50462720, O_END = 51511296;

constexpr size_t WS_CTL = 0, CTL_ZERO_BYTES = 1 * MiB;
constexpr size_t WS_MODP = 1 * MiB;
constexpr size_t WS_MOD  = 17 * MiB;
constexpr size_t WS_SP   = 18 * MiB;
constexpr size_t WS_LT   = 18 * MiB + 65536;
constexpr size_t WS_GWT  = 19 * MiB;
constexpr size_t WS_WINT = 24 * MiB;
constexpr size_t WS_GLUT = 216 * MiB;
constexpr size_t WS_OUTT = 224 * MiB;
constexpr size_t WS_WOT  = 272 * MiB;
constexpr size_t WS_FINT = 304 * MiB;
constexpr size_t WS_FOUTT = 480 * MiB;
constexpr size_t WS_MT   = 568 * MiB;
constexpr size_t WS_ET   = 600 * MiB;
constexpr size_t WS_FT   = 632 * MiB;
constexpr size_t WS_CK   = 664 * MiB;
constexpr size_t WS_CV   = 680 * MiB;
constexpr size_t WS_H    = 696 * MiB;
constexpr size_t WS_XR   = 728 * MiB;
constexpr size_t WS_XG   = 744 * MiB;
constexpr size_t WS_XC   = 760 * MiB;
constexpr size_t WS_Q    = 776 * MiB;
constexpr size_t WS_K    = 792 * MiB;
constexpr size_t WS_V    = 808 * MiB;
constexpr size_t WS_YRG  = 824 * MiB;
constexpr size_t WS_YS5  = 840 * MiB;
constexpr size_t WS_YNA  = 856 * MiB;
constexpr size_t WS_ZS   = 872 * MiB;
constexpr size_t WS_UG   = 888 * MiB;
constexpr size_t WS_HIN  = 904 * MiB;
constexpr size_t WS_G    = 920 * MiB;
constexpr size_t WS_AB   = 1016 * MiB;
constexpr size_t WS_FH   = 1016 * MiB;
constexpr size_t WS_HF   = 1144 * MiB;
constexpr size_t WS_HLOC = 1176 * MiB;
constexpr size_t WS_Z    = 1144 * MiB;
constexpr size_t WS_MM   = 1208 * MiB;
constexpr size_t WS_XS   = 1240 * MiB;
constexpr size_t WS_XB   = 1244 * MiB;
constexpr size_t WS_END  = 1276 * MiB;

constexpr int CW_TMO = 0, CW_BAR = 4096;
constexpr int CW_SEAM = 16384, SEAM_BANK = 32 * 64;
#ifndef XRES_BF16
#define XRES_BF16 1
#endif
#ifndef FUSE_NORM
#define FUSE_NORM 0
#endif

constexpr int RING_BYTES = 131072;
constexpr int LDSCTL_OFF = RING_BYTES, MISC_OFF = LDSCTL_OFF + 320;
constexpr int LDS_BYTES = 147456;

#define GAS __attribute__((address_space(1)))
#define LAS __attribute__((address_space(3)))
typedef unsigned short bf16;
typedef unsigned v4u __attribute__((ext_vector_type(4)));
typedef unsigned v2u __attribute__((ext_vector_type(2)));
typedef float f32x4 __attribute__((ext_vector_type(4)));
typedef float f32x2 __attribute__((ext_vector_type(2)));
typedef short bf16x8 __attribute__((ext_vector_type(8)));
typedef GAS unsigned gu32;
#define RLX_AGENT __ATOMIC_RELAXED, __HIP_MEMORY_SCOPE_AGENT
#define LDS_WAIT() asm volatile("s_waitcnt lgkmcnt(0)" ::: "memory")
#define VM_WAIT() asm volatile("s_waitcnt vmcnt(0)" ::: "memory")

__device__ __forceinline__ unsigned f2bf(float f) { unsigned u = __builtin_bit_cast(unsigned, f); return (u + 0x7fffu + ((u >> 16) & 1u)) >> 16; }
typedef __bf16 bf16x2_t __attribute__((ext_vector_type(2)));
__device__ __forceinline__ unsigned pk2(float lo, float hi) { const f32x2 v = {lo, hi}; const bf16x2_t b = __builtin_convertvector(v, bf16x2_t); return __builtin_bit_cast(unsigned, b); }
__device__ __forceinline__ float bflo(unsigned w) { return __builtin_bit_cast(float, w << 16); }
__device__ __forceinline__ float bfhi(unsigned w) { return __builtin_bit_cast(float, w & 0xffff0000u); }
__device__ __forceinline__ float bf2f(bf16 h) { return __builtin_bit_cast(float, (unsigned)h << 16); }
__device__ __forceinline__ float fsigmoid(float x) { return __builtin_amdgcn_rcpf(1.0f + __expf(-x)); }
__device__ __forceinline__ float gelu_tanh(float x) { const float y = 0.7978845608028654f * (x + 0.044715f * x * x * x); return x * __builtin_amdgcn_rcpf(1.0f + __expf(-2.0f * y)); }
__device__ __forceinline__ float wave_sum(float v, int lane) {
#pragma unroll
    for (int o = 1; o < 64; o <<= 1) v += __builtin_bit_cast(float, __builtin_amdgcn_ds_bpermute((lane ^ o) << 2, __builtin_bit_cast(int, v)));
    return v;
}
__device__ __forceinline__ void unpack8(const v4u w, float (&f)[8]) { f[0] = bflo(w.x); f[1] = bfhi(w.x); f[2] = bflo(w.y); f[3] = bfhi(w.y); f[4] = bflo(w.z); f[5] = bfhi(w.z); f[6] = bflo(w.w); f[7] = bfhi(w.w); }
__device__ __forceinline__ v4u pack8(const float (&f)[8]) { v4u w; w.x = pk2(f[0], f[1]); w.y = pk2(f[2], f[3]); w.z = pk2(f[4], f[5]); w.w = pk2(f[6], f[7]); return w; }

#define XB_TMO      128
#define XB_XCNT(j)  (256  + 64 * (j))
#define XB_XSUB(j)  (1280 + 64 * (j))
#define XB_XGEN(j)  (2304 + 64 * (j))
#define XB_TOP      3328
#define XB_TOPGEN   3392
#define XCD_BAR_WORDS 3456
#define XB_SPIN_CAP (1u << 18)
__device__ __forceinline__ unsigned xb_ld(unsigned* p)              { return __hip_atomic_load(p, __ATOMIC_RELAXED, __HIP_MEMORY_SCOPE_AGENT); }
__device__ __forceinline__ unsigned xb_add(unsigned* p, unsigned v) { return __hip_atomic_fetch_add(p, v, __ATOMIC_RELAXED, __HIP_MEMORY_SCOPE_AGENT); }
__device__ __forceinline__ unsigned xb_xcc_id() { return (unsigned)__builtin_amdgcn_s_getreg((3 << 11) | 20) & 0xFu; }
#define XB_SPIN(cond, bar) do { unsigned _sp = 0; while (cond) { __builtin_amdgcn_s_sleep(1); \
    if ((++_sp & 255u) == 0u) { if (xb_ld(&(bar)[XB_TMO])) break; if (_sp > XB_SPIN_CAP) { atomicAdd(&(bar)[XB_TMO], 1u); break; } } } } while (0)
struct XcdBarrier { unsigned* bar; unsigned x; volatile LAS unsigned* st; };
__device__ __forceinline__ XcdBarrier xcd_barrier_post(unsigned* bar, volatile LAS unsigned* st) {
    XcdBarrier b; b.bar = bar; b.x = xb_xcc_id(); b.st = st;
    if (threadIdx.x == 0) (void)xb_add(&bar[XB_XCNT(b.x)], 1u);
    return b;
}
__device__ __forceinline__ void xcd_barrier_complete(unsigned* bar, unsigned x, unsigned& nloc, unsigned& nx) {
    const unsigned G = gridDim.x * gridDim.y * gridDim.z;
    unsigned sum, cnt, mine, sp = 0u;
    for (;;) {
        sum = 0u; cnt = 0u; mine = 0u;
#pragma unroll
        for (unsigned j = 0; j < 16; ++j) { const unsigned c = xb_ld(&bar[XB_XCNT(j)]); sum += c; cnt += (c > 0u) ? 1u : 0u; mine = (j == x) ? c : mine; }
        if (sum == G) break;
        __builtin_amdgcn_s_sleep(1);
        if ((++sp & 255u) == 0u) { if (xb_ld(&bar[XB_TMO])) break; if (sp > XB_SPIN_CAP) { atomicAdd(&bar[XB_TMO], 1u); break; } }
    }
    nloc = mine > 0u ? mine : 1u; nx = cnt > 0u ? cnt : 1u;
}
__device__ __forceinline__ void xcd_barrier(const XcdBarrier& b) {
    asm volatile("s_waitcnt vmcnt(0)" ::: "memory");
    __syncthreads();
    int tid_b = threadIdx.x; asm volatile("" : "+v"(tid_b));
    if (tid_b == 0) {
        unsigned* bar = b.bar;
        __builtin_amdgcn_s_waitcnt(0);
        unsigned nloc = b.st[0], nx = b.st[1];
        if (nloc == 0u) { xcd_barrier_complete(bar, b.x, nloc, nx); b.st[0] = nloc; b.st[1] = nx; }
        const unsigned old = xb_add(&bar[XB_XSUB(b.x)], 1u);
        const unsigned gen = old / nloc;
        if (old + 1u == (gen + 1u) * nloc) {
            __builtin_amdgcn_fence(__ATOMIC_RELEASE, "agent");
            asm volatile("s_waitcnt vmcnt(0)" ::: "memory");
            const unsigned og = xb_add(&bar[XB_TOP], 1u);
            const unsigned tg = og / nx;
            if (og + 1u == (tg + 1u) * nx) xb_add(&bar[XB_TOPGEN], 1u);
            else XB_SPIN(xb_ld(&bar[XB_TOPGEN]) == tg, bar);
            __builtin_amdgcn_fence(__ATOMIC_ACQUIRE, "agent");
            xb_add(&bar[XB_XGEN(b.x)], 1u);
            asm volatile("s_waitcnt vmcnt(0)" ::: "memory");
        } else {
            XB_SPIN(xb_ld(&bar[XB_XGEN(b.x)]) == gen, bar);
            __builtin_amdgcn_fence(__ATOMIC_ACQUIRE, "agent");
            asm volatile("s_waitcnt vmcnt(0)" ::: "memory");
        }
    }
    __syncthreads();
}

namespace pg8 {
#define PG8_LAS __attribute__((address_space(3)))
constexpr int BM = 256, BK = 64, HALF = 128, HTB = HALF * BK * 2, STAGE_BYTES = 8 * HTB;
__host__ __device__ __forceinline__ int lds_byte(int r, int c) { const int st = (r >> 4) * 2 + (c >> 5), rr = r & 15, cc = c & 31, ob = rr * 64 + cc * 2; return st * 1024 + (ob ^ (((ob >> 9) & 1) << 5)); }
__host__ __device__ __forceinline__ void stage_rc(int b, int& R, int& C) { const int st = b / 1024, sb = b % 1024, swz = sb ^ (((sb >> 9) & 1) << 5); R = (st >> 1) * 16 + swz / 64; C = (st & 1) * 32 + (swz % 64) / 2; }
__host__ __device__ __forceinline__ int perm32(int rho) { const int n = rho >> 4, i = rho & 15; return 8 * (i >> 2) + 4 * n + (i & 3); }

struct Unit { const char* A; const char* B; int pm, pn, aux, last; };

__device__ __forceinline__ bool tile_order(long L, int nM, int nN, int& pm, int& pn) {
    const int nwg = nM * nN; if (L >= nwg) return false;
    int wgid = (int)L; { const int q = nwg / 8, r = nwg % 8, xcd = wgid % 8, off = wgid / 8; wgid = (xcd < r ? xcd * (q + 1) : r * (q + 1) + (xcd - r) * q) + off; }
    const int nig = 8 * nN, gid = wgid / nig, fm = gid * 8, gsz = (nM - fm) < 8 ? (nM - fm) : 8;
    pm = fm + ((wgid % nig) % gsz); pn = (wgid % nig) / gsz; return true;
}

typedef float f32x4 __attribute__((ext_vector_type(4)));
typedef short bf16x8 __attribute__((ext_vector_type(8)));

template <class Epi, class Sched>
__device__ __forceinline__ void gemm_phase(PG8_LAS unsigned char* lds, const int K, const int lda, const int ldb, const Sched& S, const Epi& E) {
    int tid_ = threadIdx.x; asm volatile("" : "+v"(tid_));
    const int tid = tid_, wid = __builtin_amdgcn_readfirstlane(tid >> 6), lane = tid & 63, wr = wid >> 2, wc = wid & 3, fr = lane & 15, fq = lane >> 4;
    const int nt = K / BK;
    unsigned voffA[2], voffB[2];
#pragma unroll
    for (int i = 0; i < 2; ++i) { int R, C; stage_rc(tid * 16 + i * 8192, R, C); const int Rb = Epi::PERM ? ((R & ~31) + perm32(R & 31)) : R;
        voffA[i] = (unsigned)(R * lda + C) * 2u; voffB[i] = (unsigned)(Rb * ldb + C) * 2u; }
    const size_t kstep = (size_t)(BK * 2);
    const size_t hstepA = (size_t)HALF * lda * 2, hstepB = (size_t)HALF * ldb * 2;
    const unsigned ldsw = (unsigned)wid * 1024u;
    const int aoff = lds_byte(wr * 64 + fr, fq * 8), boff = lds_byte(wc * 32 + fr, fq * 8);
#define PG8_SA(b, h) (((b) * 2 + (h)) * HTB)
#define PG8_SB(b, h) ((4 + (b) * 2 + (h)) * HTB)
#define PG8_STAGE(bufoff, gbase, voff) do { _Pragma("unroll") for (int _i = 0; _i < 2; ++_i) \
        __builtin_amdgcn_global_load_lds((const unsigned*)((const char*)(gbase) + (voff)[_i]), (PG8_LAS unsigned*)(lds + (bufoff) + ldsw + _i * 8192), 16, 0, 0); } while (0)
#define PG8_LDA(dst, b, h) do { _Pragma("unroll") for (int m = 0; m < 4; ++m) _Pragma("unroll") for (int k = 0; k < 2; ++k) dst[m][k] = *(const PG8_LAS bf16x8*)(lds + PG8_SA(b, h) + aoff + m * 2048 + k * 1024); } while (0)
#define PG8_LDB(dst, b, h) do { _Pragma("unroll") for (int n = 0; n < 2; ++n) _Pragma("unroll") for (int k = 0; k < 2; ++k) dst[n][k] = *(const PG8_LAS bf16x8*)(lds + PG8_SB(b, h) + boff + n * 2048 + k * 1024); } while (0)
#define PG8_MMA(ai, bj, At, Bt) do { __builtin_amdgcn_s_setprio(1); _Pragma("unroll") for (int m = 0; m < 4; ++m) _Pragma("unroll") for (int n = 0; n < 2; ++n) _Pragma("unroll") for (int k = 0; k < 2; ++k) \
        acc[ai][bj][m][n] = __builtin_amdgcn_mfma_f32_16x16x32_bf16(Bt[n][k], At[m][k], acc[ai][bj][m][n], 0, 0, 0); __builtin_amdgcn_s_setprio(0); } while (0)
#define PG8_WAIT_V(n) asm volatile("s_waitcnt vmcnt(" #n ")" ::: "memory")
#define PG8_WAIT_L(n) asm volatile("s_waitcnt lgkmcnt(" #n ")" ::: "memory")
#define PG8_BAR __builtin_amdgcn_s_barrier()
#define PG8_SCHED __builtin_amdgcn_sched_barrier(0)
    Unit cur, nxt; int ui = 0;
    if (!S.next(0, cur)) return;
    f32x4 acc[2][2][4][2];
#pragma unroll
    for (int a = 0; a < 2; ++a)
#pragma unroll
        for (int b = 0; b < 2; ++b)
#pragma unroll
            for (int m = 0; m < 4; ++m)
#pragma unroll
                for (int n = 0; n < 2; ++n) acc[a][b][m][n] = (f32x4){0.f, 0.f, 0.f, 0.f};
    bf16x8 At[4][2], B0[2][2], B1[2][2];
    const char* cA = cur.A; const char* cB = cur.B;
    PG8_STAGE(PG8_SB(0, 0), cB, voffB); PG8_STAGE(PG8_SB(0, 1), cB + hstepB, voffB); PG8_STAGE(PG8_SA(0, 0), cA, voffA); PG8_STAGE(PG8_SA(0, 1), cA + hstepA, voffA);
    if (wr == 1) PG8_BAR;
    PG8_WAIT_V(2); PG8_BAR;
    PG8_STAGE(PG8_SB(1, 0), cB + kstep, voffB); PG8_STAGE(PG8_SA(1, 0), cA + kstep, voffA); PG8_STAGE(PG8_SB(1, 1), cB + hstepB + kstep, voffB);
    PG8_WAIT_V(6); PG8_BAR;
    for (;;) {
        const bool has_next = S.next(ui + 1, nxt);
        const char* nA = has_next ? nxt.A : cA; const char* nB = has_next ? nxt.B : cB;
#pragma unroll 1
        for (int t = 0; t < nt; t += 2) {
            const bool last = (t == nt - 2);
            const char* a1 = cA + (size_t)(t + 1) * kstep;
            const char* a2 = last ? nA : cA + (size_t)(t + 2) * kstep; const char* b2 = last ? nB : cB + (size_t)(t + 2) * kstep;
            const char* a3 = a2 + kstep; const char* b3 = b2 + kstep;
            PG8_LDB(B0, 0, 0); PG8_LDB(B1, 0, 1); PG8_SCHED; PG8_LDA(At, 0, 0); PG8_STAGE(PG8_SA(1, 1), a1 + hstepA, voffA);
            PG8_WAIT_V(8); PG8_WAIT_L(0); PG8_BAR; PG8_MMA(0, 0, At, B0); PG8_MMA(0, 1, At, B1); PG8_BAR; PG8_SCHED;
            PG8_LDA(At, 0, 1); PG8_STAGE(PG8_SB(0, 0), b2, voffB); PG8_STAGE(PG8_SB(0, 1), b2 + hstepB, voffB); PG8_STAGE(PG8_SA(0, 0), a2, voffA);
            PG8_WAIT_V(8); PG8_WAIT_L(0); PG8_BAR; PG8_MMA(1, 0, At, B0); PG8_MMA(1, 1, At, B1); PG8_BAR; PG8_SCHED;
            PG8_LDB(B0, 1, 0); PG8_LDB(B1, 1, 1); PG8_SCHED; PG8_LDA(At, 1, 0); PG8_STAGE(PG8_SA(0, 1), a2 + hstepA, voffA);
            PG8_WAIT_V(8); PG8_WAIT_L(0); PG8_BAR; PG8_MMA(0, 0, At, B0); PG8_MMA(0, 1, At, B1); PG8_BAR; PG8_SCHED;
            PG8_LDA(At, 1, 1); PG8_STAGE(PG8_SB(1, 0), b3, voffB); PG8_STAGE(PG8_SB(1, 1), b3 + hstepB, voffB); PG8_STAGE(PG8_SA(1, 0), a3, voffA);
            PG8_WAIT_V(8); PG8_WAIT_L(0); PG8_BAR; PG8_MMA(1, 0, At, B0); PG8_MMA(1, 1, At, B1); PG8_BAR; PG8_SCHED;
        }
        if (wr == 0) PG8_BAR;
        if (cur.last) { if constexpr (!Epi::AFTER_DRAIN) E(acc, cur, wr, wc, fr, fq); } else E.mid(acc, cur, wr, wc, fr, fq);
        if (!has_next) break;
        if (cur.last) {
#pragma unroll
            for (int a = 0; a < 2; ++a)
#pragma unroll
                for (int b = 0; b < 2; ++b)
#pragma unroll
                    for (int m = 0; m < 4; ++m)
#pragma unroll
                        for (int n = 0; n < 2; ++n) acc[a][b][m][n] = (f32x4){0.f, 0.f, 0.f, 0.f};
        }
        cur = nxt; cA = nA; cB = nB; ++ui;
        if (wr == 1) PG8_BAR;
    }
    PG8_WAIT_V(0);
    PG8_BAR;
    if constexpr (Epi::AFTER_DRAIN) E.fused(acc, cur, wr, wc, fr, fq, lds, wid, lane);
#undef PG8_SA
#undef PG8_SB
#undef PG8_STAGE
#undef PG8_LDA
#undef PG8_LDB
#undef PG8_MMA
#undef PG8_WAIT_V
#undef PG8_WAIT_L
#undef PG8_BAR
#undef PG8_SCHED
}

typedef const f32x4 (&AccC)[2][2][4][2];
typedef f32x4 (&AccM)[2][2][4][2];
#define EPI_ROWS_BEGIN _Pragma("unroll") for (int ai = 0; ai < 2; ++ai) _Pragma("unroll") for (int m = 0; m < 4; ++m) { const int row = u.pm * 256 + ai * 128 + wr * 64 + m * 16 + fr;
#define EPI_ROWS_END }

#define EPI_NO_MID static constexpr bool AFTER_DRAIN = false; __device__ __forceinline__ void mid(AccM, const Unit&, int, int, int, int) const {} __device__ __forceinline__ void fused(AccM, const Unit&, int, int, int, int, PG8_LAS unsigned char*, int, int) const {}

struct EpiB16 {
    EPI_NO_MID
    static constexpr bool PERM = true;
    bf16* O; int ldc;
    __device__ __forceinline__ void operator()(AccC acc, const Unit& u, int wr, int wc, int fr, int fq) const {
        const int col0 = u.pn * 256 + wc * 32 + 8 * fq;
        EPI_ROWS_BEGIN
#pragma unroll
            for (int bj = 0; bj < 2; ++bj) { const f32x4 v0 = acc[ai][bj][m][0], v1 = acc[ai][bj][m][1]; const float f[8] = {v0[0], v0[1], v0[2], v0[3], v1[0], v1[1], v1[2], v1[3]};
                *(GAS v4u*)(O + (size_t)row * ldc + col0 + bj * 128) = pack8(f); }
        EPI_ROWS_END
    }
};
struct EpiHloc {
    EPI_NO_MID
    static constexpr bool PERM = false;
    float* O;
    __device__ __forceinline__ void operator()(AccC acc, const Unit& u, int wr, int wc, int fr, int fq) const {
        const int col0 = wc * 32 + 4 * fq; float* base = O + (size_t)u.aux * 512 * 256;
        EPI_ROWS_BEGIN
            float* rowp = base + (size_t)row * 256 + col0;
#pragma unroll
            for (int bj = 0; bj < 2; ++bj)
#pragma unroll
                for (int n = 0; n < 2; ++n) *(GAS f32x4*)(rowp + bj * 128 + n * 16) = acc[ai][bj][m][n];
        EPI_ROWS_END
    }
};
struct EpiWin {
    EPI_NO_MID
    static constexpr bool PERM = true;
    bf16 *XR, *XG, *UG, *Q, *Kb, *Vb, *G; float *outK, *outV;
    __device__ __forceinline__ void operator()(AccC acc, const Unit& u, int wr, int wc, int fr, int fq) const {
        const int pn = u.pn, seg = pn >> 2;
        const int cseg = (pn & 3) * 256 + wc * 32 + 8 * fq;
        EPI_ROWS_BEGIN
#pragma unroll
            for (int bj = 0; bj < 2; ++bj) {
                const f32x4 v0 = acc[ai][bj][m][0], v1 = acc[ai][bj][m][1];
                float f[8] = {v0[0], v0[1], v0[2], v0[3], v1[0], v1[1], v1[2], v1[3]};
                const int c = cseg + bj * 128;
                if (seg >= 6) {
#pragma unroll
                    for (int e = 0; e < 8; ++e) f[e] = fsigmoid(f[e]);
                    *(GAS v4u*)(G + (size_t)row * 6144 + (pn - 24) * 256 + wc * 32 + 8 * fq + bj * 128) = pack8(f);
                } else if (seg == 1) {
#pragma unroll
                    for (int e = 0; e < 8; ++e) f[e] = gelu_tanh(f[e]);
                    *(GAS v4u*)(XG + (size_t)row * 1024 + c) = pack8(f);
                } else if (seg == 2) {
                    const int g = c >> 4, m0 = c & 15;
                    *(GAS v4u*)(UG + ((size_t)g * 512 + (row >> 4)) * 256 + (row & 15) * 16 + m0) = pack8(f);
                } else {
                    bf16* dst = seg == 0 ? XR : (seg == 3 ? Q : (seg == 4 ? Kb : Vb));
                    *(GAS v4u*)(dst + (size_t)row * 1024 + c) = pack8(f);
                    if (seg >= 4 && row < CTXR) {
                        float* o = (seg == 4 ? outK : outV) + ((size_t)(row >> 8) * 4 * 256 + (row & 255)) * 1024 + c;
                        *(f32x4*)o = v0; *(GAS f32x4*)(o + 4) = v1;
                    }
                }
            }
        EPI_ROWS_END
    }
};
struct EpiRg {
    EPI_NO_MID
    static constexpr bool PERM = true;
    const bf16* XC; const float* gb; const float* sp; f32x2* AB;
    __device__ __forceinline__ void operator()(AccC acc, const Unit& u, int wr, int wc, int fr, int fq) const {
        const int h = u.aux >> 1, d = u.aux & 1, c0 = h * 128 + wc * 32 + 8 * fq;
        const GAS float* gbr = (const GAS float*)(gb + (d * 2 + 0) * 1024 + c0); const GAS float* gbi = (const GAS float*)(gb + (d * 2 + 1) * 1024 + c0); const GAS float* spp = (const GAS float*)(sp + d * 1024 + c0);
        EPI_ROWS_BEGIN
            float xc[8]; unpack8(*(const GAS v4u*)(XC + (size_t)row * 1024 + c0), xc);
            const f32x4 r0 = acc[ai][0][m][0], r1 = acc[ai][0][m][1], i0 = acc[ai][1][m][0], i1 = acc[ai][1][m][1];
            const float rr[8] = {r0[0], r0[1], r0[2], r0[3], r1[0], r1[1], r1[2], r1[3]}, ii[8] = {i0[0], i0[1], i0[2], i0[3], i1[0], i1[1], i1[2], i1[3]};
            unsigned* dst = (unsigned*)AB + ((size_t)d * ROWS + row) * 1024 + c0;
            v4u o0, o1; unsigned w[8];
#pragma unroll
            for (int e = 0; e < 8; ++e) {
                const float r = fsigmoid(rr[e] + gbr[e]), ig = fsigmoid(ii[e] + gbi[e]);
                const float la = -8.0f * r * spp[e]; const float a = __expf(la); const float om = 1.0f - a; const float mult = __builtin_amdgcn_sqrtf(om * (1.0f + a));
                w[e] = pk2(om, mult * ig * xc[e]);
            }
            o0.x = w[0]; o0.y = w[1]; o0.z = w[2]; o0.w = w[3]; o1.x = w[4]; o1.y = w[5]; o1.z = w[6]; o1.w = w[7];
            *(GAS v4u*)dst = o0; *(GAS v4u*)(dst + 4) = o1;
            asm volatile("" ::: "memory");
        EPI_ROWS_END
    }
};
struct EpiS5Y {
    EPI_NO_MID
    static constexpr bool PERM = true;
    const bf16* UG; const float* dvec; bf16* ZS;
    __device__ __forceinline__ void operator()(AccC acc, const Unit& u, int wr, int wc, int fr, int fq) const {
        const int g = u.aux;
        EPI_ROWS_BEGIN
#pragma unroll
            for (int bj = 0; bj < 2; ++bj) {
                const int col = bj * 128 + wc * 32 + 8 * fq, t = col >> 4, n0 = col & 15;
                float uu[8]; unpack8(*(const GAS v4u*)(UG + ((size_t)g * 512 + row) * 256 + col), uu);
                const f32x4 v0 = acc[ai][bj][m][0], v1 = acc[ai][bj][m][1];
                float f[8] = {v0[0], v0[1], v0[2], v0[3], v1[0], v1[1], v1[2], v1[3]};
#pragma unroll
                for (int e = 0; e < 8; ++e) f[e] = gelu_tanh(f[e] + ((const GAS float*)dvec)[g * 16 + n0 + e] * uu[e]);
                *(GAS v4u*)(ZS + ((size_t)row * 16 + t) * 1024 + g * 16 + n0) = pack8(f);
            }
        EPI_ROWS_END
    }
};
struct EpiGlu {
    EPI_NO_MID
    static constexpr bool PERM = true;
    const bf16* ZS; bf16* Y;
    __device__ __forceinline__ void operator()(AccC acc, const Unit& u, int wr, int wc, int fr, int fq) const {
        const int col0 = u.pn * 256 + wc * 32 + 8 * fq;
        EPI_ROWS_BEGIN
#pragma unroll
            for (int bj = 0; bj < 2; ++bj) {
                float z[8]; unpack8(*(const GAS v4u*)(ZS + (size_t)row * 1024 + col0 + bj * 128), z);
                const f32x4 v0 = acc[ai][bj][m][0], v1 = acc[ai][bj][m][1];
                float f[8] = {v0[0], v0[1], v0[2], v0[3], v1[0], v1[1], v1[2], v1[3]};
#pragma unroll
                for (int e = 0; e < 8; ++e) f[e] = z[e] * fsigmoid(f[e]);
                *(GAS v4u*)(Y + (size_t)row * 1024 + col0 + bj * 128) = pack8(f);
            }
        EPI_ROWS_END
    }
};
struct EpiMerge {
    static constexpr bool PERM = true, AFTER_DRAIN = false;
    __device__ __forceinline__ void fused(AccM, const Unit&, int, int, int, int, PG8_LAS unsigned char*, int, int) const {}
    const bf16* G; bf16* MM;
    __device__ __forceinline__ void mid(AccM acc, const Unit& u, int wr, int wc, int fr, int fq) const {
        const int col0 = u.pn * 256 + wc * 32 + 8 * fq, b = u.aux;
        EPI_ROWS_BEGIN
#pragma unroll
            for (int bj = 0; bj < 2; ++bj) {
                float ga[8], gn[8]; unpack8(*(const GAS v4u*)(G + (size_t)row * 6144 + b * 2048 + col0 + bj * 128), ga); unpack8(*(const GAS v4u*)(G + (size_t)row * 6144 + (b + 1) * 2048 + col0 + bj * 128), gn);
#pragma unroll
                for (int e = 0; e < 8; ++e) { const float rt = ga[e] * __builtin_amdgcn_rcpf(fmaxf(gn[e], 1e-30f)); acc[ai][bj][m][e >> 2][e & 3] *= rt; }
            }
        EPI_ROWS_END
    }
    __device__ __forceinline__ void operator()(AccC acc, const Unit& u, int wr, int wc, int fr, int fq) const {
        const int col0 = u.pn * 256 + wc * 32 + 8 * fq;
        EPI_ROWS_BEGIN
#pragma unroll
            for (int bj = 0; bj < 2; ++bj) {
                float g2[8]; unpack8(*(const GAS v4u*)(G + (size_t)row * 6144 + 2 * 2048 + col0 + bj * 128), g2);
                const f32x4 v0 = acc[ai][bj][m][0], v1 = acc[ai][bj][m][1];
                float f[8] = {v0[0], v0[1], v0[2], v0[3], v1[0], v1[1], v1[2], v1[3]};
#pragma unroll
                for (int e = 0; e < 8; ++e) f[e] *= g2[e];
                *(GAS v4u*)(MM + (size_t)row * 2048 + col0 + bj * 128) = pack8(f);
            }
        EPI_ROWS_END
    }
};
struct EpiSwiglu {
    EPI_NO_MID
    static constexpr bool PERM = true;
    bf16* FH;
    __device__ __forceinline__ void operator()(AccC acc, const Unit& u, int wr, int wc, int fr, int fq) const {
        const int col0 = u.pn * 128 + wc * 32 + 8 * fq;
        EPI_ROWS_BEGIN
            const f32x4 a0 = acc[ai][0][m][0], a1 = acc[ai][0][m][1], b0 = acc[ai][1][m][0], b1 = acc[ai][1][m][1];
            const float av[8] = {a0[0], a0[1], a0[2], a0[3], a1[0], a1[1], a1[2], a1[3]}, bv[8] = {b0[0], b0[1], b0[2], b0[3], b1[0], b1[1], b1[2], b1[3]};
            float f[8];
#pragma unroll
            for (int e = 0; e < 8; ++e) f[e] = av[e] * fsigmoid(av[e]) * bv[e];
            *(GAS v4u*)(FH + (size_t)row * FFH + col0) = pack8(f);
        EPI_ROWS_END
    }
};

struct PanelSS {
    float* slots; unsigned* cnt; unsigned* tmo;
    __device__ __forceinline__ void run(const f32x4 (&v)[2][2][4][2], const Unit& u, int wr, int wc, int fr, int fq, PG8_LAS unsigned char* lds, int wid, int lane) const {
        PG8_LAS float* P = (PG8_LAS float*)lds;
        PG8_LAS float* S = (PG8_LAS float*)(lds + 8192);
#pragma unroll
        for (int ai = 0; ai < 2; ++ai)
#pragma unroll
            for (int m = 0; m < 4; ++m) { float q = 0.f;
#pragma unroll
                for (int bj = 0; bj < 2; ++bj)
#pragma unroll
                    for (int n = 0; n < 2; ++n) { const f32x4 x = v[ai][bj][m][n]; q += (x[0] * x[0] + x[1] * x[1]) + (x[2] * x[2] + x[3] * x[3]); }
                q += __builtin_bit_cast(float, __builtin_amdgcn_ds_bpermute((lane ^ 16) << 2, __builtin_bit_cast(int, q)));
                q += __builtin_bit_cast(float, __builtin_amdgcn_ds_bpermute((lane ^ 32) << 2, __builtin_bit_cast(int, q)));
                if (fq == 0) P[(ai * 128 + wr * 64 + m * 16 + fr) * 4 + wc] = q; }
        asm volatile("s_waitcnt lgkmcnt(0)" ::: "memory"); __builtin_amdgcn_s_barrier(); asm volatile("" ::: "memory");
        const int row = wid * 32 + (lane & 31);
        if (lane < 32) { const float tot = (P[row * 4 + 0] + P[row * 4 + 1]) + (P[row * 4 + 2] + P[row * 4 + 3]);
            __hip_atomic_store(slots + ((size_t)(u.pm * 256 + row) * 8 + u.pn), tot, __ATOMIC_RELAXED, __HIP_MEMORY_SCOPE_AGENT); }
        asm volatile("s_waitcnt vmcnt(0)" ::: "memory");
        if (lane == 0) __hip_atomic_fetch_add(cnt + 64 * u.pm, 1u, __ATOMIC_RELAXED, __HIP_MEMORY_SCOPE_AGENT);
        if (wid == 0) {
            const unsigned long long t0 = __builtin_amdgcn_s_memrealtime();
            for (;;) {
                if ((unsigned)__builtin_amdgcn_readfirstlane(__hip_atomic_load(cnt + 64 * u.pm, __ATOMIC_RELAXED, __HIP_MEMORY_SCOPE_AGENT)) >= 64u) break;
                if (__builtin_amdgcn_s_memrealtime() - t0 > 2000000ull) { if (lane == 0) __hip_atomic_store(tmo, 1u, __ATOMIC_RELAXED, __HIP_MEMORY_SCOPE_AGENT); break; }
                __builtin_amdgcn_s_sleep(2);
            }
            __builtin_amdgcn_fence(__ATOMIC_ACQUIRE, "agent");
        }
        asm volatile("s_waitcnt vmcnt(0) lgkmcnt(0)" ::: "memory"); __builtin_amdgcn_s_barrier(); asm volatile("" ::: "memory");
        if (lane < 32) { const float* sl = slots + (size_t)(u.pm * 256 + row) * 8; float t = 0.f;
#pragma unroll
            for (int k = 0; k < 8; ++k) t += __hip_atomic_load(sl + k, __ATOMIC_RELAXED, __HIP_MEMORY_SCOPE_AGENT);
            S[row] = rsqrtf(t * (1.0f / 2048.0f) + 1e-6f); }
        asm volatile("s_waitcnt lgkmcnt(0)" ::: "memory"); __builtin_amdgcn_s_barrier(); asm volatile("" ::: "memory");
    }
};
struct EpiResNorm {
    static constexpr bool PERM = false, AFTER_DRAIN = true;
    float* X; bf16* H; const float* gpost; const float* modGate; const float* gpre; const float* modShift; const float* modScale; PanelSS st1, st2; int hasnext;
    __device__ __forceinline__ void mid(AccM, const Unit&, int, int, int, int) const {}
    __device__ __forceinline__ void operator()(AccC, const Unit&, int, int, int, int) const {}
    __device__ __forceinline__ void fused(AccM acc, const Unit& u, int wr, int wc, int fr, int fq, PG8_LAS unsigned char* lds, int wid, int lane) const {
        const PG8_LAS float* S = (const PG8_LAS float*)(lds + 8192);
        const int col0 = u.pn * 256 + wc * 32 + 4 * fq, cv = u.pm < 16 ? 0 : 1 + ((u.pm - 16) >> 2);
        st1.run(acc, u, wr, wc, fr, fq, lds, wid, lane);
#pragma unroll
        for (int ai = 0; ai < 2; ++ai)
#pragma unroll
            for (int m = 0; m < 4; ++m) { const int r = ai * 128 + wr * 64 + m * 16 + fr; const float r1 = S[r]; const size_t off = (size_t)(u.pm * 256 + r) * 2048 + col0;
#pragma unroll
                for (int bj = 0; bj < 2; ++bj)
#pragma unroll
                    for (int n = 0; n < 2; ++n) { const int c = bj * 128 + n * 16; const f32x4 xr = *(const GAS f32x4*)(X + off + c), gp = *(const GAS f32x4*)(gpost + col0 + c), gt = *(const GAS f32x4*)(modGate + (size_t)cv * 12288 + col0 + c);
                        acc[ai][bj][m][n] = xr + gt * (acc[ai][bj][m][n] * r1 * gp); }
                asm volatile("" : "+v"(acc[ai][0][m][0]), "+v"(acc[ai][0][m][1]), "+v"(acc[ai][1][m][0]), "+v"(acc[ai][1][m][1]));
                if (m & 1) asm volatile("" ::: "memory"); }
        if (hasnext) st2.run(acc, u, wr, wc, fr, fq, lds, wid, lane);
#pragma unroll
        for (int ai = 0; ai < 2; ++ai)
#pragma unroll
            for (int m = 0; m < 4; ++m) { const int r = ai * 128 + wr * 64 + m * 16 + fr; const float r2 = hasnext ? S[r] : 0.f; const size_t off = (size_t)(u.pm * 256 + r) * 2048 + col0;
#pragma unroll
                for (int bj = 0; bj < 2; ++bj)
#pragma unroll
                    for (int n = 0; n < 2; ++n) { const int c = bj * 128 + n * 16; const f32x4 x1 = acc[ai][bj][m][n]; *(GAS f32x4*)(X + off + c) = x1;
                        if (hasnext) { const f32x4 g = *(const GAS f32x4*)(gpre + col0 + c), sh = *(const GAS f32x4*)(modShift + (size_t)cv * 12288 + col0 + c), sc = *(const GAS f32x4*)(modScale + (size_t)cv * 12288 + col0 + c);
                            const f32x4 hv = x1 * r2 * g * (sc + 1.0f) + sh; v2u w; w.x = pk2(hv[0], hv[1]); w.y = pk2(hv[2], hv[3]); *(GAS v2u*)(H + off + c) = w; } }
                asm volatile("" ::: "memory"); }
    }
};

struct SchedPlain {
    const char* A; const char* B; int nM, nN, G, c; size_t tA, tB; int dup;
    __device__ __forceinline__ bool next(int i, Unit& u) const { int pm, pn; const int q = i / (dup * DUP_GEMM), r = i - q * (dup * DUP_GEMM); long L = (long)q * G + c; const int nwg = nM * nN; if (L >= nwg) return false;
        if (r) L = (L + nwg / 2 + 8) % nwg;
        if (!tile_order(L, nM, nN, pm, pn)) return false; u.A = A + (size_t)pm * tA; u.B = B + (size_t)pn * tB; u.pm = pm; u.pn = pn; u.aux = 0; u.last = 1; return true; }
};
struct SchedMerge {
    const char* A0; const char* A1; const char* A2; const char* B; int G, c;
    __device__ __forceinline__ bool next(int i, Unit& u) const { const int ti = i / 3, b = i - ti * 3; int pm, pn; const int q = ti / (DUPG6 * DUP_GEMM), r = ti - q * (DUPG6 * DUP_GEMM); long L = (long)q * G + c; if (L >= 256) return false; if (r) L = (L + 136) % 256;
        if (!tile_order(L, 32, 8, pm, pn)) return false;
        const char* Ab = b == 0 ? A0 : (b == 1 ? A1 : A2); u.A = Ab + (size_t)pm * 256 * 1024 * 2; u.B = B + ((size_t)b * 2048 + pn * 256) * 1024 * 2; u.pm = pm; u.pn = pn; u.aux = b; u.last = (b == 2); return true; }
};
struct SchedS5E {
    const char* UG; const char* ET; int G, c;
    __device__ __forceinline__ bool next(int i, Unit& u) const { const int L = (i / DUP_S5) * G + c; if (L >= 128) return false; const int g = L >> 1, pm = L & 1;
        u.A = UG + ((size_t)g * 512 + pm * 256) * 256 * 2; u.B = ET + (size_t)g * 256 * 256 * 2; u.pm = pm; u.pn = 0; u.aux = g; u.last = 1; return true; }
};
struct SchedS5Y {
    const char* UG; const char* HIN; const char* MT; const char* FT; int G, c;
    __device__ __forceinline__ bool next(int i, Unit& u) const { const int ti = (i >> 1) / DUP_S5, part = i & 1, L = ti * G + c; if (L >= 128) return false; const int g = L >> 1, pm = L & 1;
        u.A = (part ? HIN : UG) + ((size_t)g * 512 + pm * 256) * 256 * 2; u.B = (part ? FT : MT) + (size_t)g * 256 * 256 * 2; u.pm = pm; u.pn = 0; u.aux = g; u.last = part; return true; }
};
struct SchedOne {
    const char* A0; const char* B0; const char* A1; const char* B1; int pm, aux, nparts;
    __device__ __forceinline__ bool next(int i, Unit& u) const { if (i >= nparts) return false; u.A = i ? A1 : A0; u.B = i ? B1 : B0; u.pm = pm; u.pn = 0; u.aux = aux; u.last = (i == nparts - 1); return true; }
};
struct SchedRg {
    const char* XC; const char* GWT; int G, c;
    __device__ __forceinline__ bool next(int i, Unit& u) const { const int L = (i / DUP_RGG) * G + c; if (L >= 512) return false; const int pm = L & 31, hd = L >> 5;
        u.A = XC + ((size_t)pm * 256 * 1024 + (hd >> 1) * 128) * 2; u.B = GWT + (size_t)hd * 256 * 128 * 2; u.pm = pm; u.pn = 0; u.aux = hd; u.last = 1; return true; }
};
}

namespace att {
using bf16x8 = __attribute__((ext_vector_type(8))) short;
using s16x4  = __attribute__((ext_vector_type(4))) short;
using f32x16 = __attribute__((ext_vector_type(16))) float;
using u32x4  = __attribute__((ext_vector_type(4))) unsigned;
constexpr int D = 128, NW = 8, QBLK = 32, KVBLK = 64, LD = 1024;
constexpr float SCALE = 0.088388347648318440f, THR = 8.f;
constexpr size_t SHM_V = KVBLK * D * 2, SHM_K = KVBLK * D * 2, SHM_ATTN = 2 * SHM_V + 2 * SHM_K + NW * 64 * 4;
constexpr int RPB_OFF = (int)SHM_ATTN + 256;
#define KSWZ(row, colB) ((row) * 256 + ((colB) ^ (((row) & 7) << 4)))
#define SBAR() __builtin_amdgcn_sched_barrier(0)
__device__ __forceinline__ int crow(int r, int hi) { return (r & 3) + 8 * (r >> 2) + 4 * hi; }
__device__ __forceinline__ unsigned cvtpk(float lo, float hi) { return pk2(lo, hi); }
__device__ __forceinline__ void partialSM(f32x16& p0, f32x16& p1, float& m_reg, float& mn, float& alpha) {
  constexpr float C = SCALE * 1.4426950408889634f;
  float pmax = p0[0]; for (int r = 1; r < 16; ++r) pmax = fmaxf(pmax, p0[r]); for (int r = 0; r < 16; ++r) pmax = fmaxf(pmax, p1[r]);
  { auto rr = __builtin_amdgcn_permlane32_swap(__float_as_uint(pmax), __float_as_uint(pmax), false, false);
    pmax = fmaxf(__uint_as_float(rr[0]), __uint_as_float(rr[1])); }
  if (__builtin_expect(__all(pmax - m_reg <= THR / SCALE), 1)) { mn = m_reg; alpha = 1.f; }
  else { mn = fmaxf(m_reg, pmax); alpha = __builtin_amdgcn_exp2f((m_reg - mn) * C); m_reg = mn; }
  float mnC = -mn * C;
  for (int r = 0; r < 16; ++r) p0[r] = fmaf(p0[r], C, mnC); for (int r = 0; r < 16; ++r) p1[r] = fmaf(p1[r], C, mnC);
  for (int r = 0; r < 16; ++r) p0[r] = __builtin_amdgcn_exp2f(p0[r]);
}
__device__ __forceinline__ void finishSM(f32x16& p0, f32x16& p1, float alpha, float& l_reg, bf16x8& pa0, bf16x8& pa1, bf16x8& pa2, bf16x8& pa3) {
  for (int r = 0; r < 16; ++r) p1[r] = __builtin_amdgcn_exp2f(p1[r]);
  float ps = 0; for (int r = 0; r < 16; ++r) ps += p0[r]; for (int r = 0; r < 16; ++r) ps += p1[r];
  { auto rr = __builtin_amdgcn_permlane32_swap(__float_as_uint(ps), __float_as_uint(ps), false, false);
    ps = __uint_as_float(rr[0]) + __uint_as_float(rr[1]); }
  l_reg = l_reg * alpha + ps;
#define PK4(P, BASE, OUT) do { unsigned a0 = cvtpk(P[BASE + 0], P[BASE + 1]), a1 = cvtpk(P[BASE + 2], P[BASE + 3]);   \
    unsigned b0 = cvtpk(P[BASE + 4], P[BASE + 5]), b1 = cvtpk(P[BASE + 6], P[BASE + 7]);                              \
    auto r0 = __builtin_amdgcn_permlane32_swap(a0, b0, false, false); auto r1 = __builtin_amdgcn_permlane32_swap(a1, b1, false, false); \
    u32x4 w = {r0[0], r1[0], r0[1], r1[1]}; OUT = *reinterpret_cast<bf16x8*>(&w); } while (0)
  PK4(p0, 0, pa0); PK4(p0, 8, pa1); PK4(p1, 0, pa2); PK4(p1, 8, pa3);
#undef PK4
}
__device__ __forceinline__ void qkt(f32x16& p0, f32x16& p1, const bf16* Ks, const bf16x8* qr, int r32, int hi) {
  p0 = f32x16{}; p1 = f32x16{};
  for (int d0 = 0; d0 < 8; ++d0) { int cb = (d0 * 16 + hi * 8) * 2;
    bf16x8 b0 = *reinterpret_cast<const bf16x8*>((const char*)Ks + KSWZ(r32, cb));
    bf16x8 b1 = *reinterpret_cast<const bf16x8*>((const char*)Ks + KSWZ(32 + r32, cb));
    p0 = __builtin_amdgcn_mfma_f32_32x32x16_bf16(b0, qr[d0], p0, 0, 0, 0);
    p1 = __builtin_amdgcn_mfma_f32_32x32x16_bf16(b1, qr[d0], p1, 0, 0, 0); }
}
__device__ __forceinline__ int v_st(int k, int c) { const int kk = (k & ~0xC) | ((k & 4) << 1) | ((k & 8) >> 1); return ((kk >> 3) * 4 + (c >> 5)) * 512 + ((kk & 7) * 32 + (c & 31)) * 2; }
__device__ __forceinline__ int v_rd_base(int lane) { return ((lane & 3) << 3) | (((lane >> 2) & 3) << 6) | (((lane >> 4) & 1) << 5) | (((lane >> 5) & 1) << 8); }
constexpr int v_rd_off(int d0, int ks, int half) { return d0 * 512 + ks * 4096 + half * 2048; }
template <int OFF> __device__ __forceinline__ s16x4 tr_read(int vb) {
  s16x4 r; asm volatile("ds_read_b64_tr_b16 %0, %1 offset:%2" : "=&v"(r) : "v"(vb), "i"(OFF) : "memory"); return r;
}
template <int D0> __device__ __forceinline__ void pv_one(f32x16& od, int vb, bf16x8 pa0, bf16x8 pa1, bf16x8 pa2, bf16x8 pa3) {
  const s16x4 l0 = tr_read<v_rd_off(D0, 0, 0)>(vb), h0 = tr_read<v_rd_off(D0, 0, 1)>(vb), l1 = tr_read<v_rd_off(D0, 1, 0)>(vb), h1 = tr_read<v_rd_off(D0, 1, 1)>(vb);
  const s16x4 l2 = tr_read<v_rd_off(D0, 2, 0)>(vb), h2 = tr_read<v_rd_off(D0, 2, 1)>(vb), l3 = tr_read<v_rd_off(D0, 3, 0)>(vb), h3 = tr_read<v_rd_off(D0, 3, 1)>(vb);
  asm volatile("s_waitcnt lgkmcnt(0)" ::: "memory"); SBAR();
#define PK(L, H) (bf16x8){L[0], L[1], L[2], L[3], H[0], H[1], H[2], H[3]}
  od = __builtin_amdgcn_mfma_f32_32x32x16_bf16(pa0, PK(l0, h0), od, 0, 0, 0);
  od = __builtin_amdgcn_mfma_f32_32x32x16_bf16(pa1, PK(l1, h1), od, 0, 0, 0);
  od = __builtin_amdgcn_mfma_f32_32x32x16_bf16(pa2, PK(l2, h2), od, 0, 0, 0);
  od = __builtin_amdgcn_mfma_f32_32x32x16_bf16(pa3, PK(l3, h3), od, 0, 0, 0);
#undef PK
}
__device__ __forceinline__ void pv_d0(f32x16* o, int vb, bf16x8 pa0, bf16x8 pa1, bf16x8 pa2, bf16x8 pa3) {
  pv_one<0>(o[0], vb, pa0, pa1, pa2, pa3); pv_one<1>(o[1], vb, pa0, pa1, pa2, pa3); pv_one<2>(o[2], vb, pa0, pa1, pa2, pa3); pv_one<3>(o[3], vb, pa0, pa1, pa2, pa3);
}
__device__ __forceinline__ void na_mask(f32x16& p0, f32x16& p1, int kr, int qr, int rs, int ws, const float* rpbl, int hi) {
  if (kr < rs || kr >= rs + 8) {
#pragma unroll
    for (int r = 0; r < 16; ++r) { p0[r] = -1e30f; p1[r] = -1e30f; }
  } else {
    const float* row = rpbl + (kr - qr + 7) * 31 + 4 * hi; const unsigned w0 = (unsigned)(4 * hi - ws);
#pragma unroll
    for (int r = 0; r < 16; ++r) {
      const int kc = (r & 3) + 8 * (r >> 2);
      const float b0 = row[kc], b1 = row[kc + 32];
      p0[r] = (w0 + (unsigned)kc < 16u) ? p0[r] + b0 : -1e30f; p1[r] = (w0 + (unsigned)(kc + 32) < 16u) ? p1[r] + b1 : -1e30f;
      if ((r & 3) == 3) SBAR();
    }
  }
}
template <bool NA, int SD>
__device__ __forceinline__ void attn_body(const bf16* __restrict__ Qb, const bf16* __restrict__ K0, const bf16* __restrict__ V0, const bf16* __restrict__ K1, const bf16* __restrict__ V1,
                                          bf16* __restrict__ Ob, const int NT, const int lo, const int rg, char* lds) {
  int tid_ = threadIdx.x; asm volatile("" : "+v"(tid_));
  const int tid = tid_, wid = tid >> 6, lane = tid & 63, r32 = lane & 31, hi = lane >> 5;
  bf16* V_lds = (bf16*)lds; bf16* K_lds = (bf16*)(lds + 2 * SHM_V);
  float* ws_ = (float*)(lds + 2 * SHM_V + 2 * SHM_K) + wid * 64; float* li_l = ws_; float* al_l = ws_ + 32;
  const int qrow = 4 * rg + (wid >> 1), qc = 32 * (wid & 1) + r32;
  const int rs = qrow - 4 < 0 ? 0 : (qrow - 4 > 8 ? 8 : qrow - 4), wsn = qc - 8 < 0 ? 0 : (qc - 8 > 48 ? 48 : qc - 8);
  const float* rpbl = (const float*)(lds + RPB_OFF) + 15 - qc;
  float m_reg = -1e30f, l_reg = 0; f32x16 o[4] = {}; bf16x8 qr[8];
  const bf16* Qw = Qb + (long)(wid * QBLK + r32) * LD + hi * 8;
#pragma unroll
  for (int d0 = 0; d0 < 8; ++d0) qr[d0] = *(const GAS bf16x8*)(Qw + d0 * 16);
  const int sr = tid >> 4, sc = (tid & 15) * 8, vst0 = v_st(sr, sc), vst1 = v_st(32 + sr, sc);
  const int vb0 = (int)(uintptr_t)V_lds + v_rd_base(lane);
  struct { bf16x8 vs0, vs1, ks0, ks1; } sr_[SD];
#define TILEK(t) ((NA && (t) >= 8) ? K1 + (long)((t) - 8) * 64 * LD : K0 + (long)(t) * 64 * LD)
#define TILEV(t) ((NA && (t) >= 8) ? V1 + (long)((t) - 8) * 64 * LD : V0 + (long)(t) * 64 * LD)
#define SLOAD(i, t) do { const bf16* kp_ = TILEK(t); const bf16* vp_ = TILEV(t); \
    sr_[i].vs0 = *(const GAS bf16x8*)(&vp_[(long)sr * LD + sc]); sr_[i].vs1 = *(const GAS bf16x8*)(&vp_[(long)(32 + sr) * LD + sc]); \
    sr_[i].ks0 = *(const GAS bf16x8*)(&kp_[(long)sr * LD + sc]); sr_[i].ks1 = *(const GAS bf16x8*)(&kp_[(long)(32 + sr) * LD + sc]); } while (0)
#define SWRITE(b, i) do { *(bf16x8*)((char*)V_lds + (b) * SHM_V + vst0) = sr_[i].vs0;          \
    *(bf16x8*)((char*)V_lds + (b) * SHM_V + vst1) = sr_[i].vs1; int kc = sc * 2;               \
    *(bf16x8*)((char*)K_lds + (b) * SHM_K + KSWZ(sr, kc)) = sr_[i].ks0;                       \
    *(bf16x8*)((char*)K_lds + (b) * SHM_K + KSWZ(32 + sr, kc)) = sr_[i].ks1; } while (0)
#define SWAIT() do { if constexpr (SD == 2) asm volatile("s_waitcnt vmcnt(4)" ::: "memory"); else asm volatile("s_waitcnt vmcnt(0)" ::: "memory"); } while (0)
#define RESC(a) do { if (__any((a) < 1.f)) { if (hi == 0) al_l[r32] = (a); asm volatile("s_waitcnt lgkmcnt(0)" ::: "memory"); \
    for (int d = 0; d < 4; ++d) for (int r = 0; r < 16; ++r) o[d][r] *= al_l[crow(r, hi)]; } } while (0)
#define MASK(P0, P1, t) do { if (NA && (t) >= 8) na_mask(P0, P1, lo + (t) - 8, qrow, rs, wsn, rpbl, hi); } while (0)
  f32x16 pA0, pA1, pB0, pB1; float mnA, mnB, alA, alB; bf16x8 pa0, pa1, pa2, pa3;
  constexpr int SE = 0, SO = SD - 1;
  SLOAD(SE, 0); asm volatile("s_waitcnt vmcnt(0)" ::: "memory"); SWRITE(0, SE); __syncthreads();
  qkt(pA0, pA1, K_lds, qr, r32, hi); partialSM(pA0, pA1, m_reg, mnA, alA);
  SLOAD(SO, 1); if constexpr (SD == 2) { if (2 < NT) SLOAD(SE, 2); }
  SWAIT(); SWRITE(1, SO); __syncthreads();
  for (int j = 1; j + 1 < NT; j += 2) {
    SBAR(); qkt(pB0, pB1, (bf16*)((char*)K_lds + SHM_K), qr, r32, hi); MASK(pB0, pB1, j);
    finishSM(pA0, pA1, alA, l_reg, pa0, pa1, pa2, pa3); SBAR();
    SLOAD(SO, j + SD); SBAR();
    pv_d0(o, vb0, pa0, pa1, pa2, pa3); partialSM(pB0, pB1, m_reg, mnB, alB);
    __syncthreads(); SWAIT(); SWRITE(0, SE);
    RESC(alB); __syncthreads();
    SBAR(); qkt(pA0, pA1, K_lds, qr, r32, hi); MASK(pA0, pA1, j + 1);
    finishSM(pB0, pB1, alB, l_reg, pa0, pa1, pa2, pa3); SBAR();
    if (SD == 1 || j + 3 < NT) SLOAD(SE, j + 1 + SD); SBAR();
    pv_d0(o, vb0 + (int)SHM_V, pa0, pa1, pa2, pa3); partialSM(pA0, pA1, m_reg, mnA, alA);
    __syncthreads(); SWAIT(); SWRITE(1, SO);
    RESC(alA); __syncthreads();
  }
  SBAR(); qkt(pB0, pB1, (bf16*)((char*)K_lds + SHM_K), qr, r32, hi); MASK(pB0, pB1, NT - 1);
  finishSM(pA0, pA1, alA, l_reg, pa0, pa1, pa2, pa3); SBAR();
  pv_d0(o, vb0, pa0, pa1, pa2, pa3); partialSM(pB0, pB1, m_reg, mnB, alB);
  __syncthreads(); RESC(alB);
  finishSM(pB0, pB1, alB, l_reg, pa0, pa1, pa2, pa3); SBAR();
  pv_d0(o, vb0 + (int)SHM_V, pa0, pa1, pa2, pa3);
  if (hi == 0) li_l[r32] = l_reg; asm volatile("s_waitcnt lgkmcnt(0)" ::: "memory");
  float rli[16];
#pragma unroll
  for (int r = 0; r < 16; ++r) rli[r] = __builtin_amdgcn_rcpf(li_l[crow(r, hi)]);
  bf16* Ow = Ob + (long)(wid * QBLK) * LD;
#pragma unroll
  for (int r = 0; r < 16; ++r) { int orow = crow(r, hi);
    for (int d0 = 0; d0 < 4; ++d0) *(GAS bf16*)(Ow + (long)orow * LD + d0 * 32 + r32) = (bf16)f2bf(o[d0][r] * rli[r]); }
  asm volatile("s_waitcnt vmcnt(0)" ::: "memory"); __syncthreads();
#undef TILEK
#undef TILEV
#undef SLOAD
#undef SWRITE
#undef SWAIT
#undef RESC
#undef MASK
}
}

constexpr int NWAVES = 8;
struct Args { const float* in[36]; float* out; unsigned char* ws; int ph_lo, ph_hi; };
struct Frame { LAS unsigned char* lds; char* ldsg; volatile LAS unsigned* MISC; int tid, lane, wave, vcu, G; };
constexpr int INTAB_OFF = MISC_OFF + 128;
__device__ __forceinline__ const float* ld_in(const LAS unsigned char* lds, int i) { const unsigned long long v = ((const LAS unsigned long long*)(lds + INTAB_OFF))[i];
    const unsigned lo = __builtin_amdgcn_readfirstlane((unsigned)v), hi = __builtin_amdgcn_readfirstlane((unsigned)(v >> 32)); return (const float*)(((unsigned long long)hi << 32) | lo); }
#define IN(i) ld_in(F.lds, (i))

__device__ __forceinline__ void transpose_item(const float* W, int N, int k0, int n0, bf16* WT, int ldo, int drow0, float* scr, int lane) {
    const int kr = lane >> 3, n4 = (lane & 7) * 4;
    f32x4 v[8];
#pragma unroll
    for (int i = 0; i < 8; ++i) v[i] = *(const GAS f32x4*)(W + (size_t)(k0 + kr + 8 * i) * N + n0 + n4);
#pragma unroll
    for (int i = 0; i < 8; ++i) { float* d = scr + (kr + 8 * i) * 33 + n4; d[0] = v[i].x; d[1] = v[i].y; d[2] = v[i].z; d[3] = v[i].w; }
    LDS_WAIT(); asm volatile("" ::: "memory");
    const int c = lane & 7;
#pragma unroll
    for (int j = 0; j < 4; ++j) { const int n = (lane >> 3) + 8 * j; const float* s = scr + (8 * c) * 33 + n;
        v4u o; o.x = pk2(s[0 * 33], s[1 * 33]); o.y = pk2(s[2 * 33], s[3 * 33]); o.z = pk2(s[4 * 33], s[5 * 33]); o.w = pk2(s[6 * 33], s[7 * 33]);
        *(GAS v4u*)(WT + (size_t)(drow0 + n) * ldo + k0 + 8 * c) = o; }
    LDS_WAIT(); asm volatile("" ::: "memory");
}

__device__ __forceinline__ int cv_of_row(int row) { return row < CTXR ? 0 : 1 + ((row - CTXR) >> 10); }

template <bool FIRST, bool HASNEXT, bool XIN16, bool XOUT16>
__device__ __forceinline__ void resnorm_rows(const Frame& F, const float* xin0, const float* xin1, float* X, bf16* XB, const bf16* Z, const float* gpost, const float* modGate  ,
                                             const float* gpre, const float* modShift, const float* modScale, bf16* H) {
    const int gw = F.vcu * NWAVES + F.wave, NGW = F.G * NWAVES;
    for (int row = gw; row < ROWS; row += NGW) {
        const int cv = cv_of_row(row);
        f32x4 x[8];
        if (FIRST) {
            const GAS f32x4* src = (const GAS f32x4*)(row < CTXR ? xin0 + (size_t)row * DM : xin1 + (size_t)(row - CTXR) * DM);
#pragma unroll
            for (int j = 0; j < 8; ++j) x[j] = src[2 * (F.lane + 64 * (j >> 1)) + (j & 1)];
        } else {
            const GAS v4u* zr = (const GAS v4u*)(Z + (size_t)row * DM); const GAS f32x4* xr = (const GAS f32x4*)(X + (size_t)row * DM); const GAS v4u* xb = (const GAS v4u*)(XB + (size_t)row * DM);
            f32x4 xo_[8];
            if (XIN16) {
#pragma unroll
                for (int jj = 0; jj < 4; ++jj) { float f[8]; unpack8(xb[F.lane + 64 * jj], f); xo_[2 * jj] = (f32x4){f[0], f[1], f[2], f[3]}; xo_[2 * jj + 1] = (f32x4){f[4], f[5], f[6], f[7]}; }
            } else {
#pragma unroll
                for (int j = 0; j < 8; ++j) xo_[j] = xr[2 * (F.lane + 64 * (j >> 1)) + (j & 1)];
            }
            f32x4 z[8]; float ss = 0.f;
#pragma unroll
            for (int jj = 0; jj < 4; ++jj) { float f[8]; unpack8(zr[F.lane + 64 * jj], f); z[2 * jj] = (f32x4){f[0], f[1], f[2], f[3]}; z[2 * jj + 1] = (f32x4){f[4], f[5], f[6], f[7]}; }
#pragma unroll
            for (int j = 0; j < 8; ++j) ss += (z[j].x * z[j].x + z[j].y * z[j].y) + (z[j].z * z[j].z + z[j].w * z[j].w);
            const float rstd = rsqrtf(wave_sum(ss, F.lane) * (1.f / DM) + RMS_EPS);
#pragma unroll
            for (int j = 0; j < 8; ++j) { const int q = 2 * (F.lane + 64 * (j >> 1)) + (j & 1); const f32x4 gp = ((const GAS f32x4*)gpost)[q], gt = ((const GAS f32x4*)(modGate + (size_t)cv * 12288))[q];
                x[j] = xo_[j] + gt * (z[j] * rstd * gp); }
        }
        if (XOUT16) { GAS v4u* xo = (GAS v4u*)(XB + (size_t)row * DM);
#pragma unroll
          for (int jj = 0; jj < 4; ++jj) { const float f[8] = {x[2 * jj].x, x[2 * jj].y, x[2 * jj].z, x[2 * jj].w, x[2 * jj + 1].x, x[2 * jj + 1].y, x[2 * jj + 1].z, x[2 * jj + 1].w}; xo[F.lane + 64 * jj] = pack8(f); }
        } else { GAS f32x4* xo = (GAS f32x4*)(X + (size_t)row * DM);
#pragma unroll
          for (int j = 0; j < 8; ++j) xo[2 * (F.lane + 64 * (j >> 1)) + (j & 1)] = x[j]; }
        if (HASNEXT) {
            float ss = 0.f;
#pragma unroll
            for (int j = 0; j < 8; ++j) ss += (x[j].x * x[j].x + x[j].y * x[j].y) + (x[j].z * x[j].z + x[j].w * x[j].w);
            const float rstd = rsqrtf(wave_sum(ss, F.lane) * (1.f / DM) + RMS_EPS);
            GAS v4u* ho = (GAS v4u*)(H + (size_t)row * DM);
#pragma unroll
            for (int jj = 0; jj < 4; ++jj) { float f[8];
#pragma unroll
                for (int h = 0; h < 2; ++h) { const int q = 2 * (F.lane + 64 * jj) + h; const f32x4 g = ((const GAS f32x4*)gpre)[q], sh = ((const GAS f32x4*)(modShift + (size_t)cv * 12288))[q], sc = ((const GAS f32x4*)(modScale + (size_t)cv * 12288))[q];
                    const f32x4 hv = x[2 * jj + h] * rstd * g * (sc + 1.0f) + sh; f[4 * h] = hv.x; f[4 * h + 1] = hv.y; f[4 * h + 2] = hv.z; f[4 * h + 3] = hv.w; }
                ho[F.lane + 64 * jj] = pack8(f); }
        }
    }
}

__device__ __forceinline__ void s5_tables(const Frame& F, int l, int g, unsigned char* ws) {
    char* L = F.ldsg;
    f32x2* POW = (f32x2*)L;
    f32x2* BB = (f32x2*)(L + 17408);
    f32x2* CC = (f32x2*)(L + 17408 + 16384);
    float* KT = (float*)(L + 17408 + 32768);
    const int tid = F.tid;
    __syncthreads();
    if (tid < 128) {
        const int d = tid >> 6, p = tid & 63; const size_t li = ((size_t)(l * 2 + d) * 64 + g) * 64 + p;
        const float dt = expf(IN(22)[(l * 2 + d) * 64 + g]); const float lre = IN(20)[li], lim = IN(21)[li];
        const float er = expf(lre * dt); float sn, cs; sincosf(lim * dt, &sn, &cs);
        const float br = er * cs, bi = er * sn;
        const float nr = br - 1.0f, ni = bi, den = lre * lre + lim * lim;
        const float cr = (nr * lre + ni * lim) / den, ci = (ni * lre - nr * lim) / den;
        float pr = 1.f, pi = 0.f;
        for (int t = 0; t <= 16; ++t) { POW[(d * 64 + p) * 17 + t] = (f32x2){pr, pi}; const float nr2 = pr * br - pi * bi, ni2 = pr * bi + pi * br; pr = nr2; pi = ni2; }
        ((f32x2*)(ws + WS_LT))[li] = POW[(d * 64 + p) * 17 + 16];
        { f32x4 vr[4], vi[4]; const GAS f32x4* pr4 = (const GAS f32x4*)(IN(23) + li * 16); const GAS f32x4* pi4 = (const GAS f32x4*)(IN(24) + li * 16);
#pragma unroll
          for (int q = 0; q < 4; ++q) { vr[q] = pr4[q]; vi[q] = pi4[q]; }
#pragma unroll
          for (int m = 0; m < 16; ++m) { const float xr = vr[m >> 2][m & 3], xi = vi[m >> 2][m & 3]; BB[(d * 64 + p) * 16 + m] = (f32x2){cr * xr - ci * xi, cr * xi + ci * xr}; } }
    }
    for (int i = tid; i < 2048; i += 512) { const int d = i >> 10, n = (i >> 6) & 15, p = i & 63; const size_t ci_ = (((size_t)(l * 2 + d) * 64 + g) * 16 + n) * 64 + p; CC[i] = (f32x2){IN(25)[ci_], IN(26)[ci_]}; }
    __syncthreads();
    {
        const int d = tid >> 8, n = (tid >> 4) & 15, m = tid & 15; float acc[16];
#pragma unroll
        for (int t = 0; t < 16; ++t) acc[t] = 0.f;
        for (int p = 0; p < 64; ++p) { const f32x2 c = CC[(d * 16 + n) * 64 + p], b = BB[(d * 64 + p) * 16 + m]; const float cbr = c.x * b.x - c.y * b.y, cbi = c.x * b.y + c.y * b.x;
#pragma unroll
            for (int t = 0; t < 16; ++t) { const f32x2 w = POW[(d * 64 + p) * 17 + t]; acc[t] += cbr * w.x - cbi * w.y; } }
#pragma unroll
        for (int t = 0; t < 16; ++t) KT[((d * 16 + t) * 16 + n) * 16 + m] = acc[t];
    }
    __syncthreads();
    bf16* MT = (bf16*)(ws + WS_MT) + (size_t)(l * 64 + g) * 65536; bf16* ET = (bf16*)(ws + WS_ET) + (size_t)(l * 64 + g) * 65536; bf16* FT = (bf16*)(ws + WS_FT) + (size_t)(l * 64 + g) * 65536;
    for (int i = tid; i < 8192; i += 512) {
        const int rowi = i >> 5, k0 = (i & 31) * 8;
        { const int t = rowi >> 4, n = rowi & 15, s = k0 >> 4, m0 = k0 & 15; float f[8];
#pragma unroll
          for (int e = 0; e < 8; ++e) { float v = 0.f; if (s <= t) v += KT[((0 * 16 + (t - s)) * 16 + n) * 16 + m0 + e]; if (s >= t) v += KT[((1 * 16 + (s - t)) * 16 + n) * 16 + m0 + e]; f[e] = v; }
          *(GAS v4u*)(MT + (size_t)rowi * 256 + k0) = pack8(f); }
        { const int d = rowi >> 7, p = (rowi >> 1) & 63, c = rowi & 1, s = k0 >> 4, m0 = k0 & 15; float f[8];
          const f32x2 w = POW[(d * 64 + p) * 17 + (d == 0 ? 15 - s : s)];
#pragma unroll
          for (int e = 0; e < 8; ++e) { const f32x2 b = BB[(d * 64 + p) * 16 + m0 + e]; f[e] = c == 0 ? (w.x * b.x - w.y * b.y) : (w.x * b.y + w.y * b.x); }
          *(GAS v4u*)(ET + (size_t)rowi * 256 + k0) = pack8(f); }
        { const int t = rowi >> 4, n = rowi & 15; float f[8];
#pragma unroll
          for (int e = 0; e < 8; ++e) { const int k = k0 + e, d = k >> 7, p = (k >> 1) & 63, c = k & 1; const f32x2 cc = CC[(d * 16 + n) * 64 + p], w = POW[(d * 64 + p) * 17 + (d == 0 ? t + 1 : 16 - t)];
              f[e] = c == 0 ? (cc.x * w.x - cc.y * w.y) : -(cc.x * w.y + cc.y * w.x); }
          *(GAS v4u*)(FT + (size_t)rowi * 256 + k0) = pack8(f); }
    }
    __syncthreads();
}

constexpr int I_WIN = 32 * 384, I_GLU = 16 * 32, I_OUT = 16 * 64, I_WO = 32 * 64, I_FIN = 32 * 352, I_FOUT = 88 * 64, I_GW = 32 * 8;
constexpr int I_LAYER = I_WIN + I_GLU + 3 * I_OUT + I_WO + I_FIN + I_FOUT + I_GW;
__device__ __forceinline__ void weight_item(const Frame& F, unsigned char* ws, int l, int r, float* scr) {
    if (r < I_WIN) { const int kb = r / 384, nb = r % 384; transpose_item(IN(14) + (size_t)l * DM * INW, INW, kb * 64, nb * 32, (bf16*)(ws + WS_WINT) + (size_t)l * INW * DM, DM, nb * 32, scr, F.lane); return; } r -= I_WIN;
    if (r < I_GLU) { const int kb = r / 32, nb = r % 32; transpose_item(IN(28) + (size_t)l * 1024 * 1024, 1024, kb * 64, nb * 32, (bf16*)(ws + WS_GLUT) + (size_t)l * 1024 * 1024, 1024, nb * 32, scr, F.lane); return; } r -= I_GLU;
    if (r < 3 * I_OUT) { const int b = r / I_OUT, q = r % I_OUT, kb = q / 64, nb = q % 64; transpose_item(IN(30 + b) + (size_t)l * 1024 * DM, DM, kb * 64, nb * 32, (bf16*)(ws + WS_OUTT) + ((size_t)l * 3 + b) * DM * 1024, 1024, nb * 32, scr, F.lane); return; } r -= 3 * I_OUT;
    if (r < I_WO) { const int kb = r / 64, nb = r % 64; transpose_item(IN(33) + (size_t)l * DM * DM, DM, kb * 64, nb * 32, (bf16*)(ws + WS_WOT) + (size_t)l * DM * DM, DM, nb * 32, scr, F.lane); return; } r -= I_WO;
    if (r < I_FIN) { const int kb = r / 352, nb = r % 352; const int n0 = nb * 32, half = n0 >= FFH, j = n0 - half * FFH; const int drow = 256 * (j >> 7) + 128 * half + (j & 127);
        transpose_item(IN(34) + (size_t)l * DM * 2 * FFH, 2 * FFH, kb * 64, n0, (bf16*)(ws + WS_FINT) + (size_t)l * 2 * FFH * DM, DM, drow, scr, F.lane); return; } r -= I_FIN;
    if (r < I_FOUT) { const int kb = r / 64, nb = r % 64; transpose_item(IN(35) + (size_t)l * FFH * DM, DM, kb * 64, nb * 32, (bf16*)(ws + WS_FOUTT) + (size_t)l * DM * FFH, FFH, nb * 32, scr, F.lane); return; } r -= I_FOUT;
    { const int mi = r >> 3, q = r & 7, kb = q >> 2, nb = q & 3;
      const int d = mi >> 4, g = (mi >> 3) & 1, h = mi & 7;
      transpose_item(IN(17) + ((size_t)l * 32 + mi) * 128 * 128, 128, kb * 64, nb * 32, (bf16*)(ws + WS_GWT) + (((size_t)l * 8 + h) * 2 + d) * 256 * 128, 128, g * 128 + nb * 32, scr, F.lane); }
}
constexpr int QB = 16;
static_assert(I_LAYER % QB == 0, "queue batch");
constexpr int Q_P2 = 562 * QB, Q_P3 = 624 * QB, Q_P4 = 1374 * QB, Q_P5 = 1813 * QB, Q_P9 = I_LAYER;
constexpr int CW_Q = 8192;
__device__ __forceinline__ void pull_weight_items(const Frame& F, unsigned char* ws, int l, int upto) {
    if (l >= NL) return;
    unsigned* ctr = (unsigned*)(ws + WS_CTL) + CW_Q + 64 * l; float* scr = (float*)(F.ldsg + F.wave * 16384);
    const int upto_b = upto / QB;
    for (;;) {
        unsigned i = 0;
        if (F.lane == 0) asm volatile("global_atomic_add %0, %1, %2, off sc0\n\ts_waitcnt vmcnt(0)" : "=&v"(i) : "v"(ctr), "v"(1u) : "memory");
        i = (unsigned)__builtin_amdgcn_readfirstlane((int)i);
        if ((int)i >= upto_b) { if (F.lane == 0) asm volatile("global_atomic_sub %0, %1, off" :: "v"(ctr), "v"(1u) : "memory"); break; }
        for (int j = 0; j < QB; ++j) weight_item(F, ws, l, (int)i * QB + j, scr);
    }
}

constexpr int SQ_P5 = 5, SQ_P9 = 12, SQ_END = (SQ_P5 + SQ_P9) * 1024;
__device__ __forceinline__ void static_weight_items(const Frame& F, unsigned char* ws, int l, int c, int G, int k0, int nk) {
    if (l >= NL || G != 256 || c < 128) return;
    float* scr = (float*)(F.ldsg + F.wave * 16384); const int w = (c - 128) * 8 + F.wave;
    for (int k = 0; k < nk; ++k) weight_item(F, ws, l, (k0 + k) * 1024 + w, scr);
}

__global__ void __launch_bounds__(NWAVES * 64, 2) fwd_kernel(Args args) {
    extern __shared__ __attribute__((aligned(16))) unsigned char lds[];
    const int G0 = gridDim.x, c0 = (int)blockIdx.x;
    volatile LAS unsigned* MISC0 = (volatile LAS unsigned*)((LAS unsigned char*)lds + MISC_OFF);
    unsigned char* const ws0 = args.ws; float* const out0 = args.out;
    gu32* ctl = (gu32*)(ws0 + WS_CTL);
    for (int u = threadIdx.x; u < (LDS_BYTES - LDSCTL_OFF) / 4; u += NWAVES * 64) ((LAS unsigned*)((LAS unsigned char*)lds + LDSCTL_OFF))[u] = 0u;
    __syncthreads();
    if (threadIdx.x == 0) {
#pragma unroll
        for (int i = 0; i < 36; ++i) ((LAS unsigned long long*)((LAS unsigned char*)lds + INTAB_OFF))[i] = (unsigned long long)args.in[i]; }
    __syncthreads();
    XcdBarrier bar; bar.bar = (unsigned*)(ctl + CW_BAR); bar.x = 0; bar.st = nullptr;
    if (MK_N_LAUNCHES == 1) bar = xcd_barrier_post((unsigned*)(ctl + CW_BAR), MISC0 + 8);
    const int lo = args.ph_lo, hi = args.ph_hi;
    int ph = 0;
#ifndef PHMASK
#define PHMASK 0xFFFFFFFFu
#endif
#define PHASE_BEGIN(k) if (((PHMASK >> (k)) & 1u) && lo <= ph && ph < hi) { if ((k) == TSEL && threadIdx.x == 0) *(volatile LAS unsigned long long*)(MISC0 + 16) = __builtin_amdgcn_s_memrealtime(); unsigned char* ws = ws0; float* outp = out0; int tid_p = threadIdx.x, G = G0, c = c0; asm volatile("" : "+s"(ws), "+s"(outp), "+v"(tid_p), "+s"(G), "+s"(c)); const int vcu = (G % 8 == 0) ? (c % 8) * (G / 8) + c / 8 : c;     \
    Frame F; F.lds = (LAS unsigned char*)lds; F.ldsg = (char*)lds; F.MISC = (volatile LAS unsigned*)(F.lds + MISC_OFF); F.tid = tid_p; F.lane = tid_p & 63; F.wave = __builtin_amdgcn_readfirstlane(tid_p >> 6); F.G = G; F.vcu = vcu; \
    const int gw = vcu * NWAVES + F.wave, NGW = G * NWAVES, gt = vcu * 512 + F.tid, NGT = G * 512; (void)gw; (void)NGW; (void)gt; (void)NGT; \
    float* const X = outp + O_X; bf16* const Hb = (bf16*)(ws + WS_H); float* const MOD = (float*)(ws + WS_MOD); const float* const modl = MOD + (size_t)l_ * NCV * INW; (void)X; (void)Hb; (void)modl;
#define PHASE_END(k)   if (MK_N_LAUNCHES == 1 && ph + 1 < hi) { XcdBarrier b_ = bar; asm volatile("" : "+s"(b_.bar)); xcd_barrier(b_); } if ((k) == TSEL && threadIdx.x == 0) *(volatile LAS unsigned long long*)(MISC0 + 18) += __builtin_amdgcn_s_memrealtime() - *(volatile LAS unsigned long long*)(MISC0 + 16); } ++ph;
    int l_ = 0;

    PHASE_BEGIN(0)
    {
        for (int it = F.vcu; it < NL * 64; it += G) s5_tables(F, it >> 6, it & 63, ws);
        __syncthreads();
        { const float* lamp = IN(19); for (int i = gt; i < NL * 2 * 1024; i += NGT) ((float*)(ws + WS_SP))[i] = log1pf(expf(-lamp[i])); }
        float* scr = (float*)(F.ldsg + F.wave * 16384);
        { const int rest = (G == 256) ? I_LAYER - SQ_END : I_LAYER;
          for (int it = gw; it < I_LAYER + 3 * rest; it += NGW) { if (it < I_LAYER) weight_item(F, ws, 0, it, scr); else { const int q = it - I_LAYER, l = 1 + q / rest, r = q % rest; weight_item(F, ws, l, I_LAYER - rest + r, scr); } } }
        const float* ckp = IN(2); const float* cvp = IN(3);
        for (int i0 = gt; i0 < 2 * 1048576; i0 += 4 * NGT) { f32x4 a0[4], a1[4];
#pragma unroll
            for (int q = 0; q < 4; ++q) { const int i = i0 + q * NGT; if (i < 2 * 1048576) { const int which = i >> 20, j = i & 1048575; const GAS f32x4* s = (const GAS f32x4*)(which ? cvp : ckp) + (size_t)j * 2; a0[q] = s[0]; a1[q] = s[1]; } }
#pragma unroll
            for (int q = 0; q < 4; ++q) { const int i = i0 + q * NGT; if (i < 2 * 1048576) { const int which = i >> 20, j = i & 1048575;
                v4u o; o.x = pk2(a0[q].x, a0[q].y); o.y = pk2(a0[q].z, a0[q].w); o.z = pk2(a1[q].x, a1[q].y); o.w = pk2(a1[q].z, a1[q].w); ((GAS v4u*)(ws + (which ? WS_CV : WS_CK)))[j] = o; } } }
        const float* cctx = IN(7); const float* cvec = IN(6); const float* wmod = IN(8);
        for (int task = gt; task < 16 * NL * 3072; task += NGT) {
            const int n4 = task % 3072, l = (task / 3072) % NL, ks = task / (3072 * NL);
            f32x4 acc[NCV];
#pragma unroll
            for (int v = 0; v < NCV; ++v) acc[v] = (f32x4){0.f, 0.f, 0.f, 0.f};
            const GAS f32x4* wp = (const GAS f32x4*)(wmod + ((size_t)l * DM + ks * 128) * INW) + n4;
            for (int kb = 0; kb < 128; kb += 16) { f32x4 w[16];
#pragma unroll
                for (int j = 0; j < 16; ++j) w[j] = wp[(size_t)(kb + j) * (INW / 4)];
#pragma unroll
                for (int j = 0; j < 16; ++j) { const int kk = ks * 128 + kb + j;
#pragma unroll
                    for (int v = 0; v < NCV; ++v) { const float cnd = v == 0 ? cctx[kk] : cvec[(v - 1) * DM + kk]; const float sl = cnd * fsigmoid(cnd); acc[v] += w[j] * sl; } } }
#pragma unroll
            for (int v = 0; v < NCV; ++v) ((f32x4*)(ws + WS_MODP))[(((size_t)ks * NL + l) * NCV + v) * 3072 + n4] = acc[v];
        }
    }
    PHASE_END(0)
    PHASE_BEGIN(1)
        const float* bmod = IN(9);
        for (int i = gt; i < NL * NCV * 3072; i += NGT) { const int n4 = i % 3072, v = (i / 3072) % NCV, l = i / (3072 * NCV);
            f32x4 s = ((const f32x4*)(bmod + (size_t)l * INW))[n4];
            f32x4 pp[16];
#pragma unroll
            for (int ks = 0; ks < 16; ++ks) pp[ks] = ((const GAS f32x4*)(ws + WS_MODP))[(((size_t)ks * NL + l) * NCV + v) * 3072 + n4];
#pragma unroll
            for (int ks = 0; ks < 16; ++ks) s += pp[ks];
            ((f32x4*)MOD)[i] = s; }
    PHASE_END(1)
    PHASE_BEGIN(2)
        resnorm_rows<true, true, false, XRES_BF16 != 0>(F, IN(0), IN(1), X, (bf16*)(ws + WS_XB), nullptr, nullptr, nullptr, IN(10), MOD + 0 * DM, MOD + 1 * DM, Hb);
    PHASE_END(2)

    for (int l = 0; l < DBG_NL; ++l) {
        l_ = l;
        PHASE_BEGIN(3)
        {   pg8::SchedPlain S{(const char*)Hb, (const char*)(ws + WS_WINT) + (size_t)l * INW * DM * 2, 32, 48, G, c, (size_t)256 * DM * 2, (size_t)256 * DM * 2, DUPG1};
            pg8::EpiWin E{(bf16*)(ws + WS_XR), (bf16*)(ws + WS_XG), (bf16*)(ws + WS_UG), (bf16*)(ws + WS_Q), (bf16*)(ws + WS_K), (bf16*)(ws + WS_V), (bf16*)(ws + WS_G),
                          outp + O_K + (size_t)l * 256 * 1024, outp + O_V + (size_t)l * 256 * 1024};
            pg8::gemm_phase(F.lds, DM, DM, DM, S, E); }
        PHASE_END(3)
        PHASE_BEGIN(4)
        {
            { const bf16* XR = (const bf16*)(ws + WS_XR); bf16* XC = (bf16*)(ws + WS_XC); const GAS float* cw = (const GAS float*)(IN(15) + (size_t)l * 4 * 1024); const GAS float* cb = (const GAS float*)(IN(16) + (size_t)l * 1024);
              for (int i_ = gt; i_ < ROWS * 128 * DUP_CONV; i_ += NGT) { const int i = i_ % (ROWS * 128); const int row = i >> 7, c8 = (i & 127) * 8;
                  const int s0 = row < CTXR ? (row & ~255) : (CTXR + ((row - CTXR) & ~1023)), s1 = row < CTXR ? s0 + 256 : s0 + 1024;
                  v4u xw[4];
#pragma unroll
                  for (int k = 0; k < 4; ++k) { int rr = row + k - 1; rr = rr < s0 ? s0 : (rr >= s1 ? s1 - 1 : rr); xw[k] = *(const GAS v4u*)(XR + (size_t)rr * 1024 + c8); }
                  f32x4 cw0[4], cw1[4]; const f32x4 cb0 = *(const GAS f32x4*)(cb + c8), cb1 = *(const GAS f32x4*)(cb + c8 + 4);
#pragma unroll
                  for (int k = 0; k < 4; ++k) { cw0[k] = *(const GAS f32x4*)(cw + k * 1024 + c8); cw1[k] = *(const GAS f32x4*)(cw + k * 1024 + c8 + 4); }
                  float acc[8] = {cb0[0], cb0[1], cb0[2], cb0[3], cb1[0], cb1[1], cb1[2], cb1[3]};
#pragma unroll
                  for (int k = 0; k < 4; ++k) { const int rr = row + k - 1; const float ok = (rr >= s0 && rr < s1) ? 1.0f : 0.0f; float xv[8]; unpack8(xw[k], xv);
#pragma unroll
                      for (int e = 0; e < 8; ++e) acc[e] += ok * (e < 4 ? cw0[k][e] : cw1[k][e - 4]) * xv[e]; }
                  *(GAS v4u*)(XC + (size_t)row * 1024 + c8) = pack8(acc); } }
            for (int L = c; L < 128 * DUP_S5; L += G) { const int g = (L & 127) >> 1, pm = L & 1;
                { pg8::SchedOne S{(const char*)(ws + WS_UG) + ((size_t)g * 512 + pm * 256) * 256 * 2, (const char*)(ws + WS_ET) + ((size_t)l * 64 + g) * 65536 * 2, nullptr, nullptr, pm, g, 1}; pg8::EpiHloc E{(float*)(ws + WS_HLOC)};
                  pg8::gemm_phase(F.lds, 256, 256, 256, S, E); }
                { const float* HLOC = (const float*)(ws + WS_HLOC); bf16* HIN = (bf16*)(ws + WS_HIN); const GAS f32x2* LT = (const GAS f32x2*)(ws + WS_LT) + (size_t)l * 2 * 64 * 64;
                  const int nseq = pm ? 4 : 16, nch = pm ? 64 : 16;
                  for (int i = F.tid; i < nseq * 128; i += 512) { const int p = i & 63, d = (i >> 6) & 1, sq = i >> 7; const int seq = pm ? 16 + sq : sq, ch0 = pm ? 256 + sq * 64 : sq * 16;
                      const f32x2 lam = LT[(d * 64 + g) * 64 + p]; float hr = 0.f, hi_ = 0.f;
                      if (pm) { const f32x2 h0 = ((const f32x2*)IN(5))[((((size_t)sq * 4 + l) * 2 + d) * 64 + g) * 64 + p]; hr = h0.x; hi_ = h0.y; }
                      for (int kb = 0; kb < nch; kb += 16) { f32x2 hl[16];
#pragma unroll
                          for (int j = 0; j < 16; ++j) { const int ch = d == 0 ? ch0 + kb + j : ch0 + nch - 1 - kb - j; hl[j] = *(const GAS f32x2*)(HLOC + ((size_t)g * 512 + ch) * 256 + d * 128 + p * 2); }
#pragma unroll
                          for (int j = 0; j < 16; ++j) { const int ch = d == 0 ? ch0 + kb + j : ch0 + nch - 1 - kb - j; *(GAS unsigned*)(HIN + ((size_t)g * 512 + ch) * 256 + d * 128 + p * 2) = pk2(hr, hi_);
                              const float nr = lam.x * hr - lam.y * hi_ + hl[j].x, ni = lam.x * hi_ + lam.y * hr + hl[j].y; hr = nr; hi_ = ni; } }
                      if (!pm) ((f32x2*)(outp + O_S5))[((((size_t)seq * 4 + l) * 2 + d) * 64 + g) * 64 + p] = (f32x2){hr, hi_}; }
                  VM_WAIT(); __syncthreads(); }
                { pg8::SchedOne S{(const char*)(ws + WS_UG) + ((size_t)g * 512 + pm * 256) * 256 * 2, (const char*)(ws + WS_MT) + ((size_t)l * 64 + g) * 65536 * 2,
                                  (const char*)(ws + WS_HIN) + ((size_t)g * 512 + pm * 256) * 256 * 2, (const char*)(ws + WS_FT) + ((size_t)l * 64 + g) * 65536 * 2, pm, g, 2};
                  pg8::EpiS5Y E{(const bf16*)(ws + WS_UG), IN(27) + (size_t)l * 1024, (bf16*)(ws + WS_ZS)};
                  pg8::gemm_phase(F.lds, 256, 256, 256, S, E); }
            }
            __syncthreads();
            { float* rp = (float*)(F.ldsg + att::RPB_OFF); const bf16* Qb = (const bf16*)(ws + WS_Q); const bf16* Kb = (const bf16*)(ws + WS_K); const bf16* Vb = (const bf16*)(ws + WS_V); bf16* Ob = (bf16*)(ws + WS_YNA);
              for (int u_ = (c + G / 2) % G; u_ < 256 * DUP_ATT; u_ += G) { const int u = u_ & 255;
                  if (u < 128) { const int b = u >> 5, h = (u >> 2) & 7, rg = u & 3; const int lo_ = rg == 0 ? 0 : (rg == 1 ? 0 : (rg == 2 ? 4 : 8)), NT = (rg == 0 || rg == 3) ? 16 : 20;
                      for (int i = F.tid; i < 465; i += 512) rp[i] = IN(29)[((size_t)l * 8 + h) * 465 + i] * (1.0f / att::SCALE);
                      __syncthreads();
                      const size_t qoff = (size_t)(CTXR + b * 1024 + rg * 256) * 1024 + h * 128, koff = (size_t)(CTXR + b * 1024 + lo_ * 64) * 1024 + h * 128, coff = ((size_t)(b * 4 + l) * 512) * 1024 + h * 128;
                      att::attn_body<true, 1>(Qb + qoff, (const bf16*)(ws + WS_CK) + coff, (const bf16*)(ws + WS_CV) + coff, Kb + koff, Vb + koff, Ob + qoff, NT, lo_, rg, F.ldsg);
                  } else { const int b = (u - 128) >> 3, h = (u - 128) & 7; const size_t off = (size_t)(b * 256) * 1024 + h * 128;
                      att::attn_body<false, 2>(Qb + off, Kb + off, Vb + off, Kb + off, Vb + off, Ob + off, 4, 0, 0, F.ldsg); }
              } }
        }
        PHASE_END(4)
        PHASE_BEGIN(5)
        {   { pg8::SchedRg S{(const char*)(ws + WS_XC), (const char*)(ws + WS_GWT) + (size_t)l * 8 * 2 * 256 * 128 * 2, G, c};
              pg8::EpiRg E{(const bf16*)(ws + WS_XC), IN(18) + (size_t)l * 4 * 1024, (const float*)(ws + WS_SP) + (size_t)l * 2048, (f32x2*)(ws + WS_AB)};
              pg8::gemm_phase(F.lds, 128, 1024, 128, S, E); }
            { pg8::SchedPlain S{(const char*)(ws + WS_ZS), (const char*)(ws + WS_GLUT) + (size_t)l * 1024 * 1024 * 2, 32, 4, G, c, (size_t)256 * 1024 * 2, (size_t)256 * 1024 * 2, 1};
              pg8::EpiGlu E{(const bf16*)(ws + WS_ZS), (bf16*)(ws + WS_YS5)};
              pg8::gemm_phase(F.lds, 1024, 1024, 1024, S, E); }
            __syncthreads(); static_weight_items(F, ws, l + 1, c, G, 0, SQ_P5);
        }
        PHASE_END(5)
        PHASE_BEGIN(6)
        {
            { const GAS unsigned* AB = (const GAS unsigned*)(ws + WS_AB); GAS float* HF = (GAS float*)(ws + WS_HF); const GAS bf16* XG = (const GAS bf16*)(ws + WS_XG); GAS bf16* YRG = (GAS bf16*)(ws + WS_YRG);
              float* cs = (float*)F.ldsg;
              for (int task_ = (c + G / 2) % G; task_ < 320 * DUP_SCAN; task_ += G) { const int task = task_ % 320;
                  const bool lat = task >= 64 && task < 128; const int ti = lat ? task - 64 : (task < 64 ? task : task - 64); const int seq = ti >> 4, cb = ti & 15;
                  const int L = lat ? 1024 : 256, row0 = lat ? CTXR + seq * 1024 : seq * 256, ch = cb * 64 + F.lane, len = L / 8, t0 = row0 + F.wave * len;
                  __syncthreads();
                  float pf = 1.f, hf = 0.f, pb = 1.f, hb = 0.f;
                  for (int tb = 0; tb < len; tb += 16) { unsigned v[16];
#pragma unroll
                      for (int j = 0; j < 16; ++j) v[j] = AB[(size_t)(t0 + tb + j) * 1024 + ch];
#pragma unroll
                      for (int j = 0; j < 16; ++j) { const float a = 1.0f - bflo(v[j]); hf = a * hf + bfhi(v[j]); pf *= a; } }
                  for (int tb = len - 16; tb >= 0; tb -= 16) { unsigned v[16];
#pragma unroll
                      for (int j = 0; j < 16; ++j) v[j] = AB[((size_t)ROWS + t0 + tb + j) * 1024 + ch];
#pragma unroll
                      for (int j = 15; j >= 0; --j) { const float a = 1.0f - bflo(v[j]); hb = a * hb + bfhi(v[j]); pb *= a; } }
                  cs[(F.wave * 4 + 0) * 64 + F.lane] = pf; cs[(F.wave * 4 + 1) * 64 + F.lane] = hf; cs[(F.wave * 4 + 2) * 64 + F.lane] = pb; cs[(F.wave * 4 + 3) * 64 + F.lane] = hb;
                  __syncthreads();
                  float cf = lat ? IN(4)[((size_t)(seq * 4 + l) * 2 + 0) * 1024 + ch] : 0.f, cbk = lat ? IN(4)[((size_t)(seq * 4 + l) * 2 + 1) * 1024 + ch] : 0.f;
                  for (int w = 0; w < F.wave; ++w) cf = cs[(w * 4 + 0) * 64 + F.lane] * cf + cs[(w * 4 + 1) * 64 + F.lane];
                  for (int w = 7; w > F.wave; --w) cbk = cs[(w * 4 + 2) * 64 + F.lane] * cbk + cs[(w * 4 + 3) * 64 + F.lane];
                  if (!lat) { if (F.wave == 7) outp[O_RG + ((size_t)(seq * 4 + l) * 2 + 0) * 1024 + ch] = pf * cf + hf; if (F.wave == 0) outp[O_RG + ((size_t)(seq * 4 + l) * 2 + 1) * 1024 + ch] = pb * cbk + hb; }
                  float h = cf;
                  for (int tb = 0; tb < len; tb += 16) { unsigned v[16];
#pragma unroll
                      for (int j = 0; j < 16; ++j) v[j] = AB[(size_t)(t0 + tb + j) * 1024 + ch];
#pragma unroll
                      for (int j = 0; j < 16; ++j) { h = (1.0f - bflo(v[j])) * h + bfhi(v[j]); HF[(size_t)(t0 + tb + j) * 1024 + ch] = h; } }
                  VM_WAIT();
                  h = cbk;
                  for (int tb = len - 16; tb >= 0; tb -= 16) { unsigned v[16]; float hfv[16]; bf16 xg[16];
#pragma unroll
                      for (int j = 0; j < 16; ++j) { const size_t o = (size_t)(t0 + tb + j) * 1024 + ch; v[j] = AB[(size_t)ROWS * 1024 + o]; hfv[j] = HF[o]; xg[j] = XG[o]; }
#pragma unroll
                      for (int j = 15; j >= 0; --j) { h = (1.0f - bflo(v[j])) * h + bfhi(v[j]); YRG[(size_t)(t0 + tb + j) * 1024 + ch] = (bf16)f2bf((hfv[j] + h) * bf2f(xg[j])); } }
              } }
        }
        PHASE_END(6)
        PHASE_BEGIN(8)
        {   pg8::SchedMerge S{(const char*)(ws + WS_YRG), (const char*)(ws + WS_YS5), (const char*)(ws + WS_YNA), (const char*)(ws + WS_OUTT) + (size_t)l * 3 * DM * 1024 * 2, G, c};
            pg8::EpiMerge E{(const bf16*)(ws + WS_G), (bf16*)(ws + WS_MM)};
            pg8::gemm_phase(F.lds, 1024, 1024, 1024, S, E); }
        PHASE_END(8)
#if FUSE_NORM
        PHASE_BEGIN(9)
        {   pg8::SchedPlain S{(const char*)(ws + WS_MM), (const char*)(ws + WS_WOT) + (size_t)l * DM * DM * 2, 32, 8, G, c, (size_t)256 * DM * 2, (size_t)256 * DM * 2, 1};
            unsigned* ctlw = (unsigned*)(ws + WS_CTL); const int b0 = (l * 2 + 0) * 2;
            pg8::PanelSS s1{(float*)(ws + WS_XS) + (size_t)b0 * 65536, ctlw + CW_SEAM + b0 * SEAM_BANK, ctlw + CW_TMO}, s2{(float*)(ws + WS_XS) + (size_t)(b0 + 1) * 65536, ctlw + CW_SEAM + (b0 + 1) * SEAM_BANK, ctlw + CW_TMO};
            pg8::EpiResNorm E{X, Hb, IN(11) + (size_t)l * DM, modl + 2 * DM, IN(12) + (size_t)l * DM, modl + 3 * DM, modl + 4 * DM, s1, s2, 1};
            pg8::gemm_phase(F.lds, DM, DM, DM, S, E); }
        PHASE_END(9)
#else
        PHASE_BEGIN(9)
        {   pg8::SchedPlain S{(const char*)(ws + WS_MM), (const char*)(ws + WS_WOT) + (size_t)l * DM * DM * 2, 32, 8, G, c, (size_t)256 * DM * 2, (size_t)256 * DM * 2, 1};
            pg8::EpiB16 E{(bf16*)(ws + WS_Z), DM};
            pg8::gemm_phase(F.lds, DM, DM, DM, S, E); }
        PHASE_END(9)
        PHASE_BEGIN(10)
            resnorm_rows<false, true, XRES_BF16 != 0, XRES_BF16 != 0>(F, nullptr, nullptr, X, (bf16*)(ws + WS_XB), (const bf16*)(ws + WS_Z), IN(11) + (size_t)l * DM, modl + 2 * DM, IN(12) + (size_t)l * DM, modl + 3 * DM, modl + 4 * DM, Hb);
        PHASE_END(10)
#endif
        PHASE_BEGIN(11)
        {   pg8::SchedPlain S{(const char*)Hb, (const char*)(ws + WS_FINT) + (size_t)l * 2 * FFH * DM * 2, 32, 44, G, c, (size_t)256 * DM * 2, (size_t)256 * DM * 2, DUPG9};
            pg8::EpiSwiglu E{(bf16*)(ws + WS_FH)};
            pg8::gemm_phase(F.lds, DM, DM, DM, S, E);
            __syncthreads(); static_weight_items(F, ws, l + 1, c, G, SQ_P5, SQ_P9); }
        PHASE_END(11)
#if FUSE_NORM
        PHASE_BEGIN(12)
        {   pg8::SchedPlain S{(const char*)(ws + WS_FH), (const char*)(ws + WS_FOUTT) + (size_t)l * DM * FFH * 2, 32, 8, G, c, (size_t)256 * FFH * 2, (size_t)256 * FFH * 2, DUPG10};
            unsigned* ctlw = (unsigned*)(ws + WS_CTL); const int b0 = (l * 2 + 1) * 2; const int ln = l + 1 < NL ? l + 1 : l;
            pg8::PanelSS s1{(float*)(ws + WS_XS) + (size_t)b0 * 65536, ctlw + CW_SEAM + b0 * SEAM_BANK, ctlw + CW_TMO}, s2{(float*)(ws + WS_XS) + (size_t)(b0 + 1) * 65536, ctlw + CW_SEAM + (b0 + 1) * SEAM_BANK, ctlw + CW_TMO};
            pg8::EpiResNorm E{X, Hb, IN(13) + (size_t)l * DM, modl + 5 * DM, IN(10) + (size_t)ln * DM, MOD + (size_t)ln * NCV * INW + 0 * DM, MOD + (size_t)ln * NCV * INW + 1 * DM, s1, s2, (l + 1 < NL) ? 1 : 0};
            pg8::gemm_phase(F.lds, FFH, FFH, FFH, S, E); }
        PHASE_END(12)
#else
        PHASE_BEGIN(12)
        {   pg8::SchedPlain S{(const char*)(ws + WS_FH), (const char*)(ws + WS_FOUTT) + (size_t)l * DM * FFH * 2, 32, 8, G, c, (size_t)256 * FFH * 2, (size_t)256 * FFH * 2, DUPG10};
            pg8::EpiB16 E{(bf16*)(ws + WS_Z), DM};
            pg8::gemm_phase(F.lds, FFH, FFH, FFH, S, E); }
        PHASE_END(12)
        PHASE_BEGIN(13)
            if (l + 1 < NL) resnorm_rows<false, true, XRES_BF16 != 0, XRES_BF16 != 0>(F, nullptr, nullptr, X, (bf16*)(ws + WS_XB), (const bf16*)(ws + WS_Z), IN(13) + (size_t)l * DM, modl + 5 * DM, IN(10) + (size_t)(l + 1) * DM, modl + NCV * INW + 0 * DM, modl + NCV * INW + 1 * DM, Hb);
            else resnorm_rows<false, false, XRES_BF16 != 0, false>(F, nullptr, nullptr, X, (bf16*)(ws + WS_XB), (const bf16*)(ws + WS_Z), IN(13) + (size_t)l * DM, modl + 5 * DM, nullptr, nullptr, nullptr, Hb);
        PHASE_END(13)
#endif
    }
#if DBG_KEEP
    PHASE_BEGIN(14)
        for (size_t i = (size_t)gt; i < O_END; i += (size_t)NGT) {
            int r, lay = 0;
            if (i < O_K) r = i < O_K / 2 ? 0 : 1;
            else if (i < O_V) { r = 2; lay = (int)(((i - O_K) / (256 * 1024)) & 3); }
            else if (i < O_RG) { r = 3; lay = (int)(((i - O_V) / (256 * 1024)) & 3); }
            else if (i < O_S5) { r = 4; lay = (int)(((i - O_RG) / 2048) & 3); }
            else { r = 5; lay = (int)(((i - O_S5) / 16384) & 3); }
            const bool keep = ((DBG_KEEP >> r) & 1) && (r < 2 || ((DBG_LMASK >> lay) & 1));
            float v = keep ? 3.0f * outp[i] : 0.0f;
#if DBG_DUMP
            v = 0.f;
            if (i >= O_K && i < O_K + (size_t)ROWS * 1024) { const size_t j = i - O_K;
                if (DBG_DUMP == 1) v = bf2f(((const bf16*)(ws + WS_YNA))[j]);
                if (DBG_DUMP == 2) v = bf2f(((const bf16*)(ws + WS_YS5))[j]);
                if (DBG_DUMP == 3) v = bf2f(((const bf16*)(ws + WS_YRG))[j]);
                if (DBG_DUMP == 4) v = bf2f(((const bf16*)(ws + WS_ZS))[j]);
                if (DBG_DUMP == 5) v = bf2f(((const bf16*)(ws + WS_MM))[j]);
                if (DBG_DUMP == 6) v = ((const bf16*)(ws + WS_Z))[j];
                if (DBG_DUMP == 7) v = bf2f(((const bf16*)(ws + WS_FH))[j]);
                if (DBG_DUMP == 8) v = bf2f(((const bf16*)(ws + WS_H))[j]);
                if (DBG_DUMP == 9) v = bf2f(((const bf16*)(ws + WS_G))[j]);
                if (DBG_DUMP == 11) v = bf2f(((const bf16*)(ws + WS_G))[(size_t)8192 * 6144 + j]);
                if (DBG_DUMP == 10) v = bf2f(((const bf16*)(ws + WS_WINT))[(size_t)6144 * 2048 + j]);
            }
#endif
            outp[i] = v;
        }
    PHASE_END(14)
#endif
    if (TSEL >= 0 && blockIdx.x == 0 && threadIdx.x == 0) { const float us = (float)(*(volatile LAS unsigned long long*)(MISC0 + 18)) * 0.01f; out0[0] = exp2f(rintf(log2f(us) * 10.0f) * 0.1f); }
#undef PHASE_BEGIN
#undef PHASE_END
}
constexpr int N_PHASES = 3 + DBG_NL * (FUSE_NORM ? 8 : 10) + (DBG_KEEP ? 1 : 0);

extern "C" void kernel_launch(void* const* d_in, const int* in_sizes, int n_in, void* d_out, int out_size, void* d_ws, size_t ws_size, hipStream_t stream) {
    static int grid = 0;
    if (grid == 0) {
        if (n_in != 36 || out_size != (int)O_END || ws_size < WS_END) { fprintf(stderr, "kernel_launch: unexpected shapes (n_in %d out %d ws %zu)\n", n_in, out_size, ws_size); grid = -1; return; }
        int dev = 0, cus = 0, per_cu = 0;
        if (hipGetDevice(&dev) != hipSuccess || hipDeviceGetAttribute(&cus, hipDeviceAttributeMultiprocessorCount, dev) != hipSuccess) { grid = -1; return; }
        if (hipFuncSetAttribute((const void*)fwd_kernel, hipFuncAttributeMaxDynamicSharedMemorySize, LDS_BYTES) != hipSuccess) { fprintf(stderr, "kernel_launch: hipFuncSetAttribute failed\n"); grid = -1; return; }
        if (hipOccupancyMaxActiveBlocksPerMultiprocessor(&per_cu, (const void*)fwd_kernel, NWAVES * 64, LDS_BYTES) != hipSuccess || per_cu < 1) { fprintf(stderr, "kernel_launch: occupancy query reports %d blocks per CU\n", per_cu); }
        (void)hipGetLastError();
        grid = cus;
        if (FUSE_NORM && cus != 256) { fprintf(stderr, "kernel_launch: the fused residual+norm epilogues need exactly 256 workgroups (one 256x256 tile each); build with -DFUSE_NORM=0 for %d CUs\n", cus); grid = -1; return; }
    }
    if (grid < 0) return;
    if (hipMemsetAsync((char*)d_ws + WS_CTL, 0, CTL_ZERO_BYTES, stream) != hipSuccess) return;
    Args a{};
    for (int i = 0; i < 36; ++i) a.in[i] = (const float*)d_in[i];
    a.out = (float*)d_out; a.ws = (unsigned char*)d_ws;
    if (MK_N_LAUNCHES == 1) { a.ph_lo = 0; a.ph_hi = N_PHASES; hipLaunchKernelGGL(fwd_kernel, dim3(grid), dim3(NWAVES * 64), LDS_BYTES, stream, a); }
    else for (int p = 0; p < N_PHASES; ++p) { a.ph_lo = p; a.ph_hi = p + 1; hipLaunchKernelGGL(fwd_kernel, dim3(grid), dim3(NWAVES * 64), LDS_BYTES, stream, a); }
}
```

```cpp
#include <hip/hip_runtime.h>
#include <hip/hip_bf16.h>
#include <cstdio>
#include <cstdint>

#ifndef MK_N_LAUNCHES
#define MK_N_LAUNCHES 1
#endif
#ifndef DBG_KEEP
#define DBG_KEEP 0
#endif
#ifndef DUP_SCAN
#define DUP_SCAN 1
#endif
#ifndef DUP_ATT
#define DUP_ATT 1
#endif
#ifndef DUP_CARRY
#define DUP_CARRY 1
#endif
#ifndef DUP_CONV
#define DUP_CONV 1
#endif
#ifndef DUP_RGG
#define DUP_RGG 1
#endif
#ifndef DUP_S5
#define DUP_S5 1
#endif
#ifndef TSEL
#define TSEL (-1)
#endif
#ifndef DUPG1
#define DUPG1 1
#endif
#ifndef DUPG6
#define DUPG6 1
#endif
#ifndef DUPG9
#define DUPG9 1
#endif
#ifndef DUPG10
#define DUPG10 1
#endif
#ifndef DUP_GEMM
#define DUP_GEMM 1
#endif
#ifndef DUP_MASK
#define DUP_MASK 0u
#endif
#ifndef DBG_LMASK
#define DBG_LMASK 15
#endif
#ifndef DBG_DUMP
#define DBG_DUMP 0
#endif
#ifndef DBG_NL
#define DBG_NL 4
#endif

constexpr int DM = 2048, ROWS = 8192, CTXR = 4096, INW = 12288, FFH = 5632, NL = 4, W1K = 1024;
constexpr int NCV = 5;
constexpr float RMS_EPS = 1e-6f;
constexpr size_t MiB = 1u << 20;

constexpr size_t O_X = 0, O_K = 16777216, O_V = 33554432, O_RG = 50331648, O_S5 = 50462720, O_END = 51511296;

constexpr size_t WS_CTL = 0, CTL_ZERO_BYTES = 1 * MiB;
constexpr size_t WS_MODP = 1 * MiB;
constexpr size_t WS_MOD  = 17 * MiB;
constexpr size_t WS_SP   = 18 * MiB;
constexpr size_t WS_LT   = 18 * MiB + 65536;
constexpr size_t WS_GWT  = 19 * MiB;
constexpr size_t WS_WINT = 24 * MiB;
constexpr size_t WS_GLUT = 216 * MiB;
constexpr size_t WS_OUTT = 224 * MiB;
constexpr size_t WS_WOT  = 272 * MiB;
constexpr size_t WS_FINT = 304 * MiB;
constexpr size_t WS_FOUTT = 480 * MiB;
constexpr size_t WS_MT   = 568 * MiB;
constexpr size_t WS_ET   = 600 * MiB;
constexpr size_t WS_FT   = 632 * MiB;
constexpr size_t WS_CK   = 664 * MiB;
constexpr size_t WS_CV   = 680 * MiB;
constexpr size_t WS_H    = 696 * MiB;
constexpr size_t WS_XR   = 728 * MiB;
constexpr size_t WS_XG   = 744 * MiB;
constexpr size_t WS_XC   = 760 * MiB;
constexpr size_t WS_Q    = 776 * MiB;
constexpr size_t WS_K    = 792 * MiB;
constexpr size_t WS_V    = 808 * MiB;
constexpr size_t WS_YRG  = 824 * MiB;
constexpr size_t WS_YS5  = 840 * MiB;
constexpr size_t WS_YNA  = 856 * MiB;
constexpr size_t WS_ZS   = 872 * MiB;
constexpr size_t WS_UG   = 888 * MiB;
constexpr size_t WS_HIN  = 904 * MiB;
constexpr size_t WS_G    = 920 * MiB;
constexpr size_t WS_AB   = 1016 * MiB;
constexpr size_t WS_FH   = 1016 * MiB;
constexpr size_t WS_HF   = 1144 * MiB;
constexpr size_t WS_HLOC = 1176 * MiB;
constexpr size_t WS_Z    = 1144 * MiB;
constexpr size_t WS_MM   = 1208 * MiB;
constexpr size_t WS_XS   = 1240 * MiB;
constexpr size_t WS_XB   = 1244 * MiB;
constexpr size_t WS_END  = 1276 * MiB;

constexpr int CW_TMO = 0, CW_BAR = 4096;
constexpr int CW_SEAM = 16384, SEAM_BANK = 32 * 64;
#ifndef XRES_BF16
#define XRES_BF16 1
#endif
#ifndef FUSE_NORM
#define FUSE_NORM 0
#endif

constexpr int RING_BYTES = 131072;
constexpr int LDSCTL_OFF = RING_BYTES, MISC_OFF = LDSCTL_OFF + 320;
constexpr int LDS_BYTES = 147456;

#define GAS __attribute__((address_space(1)))
#define LAS __attribute__((address_space(3)))
typedef unsigned short bf16;
typedef unsigned v4u __attribute__((ext_vector_type(4)));
typedef unsigned v2u __attribute__((ext_vector_type(2)));
typedef float f32x4 __attribute__((ext_vector_type(4)));
typedef float f32x2 __attribute__((ext_vector_type(2)));
typedef short bf16x8 __attribute__((ext_vector_type(8)));
typedef GAS unsigned gu32;
#define RLX_AGENT __ATOMIC_RELAXED, __HIP_MEMORY_SCOPE_AGENT
#define LDS_WAIT() asm volatile("s_waitcnt lgkmcnt(0)" ::: "memory")
#define VM_WAIT() asm volatile("s_waitcnt vmcnt(0)" ::: "memory")

__device__ __forceinline__ unsigned f2bf(float f) { unsigned u = __builtin_bit_cast(unsigned, f); return (u + 0x7fffu + ((u >> 16) & 1u)) >> 16; }
typedef __bf16 bf16x2_t __attribute__((ext_vector_type(2)));
__device__ __forceinline__ unsigned pk2(float lo, float hi) { const f32x2 v = {lo, hi}; const bf16x2_t b = __builtin_convertvector(v, bf16x2_t); return __builtin_bit_cast(unsigned, b); }
__device__ __forceinline__ float bflo(unsigned w) { return __builtin_bit_cast(float, w << 16); }
__device__ __forceinline__ float bfhi(unsigned w) { return __builtin_bit_cast(float, w & 0xffff0000u); }
__device__ __forceinline__ float bf2f(bf16 h) { return __builtin_bit_cast(float, (unsigned)h << 16); }
__device__ __forceinline__ float fsigmoid(float x) { return __builtin_amdgcn_rcpf(1.0f + __expf(-x)); }
__device__ __forceinline__ float gelu_tanh(float x) { const float y = 0.7978845608028654f * (x + 0.044715f * x * x * x); return x * __builtin_amdgcn_rcpf(1.0f + __expf(-2.0f * y)); }
__device__ __forceinline__ float wave_sum(float v, int lane) {
#pragma unroll
    for (int o = 1; o < 64; o <<= 1) v += __builtin_bit_cast(float, __builtin_amdgcn_ds_bpermute((lane ^ o) << 2, __builtin_bit_cast(int, v)));
    return v;
}
__device__ __forceinline__ void unpack8(const v4u w, float (&f)[8]) { f[0] = bflo(w.x); f[1] = bfhi(w.x); f[2] = bflo(w.y); f[3] = bfhi(w.y); f[4] = bflo(w.z); f[5] = bfhi(w.z); f[6] = bflo(w.w); f[7] = bfhi(w.w); }
__device__ __forceinline__ v4u pack8(const float (&f)[8]) { v4u w; w.x = pk2(f[0], f[1]); w.y = pk2(f[2], f[3]); w.z = pk2(f[4], f[5]); w.w = pk2(f[6], f[7]); return w; }

#define XB_TMO      128
#define XB_XCNT(j)  (256  + 64 * (j))
#define XB_XSUB(j)  (1280 + 64 * (j))
#define XB_XGEN(j)  (2304 + 64 * (j))
#define XB_TOP      3328
#define XB_TOPGEN   3392
#define XCD_BAR_WORDS 3456
#define XB_SPIN_CAP (1u << 18)
__device__ __forceinline__ unsigned xb_ld(unsigned* p)              { return __hip_atomic_load(p, __ATOMIC_RELAXED, __HIP_MEMORY_SCOPE_AGENT); }
__device__ __forceinline__ unsigned xb_add(unsigned* p, unsigned v) { return __hip_atomic_fetch_add(p, v, __ATOMIC_RELAXED, __HIP_MEMORY_SCOPE_AGENT); }
__device__ __forceinline__ unsigned xb_xcc_id() { return (unsigned)__builtin_amdgcn_s_getreg((3 << 11) | 20) & 0xFu; }
#define XB_SPIN(cond, bar) do { unsigned _sp = 0; while (cond) { __builtin_amdgcn_s_sleep(1); \
    if ((++_sp & 255u) == 0u) { if (xb_ld(&(bar)[XB_TMO])) break; if (_sp > XB_SPIN_CAP) { atomicAdd(&(bar)[XB_TMO], 1u); break; } } } } while (0)
struct XcdBarrier { unsigned* bar; unsigned x; volatile LAS unsigned* st; };
__device__ __forceinline__ XcdBarrier xcd_barrier_post(unsigned* bar, volatile LAS unsigned* st) {
    XcdBarrier b; b.bar = bar; b.x = xb_xcc_id(); b.st = st;
    if (threadIdx.x == 0) (void)xb_add(&bar[XB_XCNT(b.x)], 1u);
    return b;
}
__device__ __forceinline__ void xcd_barrier_complete(unsigned* bar, unsigned x, unsigned& nloc, unsigned& nx) {
    const unsigned G = gridDim.x * gridDim.y * gridDim.z;
    unsigned sum, cnt, mine, sp = 0u;
    for (;;) {
        sum = 0u; cnt = 0u; mine = 0u;
#pragma unroll
        for (unsigned j = 0; j < 16; ++j) { const unsigned c = xb_ld(&bar[XB_XCNT(j)]); sum += c; cnt += (c > 0u) ? 1u : 0u; mine = (j == x) ? c : mine; }
        if (sum == G) break;
        __builtin_amdgcn_s_sleep(1);
        if ((++sp & 255u) == 0u) { if (xb_ld(&bar[XB_TMO])) break; if (sp > XB_SPIN_CAP) { atomicAdd(&bar[XB_TMO], 1u); break; } }
    }
    nloc = mine > 0u ? mine : 1u; nx = cnt > 0u ? cnt : 1u;
}
__device__ __forceinline__ void xcd_barrier(const XcdBarrier& b) {
    asm volatile("s_waitcnt vmcnt(0)" ::: "memory");
    __syncthreads();
    int tid_b = threadIdx.x; asm volatile("" : "+v"(tid_b));
    if (tid_b == 0) {
        unsigned* bar = b.bar;
        __builtin_amdgcn_s_waitcnt(0);
        unsigned nloc = b.st[0], nx = b.st[1];
        if (nloc == 0u) { xcd_barrier_complete(bar, b.x, nloc, nx); b.st[0] = nloc; b.st[1] = nx; }
        const unsigned old = xb_add(&bar[XB_XSUB(b.x)], 1u);
        const unsigned gen = old / nloc;
        if (old + 1u == (gen + 1u) * nloc) {
            __builtin_amdgcn_fence(__ATOMIC_RELEASE, "agent");
            asm volatile("s_waitcnt vmcnt(0)" ::: "memory");
            const unsigned og = xb_add(&bar[XB_TOP], 1u);
            const unsigned tg = og / nx;
            if (og + 1u == (tg + 1u) * nx) xb_add(&bar[XB_TOPGEN], 1u);
            else XB_SPIN(xb_ld(&bar[XB_TOPGEN]) == tg, bar);
            __builtin_amdgcn_fence(__ATOMIC_ACQUIRE, "agent");
            xb_add(&bar[XB_XGEN(b.x)], 1u);
            asm volatile("s_waitcnt vmcnt(0)" ::: "memory");
        } else {
            XB_SPIN(xb_ld(&bar[XB_XGEN(b.x)]) == gen, bar);
            __builtin_amdgcn_fence(__ATOMIC_ACQUIRE, "agent");
            asm volatile("s_waitcnt vmcnt(0)" ::: "memory");
        }
    }
    __syncthreads();
}

namespace pg8 {
#define PG8_LAS __attribute__((address_space(3)))
constexpr int BM = 256, BK = 64, HALF = 128, HTB = HALF * BK * 2, STAGE_BYTES = 8 * HTB;
__host__ __device__ __forceinline__ int lds_byte(int r, int c) { const int st = (r >> 4) * 2 + (c >> 5), rr = r & 15, cc = c & 31, ob = rr * 64 + cc * 2; return st * 1024 + (ob ^ (((ob >> 9) & 1) << 5)); }
__host__ __device__ __forceinline__ void stage_rc(int b, int& R, int& C) { const int st = b / 1024, sb = b % 1024, swz = sb ^ (((sb >> 9) & 1) << 5); R = (st >> 1) * 16 + swz / 64; C = (st & 1) * 32 + (swz % 64) / 2; }
__host__ __device__ __forceinline__ int perm32(int rho) { const int n = rho >> 4, i = rho & 15; return 8 * (i >> 2) + 4 * n + (i & 3); }

struct Unit { const char* A; const char* B; int pm, pn, aux, last; };

__device__ __forceinline__ bool tile_order(long L, int nM, int nN, int& pm, int& pn) {
    const int nwg = nM * nN; if (L >= nwg) return false;
    int wgid = (int)L; { const int q = nwg / 8, r = nwg % 8, xcd = wgid % 8, off = wgid / 8; wgid = (xcd < r ? xcd * (q + 1) : r * (q + 1) + (xcd - r) * q) + off; }
    const int nig = 8 * nN, gid = wgid / nig, fm = gid * 8, gsz = (nM - fm) < 8 ? (nM - fm) : 8;
    pm = fm + ((wgid % nig) % gsz); pn = (wgid % nig) / gsz; return true;
}

typedef float f32x4 __attribute__((ext_vector_type(4)));
typedef short bf16x8 __attribute__((ext_vector_type(8)));

template <class Epi, class Sched>
__device__ __forceinline__ void gemm_phase(PG8_LAS unsigned char* lds, const int K, const int lda, const int ldb, const Sched& S, const Epi& E) {
    int tid_ = threadIdx.x; asm volatile("" : "+v"(tid_));
    const int tid = tid_, wid = __builtin_amdgcn_readfirstlane(tid >> 6), lane = tid & 63, wr = wid >> 2, wc = wid & 3, fr = lane & 15, fq = lane >> 4;
    const int nt = K / BK;
    unsigned voffA[2], voffB[2];
#pragma unroll
    for (int i = 0; i < 2; ++i) { int R, C; stage_rc(tid * 16 + i * 8192, R, C); const int Rb = Epi::PERM ? ((R & ~31) + perm32(R & 31)) : R;
        voffA[i] = (unsigned)(R * lda + C) * 2u; voffB[i] = (unsigned)(Rb * ldb + C) * 2u; }
    const size_t kstep = (size_t)(BK * 2);
    const size_t hstepA = (size_t)HALF * lda * 2, hstepB = (size_t)HALF * ldb * 2;
    const unsigned ldsw = (unsigned)wid * 1024u;
    const int aoff = lds_byte(wr * 64 + fr, fq * 8), boff = lds_byte(wc * 32 + fr, fq * 8);
#define PG8_SA(b, h) (((b) * 2 + (h)) * HTB)
#define PG8_SB(b, h) ((4 + (b) * 2 + (h)) * HTB)
#define PG8_STAGE(bufoff, gbase, voff) do { _Pragma("unroll") for (int _i = 0; _i < 2; ++_i) \
        __builtin_amdgcn_global_load_lds((const unsigned*)((const char*)(gbase) + (voff)[_i]), (PG8_LAS unsigned*)(lds + (bufoff) + ldsw + _i * 8192), 16, 0, 0); } while (0)
#define PG8_LDA(dst, b, h) do { _Pragma("unroll") for (int m = 0; m < 4; ++m) _Pragma("unroll") for (int k = 0; k < 2; ++k) dst[m][k] = *(const PG8_LAS bf16x8*)(lds + PG8_SA(b, h) + aoff + m * 2048 + k * 1024); } while (0)
#define PG8_LDB(dst, b, h) do { _Pragma("unroll") for (int n = 0; n < 2; ++n) _Pragma("unroll") for (int k = 0; k < 2; ++k) dst[n][k] = *(const PG8_LAS bf16x8*)(lds + PG8_SB(b, h) + boff + n * 2048 + k * 1024); } while (0)
#define PG8_MMA(ai, bj, At, Bt) do { __builtin_amdgcn_s_setprio(1); _Pragma("unroll") for (int m = 0; m < 4; ++m) _Pragma("unroll") for (int n = 0; n < 2; ++n) _Pragma("unroll") for (int k = 0; k < 2; ++k) \
        acc[ai][bj][m][n] = __builtin_amdgcn_mfma_f32_16x16x32_bf16(Bt[n][k], At[m][k], acc[ai][bj][m][n], 0, 0, 0); __builtin_amdgcn_s_setprio(0); } while (0)
#define PG8_WAIT_V(n) asm volatile("s_waitcnt vmcnt(" #n ")" ::: "memory")
#define PG8_WAIT_L(n) asm volatile("s_waitcnt lgkmcnt(" #n ")" ::: "memory")
#define PG8_BAR __builtin_amdgcn_s_barrier()
#define PG8_SCHED __builtin_amdgcn_sched_barrier(0)
    Unit cur, nxt; int ui = 0;
    if (!S.next(0, cur)) return;
    f32x4 acc[2][2][4][2];
#pragma unroll
    for (int a = 0; a < 2; ++a)
#pragma unroll
        for (int b = 0; b < 2; ++b)
#pragma unroll
            for (int m = 0; m < 4; ++m)
#pragma unroll
                for (int n = 0; n < 2; ++n) acc[a][b][m][n] = (f32x4){0.f, 0.f, 0.f, 0.f};
    bf16x8 At[4][2], B0[2][2], B1[2][2];
    const char* cA = cur.A; const char* cB = cur.B;
    PG8_STAGE(PG8_SB(0, 0), cB, voffB); PG8_STAGE(PG8_SB(0, 1), cB + hstepB, voffB); PG8_STAGE(PG8_SA(0, 0), cA, voffA); PG8_STAGE(PG8_SA(0, 1), cA + hstepA, voffA);
    if (wr == 1) PG8_BAR;
    PG8_WAIT_V(2); PG8_BAR;
    PG8_STAGE(PG8_SB(1, 0), cB + kstep, voffB); PG8_STAGE(PG8_SA(1, 0), cA + kstep, voffA); PG8_STAGE(PG8_SB(1, 1), cB + hstepB + kstep, voffB);
    PG8_WAIT_V(6); PG8_BAR;
    for (;;) {
        const bool has_next = S.next(ui + 1, nxt);
        const char* nA = has_next ? nxt.A : cA; const char* nB = has_next ? nxt.B : cB;
#pragma unroll 1
        for (int t = 0; t < nt; t += 2) {
            const bool last = (t == nt - 2);
            const char* a1 = cA + (size_t)(t + 1) * kstep;
            const char* a2 = last ? nA : cA + (size_t)(t + 2) * kstep; const char* b2 = last ? nB : cB + (size_t)(t + 2) * kstep;
            const char* a3 = a2 + kstep; const char* b3 = b2 + kstep;
            PG8_LDB(B0, 0, 0); PG8_LDB(B1, 0, 1); PG8_SCHED; PG8_LDA(At, 0, 0); PG8_STAGE(PG8_SA(1, 1), a1 + hstepA, voffA);
            PG8_WAIT_V(8); PG8_WAIT_L(0); PG8_BAR; PG8_MMA(0, 0, At, B0); PG8_MMA(0, 1, At, B1); PG8_BAR; PG8_SCHED;
            PG8_LDA(At, 0, 1); PG8_STAGE(PG8_SB(0, 0), b2, voffB); PG8_STAGE(PG8_SB(0, 1), b2 + hstepB, voffB); PG8_STAGE(PG8_SA(0, 0), a2, voffA);
            PG8_WAIT_V(8); PG8_WAIT_L(0); PG8_BAR; PG8_MMA(1, 0, At, B0); PG8_MMA(1, 1, At, B1); PG8_BAR; PG8_SCHED;
            PG8_LDB(B0, 1, 0); PG8_LDB(B1, 1, 1); PG8_SCHED; PG8_LDA(At, 1, 0); PG8_STAGE(PG8_SA(0, 1), a2 + hstepA, voffA);
            PG8_WAIT_V(8); PG8_WAIT_L(0); PG8_BAR; PG8_MMA(0, 0, At, B0); PG8_MMA(0, 1, At, B1); PG8_BAR; PG8_SCHED;
            PG8_LDA(At, 1, 1); PG8_STAGE(PG8_SB(1, 0), b3, voffB); PG8_STAGE(PG8_SB(1, 1), b3 + hstepB, voffB); PG8_STAGE(PG8_SA(1, 0), a3, voffA);
            PG8_WAIT_V(8); PG8_WAIT_L(0); PG8_BAR; PG8_MMA(1, 0, At, B0); PG8_MMA(1, 1, At, B1); PG8_BAR; PG8_SCHED;
        }
        if (wr == 0) PG8_BAR;
        if (cur.last) { if constexpr (!Epi::AFTER_DRAIN) E(acc, cur, wr, wc, fr, fq); } else E.mid(acc, cur, wr, wc, fr, fq);
        if (!has_next) break;
        if (cur.last) {
#pragma unroll
            for (int a = 0; a < 2; ++a)
#pragma unroll
                for (int b = 0; b < 2; ++b)
#pragma unroll
                    for (int m = 0; m < 4; ++m)
#pragma unroll
                        for (int n = 0; n < 2; ++n) acc[a][b][m][n] = (f32x4){0.f, 0.f, 0.f, 0.f};
        }
        cur = nxt; cA = nA; cB = nB; ++ui;
        if (wr == 1) PG8_BAR;
    }
    PG8_WAIT_V(0);
    PG8_BAR;
    if constexpr (Epi::AFTER_DRAIN) E.fused(acc, cur, wr, wc, fr, fq, lds, wid, lane);
#undef PG8_SA
#undef PG8_SB
#undef PG8_STAGE
#undef PG8_LDA
#undef PG8_LDB
#undef PG8_MMA
#undef PG8_WAIT_V
#undef PG8_WAIT_L
#undef PG8_BAR
#undef PG8_SCHED
}

typedef const f32x4 (&AccC)[2][2][4][2];
typedef f32x4 (&AccM)[2][2][4][2];
#define EPI_ROWS_BEGIN _Pragma("unroll") for (int ai = 0; ai < 2; ++ai) _Pragma("unroll") for (int m = 0; m < 4; ++m) { const int row = u.pm * 256 + ai * 128 + wr * 64 + m * 16 + fr;
#define EPI_ROWS_END }

#define EPI_NO_MID static constexpr bool AFTER_DRAIN = false; __device__ __forceinline__ void mid(AccM, const Unit&, int, int, int, int) const {} __device__ __forceinline__ void fused(AccM, const Unit&, int, int, int, int, PG8_LAS unsigned char*, int, int) const {}

struct EpiB16 {
    EPI_NO_MID
    static constexpr bool PERM = true;
    bf16* O; int ldc;
    __device__ __forceinline__ void operator()(AccC acc, const Unit& u, int wr, int wc, int fr, int fq) const {
        const int col0 = u.pn * 256 + wc * 32 + 8 * fq;
        EPI_ROWS_BEGIN
#pragma unroll
            for (int bj = 0; bj < 2; ++bj) { const f32x4 v0 = acc[ai][bj][m][0], v1 = acc[ai][bj][m][1]; const float f[8] = {v0[0], v0[1], v0[2], v0[3], v1[0], v1[1], v1[2], v1[3]};
                *(GAS v4u*)(O + (size_t)row * ldc + col0 + bj * 128) = pack8(f); }
        EPI_ROWS_END
    }
};
struct EpiHloc {
    EPI_NO_MID
    static constexpr bool PERM = false;
    float* O;
    __device__ __forceinline__ void operator()(AccC acc, const Unit& u, int wr, int wc, int fr, int fq) const {
        const int col0 = wc * 32 + 4 * fq; float* base = O + (size_t)u.aux * 512 * 256;
        EPI_ROWS_BEGIN
            float* rowp = base + (size_t)row * 256 + col0;
#pragma unroll
            for (int bj = 0; bj < 2; ++bj)
#pragma unroll
                for (int n = 0; n < 2; ++n) *(GAS f32x4*)(rowp + bj * 128 + n * 16) = acc[ai][bj][m][n];
        EPI_ROWS_END
    }
};
struct EpiWin {
    EPI_NO_MID
    static constexpr bool PERM = true;
    bf16 *XR, *XG, *UG, *Q, *Kb, *Vb, *G; float *outK, *outV;
    __device__ __forceinline__ void operator()(AccC acc, const Unit& u, int wr, int wc, int fr, int fq) const {
        const int pn = u.pn, seg = pn >> 2;
        const int cseg = (pn & 3) * 256 + wc * 32 + 8 * fq;
        EPI_ROWS_BEGIN
#pragma unroll
            for (int bj = 0; bj < 2; ++bj) {
                const f32x4 v0 = acc[ai][bj][m][0], v1 = acc[ai][bj][m][1];
                float f[8] = {v0[0], v0[1], v0[2], v0[3], v1[0], v1[1], v1[2], v1[3]};
                const int c = cseg + bj * 128;
                if (seg >= 6) {
#pragma unroll
                    for (int e = 0; e < 8; ++e) f[e] = fsigmoid(f[e]);
                    *(GAS v4u*)(G + (size_t)row * 6144 + (pn - 24) * 256 + wc * 32 + 8 * fq + bj * 128) = pack8(f);
                } else if (seg == 1) {
#pragma unroll
                    for (int e = 0; e < 8; ++e) f[e] = gelu_tanh(f[e]);
                    *(GAS v4u*)(XG + (size_t)row * 1024 + c) = pack8(f);
                } else if (seg == 2) {
                    const int g = c >> 4, m0 = c & 15;
                    *(GAS v4u*)(UG + ((size_t)g * 512 + (row >> 4)) * 256 + (row & 15) * 16 + m0) = pack8(f);
                } else {
                    bf16* dst = seg == 0 ? XR : (seg == 3 ? Q : (seg == 4 ? Kb : Vb));
                    *(GAS v4u*)(dst + (size_t)row * 1024 + c) = pack8(f);
                    if (seg >= 4 && row < CTXR) {
                        float* o = (seg == 4 ? outK : outV) + ((size_t)(row >> 8) * 4 * 256 + (row & 255)) * 1024 + c;
                        *(f32x4*)o = v0; *(GAS f32x4*)(o + 4) = v1;
                    }
                }
            }
        EPI_ROWS_END
    }
};
struct EpiRg {
    EPI_NO_MID
    static constexpr bool PERM = true;
    const bf16* XC; const float* gb; const float* sp; f32x2* AB;
    __device__ __forceinline__ void operator()(AccC acc, const Unit& u, int wr, int wc, int fr, int fq) const {
        const int h = u.aux >> 1, d = u.aux & 1, c0 = h * 128 + wc * 32 + 8 * fq;
        const GAS float* gbr = (const GAS float*)(gb + (d * 2 + 0) * 1024 + c0); const GAS float* gbi = (const GAS float*)(gb + (d * 2 + 1) * 1024 + c0); const GAS float* spp = (const GAS float*)(sp + d * 1024 + c0);
        EPI_ROWS_BEGIN
            float xc[8]; unpack8(*(const GAS v4u*)(XC + (size_t)row * 1024 + c0), xc);
            const f32x4 r0 = acc[ai][0][m][0], r1 = acc[ai][0][m][1], i0 = acc[ai][1][m][0], i1 = acc[ai][1][m][1];
            const float rr[8] = {r0[0], r0[1], r0[2], r0[3], r1[0], r1[1], r1[2], r1[3]}, ii[8] = {i0[0], i0[1], i0[2], i0[3], i1[0], i1[1], i1[2], i1[3]};
            unsigned* dst = (unsigned*)AB + ((size_t)d * ROWS + row) * 1024 + c0;
            v4u o0, o1; unsigned w[8];
#pragma unroll
            for (int e = 0; e < 8; ++e) {
                const float r = fsigmoid(rr[e] + gbr[e]), ig = fsigmoid(ii[e] + gbi[e]);
                const float la = -8.0f * r * spp[e]; const float a = __expf(la); const float om = 1.0f - a; const float mult = __builtin_amdgcn_sqrtf(om * (1.0f + a));
                w[e] = pk2(om, mult * ig * xc[e]);
            }
            o0.x = w[0]; o0.y = w[1]; o0.z = w[2]; o0.w = w[3]; o1.x = w[4]; o1.y = w[5]; o1.z = w[6]; o1.w = w[7];
            *(GAS v4u*)dst = o0; *(GAS v4u*)(dst + 4) = o1;
            asm volatile("" ::: "memory");
        EPI_ROWS_END
    }
};
struct EpiS5Y {
    EPI_NO_MID
    static constexpr bool PERM = true;
    const bf16* UG; const float* dvec; bf16* ZS;
    __device__ __forceinline__ void operator()(AccC acc, const Unit& u, int wr, int wc, int fr, int fq) const {
        const int g = u.aux;
        EPI_ROWS_BEGIN
#pragma unroll
            for (int bj = 0; bj < 2; ++bj) {
                const int col = bj * 128 + wc * 32 + 8 * fq, t = col >> 4, n0 = col & 15;
                float uu[8]; unpack8(*(const GAS v4u*)(UG + ((size_t)g * 512 + row) * 256 + col), uu);
                const f32x4 v0 = acc[ai][bj][m][0], v1 = acc[ai][bj][m][1];
                float f[8] = {v0[0], v0[1], v0[2], v0[3], v1[0], v1[1], v1[2], v1[3]};
#pragma unroll
                for (int e = 0; e < 8; ++e) f[e] = gelu_tanh(f[e] + ((const GAS float*)dvec)[g * 16 + n0 + e] * uu[e]);
                *(GAS v4u*)(ZS + ((size_t)row * 16 + t) * 1024 + g * 16 + n0) = pack8(f);
            }
        EPI_ROWS_END
    }
};
struct EpiGlu {
    EPI_NO_MID
    static constexpr bool PERM = true;
    const bf16* ZS; bf16* Y;
    __device__ __forceinline__ void operator()(AccC acc, const Unit& u, int wr, int wc, int fr, int fq) const {
        const int col0 = u.pn * 256 + wc * 32 + 8 * fq;
        EPI_ROWS_BEGIN
#pragma unroll
            for (int bj = 0; bj < 2; ++bj) {
                float z[8]; unpack8(*(const GAS v4u*)(ZS + (size_t)row * 1024 + col0 + bj * 128), z);
                const f32x4 v0 = acc[ai][bj][m][0], v1 = acc[ai][bj][m][1];
                float f[8] = {v0[0], v0[1], v0[2], v0[3], v1[0], v1[1], v1[2], v1[3]};
#pragma unroll
                for (int e = 0; e < 8; ++e) f[e] = z[e] * fsigmoid(f[e]);
                *(GAS v4u*)(Y + (size_t)row * 1024 + col0 + bj * 128) = pack8(f);
            }
        EPI_ROWS_END
    }
};
struct EpiMerge {
    static constexpr bool PERM = true, AFTER_DRAIN = false;
    __device__ __forceinline__ void fused(AccM, const Unit&, int, int, int, int, PG8_LAS unsigned char*, int, int) const {}
    const bf16* G; bf16* MM;
    __device__ __forceinline__ void mid(AccM acc, const Unit& u, int wr, int wc, int fr, int fq) const {
        const int col0 = u.pn * 256 + wc * 32 + 8 * fq, b = u.aux;
        EPI_ROWS_BEGIN
#pragma unroll
            for (int bj = 0; bj < 2; ++bj) {
                float ga[8], gn[8]; unpack8(*(const GAS v4u*)(G + (size_t)row * 6144 + b * 2048 + col0 + bj * 128), ga); unpack8(*(const GAS v4u*)(G + (size_t)row * 6144 + (b + 1) * 2048 + col0 + bj * 128), gn);
#pragma unroll
                for (int e = 0; e < 8; ++e) { const float rt = ga[e] * __builtin_amdgcn_rcpf(fmaxf(gn[e], 1e-30f)); acc[ai][bj][m][e >> 2][e & 3] *= rt; }
            }
        EPI_ROWS_END
    }
    __device__ __forceinline__ void operator()(AccC acc, const Unit& u, int wr, int wc, int fr, int fq) const {
        const int col0 = u.pn * 256 + wc * 32 + 8 * fq;
        EPI_ROWS_BEGIN
#pragma unroll
            for (int bj = 0; bj < 2; ++bj) {
                float g2[8]; unpack8(*(const GAS v4u*)(G + (size_t)row * 6144 + 2 * 2048 + col0 + bj * 128), g2);
                const f32x4 v0 = acc[ai][bj][m][0], v1 = acc[ai][bj][m][1];
                float f[8] = {v0[0], v0[1], v0[2], v0[3], v1[0], v1[1], v1[2], v1[3]};
#pragma unroll
                for (int e = 0; e < 8; ++e) f[e] *= g2[e];
                *(GAS v4u*)(MM + (size_t)row * 2048 + col0 + bj * 128) = pack8(f);
            }
        EPI_ROWS_END
    }
};
struct EpiSwiglu {
    EPI_NO_MID
    static constexpr bool PERM = true;
    bf16* FH;
    __device__ __forceinline__ void operator()(AccC acc, const Unit& u, int wr, int wc, int fr, int fq) const {
        const int col0 = u.pn * 128 + wc * 32 + 8 * fq;
        EPI_ROWS_BEGIN
            const f32x4 a0 = acc[ai][0][m][0], a1 = acc[ai][0][m][1], b0 = acc[ai][1][m][0], b1 = acc[ai][1][m][1];
            const float av[8] = {a0[0], a0[1], a0[2], a0[3], a1[0], a1[1], a1[2], a1[3]}, bv[8] = {b0[0], b0[1], b0[2], b0[3], b1[0], b1[1], b1[2], b1[3]};
            float f[8];
#pragma unroll
            for (int e = 0; e < 8; ++e) f[e] = av[e] * fsigmoid(av[e]) * bv[e];
            *(GAS v4u*)(FH + (size_t)row * FFH + col0) = pack8(f);
        EPI_ROWS_END
    }
};

struct PanelSS {
    float* slots; unsigned* cnt; unsigned* tmo;
    __device__ __forceinline__ void run(const f32x4 (&v)[2][2][4][2], const Unit& u, int wr, int wc, int fr, int fq, PG8_LAS unsigned char* lds, int wid, int lane) const {
        PG8_LAS float* P = (PG8_LAS float*)lds;
        PG8_LAS float* S = (PG8_LAS float*)(lds + 8192);
#pragma unroll
        for (int ai = 0; ai < 2; ++ai)
#pragma unroll
            for (int m = 0; m < 4; ++m) { float q = 0.f;
#pragma unroll
                for (int bj = 0; bj < 2; ++bj)
#pragma unroll
                    for (int n = 0; n < 2; ++n) { const f32x4 x = v[ai][bj][m][n]; q += (x[0] * x[0] + x[1] * x[1]) + (x[2] * x[2] + x[3] * x[3]); }
                q += __builtin_bit_cast(float, __builtin_amdgcn_ds_bpermute((lane ^ 16) << 2, __builtin_bit_cast(int, q)));
                q += __builtin_bit_cast(float, __builtin_amdgcn_ds_bpermute((lane ^ 32) << 2, __builtin_bit_cast(int, q)));
                if (fq == 0) P[(ai * 128 + wr * 64 + m * 16 + fr) * 4 + wc] = q; }
        asm volatile("s_waitcnt lgkmcnt(0)" ::: "memory"); __builtin_amdgcn_s_barrier(); asm volatile("" ::: "memory");
        const int row = wid * 32 + (lane & 31);
        if (lane < 32) { const float tot = (P[row * 4 + 0] + P[row * 4 + 1]) + (P[row * 4 + 2] + P[row * 4 + 3]);
            __hip_atomic_store(slots + ((size_t)(u.pm * 256 + row) * 8 + u.pn), tot, __ATOMIC_RELAXED, __HIP_MEMORY_SCOPE_AGENT); }
        asm volatile("s_waitcnt vmcnt(0)" ::: "memory");
        if (lane == 0) __hip_atomic_fetch_add(cnt + 64 * u.pm, 1u, __ATOMIC_RELAXED, __HIP_MEMORY_SCOPE_AGENT);
        if (wid == 0) {
            const unsigned long long t0 = __builtin_amdgcn_s_memrealtime();
            for (;;) {
                if ((unsigned)__builtin_amdgcn_readfirstlane(__hip_atomic_load(cnt + 64 * u.pm, __ATOMIC_RELAXED, __HIP_MEMORY_SCOPE_AGENT)) >= 64u) break;
                if (__builtin_amdgcn_s_memrealtime() - t0 > 2000000ull) { if (lane == 0) __hip_atomic_store(tmo, 1u, __ATOMIC_RELAXED, __HIP_MEMORY_SCOPE_AGENT); break; }
                __builtin_amdgcn_s_sleep(2);
            }
            __builtin_amdgcn_fence(__ATOMIC_ACQUIRE, "agent");
        }
        asm volatile("s_waitcnt vmcnt(0) lgkmcnt(0)" ::: "memory"); __builtin_amdgcn_s_barrier(); asm volatile("" ::: "memory");
        if (lane < 32) { const float* sl = slots + (size_t)(u.pm * 256 + row) * 8; float t = 0.f;
#pragma unroll
            for (int k = 0; k < 8; ++k) t += __hip_atomic_load(sl + k, __ATOMIC_RELAXED, __HIP_MEMORY_SCOPE_AGENT);
            S[row] = rsqrtf(t * (1.0f / 2048.0f) + 1e-6f); }
        asm volatile("s_waitcnt lgkmcnt(0)" ::: "memory"); __builtin_amdgcn_s_barrier(); asm volatile("" ::: "memory");
    }
};
struct EpiResNorm {
    static constexpr bool PERM = false, AFTER_DRAIN = true;
    float* X; bf16* H; const float* gpost; const float* modGate; const float* gpre; const float* modShift; const float* modScale; PanelSS st1, st2; int hasnext;
    __device__ __forceinline__ void mid(AccM, const Unit&, int, int, int, int) const {}
    __device__ __forceinline__ void operator()(AccC, const Unit&, int, int, int, int) const {}
    __device__ __forceinline__ void fused(AccM acc, const Unit& u, int wr, int wc, int fr, int fq, PG8_LAS unsigned char* lds, int wid, int lane) const {
        const PG8_LAS float* S = (const PG8_LAS float*)(lds + 8192);
        const int col0 = u.pn * 256 + wc * 32 + 4 * fq, cv = u.pm < 16 ? 0 : 1 + ((u.pm - 16) >> 2);
        st1.run(acc, u, wr, wc, fr, fq, lds, wid, lane);
#pragma unroll
        for (int ai = 0; ai < 2; ++ai)
#pragma unroll
            for (int m = 0; m < 4; ++m) { const int r = ai * 128 + wr * 64 + m * 16 + fr; const float r1 = S[r]; const size_t off = (size_t)(u.pm * 256 + r) * 2048 + col0;
#pragma unroll
                for (int bj = 0; bj < 2; ++bj)
#pragma unroll
                    for (int n = 0; n < 2; ++n) { const int c = bj * 128 + n * 16; const f32x4 xr = *(const GAS f32x4*)(X + off + c), gp = *(const GAS f32x4*)(gpost + col0 + c), gt = *(const GAS f32x4*)(modGate + (size_t)cv * 12288 + col0 + c);
                        acc[ai][bj][m][n] = xr + gt * (acc[ai][bj][m][n] * r1 * gp); }
                asm volatile("" : "+v"(acc[ai][0][m][0]), "+v"(acc[ai][0][m][1]), "+v"(acc[ai][1][m][0]), "+v"(acc[ai][1][m][1]));
                if (m & 1) asm volatile("" ::: "memory"); }
        if (hasnext) st2.run(acc, u, wr, wc, fr, fq, lds, wid, lane);
#pragma unroll
        for (int ai = 0; ai < 2; ++ai)
#pragma unroll
            for (int m = 0; m < 4; ++m) { const int r = ai * 128 + wr * 64 + m * 16 + fr; const float r2 = hasnext ? S[r] : 0.f; const size_t off = (size_t)(u.pm * 256 + r) * 2048 + col0;
#pragma unroll
                for (int bj = 0; bj < 2; ++bj)
#pragma unroll
                    for (int n = 0; n < 2; ++n) { const int c = bj * 128 + n * 16; const f32x4 x1 = acc[ai][bj][m][n]; *(GAS f32x4*)(X + off + c) = x1;
                        if (hasnext) { const f32x4 g = *(const GAS f32x4*)(gpre + col0 + c), sh = *(const GAS f32x4*)(modShift + (size_t)cv * 12288 + col0 + c), sc = *(const GAS f32x4*)(modScale + (size_t)cv * 12288 + col0 + c);
                            const f32x4 hv = x1 * r2 * g * (sc + 1.0f) + sh; v2u w; w.x = pk2(hv[0], hv[1]); w.y = pk2(hv[2], hv[3]); *(GAS v2u*)(H + off + c) = w; } }
                asm volatile("" ::: "memory"); }
    }
};

struct SchedPlain {
    const char* A; const char* B; int nM, nN, G, c; size_t tA, tB; int dup;
    __device__ __forceinline__ bool next(int i, Unit& u) const { int pm, pn; const int q = i / (dup * DUP_GEMM), r = i - q * (dup * DUP_GEMM); long L = (long)q * G + c; const int nwg = nM * nN; if (L >= nwg) return false;
        if (r) L = (L + nwg / 2 + 8) % nwg;
        if (!tile_order(L, nM, nN, pm, pn)) return false; u.A = A + (size_t)pm * tA; u.B = B + (size_t)pn * tB; u.pm = pm; u.pn = pn; u.aux = 0; u.last = 1; return true; }
};
struct SchedMerge {
    const char* A0; const char* A1; const char* A2; const char* B; int G, c;
    __device__ __forceinline__ bool next(int i, Unit& u) const { const int ti = i / 3, b = i - ti * 3; int pm, pn; const int q = ti / (DUPG6 * DUP_GEMM), r = ti - q * (DUPG6 * DUP_GEMM); long L = (long)q * G + c; if (L >= 256) return false; if (r) L = (L + 136) % 256;
        if (!tile_order(L, 32, 8, pm, pn)) return false;
        const char* Ab = b == 0 ? A0 : (b == 1 ? A1 : A2); u.A = Ab + (size_t)pm * 256 * 1024 * 2; u.B = B + ((size_t)b * 2048 + pn * 256) * 1024 * 2; u.pm = pm; u.pn = pn; u.aux = b; u.last = (b == 2); return true; }
};
struct SchedS5E {
    const char* UG; const char* ET; int G, c;
    __device__ __forceinline__ bool next(int i, Unit& u) const { const int L = (i / DUP_S5) * G + c; if (L >= 128) return false; const int g = L >> 1, pm = L & 1;
        u.A = UG + ((size_t)g * 512 + pm * 256) * 256 * 2; u.B = ET + (size_t)g * 256 * 256 * 2; u.pm = pm; u.pn = 0; u.aux = g; u.last = 1; return true; }
};
struct SchedS5Y {
    const char* UG; const char* HIN; const char* MT; const char* FT; int G, c;
    __device__ __forceinline__ bool next(int i, Unit& u) const { const int ti = (i >> 1) / DUP_S5, part = i & 1, L = ti * G + c; if (L >= 128) return false; const int g = L >> 1, pm = L & 1;
        u.A = (part ? HIN : UG) + ((size_t)g * 512 + pm * 256) * 256 * 2; u.B = (part ? FT : MT) + (size_t)g * 256 * 256 * 2; u.pm = pm; u.pn = 0; u.aux = g; u.last = part; return true; }
};
struct SchedOne {
    const char* A0; const char* B0; const char* A1; const char* B1; int pm, aux, nparts;
    __device__ __forceinline__ bool next(int i, Unit& u) const { if (i >= nparts) return false; u.A = i ? A1 : A0; u.B = i ? B1 : B0; u.pm = pm; u.pn = 0; u.aux = aux; u.last = (i == nparts - 1); return true; }
};
struct SchedRg {
    const char* XC; const char* GWT; int G, c;
    __device__ __forceinline__ bool next(int i, Unit& u) const { const int L = (i / DUP_RGG) * G + c; if (L >= 512) return false; const int pm = L & 31, hd = L >> 5;
        u.A = XC + ((size_t)pm * 256 * 1024 + (hd >> 1) * 128) * 2; u.B = GWT + (size_t)hd * 256 * 128 * 2; u.pm = pm; u.pn = 0; u.aux = hd; u.last = 1; return true; }
};
}

namespace att {
using bf16x8 = __attribute__((ext_vector_type(8))) short;
using s16x4  = __attribute__((ext_vector_type(4))) short;
using f32x16 = __attribute__((ext_vector_type(16))) float;
using u32x4  = __attribute__((ext_vector_type(4))) unsigned;
constexpr int D = 128, NW = 8, QBLK = 32, KVBLK = 64, LD = 1024;
constexpr float SCALE = 0.088388347648318440f, THR = 8.f;
constexpr size_t SHM_V = KVBLK * D * 2, SHM_K = KVBLK * D * 2, SHM_ATTN = 2 * SHM_V + 2 * SHM_K + NW * 64 * 4;
constexpr int RPB_OFF = (int)SHM_ATTN + 256;
#define KSWZ(row, colB) ((row) * 256 + ((colB) ^ (((row) & 7) << 4)))
#define SBAR() __builtin_amdgcn_sched_barrier(0)
__device__ __forceinline__ int crow(int r, int hi) { return (r & 3) + 8 * (r >> 2) + 4 * hi; }
__device__ __forceinline__ unsigned cvtpk(float lo, float hi) { return pk2(lo, hi); }
__device__ __forceinline__ void partialSM(f32x16& p0, f32x16& p1, float& m_reg, float& mn, float& alpha) {
  constexpr float C = SCALE * 1.4426950408889634f;
  float pmax = p0[0]; for (int r = 1; r < 16; ++r) pmax = fmaxf(pmax, p0[r]); for (int r = 0; r < 16; ++r) pmax = fmaxf(pmax, p1[r]);
  { auto rr = __builtin_amdgcn_permlane32_swap(__float_as_uint(pmax), __float_as_uint(pmax), false, false);
    pmax = fmaxf(__uint_as_float(rr[0]), __uint_as_float(rr[1])); }
  if (__builtin_expect(__all(pmax - m_reg <= THR / SCALE), 1)) { mn = m_reg; alpha = 1.f; }
  else { mn = fmaxf(m_reg, pmax); alpha = __builtin_amdgcn_exp2f((m_reg - mn) * C); m_reg = mn; }
  float mnC = -mn * C;
  for (int r = 0; r < 16; ++r) p0[r] = fmaf(p0[r], C, mnC); for (int r = 0; r < 16; ++r) p1[r] = fmaf(p1[r], C, mnC);
  for (int r = 0; r < 16; ++r) p0[r] = __builtin_amdgcn_exp2f(p0[r]);
}
__device__ __forceinline__ void finishSM(f32x16& p0, f32x16& p1, float alpha, float& l_reg, bf16x8& pa0, bf16x8& pa1, bf16x8& pa2, bf16x8& pa3) {
  for (int r = 0; r < 16; ++r) p1[r] = __builtin_amdgcn_exp2f(p1[r]);
  float ps = 0; for (int r = 0; r < 16; ++r) ps += p0[r]; for (int r = 0; r < 16; ++r) ps += p1[r];
  { auto rr = __builtin_amdgcn_permlane32_swap(__float_as_uint(ps), __float_as_uint(ps), false, false);
    ps = __uint_as_float(rr[0]) + __uint_as_float(rr[1]); }
  l_reg = l_reg * alpha + ps;
#define PK4(P, BASE, OUT) do { unsigned a0 = cvtpk(P[BASE + 0], P[BASE + 1]), a1 = cvtpk(P[BASE + 2], P[BASE + 3]);   \
    unsigned b0 = cvtpk(P[BASE + 4], P[BASE + 5]), b1 = cvtpk(P[BASE + 6], P[BASE + 7]);                              \
    auto r0 = __builtin_amdgcn_permlane32_swap(a0, b0, false, false); auto r1 = __builtin_amdgcn_permlane32_swap(a1, b1, false, false); \
    u32x4 w = {r0[0], r1[0], r0[1], r1[1]}; OUT = *reinterpret_cast<bf16x8*>(&w); } while (0)
  PK4(p0, 0, pa0); PK4(p0, 8, pa1); PK4(p1, 0, pa2); PK4(p1, 8, pa3);
#undef PK4
}
__device__ __forceinline__ void qkt(f32x16& p0, f32x16& p1, const bf16* Ks, const bf16x8* qr, int r32, int hi) {
  p0 = f32x16{}; p1 = f32x16{};
  for (int d0 = 0; d0 < 8; ++d0) { int cb = (d0 * 16 + hi * 8) * 2;
    bf16x8 b0 = *reinterpret_cast<const bf16x8*>((const char*)Ks + KSWZ(r32, cb));
    bf16x8 b1 = *reinterpret_cast<const bf16x8*>((const char*)Ks + KSWZ(32 + r32, cb));
    p0 = __builtin_amdgcn_mfma_f32_32x32x16_bf16(b0, qr[d0], p0, 0, 0, 0);
    p1 = __builtin_amdgcn_mfma_f32_32x32x16_bf16(b1, qr[d0], p1, 0, 0, 0); }
}
__device__ __forceinline__ int v_st(int k, int c) { const int kk = (k & ~0xC) | ((k & 4) << 1) | ((k & 8) >> 1); return ((kk >> 3) * 4 + (c >> 5)) * 512 + ((kk & 7) * 32 + (c & 31)) * 2; }
__device__ __forceinline__ int v_rd_base(int lane) { return ((lane & 3) << 3) | (((lane >> 2) & 3) << 6) | (((lane >> 4) & 1) << 5) | (((lane >> 5) & 1) << 8); }
constexpr int v_rd_off(int d0, int ks, int half) { return d0 * 512 + ks * 4096 + half * 2048; }
template <int OFF> __device__ __forceinline__ s16x4 tr_read(int vb) {
  s16x4 r; asm volatile("ds_read_b64_tr_b16 %0, %1 offset:%2" : "=&v"(r) : "v"(vb), "i"(OFF) : "memory"); return r;
}
template <int D0> __device__ __forceinline__ void pv_one(f32x16& od, int vb, bf16x8 pa0, bf16x8 pa1, bf16x8 pa2, bf16x8 pa3) {
  const s16x4 l0 = tr_read<v_rd_off(D0, 0, 0)>(vb), h0 = tr_read<v_rd_off(D0, 0, 1)>(vb), l1 = tr_read<v_rd_off(D0, 1, 0)>(vb), h1 = tr_read<v_rd_off(D0, 1, 1)>(vb);
  const s16x4 l2 = tr_read<v_rd_off(D0, 2, 0)>(vb), h2 = tr_read<v_rd_off(D0, 2, 1)>(vb), l3 = tr_read<v_rd_off(D0, 3, 0)>(vb), h3 = tr_read<v_rd_off(D0, 3, 1)>(vb);
  asm volatile("s_waitcnt lgkmcnt(0)" ::: "memory"); SBAR();
#define PK(L, H) (bf16x8){L[0], L[1], L[2], L[3], H[0], H[1], H[2], H[3]}
  od = __builtin_amdgcn_mfma_f32_32x32x16_bf16(pa0, PK(l0, h0), od, 0, 0, 0);
  od = __builtin_amdgcn_mfma_f32_32x32x16_bf16(pa1, PK(l1, h1), od, 0, 0, 0);
  od = __builtin_amdgcn_mfma_f32_32x32x16_bf16(pa2, PK(l2, h2), od, 0, 0, 0);
  od = __builtin_amdgcn_mfma_f32_32x32x16_bf16(pa3, PK(l3, h3), od, 0, 0, 0);
#undef PK
}
__device__ __forceinline__ void pv_d0(f32x16* o, int vb, bf16x8 pa0, bf16x8 pa1, bf16x8 pa2, bf16x8 pa3) {
  pv_one<0>(o[0], vb, pa0, pa1, pa2, pa3); pv_one<1>(o[1], vb, pa0, pa1, pa2, pa3); pv_one<2>(o[2], vb, pa0, pa1, pa2, pa3); pv_one<3>(o[3], vb, pa0, pa1, pa2, pa3);
}
__device__ __forceinline__ void na_mask(f32x16& p0, f32x16& p1, int kr, int qr, int rs, int ws, const float* rpbl, int hi) {
  if (kr < rs || kr >= rs + 8) {
#pragma unroll
    for (int r = 0; r < 16; ++r) { p0[r] = -1e30f; p1[r] = -1e30f; }
  } else {
    const float* row = rpbl + (kr - qr + 7) * 31 + 4 * hi; const unsigned w0 = (unsigned)(4 * hi - ws);
#pragma unroll
    for (int r = 0; r < 16; ++r) {
      const int kc = (r & 3) + 8 * (r >> 2);
      const float b0 = row[kc], b1 = row[kc + 32];
      p0[r] = (w0 + (unsigned)kc < 16u) ? p0[r] + b0 : -1e30f; p1[r] = (w0 + (unsigned)(kc + 32) < 16u) ? p1[r] + b1 : -1e30f;
      if ((r & 3) == 3) SBAR();
    }
  }
}
template <bool NA, int SD>
__device__ __forceinline__ void attn_body(const bf16* __restrict__ Qb, const bf16* __restrict__ K0, const bf16* __restrict__ V0, const bf16* __restrict__ K1, const bf16* __restrict__ V1,
                                          bf16* __restrict__ Ob, const int NT, const int lo, const int rg, char* lds) {
  int tid_ = threadIdx.x; asm volatile("" : "+v"(tid_));
  const int tid = tid_, wid = tid >> 6, lane = tid & 63, r32 = lane & 31, hi = lane >> 5;
  bf16* V_lds = (bf16*)lds; bf16* K_lds = (bf16*)(lds + 2 * SHM_V);
  float* ws_ = (float*)(lds + 2 * SHM_V + 2 * SHM_K) + wid * 64; float* li_l = ws_; float* al_l = ws_ + 32;
  const int qrow = 4 * rg + (wid >> 1), qc = 32 * (wid & 1) + r32;
  const int rs = qrow - 4 < 0 ? 0 : (qrow - 4 > 8 ? 8 : qrow - 4), wsn = qc - 8 < 0 ? 0 : (qc - 8 > 48 ? 48 : qc - 8);
  const float* rpbl = (const float*)(lds + RPB_OFF) + 15 - qc;
  float m_reg = -1e30f, l_reg = 0; f32x16 o[4] = {}; bf16x8 qr[8];
  const bf16* Qw = Qb + (long)(wid * QBLK + r32) * LD + hi * 8;
#pragma unroll
  for (int d0 = 0; d0 < 8; ++d0) qr[d0] = *(const GAS bf16x8*)(Qw + d0 * 16);
  const int sr = tid >> 4, sc = (tid & 15) * 8, vst0 = v_st(sr, sc), vst1 = v_st(32 + sr, sc);
  const int vb0 = (int)(uintptr_t)V_lds + v_rd_base(lane);
  struct { bf16x8 vs0, vs1, ks0, ks1; } sr_[SD];
#define TILEK(t) ((NA && (t) >= 8) ? K1 + (long)((t) - 8) * 64 * LD : K0 + (long)(t) * 64 * LD)
#define TILEV(t) ((NA && (t) >= 8) ? V1 + (long)((t) - 8) * 64 * LD : V0 + (long)(t) * 64 * LD)
#define SLOAD(i, t) do { const bf16* kp_ = TILEK(t); const bf16* vp_ = TILEV(t); \
    sr_[i].vs0 = *(const GAS bf16x8*)(&vp_[(long)sr * LD + sc]); sr_[i].vs1 = *(const GAS bf16x8*)(&vp_[(long)(32 + sr) * LD + sc]); \
    sr_[i].ks0 = *(const GAS bf16x8*)(&kp_[(long)sr * LD + sc]); sr_[i].ks1 = *(const GAS bf16x8*)(&kp_[(long)(32 + sr) * LD + sc]); } while (0)
#define SWRITE(b, i) do { *(bf16x8*)((char*)V_lds + (b) * SHM_V + vst0) = sr_[i].vs0;          \
    *(bf16x8*)((char*)V_lds + (b) * SHM_V + vst1) = sr_[i].vs1; int kc = sc * 2;               \
    *(bf16x8*)((char*)K_lds + (b) * SHM_K + KSWZ(sr, kc)) = sr_[i].ks0;                       \
    *(bf16x8*)((char*)K_lds + (b) * SHM_K + KSWZ(32 + sr, kc)) = sr_[i].ks1; } while (0)
#define SWAIT() do { if constexpr (SD == 2) asm volatile("s_waitcnt vmcnt(4)" ::: "memory"); else asm volatile("s_waitcnt vmcnt(0)" ::: "memory"); } while (0)
#define RESC(a) do { if (__any((a) < 1.f)) { if (hi == 0) al_l[r32] = (a); asm volatile("s_waitcnt lgkmcnt(0)" ::: "memory"); \
    for (int d = 0; d < 4; ++d) for (int r = 0; r < 16; ++r) o[d][r] *= al_l[crow(r, hi)]; } } while (0)
#define MASK(P0, P1, t) do { if (NA && (t) >= 8) na_mask(P0, P1, lo + (t) - 8, qrow, rs, wsn, rpbl, hi); } while (0)
  f32x16 pA0, pA1, pB0, pB1; float mnA, mnB, alA, alB; bf16x8 pa0, pa1, pa2, pa3;
  constexpr int SE = 0, SO = SD - 1;
  SLOAD(SE, 0); asm volatile("s_waitcnt vmcnt(0)" ::: "memory"); SWRITE(0, SE); __syncthreads();
  qkt(pA0, pA1, K_lds, qr, r32, hi); partialSM(pA0, pA1, m_reg, mnA, alA);
  SLOAD(SO, 1); if constexpr (SD == 2) { if (2 < NT) SLOAD(SE, 2); }
  SWAIT(); SWRITE(1, SO); __syncthreads();
  for (int j = 1; j + 1 < NT; j += 2) {
    SBAR(); qkt(pB0, pB1, (bf16*)((char*)K_lds + SHM_K), qr, r32, hi); MASK(pB0, pB1, j);
    finishSM(pA0, pA1, alA, l_reg, pa0, pa1, pa2, pa3); SBAR();
    SLOAD(SO, j + SD); SBAR();
    pv_d0(o, vb0, pa0, pa1, pa2, pa3); partialSM(pB0, pB1, m_reg, mnB, alB);
    __syncthreads(); SWAIT(); SWRITE(0, SE);
    RESC(alB); __syncthreads();
    SBAR(); qkt(pA0, pA1, K_lds, qr, r32, hi); MASK(pA0, pA1, j + 1);
    finishSM(pB0, pB1, alB, l_reg, pa0, pa1, pa2, pa3); SBAR();
    if (SD == 1 || j + 3 < NT) SLOAD(SE, j + 1 + SD); SBAR();
    pv_d0(o, vb0 + (int)SHM_V, pa0, pa1, pa2, pa3); partialSM(pA0, pA1, m_reg, mnA, alA);
    __syncthreads(); SWAIT(); SWRITE(1, SO);
    RESC(alA); __syncthreads();
  }
  SBAR(); qkt(pB0, pB1, (bf16*)((char*)K_lds + SHM_K), qr, r32, hi); MASK(pB0, pB1, NT - 1);
  finishSM(pA0, pA1, alA, l_reg, pa0, pa1, pa2, pa3); SBAR();
  pv_d0(o, vb0, pa0, pa1, pa2, pa3); partialSM(pB0, pB1, m_reg, mnB, alB);
  __syncthreads(); RESC(alB);
  finishSM(pB0, pB1, alB, l_reg, pa0, pa1, pa2, pa3); SBAR();
  pv_d0(o, vb0 + (int)SHM_V, pa0, pa1, pa2, pa3);
  if (hi == 0) li_l[r32] = l_reg; asm volatile("s_waitcnt lgkmcnt(0)" ::: "memory");
  float rli[16];
#pragma unroll
  for (int r = 0; r < 16; ++r) rli[r] = __builtin_amdgcn_rcpf(li_l[crow(r, hi)]);
  bf16* Ow = Ob + (long)(wid * QBLK) * LD;
#pragma unroll
  for (int r = 0; r < 16; ++r) { int orow = crow(r, hi);
    for (int d0 = 0; d0 < 4; ++d0) *(GAS bf16*)(Ow + (long)orow * LD + d0 * 32 + r32) = (bf16)f2bf(o[d0][r] * rli[r]); }
  asm volatile("s_waitcnt vmcnt(0)" ::: "memory"); __syncthreads();
#undef TILEK
#undef TILEV
#undef SLOAD
#undef SWRITE
#undef SWAIT
#undef RESC
#undef MASK
}
}

constexpr int NWAVES = 8;
struct Args { const float* in[36]; float* out; unsigned char* ws; int ph_lo, ph_hi; };
struct Frame { LAS unsigned char* lds; char* ldsg; volatile LAS unsigned* MISC; int tid, lane, wave, vcu, G; };
constexpr int INTAB_OFF = MISC_OFF + 128;
__device__ __forceinline__ const float* ld_in(const LAS unsigned char* lds, int i) { const unsigned long long v = ((const LAS unsigned long long*)(lds + INTAB_OFF))[i];
    const unsigned lo = __builtin_amdgcn_readfirstlane((unsigned)v), hi = __builtin_amdgcn_readfirstlane((unsigned)(v >> 32)); return (const float*)(((unsigned long long)hi << 32) | lo); }
#define IN(i) ld_in(F.lds, (i))

__device__ __forceinline__ void transpose_item(const float* W, int N, int k0, int n0, bf16* WT, int ldo, int drow0, float* scr, int lane) {
    const int kr = lane >> 3, n4 = (lane & 7) * 4;
    f32x4 v[8];
#pragma unroll
    for (int i = 0; i < 8; ++i) v[i] = *(const GAS f32x4*)(W + (size_t)(k0 + kr + 8 * i) * N + n0 + n4);
#pragma unroll
    for (int i = 0; i < 8; ++i) { float* d = scr + (kr + 8 * i) * 33 + n4; d[0] = v[i].x; d[1] = v[i].y; d[2] = v[i].z; d[3] = v[i].w; }
    LDS_WAIT(); asm volatile("" ::: "memory");
    const int c = lane & 7;
#pragma unroll
    for (int j = 0; j < 4; ++j) { const int n = (lane >> 3) + 8 * j; const float* s = scr + (8 * c) * 33 + n;
        v4u o; o.x = pk2(s[0 * 33], s[1 * 33]); o.y = pk2(s[2 * 33], s[3 * 33]); o.z = pk2(s[4 * 33], s[5 * 33]); o.w = pk2(s[6 * 33], s[7 * 33]);
        *(GAS v4u*)(WT + (size_t)(drow0 + n) * ldo + k0 + 8 * c) = o; }
    LDS_WAIT(); asm volatile("" ::: "memory");
}

__device__ __forceinline__ int cv_of_row(int row) { return row < CTXR ? 0 : 1 + ((row - CTXR) >> 10); }

template <bool FIRST, bool HASNEXT, bool XIN16, bool XOUT16>
__device__ __forceinline__ void resnorm_rows(const Frame& F, const float* xin0, const float* xin1, float* X, bf16* XB, const bf16* Z, const float* gpost, const float* modGate  ,
                                             const float* gpre, const float* modShift, const float* modScale, bf16* H) {
    const int gw = F.vcu * NWAVES + F.wave, NGW = F.G * NWAVES;
    for (int rb = gw * 4; rb < ROWS; rb += NGW * 4) {
        const int cv = cv_of_row(rb);
        f32x4 gg[8], gs[8], shv[8];
#pragma unroll
        for (int j = 0; j < 8; ++j) { const int q = 2 * (F.lane + 64 * (j >> 1)) + (j & 1);
            if (!FIRST) gg[j] = ((const GAS f32x4*)gpost)[q] * ((const GAS f32x4*)(modGate + (size_t)cv * 12288))[q];
            if (HASNEXT) { gs[j] = ((const GAS f32x4*)gpre)[q] * (((const GAS f32x4*)(modScale + (size_t)cv * 12288))[q] + 1.0f); shv[j] = ((const GAS f32x4*)(modShift + (size_t)cv * 12288))[q]; } }
#pragma unroll 1
        for (int r2 = 0; r2 < 4; r2 += 2) {
            v4u zw[2][4], xw[2][4]; f32x4 xf[2][8];
#pragma unroll
            for (int rr = 0; rr < 2; ++rr) { const int row = rb + r2 + rr;
                if (FIRST) { const GAS f32x4* src = (const GAS f32x4*)(row < CTXR ? xin0 + (size_t)row * DM : xin1 + (size_t)(row - CTXR) * DM);
#pragma unroll
                    for (int j = 0; j < 8; ++j) xf[rr][j] = src[2 * (F.lane + 64 * (j >> 1)) + (j & 1)];
                } else {
#pragma unroll
                    for (int jj = 0; jj < 4; ++jj) zw[rr][jj] = ((const GAS v4u*)(Z + (size_t)row * DM))[F.lane + 64 * jj];
                    if (XIN16) {
#pragma unroll
                        for (int jj = 0; jj < 4; ++jj) xw[rr][jj] = ((const GAS v4u*)(XB + (size_t)row * DM))[F.lane + 64 * jj];
                    } else {
#pragma unroll
                        for (int j = 0; j < 8; ++j) xf[rr][j] = ((const GAS f32x4*)(X + (size_t)row * DM))[2 * (F.lane + 64 * (j >> 1)) + (j & 1)];
                    } } }
#pragma unroll
            for (int rr = 0; rr < 2; ++rr) { const int row = rb + r2 + rr;
                f32x4 x[8];
                if (FIRST) {
#pragma unroll
                    for (int j = 0; j < 8; ++j) x[j] = xf[rr][j];
                } else {
                    f32x4 z[8]; float ss = 0.f;
#pragma unroll
                    for (int jj = 0; jj < 4; ++jj) { float f[8]; unpack8(zw[rr][jj], f); z[2 * jj] = (f32x4){f[0], f[1], f[2], f[3]}; z[2 * jj + 1] = (f32x4){f[4], f[5], f[6], f[7]}; }
#pragma unroll
                    for (int j = 0; j < 8; ++j) ss += (z[j].x * z[j].x + z[j].y * z[j].y) + (z[j].z * z[j].z + z[j].w * z[j].w);
                    const float rstd = rsqrtf(wave_sum(ss, F.lane) * (1.f / DM) + RMS_EPS);
#pragma unroll
                    for (int j = 0; j < 8; ++j) { f32x4 xo;
                        if (XIN16) { float f[8]; unpack8(xw[rr][j >> 1], f); xo = (j & 1) ? (f32x4){f[4], f[5], f[6], f[7]} : (f32x4){f[0], f[1], f[2], f[3]}; } else xo = xf[rr][j];
                        x[j] = xo + gg[j] * (z[j] * rstd); }
                }
                if (XOUT16) { GAS v4u* xo = (GAS v4u*)(XB + (size_t)row * DM);
#pragma unroll
                  for (int jj = 0; jj < 4; ++jj) { const float f[8] = {x[2 * jj].x, x[2 * jj].y, x[2 * jj].z, x[2 * jj].w, x[2 * jj + 1].x, x[2 * jj + 1].y, x[2 * jj + 1].z, x[2 * jj + 1].w}; xo[F.lane + 64 * jj] = pack8(f); }
                } else { GAS f32x4* xo = (GAS f32x4*)(X + (size_t)row * DM);
#pragma unroll
                  for (int j = 0; j < 8; ++j) xo[2 * (F.lane + 64 * (j >> 1)) + (j & 1)] = x[j]; }
                if (HASNEXT) {
                    float ss = 0.f;
#pragma unroll
                    for (int j = 0; j < 8; ++j) ss += (x[j].x * x[j].x + x[j].y * x[j].y) + (x[j].z * x[j].z + x[j].w * x[j].w);
                    const float rstd = rsqrtf(wave_sum(ss, F.lane) * (1.f / DM) + RMS_EPS);
                    GAS v4u* ho = (GAS v4u*)(H + (size_t)row * DM);
#pragma unroll
                    for (int jj = 0; jj < 4; ++jj) { float f[8];
#pragma unroll
                        for (int h = 0; h < 2; ++h) { const f32x4 hv = x[2 * jj + h] * rstd * gs[2 * jj + h] + shv[2 * jj + h]; f[4 * h] = hv.x; f[4 * h + 1] = hv.y; f[4 * h + 2] = hv.z; f[4 * h + 3] = hv.w; }
                        ho[F.lane + 64 * jj] = pack8(f); }
                }
            }
        }
    }
}

__device__ __forceinline__ void s5_tables(const Frame& F, int l, int g, unsigned char* ws) {
    char* L = F.ldsg;
    f32x2* POW = (f32x2*)L;
    f32x2* BB = (f32x2*)(L + 17408);
    f32x2* CC = (f32x2*)(L + 17408 + 16384);
    float* KT = (float*)(L + 17408 + 32768);
    const int tid = F.tid;
    __syncthreads();
    if (tid < 128) {
        const int d = tid >> 6, p = tid & 63; const size_t li = ((size_t)(l * 2 + d) * 64 + g) * 64 + p;
        const float dt = expf(IN(22)[(l * 2 + d) * 64 + g]); const float lre = IN(20)[li], lim = IN(21)[li];
        const float er = expf(lre * dt); float sn, cs; sincosf(lim * dt, &sn, &cs);
        const float br = er * cs, bi = er * sn;
        const float nr = br - 1.0f, ni = bi, den = lre * lre + lim * lim;
        const float cr = (nr * lre + ni * lim) / den, ci = (ni * lre - nr * lim) / den;
        float pr = 1.f, pi = 0.f;
        for (int t = 0; t <= 16; ++t) { POW[(d * 64 + p) * 17 + t] = (f32x2){pr, pi}; const float nr2 = pr * br - pi * bi, ni2 = pr * bi + pi * br; pr = nr2; pi = ni2; }
        ((f32x2*)(ws + WS_LT))[li] = POW[(d * 64 + p) * 17 + 16];
        { f32x4 vr[4], vi[4]; const GAS f32x4* pr4 = (const GAS f32x4*)(IN(23) + li * 16); const GAS f32x4* pi4 = (const GAS f32x4*)(IN(24) + li * 16);
#pragma unroll
          for (int q = 0; q < 4; ++q) { vr[q] = pr4[q]; vi[q] = pi4[q]; }
#pragma unroll
          for (int m = 0; m < 16; ++m) { const float xr = vr[m >> 2][m & 3], xi = vi[m >> 2][m & 3]; BB[(d * 64 + p) * 16 + m] = (f32x2){cr * xr - ci * xi, cr * xi + ci * xr}; } }
    }
    for (int i = tid; i < 2048; i += 512) { const int d = i >> 10, n = (i >> 6) & 15, p = i & 63; const size_t ci_ = (((size_t)(l * 2 + d) * 64 + g) * 16 + n) * 64 + p; CC[i] = (f32x2){IN(25)[ci_], IN(26)[ci_]}; }
    __syncthreads();
    {
        const int d = tid >> 8, n = (tid >> 4) & 15, m = tid & 15; float acc[16];
#pragma unroll
        for (int t = 0; t < 16; ++t) acc[t] = 0.f;
        for (int p = 0; p < 64; ++p) { const f32x2 c = CC[(d * 16 + n) * 64 + p], b = BB[(d * 64 + p) * 16 + m]; const float cbr = c.x * b.x - c.y * b.y, cbi = c.x * b.y + c.y * b.x;
#pragma unroll
            for (int t = 0; t < 16; ++t) { const f32x2 w = POW[(d * 64 + p) * 17 + t]; acc[t] += cbr * w.x - cbi * w.y; } }
#pragma unroll
        for (int t = 0; t < 16; ++t) KT[((d * 16 + t) * 16 + n) * 16 + m] = acc[t];
    }
    __syncthreads();
    bf16* MT = (bf16*)(ws + WS_MT) + (size_t)(l * 64 + g) * 65536; bf16* ET = (bf16*)(ws + WS_ET) + (size_t)(l * 64 + g) * 65536; bf16* FT = (bf16*)(ws + WS_FT) + (size_t)(l * 64 + g) * 65536;
    for (int i = tid; i < 8192; i += 512) {
        const int rowi = i >> 5, k0 = (i & 31) * 8;
        { const int t = rowi >> 4, n = rowi & 15, s = k0 >> 4, m0 = k0 & 15; float f[8];
#pragma unroll
          for (int e = 0; e < 8; ++e) { float v = 0.f; if (s <= t) v += KT[((0 * 16 + (t - s)) * 16 + n) * 16 + m0 + e]; if (s >= t) v += KT[((1 * 16 + (s - t)) * 16 + n) * 16 + m0 + e]; f[e] = v; }
          *(GAS v4u*)(MT + (size_t)rowi * 256 + k0) = pack8(f); }
        { const int d = rowi >> 7, p = (rowi >> 1) & 63, c = rowi & 1, s = k0 >> 4, m0 = k0 & 15; float f[8];
          const f32x2 w = POW[(d * 64 + p) * 17 + (d == 0 ? 15 - s : s)];
#pragma unroll
          for (int e = 0; e < 8; ++e) { const f32x2 b = BB[(d * 64 + p) * 16 + m0 + e]; f[e] = c == 0 ? (w.x * b.x - w.y * b.y) : (w.x * b.y + w.y * b.x); }
          *(GAS v4u*)(ET + (size_t)rowi * 256 + k0) = pack8(f); }
        { const int t = rowi >> 4, n = rowi & 15; float f[8];
#pragma unroll
          for (int e = 0; e < 8; ++e) { const int k = k0 + e, d = k >> 7, p = (k >> 1) & 63, c = k & 1; const f32x2 cc = CC[(d * 16 + n) * 64 + p], w = POW[(d * 64 + p) * 17 + (d == 0 ? t + 1 : 16 - t)];
              f[e] = c == 0 ? (cc.x * w.x - cc.y * w.y) : -(cc.x * w.y + cc.y * w.x); }
          *(GAS v4u*)(FT + (size_t)rowi * 256 + k0) = pack8(f); }
    }
    __syncthreads();
}

constexpr int I_WIN = 32 * 384, I_GLU = 16 * 32, I_OUT = 16 * 64, I_WO = 32 * 64, I_FIN = 32 * 352, I_FOUT = 88 * 64, I_GW = 32 * 8;
constexpr int I_LAYER = I_WIN + I_GLU + 3 * I_OUT + I_WO + I_FIN + I_FOUT + I_GW;
__device__ __forceinline__ void weight_item(const Frame& F, unsigned char* ws, int l, int r, float* scr) {
    if (r < I_WIN) { const int kb = r / 384, nb = r % 384; transpose_item(IN(14) + (size_t)l * DM * INW, INW, kb * 64, nb * 32, (bf16*)(ws + WS_WINT) + (size_t)l * INW * DM, DM, nb * 32, scr, F.lane); return; } r -= I_WIN;
    if (r < I_GLU) { const int kb = r / 32, nb = r % 32; transpose_item(IN(28) + (size_t)l * 1024 * 1024, 1024, kb * 64, nb * 32, (bf16*)(ws + WS_GLUT) + (size_t)l * 1024 * 1024, 1024, nb * 32, scr, F.lane); return; } r -= I_GLU;
    if (r < 3 * I_OUT) { const int b = r / I_OUT, q = r % I_OUT, kb = q / 64, nb = q % 64; transpose_item(IN(30 + b) + (size_t)l * 1024 * DM, DM, kb * 64, nb * 32, (bf16*)(ws + WS_OUTT) + ((size_t)l * 3 + b) * DM * 1024, 1024, nb * 32, scr, F.lane); return; } r -= 3 * I_OUT;
    if (r < I_WO) { const int kb = r / 64, nb = r % 64; transpose_item(IN(33) + (size_t)l * DM * DM, DM, kb * 64, nb * 32, (bf16*)(ws + WS_WOT) + (size_t)l * DM * DM, DM, nb * 32, scr, F.lane); return; } r -= I_WO;
    if (r < I_FIN) { const int kb = r / 352, nb = r % 352; const int n0 = nb * 32, half = n0 >= FFH, j = n0 - half * FFH; const int drow = 256 * (j >> 7) + 128 * half + (j & 127);
        transpose_item(IN(34) + (size_t)l * DM * 2 * FFH, 2 * FFH, kb * 64, n0, (bf16*)(ws + WS_FINT) + (size_t)l * 2 * FFH * DM, DM, drow, scr, F.lane); return; } r -= I_FIN;
    if (r < I_FOUT) { const int kb = r / 64, nb = r % 64; transpose_item(IN(35) + (size_t)l * FFH * DM, DM, kb * 64, nb * 32, (bf16*)(ws + WS_FOUTT) + (size_t)l * DM * FFH, FFH, nb * 32, scr, F.lane); return; } r -= I_FOUT;
    { const int mi = r >> 3, q = r & 7, kb = q >> 2, nb = q & 3;
      const int d = mi >> 4, g = (mi >> 3) & 1, h = mi & 7;
      transpose_item(IN(17) + ((size_t)l * 32 + mi) * 128 * 128, 128, kb * 64, nb * 32, (bf16*)(ws + WS_GWT) + (((size_t)l * 8 + h) * 2 + d) * 256 * 128, 128, g * 128 + nb * 32, scr, F.lane); }
}
constexpr int QB = 16;
static_assert(I_LAYER % QB == 0, "queue batch");
constexpr int Q_P2 = 562 * QB, Q_P3 = 624 * QB, Q_P4 = 1374 * QB, Q_P5 = 1813 * QB, Q_P9 = I_LAYER;
constexpr int CW_Q = 8192;
__device__ __forceinline__ void pull_weight_items(const Frame& F, unsigned char* ws, int l, int upto) {
    if (l >= NL) return;
    unsigned* ctr = (unsigned*)(ws + WS_CTL) + CW_Q + 64 * l; float* scr = (float*)(F.ldsg + F.wave * 16384);
    const int upto_b = upto / QB;
    for (;;) {
        unsigned i = 0;
        if (F.lane == 0) asm volatile("global_atomic_add %0, %1, %2, off sc0\n\ts_waitcnt vmcnt(0)" : "=&v"(i) : "v"(ctr), "v"(1u) : "memory");
        i = (unsigned)__builtin_amdgcn_readfirstlane((int)i);
        if ((int)i >= upto_b) { if (F.lane == 0) asm volatile("global_atomic_sub %0, %1, off" :: "v"(ctr), "v"(1u) : "memory"); break; }
        for (int j = 0; j < QB; ++j) weight_item(F, ws, l, (int)i * QB + j, scr);
    }
}

constexpr int SQ_P5 = 5, SQ_P9 = 12, SQ_END = (SQ_P5 + SQ_P9) * 1024;
__device__ __forceinline__ void static_weight_items(const Frame& F, unsigned char* ws, int l, int c, int G, int k0, int nk) {
    if (l >= NL || G != 256 || c < 128) return;
    float* scr = (float*)(F.ldsg + F.wave * 16384); const int w = (c - 128) * 8 + F.wave;
    for (int k = 0; k < nk; ++k) weight_item(F, ws, l, (k0 + k) * 1024 + w, scr);
}

__global__ void __launch_bounds__(NWAVES * 64, 2) fwd_kernel(Args args) {
    extern __shared__ __attribute__((aligned(16))) unsigned char lds[];
    const int G0 = gridDim.x, c0 = (int)blockIdx.x;
    volatile LAS unsigned* MISC0 = (volatile LAS unsigned*)((LAS unsigned char*)lds + MISC_OFF);
    unsigned char* const ws0 = args.ws; float* const out0 = args.out;
    gu32* ctl = (gu32*)(ws0 + WS_CTL);
    for (int u = threadIdx.x; u < (LDS_BYTES - LDSCTL_OFF) / 4; u += NWAVES * 64) ((LAS unsigned*)((LAS unsigned char*)lds + LDSCTL_OFF))[u] = 0u;
    __syncthreads();
    if (threadIdx.x == 0) {
#pragma unroll
        for (int i = 0; i < 36; ++i) ((LAS unsigned long long*)((LAS unsigned char*)lds + INTAB_OFF))[i] = (unsigned long long)args.in[i]; }
    __syncthreads();
    XcdBarrier bar; bar.bar = (unsigned*)(ctl + CW_BAR); bar.x = 0; bar.st = nullptr;
    if (MK_N_LAUNCHES == 1) bar = xcd_barrier_post((unsigned*)(ctl + CW_BAR), MISC0 + 8);
    const int lo = args.ph_lo, hi = args.ph_hi;
    int ph = 0;
#ifndef PHMASK
#define PHMASK 0xFFFFFFFFu
#endif
#define PHASE_BEGIN(k) if (((PHMASK >> (k)) & 1u) && lo <= ph && ph < hi) { if ((k) == TSEL && threadIdx.x == 0) *(volatile LAS unsigned long long*)(MISC0 + 16) = __builtin_amdgcn_s_memrealtime(); unsigned char* ws = ws0; float* outp = out0; int tid_p = threadIdx.x, G = G0, c = c0; asm volatile("" : "+s"(ws), "+s"(outp), "+v"(tid_p), "+s"(G), "+s"(c)); const int vcu = (G % 8 == 0) ? (c % 8) * (G / 8) + c / 8 : c;     \
    Frame F; F.lds = (LAS unsigned char*)lds; F.ldsg = (char*)lds; F.MISC = (volatile LAS unsigned*)(F.lds + MISC_OFF); F.tid = tid_p; F.lane = tid_p & 63; F.wave = __builtin_amdgcn_readfirstlane(tid_p >> 6); F.G = G; F.vcu = vcu; \
    const int gw = vcu * NWAVES + F.wave, NGW = G * NWAVES, gt = vcu * 512 + F.tid, NGT = G * 512; (void)gw; (void)NGW; (void)gt; (void)NGT; \
    float* const X = outp + O_X; bf16* const Hb = (bf16*)(ws + WS_H); float* const MOD = (float*)(ws + WS_MOD); const float* const modl = MOD + (size_t)l_ * NCV * INW; (void)X; (void)Hb; (void)modl;
#define PHASE_END(k)   if (MK_N_LAUNCHES == 1 && ph + 1 < hi) { XcdBarrier b_ = bar; asm volatile("" : "+s"(b_.bar)); xcd_barrier(b_); } if ((k) == TSEL && threadIdx.x == 0) *(volatile LAS unsigned long long*)(MISC0 + 18) += __builtin_amdgcn_s_memrealtime() - *(volatile LAS unsigned long long*)(MISC0 + 16); } ++ph;
    int l_ = 0;

    PHASE_BEGIN(0)
    {
        for (int it = F.vcu; it < NL * 64; it += G) s5_tables(F, it >> 6, it & 63, ws);
        __syncthreads();
        { const float* lamp = IN(19); for (int i = gt; i < NL * 2 * 1024; i += NGT) ((float*)(ws + WS_SP))[i] = log1pf(expf(-lamp[i])); }
        float* scr = (float*)(F.ldsg + F.wave * 16384);
        { const int rest = (G == 256) ? I_LAYER - SQ_END : I_LAYER;
          for (int it = gw; it < I_LAYER + 3 * rest; it += NGW) { if (it < I_LAYER) weight_item(F, ws, 0, it, scr); else { const int q = it - I_LAYER, l = 1 + q / rest, r = q % rest; weight_item(F, ws, l, I_LAYER - rest + r, scr); } } }
        const float* ckp = IN(2); const float* cvp = IN(3);
        for (int i0 = gt; i0 < 2 * 1048576; i0 += 4 * NGT) { f32x4 a0[4], a1[4];
#pragma unroll
            for (int q = 0; q < 4; ++q) { const int i = i0 + q * NGT; if (i < 2 * 1048576) { const int which = i >> 20, j = i & 1048575; const GAS f32x4* s = (const GAS f32x4*)(which ? cvp : ckp) + (size_t)j * 2; a0[q] = s[0]; a1[q] = s[1]; } }
#pragma unroll
            for (int q = 0; q < 4; ++q) { const int i = i0 + q * NGT; if (i < 2 * 1048576) { const int which = i >> 20, j = i & 1048575;
                v4u o; o.x = pk2(a0[q].x, a0[q].y); o.y = pk2(a0[q].z, a0[q].w); o.z = pk2(a1[q].x, a1[q].y); o.w = pk2(a1[q].z, a1[q].w); ((GAS v4u*)(ws + (which ? WS_CV : WS_CK)))[j] = o; } } }
        const float* cctx = IN(7); const float* cvec = IN(6); const float* wmod = IN(8);
        for (int task = gt; task < 16 * NL * 3072; task += NGT) {
            const int n4 = task % 3072, l = (task / 3072) % NL, ks = task / (3072 * NL);
            f32x4 acc[NCV];
#pragma unroll
            for (int v = 0; v < NCV; ++v) acc[v] = (f32x4){0.f, 0.f, 0.f, 0.f};
            const GAS f32x4* wp = (const GAS f32x4*)(wmod + ((size_t)l * DM + ks * 128) * INW) + n4;
            for (int kb = 0; kb < 128; kb += 16) { f32x4 w[16];
#pragma unroll
                for (int j = 0; j < 16; ++j) w[j] = wp[(size_t)(kb + j) * (INW / 4)];
#pragma unroll
                for (int j = 0; j < 16; ++j) { const int kk = ks * 128 + kb + j;
#pragma unroll
                    for (int v = 0; v < NCV; ++v) { const float cnd = v == 0 ? cctx[kk] : cvec[(v - 1) * DM + kk]; const float sl = cnd * fsigmoid(cnd); acc[v] += w[j] * sl; } } }
#pragma unroll
            for (int v = 0; v < NCV; ++v) ((f32x4*)(ws + WS_MODP))[(((size_t)ks * NL + l) * NCV + v) * 3072 + n4] = acc[v];
        }
    }
    PHASE_END(0)
    PHASE_BEGIN(1)
        const float* bmod = IN(9);
        for (int i = gt; i < NL * NCV * 3072; i += NGT) { const int n4 = i % 3072, v = (i / 3072) % NCV, l = i / (3072 * NCV);
            f32x4 s = ((const f32x4*)(bmod + (size_t)l * INW))[n4];
            f32x4 pp[16];
#pragma unroll
            for (int ks = 0; ks < 16; ++ks) pp[ks] = ((const GAS f32x4*)(ws + WS_MODP))[(((size_t)ks * NL + l) * NCV + v) * 3072 + n4];
#pragma unroll
            for (int ks = 0; ks < 16; ++ks) s += pp[ks];
            ((f32x4*)MOD)[i] = s; }
    PHASE_END(1)
    PHASE_BEGIN(2)
        resnorm_rows<true, true, false, XRES_BF16 != 0>(F, IN(0), IN(1), X, (bf16*)(ws + WS_XB), nullptr, nullptr, nullptr, IN(10), MOD + 0 * DM, MOD + 1 * DM, Hb);
    PHASE_END(2)

    for (int l = 0; l < DBG_NL; ++l) {
        l_ = l;
        PHASE_BEGIN(3)
        {   pg8::SchedPlain S{(const char*)Hb, (const char*)(ws + WS_WINT) + (size_t)l * INW * DM * 2, 32, 48, G, c, (size_t)256 * DM * 2, (size_t)256 * DM * 2, DUPG1};
            pg8::EpiWin E{(bf16*)(ws + WS_XR), (bf16*)(ws + WS_XG), (bf16*)(ws + WS_UG), (bf16*)(ws + WS_Q), (bf16*)(ws + WS_K), (bf16*)(ws + WS_V), (bf16*)(ws + WS_G),
                          outp + O_K + (size_t)l * 256 * 1024, outp + O_V + (size_t)l * 256 * 1024};
            pg8::gemm_phase(F.lds, DM, DM, DM, S, E); }
        PHASE_END(3)
        PHASE_BEGIN(4)
        {
            { const bf16* XR = (const bf16*)(ws + WS_XR); bf16* XC = (bf16*)(ws + WS_XC); const GAS float* cw = (const GAS float*)(IN(15) + (size_t)l * 4 * 1024); const GAS float* cb = (const GAS float*)(IN(16) + (size_t)l * 1024);
              for (int i_ = gt; i_ < ROWS * 128 * DUP_CONV; i_ += NGT) { const int i = i_ % (ROWS * 128); const int row = i >> 7, c8 = (i & 127) * 8;
                  const int s0 = row < CTXR ? (row & ~255) : (CTXR + ((row - CTXR) & ~1023)), s1 = row < CTXR ? s0 + 256 : s0 + 1024;
                  v4u xw[4];
#pragma unroll
                  for (int k = 0; k < 4; ++k) { int rr = row + k - 1; rr = rr < s0 ? s0 : (rr >= s1 ? s1 - 1 : rr); xw[k] = *(const GAS v4u*)(XR + (size_t)rr * 1024 + c8); }
                  f32x4 cw0[4], cw1[4]; const f32x4 cb0 = *(const GAS f32x4*)(cb + c8), cb1 = *(const GAS f32x4*)(cb + c8 + 4);
#pragma unroll
                  for (int k = 0; k < 4; ++k) { cw0[k] = *(const GAS f32x4*)(cw + k * 1024 + c8); cw1[k] = *(const GAS f32x4*)(cw + k * 1024 + c8 + 4); }
                  float acc[8] = {cb0[0], cb0[1], cb0[2], cb0[3], cb1[0], cb1[1], cb1[2], cb1[3]};
#pragma unroll
                  for (int k = 0; k < 4; ++k) { const int rr = row + k - 1; const float ok = (rr >= s0 && rr < s1) ? 1.0f : 0.0f; float xv[8]; unpack8(xw[k], xv);
#pragma unroll
                      for (int e = 0; e < 8; ++e) acc[e] += ok * (e < 4 ? cw0[k][e] : cw1[k][e - 4]) * xv[e]; }
                  *(GAS v4u*)(XC + (size_t)row * 1024 + c8) = pack8(acc); } }
            for (int L = c; L < 128 * DUP_S5; L += G) { const int g = (L & 127) >> 1, pm = L & 1;
                { pg8::SchedOne S{(const char*)(ws + WS_UG) + ((size_t)g * 512 + pm * 256) * 256 * 2, (const char*)(ws + WS_ET) + ((size_t)l * 64 + g) * 65536 * 2, nullptr, nullptr, pm, g, 1}; pg8::EpiHloc E{(float*)(ws + WS_HLOC)};
                  pg8::gemm_phase(F.lds, 256, 256, 256, S, E); }
                { const float* HLOC = (const float*)(ws + WS_HLOC); bf16* HIN = (bf16*)(ws + WS_HIN); const GAS f32x2* LT = (const GAS f32x2*)(ws + WS_LT) + (size_t)l * 2 * 64 * 64;
                  const int nseq = pm ? 4 : 16, nch = pm ? 64 : 16;
                  for (int i = F.tid; i < nseq * 128; i += 512) { const int p = i & 63, d = (i >> 6) & 1, sq = i >> 7; const int seq = pm ? 16 + sq : sq, ch0 = pm ? 256 + sq * 64 : sq * 16;
                      const f32x2 lam = LT[(d * 64 + g) * 64 + p]; float hr = 0.f, hi_ = 0.f;
                      if (pm) { const f32x2 h0 = ((const f32x2*)IN(5))[((((size_t)sq * 4 + l) * 2 + d) * 64 + g) * 64 + p]; hr = h0.x; hi_ = h0.y; }
                      for (int kb = 0; kb < nch; kb += 16) { f32x2 hl[16];
#pragma unroll
                          for (int j = 0; j < 16; ++j) { const int ch = d == 0 ? ch0 + kb + j : ch0 + nch - 1 - kb - j; hl[j] = *(const GAS f32x2*)(HLOC + ((size_t)g * 512 + ch) * 256 + d * 128 + p * 2); }
#pragma unroll
                          for (int j = 0; j < 16; ++j) { const int ch = d == 0 ? ch0 + kb + j : ch0 + nch - 1 - kb - j; *(GAS unsigned*)(HIN + ((size_t)g * 512 + ch) * 256 + d * 128 + p * 2) = pk2(hr, hi_);
                              const float nr = lam.x * hr - lam.y * hi_ + hl[j].x, ni = lam.x * hi_ + lam.y * hr + hl[j].y; hr = nr; hi_ = ni; } }
                      if (!pm) ((f32x2*)(outp + O_S5))[((((size_t)seq * 4 + l) * 2 + d) * 64 + g) * 64 + p] = (f32x2){hr, hi_}; }
                  VM_WAIT(); __syncthreads(); }
                { pg8::SchedOne S{(const char*)(ws + WS_UG) + ((size_t)g * 512 + pm * 256) * 256 * 2, (const char*)(ws + WS_MT) + ((size_t)l * 64 + g) * 65536 * 2,
                                  (const char*)(ws + WS_HIN) + ((size_t)g * 512 + pm * 256) * 256 * 2, (const char*)(ws + WS_FT) + ((size_t)l * 64 + g) * 65536 * 2, pm, g, 2};
                  pg8::EpiS5Y E{(const bf16*)(ws + WS_UG), IN(27) + (size_t)l * 1024, (bf16*)(ws + WS_ZS)};
                  pg8::gemm_phase(F.lds, 256, 256, 256, S, E); }
            }
            __syncthreads();
            { float* rp = (float*)(F.ldsg + att::RPB_OFF); const bf16* Qb = (const bf16*)(ws + WS_Q); const bf16* Kb = (const bf16*)(ws + WS_K); const bf16* Vb = (const bf16*)(ws + WS_V); bf16* Ob = (bf16*)(ws + WS_YNA);
              for (int u_ = (c + G / 2) % G; u_ < 256 * DUP_ATT; u_ += G) { const int u = u_ & 255;
                  if (u < 128) { const int b = u >> 5, h = (u >> 2) & 7, rg = u & 3; const int lo_ = rg == 0 ? 0 : (rg == 1 ? 0 : (rg == 2 ? 4 : 8)), NT = (rg == 0 || rg == 3) ? 16 : 20;
                      for (int i = F.tid; i < 465; i += 512) rp[i] = IN(29)[((size_t)l * 8 + h) * 465 + i] * (1.0f / att::SCALE);
                      __syncthreads();
                      const size_t qoff = (size_t)(CTXR + b * 1024 + rg * 256) * 1024 + h * 128, koff = (size_t)(CTXR + b * 1024 + lo_ * 64) * 1024 + h * 128, coff = ((size_t)(b * 4 + l) * 512) * 1024 + h * 128;
                      att::attn_body<true, 1>(Qb + qoff, (const bf16*)(ws + WS_CK) + coff, (const bf16*)(ws + WS_CV) + coff, Kb + koff, Vb + koff, Ob + qoff, NT, lo_, rg, F.ldsg);
                  } else { const int b = (u - 128) >> 3, h = (u - 128) & 7; const size_t off = (size_t)(b * 256) * 1024 + h * 128;
                      att::attn_body<false, 2>(Qb + off, Kb + off, Vb + off, Kb + off, Vb + off, Ob + off, 4, 0, 0, F.ldsg); }
              } }
        }
        PHASE_END(4)
        PHASE_BEGIN(5)
        {   { pg8::SchedRg S{(const char*)(ws + WS_XC), (const char*)(ws + WS_GWT) + (size_t)l * 8 * 2 * 256 * 128 * 2, G, c};
              pg8::EpiRg E{(const bf16*)(ws + WS_XC), IN(18) + (size_t)l * 4 * 1024, (const float*)(ws + WS_SP) + (size_t)l * 2048, (f32x2*)(ws + WS_AB)};
              pg8::gemm_phase(F.lds, 128, 1024, 128, S, E); }
            { pg8::SchedPlain S{(const char*)(ws + WS_ZS), (const char*)(ws + WS_GLUT) + (size_t)l * 1024 * 1024 * 2, 32, 4, G, c, (size_t)256 * 1024 * 2, (size_t)256 * 1024 * 2, 1};
              pg8::EpiGlu E{(const bf16*)(ws + WS_ZS), (bf16*)(ws + WS_YS5)};
              pg8::gemm_phase(F.lds, 1024, 1024, 1024, S, E); }
            __syncthreads(); static_weight_items(F, ws, l + 1, c, G, 0, SQ_P5);
        }
        PHASE_END(5)
        PHASE_BEGIN(6)
        {
            { const GAS unsigned* AB = (const GAS unsigned*)(ws + WS_AB); GAS float* HF = (GAS float*)(ws + WS_HF); const GAS bf16* XG = (const GAS bf16*)(ws + WS_XG); GAS bf16* YRG = (GAS bf16*)(ws + WS_YRG);
              float* cs = (float*)F.ldsg;
              for (int task_ = (c + G / 2) % G; task_ < 320 * DUP_SCAN; task_ += G) { const int task = task_ % 320;
                  const bool lat = task >= 64 && task < 128; const int ti = lat ? task - 64 : (task < 64 ? task : task - 64); const int seq = ti >> 4, cb = ti & 15;
                  const int L = lat ? 1024 : 256, row0 = lat ? CTXR + seq * 1024 : seq * 256, ch = cb * 64 + F.lane, len = L / 8, t0 = row0 + F.wave * len;
                  __syncthreads();
                  float pf = 1.f, hf = 0.f, pb = 1.f, hb = 0.f;
                  for (int tb = 0; tb < len; tb += 16) { unsigned v[16];
#pragma unroll
                      for (int j = 0; j < 16; ++j) v[j] = AB[(size_t)(t0 + tb + j) * 1024 + ch];
#pragma unroll
                      for (int j = 0; j < 16; ++j) { const float a = 1.0f - bflo(v[j]); hf = a * hf + bfhi(v[j]); pf *= a; } }
                  for (int tb = len - 16; tb >= 0; tb -= 16) { unsigned v[16];
#pragma unroll
                      for (int j = 0; j < 16; ++j) v[j] = AB[((size_t)ROWS + t0 + tb + j) * 1024 + ch];
#pragma unroll
                      for (int j = 15; j >= 0; --j) { const float a = 1.0f - bflo(v[j]); hb = a * hb + bfhi(v[j]); pb *= a; } }
                  cs[(F.wave * 4 + 0) * 64 + F.lane] = pf; cs[(F.wave * 4 + 1) * 64 + F.lane] = hf; cs[(F.wave * 4 + 2) * 64 + F.lane] = pb; cs[(F.wave * 4 + 3) * 64 + F.lane] = hb;
                  __syncthreads();
                  float cf = lat ? IN(4)[((size_t)(seq * 4 + l) * 2 + 0) * 1024 + ch] : 0.f, cbk = lat ? IN(4)[((size_t)(seq * 4 + l) * 2 + 1) * 1024 + ch] : 0.f;
                  for (int w = 0; w < F.wave; ++w) cf = cs[(w * 4 + 0) * 64 + F.lane] * cf + cs[(w * 4 + 1) * 64 + F.lane];
                  for (int w = 7; w > F.wave; --w) cbk = cs[(w * 4 + 2) * 64 + F.lane] * cbk + cs[(w * 4 + 3) * 64 + F.lane];
                  if (!lat) { if (F.wave == 7) outp[O_RG + ((size_t)(seq * 4 + l) * 2 + 0) * 1024 + ch] = pf * cf + hf; if (F.wave == 0) outp[O_RG + ((size_t)(seq * 4 + l) * 2 + 1) * 1024 + ch] = pb * cbk + hb; }
                  float h = cf;
                  for (int tb = 0; tb < len; tb += 16) { unsigned v[16];
#pragma unroll
                      for (int j = 0; j < 16; ++j) v[j] = AB[(size_t)(t0 + tb + j) * 1024 + ch];
#pragma unroll
                      for (int j = 0; j < 16; ++j) { h = (1.0f - bflo(v[j])) * h + bfhi(v[j]); HF[(size_t)(t0 + tb + j) * 1024 + ch] = h; } }
                  VM_WAIT();
                  h = cbk;
                  for (int tb = len - 16; tb >= 0; tb -= 16) { unsigned v[16]; float hfv[16]; bf16 xg[16];
#pragma unroll
                      for (int j = 0; j < 16; ++j) { const size_t o = (size_t)(t0 + tb + j) * 1024 + ch; v[j] = AB[(size_t)ROWS * 1024 + o]; hfv[j] = HF[o]; xg[j] = XG[o]; }
#pragma unroll
                      for (int j = 15; j >= 0; --j) { h = (1.0f - bflo(v[j])) * h + bfhi(v[j]); YRG[(size_t)(t0 + tb + j) * 1024 + ch] = (bf16)f2bf((hfv[j] + h) * bf2f(xg[j])); } }
              } }
        }
        PHASE_END(6)
        PHASE_BEGIN(8)
        {   pg8::SchedMerge S{(const char*)(ws + WS_YRG), (const char*)(ws + WS_YS5), (const char*)(ws + WS_YNA), (const char*)(ws + WS_OUTT) + (size_t)l * 3 * DM * 1024 * 2, G, c};
            pg8::EpiMerge E{(const bf16*)(ws + WS_G), (bf16*)(ws + WS_MM)};
            pg8::gemm_phase(F.lds, 1024, 1024, 1024, S, E); }
        PHASE_END(8)
#if FUSE_NORM
        PHASE_BEGIN(9)
        {   pg8::SchedPlain S{(const char*)(ws + WS_MM), (const char*)(ws + WS_WOT) + (size_t)l * DM * DM * 2, 32, 8, G, c, (size_t)256 * DM * 2, (size_t)256 * DM * 2, 1};
            unsigned* ctlw = (unsigned*)(ws + WS_CTL); const int b0 = (l * 2 + 0) * 2;
            pg8::PanelSS s1{(float*)(ws + WS_XS) + (size_t)b0 * 65536, ctlw + CW_SEAM + b0 * SEAM_BANK, ctlw + CW_TMO}, s2{(float*)(ws + WS_XS) + (size_t)(b0 + 1) * 65536, ctlw + CW_SEAM + (b0 + 1) * SEAM_BANK, ctlw + CW_TMO};
            pg8::EpiResNorm E{X, Hb, IN(11) + (size_t)l * DM, modl + 2 * DM, IN(12) + (size_t)l * DM, modl + 3 * DM, modl + 4 * DM, s1, s2, 1};
            pg8::gemm_phase(F.lds, DM, DM, DM, S, E); }
        PHASE_END(9)
#else
        PHASE_BEGIN(9)
        {   pg8::SchedPlain S{(const char*)(ws + WS_MM), (const char*)(ws + WS_WOT) + (size_t)l * DM * DM * 2, 32, 8, G, c, (size_t)256 * DM * 2, (size_t)256 * DM * 2, 1};
            pg8::EpiB16 E{(bf16*)(ws + WS_Z), DM};
            pg8::gemm_phase(F.lds, DM, DM, DM, S, E); }
        PHASE_END(9)
        PHASE_BEGIN(10)
            resnorm_rows<false, true, XRES_BF16 != 0, XRES_BF16 != 0>(F, nullptr, nullptr, X, (bf16*)(ws + WS_XB), (const bf16*)(ws + WS_Z), IN(11) + (size_t)l * DM, modl + 2 * DM, IN(12) + (size_t)l * DM, modl + 3 * DM, modl + 4 * DM, Hb);
        PHASE_END(10)
#endif
        PHASE_BEGIN(11)
        {   pg8::SchedPlain S{(const char*)Hb, (const char*)(ws + WS_FINT) + (size_t)l * 2 * FFH * DM * 2, 32, 44, G, c, (size_t)256 * DM * 2, (size_t)256 * DM * 2, DUPG9};
            pg8::EpiSwiglu E{(bf16*)(ws + WS_FH)};
            pg8::gemm_phase(F.lds, DM, DM, DM, S, E);
            __syncthreads(); static_weight_items(F, ws, l + 1, c, G, SQ_P5, SQ_P9); }
        PHASE_END(11)
#if FUSE_NORM
        PHASE_BEGIN(12)
        {   pg8::SchedPlain S{(const char*)(ws + WS_FH), (const char*)(ws + WS_FOUTT) + (size_t)l * DM * FFH * 2, 32, 8, G, c, (size_t)256 * FFH * 2, (size_t)256 * FFH * 2, DUPG10};
            unsigned* ctlw = (unsigned*)(ws + WS_CTL); const int b0 = (l * 2 + 1) * 2; const int ln = l + 1 < NL ? l + 1 : l;
            pg8::PanelSS s1{(float*)(ws + WS_XS) + (size_t)b0 * 65536, ctlw + CW_SEAM + b0 * SEAM_BANK, ctlw + CW_TMO}, s2{(float*)(ws + WS_XS) + (size_t)(b0 + 1) * 65536, ctlw + CW_SEAM + (b0 + 1) * SEAM_BANK, ctlw + CW_TMO};
            pg8::EpiResNorm E{X, Hb, IN(13) + (size_t)l * DM, modl + 5 * DM, IN(10) + (size_t)ln * DM, MOD + (size_t)ln * NCV * INW + 0 * DM, MOD + (size_t)ln * NCV * INW + 1 * DM, s1, s2, (l + 1 < NL) ? 1 : 0};
            pg8::gemm_phase(F.lds, FFH, FFH, FFH, S, E); }
        PHASE_END(12)
#else
        PHASE_BEGIN(12)
        {   pg8::SchedPlain S{(const char*)(ws + WS_FH), (const char*)(ws + WS_FOUTT) + (size_t)l * DM * FFH * 2, 32, 8, G, c, (size_t)256 * FFH * 2, (size_t)256 * FFH * 2, DUPG10};
            pg8::EpiB16 E{(bf16*)(ws + WS_Z), DM};
            pg8::gemm_phase(F.lds, FFH, FFH, FFH, S, E); }
        PHASE_END(12)
        PHASE_BEGIN(13)
            if (l + 1 < NL) resnorm_rows<false, true, XRES_BF16 != 0, XRES_BF16 != 0>(F, nullptr, nullptr, X, (bf16*)(ws + WS_XB), (const bf16*)(ws + WS_Z), IN(13) + (size_t)l * DM, modl + 5 * DM, IN(10) + (size_t)(l + 1) * DM, modl + NCV * INW + 0 * DM, modl + NCV * INW + 1 * DM, Hb);
            else resnorm_rows<false, false, XRES_BF16 != 0, false>(F, nullptr, nullptr, X, (bf16*)(ws + WS_XB), (const bf16*)(ws + WS_Z), IN(13) + (size_t)l * DM, modl + 5 * DM, nullptr, nullptr, nullptr, Hb);
        PHASE_END(13)
#endif
    }
#if DBG_KEEP
    PHASE_BEGIN(14)
        for (size_t i = (size_t)gt; i < O_END; i += (size_t)NGT) {
            int r, lay = 0;
            if (i < O_K) r = i < O_K / 2 ? 0 : 1;
            else if (i < O_V) { r = 2; lay = (int)(((i - O_K) / (256 * 1024)) & 3); }
            else if (i < O_RG) { r = 3; lay = (int)(((i - O_V) / (256 * 1024)) & 3); }
            else if (i < O_S5) { r = 4; lay = (int)(((i - O_RG) / 2048) & 3); }
            else { r = 5; lay = (int)(((i - O_S5) / 16384) & 3); }
            const bool keep = ((DBG_KEEP >> r) & 1) && (r < 2 || ((DBG_LMASK >> lay) & 1));
            float v = keep ? 3.0f * outp[i] : 0.0f;
#if DBG_DUMP
            v = 0.f;
            if (i >= O_K && i < O_K + (size_t)ROWS * 1024) { const size_t j = i - O_K;
                if (DBG_DUMP == 1) v = bf2f(((const bf16*)(ws + WS_YNA))[j]);
                if (DBG_DUMP == 2) v = bf2f(((const bf16*)(ws + WS_YS5))[j]);
                if (DBG_DUMP == 3) v = bf2f(((const bf16*)(ws + WS_YRG))[j]);
                if (DBG_DUMP == 4) v = bf2f(((const bf16*)(ws + WS_ZS))[j]);
                if (DBG_DUMP == 5) v = bf2f(((const bf16*)(ws + WS_MM))[j]);
                if (DBG_DUMP == 6) v = ((const bf16*)(ws + WS_Z))[j];
                if (DBG_DUMP == 7) v = bf2f(((const bf16*)(ws + WS_FH))[j]);
                if (DBG_DUMP == 8) v = bf2f(((const bf16*)(ws + WS_H))[j]);
                if (DBG_DUMP == 9) v = bf2f(((const bf16*)(ws + WS_G))[j]);
                if (DBG_DUMP == 11) v = bf2f(((const bf16*)(ws + WS_G))[(size_t)8192 * 6144 + j]);
                if (DBG_DUMP == 10) v = bf2f(((const bf16*)(ws + WS_WINT))[(size_t)6144 * 2048 + j]);
            }
#endif
            outp[i] = v;
        }
    PHASE_END(14)
#endif
    if (TSEL >= 0 && blockIdx.x == 0 && threadIdx.x == 0) { const float us = (float)(*(volatile LAS unsigned long long*)(MISC0 + 18)) * 0.01f; out0[0] = exp2f(rintf(log2f(us) * 10.0f) * 0.1f); }
#undef PHASE_BEGIN
#undef PHASE_END
}
constexpr int N_PHASES = 3 + DBG_NL * (FUSE_NORM ? 8 : 10) + (DBG_KEEP ? 1 : 0);

extern "C" void kernel_launch(void* const* d_in, const int* in_sizes, int n_in, void* d_out, int out_size, void* d_ws, size_t ws_size, hipStream_t stream) {
    static int grid = 0;
    if (grid == 0) {
        if (n_in != 36 || out_size != (int)O_END || ws_size < WS_END) { fprintf(stderr, "kernel_launch: unexpected shapes (n_in %d out %d ws %zu)\n", n_in, out_size, ws_size); grid = -1; return; }
        int dev = 0, cus = 0, per_cu = 0;
        if (hipGetDevice(&dev) != hipSuccess || hipDeviceGetAttribute(&cus, hipDeviceAttributeMultiprocessorCount, dev) != hipSuccess) { grid = -1; return; }
        if (hipFuncSetAttribute((const void*)fwd_kernel, hipFuncAttributeMaxDynamicSharedMemorySize, LDS_BYTES) != hipSuccess) { fprintf(stderr, "kernel_launch: hipFuncSetAttribute failed\n"); grid = -1; return; }
        if (hipOccupancyMaxActiveBlocksPerMultiprocessor(&per_cu, (const void*)fwd_kernel, NWAVES * 64, LDS_BYTES) != hipSuccess || per_cu < 1) { fprintf(stderr, "kernel_launch: occupancy query reports %d blocks per CU\n", per_cu); }
        (void)hipGetLastError();
        grid = cus;
        if (FUSE_NORM && cus != 256) { fprintf(stderr, "kernel_launch: the fused residual+norm epilogues need exactly 256 workgroups (one 256x256 tile each); build with -DFUSE_NORM=0 for %d CUs\n", cus); grid = -1; return; }
    }
    if (grid < 0) return;
    if (hipMemsetAsync((char*)d_ws + WS_CTL, 0, CTL_ZERO_BYTES, stream) != hipSuccess) return;
    Args a{};
    for (int i = 0; i < 36; ++i) a.in[i] = (const float*)d_in[i];
    a.out = (float*)d_out; a.ws = (unsigned char*)d_ws;
    if (MK_N_LAUNCHES == 1) { a.ph_lo = 0; a.ph_hi = N_PHASES; hipLaunchKernelGGL(fwd_kernel, dim3(grid), dim3(NWAVES * 64), LDS_BYTES, stream, a); }
    else for (int p = 0; p < N_PHASES; ++p) { a.ph_lo = p; a.ph_hi = p + 1; hipLaunchKernelGGL(fwd_kernel, dim3(grid), dim3(NWAVES * 64), LDS_BYTES, stream, a); }
}
```

```cpp
#include <hip/hip_runtime.h>
#include <hip/hip_bf16.h>
#include <cstdio>
#include <cstdint>

#ifndef MK_N_LAUNCHES
#define MK_N_LAUNCHES 1
#endif
#ifndef DBG_KEEP
#define DBG_KEEP 0
#endif
#ifndef DUP_SCAN
#define DUP_SCAN 1
#endif
#ifndef DUP_ATT
#define DUP_ATT 1
#endif
#ifndef DUP_CARRY
#define DUP_CARRY 1
#endif
#ifndef DUP_CONV
#define DUP_CONV 1
#endif
#ifndef DUP_RGG
#define DUP_RGG 1
#endif
#ifndef DUP_S5
#define DUP_S5 1
#endif
#ifndef TSEL
#define TSEL (-1)
#endif
#ifndef DUPG1
#define DUPG1 1
#endif
#ifndef DUPG6
#define DUPG6 1
#endif
#ifndef DUPG9
#define DUPG9 1
#endif
#ifndef DUPG10
#define DUPG10 1
#endif
#ifndef DUP_GEMM
#define DUP_GEMM 1
#endif
#ifndef DUP_MASK
#define DUP_MASK 0u
#endif
#ifndef DBG_LMASK
#define DBG_LMASK 15
#endif
#ifndef DBG_DUMP
#define DBG_DUMP 0
#endif
#ifndef DBG_NL
#define DBG_NL 4
#endif

constexpr int DM = 2048, ROWS = 8192, CTXR = 4096, INW = 12288, FFH = 5632, NL = 4, W1K = 1024;
constexpr int NCV = 5;
constexpr float RMS_EPS = 1e-6f;
constexpr size_t MiB = 1u << 20;

constexpr size_t O_X = 0, O_K = 16777216, O_V = 33554432, O_RG = 50331648, O_S5 = 50462720, O_END = 51511296;

constexpr size_t WS_CTL = 0, CTL_ZERO_BYTES = 1 * MiB;
constexpr size_t WS_MODP = 1 * MiB;
constexpr size_t WS_MOD  = 17 * MiB;
constexpr size_t WS_SP   = 18 * MiB;
constexpr size_t WS_LT   = 18 * MiB + 65536;
constexpr size_t WS_GWT  = 19 * MiB;
constexpr size_t WS_WINT = 24 * MiB;
constexpr size_t WS_GLUT = 216 * MiB;
constexpr size_t WS_OUTT = 224 * MiB;
constexpr size_t WS_WOT  = 272 * MiB;
constexpr size_t WS_FINT = 304 * MiB;
constexpr size_t WS_FOUTT = 480 * MiB;
constexpr size_t WS_MT   = 568 * MiB;
constexpr size_t WS_ET   = 600 * MiB;
constexpr size_t WS_FT   = 632 * MiB;
constexpr size_t WS_CK   = 664 * MiB;
constexpr size_t WS_CV   = 680 * MiB;
constexpr size_t WS_H    = 696 * MiB;
constexpr size_t WS_XR   = 728 * MiB;
constexpr size_t WS_XG   = 744 * MiB;
constexpr size_t WS_XC   = 760 * MiB;
constexpr size_t WS_Q    = 776 * MiB;
constexpr size_t WS_K    = 792 * MiB;
constexpr size_t WS_V    = 808 * MiB;
constexpr size_t WS_YRG  = 824 * MiB;
constexpr size_t WS_YS5  = 840 * MiB;
constexpr size_t WS_YNA  = 856 * MiB;
constexpr size_t WS_ZS   = 872 * MiB;
constexpr size_t WS_UG   = 888 * MiB;
constexpr size_t WS_HIN  = 904 * MiB;
constexpr size_t WS_G    = 920 * MiB;
constexpr size_t WS_AB   = 1016 * MiB;
constexpr size_t WS_FH   = 1016 * MiB;
constexpr size_t WS_HF   = 1144 * MiB;
constexpr size_t WS_HLOC = 1176 * MiB;
constexpr size_t WS_Z    = 1144 * MiB;
constexpr size_t WS_MM   = 1208 * MiB;
constexpr size_t WS_XS   = 1240 * MiB;
constexpr size_t WS_XB   = 1244 * MiB;
constexpr size_t WS_END  = 1276 * MiB;

constexpr int CW_TMO = 0, CW_BAR = 4096;
constexpr int CW_SEAM = 16384, SEAM_BANK = 32 * 64;
#ifndef XRES_BF16
#define XRES_BF16 1
#endif
#ifndef FUSE_NORM
#define FUSE_NORM 0
#endif

constexpr int RING_BYTES = 131072;
constexpr int LDSCTL_OFF = RING_BYTES, MISC_OFF = LDSCTL_OFF + 320;
constexpr int LDS_BYTES = 147456;

#define GAS __attribute__((address_space(1)))
#define LAS __attribute__((address_space(3)))
typedef unsigned short bf16;
typedef unsigned v4u __attribute__((ext_vector_type(4)));
typedef unsigned v2u __attribute__((ext_vector_type(2)));
typedef float f32x4 __attribute__((ext_vector_type(4)));
typedef float f32x2 __attribute__((ext_vector_type(2)));
typedef short bf16x8 __attribute__((ext_vector_type(8)));
typedef GAS unsigned gu32;
#define RLX_AGENT __ATOMIC_RELAXED, __HIP_MEMORY_SCOPE_AGENT
#define LDS_WAIT() asm volatile("s_waitcnt lgkmcnt(0)" ::: "memory")
#define VM_WAIT() asm volatile("s_waitcnt vmcnt(0)" ::: "memory")

__device__ __forceinline__ unsigned f2bf(float f) { unsigned u = __builtin_bit_cast(unsigned, f); return (u + 0x7fffu + ((u >> 16) & 1u)) >> 16; }
typedef __bf16 bf16x2_t __attribute__((ext_vector_type(2)));
__device__ __forceinline__ unsigned pk2(float lo, float hi) { const f32x2 v = {lo, hi}; const bf16x2_t b = __builtin_convertvector(v, bf16x2_t); return __builtin_bit_cast(unsigned, b); }
__device__ __forceinline__ float bflo(unsigned w) { return __builtin_bit_cast(float, w << 16); }
__device__ __forceinline__ float bfhi(unsigned w) { return __builtin_bit_cast(float, w & 0xffff0000u); }
__device__ __forceinline__ float bf2f(bf16 h) { return __builtin_bit_cast(float, (unsigned)h << 16); }
__device__ __forceinline__ float fsigmoid(float x) { return __builtin_amdgcn_rcpf(1.0f + __expf(-x)); }
__device__ __forceinline__ float gelu_tanh(float x) { const float y = 0.7978845608028654f * (x + 0.044715f * x * x * x); return x * __builtin_amdgcn_rcpf(1.0f + __expf(-2.0f * y)); }
__device__ __forceinline__ float wave_sum(float v, int lane) {
#pragma unroll
    for (int o = 1; o < 64; o <<= 1) v += __builtin_bit_cast(float, __builtin_amdgcn_ds_bpermute((lane ^ o) << 2, __builtin_bit_cast(int, v)));
    return v;
}
__device__ __forceinline__ void unpack8(const v4u w, float (&f)[8]) { f[0] = bflo(w.x); f[1] = bfhi(w.x); f[2] = bflo(w.y); f[3] = bfhi(w.y); f[4] = bflo(w.z); f[5] = bfhi(w.z); f[6] = bflo(w.w); f[7] = bfhi(w.w); }
__device__ __forceinline__ v4u pack8(const float (&f)[8]) { v4u w; w.x = pk2(f[0], f[1]); w.y = pk2(f[2], f[3]); w.z = pk2(f[4], f[5]); w.w = pk2(f[6], f[7]); return w; }

#define XB_TMO      128
#define XB_XCNT(j)  (256  + 64 * (j))
#define XB_XSUB(j)  (1280 + 64 * (j))
#define XB_XGEN(j)  (2304 + 64 * (j))
#define XB_TOP      3328
#define XB_TOPGEN   3392
#define XCD_BAR_WORDS 3456
#define XB_SPIN_CAP (1u << 18)
__device__ __forceinline__ unsigned xb_ld(unsigned* p)              { return __hip_atomic_load(p, __ATOMIC_RELAXED, __HIP_MEMORY_SCOPE_AGENT); }
__device__ __forceinline__ unsigned xb_add(unsigned* p, unsigned v) { return __hip_atomic_fetch_add(p, v, __ATOMIC_RELAXED, __HIP_MEMORY_SCOPE_AGENT); }
__device__ __forceinline__ unsigned xb_xcc_id() { return (unsigned)__builtin_amdgcn_s_getreg((3 << 11) | 20) & 0xFu; }
#define XB_SPIN(cond, bar) do { unsigned _sp = 0; while (cond) { __builtin_amdgcn_s_sleep(1); \
    if ((++_sp & 255u) == 0u) { if (xb_ld(&(bar)[XB_TMO])) break; if (_sp > XB_SPIN_CAP) { atomicAdd(&(bar)[XB_TMO], 1u); break; } } } } while (0)
struct XcdBarrier { unsigned* bar; unsigned x; volatile LAS unsigned* st; };
__device__ __forceinline__ XcdBarrier xcd_barrier_post(unsigned* bar, volatile LAS unsigned* st) {
    XcdBarrier b; b.bar = bar; b.x = xb_xcc_id(); b.st = st;
    if (threadIdx.x == 0) (void)xb_add(&bar[XB_XCNT(b.x)], 1u);
    return b;
}
__device__ __forceinline__ void xcd_barrier_complete(unsigned* bar, unsigned x, unsigned& nloc, unsigned& nx) {
    const unsigned G = gridDim.x * gridDim.y * gridDim.z;
    unsigned sum, cnt, mine, sp = 0u;
    for (;;) {
        sum = 0u; cnt = 0u; mine = 0u;
#pragma unroll
        for (unsigned j = 0; j < 16; ++j) { const unsigned c = xb_ld(&bar[XB_XCNT(j)]); sum += c; cnt += (c > 0u) ? 1u : 0u; mine = (j == x) ? c : mine; }
        if (sum == G) break;
        __builtin_amdgcn_s_sleep(1);
        if ((++sp & 255u) == 0u) { if (xb_ld(&bar[XB_TMO])) break; if (sp > XB_SPIN_CAP) { atomicAdd(&bar[XB_TMO], 1u); break; } }
    }
    nloc = mine > 0u ? mine : 1u; nx = cnt > 0u ? cnt : 1u;
}
__device__ __forceinline__ void xcd_barrier(const XcdBarrier& b) {
    asm volatile("s_waitcnt vmcnt(0)" ::: "memory");
    __syncthreads();
    int tid_b = threadIdx.x; asm volatile("" : "+v"(tid_b));
    if (tid_b == 0) {
        unsigned* bar = b.bar;
        __builtin_amdgcn_s_waitcnt(0);
        unsigned nloc = b.st[0], nx = b.st[1];
        if (nloc == 0u) { xcd_barrier_complete(bar, b.x, nloc, nx); b.st[0] = nloc; b.st[1] = nx; }
        const unsigned old = xb_add(&bar[XB_XSUB(b.x)], 1u);
        const unsigned gen = old / nloc;
        if (old + 1u == (gen + 1u) * nloc) {
            __builtin_amdgcn_fence(__ATOMIC_RELEASE, "agent");
            asm volatile("s_waitcnt vmcnt(0)" ::: "memory");
            const unsigned og = xb_add(&bar[XB_TOP], 1u);
            const unsigned tg = og / nx;
            if (og + 1u == (tg + 1u) * nx) xb_add(&bar[XB_TOPGEN], 1u);
            else XB_SPIN(xb_ld(&bar[XB_TOPGEN]) == tg, bar);
            __builtin_amdgcn_fence(__ATOMIC_ACQUIRE, "agent");
            xb_add(&bar[XB_XGEN(b.x)], 1u);
            asm volatile("s_waitcnt vmcnt(0)" ::: "memory");
        } else {
            XB_SPIN(xb_ld(&bar[XB_XGEN(b.x)]) == gen, bar);
            __builtin_amdgcn_fence(__ATOMIC_ACQUIRE, "agent");
            asm volatile("s_waitcnt vmcnt(0)" ::: "memory");
        }
    }
    __syncthreads();
}

namespace pg8 {
#define PG8_LAS __attribute__((address_space(3)))
constexpr int BM = 256, BK = 64, HALF = 128, HTB = HALF * BK * 2, STAGE_BYTES = 8 * HTB;
__host__ __device__ __forceinline__ int lds_byte(int r, int c) { const int st = (r >> 4) * 2 + (c >> 5), rr = r & 15, cc = c & 31, ob = rr * 64 + cc * 2; return st * 1024 + (ob ^ (((ob >> 9) & 1) << 5)); }
__host__ __device__ __forceinline__ void stage_rc(int b, int& R, int& C) { const int st = b / 1024, sb = b % 1024, swz = sb ^ (((sb >> 9) & 1) << 5); R = (st >> 1) * 16 + swz / 64; C = (st & 1) * 32 + (swz % 64) / 2; }
__host__ __device__ __forceinline__ int perm32(int rho) { const int n = rho >> 4, i = rho & 15; return 8 * (i >> 2) + 4 * n + (i & 3); }

struct Unit { const char* A; const char* B; int pm, pn, aux, last; };

__device__ __forceinline__ bool tile_order(long L, int nM, int nN, int& pm, int& pn) {
    const int nwg = nM * nN; if (L >= nwg) return false;
    int wgid = (int)L; { const int q = nwg / 8, r = nwg % 8, xcd = wgid % 8, off = wgid / 8; wgid = (xcd < r ? xcd * (q + 1) : r * (q + 1) + (xcd - r) * q) + off; }
    const int nig = 8 * nN, gid = wgid / nig, fm = gid * 8, gsz = (nM - fm) < 8 ? (nM - fm) : 8;
    pm = fm + ((wgid % nig) % gsz); pn = (wgid % nig) / gsz; return true;
}

typedef float f32x4 __attribute__((ext_vector_type(4)));
typedef short bf16x8 __attribute__((ext_vector_type(8)));

template <class Epi, class Sched>
__device__ __forceinline__ void gemm_phase(PG8_LAS unsigned char* lds, const int K, const int lda, const int ldb, const Sched& S, const Epi& E) {
    int tid_ = threadIdx.x; asm volatile("" : "+v"(tid_));
    const int tid = tid_, wid = __builtin_amdgcn_readfirstlane(tid >> 6), lane = tid & 63, wr = wid >> 2, wc = wid & 3, fr = lane & 15, fq = lane >> 4;
    const int nt = K / BK;
    unsigned voffA[2], voffB[2];
#pragma unroll
    for (int i = 0; i < 2; ++i) { int R, C; stage_rc(tid * 16 + i * 8192, R, C); const int Rb = Epi::PERM ? ((R & ~31) + perm32(R & 31)) : R;
        voffA[i] = (unsigned)(R * lda + C) * 2u; voffB[i] = (unsigned)(Rb * ldb + C) * 2u; }
    const size_t kstep = (size_t)(BK * 2);
    const size_t hstepA = (size_t)HALF * lda * 2, hstepB = (size_t)HALF * ldb * 2;
    const unsigned ldsw = (unsigned)wid * 1024u;
    const int aoff = lds_byte(wr * 64 + fr, fq * 8), boff = lds_byte(wc * 32 + fr, fq * 8);
#define PG8_SA(b, h) (((b) * 2 + (h)) * HTB)
#define PG8_SB(b, h) ((4 + (b) * 2 + (h)) * HTB)
#define PG8_STAGE(bufoff, gbase, voff) do { _Pragma("unroll") for (int _i = 0; _i < 2; ++_i) \
        __builtin_amdgcn_global_load_lds((const unsigned*)((const char*)(gbase) + (voff)[_i]), (PG8_LAS unsigned*)(lds + (bufoff) + ldsw + _i * 8192), 16, 0, 0); } while (0)
#define PG8_LDA(dst, b, h) do { _Pragma("unroll") for (int m = 0; m < 4; ++m) _Pragma("unroll") for (int k = 0; k < 2; ++k) dst[m][k] = *(const PG8_LAS bf16x8*)(lds + PG8_SA(b, h) + aoff + m * 2048 + k * 1024); } while (0)
#define PG8_LDB(dst, b, h) do { _Pragma("unroll") for (int n = 0; n < 2; ++n) _Pragma("unroll") for (int k = 0; k < 2; ++k) dst[n][k] = *(const PG8_LAS bf16x8*)(lds + PG8_SB(b, h) + boff + n * 2048 + k * 1024); } while (0)
#define PG8_MMA(ai, bj, At, Bt) do { __builtin_amdgcn_s_setprio(1); _Pragma("unroll") for (int m = 0; m < 4; ++m) _Pragma("unroll") for (int n = 0; n < 2; ++n) _Pragma("unroll") for (int k = 0; k < 2; ++k) \
        acc[ai][bj][m][n] = __builtin_amdgcn_mfma_f32_16x16x32_bf16(Bt[n][k], At[m][k], acc[ai][bj][m][n], 0, 0, 0); __builtin_amdgcn_s_setprio(0); } while (0)
#define PG8_WAIT_V(n) asm volatile("s_waitcnt vmcnt(" #n ")" ::: "memory")
#define PG8_WAIT_L(n) asm volatile("s_waitcnt lgkmcnt(" #n ")" ::: "memory")
#define PG8_BAR __builtin_amdgcn_s_barrier()
#define PG8_SCHED __builtin_amdgcn_sched_barrier(0)
    Unit cur, nxt; int ui = 0;
    if (!S.next(0, cur)) return;
    f32x4 acc[2][2][4][2];
#pragma unroll
    for (int a = 0; a < 2; ++a)
#pragma unroll
        for (int b = 0; b < 2; ++b)
#pragma unroll
            for (int m = 0; m < 4; ++m)
#pragma unroll
                for (int n = 0; n < 2; ++n) acc[a][b][m][n] = (f32x4){0.f, 0.f, 0.f, 0.f};
    bf16x8 At[4][2], B0[2][2], B1[2][2];
    const char* cA = cur.A; const char* cB = cur.B;
    PG8_STAGE(PG8_SB(0, 0), cB, voffB); PG8_STAGE(PG8_SB(0, 1), cB + hstepB, voffB); PG8_STAGE(PG8_SA(0, 0), cA, voffA); PG8_STAGE(PG8_SA(0, 1), cA + hstepA, voffA);
    if (wr == 1) PG8_BAR;
    PG8_WAIT_V(2); PG8_BAR;
    PG8_STAGE(PG8_SB(1, 0), cB + kstep, voffB); PG8_STAGE(PG8_SA(1, 0), cA + kstep, voffA); PG8_STAGE(PG8_SB(1, 1), cB + hstepB + kstep, voffB);
    PG8_WAIT_V(6); PG8_BAR;
    for (;;) {
        const bool has_next = S.next(ui + 1, nxt);
        const char* nA = has_next ? nxt.A : cA; const char* nB = has_next ? nxt.B : cB;
#pragma unroll 1
        for (int t = 0; t < nt; t += 2) {
            const bool last = (t == nt - 2);
            const char* a1 = cA + (size_t)(t + 1) * kstep;
            const char* a2 = last ? nA : cA + (size_t)(t + 2) * kstep; const char* b2 = last ? nB : cB + (size_t)(t + 2) * kstep;
            const char* a3 = a2 + kstep; const char* b3 = b2 + kstep;
            PG8_LDB(B0, 0, 0); PG8_LDB(B1, 0, 1); PG8_SCHED; PG8_LDA(At, 0, 0); PG8_STAGE(PG8_SA(1, 1), a1 + hstepA, voffA);
            PG8_WAIT_V(8); PG8_WAIT_L(0); PG8_BAR; PG8_MMA(0, 0, At, B0); PG8_MMA(0, 1, At, B1); PG8_BAR; PG8_SCHED;
            PG8_LDA(At, 0, 1); PG8_STAGE(PG8_SB(0, 0), b2, voffB); PG8_STAGE(PG8_SB(0, 1), b2 + hstepB, voffB); PG8_STAGE(PG8_SA(0, 0), a2, voffA);
            PG8_WAIT_V(8); PG8_WAIT_L(0); PG8_BAR; PG8_MMA(1, 0, At, B0); PG8_MMA(1, 1, At, B1); PG8_BAR; PG8_SCHED;
            PG8_LDB(B0, 1, 0); PG8_LDB(B1, 1, 1); PG8_SCHED; PG8_LDA(At, 1, 0); PG8_STAGE(PG8_SA(0, 1), a2 + hstepA, voffA);
            PG8_WAIT_V(8); PG8_WAIT_L(0); PG8_BAR; PG8_MMA(0, 0, At, B0); PG8_MMA(0, 1, At, B1); PG8_BAR; PG8_SCHED;
            PG8_LDA(At, 1, 1); PG8_STAGE(PG8_SB(1, 0), b3, voffB); PG8_STAGE(PG8_SB(1, 1), b3 + hstepB, voffB); PG8_STAGE(PG8_SA(1, 0), a3, voffA);
            PG8_WAIT_V(8); PG8_WAIT_L(0); PG8_BAR; PG8_MMA(1, 0, At, B0); PG8_MMA(1, 1, At, B1); PG8_BAR; PG8_SCHED;
        }
        if (wr == 0) PG8_BAR;
        if (cur.last) { if constexpr (!Epi::AFTER_DRAIN) E(acc, cur, wr, wc, fr, fq); } else E.mid(acc, cur, wr, wc, fr, fq);
        if (!has_next) break;
        if (cur.last) {
#pragma unroll
            for (int a = 0; a < 2; ++a)
#pragma unroll
                for (int b = 0; b < 2; ++b)
#pragma unroll
                    for (int m = 0; m < 4; ++m)
#pragma unroll
                        for (int n = 0; n < 2; ++n) acc[a][b][m][n] = (f32x4){0.f, 0.f, 0.f, 0.f};
        }
        cur = nxt; cA = nA; cB = nB; ++ui;
        if (wr == 1) PG8_BAR;
    }
    PG8_WAIT_V(0);
    PG8_BAR;
    if constexpr (Epi::AFTER_DRAIN) E.fused(acc, cur, wr, wc, fr, fq, lds, wid, lane);
#undef PG8_SA
#undef PG8_SB
#undef PG8_STAGE
#undef PG8_LDA
#undef PG8_LDB
#undef PG8_MMA
#undef PG8_WAIT_V
#undef PG8_WAIT_L
#undef PG8_BAR
#undef PG8_SCHED
}

typedef const f32x4 (&AccC)[2][2][4][2];
typedef f32x4 (&AccM)[2][2][4][2];
#define EPI_ROWS_BEGIN _Pragma("unroll") for (int ai = 0; ai < 2; ++ai) _Pragma("unroll") for (int m = 0; m < 4; ++m) { const int row = u.pm * 256 + ai * 128 + wr * 64 + m * 16 + fr;
#define EPI_ROWS_END }

#define EPI_NO_MID static constexpr bool AFTER_DRAIN = false; __device__ __forceinline__ void mid(AccM, const Unit&, int, int, int, int) const {} __device__ __forceinline__ void fused(AccM, const Unit&, int, int, int, int, PG8_LAS unsigned char*, int, int) const {}

struct EpiB16 {
    EPI_NO_MID
    static constexpr bool PERM = true;
    bf16* O; int ldc;
    __device__ __forceinline__ void operator()(AccC acc, const Unit& u, int wr, int wc, int fr, int fq) const {
        const int col0 = u.pn * 256 + wc * 32 + 8 * fq;
        EPI_ROWS_BEGIN
#pragma unroll
            for (int bj = 0; bj < 2; ++bj) { const f32x4 v0 = acc[ai][bj][m][0], v1 = acc[ai][bj][m][1]; const float f[8] = {v0[0], v0[1], v0[2], v0[3], v1[0], v1[1], v1[2], v1[3]};
                *(GAS v4u*)(O + (size_t)row * ldc + col0 + bj * 128) = pack8(f); }
        EPI_ROWS_END
    }
};
struct EpiHloc {
    EPI_NO_MID
    static constexpr bool PERM = false;
    float* O;
    __device__ __forceinline__ void operator()(AccC acc, const Unit& u, int wr, int wc, int fr, int fq) const {
        const int col0 = wc * 32 + 4 * fq; float* base = O + (size_t)u.aux * 512 * 256;
        EPI_ROWS_BEGIN
            float* rowp = base + (size_t)row * 256 + col0;
#pragma unroll
            for (int bj = 0; bj < 2; ++bj)
#pragma unroll
                for (int n = 0; n < 2; ++n) *(GAS f32x4*)(rowp + bj * 128 + n * 16) = acc[ai][bj][m][n];
        EPI_ROWS_END
    }
};
struct EpiWin {
    EPI_NO_MID
    static constexpr bool PERM = true;
    bf16 *XR, *XG, *UG, *Q, *Kb, *Vb, *G; float *outK, *outV;
    __device__ __forceinline__ void operator()(AccC acc, const Unit& u, int wr, int wc, int fr, int fq) const {
        const int pn = u.pn, seg = pn >> 2;
        const int cseg = (pn & 3) * 256 + wc * 32 + 8 * fq;
        EPI_ROWS_BEGIN
#pragma unroll
            for (int bj = 0; bj < 2; ++bj) {
                const f32x4 v0 = acc[ai][bj][m][0], v1 = acc[ai][bj][m][1];
                float f[8] = {v0[0], v0[1], v0[2], v0[3], v1[0], v1[1], v1[2], v1[3]};
                const int c = cseg + bj * 128;
                if (seg >= 6) {
#pragma unroll
                    for (int e = 0; e < 8; ++e) f[e] = fsigmoid(f[e]);
                    *(GAS v4u*)(G + (size_t)row * 6144 + (pn - 24) * 256 + wc * 32 + 8 * fq + bj * 128) = pack8(f);
                } else if (seg == 1) {
#pragma unroll
                    for (int e = 0; e < 8; ++e) f[e] = gelu_tanh(f[e]);
                    *(GAS v4u*)(XG + (size_t)row * 1024 + c) = pack8(f);
                } else if (seg == 2) {
                    const int g = c >> 4, m0 = c & 15;
                    *(GAS v4u*)(UG + ((size_t)g * 512 + (row >> 4)) * 256 + (row & 15) * 16 + m0) = pack8(f);
                } else {
                    bf16* dst = seg == 0 ? XR : (seg == 3 ? Q : (seg == 4 ? Kb : Vb));
                    *(GAS v4u*)(dst + (size_t)row * 1024 + c) = pack8(f);
                    if (seg >= 4 && row < CTXR) {
                        float* o = (seg == 4 ? outK : outV) + ((size_t)(row >> 8) * 4 * 256 + (row & 255)) * 1024 + c;
                        *(f32x4*)o = v0; *(GAS f32x4*)(o + 4) = v1;
                    }
                }
            }
        EPI_ROWS_END
    }
};
struct EpiRg {
    EPI_NO_MID
    static constexpr bool PERM = true;
    const bf16* XC; const float* gb; const float* sp; f32x2* AB;
    __device__ __forceinline__ void operator()(AccC acc, const Unit& u, int wr, int wc, int fr, int fq) const {
        const int h = u.aux >> 1, d = u.aux & 1, c0 = h * 128 + wc * 32 + 8 * fq;
        const GAS float* gbr = (const GAS float*)(gb + (d * 2 + 0) * 1024 + c0); const GAS float* gbi = (const GAS float*)(gb + (d * 2 + 1) * 1024 + c0); const GAS float* spp = (const GAS float*)(sp + d * 1024 + c0);
        EPI_ROWS_BEGIN
            float xc[8]; unpack8(*(const GAS v4u*)(XC + (size_t)row * 1024 + c0), xc);
            const f32x4 r0 = acc[ai][0][m][0], r1 = acc[ai][0][m][1], i0 = acc[ai][1][m][0], i1 = acc[ai][1][m][1];
            const float rr[8] = {r0[0], r0[1], r0[2], r0[3], r1[0], r1[1], r1[2], r1[3]}, ii[8] = {i0[0], i0[1], i0[2], i0[3], i1[0], i1[1], i1[2], i1[3]};
            unsigned* dst = (unsigned*)AB + ((size_t)d * ROWS + row) * 1024 + c0;
            v4u o0, o1; unsigned w[8];
#pragma unroll
            for (int e = 0; e < 8; ++e) {
                const float r = fsigmoid(rr[e] + gbr[e]), ig = fsigmoid(ii[e] + gbi[e]);
                const float la = -8.0f * r * spp[e]; const float a = __expf(la); const float om = 1.0f - a; const float mult = __builtin_amdgcn_sqrtf(om * (1.0f + a));
                w[e] = pk2(om, mult * ig * xc[e]);
            }
            o0.x = w[0]; o0.y = w[1]; o0.z = w[2]; o0.w = w[3]; o1.x = w[4]; o1.y = w[5]; o1.z = w[6]; o1.w = w[7];
            *(GAS v4u*)dst = o0; *(GAS v4u*)(dst + 4) = o1;
            asm volatile("" ::: "memory");
        EPI_ROWS_END
    }
};
struct EpiS5Y {
    EPI_NO_MID
    static constexpr bool PERM = true;
    const bf16* UG; const float* dvec; bf16* ZS;
    __device__ __forceinline__ void operator()(AccC acc, const Unit& u, int wr, int wc, int fr, int fq) const {
        const int g = u.aux;
        v4u pf[2][4][2]; const int n0 = (8 * fq) & 15; const f32x4 d0 = *(const GAS f32x4*)(dvec + g * 16 + n0), d1 = *(const GAS f32x4*)(dvec + g * 16 + n0 + 4);
        EPI_ROWS_BEGIN
#pragma unroll
            for (int bj = 0; bj < 2; ++bj) pf[ai][m][bj] = *(const GAS v4u*)(UG + ((size_t)g * 512 + row) * 256 + bj * 128 + wc * 32 + 8 * fq);
        EPI_ROWS_END
        const float dv[8] = {d0[0], d0[1], d0[2], d0[3], d1[0], d1[1], d1[2], d1[3]};
        EPI_ROWS_BEGIN
#pragma unroll
            for (int bj = 0; bj < 2; ++bj) {
                const int col = bj * 128 + wc * 32 + 8 * fq, t = col >> 4;
                float uu[8]; unpack8(pf[ai][m][bj], uu);
                const f32x4 v0 = acc[ai][bj][m][0], v1 = acc[ai][bj][m][1];
                float f[8] = {v0[0], v0[1], v0[2], v0[3], v1[0], v1[1], v1[2], v1[3]};
#pragma unroll
                for (int e = 0; e < 8; ++e) f[e] = gelu_tanh(f[e] + dv[e] * uu[e]);
                *(GAS v4u*)(ZS + ((size_t)row * 16 + t) * 1024 + g * 16 + n0) = pack8(f);
            }
        EPI_ROWS_END
    }
};
struct EpiGlu {
    EPI_NO_MID
    static constexpr bool PERM = true;
    const bf16* ZS; bf16* Y;
    __device__ __forceinline__ void operator()(AccC acc, const Unit& u, int wr, int wc, int fr, int fq) const {
        const int col0 = u.pn * 256 + wc * 32 + 8 * fq;
        v4u pf[2][4][2];
        EPI_ROWS_BEGIN
#pragma unroll
            for (int bj = 0; bj < 2; ++bj) pf[ai][m][bj] = *(const GAS v4u*)(ZS + (size_t)row * 1024 + col0 + bj * 128);
        EPI_ROWS_END
        EPI_ROWS_BEGIN
#pragma unroll
            for (int bj = 0; bj < 2; ++bj) {
                float z[8]; unpack8(pf[ai][m][bj], z);
                const f32x4 v0 = acc[ai][bj][m][0], v1 = acc[ai][bj][m][1];
                float f[8] = {v0[0], v0[1], v0[2], v0[3], v1[0], v1[1], v1[2], v1[3]};
#pragma unroll
                for (int e = 0; e < 8; ++e) f[e] = z[e] * fsigmoid(f[e]);
                *(GAS v4u*)(Y + (size_t)row * 1024 + col0 + bj * 128) = pack8(f);
            }
        EPI_ROWS_END
    }
};
struct EpiMerge {
    static constexpr bool PERM = true, AFTER_DRAIN = false;
    __device__ __forceinline__ void fused(AccM, const Unit&, int, int, int, int, PG8_LAS unsigned char*, int, int) const {}
    const bf16* G; bf16* MM;
    __device__ __forceinline__ void mid(AccM acc, const Unit& u, int wr, int wc, int fr, int fq) const {
        const int col0 = u.pn * 256 + wc * 32 + 8 * fq, b = u.aux;
        EPI_ROWS_BEGIN
#pragma unroll
            for (int bj = 0; bj < 2; ++bj) {
                float ga[8], gn[8]; unpack8(*(const GAS v4u*)(G + (size_t)row * 6144 + b * 2048 + col0 + bj * 128), ga); unpack8(*(const GAS v4u*)(G + (size_t)row * 6144 + (b + 1) * 2048 + col0 + bj * 128), gn);
#pragma unroll
                for (int e = 0; e < 8; ++e) { const float rt = ga[e] * __builtin_amdgcn_rcpf(fmaxf(gn[e], 1e-30f)); acc[ai][bj][m][e >> 2][e & 3] *= rt; }
            }
        EPI_ROWS_END
    }
    __device__ __forceinline__ void operator()(AccC acc, const Unit& u, int wr, int wc, int fr, int fq) const {
        const int col0 = u.pn * 256 + wc * 32 + 8 * fq;
        v4u pf[2][4][2];
        EPI_ROWS_BEGIN
#pragma unroll
            for (int bj = 0; bj < 2; ++bj) pf[ai][m][bj] = *(const GAS v4u*)(G + (size_t)row * 6144 + 2 * 2048 + col0 + bj * 128);
        EPI_ROWS_END
        EPI_ROWS_BEGIN
#pragma unroll
            for (int bj = 0; bj < 2; ++bj) {
                float g2[8]; unpack8(pf[ai][m][bj], g2);
                const f32x4 v0 = acc[ai][bj][m][0], v1 = acc[ai][bj][m][1];
                float f[8] = {v0[0], v0[1], v0[2], v0[3], v1[0], v1[1], v1[2], v1[3]};
#pragma unroll
                for (int e = 0; e < 8; ++e) f[e] *= g2[e];
                *(GAS v4u*)(MM + (size_t)row * 2048 + col0 + bj * 128) = pack8(f);
            }
        EPI_ROWS_END
    }
};
struct EpiSwiglu {
    EPI_NO_MID
    static constexpr bool PERM = true;
    bf16* FH;
    __device__ __forceinline__ void operator()(AccC acc, const Unit& u, int wr, int wc, int fr, int fq) const {
        const int col0 = u.pn * 128 + wc * 32 + 8 * fq;
        EPI_ROWS_BEGIN
            const f32x4 a0 = acc[ai][0][m][0], a1 = acc[ai][0][m][1], b0 = acc[ai][1][m][0], b1 = acc[ai][1][m][1];
            const float av[8] = {a0[0], a0[1], a0[2], a0[3], a1[0], a1[1], a1[2], a1[3]}, bv[8] = {b0[0], b0[1], b0[2], b0[3], b1[0], b1[1], b1[2], b1[3]};
            float f[8];
#pragma unroll
            for (int e = 0; e < 8; ++e) f[e] = av[e] * fsigmoid(av[e]) * bv[e];
            *(GAS v4u*)(FH + (size_t)row * FFH + col0) = pack8(f);
        EPI_ROWS_END
    }
};

struct PanelSS {
    float* slots; unsigned* cnt; unsigned* tmo;
    __device__ __forceinline__ void run(const f32x4 (&v)[2][2][4][2], const Unit& u, int wr, int wc, int fr, int fq, PG8_LAS unsigned char* lds, int wid, int lane) const {
        PG8_LAS float* P = (PG8_LAS float*)lds;
        PG8_LAS float* S = (PG8_LAS float*)(lds + 8192);
#pragma unroll
        for (int ai = 0; ai < 2; ++ai)
#pragma unroll
            for (int m = 0; m < 4; ++m) { float q = 0.f;
#pragma unroll
                for (int bj = 0; bj < 2; ++bj)
#pragma unroll
                    for (int n = 0; n < 2; ++n) { const f32x4 x = v[ai][bj][m][n]; q += (x[0] * x[0] + x[1] * x[1]) + (x[2] * x[2] + x[3] * x[3]); }
                q += __builtin_bit_cast(float, __builtin_amdgcn_ds_bpermute((lane ^ 16) << 2, __builtin_bit_cast(int, q)));
                q += __builtin_bit_cast(float, __builtin_amdgcn_ds_bpermute((lane ^ 32) << 2, __builtin_bit_cast(int, q)));
                if (fq == 0) P[(ai * 128 + wr * 64 + m * 16 + fr) * 4 + wc] = q; }
        asm volatile("s_waitcnt lgkmcnt(0)" ::: "memory"); __builtin_amdgcn_s_barrier(); asm volatile("" ::: "memory");
        const int row = wid * 32 + (lane & 31);
        if (lane < 32) { const float tot = (P[row * 4 + 0] + P[row * 4 + 1]) + (P[row * 4 + 2] + P[row * 4 + 3]);
            __hip_atomic_store(slots + ((size_t)(u.pm * 256 + row) * 8 + u.pn), tot, __ATOMIC_RELAXED, __HIP_MEMORY_SCOPE_AGENT); }
        asm volatile("s_waitcnt vmcnt(0)" ::: "memory");
        if (lane == 0) __hip_atomic_fetch_add(cnt + 64 * u.pm, 1u, __ATOMIC_RELAXED, __HIP_MEMORY_SCOPE_AGENT);
        if (wid == 0) {
            const unsigned long long t0 = __builtin_amdgcn_s_memrealtime();
            for (;;) {
                if ((unsigned)__builtin_amdgcn_readfirstlane(__hip_atomic_load(cnt + 64 * u.pm, __ATOMIC_RELAXED, __HIP_MEMORY_SCOPE_AGENT)) >= 64u) break;
                if (__builtin_amdgcn_s_memrealtime() - t0 > 2000000ull) { if (lane == 0) __hip_atomic_store(tmo, 1u, __ATOMIC_RELAXED, __HIP_MEMORY_SCOPE_AGENT); break; }
                __builtin_amdgcn_s_sleep(2);
            }
            __builtin_amdgcn_fence(__ATOMIC_ACQUIRE, "agent");
        }
        asm volatile("s_waitcnt vmcnt(0) lgkmcnt(0)" ::: "memory"); __builtin_amdgcn_s_barrier(); asm volatile("" ::: "memory");
        if (lane < 32) { const float* sl = slots + (size_t)(u.pm * 256 + row) * 8; float t = 0.f;
#pragma unroll
            for (int k = 0; k < 8; ++k) t += __hip_atomic_load(sl + k, __ATOMIC_RELAXED, __HIP_MEMORY_SCOPE_AGENT);
            S[row] = rsqrtf(t * (1.0f / 2048.0f) + 1e-6f); }
        asm volatile("s_waitcnt lgkmcnt(0)" ::: "memory"); __builtin_amdgcn_s_barrier(); asm volatile("" ::: "memory");
    }
};
struct EpiResNorm {
    static constexpr bool PERM = false, AFTER_DRAIN = true;
    float* X; bf16* H; const float* gpost; const float* modGate; const float* gpre; const float* modShift; const float* modScale; PanelSS st1, st2; int hasnext;
    __device__ __forceinline__ void mid(AccM, const Unit&, int, int, int, int) const {}
    __device__ __forceinline__ void operator()(AccC, const Unit&, int, int, int, int) const {}
    __device__ __forceinline__ void fused(AccM acc, const Unit& u, int wr, int wc, int fr, int fq, PG8_LAS unsigned char* lds, int wid, int lane) const {
        const PG8_LAS float* S = (const PG8_LAS float*)(lds + 8192);
        const int col0 = u.pn * 256 + wc * 32 + 4 * fq, cv = u.pm < 16 ? 0 : 1 + ((u.pm - 16) >> 2);
        st1.run(acc, u, wr, wc, fr, fq, lds, wid, lane);
#pragma unroll
        for (int ai = 0; ai < 2; ++ai)
#pragma unroll
            for (int m = 0; m < 4; ++m) { const int r = ai * 128 + wr * 64 + m * 16 + fr; const float r1 = S[r]; const size_t off = (size_t)(u.pm * 256 + r) * 2048 + col0;
#pragma unroll
                for (int bj = 0; bj < 2; ++bj)
#pragma unroll
                    for (int n = 0; n < 2; ++n) { const int c = bj * 128 + n * 16; const f32x4 xr = *(const GAS f32x4*)(X + off + c), gp = *(const GAS f32x4*)(gpost + col0 + c), gt = *(const GAS f32x4*)(modGate + (size_t)cv * 12288 + col0 + c);
                        acc[ai][bj][m][n] = xr + gt * (acc[ai][bj][m][n] * r1 * gp); }
                asm volatile("" : "+v"(acc[ai][0][m][0]), "+v"(acc[ai][0][m][1]), "+v"(acc[ai][1][m][0]), "+v"(acc[ai][1][m][1]));
                if (m & 1) asm volatile("" ::: "memory"); }
        if (hasnext) st2.run(acc, u, wr, wc, fr, fq, lds, wid, lane);
#pragma unroll
        for (int ai = 0; ai < 2; ++ai)
#pragma unroll
            for (int m = 0; m < 4; ++m) { const int r = ai * 128 + wr * 64 + m * 16 + fr; const float r2 = hasnext ? S[r] : 0.f; const size_t off = (size_t)(u.pm * 256 + r) * 2048 + col0;
#pragma unroll
                for (int bj = 0; bj < 2; ++bj)
#pragma unroll
                    for (int n = 0; n < 2; ++n) { const int c = bj * 128 + n * 16; const f32x4 x1 = acc[ai][bj][m][n]; *(GAS f32x4*)(X + off + c) = x1;
                        if (hasnext) { const f32x4 g = *(const GAS f32x4*)(gpre + col0 + c), sh = *(const GAS f32x4*)(modShift + (size_t)cv * 12288 + col0 + c), sc = *(const GAS f32x4*)(modScale + (size_t)cv * 12288 + col0 + c);
                            const f32x4 hv = x1 * r2 * g * (sc + 1.0f) + sh; v2u w; w.x = pk2(hv[0], hv[1]); w.y = pk2(hv[2], hv[3]); *(GAS v2u*)(H + off + c) = w; } }
                asm volatile("" ::: "memory"); }
    }
};

struct SchedPlain {
    const char* A; const char* B; int nM, nN, G, c; size_t tA, tB; int dup;
    __device__ __forceinline__ bool next(int i, Unit& u) const { int pm, pn; const int q = i / (dup * DUP_GEMM), r = i - q * (dup * DUP_GEMM); long L = (long)q * G + c; const int nwg = nM * nN; if (L >= nwg) return false;
        if (r) L = (L + nwg / 2 + 8) % nwg;
        if (!tile_order(L, nM, nN, pm, pn)) return false; u.A = A + (size_t)pm * tA; u.B = B + (size_t)pn * tB; u.pm = pm; u.pn = pn; u.aux = 0; u.last = 1; return true; }
};
struct SchedMerge {
    const char* A0; const char* A1; const char* A2; const char* B; int G, c;
    __device__ __forceinline__ bool next(int i, Unit& u) const { const int ti = i / 3, b = i - ti * 3; int pm, pn; const int q = ti / (DUPG6 * DUP_GEMM), r = ti - q * (DUPG6 * DUP_GEMM); long L = (long)q * G + c; if (L >= 256) return false; if (r) L = (L + 136) % 256;
        if (!tile_order(L, 32, 8, pm, pn)) return false;
        const char* Ab = b == 0 ? A0 : (b == 1 ? A1 : A2); u.A = Ab + (size_t)pm * 256 * 1024 * 2; u.B = B + ((size_t)b * 2048 + pn * 256) * 1024 * 2; u.pm = pm; u.pn = pn; u.aux = b; u.last = (b == 2); return true; }
};
struct SchedS5E {
    const char* UG; const char* ET; int G, c;
    __device__ __forceinline__ bool next(int i, Unit& u) const { const int L = (i / DUP_S5) * G + c; if (L >= 128) return false; const int g = L >> 1, pm = L & 1;
        u.A = UG + ((size_t)g * 512 + pm * 256) * 256 * 2; u.B = ET + (size_t)g * 256 * 256 * 2; u.pm = pm; u.pn = 0; u.aux = g; u.last = 1; return true; }
};
struct SchedS5Y {
    const char* UG; const char* HIN; const char* MT; const char* FT; int G, c;
    __device__ __forceinline__ bool next(int i, Unit& u) const { const int ti = (i >> 1) / DUP_S5, part = i & 1, L = ti * G + c; if (L >= 128) return false; const int g = L >> 1, pm = L & 1;
        u.A = (part ? HIN : UG) + ((size_t)g * 512 + pm * 256) * 256 * 2; u.B = (part ? FT : MT) + (size_t)g * 256 * 256 * 2; u.pm = pm; u.pn = 0; u.aux = g; u.last = part; return true; }
};
struct SchedOne {
    const char* A0; const char* B0; const char* A1; const char* B1; int pm, aux, nparts;
    __device__ __forceinline__ bool next(int i, Unit& u) const { if (i >= nparts) return false; u.A = i ? A1 : A0; u.B = i ? B1 : B0; u.pm = pm; u.pn = 0; u.aux = aux; u.last = (i == nparts - 1); return true; }
};
struct SchedRg {
    const char* XC; const char* GWT; int G, c;
    __device__ __forceinline__ bool next(int i, Unit& u) const { const int L = (i / DUP_RGG) * G + c; if (L >= 512) return false; const int pm = L & 31, hd = L >> 5;
        u.A = XC + ((size_t)pm * 256 * 1024 + (hd >> 1) * 128) * 2; u.B = GWT + (size_t)hd * 256 * 128 * 2; u.pm = pm; u.pn = 0; u.aux = hd; u.last = 1; return true; }
};
}

namespace att {
using bf16x8 = __attribute__((ext_vector_type(8))) short;
using s16x4  = __attribute__((ext_vector_type(4))) short;
using f32x16 = __attribute__((ext_vector_type(16))) float;
using u32x4  = __attribute__((ext_vector_type(4))) unsigned;
constexpr int D = 128, NW = 8, QBLK = 32, KVBLK = 64, LD = 1024;
constexpr float SCALE = 0.088388347648318440f, THR = 8.f;
constexpr size_t SHM_V = KVBLK * D * 2, SHM_K = KVBLK * D * 2, SHM_ATTN = 2 * SHM_V + 2 * SHM_K + NW * 64 * 4;
constexpr int RPB_OFF = (int)SHM_ATTN + 256;
#define KSWZ(row, colB) ((row) * 256 + ((colB) ^ (((row) & 7) << 4)))
#define SBAR() __builtin_amdgcn_sched_barrier(0)
__device__ __forceinline__ int crow(int r, int hi) { return (r & 3) + 8 * (r >> 2) + 4 * hi; }
__device__ __forceinline__ unsigned cvtpk(float lo, float hi) { return pk2(lo, hi); }
__device__ __forceinline__ void partialSM(f32x16& p0, f32x16& p1, float& m_reg, float& mn, float& alpha) {
  constexpr float C = SCALE * 1.4426950408889634f;
  float pmax = p0[0]; for (int r = 1; r < 16; ++r) pmax = fmaxf(pmax, p0[r]); for (int r = 0; r < 16; ++r) pmax = fmaxf(pmax, p1[r]);
  { auto rr = __builtin_amdgcn_permlane32_swap(__float_as_uint(pmax), __float_as_uint(pmax), false, false);
    pmax = fmaxf(__uint_as_float(rr[0]), __uint_as_float(rr[1])); }
  if (__builtin_expect(__all(pmax - m_reg <= THR / SCALE), 1)) { mn = m_reg; alpha = 1.f; }
  else { mn = fmaxf(m_reg, pmax); alpha = __builtin_amdgcn_exp2f((m_reg - mn) * C); m_reg = mn; }
  float mnC = -mn * C;
  for (int r = 0; r < 16; ++r) p0[r] = fmaf(p0[r], C, mnC); for (int r = 0; r < 16; ++r) p1[r] = fmaf(p1[r], C, mnC);
  for (int r = 0; r < 16; ++r) p0[r] = __builtin_amdgcn_exp2f(p0[r]);
}
__device__ __forceinline__ void finishSM(f32x16& p0, f32x16& p1, float alpha, float& l_reg, bf16x8& pa0, bf16x8& pa1, bf16x8& pa2, bf16x8& pa3) {
  for (int r = 0; r < 16; ++r) p1[r] = __builtin_amdgcn_exp2f(p1[r]);
  float ps = 0; for (int r = 0; r < 16; ++r) ps += p0[r]; for (int r = 0; r < 16; ++r) ps += p1[r];
  { auto rr = __builtin_amdgcn_permlane32_swap(__float_as_uint(ps), __float_as_uint(ps), false, false);
    ps = __uint_as_float(rr[0]) + __uint_as_float(rr[1]); }
  l_reg = l_reg * alpha + ps;
#define PK4(P, BASE, OUT) do { unsigned a0 = cvtpk(P[BASE + 0], P[BASE + 1]), a1 = cvtpk(P[BASE + 2], P[BASE + 3]);   \
    unsigned b0 = cvtpk(P[BASE + 4], P[BASE + 5]), b1 = cvtpk(P[BASE + 6], P[BASE + 7]);                              \
    auto r0 = __builtin_amdgcn_permlane32_swap(a0, b0, false, false); auto r1 = __builtin_amdgcn_permlane32_swap(a1, b1, false, false); \
    u32x4 w = {r0[0], r1[0], r0[1], r1[1]}; OUT = *reinterpret_cast<bf16x8*>(&w); } while (0)
  PK4(p0, 0, pa0); PK4(p0, 8, pa1); PK4(p1, 0, pa2); PK4(p1, 8, pa3);
#undef PK4
}
__device__ __forceinline__ void qkt(f32x16& p0, f32x16& p1, const bf16* Ks, const bf16x8* qr, int r32, int hi) {
  p0 = f32x16{}; p1 = f32x16{};
  for (int d0 = 0; d0 < 8; ++d0) { int cb = (d0 * 16 + hi * 8) * 2;
    bf16x8 b0 = *reinterpret_cast<const bf16x8*>((const char*)Ks + KSWZ(r32, cb));
    bf16x8 b1 = *reinterpret_cast<const bf16x8*>((const char*)Ks + KSWZ(32 + r32, cb));
    p0 = __builtin_amdgcn_mfma_f32_32x32x16_bf16(b0, qr[d0], p0, 0, 0, 0);
    p1 = __builtin_amdgcn_mfma_f32_32x32x16_bf16(b1, qr[d0], p1, 0, 0, 0); }
}
__device__ __forceinline__ int v_st(int k, int c) { const int kk = (k & ~0xC) | ((k & 4) << 1) | ((k & 8) >> 1); return ((kk >> 3) * 4 + (c >> 5)) * 512 + ((kk & 7) * 32 + (c & 31)) * 2; }
__device__ __forceinline__ int v_rd_base(int lane) { return ((lane & 3) << 3) | (((lane >> 2) & 3) << 6) | (((lane >> 4) & 1) << 5) | (((lane >> 5) & 1) << 8); }
constexpr int v_rd_off(int d0, int ks, int half) { return d0 * 512 + ks * 4096 + half * 2048; }
template <int OFF> __device__ __forceinline__ s16x4 tr_read(int vb) {
  s16x4 r; asm volatile("ds_read_b64_tr_b16 %0, %1 offset:%2" : "=&v"(r) : "v"(vb), "i"(OFF) : "memory"); return r;
}
template <int D0> __device__ __forceinline__ void pv_one(f32x16& od, int vb, bf16x8 pa0, bf16x8 pa1, bf16x8 pa2, bf16x8 pa3) {
  const s16x4 l0 = tr_read<v_rd_off(D0, 0, 0)>(vb), h0 = tr_read<v_rd_off(D0, 0, 1)>(vb), l1 = tr_read<v_rd_off(D0, 1, 0)>(vb), h1 = tr_read<v_rd_off(D0, 1, 1)>(vb);
  const s16x4 l2 = tr_read<v_rd_off(D0, 2, 0)>(vb), h2 = tr_read<v_rd_off(D0, 2, 1)>(vb), l3 = tr_read<v_rd_off(D0, 3, 0)>(vb), h3 = tr_read<v_rd_off(D0, 3, 1)>(vb);
  asm volatile("s_waitcnt lgkmcnt(0)" ::: "memory"); SBAR();
#define PK(L, H) (bf16x8){L[0], L[1], L[2], L[3], H[0], H[1], H[2], H[3]}
  od = __builtin_amdgcn_mfma_f32_32x32x16_bf16(pa0, PK(l0, h0), od, 0, 0, 0);
  od = __builtin_amdgcn_mfma_f32_32x32x16_bf16(pa1, PK(l1, h1), od, 0, 0, 0);
  od = __builtin_amdgcn_mfma_f32_32x32x16_bf16(pa2, PK(l2, h2), od, 0, 0, 0);
  od = __builtin_amdgcn_mfma_f32_32x32x16_bf16(pa3, PK(l3, h3), od, 0, 0, 0);
#undef PK
}
__device__ __forceinline__ void pv_d0(f32x16* o, int vb, bf16x8 pa0, bf16x8 pa1, bf16x8 pa2, bf16x8 pa3) {
  pv_one<0>(o[0], vb, pa0, pa1, pa2, pa3); pv_one<1>(o[1], vb, pa0, pa1, pa2, pa3); pv_one<2>(o[2], vb, pa0, pa1, pa2, pa3); pv_one<3>(o[3], vb, pa0, pa1, pa2, pa3);
}
__device__ __forceinline__ void na_mask(f32x16& p0, f32x16& p1, int kr, int qr, int rs, int ws, const float* rpbl, int hi) {
  if (kr < rs || kr >= rs + 8) {
#pragma unroll
    for (int r = 0; r < 16; ++r) { p0[r] = -1e30f; p1[r] = -1e30f; }
  } else {
    const float* row = rpbl + (kr - qr + 7) * 31 + 4 * hi; const unsigned w0 = (unsigned)(4 * hi - ws);
#pragma unroll
    for (int r = 0; r < 16; ++r) {
      const int kc = (r & 3) + 8 * (r >> 2);
      const float b0 = row[kc], b1 = row[kc + 32];
      p0[r] = (w0 + (unsigned)kc < 16u) ? p0[r] + b0 : -1e30f; p1[r] = (w0 + (unsigned)(kc + 32) < 16u) ? p1[r] + b1 : -1e30f;
      if ((r & 3) == 3) SBAR();
    }
  }
}
template <bool NA, int SD>
__device__ __forceinline__ void attn_body(const bf16* __restrict__ Qb, const bf16* __restrict__ K0, const bf16* __restrict__ V0, const bf16* __restrict__ K1, const bf16* __restrict__ V1,
                                          bf16* __restrict__ Ob, const int NT, const int lo, const int rg, char* lds) {
  int tid_ = threadIdx.x; asm volatile("" : "+v"(tid_));
  const int tid = tid_, wid = tid >> 6, lane = tid & 63, r32 = lane & 31, hi = lane >> 5;
  bf16* V_lds = (bf16*)lds; bf16* K_lds = (bf16*)(lds + 2 * SHM_V);
  float* ws_ = (float*)(lds + 2 * SHM_V + 2 * SHM_K) + wid * 64; float* li_l = ws_; float* al_l = ws_ + 32;
  const int qrow = 4 * rg + (wid >> 1), qc = 32 * (wid & 1) + r32;
  const int rs = qrow - 4 < 0 ? 0 : (qrow - 4 > 8 ? 8 : qrow - 4), wsn = qc - 8 < 0 ? 0 : (qc - 8 > 48 ? 48 : qc - 8);
  const float* rpbl = (const float*)(lds + RPB_OFF) + 15 - qc;
  float m_reg = -1e30f, l_reg = 0; f32x16 o[4] = {}; bf16x8 qr[8];
  const bf16* Qw = Qb + (long)(wid * QBLK + r32) * LD + hi * 8;
#pragma unroll
  for (int d0 = 0; d0 < 8; ++d0) qr[d0] = *(const GAS bf16x8*)(Qw + d0 * 16);
  const int sr = tid >> 4, sc = (tid & 15) * 8, vst0 = v_st(sr, sc), vst1 = v_st(32 + sr, sc);
  const int vb0 = (int)(uintptr_t)V_lds + v_rd_base(lane);
  struct { bf16x8 vs0, vs1, ks0, ks1; } sr_[SD];
#define TILEK(t) ((NA && (t) >= 8) ? K1 + (long)((t) - 8) * 64 * LD : K0 + (long)(t) * 64 * LD)
#define TILEV(t) ((NA && (t) >= 8) ? V1 + (long)((t) - 8) * 64 * LD : V0 + (long)(t) * 64 * LD)
#define SLOAD(i, t) do { const bf16* kp_ = TILEK(t); const bf16* vp_ = TILEV(t); \
    sr_[i].vs0 = *(const GAS bf16x8*)(&vp_[(long)sr * LD + sc]); sr_[i].vs1 = *(const GAS bf16x8*)(&vp_[(long)(32 + sr) * LD + sc]); \
    sr_[i].ks0 = *(const GAS bf16x8*)(&kp_[(long)sr * LD + sc]); sr_[i].ks1 = *(const GAS bf16x8*)(&kp_[(long)(32 + sr) * LD + sc]); } while (0)
#define SWRITE(b, i) do { *(bf16x8*)((char*)V_lds + (b) * SHM_V + vst0) = sr_[i].vs0;          \
    *(bf16x8*)((char*)V_lds + (b) * SHM_V + vst1) = sr_[i].vs1; int kc = sc * 2;               \
    *(bf16x8*)((char*)K_lds + (b) * SHM_K + KSWZ(sr, kc)) = sr_[i].ks0;                       \
    *(bf16x8*)((char*)K_lds + (b) * SHM_K + KSWZ(32 + sr, kc)) = sr_[i].ks1; } while (0)
#define SWAIT() do { if constexpr (SD == 2) asm volatile("s_waitcnt vmcnt(4)" ::: "memory"); else asm volatile("s_waitcnt vmcnt(0)" ::: "memory"); } while (0)
#define RESC(a) do { if (__any((a) < 1.f)) { if (hi == 0) al_l[r32] = (a); asm volatile("s_waitcnt lgkmcnt(0)" ::: "memory"); \
    for (int d = 0; d < 4; ++d) for (int r = 0; r < 16; ++r) o[d][r] *= al_l[crow(r, hi)]; } } while (0)
#define MASK(P0, P1, t) do { if (NA && (t) >= 8) na_mask(P0, P1, lo + (t) - 8, qrow, rs, wsn, rpbl, hi); } while (0)
  f32x16 pA0, pA1, pB0, pB1; float mnA, mnB, alA, alB; bf16x8 pa0, pa1, pa2, pa3;
  constexpr int SE = 0, SO = SD - 1;
  SLOAD(SE, 0); asm volatile("s_waitcnt vmcnt(0)" ::: "memory"); SWRITE(0, SE); __syncthreads();
  qkt(pA0, pA1, K_lds, qr, r32, hi); partialSM(pA0, pA1, m_reg, mnA, alA);
  SLOAD(SO, 1); if constexpr (SD == 2) { if (2 < NT) SLOAD(SE, 2); }
  SWAIT(); SWRITE(1, SO); __syncthreads();
  for (int j = 1; j + 1 < NT; j += 2) {
    SBAR(); qkt(pB0, pB1, (bf16*)((char*)K_lds + SHM_K), qr, r32, hi); MASK(pB0, pB1, j);
    finishSM(pA0, pA1, alA, l_reg, pa0, pa1, pa2, pa3); SBAR();
    SLOAD(SO, j + SD); SBAR();
    pv_d0(o, vb0, pa0, pa1, pa2, pa3); partialSM(pB0, pB1, m_reg, mnB, alB);
    __syncthreads(); SWAIT(); SWRITE(0, SE);
    RESC(alB); __syncthreads();
    SBAR(); qkt(pA0, pA1, K_lds, qr, r32, hi); MASK(pA0, pA1, j + 1);
    finishSM(pB0, pB1, alB, l_reg, pa0, pa1, pa2, pa3); SBAR();
    if (SD == 1 || j + 3 < NT) SLOAD(SE, j + 1 + SD); SBAR();
    pv_d0(o, vb0 + (int)SHM_V, pa0, pa1, pa2, pa3); partialSM(pA0, pA1, m_reg, mnA, alA);
    __syncthreads(); SWAIT(); SWRITE(1, SO);
    RESC(alA); __syncthreads();
  }
  SBAR(); qkt(pB0, pB1, (bf16*)((char*)K_lds + SHM_K), qr, r32, hi); MASK(pB0, pB1, NT - 1);
  finishSM(pA0, pA1, alA, l_reg, pa0, pa1, pa2, pa3); SBAR();
  pv_d0(o, vb0, pa0, pa1, pa2, pa3); partialSM(pB0, pB1, m_reg, mnB, alB);
  __syncthreads(); RESC(alB);
  finishSM(pB0, pB1, alB, l_reg, pa0, pa1, pa2, pa3); SBAR();
  pv_d0(o, vb0 + (int)SHM_V, pa0, pa1, pa2, pa3);
  if (hi == 0) li_l[r32] = l_reg; asm volatile("s_waitcnt lgkmcnt(0)" ::: "memory");
  float rli[16];
#pragma unroll
  for (int r = 0; r < 16; ++r) rli[r] = __builtin_amdgcn_rcpf(li_l[crow(r, hi)]);
  bf16* Ow = Ob + (long)(wid * QBLK) * LD;
#pragma unroll
  for (int r = 0; r < 16; ++r) { int orow = crow(r, hi);
    for (int d0 = 0; d0 < 4; ++d0) *(GAS bf16*)(Ow + (long)orow * LD + d0 * 32 + r32) = (bf16)f2bf(o[d0][r] * rli[r]); }
  asm volatile("s_waitcnt vmcnt(0)" ::: "memory"); __syncthreads();
#undef TILEK
#undef TILEV
#undef SLOAD
#undef SWRITE
#undef SWAIT
#undef RESC
#undef MASK
}
}

constexpr int NWAVES = 8;
struct Args { const float* in[36]; float* out; unsigned char* ws; int ph_lo, ph_hi; };
struct Frame { LAS unsigned char* lds; char* ldsg; volatile LAS unsigned* MISC; int tid, lane, wave, vcu, G; };
constexpr int INTAB_OFF = MISC_OFF + 128;
__device__ __forceinline__ const float* ld_in(const LAS unsigned char* lds, int i) { const unsigned long long v = ((const LAS unsigned long long*)(lds + INTAB_OFF))[i];
    const unsigned lo = __builtin_amdgcn_readfirstlane((unsigned)v), hi = __builtin_amdgcn_readfirstlane((unsigned)(v >> 32)); return (const float*)(((unsigned long long)hi << 32) | lo); }
#define IN(i) ld_in(F.lds, (i))

__device__ __forceinline__ void transpose_item(const float* W, int N, int k0, int n0, bf16* WT, int ldo, int drow0, float* scr, int lane) {
    const int kr = lane >> 3, n4 = (lane & 7) * 4;
    f32x4 v[8];
#pragma unroll
    for (int i = 0; i < 8; ++i) v[i] = *(const GAS f32x4*)(W + (size_t)(k0 + kr + 8 * i) * N + n0 + n4);
#pragma unroll
    for (int i = 0; i < 8; ++i) { float* d = scr + (kr + 8 * i) * 33 + n4; d[0] = v[i].x; d[1] = v[i].y; d[2] = v[i].z; d[3] = v[i].w; }
    LDS_WAIT(); asm volatile("" ::: "memory");
    const int c = lane & 7;
#pragma unroll
    for (int j = 0; j < 4; ++j) { const int n = (lane >> 3) + 8 * j; const float* s = scr + (8 * c) * 33 + n;
        v4u o; o.x = pk2(s[0 * 33], s[1 * 33]); o.y = pk2(s[2 * 33], s[3 * 33]); o.z = pk2(s[4 * 33], s[5 * 33]); o.w = pk2(s[6 * 33], s[7 * 33]);
        *(GAS v4u*)(WT + (size_t)(drow0 + n) * ldo + k0 + 8 * c) = o; }
    LDS_WAIT(); asm volatile("" ::: "memory");
}

__device__ __forceinline__ int cv_of_row(int row) { return row < CTXR ? 0 : 1 + ((row - CTXR) >> 10); }

template <bool FIRST, bool HASNEXT, bool XIN16, bool XOUT16>
__device__ __forceinline__ void resnorm_rows(const Frame& F, const float* xin0, const float* xin1, float* X, bf16* XB, const bf16* Z, const float* gpost, const float* modGate  ,
                                             const float* gpre, const float* modShift, const float* modScale, bf16* H) {
    const int gw = F.vcu * NWAVES + F.wave, NGW = F.G * NWAVES;
    for (int rb = gw * 4; rb < ROWS; rb += NGW * 4) {
        const int cv = cv_of_row(rb);
        f32x4 gg[8], gs[8], shv[8];
#pragma unroll
        for (int j = 0; j < 8; ++j) { const int q = 2 * (F.lane + 64 * (j >> 1)) + (j & 1);
            if (!FIRST) gg[j] = ((const GAS f32x4*)gpost)[q] * ((const GAS f32x4*)(modGate + (size_t)cv * 12288))[q];
            if (HASNEXT) { gs[j] = ((const GAS f32x4*)gpre)[q] * (((const GAS f32x4*)(modScale + (size_t)cv * 12288))[q] + 1.0f); shv[j] = ((const GAS f32x4*)(modShift + (size_t)cv * 12288))[q]; } }
#pragma unroll 1
        for (int r2 = 0; r2 < 4; r2 += 2) {
            v4u zw[2][4], xw[2][4]; f32x4 xf[2][8];
#pragma unroll
            for (int rr = 0; rr < 2; ++rr) { const int row = rb + r2 + rr;
                if (FIRST) { const GAS f32x4* src = (const GAS f32x4*)(row < CTXR ? xin0 + (size_t)row * DM : xin1 + (size_t)(row - CTXR) * DM);
#pragma unroll
                    for (int j = 0; j < 8; ++j) xf[rr][j] = src[2 * (F.lane + 64 * (j >> 1)) + (j & 1)];
                } else {
#pragma unroll
                    for (int jj = 0; jj < 4; ++jj) zw[rr][jj] = ((const GAS v4u*)(Z + (size_t)row * DM))[F.lane + 64 * jj];
                    if (XIN16) {
#pragma unroll
                        for (int jj = 0; jj < 4; ++jj) xw[rr][jj] = ((const GAS v4u*)(XB + (size_t)row * DM))[F.lane + 64 * jj];
                    } else {
#pragma unroll
                        for (int j = 0; j < 8; ++j) xf[rr][j] = ((const GAS f32x4*)(X + (size_t)row * DM))[2 * (F.lane + 64 * (j >> 1)) + (j & 1)];
                    } } }
#pragma unroll
            for (int rr = 0; rr < 2; ++rr) { const int row = rb + r2 + rr;
                f32x4 x[8];
                if (FIRST) {
#pragma unroll
                    for (int j = 0; j < 8; ++j) x[j] = xf[rr][j];
                } else {
                    f32x4 z[8]; float ss = 0.f;
#pragma unroll
                    for (int jj = 0; jj < 4; ++jj) { float f[8]; unpack8(zw[rr][jj], f); z[2 * jj] = (f32x4){f[0], f[1], f[2], f[3]}; z[2 * jj + 1] = (f32x4){f[4], f[5], f[6], f[7]}; }
#pragma unroll
                    for (int j = 0; j < 8; ++j) ss += (z[j].x * z[j].x + z[j].y * z[j].y) + (z[j].z * z[j].z + z[j].w * z[j].w);
                    const float rstd = rsqrtf(wave_sum(ss, F.lane) * (1.f / DM) + RMS_EPS);
#pragma unroll
                    for (int j = 0; j < 8; ++j) { f32x4 xo;
                        if (XIN16) { float f[8]; unpack8(xw[rr][j >> 1], f); xo = (j & 1) ? (f32x4){f[4], f[5], f[6], f[7]} : (f32x4){f[0], f[1], f[2], f[3]}; } else xo = xf[rr][j];
                        x[j] = xo + gg[j] * (z[j] * rstd); }
                }
                if (XOUT16) { GAS v4u* xo = (GAS v4u*)(XB + (size_t)row * DM);
#pragma unroll
                  for (int jj = 0; jj < 4; ++jj) { const float f[8] = {x[2 * jj].x, x[2 * jj].y, x[2 * jj].z, x[2 * jj].w, x[2 * jj + 1].x, x[2 * jj + 1].y, x[2 * jj + 1].z, x[2 * jj + 1].w}; xo[F.lane + 64 * jj] = pack8(f); }
                } else { GAS f32x4* xo = (GAS f32x4*)(X + (size_t)row * DM);
#pragma unroll
                  for (int j = 0; j < 8; ++j) xo[2 * (F.lane + 64 * (j >> 1)) + (j & 1)] = x[j]; }
                if (HASNEXT) {
                    float ss = 0.f;
#pragma unroll
                    for (int j = 0; j < 8; ++j) ss += (x[j].x * x[j].x + x[j].y * x[j].y) + (x[j].z * x[j].z + x[j].w * x[j].w);
                    const float rstd = rsqrtf(wave_sum(ss, F.lane) * (1.f / DM) + RMS_EPS);
                    GAS v4u* ho = (GAS v4u*)(H + (size_t)row * DM);
#pragma unroll
                    for (int jj = 0; jj < 4; ++jj) { float f[8];
#pragma unroll
                        for (int h = 0; h < 2; ++h) { const f32x4 hv = x[2 * jj + h] * rstd * gs[2 * jj + h] + shv[2 * jj + h]; f[4 * h] = hv.x; f[4 * h + 1] = hv.y; f[4 * h + 2] = hv.z; f[4 * h + 3] = hv.w; }
                        ho[F.lane + 64 * jj] = pack8(f); }
                }
            }
        }
    }
}

__device__ __forceinline__ void s5_tables(const Frame& F, int l, int g, unsigned char* ws) {
    char* L = F.ldsg;
    f32x2* POW = (f32x2*)L;
    f32x2* BB = (f32x2*)(L + 17408);
    f32x2* CC = (f32x2*)(L + 17408 + 16384);
    float* KT = (float*)(L + 17408 + 32768);
    const int tid = F.tid;
    __syncthreads();
    if (tid < 128) {
        const int d = tid >> 6, p = tid & 63; const size_t li = ((size_t)(l * 2 + d) * 64 + g) * 64 + p;
        const float dt = expf(IN(22)[(l * 2 + d) * 64 + g]); const float lre = IN(20)[li], lim = IN(21)[li];
        const float er = expf(lre * dt); float sn, cs; sincosf(lim * dt, &sn, &cs);
        const float br = er * cs, bi = er * sn;
        const float nr = br - 1.0f, ni = bi, den = lre * lre + lim * lim;
        const float cr = (nr * lre + ni * lim) / den, ci = (ni * lre - nr * lim) / den;
        float pr = 1.f, pi = 0.f;
        for (int t = 0; t <= 16; ++t) { POW[(d * 64 + p) * 17 + t] = (f32x2){pr, pi}; const float nr2 = pr * br - pi * bi, ni2 = pr * bi + pi * br; pr = nr2; pi = ni2; }
        ((f32x2*)(ws + WS_LT))[li] = POW[(d * 64 + p) * 17 + 16];
        { f32x4 vr[4], vi[4]; const GAS f32x4* pr4 = (const GAS f32x4*)(IN(23) + li * 16); const GAS f32x4* pi4 = (const GAS f32x4*)(IN(24) + li * 16);
#pragma unroll
          for (int q = 0; q < 4; ++q) { vr[q] = pr4[q]; vi[q] = pi4[q]; }
#pragma unroll
          for (int m = 0; m < 16; ++m) { const float xr = vr[m >> 2][m & 3], xi = vi[m >> 2][m & 3]; BB[(d * 64 + p) * 16 + m] = (f32x2){cr * xr - ci * xi, cr * xi + ci * xr}; } }
    }
    for (int i = tid; i < 2048; i += 512) { const int d = i >> 10, n = (i >> 6) & 15, p = i & 63; const size_t ci_ = (((size_t)(l * 2 + d) * 64 + g) * 16 + n) * 64 + p; CC[i] = (f32x2){IN(25)[ci_], IN(26)[ci_]}; }
    __syncthreads();
    {
        const int d = tid >> 8, n = (tid >> 4) & 15, m = tid & 15; float acc[16];
#pragma unroll
        for (int t = 0; t < 16; ++t) acc[t] = 0.f;
        for (int p = 0; p < 64; ++p) { const f32x2 c = CC[(d * 16 + n) * 64 + p], b = BB[(d * 64 + p) * 16 + m]; const float cbr = c.x * b.x - c.y * b.y, cbi = c.x * b.y + c.y * b.x;
#pragma unroll
            for (int t = 0; t < 16; ++t) { const f32x2 w = POW[(d * 64 + p) * 17 + t]; acc[t] += cbr * w.x - cbi * w.y; } }
#pragma unroll
        for (int t = 0; t < 16; ++t) KT[((d * 16 + t) * 16 + n) * 16 + m] = acc[t];
    }
    __syncthreads();
    bf16* MT = (bf16*)(ws + WS_MT) + (size_t)(l * 64 + g) * 65536; bf16* ET = (bf16*)(ws + WS_ET) + (size_t)(l * 64 + g) * 65536; bf16* FT = (bf16*)(ws + WS_FT) + (size_t)(l * 64 + g) * 65536;
    for (int i = tid; i < 8192; i += 512) {
        const int rowi = i >> 5, k0 = (i & 31) * 8;
        { const int t = rowi >> 4, n = rowi & 15, s = k0 >> 4, m0 = k0 & 15; float f[8];
#pragma unroll
          for (int e = 0; e < 8; ++e) { float v = 0.f; if (s <= t) v += KT[((0 * 16 + (t - s)) * 16 + n) * 16 + m0 + e]; if (s >= t) v += KT[((1 * 16 + (s - t)) * 16 + n) * 16 + m0 + e]; f[e] = v; }
          *(GAS v4u*)(MT + (size_t)rowi * 256 + k0) = pack8(f); }
        { const int d = rowi >> 7, p = (rowi >> 1) & 63, c = rowi & 1, s = k0 >> 4, m0 = k0 & 15; float f[8];
          const f32x2 w = POW[(d * 64 + p) * 17 + (d == 0 ? 15 - s : s)];
#pragma unroll
          for (int e = 0; e < 8; ++e) { const f32x2 b = BB[(d * 64 + p) * 16 + m0 + e]; f[e] = c == 0 ? (w.x * b.x - w.y * b.y) : (w.x * b.y + w.y * b.x); }
          *(GAS v4u*)(ET + (size_t)rowi * 256 + k0) = pack8(f); }
        { const int t = rowi >> 4, n = rowi & 15; float f[8];
#pragma unroll
          for (int e = 0; e < 8; ++e) { const int k = k0 + e, d = k >> 7, p = (k >> 1) & 63, c = k & 1; const f32x2 cc = CC[(d * 16 + n) * 64 + p], w = POW[(d * 64 + p) * 17 + (d == 0 ? t + 1 : 16 - t)];
              f[e] = c == 0 ? (cc.x * w.x - cc.y * w.y) : -(cc.x * w.y + cc.y * w.x); }
          *(GAS v4u*)(FT + (size_t)rowi * 256 + k0) = pack8(f); }
    }
    __syncthreads();
}

constexpr int I_WIN = 32 * 384, I_GLU = 16 * 32, I_OUT = 16 * 64, I_WO = 32 * 64, I_FIN = 32 * 352, I_FOUT = 88 * 64, I_GW = 32 * 8;
constexpr int I_LAYER = I_WIN + I_GLU + 3 * I_OUT + I_WO + I_FIN + I_FOUT + I_GW;
__device__ __forceinline__ void weight_item(const Frame& F, unsigned char* ws, int l, int r, float* scr) {
    if (r < I_WIN) { const int kb = r / 384, nb = r % 384; transpose_item(IN(14) + (size_t)l * DM * INW, INW, kb * 64, nb * 32, (bf16*)(ws + WS_WINT) + (size_t)l * INW * DM, DM, nb * 32, scr, F.lane); return; } r -= I_WIN;
    if (r < I_GLU) { const int kb = r / 32, nb = r % 32; transpose_item(IN(28) + (size_t)l * 1024 * 1024, 1024, kb * 64, nb * 32, (bf16*)(ws + WS_GLUT) + (size_t)l * 1024 * 1024, 1024, nb * 32, scr, F.lane); return; } r -= I_GLU;
    if (r < 3 * I_OUT) { const int b = r / I_OUT, q = r % I_OUT, kb = q / 64, nb = q % 64; transpose_item(IN(30 + b) + (size_t)l * 1024 * DM, DM, kb * 64, nb * 32, (bf16*)(ws + WS_OUTT) + ((size_t)l * 3 + b) * DM * 1024, 1024, nb * 32, scr, F.lane); return; } r -= 3 * I_OUT;
    if (r < I_WO) { const int kb = r / 64, nb = r % 64; transpose_item(IN(33) + (size_t)l * DM * DM, DM, kb * 64, nb * 32, (bf16*)(ws + WS_WOT) + (size_t)l * DM * DM, DM, nb * 32, scr, F.lane); return; } r -= I_WO;
    if (r < I_FIN) { const int kb = r / 352, nb = r % 352; const int n0 = nb * 32, half = n0 >= FFH, j = n0 - half * FFH; const int drow = 256 * (j >> 7) + 128 * half + (j & 127);
        transpose_item(IN(34) + (size_t)l * DM * 2 * FFH, 2 * FFH, kb * 64, n0, (bf16*)(ws + WS_FINT) + (size_t)l * 2 * FFH * DM, DM, drow, scr, F.lane); return; } r -= I_FIN;
    if (r < I_FOUT) { const int kb = r / 64, nb = r % 64; transpose_item(IN(35) + (size_t)l * FFH * DM, DM, kb * 64, nb * 32, (bf16*)(ws + WS_FOUTT) + (size_t)l * DM * FFH, FFH, nb * 32, scr, F.lane); return; } r -= I_FOUT;
    { const int mi = r >> 3, q = r & 7, kb = q >> 2, nb = q & 3;
      const int d = mi >> 4, g = (mi >> 3) & 1, h = mi & 7;
      transpose_item(IN(17) + ((size_t)l * 32 + mi) * 128 * 128, 128, kb * 64, nb * 32, (bf16*)(ws + WS_GWT) + (((size_t)l * 8 + h) * 2 + d) * 256 * 128, 128, g * 128 + nb * 32, scr, F.lane); }
}
constexpr int QB = 16;
static_assert(I_LAYER % QB == 0, "queue batch");
constexpr int Q_P2 = 562 * QB, Q_P3 = 624 * QB, Q_P4 = 1374 * QB, Q_P5 = 1813 * QB, Q_P9 = I_LAYER;
constexpr int CW_Q = 8192;
__device__ __forceinline__ void pull_weight_items(const Frame& F, unsigned char* ws, int l, int upto) {
    if (l >= NL) return;
    unsigned* ctr = (unsigned*)(ws + WS_CTL) + CW_Q + 64 * l; float* scr = (float*)(F.ldsg + F.wave * 16384);
    const int upto_b = upto / QB;
    for (;;) {
        unsigned i = 0;
        if (F.lane == 0) asm volatile("global_atomic_add %0, %1, %2, off sc0\n\ts_waitcnt vmcnt(0)" : "=&v"(i) : "v"(ctr), "v"(1u) : "memory");
        i = (unsigned)__builtin_amdgcn_readfirstlane((int)i);
        if ((int)i >= upto_b) { if (F.lane == 0) asm volatile("global_atomic_sub %0, %1, off" :: "v"(ctr), "v"(1u) : "memory"); break; }
        for (int j = 0; j < QB; ++j) weight_item(F, ws, l, (int)i * QB + j, scr);
    }
}

constexpr int SQ_P5 = 5, SQ_P9 = 12, SQ_END = (SQ_P5 + SQ_P9) * 1024;
__device__ __forceinline__ void static_weight_items(const Frame& F, unsigned char* ws, int l, int c, int G, int k0, int nk) {
    if (l >= NL || G != 256 || c < 128) return;
    float* scr = (float*)(F.ldsg + F.wave * 16384); const int w = (c - 128) * 8 + F.wave;
    for (int k = 0; k < nk; ++k) weight_item(F, ws, l, (k0 + k) * 1024 + w, scr);
}

__global__ void __launch_bounds__(NWAVES * 64, 2) fwd_kernel(Args args) {
    extern __shared__ __attribute__((aligned(16))) unsigned char lds[];
    const int G0 = gridDim.x, c0 = (int)blockIdx.x;
    volatile LAS unsigned* MISC0 = (volatile LAS unsigned*)((LAS unsigned char*)lds + MISC_OFF);
    unsigned char* const ws0 = args.ws; float* const out0 = args.out;
    gu32* ctl = (gu32*)(ws0 + WS_CTL);
    for (int u = threadIdx.x; u < (LDS_BYTES - LDSCTL_OFF) / 4; u += NWAVES * 64) ((LAS unsigned*)((LAS unsigned char*)lds + LDSCTL_OFF))[u] = 0u;
    __syncthreads();
    if (threadIdx.x == 0) {
#pragma unroll
        for (int i = 0; i < 36; ++i) ((LAS unsigned long long*)((LAS unsigned char*)lds + INTAB_OFF))[i] = (unsigned long long)args.in[i]; }
    __syncthreads();
    XcdBarrier bar; bar.bar = (unsigned*)(ctl + CW_BAR); bar.x = 0; bar.st = nullptr;
    if (MK_N_LAUNCHES == 1) bar = xcd_barrier_post((unsigned*)(ctl + CW_BAR), MISC0 + 8);
    const int lo = args.ph_lo, hi = args.ph_hi;
    int ph = 0;
#ifndef PHMASK
#define PHMASK 0xFFFFFFFFu
#endif
#define PHASE_BEGIN(k) if (((PHMASK >> (k)) & 1u) && lo <= ph && ph < hi) { if ((k) == TSEL && threadIdx.x == 0) *(volatile LAS unsigned long long*)(MISC0 + 16) = __builtin_amdgcn_s_memrealtime(); unsigned char* ws = ws0; float* outp = out0; int tid_p = threadIdx.x, G = G0, c = c0; asm volatile("" : "+s"(ws), "+s"(outp), "+v"(tid_p), "+s"(G), "+s"(c)); const int vcu = (G % 8 == 0) ? (c % 8) * (G / 8) + c / 8 : c;     \
    Frame F; F.lds = (LAS unsigned char*)lds; F.ldsg = (char*)lds; F.MISC = (volatile LAS unsigned*)(F.lds + MISC_OFF); F.tid = tid_p; F.lane = tid_p & 63; F.wave = __builtin_amdgcn_readfirstlane(tid_p >> 6); F.G = G; F.vcu = vcu; \
    const int gw = vcu * NWAVES + F.wave, NGW = G * NWAVES, gt = vcu * 512 + F.tid, NGT = G * 512; (void)gw; (void)NGW; (void)gt; (void)NGT; \
    float* const X = outp + O_X; bf16* const Hb = (bf16*)(ws + WS_H); float* const MOD = (float*)(ws + WS_MOD); const float* const modl = MOD + (size_t)l_ * NCV * INW; (void)X; (void)Hb; (void)modl;
#define PHASE_END(k)   if (MK_N_LAUNCHES == 1 && ph + 1 < hi) { XcdBarrier b_ = bar; asm volatile("" : "+s"(b_.bar)); xcd_barrier(b_); } if ((k) == TSEL && threadIdx.x == 0) *(volatile LAS unsigned long long*)(MISC0 + 18) += __builtin_amdgcn_s_memrealtime() - *(volatile LAS unsigned long long*)(MISC0 + 16); } ++ph;
    int l_ = 0;

    PHASE_BEGIN(0)
    {
        if (!(c & 1)) { for (int it = F.vcu; it < NL * 64; it += G) s5_tables(F, it >> 6, it & 63, ws); }
        __syncthreads();
        { const float* lamp = IN(19); for (int i = gt; i < NL * 2 * 1024; i += NGT) ((float*)(ws + WS_SP))[i] = log1pf(expf(-lamp[i])); }
        float* scr = (float*)(F.ldsg + F.wave * 16384);
        { const int rest = (G == 256) ? I_LAYER - SQ_END : I_LAYER;
          for (int it = gw; it < I_LAYER + 3 * rest; it += NGW) { if (it < I_LAYER) weight_item(F, ws, 0, it, scr); else { const int q = it - I_LAYER, l = 1 + q / rest, r = q % rest; weight_item(F, ws, l, I_LAYER - rest + r, scr); } } }
        const float* ckp = IN(2); const float* cvp = IN(3);
        for (int i0 = gt; i0 < 2 * 1048576; i0 += 4 * NGT) { f32x4 a0[4], a1[4];
#pragma unroll
            for (int q = 0; q < 4; ++q) { const int i = i0 + q * NGT; if (i < 2 * 1048576) { const int which = i >> 20, j = i & 1048575; const GAS f32x4* s = (const GAS f32x4*)(which ? cvp : ckp) + (size_t)j * 2; a0[q] = s[0]; a1[q] = s[1]; } }
#pragma unroll
            for (int q = 0; q < 4; ++q) { const int i = i0 + q * NGT; if (i < 2 * 1048576) { const int which = i >> 20, j = i & 1048575;
                v4u o; o.x = pk2(a0[q].x, a0[q].y); o.y = pk2(a0[q].z, a0[q].w); o.z = pk2(a1[q].x, a1[q].y); o.w = pk2(a1[q].z, a1[q].w); ((GAS v4u*)(ws + (which ? WS_CV : WS_CK)))[j] = o; } } }
        const float* cctx = IN(7); const float* cvec = IN(6); const float* wmod = IN(8);
        for (int task = gt; task < 16 * NL * 3072; task += NGT) {
            const int n4 = task % 3072, l = (task / 3072) % NL, ks = task / (3072 * NL);
            f32x4 acc[NCV];
#pragma unroll
            for (int v = 0; v < NCV; ++v) acc[v] = (f32x4){0.f, 0.f, 0.f, 0.f};
            const GAS f32x4* wp = (const GAS f32x4*)(wmod + ((size_t)l * DM + ks * 128) * INW) + n4;
            for (int kb = 0; kb < 128; kb += 16) { f32x4 w[16];
#pragma unroll
                for (int j = 0; j < 16; ++j) w[j] = wp[(size_t)(kb + j) * (INW / 4)];
#pragma unroll
                for (int j = 0; j < 16; ++j) { const int kk = ks * 128 + kb + j;
#pragma unroll
                    for (int v = 0; v < NCV; ++v) { const float cnd = v == 0 ? cctx[kk] : cvec[(v - 1) * DM + kk]; const float sl = cnd * fsigmoid(cnd); acc[v] += w[j] * sl; } } }
#pragma unroll
            for (int v = 0; v < NCV; ++v) ((f32x4*)(ws + WS_MODP))[(((size_t)ks * NL + l) * NCV + v) * 3072 + n4] = acc[v];
        }
        if (c & 1) { __syncthreads(); for (int it = F.vcu; it < NL * 64; it += G) s5_tables(F, it >> 6, it & 63, ws); }
    }
    PHASE_END(0)
    PHASE_BEGIN(1)
        const float* bmod = IN(9);
        for (int i = gt; i < NL * NCV * 3072; i += NGT) { const int n4 = i % 3072, v = (i / 3072) % NCV, l = i / (3072 * NCV);
            f32x4 s = ((const f32x4*)(bmod + (size_t)l * INW))[n4];
            f32x4 pp[16];
#pragma unroll
            for (int ks = 0; ks < 16; ++ks) pp[ks] = ((const GAS f32x4*)(ws + WS_MODP))[(((size_t)ks * NL + l) * NCV + v) * 3072 + n4];
#pragma unroll
            for (int ks = 0; ks < 16; ++ks) s += pp[ks];
            ((f32x4*)MOD)[i] = s; }
    PHASE_END(1)
    PHASE_BEGIN(2)
        resnorm_rows<true, true, false, XRES_BF16 != 0>(F, IN(0), IN(1), X, (bf16*)(ws + WS_XB), nullptr, nullptr, nullptr, IN(10), MOD + 0 * DM, MOD + 1 * DM, Hb);
    PHASE_END(2)

    for (int l = 0; l < DBG_NL; ++l) {
        l_ = l;
        PHASE_BEGIN(3)
        {   pg8::SchedPlain S{(const char*)Hb, (const char*)(ws + WS_WINT) + (size_t)l * INW * DM * 2, 32, 48, G, c, (size_t)256 * DM * 2, (size_t)256 * DM * 2, DUPG1};
            pg8::EpiWin E{(bf16*)(ws + WS_XR), (bf16*)(ws + WS_XG), (bf16*)(ws + WS_UG), (bf16*)(ws + WS_Q), (bf16*)(ws + WS_K), (bf16*)(ws + WS_V), (bf16*)(ws + WS_G),
                          outp + O_K + (size_t)l * 256 * 1024, outp + O_V + (size_t)l * 256 * 1024};
            pg8::gemm_phase(F.lds, DM, DM, DM, S, E); }
        PHASE_END(3)
        PHASE_BEGIN(4)
        {
            { const bf16* XR = (const bf16*)(ws + WS_XR); bf16* XC = (bf16*)(ws + WS_XC); const GAS float* cw = (const GAS float*)(IN(15) + (size_t)l * 4 * 1024); const GAS float* cb = (const GAS float*)(IN(16) + (size_t)l * 1024);
              for (int i_ = gt; i_ < ROWS * 128 * DUP_CONV; i_ += NGT) { const int i = i_ % (ROWS * 128); const int row = i >> 7, c8 = (i & 127) * 8;
                  const int s0 = row < CTXR ? (row & ~255) : (CTXR + ((row - CTXR) & ~1023)), s1 = row < CTXR ? s0 + 256 : s0 + 1024;
                  v4u xw[4];
#pragma unroll
                  for (int k = 0; k < 4; ++k) { int rr = row + k - 1; rr = rr < s0 ? s0 : (rr >= s1 ? s1 - 1 : rr); xw[k] = *(const GAS v4u*)(XR + (size_t)rr * 1024 + c8); }
                  f32x4 cw0[4], cw1[4]; const f32x4 cb0 = *(const GAS f32x4*)(cb + c8), cb1 = *(const GAS f32x4*)(cb + c8 + 4);
#pragma unroll
                  for (int k = 0; k < 4; ++k) { cw0[k] = *(const GAS f32x4*)(cw + k * 1024 + c8); cw1[k] = *(const GAS f32x4*)(cw + k * 1024 + c8 + 4); }
                  float acc[8] = {cb0[0], cb0[1], cb0[2], cb0[3], cb1[0], cb1[1], cb1[2], cb1[3]};
#pragma unroll
                  for (int k = 0; k < 4; ++k) { const int rr = row + k - 1; const float ok = (rr >= s0 && rr < s1) ? 1.0f : 0.0f; float xv[8]; unpack8(xw[k], xv);
#pragma unroll
                      for (int e = 0; e < 8; ++e) acc[e] += ok * (e < 4 ? cw0[k][e] : cw1[k][e - 4]) * xv[e]; }
                  *(GAS v4u*)(XC + (size_t)row * 1024 + c8) = pack8(acc); } }
            for (int L = c; L < 128 * DUP_S5; L += G) { const int g = (L & 127) >> 1, pm = L & 1;
                { pg8::SchedOne S{(const char*)(ws + WS_UG) + ((size_t)g * 512 + pm * 256) * 256 * 2, (const char*)(ws + WS_ET) + ((size_t)l * 64 + g) * 65536 * 2, nullptr, nullptr, pm, g, 1}; pg8::EpiHloc E{(float*)(ws + WS_HLOC)};
                  pg8::gemm_phase(F.lds, 256, 256, 256, S, E); }
                { const float* HLOC = (const float*)(ws + WS_HLOC); bf16* HIN = (bf16*)(ws + WS_HIN); const GAS f32x2* LT = (const GAS f32x2*)(ws + WS_LT) + (size_t)l * 2 * 64 * 64;
                  const int nseq = pm ? 4 : 16, nch = pm ? 64 : 16;
                  for (int i = F.tid; i < nseq * 128; i += 512) { const int p = i & 63, d = (i >> 6) & 1, sq = i >> 7; const int seq = pm ? 16 + sq : sq, ch0 = pm ? 256 + sq * 64 : sq * 16;
                      const f32x2 lam = LT[(d * 64 + g) * 64 + p]; float hr = 0.f, hi_ = 0.f;
                      if (pm) { const f32x2 h0 = ((const f32x2*)IN(5))[((((size_t)sq * 4 + l) * 2 + d) * 64 + g) * 64 + p]; hr = h0.x; hi_ = h0.y; }
                      for (int kb = 0; kb < nch; kb += 16) { f32x2 hl[16];
#pragma unroll
                          for (int j = 0; j < 16; ++j) { const int ch = d == 0 ? ch0 + kb + j : ch0 + nch - 1 - kb - j; hl[j] = *(const GAS f32x2*)(HLOC + ((size_t)g * 512 + ch) * 256 + d * 128 + p * 2); }
#pragma unroll
                          for (int j = 0; j < 16; ++j) { const int ch = d == 0 ? ch0 + kb + j : ch0 + nch - 1 - kb - j; *(GAS unsigned*)(HIN + ((size_t)g * 512 + ch) * 256 + d * 128 + p * 2) = pk2(hr, hi_);
                              const float nr = lam.x * hr - lam.y * hi_ + hl[j].x, ni = lam.x * hi_ + lam.y * hr + hl[j].y; hr = nr; hi_ = ni; } }
                      if (!pm) ((f32x2*)(outp + O_S5))[((((size_t)seq * 4 + l) * 2 + d) * 64 + g) * 64 + p] = (f32x2){hr, hi_}; }
                  VM_WAIT(); __syncthreads(); }
                { pg8::SchedOne S{(const char*)(ws + WS_UG) + ((size_t)g * 512 + pm * 256) * 256 * 2, (const char*)(ws + WS_MT) + ((size_t)l * 64 + g) * 65536 * 2,
                                  (const char*)(ws + WS_HIN) + ((size_t)g * 512 + pm * 256) * 256 * 2, (const char*)(ws + WS_FT) + ((size_t)l * 64 + g) * 65536 * 2, pm, g, 2};
                  pg8::EpiS5Y E{(const bf16*)(ws + WS_UG), IN(27) + (size_t)l * 1024, (bf16*)(ws + WS_ZS)};
                  pg8::gemm_phase(F.lds, 256, 256, 256, S, E); }
            }
            __syncthreads();
            { float* rp = (float*)(F.ldsg + att::RPB_OFF); const bf16* Qb = (const bf16*)(ws + WS_Q); const bf16* Kb = (const bf16*)(ws + WS_K); const bf16* Vb = (const bf16*)(ws + WS_V); bf16* Ob = (bf16*)(ws + WS_YNA);
              for (int u_ = (c + G / 2) % G; u_ < 256 * DUP_ATT; u_ += G) { const int u = u_ & 255;
                  if (u < 128) { const int b = u >> 5, h = (u >> 2) & 7, rg = u & 3; const int lo_ = rg == 0 ? 0 : (rg == 1 ? 0 : (rg == 2 ? 4 : 8)), NT = (rg == 0 || rg == 3) ? 16 : 20;
                      for (int i = F.tid; i < 465; i += 512) rp[i] = IN(29)[((size_t)l * 8 + h) * 465 + i] * (1.0f / att::SCALE);
                      __syncthreads();
                      const size_t qoff = (size_t)(CTXR + b * 1024 + rg * 256) * 1024 + h * 128, koff = (size_t)(CTXR + b * 1024 + lo_ * 64) * 1024 + h * 128, coff = ((size_t)(b * 4 + l) * 512) * 1024 + h * 128;
                      att::attn_body<true, 1>(Qb + qoff, (const bf16*)(ws + WS_CK) + coff, (const bf16*)(ws + WS_CV) + coff, Kb + koff, Vb + koff, Ob + qoff, NT, lo_, rg, F.ldsg);
                  } else { const int b = (u - 128) >> 3, h = (u - 128) & 7; const size_t off = (size_t)(b * 256) * 1024 + h * 128;
                      att::attn_body<false, 2>(Qb + off, Kb + off, Vb + off, Kb + off, Vb + off, Ob + off, 4, 0, 0, F.ldsg); }
              } }
        }
        PHASE_END(4)
        PHASE_BEGIN(5)
        {   { pg8::SchedRg S{(const char*)(ws + WS_XC), (const char*)(ws + WS_GWT) + (size_t)l * 8 * 2 * 256 * 128 * 2, G, c};
              pg8::EpiRg E{(const bf16*)(ws + WS_XC), IN(18) + (size_t)l * 4 * 1024, (const float*)(ws + WS_SP) + (size_t)l * 2048, (f32x2*)(ws + WS_AB)};
              pg8::gemm_phase(F.lds, 128, 1024, 128, S, E); }
            { pg8::SchedPlain S{(const char*)(ws + WS_ZS), (const char*)(ws + WS_GLUT) + (size_t)l * 1024 * 1024 * 2, 32, 4, G, c, (size_t)256 * 1024 * 2, (size_t)256 * 1024 * 2, 1};
              pg8::EpiGlu E{(const bf16*)(ws + WS_ZS), (bf16*)(ws + WS_YS5)};
              pg8::gemm_phase(F.lds, 1024, 1024, 1024, S, E); }
            __syncthreads(); static_weight_items(F, ws, l + 1, c, G, 0, SQ_P5);
        }
        PHASE_END(5)
        PHASE_BEGIN(6)
        {
            { const GAS unsigned* AB = (const GAS unsigned*)(ws + WS_AB); GAS float* HF = (GAS float*)(ws + WS_HF); const GAS bf16* XG = (const GAS bf16*)(ws + WS_XG); GAS bf16* YRG = (GAS bf16*)(ws + WS_YRG);
              float* cs = (float*)F.ldsg;
              for (int task_ = (c + G / 2) % G; task_ < 320 * DUP_SCAN; task_ += G) { const int task = task_ % 320;
                  const bool lat = task >= 64 && task < 128; const int ti = lat ? task - 64 : (task < 64 ? task : task - 64); const int seq = ti >> 4, cb = ti & 15;
                  const int L = lat ? 1024 : 256, row0 = lat ? CTXR + seq * 1024 : seq * 256, ch = cb * 64 + F.lane, len = L / 8, t0 = row0 + F.wave * len;
                  __syncthreads();
                  float pf = 1.f, hf = 0.f, pb = 1.f, hb = 0.f;
                  for (int tb = 0; tb < len; tb += 16) { unsigned v[16];
#pragma unroll
                      for (int j = 0; j < 16; ++j) v[j] = AB[(size_t)(t0 + tb + j) * 1024 + ch];
#pragma unroll
                      for (int j = 0; j < 16; ++j) { const float a = 1.0f - bflo(v[j]); hf = a * hf + bfhi(v[j]); pf *= a; } }
                  for (int tb = len - 16; tb >= 0; tb -= 16) { unsigned v[16];
#pragma unroll
                      for (int j = 0; j < 16; ++j) v[j] = AB[((size_t)ROWS + t0 + tb + j) * 1024 + ch];
#pragma unroll
                      for (int j = 15; j >= 0; --j) { const float a = 1.0f - bflo(v[j]); hb = a * hb + bfhi(v[j]); pb *= a; } }
                  cs[(F.wave * 4 + 0) * 64 + F.lane] = pf; cs[(F.wave * 4 + 1) * 64 + F.lane] = hf; cs[(F.wave * 4 + 2) * 64 + F.lane] = pb; cs[(F.wave * 4 + 3) * 64 + F.lane] = hb;
                  __syncthreads();
                  float cf = lat ? IN(4)[((size_t)(seq * 4 + l) * 2 + 0) * 1024 + ch] : 0.f, cbk = lat ? IN(4)[((size_t)(seq * 4 + l) * 2 + 1) * 1024 + ch] : 0.f;
                  for (int w = 0; w < F.wave; ++w) cf = cs[(w * 4 + 0) * 64 + F.lane] * cf + cs[(w * 4 + 1) * 64 + F.lane];
                  for (int w = 7; w > F.wave; --w) cbk = cs[(w * 4 + 2) * 64 + F.lane] * cbk + cs[(w * 4 + 3) * 64 + F.lane];
                  if (!lat) { if (F.wave == 7) outp[O_RG + ((size_t)(seq * 4 + l) * 2 + 0) * 1024 + ch] = pf * cf + hf; if (F.wave == 0) outp[O_RG + ((size_t)(seq * 4 + l) * 2 + 1) * 1024 + ch] = pb * cbk + hb; }
                  float h = cf;
                  for (int tb = 0; tb < len; tb += 16) { unsigned v[16];
#pragma unroll
                      for (int j = 0; j < 16; ++j) v[j] = AB[(size_t)(t0 + tb + j) * 1024 + ch];
#pragma unroll
                      for (int j = 0; j < 16; ++j) { h = (1.0f - bflo(v[j])) * h + bfhi(v[j]); HF[(size_t)(t0 + tb + j) * 1024 + ch] = h; } }
                  VM_WAIT();
                  h = cbk;
                  for (int tb = len - 16; tb >= 0; tb -= 16) { unsigned v[16]; float hfv[16]; bf16 xg[16];
#pragma unroll
                      for (int j = 0; j < 16; ++j) { const size_t o = (size_t)(t0 + tb + j) * 1024 + ch; v[j] = AB[(size_t)ROWS * 1024 + o]; hfv[j] = HF[o]; xg[j] = XG[o]; }
#pragma unroll
                      for (int j = 15; j >= 0; --j) { h = (1.0f - bflo(v[j])) * h + bfhi(v[j]); YRG[(size_t)(t0 + tb + j) * 1024 + ch] = (bf16)f2bf((hfv[j] + h) * bf2f(xg[j])); } }
              } }
        }
        PHASE_END(6)
        PHASE_BEGIN(8)
        {   pg8::SchedMerge S{(const char*)(ws + WS_YRG), (const char*)(ws + WS_YS5), (const char*)(ws + WS_YNA), (const char*)(ws + WS_OUTT) + (size_t)l * 3 * DM * 1024 * 2, G, c};
            pg8::EpiMerge E{(const bf16*)(ws + WS_G), (bf16*)(ws + WS_MM)};
            pg8::gemm_phase(F.lds, 1024, 1024, 1024, S, E); }
        PHASE_END(8)
#if FUSE_NORM
        PHASE_BEGIN(9)
        {   pg8::SchedPlain S{(const char*)(ws + WS_MM), (const char*)(ws + WS_WOT) + (size_t)l * DM * DM * 2, 32, 8, G, c, (size_t)256 * DM * 2, (size_t)256 * DM * 2, 1};
            unsigned* ctlw = (unsigned*)(ws + WS_CTL); const int b0 = (l * 2 + 0) * 2;
            pg8::PanelSS s1{(float*)(ws + WS_XS) + (size_t)b0 * 65536, ctlw + CW_SEAM + b0 * SEAM_BANK, ctlw + CW_TMO}, s2{(float*)(ws + WS_XS) + (size_t)(b0 + 1) * 65536, ctlw + CW_SEAM + (b0 + 1) * SEAM_BANK, ctlw + CW_TMO};
            pg8::EpiResNorm E{X, Hb, IN(11) + (size_t)l * DM, modl + 2 * DM, IN(12) + (size_t)l * DM, modl + 3 * DM, modl + 4 * DM, s1, s2, 1};
            pg8::gemm_phase(F.lds, DM, DM, DM, S, E); }
        PHASE_END(9)
#else
        PHASE_BEGIN(9)
        {   pg8::SchedPlain S{(const char*)(ws + WS_MM), (const char*)(ws + WS_WOT) + (size_t)l * DM * DM * 2, 32, 8, G, c, (size_t)256 * DM * 2, (size_t)256 * DM * 2, 1};
            pg8::EpiB16 E{(bf16*)(ws + WS_Z), DM};
            pg8::gemm_phase(F.lds, DM, DM, DM, S, E); }
        PHASE_END(9)
        PHASE_BEGIN(10)
            resnorm_rows<false, true, XRES_BF16 != 0, XRES_BF16 != 0>(F, nullptr, nullptr, X, (bf16*)(ws + WS_XB), (const bf16*)(ws + WS_Z), IN(11) + (size_t)l * DM, modl + 2 * DM, IN(12) + (size_t)l * DM, modl + 3 * DM, modl + 4 * DM, Hb);
        PHASE_END(10)
#endif
        PHASE_BEGIN(11)
        {   pg8::SchedPlain S{(const char*)Hb, (const char*)(ws + WS_FINT) + (size_t)l * 2 * FFH * DM * 2, 32, 44, G, c, (size_t)256 * DM * 2, (size_t)256 * DM * 2, DUPG9};
            pg8::EpiSwiglu E{(bf16*)(ws + WS_FH)};
            pg8::gemm_phase(F.lds, DM, DM, DM, S, E);
            __syncthreads(); static_weight_items(F, ws, l + 1, c, G, SQ_P5, SQ_P9); }
        PHASE_END(11)
#if FUSE_NORM
        PHASE_BEGIN(12)
        {   pg8::SchedPlain S{(const char*)(ws + WS_FH), (const char*)(ws + WS_FOUTT) + (size_t)l * DM * FFH * 2, 32, 8, G, c, (size_t)256 * FFH * 2, (size_t)256 * FFH * 2, DUPG10};
            unsigned* ctlw = (unsigned*)(ws + WS_CTL); const int b0 = (l * 2 + 1) * 2; const int ln = l + 1 < NL ? l + 1 : l;
            pg8::PanelSS s1{(float*)(ws + WS_XS) + (size_t)b0 * 65536, ctlw + CW_SEAM + b0 * SEAM_BANK, ctlw + CW_TMO}, s2{(float*)(ws + WS_XS) + (size_t)(b0 + 1) * 65536, ctlw + CW_SEAM + (b0 + 1) * SEAM_BANK, ctlw + CW_TMO};
            pg8::EpiResNorm E{X, Hb, IN(13) + (size_t)l * DM, modl + 5 * DM, IN(10) + (size_t)ln * DM, MOD + (size_t)ln * NCV * INW + 0 * DM, MOD + (size_t)ln * NCV * INW + 1 * DM, s1, s2, (l + 1 < NL) ? 1 : 0};
            pg8::gemm_phase(F.lds, FFH, FFH, FFH, S, E); }
        PHASE_END(12)
#else
        PHASE_BEGIN(12)
        {   pg8::SchedPlain S{(const char*)(ws + WS_FH), (const char*)(ws + WS_FOUTT) + (size_t)l * DM * FFH * 2, 32, 8, G, c, (size_t)256 * FFH * 2, (size_t)256 * FFH * 2, DUPG10};
            pg8::EpiB16 E{(bf16*)(ws + WS_Z), DM};
            pg8::gemm_phase(F.lds, FFH, FFH, FFH, S, E); }
        PHASE_END(12)
        PHASE_BEGIN(13)
            if (l + 1 < NL) resnorm_rows<false, true, XRES_BF16 != 0, XRES_BF16 != 0>(F, nullptr, nullptr, X, (bf16*)(ws + WS_XB), (const bf16*)(ws + WS_Z), IN(13) + (size_t)l * DM, modl + 5 * DM, IN(10) + (size_t)(l + 1) * DM, modl + NCV * INW + 0 * DM, modl + NCV * INW + 1 * DM, Hb);
            else resnorm_rows<false, false, XRES_BF16 != 0, false>(F, nullptr, nullptr, X, (bf16*)(ws + WS_XB), (const bf16*)(ws + WS_Z), IN(13) + (size_t)l * DM, modl + 5 * DM, nullptr, nullptr, nullptr, Hb);
        PHASE_END(13)
#endif
    }
#if DBG_KEEP
    PHASE_BEGIN(14)
        for (size_t i = (size_t)gt; i < O_END; i += (size_t)NGT) {
            int r, lay = 0;
            if (i < O_K) r = i < O_K / 2 ? 0 : 1;
            else if (i < O_V) { r = 2; lay = (int)(((i - O_K) / (256 * 1024)) & 3); }
            else if (i < O_RG) { r = 3; lay = (int)(((i - O_V) / (256 * 1024)) & 3); }
            else if (i < O_S5) { r = 4; lay = (int)(((i - O_RG) / 2048) & 3); }
            else { r = 5; lay = (int)(((i - O_S5) / 16384) & 3); }
            const bool keep = ((DBG_KEEP >> r) & 1) && (r < 2 || ((DBG_LMASK >> lay) & 1));
            float v = keep ? 3.0f * outp[i] : 0.0f;
#if DBG_DUMP
            v = 0.f;
            if (i >= O_K && i < O_K + (size_t)ROWS * 1024) { const size_t j = i - O_K;
                if (DBG_DUMP == 1) v = bf2f(((const bf16*)(ws + WS_YNA))[j]);
                if (DBG_DUMP == 2) v = bf2f(((const bf16*)(ws + WS_YS5))[j]);
                if (DBG_DUMP == 3) v = bf2f(((const bf16*)(ws + WS_YRG))[j]);
                if (DBG_DUMP == 4) v = bf2f(((const bf16*)(ws + WS_ZS))[j]);
                if (DBG_DUMP == 5) v = bf2f(((const bf16*)(ws + WS_MM))[j]);
                if (DBG_DUMP == 6) v = ((const bf16*)(ws + WS_Z))[j];
                if (DBG_DUMP == 7) v = bf2f(((const bf16*)(ws + WS_FH))[j]);
                if (DBG_DUMP == 8) v = bf2f(((const bf16*)(ws + WS_H))[j]);
                if (DBG_DUMP == 9) v = bf2f(((const bf16*)(ws + WS_G))[j]);
                if (DBG_DUMP == 11) v = bf2f(((const bf16*)(ws + WS_G))[(size_t)8192 * 6144 + j]);
                if (DBG_DUMP == 10) v = bf2f(((const bf16*)(ws + WS_WINT))[(size_t)6144 * 2048 + j]);
            }
#endif
            outp[i] = v;
        }
    PHASE_END(14)
#endif
    if (TSEL >= 0 && blockIdx.x == 0 && threadIdx.x == 0) { const float us = (float)(*(volatile LAS unsigned long long*)(MISC0 + 18)) * 0.01f; out0[0] = exp2f(rintf(log2f(us) * 10.0f) * 0.1f); }
#undef PHASE_BEGIN
#undef PHASE_END
}
constexpr int N_PHASES = 3 + DBG_NL * (FUSE_NORM ? 8 : 10) + (DBG_KEEP ? 1 : 0);

extern "C" void kernel_launch(void* const* d_in, const int* in_sizes, int n_in, void* d_out, int out_size, void* d_ws, size_t ws_size, hipStream_t stream) {
    static int grid = 0;
    if (grid == 0) {
        if (n_in != 36 || out_size != (int)O_END || ws_size < WS_END) { fprintf(stderr, "kernel_launch: unexpected shapes (n_in %d out %d ws %zu)\n", n_in, out_size, ws_size); grid = -1; return; }
        int dev = 0, cus = 0, per_cu = 0;
        if (hipGetDevice(&dev) != hipSuccess || hipDeviceGetAttribute(&cus, hipDeviceAttributeMultiprocessorCount, dev) != hipSuccess) { grid = -1; return; }
        if (hipFuncSetAttribute((const void*)fwd_kernel, hipFuncAttributeMaxDynamicSharedMemorySize, LDS_BYTES) != hipSuccess) { fprintf(stderr, "kernel_launch: hipFuncSetAttribute failed\n"); grid = -1; return; }
        if (hipOccupancyMaxActiveBlocksPerMultiprocessor(&per_cu, (const void*)fwd_kernel, NWAVES * 64, LDS_BYTES) != hipSuccess || per_cu < 1) { fprintf(stderr, "kernel_launch: occupancy query reports %d blocks per CU\n", per_cu); }
        (void)hipGetLastError();
        grid = cus;
        if (FUSE_NORM && cus != 256) { fprintf(stderr, "kernel_launch: the fused residual+norm epilogues need exactly 256 workgroups (one 256x256 tile each); build with -DFUSE_NORM=0 for %d CUs\n", cus); grid = -1; return; }
    }
    if (grid < 0) return;
    if (hipMemsetAsync((char*)d_ws + WS_CTL, 0, CTL_ZERO_BYTES, stream) != hipSuccess) return;
    Args a{};
    for (int i = 0; i < 36; ++i) a.in[i] = (const float*)d_in[i];
    a.out = (float*)d_out; a.ws = (unsigned char*)d_ws;
    if (MK_N_LAUNCHES == 1) { a.ph_lo = 0; a.ph_hi = N_PHASES; hipLaunchKernelGGL(fwd_kernel, dim3(grid), dim3(NWAVES * 64), LDS_BYTES, stream, a); }
    else for (int p = 0; p < N_PHASES; ++p) { a.ph_lo = p; a.ph_hi = p + 1; hipLaunchKernelGGL(fwd_kernel, dim3(grid), dim3(NWAVES * 64), LDS_BYTES, stream, a); }
}
```
